# Optimizing an MI355X kernel written in HIP

```python
import math
import jax, jax.numpy as jnp
from jax import lax
import numpy as np

D_MODEL = 1024
BATCH = 16
SEQ = 2048
DEPTH = 1

D_MIX = D_MODEL
GDN_HEADS = 4
GDN_HEAD_DIM = 128
GDN_WIDTH = GDN_HEADS * GDN_HEAD_DIM
DIFF_HEADS = 4
DIFF_QK_DIM = 64
DIFF_V_DIM = 2 * DIFF_QK_DIM
DIFF_WIDTH = DIFF_HEADS * DIFF_V_DIM
CONV_K = 4
CHUNK = 64
Q_BLOCK = 128
NORM_EPS = 1e-6
SPLITS = (GDN_WIDTH, GDN_WIDTH, GDN_WIDTH, GDN_WIDTH, GDN_HEADS, GDN_HEADS,
          DIFF_HEADS * 2 * DIFF_QK_DIM, DIFF_HEADS * 2 * DIFF_QK_DIM, DIFF_WIDTH, DIFF_WIDTH)
D_IN_PROJ = 4 * GDN_WIDTH + 2 * GDN_HEADS + 4 * DIFF_HEADS * 2 * DIFF_QK_DIM

kernel_name = "hybrid_gdn_diffattn_parallel_heads"


def rmsnorm(x, w, eps=NORM_EPS):
    x32 = x.astype(jnp.float32)
    y = x32 * lax.rsqrt(jnp.mean(x32 * x32, axis=-1, keepdims=True) + eps)
    return (y * w.astype(jnp.float32)).astype(x.dtype)


def l2norm(x, eps=1e-6):
    return x * lax.rsqrt(jnp.sum(x * x, axis=-1, keepdims=True) + eps)


def causal_depthwise_conv(x, w):
    k_len, c = w.shape
    return lax.conv_general_dilated(
        x, w[:, None, :].astype(x.dtype), window_strides=(1,), padding=[(k_len - 1, 0)],
        dimension_numbers=("NWC", "WIO", "NWC"), feature_group_count=c)


def alibi_slopes(n_heads):
    return jnp.asarray(2.0 ** (-8.0 * (np.arange(n_heads) + 1) / n_heads), dtype=jnp.float32)


def chunk_gated_delta_rule(q, k, v, g, beta):
    b_sz, seq_len, n_h, dk = q.shape
    dv = v.shape[-1]
    n_chunks = seq_len // CHUNK

    def to_chunks(t):
        t = jnp.moveaxis(t, 2, 1)
        return t.reshape((b_sz, n_h, n_chunks, CHUNK) + t.shape[3:])

    q, k, v, g, beta = (to_chunks(t) for t in (q, k, v, g, beta))
    q = q * (dk ** -0.5)
    g_cum = jnp.cumsum(g, axis=-1)
    idx = jnp.arange(CHUNK)
    tril = idx[:, None] >= idx[None, :]
    strict = idx[:, None] > idx[None, :]
    decay = jnp.exp(jnp.where(tril, g_cum[..., :, None] - g_cum[..., None, :], -jnp.inf))
    k_beta = k * beta[..., None]
    v_beta = v * beta[..., None]
    m = jnp.where(strict, jnp.einsum("bhncd,bhnsd->bhncs", k_beta, k) * decay, 0.0)
    eye = jnp.eye(CHUNK, dtype=jnp.float32)
    t_inv = lax.linalg.triangular_solve(eye + m, jnp.broadcast_to(eye, m.shape),
                                        left_side=True, lower=True)
    u = jnp.einsum("bhncs,bhnsd->bhncd", t_inv, v_beta)
    w = jnp.einsum("bhncs,bhnsd->bhncd", t_inv, k_beta * jnp.exp(g_cum)[..., None])
    a_qk = jnp.einsum("bhncd,bhnsd->bhncs", q, k) * decay
    q_dec = q * jnp.exp(g_cum)[..., None]
    g_last = g_cum[..., -1]
    k_dec = k * jnp.exp(g_last[..., None] - g_cum)[..., None]

    def step(state, xs):
        u_i, w_i, a_i, qd_i, kd_i, gl_i = xs
        v_new = u_i - jnp.einsum("bhcd,bhde->bhce", w_i, state)
        o_i = (jnp.einsum("bhcd,bhde->bhce", qd_i, state)
               + jnp.einsum("bhcs,bhse->bhce", a_i, v_new))
        state = (state * jnp.exp(gl_i)[..., None, None]
                 + jnp.einsum("bhcd,bhce->bhde", kd_i, v_new))
        return state, o_i

    xs = tuple(jnp.moveaxis(t, 2, 0) for t in (u, w, a_qk, q_dec, k_dec, g_last))
    s0 = jnp.zeros((b_sz, n_h, dk, dv), dtype=jnp.float32)
    _, o = lax.scan(step, s0, xs)
    o = jnp.moveaxis(o, 0, 2).reshape(b_sz, n_h, seq_len, dv)
    return jnp.moveaxis(o, 1, 2)


def diff_attention(q, k, v, slopes, lam):
    b_sz, seq_len, n_h, _, dq = q.shape
    dv = v.shape[-1]
    n_blocks = seq_len // Q_BLOCK
    scale = dq ** -0.5
    kpos = jnp.arange(seq_len)
    q_blocks = jnp.moveaxis(q.reshape(b_sz, n_blocks, Q_BLOCK, n_h, 2, dq), 1, 0)

    def block(args):
        qb, start = args
        s = jnp.einsum("bqhcd,bkhcd->bhcqk", qb, k).astype(jnp.float32) * scale
        qpos = start + jnp.arange(Q_BLOCK)
        dist = (qpos[:, None] - kpos[None, :]).astype(jnp.float32)
        bias = -slopes[:, None, None, None] * dist
        s = jnp.where(dist >= 0, s + bias[None], -jnp.inf)
        p = jax.nn.softmax(s, axis=-1)
        p = p[:, :, 0] - lam * p[:, :, 1]
        return jnp.einsum("bhqk,bkhd->bqhd", p.astype(v.dtype), v)

    starts = jnp.arange(n_blocks) * Q_BLOCK
    o = lax.map(block, (q_blocks, starts))
    return jnp.moveaxis(o, 0, 1).reshape(b_sz, seq_len, n_h, dv)


def hybrid_layer(x, norm_w, w_in, conv_w, a_log, dt_bias, gdn_norm_w,
                 lambda_q1, lambda_k1, lambda_q2, lambda_k2, diff_norm_w, w_out, layer_idx):
    b_sz, seq_len, _ = x.shape
    f32 = jnp.float32
    h = rmsnorm(x, norm_w)
    proj = h @ w_in
    split_pts = np.cumsum(SPLITS)[:-1]
    gq, gk, gv, gz, gb, ga, dq, dk, dvv, dz = jnp.split(proj, split_pts, axis=-1)

    qkv = jax.nn.silu(causal_depthwise_conv(jnp.concatenate([gq, gk, gv], axis=-1), conv_w))
    gq, gk, gv = jnp.split(qkv.astype(f32), 3, axis=-1)
    shp = (b_sz, seq_len, GDN_HEADS, GDN_HEAD_DIM)
    gq = l2norm(gq.reshape(shp))
    gk = l2norm(gk.reshape(shp))
    gv = gv.reshape(shp)
    beta = jax.nn.sigmoid(gb.astype(f32))
    g = -jnp.exp(a_log.astype(f32)) * jax.nn.softplus(ga.astype(f32) + dt_bias.astype(f32))
    o_a = chunk_gated_delta_rule(gq, gk, gv, g, beta)
    o_a = rmsnorm(o_a, gdn_norm_w) * jax.nn.silu(gz.astype(f32).reshape(shp))
    o_a = o_a.reshape(b_sz, seq_len, GDN_WIDTH).astype(x.dtype)

    lam_init = 0.8 - 0.6 * math.exp(-0.3 * layer_idx)
    lam = (jnp.exp(jnp.sum(lambda_q1.astype(f32) * lambda_k1.astype(f32)))
           - jnp.exp(jnp.sum(lambda_q2.astype(f32) * lambda_k2.astype(f32))) + lam_init)
    dq = dq.reshape(b_sz, seq_len, DIFF_HEADS, 2, DIFF_QK_DIM)
    dk = dk.reshape(b_sz, seq_len, DIFF_HEADS, 2, DIFF_QK_DIM)
    dvv = dvv.reshape(b_sz, seq_len, DIFF_HEADS, DIFF_V_DIM)
    o_b = diff_attention(dq, dk, dvv, alibi_slopes(DIFF_HEADS), lam)
    o_b = rmsnorm(o_b.astype(f32), diff_norm_w) * (1.0 - lam_init)
    o_b = o_b.reshape(b_sz, seq_len, DIFF_WIDTH) * jax.nn.silu(dz.astype(f32))
    o_b = o_b.astype(x.dtype)

    mix = jnp.concatenate([o_a, o_b], axis=-1) @ w_out
    return x + mix


def setup_inputs(seed: int = 0) -> dict:
    key = jax.random.key(seed)
    ks = jax.random.split(key, 16)
    f32 = jnp.float32
    x = jax.random.normal(ks[0], (BATCH, SEQ, D_MODEL), f32)
    norm_w = 1.0 + 0.01 * jax.random.normal(ks[1], (DEPTH, D_MODEL), f32)
    w_in = jax.random.normal(ks[2], (DEPTH, D_MODEL, D_IN_PROJ), f32) * D_MODEL ** -0.5
    conv_w = jax.random.normal(ks[3], (DEPTH, CONV_K, 3 * GDN_WIDTH), f32) * CONV_K ** -0.5
    a_log = jnp.log(jax.random.uniform(ks[4], (DEPTH, GDN_HEADS), f32, 1.0, 16.0))
    dt = jnp.exp(jax.random.uniform(ks[5], (DEPTH, GDN_HEADS), f32,
                                    math.log(1e-3), math.log(1e-1)))
    dt_bias = dt + jnp.log(-jnp.expm1(-dt))
    gdn_norm_w = 1.0 + 0.01 * jax.random.normal(ks[6], (DEPTH, GDN_HEAD_DIM), f32)
    lambda_q1 = 0.1 * jax.random.normal(ks[7], (DEPTH, DIFF_QK_DIM), f32)
    lambda_k1 = 0.1 * jax.random.normal(ks[8], (DEPTH, DIFF_QK_DIM), f32)
    lambda_q2 = 0.1 * jax.random.normal(ks[9], (DEPTH, DIFF_QK_DIM), f32)
    lambda_k2 = 0.1 * jax.random.normal(ks[10], (DEPTH, DIFF_QK_DIM), f32)
    diff_norm_w = 1.0 + 0.01 * jax.random.normal(ks[11], (DEPTH, DIFF_V_DIM), f32)
    w_out = jax.random.normal(ks[12], (DEPTH, D_MIX, D_MODEL), f32) * D_MIX ** -0.5
    final_norm_w = 1.0 + 0.01 * jax.random.normal(ks[13], (D_MODEL,), f32)
    return {"x": x, "norm_w": norm_w, "w_in": w_in, "conv_w": conv_w, "a_log": a_log,
            "dt_bias": dt_bias, "gdn_norm_w": gdn_norm_w, "lambda_q1": lambda_q1,
            "lambda_k1": lambda_k1, "lambda_q2": lambda_q2, "lambda_k2": lambda_k2,
            "diff_norm_w": diff_norm_w, "w_out": w_out, "final_norm_w": final_norm_w}


def reference(x, norm_w, w_in, conv_w, a_log, dt_bias, gdn_norm_w, lambda_q1, lambda_k1,
              lambda_q2, lambda_k2, diff_norm_w, w_out, final_norm_w):
    for i in range(DEPTH):
        x = hybrid_layer(x, norm_w[i], w_in[i], conv_w[i], a_log[i], dt_bias[i], gdn_norm_w[i],
                         lambda_q1[i], lambda_k1[i], lambda_q2[i], lambda_k2[i],
                         diff_norm_w[i], w_out[i], layer_idx=i)
    return rmsnorm(x, final_norm_w)
```

```cpp
#include <hip/hip_runtime.h>
#include <hip/hip_cooperative_groups.h>
#include <cstdio>
namespace cg = cooperative_groups;

#ifndef ENABLE_ATTN
#define ENABLE_ATTN 1
#endif
#ifndef ENABLE_GDN
#define ENABLE_GDN 1
#endif

#define LAS __attribute__((address_space(3)))
#define DI __device__ __forceinline__
typedef unsigned short bf16_t;
typedef short bf16x8 __attribute__((ext_vector_type(8)));
typedef short s16x4 __attribute__((ext_vector_type(4)));
typedef float f32x2 __attribute__((ext_vector_type(2)));
typedef float f32x4 __attribute__((ext_vector_type(4)));
typedef float f32x16 __attribute__((ext_vector_type(16)));
typedef unsigned u32x2 __attribute__((ext_vector_type(2)));
typedef unsigned u32x4 __attribute__((ext_vector_type(4)));
typedef __bf16 bf16x2_t __attribute__((ext_vector_type(2)));

#define MFMA32(a, b, c) __builtin_amdgcn_mfma_f32_32x32x16_bf16((a), (b), (c), 0, 0, 0)

constexpr int NB = 16, SEQ = 2048, DM = 1024, MTOK = NB * SEQ, NP1 = 3584;
constexpr int C_GQ = 0, C_GK = 512, C_GV = 1024, C_GZ = 1536, C_DQ = 2048, C_DK = 2560, C_DZ = 3072;
constexpr float EPS = 1e-6f;
constexpr float LOG2E = 1.4426950408889634f;

constexpr size_t OFF_HB = 0;
constexpr size_t OFF_WINT = OFF_HB + (size_t)MTOK * DM * 2;
constexpr size_t OFF_WOUTT = OFF_WINT + (size_t)4096 * 1024 * 2;
constexpr size_t OFF_GBGA = OFF_WOUTT + (size_t)1024 * 1024 * 2;
constexpr size_t OFF_P1 = OFF_GBGA + (size_t)MTOK * 8 * 4;
constexpr size_t OFF_VT = OFF_P1 + (size_t)MTOK * NP1 * 2;
constexpr size_t OFF_WN = OFF_VT + (size_t)64 * 128 * 2048 * 2;
constexpr size_t OFF_QD = OFF_WN + (size_t)2048 * 64 * 128 * 2;
constexpr size_t OFF_KD = OFF_QD + (size_t)2048 * 64 * 128 * 2;
constexpr size_t OFF_AQK = OFF_KD + (size_t)2048 * 64 * 128 * 2;
constexpr size_t OFF_U = OFF_AQK + (size_t)2048 * 64 * 64 * 2;
constexpr size_t OFF_GL = OFF_U + (size_t)2048 * 64 * 128 * 4;
constexpr size_t OFF_ROWSQ = OFF_GL + 8192;
constexpr size_t OFF_MISC = OFF_ROWSQ + (size_t)MTOK * 16 * 4;
constexpr size_t WS_END = OFF_MISC + 256;

constexpr int LDS_BYTES = 156 * 1024;

struct Params {
    const float *x, *norm_w, *w_in, *conv_w, *a_log, *dt_bias, *gdn_norm_w, *lq1, *lk1, *lq2, *lk2, *diff_norm_w, *w_out, *final_norm_w;
    float* out; unsigned char* ws;
};

DI unsigned pk_bf16(float a, float b) { f32x2 v = {a, b}; bf16x2_t r = __builtin_convertvector(v, bf16x2_t); return __builtin_bit_cast(unsigned, r); }
DI float bf_lo(unsigned u) { return __uint_as_float(u << 16); }
DI float bf_hi(unsigned u) { return __uint_as_float(u & 0xffff0000u); }
DI float wave_sum(float v) {
#pragma unroll
    for (int o = 32; o; o >>= 1) v += __shfl_xor(v, o);
    return v;
}
DI float silu_f(float z) { return z / (1.0f + __expf(-z)); }
DI int perm23(int t) { return (t & ~12) | ((t & 4) << 1) | ((t & 8) >> 1); }

namespace pg8 {
constexpr int BM = 256, BK = 64, HALF = 128, HTB = HALF * BK * 2, STAGE_BYTES = 8 * HTB, NXCD = 8, WGM = 8;
DI int lds_byte(int r, int c) { const int st = (r >> 4) * 2 + (c >> 5), rr = r & 15, cc = c & 31, ob = rr * 64 + cc * 2; return st * 1024 + (ob ^ (((ob >> 9) & 1) << 5)); }
DI void stage_rc(int b, int& R, int& C) { const int st = b / 1024, sb = b % 1024, swz = sb ^ (((sb >> 9) & 1) << 5); R = (st >> 1) * 16 + swz / 64; C = (st & 1) * 32 + (swz % 64) / 2; }
DI int perm32(int rho) { const int n = rho >> 4, i = rho & 15; return 8 * (i >> 2) + 4 * n + (i & 3); }
struct Unit { int pm, pn; };
struct Gemm { const bf16_t* A; const bf16_t* Bt; int M, N, K; };
struct StaticOrder {
    int nM, nN, nwg, G, c;
    DI void init(int M, int N, int G_, int c_) { nM = M / BM; nN = N / BM; nwg = nM * nN; G = G_; c = c_; }
    DI bool next(int i, Unit& u) const {
        const long L = (long)i * G + c; if (L >= nwg) return false;
        int wgid = (int)L; { const int q = nwg / NXCD, r = nwg % NXCD, xcd = wgid % NXCD, off = wgid / NXCD; wgid = (xcd < r ? xcd * (q + 1) : r * (q + 1) + (xcd - r) * q) + off; }
        const int nig = WGM * nN, gid = wgid / nig, fm = gid * WGM, gsz = (nM - fm) < WGM ? (nM - fm) : WGM;
        u.pm = fm + ((wgid % nig) % gsz); u.pn = (wgid % nig) / gsz; return true;
    }
    DI void a_ready(const Unit&) const {}
    DI void done(const Unit&) const {}
};

struct EpiP1 {
    static constexpr bool PERM = true;
    bf16_t* O; int ldc;
    DI void operator()(const f32x4 (&acc)[2][2][4][2], const Unit& u, int wr, int wc, int fr, int fq) const {
        const int row0 = u.pm * BM + wr * 64 + fr, col0 = u.pn * BM + wc * 32 + 8 * fq;
#pragma unroll
        for (int ai = 0; ai < 2; ++ai)
#pragma unroll
            for (int m = 0; m < 4; ++m) { bf16_t* rowp = O + (size_t)(row0 + ai * HALF + m * 16) * ldc + col0;
#pragma unroll
                for (int bj = 0; bj < 2; ++bj) { const f32x4 v0 = acc[ai][bj][m][0], v1 = acc[ai][bj][m][1];
                    u32x4 w; w.x = pk_bf16(v0[0], v0[1]); w.y = pk_bf16(v0[2], v0[3]); w.z = pk_bf16(v1[0], v1[1]); w.w = pk_bf16(v1[2], v1[3]);
                    *(u32x4*)(rowp + bj * HALF) = w; } }
    }
};
struct EpiVT {
    static constexpr bool PERM = false;
    bf16_t* VT;
    DI void operator()(const f32x4 (&acc)[2][2][4][2], const Unit& u, int wr, int wc, int fr, int fq) const {
#pragma unroll
        for (int ai = 0; ai < 2; ++ai)
#pragma unroll
            for (int m = 0; m < 4; ++m) {
                const int t = u.pm * BM + ai * HALF + wr * 64 + m * 16 + 4 * fq, b = t >> 11, tok = t & 2047, pos = perm23(tok);
#pragma unroll
                for (int bj = 0; bj < 2; ++bj)
#pragma unroll
                    for (int n = 0; n < 2; ++n) {
                        const int c = u.pn * BM + bj * HALF + wc * 32 + n * 16 + fr, hh = c >> 7, dv = c & 127;
                        const f32x4 v = acc[ai][bj][m][n];
                        u32x2 w; w.x = pk_bf16(v[0], v[1]); w.y = pk_bf16(v[2], v[3]);
                        *(u32x2*)(VT + ((size_t)((b * 4 + hh) * 128 + dv)) * 2048 + pos) = w;
                    }
            }
    }
};
struct EpiOut {
    static constexpr bool PERM = false;
    const float* X; float* Y; float* rowsq;
    DI void operator()(const f32x4 (&acc)[2][2][4][2], const Unit& u, int wr, int wc, int fr, int fq) const {
        const int row0 = u.pm * BM + wr * 64 + fr, col0 = u.pn * BM + wc * 32 + 4 * fq;
#pragma unroll
        for (int ai = 0; ai < 2; ++ai)
#pragma unroll
            for (int m = 0; m < 4; ++m) {
                const int row = row0 + ai * HALF + m * 16; float ss = 0.f;
#pragma unroll
                for (int bj = 0; bj < 2; ++bj)
#pragma unroll
                    for (int n = 0; n < 2; ++n) {
                        const size_t o = (size_t)row * DM + col0 + bj * HALF + n * 16;
                        const f32x4 xv = *(const f32x4*)(X + o); const f32x4 y = acc[ai][bj][m][n] + xv;
                        *(f32x4*)(Y + o) = y; ss += y[0] * y[0] + y[1] * y[1] + y[2] * y[2] + y[3] * y[3];
                    }
                ss += __shfl_xor(ss, 16); ss += __shfl_xor(ss, 32);
                if (fq == 0) rowsq[(size_t)row * 16 + u.pn * 4 + wc] = ss;
            }
    }
};

template <class Epi, bool SWAP>
DI void gemm_phase(LAS unsigned char* lds, const Gemm g, const StaticOrder& S, const Epi& E) {
    int tid = threadIdx.x; asm volatile("" : "+v"(tid));
    const int wid = __builtin_amdgcn_readfirstlane(tid >> 6), lane = tid & 63, wr = wid >> 2, wc = wid & 3, fr = lane & 15, fq = lane >> 4;
    const int K = g.K, nt = K / BK;
    unsigned voffA[2], voffB[2];
#pragma unroll
    for (int i = 0; i < 2; ++i) { int R, C; stage_rc(tid * 16 + i * 8192, R, C); const int Rb = Epi::PERM ? ((R & ~31) + perm32(R & 31)) : R;
        voffA[i] = (unsigned)(R * K + C) * 2u; voffB[i] = (unsigned)(Rb * K + C) * 2u; }
    const size_t kstep = (size_t)(BK * 2);
    const size_t hstep = (size_t)HALF * K * 2;
    const size_t tstep = 2 * hstep;
    const unsigned ldsw = (unsigned)wid * 1024u;
    const int aoff = lds_byte(wr * 64 + fr, fq * 8), boff = lds_byte(wc * 32 + fr, fq * 8);
#define PG8_SA(b, h) (((b) * 2 + (h)) * HTB)
#define PG8_SB(b, h) ((4 + (b) * 2 + (h)) * HTB)
#define PG8_STAGE(bufoff, gbase, voff) do { _Pragma("unroll") for (int _i = 0; _i < 2; ++_i) \
        __builtin_amdgcn_global_load_lds((const unsigned*)((const char*)(gbase) + (voff)[_i]), (LAS unsigned*)(lds + (bufoff) + ldsw + _i * 8192), 16, 0, 0); } while (0)
#define PG8_LDA(dst, b, h) do { _Pragma("unroll") for (int m = 0; m < 4; ++m) _Pragma("unroll") for (int k = 0; k < 2; ++k) dst[m][k] = *(const LAS bf16x8*)(lds + PG8_SA(b, h) + aoff + m * 2048 + k * 1024); } while (0)
#define PG8_LDB(dst, b, h) do { _Pragma("unroll") for (int n = 0; n < 2; ++n) _Pragma("unroll") for (int k = 0; k < 2; ++k) dst[n][k] = *(const LAS bf16x8*)(lds + PG8_SB(b, h) + boff + n * 2048 + k * 1024); } while (0)
#define PG8_MMA(ai, bj, At, Bt) do { __builtin_amdgcn_s_setprio(1); _Pragma("unroll") for (int m = 0; m < 4; ++m) _Pragma("unroll") for (int n = 0; n < 2; ++n) _Pragma("unroll") for (int k = 0; k < 2; ++k) \
        acc[ai][bj][m][n] = SWAP ? __builtin_amdgcn_mfma_f32_16x16x32_bf16(At[m][k], Bt[n][k], acc[ai][bj][m][n], 0, 0, 0) \
                                 : __builtin_amdgcn_mfma_f32_16x16x32_bf16(Bt[n][k], At[m][k], acc[ai][bj][m][n], 0, 0, 0); __builtin_amdgcn_s_setprio(0); } while (0)
#define PG8_WAIT_V(n) asm volatile("s_waitcnt vmcnt(" #n ")" ::: "memory")
#define PG8_WAIT_L(n) asm volatile("s_waitcnt lgkmcnt(" #n ")" ::: "memory")
#define PG8_BAR __builtin_amdgcn_s_barrier()
#define PG8_SCHED __builtin_amdgcn_sched_barrier(0)
    Unit cur, nxt; int ui = 0;
    if (!S.next(0, cur)) return;
    f32x4 acc[2][2][4][2];
#pragma unroll
    for (int a = 0; a < 2; ++a)
#pragma unroll
        for (int b = 0; b < 2; ++b)
#pragma unroll
            for (int m = 0; m < 4; ++m)
#pragma unroll
                for (int n = 0; n < 2; ++n) acc[a][b][m][n] = (f32x4){0.f, 0.f, 0.f, 0.f};
    bf16x8 At[4][2], B0[2][2], B1[2][2];
    const char* cA = (const char*)g.A + (size_t)cur.pm * tstep; const char* cB = (const char*)g.Bt + (size_t)cur.pn * tstep;
    PG8_STAGE(PG8_SB(0, 0), cB, voffB); PG8_STAGE(PG8_SA(0, 0), cA, voffA); PG8_STAGE(PG8_SB(0, 1), cB + hstep, voffB); PG8_STAGE(PG8_SA(0, 1), cA + hstep, voffA);
    if (wr == 1) PG8_BAR;
    PG8_WAIT_V(4); PG8_BAR;
    PG8_STAGE(PG8_SB(1, 0), cB + kstep, voffB); PG8_STAGE(PG8_SA(1, 0), cA + kstep, voffA); PG8_STAGE(PG8_SB(1, 1), cB + hstep + kstep, voffB);
    PG8_WAIT_V(6); PG8_BAR;
    for (;;) {
        const bool has_next = S.next(ui + 1, nxt);
        const char* nA = has_next ? (const char*)g.A + (size_t)nxt.pm * tstep : cA; const char* nB = has_next ? (const char*)g.Bt + (size_t)nxt.pn * tstep : cB;
        for (int t = 0; t < nt; t += 2) {
            const bool last = (t == nt - 2);
            const char* a1 = cA + (size_t)(t + 1) * kstep;
            const char* a2 = last ? nA : cA + (size_t)(t + 2) * kstep; const char* b2 = last ? nB : cB + (size_t)(t + 2) * kstep;
            const char* a3 = a2 + kstep; const char* b3 = b2 + kstep;
            PG8_LDB(B0, 0, 0); PG8_SCHED; PG8_LDA(At, 0, 0); PG8_STAGE(PG8_SA(1, 1), a1 + hstep, voffA);
            PG8_WAIT_L(8); PG8_BAR; PG8_WAIT_L(0); PG8_MMA(0, 0, At, B0); PG8_BAR; PG8_SCHED;
            PG8_LDB(B1, 0, 1); PG8_STAGE(PG8_SB(0, 0), b2, voffB);
            PG8_BAR; PG8_WAIT_L(0); PG8_MMA(0, 1, At, B1); PG8_BAR;
            PG8_LDA(At, 0, 1); PG8_STAGE(PG8_SA(0, 0), a2, voffA);
            PG8_BAR; PG8_WAIT_L(0); PG8_MMA(1, 0, At, B0); PG8_BAR; PG8_SCHED;
            PG8_STAGE(PG8_SB(0, 1), b2 + hstep, voffB);
            PG8_WAIT_V(6); PG8_BAR; PG8_MMA(1, 1, At, B1); PG8_BAR;
            PG8_LDB(B0, 1, 0); PG8_SCHED; PG8_LDA(At, 1, 0); PG8_STAGE(PG8_SA(0, 1), a2 + hstep, voffA);
            PG8_WAIT_L(8); PG8_BAR; PG8_WAIT_L(0); PG8_MMA(0, 0, At, B0); PG8_BAR; PG8_SCHED;
            PG8_LDB(B1, 1, 1); PG8_STAGE(PG8_SB(1, 0), b3, voffB);
            PG8_BAR; PG8_WAIT_L(0); PG8_MMA(0, 1, At, B1); PG8_BAR;
            PG8_LDA(At, 1, 1); PG8_STAGE(PG8_SA(1, 0), a3, voffA);
            PG8_BAR; PG8_WAIT_L(0); PG8_MMA(1, 0, At, B0); PG8_BAR; PG8_SCHED;
            PG8_STAGE(PG8_SB(1, 1), b3 + hstep, voffB);
            PG8_WAIT_V(6); PG8_BAR; PG8_MMA(1, 1, At, B1); PG8_BAR;
        }
        E(acc, cur, wr, wc, fr, fq);
        if (!has_next) break;
#pragma unroll
        for (int a = 0; a < 2; ++a)
#pragma unroll
            for (int b = 0; b < 2; ++b)
#pragma unroll
                for (int m = 0; m < 4; ++m)
#pragma unroll
                    for (int n = 0; n < 2; ++n) acc[a][b][m][n] = (f32x4){0.f, 0.f, 0.f, 0.f};
        cur = nxt; cA = nA; cB = nB; ++ui;
    }
    PG8_WAIT_V(0);
    if (wr == 0) PG8_BAR;
    PG8_BAR;
#undef PG8_SA
#undef PG8_SB
#undef PG8_STAGE
#undef PG8_LDA
#undef PG8_LDB
#undef PG8_MMA
#undef PG8_WAIT_V
#undef PG8_WAIT_L
#undef PG8_BAR
#undef PG8_SCHED
}
}

DI int win_src_col(int n0) {
    if (n0 < 2048) return n0;
    if (n0 < 2560) return 2056 + (n0 - 2048);
    if (n0 < 3072) return 2568 + (n0 - 2560);
    if (n0 < 3584) return 3592 + (n0 - 3072);
    return 3080 + (n0 - 3584);
}
DI void phase_prep(const Params& p, LAS unsigned char* lds) {
    const int tid = threadIdx.x, lane = tid & 63, wid = tid >> 6;
    if (blockIdx.x == 0 && wid == 0) {
        float a = p.lq1[lane] * p.lk1[lane], b = p.lq2[lane] * p.lk2[lane];
        a = wave_sum(a); b = wave_sum(b);
        if (lane == 0) { *(float*)(p.ws + OFF_MISC) = expf(a) - expf(b) + 0.2f; *(unsigned*)(p.ws + OFF_MISC + 4) = 0u; }
    }
    bf16_t* hb = (bf16_t*)(p.ws + OFF_HB);
    float* gbga = (float*)(p.ws + OFF_GBGA);
    const int gw = blockIdx.x * 8 + wid, nw = gridDim.x * 8;
    for (int row = gw; row < MTOK; row += nw) {
        const f32x4* xr = (const f32x4*)(p.x + (size_t)row * DM);
        f32x4 v[4]; float ss = 0.f;
#pragma unroll
        for (int i = 0; i < 4; ++i) { v[i] = xr[lane + 64 * i]; ss += v[i][0] * v[i][0] + v[i][1] * v[i][1] + v[i][2] * v[i][2] + v[i][3] * v[i][3]; }
        ss = wave_sum(ss);
        const float rstd = rsqrtf(ss * (1.0f / DM) + EPS);
        float a8[8];
#pragma unroll
        for (int j = 0; j < 8; ++j) a8[j] = 0.f;
#pragma unroll
        for (int i = 0; i < 4; ++i) {
            const f32x4 nwv = ((const f32x4*)p.norm_w)[lane + 64 * i];
            const f32x4 h = v[i] * rstd * nwv;
            u32x2 w; w.x = pk_bf16(h[0], h[1]); w.y = pk_bf16(h[2], h[3]);
            *(u32x2*)(hb + (size_t)row * DM + 4 * (lane + 64 * i)) = w;
#pragma unroll
            for (int e = 0; e < 4; ++e) {
                const int k = 4 * (lane + 64 * i) + e;
                const f32x4* wp = (const f32x4*)(p.w_in + (size_t)k * 4104 + 2048);
                const f32x4 w0 = wp[0], w1 = wp[1];
#pragma unroll
                for (int j = 0; j < 4; ++j) { a8[j] += h[e] * w0[j]; a8[4 + j] += h[e] * w1[j]; }
            }
        }
#pragma unroll
        for (int j = 0; j < 8; ++j) a8[j] = wave_sum(a8[j]);
        if (lane == 0) { f32x4 o0 = {a8[0], a8[1], a8[2], a8[3]}, o1 = {a8[4], a8[5], a8[6], a8[7]};
            *(f32x4*)(gbga + (size_t)row * 8) = o0; *(f32x4*)(gbga + (size_t)row * 8 + 4) = o1; }
    }
    LAS float* tl = (LAS float*)lds;
    for (int tile = blockIdx.x; tile < 1024 + 256; tile += gridDim.x) {
        const float* src; int ld, n0, k0, srcn0; bf16_t* dst;
        if (tile < 1024) { n0 = (tile >> 4) * 64; k0 = (tile & 15) * 64; srcn0 = win_src_col(n0); src = p.w_in; ld = 4104; dst = (bf16_t*)(p.ws + OFF_WINT); }
        else { const int t2 = tile - 1024; n0 = (t2 >> 4) * 64; k0 = (t2 & 15) * 64; srcn0 = n0; src = p.w_out; ld = 1024; dst = (bf16_t*)(p.ws + OFF_WOUTT); }
        const int kk = tid >> 4, n4 = tid & 15;
#pragma unroll
        for (int ps = 0; ps < 2; ++ps) { const int k = kk + 32 * ps;
            const f32x4 v = *(const f32x4*)(src + (size_t)(k0 + k) * ld + srcn0 + 4 * n4);
#pragma unroll
            for (int e = 0; e < 4; ++e) tl[k * 65 + 4 * n4 + e] = v[e]; }
        __syncthreads();
        { const int n = tid >> 3, k8 = tid & 7; float f[8];
#pragma unroll
            for (int e = 0; e < 8; ++e) f[e] = tl[(8 * k8 + e) * 65 + n];
            u32x4 w; w.x = pk_bf16(f[0], f[1]); w.y = pk_bf16(f[2], f[3]); w.z = pk_bf16(f[4], f[5]); w.w = pk_bf16(f[6], f[7]);
            *(u32x4*)(dst + (size_t)(n0 + n) * 1024 + k0 + 8 * k8) = w; }
        __syncthreads();
    }
}

constexpr int AT_ROW = 144, AT_KB = 64 * AT_ROW, AT_VB = 128 * AT_ROW, AT_BUF = AT_KB + AT_VB, AT_TASK = 2 * AT_BUF, AT_O1 = AT_TASK + 256;

DI void attn_qblock(const Params& p, LAS unsigned char* lds, int b, int hh, int qb, float lam) {
    int tid = threadIdx.x; asm volatile("" : "+v"(tid));
    const int lane = tid & 63, wid = __builtin_amdgcn_readfirstlane(tid >> 6), r = lane & 31, h2 = lane >> 5;
    const bf16_t* P1 = (const bf16_t*)(p.ws + OFF_P1);
    const bf16_t* VT = (const bf16_t*)(p.ws + OFF_VT) + (size_t)(b * 4 + hh) * 128 * 2048;
    bf16_t* mix = (bf16_t*)(p.ws + OFF_HB);
    const int q0 = qb * 256 + wid * 32;
    const size_t tokbase = (size_t)b * SEQ;
    const int nkt = (qb + 1) * 4;
    const float sl2 = exp2f(-2.0f * (float)(hh + 1)) * LOG2E;
    const float c1 = 0.125f * LOG2E;
    const int srow = tid >> 3, spc = tid & 7;
    LAS unsigned* o1l = (LAS unsigned*)(lds + AT_O1 + wid * 8192) + lane;
#pragma unroll 1
    for (int map = 0; map < 2; ++map) {
        bf16x8 qf[4];
        { const bf16_t* qp = P1 + (tokbase + q0 + r) * NP1 + C_DQ + hh * 128 + map * 64 + 8 * h2;
#pragma unroll
            for (int ks = 0; ks < 4; ++ks) qf[ks] = *(const bf16x8*)(qp + 16 * ks); }
        f32x16 O[4];
#pragma unroll
        for (int mt = 0; mt < 4; ++mt)
#pragma unroll
            for (int i = 0; i < 16; ++i) O[mt][i] = 0.f;
        float m = -INFINITY, l = 0.f;
        const bf16_t* kgp = P1 + (tokbase + srow) * NP1 + C_DK + hh * 128 + map * 64 + spc * 8;
        const bf16_t* vgp = VT + (size_t)srow * 2048 + spc * 8;
        u32x4 rk = *(const u32x4*)kgp, rv0 = *(const u32x4*)vgp, rv1 = *(const u32x4*)(vgp + 64 * 2048);
        *(LAS u32x4*)(lds + srow * AT_ROW + spc * 16) = rk;
        *(LAS u32x4*)(lds + AT_KB + srow * AT_ROW + spc * 16) = rv0;
        *(LAS u32x4*)(lds + AT_KB + (srow + 64) * AT_ROW + spc * 16) = rv1;
        __syncthreads();
#pragma unroll 1
        for (int kt = 0; kt < nkt; ++kt) {
            LAS unsigned char* cur = lds + (kt & 1) * AT_BUF;
            LAS unsigned char* nxt = lds + ((kt + 1) & 1) * AT_BUF;
            const bool more = kt + 1 < nkt;
            if (more) { rk = *(const u32x4*)(kgp + (size_t)(kt + 1) * 64 * NP1); rv0 = *(const u32x4*)(vgp + (kt + 1) * 64); rv1 = *(const u32x4*)(vgp + 64 * 2048 + (kt + 1) * 64); }
            const int k0 = kt * 64;
            if (k0 <= q0) {
                const bool sub1 = (k0 + 32 <= q0);
                f32x16 s0, s1;
#pragma unroll
                for (int i = 0; i < 16; ++i) { s0[i] = 0.f; s1[i] = 0.f; }
#pragma unroll
                for (int ks = 0; ks < 4; ++ks) { const bf16x8 kf = *(const LAS bf16x8*)(cur + r * AT_ROW + (16 * ks + 8 * h2) * 2); s0 = MFMA32(kf, qf[ks], s0); }
                if (sub1) {
#pragma unroll
                    for (int ks = 0; ks < 4; ++ks) { const bf16x8 kf = *(const LAS bf16x8*)(cur + (32 + r) * AT_ROW + (16 * ks + 8 * h2) * 2); s1 = MFMA32(kf, qf[ks], s1); }
                }
                const float base0 = sl2 * (float)(k0 - q0 + 4 * h2);
                const bool diag0 = (k0 == q0), diag1 = (k0 + 32 == q0);
                float mx = -INFINITY;
#pragma unroll
                for (int i = 0; i < 16; ++i) {
                    const int ci = (i & 3) + 8 * (i >> 2);
                    float t0 = fmaf(s0[i], c1, base0 + sl2 * (float)ci);
                    if (diag0 && (ci + 4 * h2 > r)) t0 = -INFINITY;
                    float t1 = fmaf(s1[i], c1, base0 + sl2 * (float)(32 + ci));
                    if (!sub1 || (diag1 && (ci + 4 * h2 > r))) t1 = -INFINITY;
                    s0[i] = t0; s1[i] = t1; mx = fmaxf(mx, fmaxf(t0, t1));
                }
                mx = fmaxf(mx, __shfl_xor(mx, 32));
                const float mn = fmaxf(m, mx);
                const float alpha = __builtin_amdgcn_exp2f(m - mn);
                m = mn; l *= alpha;
#pragma unroll
                for (int mt = 0; mt < 4; ++mt)
#pragma unroll
                    for (int i = 0; i < 16; ++i) O[mt][i] *= alpha;
                float ls = 0.f;
#pragma unroll
                for (int i = 0; i < 16; ++i) { s0[i] = __builtin_amdgcn_exp2f(s0[i] - mn); s1[i] = __builtin_amdgcn_exp2f(s1[i] - mn); ls += s0[i] + s1[i]; }
                l += ls;
                bf16x8 pf[4];
#pragma unroll
                for (int s = 0; s < 2; ++s) {
                    u32x4 a, c;
                    a.x = pk_bf16(s0[8 * s + 0], s0[8 * s + 1]); a.y = pk_bf16(s0[8 * s + 2], s0[8 * s + 3]); a.z = pk_bf16(s0[8 * s + 4], s0[8 * s + 5]); a.w = pk_bf16(s0[8 * s + 6], s0[8 * s + 7]);
                    c.x = pk_bf16(s1[8 * s + 0], s1[8 * s + 1]); c.y = pk_bf16(s1[8 * s + 2], s1[8 * s + 3]); c.z = pk_bf16(s1[8 * s + 4], s1[8 * s + 5]); c.w = pk_bf16(s1[8 * s + 6], s1[8 * s + 7]);
                    pf[s] = __builtin_bit_cast(bf16x8, a); pf[2 + s] = __builtin_bit_cast(bf16x8, c);
                }
                const LAS unsigned char* vb = cur + AT_KB + r * AT_ROW + 16 * h2;
#pragma unroll
                for (int s2 = 0; s2 < 2; ++s2)
#pragma unroll
                    for (int mt = 0; mt < 4; ++mt) { const bf16x8 vf = *(const LAS bf16x8*)(vb + mt * 32 * AT_ROW + s2 * 32); O[mt] = MFMA32(vf, pf[s2], O[mt]); }
                if (sub1) {
#pragma unroll
                    for (int s2 = 2; s2 < 4; ++s2)
#pragma unroll
                        for (int mt = 0; mt < 4; ++mt) { const bf16x8 vf = *(const LAS bf16x8*)(vb + mt * 32 * AT_ROW + s2 * 32); O[mt] = MFMA32(vf, pf[s2], O[mt]); }
                }
            }
            if (more) {
                *(LAS u32x4*)(nxt + srow * AT_ROW + spc * 16) = rk;
                *(LAS u32x4*)(nxt + AT_KB + srow * AT_ROW + spc * 16) = rv0;
                *(LAS u32x4*)(nxt + AT_KB + (srow + 64) * AT_ROW + spc * 16) = rv1;
            }
            __syncthreads();
        }
        const float lt = l + __shfl_xor(l, 32);
        if (map == 0) {
            const float inv1 = 1.0f / lt;
#pragma unroll
            for (int mt = 0; mt < 4; ++mt)
#pragma unroll
                for (int j = 0; j < 8; ++j) o1l[(mt * 8 + j) * 64] = pk_bf16(O[mt][2 * j] * inv1, O[mt][2 * j + 1] * inv1);
        } else {
            const float inv2 = lam / lt;
            float ss = 0.f;
#pragma unroll
            for (int mt = 0; mt < 4; ++mt)
#pragma unroll
                for (int j = 0; j < 8; ++j) {
                    const unsigned o1 = o1l[(mt * 8 + j) * 64];
                    const float a = bf_lo(o1) - O[mt][2 * j] * inv2, c = bf_hi(o1) - O[mt][2 * j + 1] * inv2;
                    O[mt][2 * j] = a; O[mt][2 * j + 1] = c; ss += a * a + c * c;
                }
            ss += __shfl_xor(ss, 32);
            const float rs = rsqrtf(ss * (1.0f / 128.0f) + EPS) * 0.8f;
#pragma unroll
            for (int mt = 0; mt < 4; ++mt)
#pragma unroll
                for (int j = 0; j < 8; ++j) o1l[(mt * 8 + j) * 64] = pk_bf16(O[mt][2 * j] * rs, O[mt][2 * j + 1] * rs);
            __builtin_amdgcn_wave_barrier();
            const int dvg = lane & 15, qs = lane >> 4;
            const f32x4 nw0 = *(const f32x4*)(p.diff_norm_w + 8 * dvg), nw1 = *(const f32x4*)(p.diff_norm_w + 8 * dvg + 4);
            const LAS unsigned* ob = (const LAS unsigned*)(lds + AT_O1 + wid * 8192);
            const int slot = (dvg >> 2) * 8 + 2 * (dvg & 3);
#pragma unroll 2
            for (int it = 0; it < 8; ++it) {
                const int q = it * 4 + qs; const size_t row = tokbase + q0 + q;
                const unsigned u0 = ob[slot * 64 + q], u1 = ob[(slot + 1) * 64 + q], u2 = ob[slot * 64 + q + 32], u3 = ob[(slot + 1) * 64 + q + 32];
                const u32x4 dz = *(const u32x4*)(P1 + row * NP1 + C_DZ + hh * 128 + 8 * dvg);
                u32x4 w;
                w.x = pk_bf16(bf_lo(u0) * nw0[0] * silu_f(bf_lo(dz.x)), bf_hi(u0) * nw0[1] * silu_f(bf_hi(dz.x)));
                w.y = pk_bf16(bf_lo(u1) * nw0[2] * silu_f(bf_lo(dz.y)), bf_hi(u1) * nw0[3] * silu_f(bf_hi(dz.y)));
                w.z = pk_bf16(bf_lo(u2) * nw1[0] * silu_f(bf_lo(dz.z)), bf_hi(u2) * nw1[1] * silu_f(bf_hi(dz.z)));
                w.w = pk_bf16(bf_lo(u3) * nw1[2] * silu_f(bf_lo(dz.w)), bf_hi(u3) * nw1[3] * silu_f(bf_hi(dz.w)));
                *(u32x4*)(mix + row * DM + 512 + hh * 128 + 8 * dvg) = w;
            }
            __builtin_amdgcn_wave_barrier();
        }
    }
}

DI void phase_attn(const Params& p, LAS unsigned char* lds) {
    const float lam = *(const float*)(p.ws + OFF_MISC);
    unsigned* counter = (unsigned*)(p.ws + OFF_MISC + 4);
    LAS int* tslot = (LAS int*)(lds + AT_TASK);
    for (;;) {
        if (threadIdx.x == 0) *tslot = (int)atomicAdd(counter, 1u);
        __syncthreads();
        const int t = *tslot;
        __syncthreads();
        if (t >= 512) break;
        const int qb = 7 - (t >> 6), bh = t & 63;
        attn_qblock(p, lds, bh >> 2, bh & 3, qb, lam);
    }
}


constexpr int G_QN = 0, G_KN = 17408, G_VB = 34816, G_KBG = 52224, G_M = 69632, G_T = 86016, G_SM = 95232;
DI int crow(int i, int h2) { return (i & 3) + 8 * (i >> 2) + 4 * h2; }
DI bf16x8 tr_pair(const LAS unsigned char* lo_addr, int hi_off) {
    const s16x4 lo = __builtin_amdgcn_ds_read_tr16_b64_v4i16((LAS s16x4*)(lo_addr));
    const s16x4 hi = __builtin_amdgcn_ds_read_tr16_b64_v4i16((LAS s16x4*)(lo_addr + hi_off));
    return __builtin_shufflevector(lo, hi, 0, 1, 2, 3, 4, 5, 6, 7);
}
DI bf16x8 pack8(const f32x16& x, int s) {
    u32x4 w; w.x = pk_bf16(x[8 * s + 0], x[8 * s + 1]); w.y = pk_bf16(x[8 * s + 2], x[8 * s + 3]); w.z = pk_bf16(x[8 * s + 4], x[8 * s + 5]); w.w = pk_bf16(x[8 * s + 6], x[8 * s + 7]);
    return __builtin_bit_cast(bf16x8, w);
}
DI bf16_t bf16_1(float v) { return (bf16_t)(pk_bf16(v, 0.f) & 0xffffu); }

DI void gdn_prep(const Params& p, LAS unsigned char* lds, int c2) {
    int tid = threadIdx.x; asm volatile("" : "+v"(tid));
    const int lane = tid & 63, wid = __builtin_amdgcn_readfirstlane(tid >> 6), r = lane & 31, h2 = lane >> 5;
    const int b = c2 >> 7, hh = (c2 >> 5) & 3, n = c2 & 31;
    const size_t tok0 = (size_t)b * SEQ + (size_t)n * 64;
    const bf16_t* P1 = (const bf16_t*)(p.ws + OFF_P1);
    LAS float* sm = (LAS float*)(lds + G_SM);
    LAS float* Mf = (LAS float*)(lds + G_M);
    bf16_t* WN = (bf16_t*)(p.ws + OFF_WN) + (size_t)c2 * 8192;
    bf16_t* QD = (bf16_t*)(p.ws + OFF_QD) + (size_t)c2 * 8192;
    bf16_t* KD = (bf16_t*)(p.ws + OFF_KD) + (size_t)c2 * 8192;
    bf16_t* AQ = (bf16_t*)(p.ws + OFF_AQK) + (size_t)c2 * 4096;
    float* U = (float*)(p.ws + OFF_U) + (size_t)c2 * 8192;
    if (wid == 0) {
        const float* gg = (const float*)(p.ws + OFF_GBGA) + (tok0 + lane) * 8;
        const float gbv = gg[hh], gav = gg[4 + hh];
        const float beta = 1.0f / (1.0f + expf(-gbv));
        const float xs = gav + p.dt_bias[hh];
        const float sp = fmaxf(xs, 0.f) + log1pf(expf(-fabsf(xs)));
        float gc = -expf(p.a_log[hh]) * sp;
#pragma unroll
        for (int o = 1; o < 64; o <<= 1) { const float t = __shfl_up(gc, o); if (lane >= o) gc += t; }
        const float gl = __shfl(gc, 63);
        sm[lane] = beta; sm[64 + lane] = gc; sm[128 + lane] = expf(gc); sm[192 + lane] = expf(gl - gc);
        if (lane == 63) ((float*)(p.ws + OFF_GL))[c2] = expf(gl);
    }
    __syncthreads();
#pragma unroll 1
    for (int i = 0; i < 6; ++i) {
        const int item = tid + 512 * i, g = item & 15, t = (item >> 4) & 63, part = i >> 1;
        const int ch = part * 512 + hh * 128 + g * 8;
        float a[8];
#pragma unroll
        for (int e = 0; e < 8; ++e) a[e] = 0.f;
#pragma unroll
        for (int j = 0; j < 4; ++j) {
            const int tt = n * 64 + t - 3 + j;
            if (tt >= 0) {
                const u32x4 raw = *(const u32x4*)(P1 + ((size_t)b * SEQ + tt) * NP1 + ch);
                const f32x4 w0 = *(const f32x4*)(p.conv_w + j * 1536 + ch), w1 = *(const f32x4*)(p.conv_w + j * 1536 + ch + 4);
                a[0] += w0[0] * bf_lo(raw.x); a[1] += w0[1] * bf_hi(raw.x); a[2] += w0[2] * bf_lo(raw.y); a[3] += w0[3] * bf_hi(raw.y);
                a[4] += w1[0] * bf_lo(raw.z); a[5] += w1[1] * bf_hi(raw.z); a[6] += w1[2] * bf_lo(raw.w); a[7] += w1[3] * bf_hi(raw.w);
            }
        }
        float ss = 0.f;
#pragma unroll
        for (int e = 0; e < 8; ++e) { a[e] = silu_f(a[e]); ss += a[e] * a[e]; }
        const float beta = sm[t], egc = sm[128 + t], ekd = sm[192 + t];
        if (part < 2) {
            ss += __shfl_xor(ss, 1); ss += __shfl_xor(ss, 2); ss += __shfl_xor(ss, 4); ss += __shfl_xor(ss, 8);
            const float rn = rsqrtf(ss + 1e-6f) * (part == 0 ? 0.08838834764831845f : 1.0f);
#pragma unroll
            for (int e = 0; e < 8; ++e) a[e] *= rn;
            u32x4 w; w.x = pk_bf16(a[0], a[1]); w.y = pk_bf16(a[2], a[3]); w.z = pk_bf16(a[4], a[5]); w.w = pk_bf16(a[6], a[7]);
            *(LAS u32x4*)(lds + (part == 0 ? G_QN : G_KN) + t * 272 + g * 16) = w;
            if (part == 0) {
                u32x2 lo, hi; lo.x = pk_bf16(a[0] * egc, a[1] * egc); lo.y = pk_bf16(a[2] * egc, a[3] * egc); hi.x = pk_bf16(a[4] * egc, a[5] * egc); hi.y = pk_bf16(a[6] * egc, a[7] * egc);
                bf16_t* qd = QD + t * 128 + 16 * (g >> 1) + 4 * (g & 1);
                *(u32x2*)qd = lo; *(u32x2*)(qd + 8) = hi;
            } else {
                const float f1 = beta * egc;
                u32x4 w2; w2.x = pk_bf16(a[0] * f1, a[1] * f1); w2.y = pk_bf16(a[2] * f1, a[3] * f1); w2.z = pk_bf16(a[4] * f1, a[5] * f1); w2.w = pk_bf16(a[6] * f1, a[7] * f1);
                *(LAS u32x4*)(lds + G_KBG + t * 272 + g * 16) = w2;
                u32x4 w3; w3.x = pk_bf16(a[0] * ekd, a[1] * ekd); w3.y = pk_bf16(a[2] * ekd, a[3] * ekd); w3.z = pk_bf16(a[4] * ekd, a[5] * ekd); w3.w = pk_bf16(a[6] * ekd, a[7] * ekd);
                *(u32x4*)(KD + t * 128 + g * 8) = w3;
            }
        } else {
            u32x4 w; w.x = pk_bf16(a[0] * beta, a[1] * beta); w.y = pk_bf16(a[2] * beta, a[3] * beta); w.z = pk_bf16(a[4] * beta, a[5] * beta); w.w = pk_bf16(a[6] * beta, a[7] * beta);
            *(LAS u32x4*)(lds + G_VB + t * 272 + g * 16) = w;
        }
    }
    __syncthreads();
    {
        const int w4 = wid & 3, mt = w4 >> 1, nt = w4 & 1; const bool isqk = wid >= 4;
        if (!(mt == 0 && nt == 1)) {
            const LAS unsigned char* Ab = lds + (isqk ? G_QN : G_KN) + (32 * mt + r) * 272 + 16 * h2;
            const LAS unsigned char* Bb = lds + G_KN + (32 * nt + r) * 272 + 16 * h2;
            f32x16 X;
#pragma unroll
            for (int i = 0; i < 16; ++i) X[i] = 0.f;
#pragma unroll
            for (int ks = 0; ks < 8; ++ks) X = MFMA32(*(const LAS bf16x8*)(Ab + 32 * ks), *(const LAS bf16x8*)(Bb + 32 * ks), X);
            const int s = 32 * nt + r; const float gcs = sm[64 + s];
#pragma unroll
            for (int i = 0; i < 16; ++i) {
                const int c = 32 * mt + crow(i, h2);
                const float dec = expf(sm[64 + c] - gcs);
                if (!isqk) Mf[c * 64 + s] = (c > s) ? sm[c] * X[i] * dec : 0.f;
                else AQ[c * 64 + perm23(s)] = bf16_1((c >= s) ? X[i] * dec : 0.f);
            }
        }
    }
    __syncthreads();
    if (wid == 0) {
        const int cc = r, hb = h2;
        const LAS float* Mb = Mf + (32 * hb) * 64 + 32 * hb;
        float T[32];
#pragma unroll
        for (int i = 0; i < 32; ++i) T[i] = 0.f;
#pragma unroll
        for (int i = 0; i < 32; ++i) {
            float acc = (i == cc) ? 1.f : 0.f;
#pragma unroll
            for (int s4 = 0; s4 < (i + 3) / 4; ++s4) {
                const f32x4 m4 = *(const LAS f32x4*)(Mb + i * 64 + 4 * s4);
                acc -= m4[0] * T[4 * s4]; acc -= m4[1] * T[4 * s4 + 1]; acc -= m4[2] * T[4 * s4 + 2]; acc -= m4[3] * T[4 * s4 + 3];
            }
            T[i] = acc;
            if ((i & 1) == 1) asm volatile("" : "+v"(acc) :: "memory");
            T[i] = acc;
        }
        LAS bf16_t* Tb = (LAS bf16_t*)(lds + G_T);
#pragma unroll
        for (int i = 0; i < 32; ++i) {
            Tb[(32 * hb + i) * 72 + 32 * hb + cc] = bf16_1(T[i]);
            if (hb == 0) Tb[i * 72 + 32 + cc] = 0;
        }
        __builtin_amdgcn_wave_barrier();
        asm volatile("s_waitcnt lgkmcnt(0)" ::: "memory");
        const int i16 = lane & 15, q = i16 >> 2, pp = i16 & 3, blk = (lane >> 4) & 1;
        f32x16 Y;
#pragma unroll
        for (int i = 0; i < 16; ++i) Y[i] = 0.f;
#pragma unroll
        for (int ks = 0; ks < 2; ++ks) {
            const LAS float* mp = Mf + (32 + r) * 64 + 16 * ks + 8 * h2;
            const f32x4 m0 = *(const LAS f32x4*)mp, m1 = *(const LAS f32x4*)(mp + 4);
            u32x4 aw; aw.x = pk_bf16(m0[0], m0[1]); aw.y = pk_bf16(m0[2], m0[3]); aw.z = pk_bf16(m1[0], m1[1]); aw.w = pk_bf16(m1[2], m1[3]);
            const bf16x8 bfrag = tr_pair(lds + G_T + (16 * ks + 8 * h2 + q) * 144 + (16 * blk + 4 * pp) * 2, 4 * 144);
            Y = MFMA32(__builtin_bit_cast(bf16x8, aw), bfrag, Y);
        }
        f32x16 Z;
#pragma unroll
        for (int i = 0; i < 16; ++i) Z[i] = 0.f;
#pragma unroll
        for (int s = 0; s < 2; ++s) {
            const LAS unsigned char* tp = lds + G_T + (32 + r) * 144 + (32 + 16 * s + 4 * h2) * 2;
            const u32x2 lo = *(const LAS u32x2*)tp, hi = *(const LAS u32x2*)(tp + 16);
            u32x4 aw; aw.x = lo.x; aw.y = lo.y; aw.z = hi.x; aw.w = hi.y;
            Z = MFMA32(__builtin_bit_cast(bf16x8, aw), pack8(Y, s), Z);
        }
#pragma unroll
        for (int i = 0; i < 16; ++i) Tb[(32 + crow(i, h2)) * 72 + r] = bf16_1(-Z[i]);
    }
    __syncthreads();
    {
        const int mt = wid >> 2, nt = wid & 3;
        const int i16 = lane & 15, q = i16 >> 2, pp = i16 & 3, blk = (lane >> 4) & 1;
        f32x16 Xu, Xw;
#pragma unroll
        for (int i = 0; i < 16; ++i) { Xu[i] = 0.f; Xw[i] = 0.f; }
#pragma unroll
        for (int ks = 0; ks < 4; ++ks) {
            if (ks < 2 * (mt + 1)) {
                const bf16x8 af = *(const LAS bf16x8*)(lds + G_T + (32 * mt + r) * 144 + (16 * ks + 8 * h2) * 2);
                const int boff = (16 * ks + 8 * h2 + q) * 272 + (32 * nt + 16 * blk + 4 * pp) * 2;
                Xu = MFMA32(af, tr_pair(lds + G_VB + boff, 4 * 272), Xu);
                Xw = MFMA32(af, tr_pair(lds + G_KBG + boff, 4 * 272), Xw);
            }
        }
        const int d = 32 * nt + r, dp = perm23(d);
        {
            float* up = U + ((nt * 2 + mt) * 64 + lane) * 16;
#pragma unroll
            for (int k = 0; k < 4; ++k) { const f32x4 v = {Xu[4 * k], Xu[4 * k + 1], Xu[4 * k + 2], Xu[4 * k + 3]}; *(f32x4*)(up + 4 * k) = v; }
        }
#pragma unroll
        for (int i = 0; i < 16; ++i) {
            const int c = 32 * mt + crow(i, h2);
            WN[c * 128 + dp] = bf16_1(-Xw[i]);
        }
    }
    __syncthreads();
}

constexpr int S_WN = 0, S_QD = 17408, S_KD = 34816, S_AQ = 52224, S_BUF = 61440, S_STG = 2 * S_BUF;

DI void scan_gate(const Params& p, LAS unsigned char* lds, int tid, int b, int hh, int n) {
    const int gc_ = tid >> 3, seg = tid & 7;
    const bf16_t* P1 = (const bf16_t*)(p.ws + OFF_P1);
    bf16_t* mix = (bf16_t*)(p.ws + OFF_HB);
    const LAS float* st = (const LAS float*)(lds + S_STG) + gc_ * 132 + seg * 16;
    f32x4 ov[4]; float ss = 0.f;
#pragma unroll
    for (int k = 0; k < 4; ++k) { ov[k] = *(const LAS f32x4*)(st + 4 * k); ss += ov[k][0] * ov[k][0] + ov[k][1] * ov[k][1] + ov[k][2] * ov[k][2] + ov[k][3] * ov[k][3]; }
    ss += __shfl_xor(ss, 1); ss += __shfl_xor(ss, 2); ss += __shfl_xor(ss, 4);
    const float rstd = rsqrtf(ss * (1.0f / 128.0f) + EPS);
    f32x4 gnw[4];
#pragma unroll
    for (int k = 0; k < 4; ++k) gnw[k] = *(const f32x4*)(p.gdn_norm_w + seg * 16 + 4 * k);
    const size_t row = (size_t)b * SEQ + n * 64 + gc_;
    const u32x4 z0 = *(const u32x4*)(P1 + row * NP1 + C_GZ + hh * 128 + seg * 16), z1 = *(const u32x4*)(P1 + row * NP1 + C_GZ + hh * 128 + seg * 16 + 8);
    u32x4 w0, w1;
    w0.x = pk_bf16(ov[0][0] * rstd * gnw[0][0] * silu_f(bf_lo(z0.x)), ov[0][1] * rstd * gnw[0][1] * silu_f(bf_hi(z0.x)));
    w0.y = pk_bf16(ov[0][2] * rstd * gnw[0][2] * silu_f(bf_lo(z0.y)), ov[0][3] * rstd * gnw[0][3] * silu_f(bf_hi(z0.y)));
    w0.z = pk_bf16(ov[1][0] * rstd * gnw[1][0] * silu_f(bf_lo(z0.z)), ov[1][1] * rstd * gnw[1][1] * silu_f(bf_hi(z0.z)));
    w0.w = pk_bf16(ov[1][2] * rstd * gnw[1][2] * silu_f(bf_lo(z0.w)), ov[1][3] * rstd * gnw[1][3] * silu_f(bf_hi(z0.w)));
    w1.x = pk_bf16(ov[2][0] * rstd * gnw[2][0] * silu_f(bf_lo(z1.x)), ov[2][1] * rstd * gnw[2][1] * silu_f(bf_hi(z1.x)));
    w1.y = pk_bf16(ov[2][2] * rstd * gnw[2][2] * silu_f(bf_lo(z1.y)), ov[2][3] * rstd * gnw[2][3] * silu_f(bf_hi(z1.y)));
    w1.z = pk_bf16(ov[3][0] * rstd * gnw[3][0] * silu_f(bf_lo(z1.z)), ov[3][1] * rstd * gnw[3][1] * silu_f(bf_hi(z1.z)));
    w1.w = pk_bf16(ov[3][2] * rstd * gnw[3][2] * silu_f(bf_lo(z1.w)), ov[3][3] * rstd * gnw[3][3] * silu_f(bf_hi(z1.w)));
    bf16_t* mp = mix + row * DM + hh * 128 + seg * 16;
    *(u32x4*)mp = w0; *(u32x4*)(mp + 8) = w1;
}

DI void scan_load_chunk(LAS unsigned char* dst, const bf16_t* WN, const bf16_t* QD, const bf16_t* KD, const bf16_t* AQ, int ltid) {
    {
        u32x4 t0[4], t1[4];
#pragma unroll
        for (int i = 0; i < 4; ++i) { const int pi = ltid + 256 * i; t0[i] = *(const u32x4*)(WN + pi * 8); t1[i] = *(const u32x4*)(QD + pi * 8); }
#pragma unroll
        for (int i = 0; i < 4; ++i) { const int pi = ltid + 256 * i, row = pi >> 4, pc = pi & 15;
            *(LAS u32x4*)(dst + S_WN + row * 272 + pc * 16) = t0[i]; *(LAS u32x4*)(dst + S_QD + row * 272 + pc * 16) = t1[i]; }
    }
    asm volatile("" ::: "memory");
    {
        u32x4 t2[4], t3[2];
#pragma unroll
        for (int i = 0; i < 4; ++i) { const int pi = ltid + 256 * i; t2[i] = *(const u32x4*)(KD + pi * 8); }
#pragma unroll
        for (int i = 0; i < 2; ++i) { const int pi = ltid + 256 * i; t3[i] = *(const u32x4*)(AQ + pi * 8); }
#pragma unroll
        for (int i = 0; i < 4; ++i) { const int pi = ltid + 256 * i, row = pi >> 4, pc = pi & 15; *(LAS u32x4*)(dst + S_KD + row * 272 + pc * 16) = t2[i]; }
#pragma unroll
        for (int i = 0; i < 2; ++i) { const int pi = ltid + 256 * i, row = pi >> 3, pc = pi & 7; *(LAS u32x4*)(dst + S_AQ + row * 144 + pc * 16) = t3[i]; }
    }
}

DI void gdn_scan(const Params& p, LAS unsigned char* lds, int bh) {
    int tid = threadIdx.x; asm volatile("" : "+v"(tid));
    const int lane = tid & 63, wid = __builtin_amdgcn_readfirstlane(tid >> 6), r = lane & 31, h2 = lane >> 5;
    const int b = bh >> 2, hh = bh & 3;
    const bf16_t* WN = (const bf16_t*)(p.ws + OFF_WN) + (size_t)bh * 32 * 8192;
    const bf16_t* QD = (const bf16_t*)(p.ws + OFF_QD) + (size_t)bh * 32 * 8192;
    const bf16_t* KD = (const bf16_t*)(p.ws + OFF_KD) + (size_t)bh * 32 * 8192;
    const bf16_t* AQ = (const bf16_t*)(p.ws + OFF_AQK) + (size_t)bh * 32 * 4096;
    const float* U = (const float*)(p.ws + OFF_U) + (size_t)bh * 32 * 8192;
    const float* GL = (const float*)(p.ws + OFF_GL) + bh * 32;
    if (wid >= 4) {
        const int ltid = tid & 255;
        scan_load_chunk(lds, WN, QD, KD, AQ, ltid);
#pragma unroll 1
        for (int n = 0; n < 32; ++n) {
            __syncthreads();
            if (n + 1 < 32) scan_load_chunk(lds + ((n + 1) & 1) * S_BUF, WN + (size_t)(n + 1) * 8192, QD + (size_t)(n + 1) * 8192, KD + (size_t)(n + 1) * 8192, AQ + (size_t)(n + 1) * 4096, ltid);
            __syncthreads();
            scan_gate(p, lds, tid, b, hh, n);
        }
    } else {
        const int i16 = lane & 15, q4 = i16 >> 2, pp = i16 & 3, blk = (lane >> 4) & 1;
        f32x16 St[4], u[2];
#pragma unroll
        for (int k = 0; k < 4; ++k)
#pragma unroll
            for (int i = 0; i < 16; ++i) St[k][i] = 0.f;
#pragma unroll
        for (int mt = 0; mt < 2; ++mt)
#pragma unroll
            for (int k = 0; k < 4; ++k) { const f32x4 v = *(const f32x4*)(U + ((wid * 2 + mt) * 64 + lane) * 16 + 4 * k); u[mt][4 * k] = v[0]; u[mt][4 * k + 1] = v[1]; u[mt][4 * k + 2] = v[2]; u[mt][4 * k + 3] = v[3]; }
#pragma unroll 1
        for (int n = 0; n < 32; ++n) {
            LAS unsigned char* buf = lds + (n & 1) * S_BUF;
            __syncthreads();
            const float egl = GL[n];
            f32x16 vn[2], o[2];
            vn[0] = u[0]; vn[1] = u[1];
#pragma unroll
            for (int mt = 0; mt < 2; ++mt)
#pragma unroll
                for (int i = 0; i < 16; ++i) o[mt][i] = 0.f;
#pragma unroll
            for (int ks = 0; ks < 8; ++ks) {
                const bf16x8 sf = pack8(St[ks >> 1], ks & 1);
#pragma unroll
                for (int mt = 0; mt < 2; ++mt) {
                    const bf16x8 wf = *(const LAS bf16x8*)(buf + S_WN + (32 * mt + r) * 272 + (16 * ks + 8 * h2) * 2);
                    vn[mt] = MFMA32(wf, sf, vn[mt]);
                    const bf16x8 qf = *(const LAS bf16x8*)(buf + S_QD + (32 * mt + r) * 272 + (16 * ks + 8 * h2) * 2);
                    o[mt] = MFMA32(qf, sf, o[mt]);
                }
                asm volatile("" ::: "memory");
            }
            bf16x8 vf[4];
#pragma unroll
            for (int k2 = 0; k2 < 4; ++k2) vf[k2] = pack8(vn[k2 >> 1], k2 & 1);
            {
                const int nn = (n + 1 < 32) ? n + 1 : n;
                const float* up = U + (size_t)nn * 8192 + ((wid * 2) * 64 + lane) * 16;
#pragma unroll
                for (int mt = 0; mt < 2; ++mt)
#pragma unroll
                    for (int k = 0; k < 4; ++k) { const f32x4 v = *(const f32x4*)(up + mt * 1024 + 4 * k); u[mt][4 * k] = v[0]; u[mt][4 * k + 1] = v[1]; u[mt][4 * k + 2] = v[2]; u[mt][4 * k + 3] = v[3]; }
            }
#pragma unroll
            for (int mt = 0; mt < 2; ++mt)
#pragma unroll
                for (int k2 = 0; k2 < 2 * (mt + 1); ++k2) {
                    const bf16x8 af = *(const LAS bf16x8*)(buf + S_AQ + (32 * mt + r) * 144 + (16 * k2 + 8 * h2) * 2);
                    o[mt] = MFMA32(af, vf[k2], o[mt]);
                }
            {
                LAS float* st = (LAS float*)(lds + S_STG);
#pragma unroll
                for (int mt = 0; mt < 2; ++mt)
#pragma unroll
                    for (int i = 0; i < 16; ++i) st[(32 * mt + crow(i, h2)) * 132 + 32 * wid + r] = o[mt][i];
            }
#pragma unroll
            for (int kt = 0; kt < 4; ++kt) {
#pragma unroll
                for (int i = 0; i < 16; ++i) St[kt][i] *= egl;
#pragma unroll
                for (int k2 = 0; k2 < 4; ++k2) {
                    const bf16x8 kf = tr_pair(buf + S_KD + (16 * k2 + 4 * h2 + q4) * 272 + (32 * kt + 16 * blk + 4 * pp) * 2, 8 * 272);
                    St[kt] = MFMA32(kf, vf[k2], St[kt]);
                }
                asm volatile("" ::: "memory");
            }
            __syncthreads();
            scan_gate(p, lds, tid, b, hh, n);
        }
    }
    __syncthreads();
}

DI void zero_mix_half(const Params& p, int half) {
    bf16_t* mix = (bf16_t*)(p.ws + OFF_HB);
    const size_t n16 = (size_t)MTOK * 64;
    for (size_t i = (size_t)blockIdx.x * 512 + threadIdx.x; i < n16; i += (size_t)gridDim.x * 512) {
        const size_t row = i >> 6, pc = i & 63;
        *(u32x4*)(mix + row * DM + half * 512 + pc * 8) = (u32x4){0u, 0u, 0u, 0u};
    }
}

DI void phase_final(const Params& p) {
    const int tid = threadIdx.x, lane = tid & 63, wid = tid >> 6;
    const float* rowsq = (const float*)(p.ws + OFF_ROWSQ);
    const int gw = blockIdx.x * 8 + wid, nw = gridDim.x * 8;
    for (int row = gw; row < MTOK; row += nw) {
        float ss = lane < 16 ? rowsq[(size_t)row * 16 + lane] : 0.f;
        ss = wave_sum(ss);
        const float rstd = rsqrtf(ss * (1.0f / DM) + EPS);
        f32x4* o = (f32x4*)(p.out + (size_t)row * DM);
#pragma unroll
        for (int i = 0; i < 4; ++i) { const f32x4 y = o[lane + 64 * i]; const f32x4 fw = ((const f32x4*)p.final_norm_w)[lane + 64 * i]; o[lane + 64 * i] = y * rstd * fw; }
    }
}

__global__ void __launch_bounds__(512) mega(Params p) {
    extern __shared__ __attribute__((aligned(16))) unsigned char shm[];
    LAS unsigned char* lds = (LAS unsigned char*)shm;
    cg::grid_group grid = cg::this_grid();

    phase_prep(p, lds);
    grid.sync();
    {
        pg8::Gemm g{(const bf16_t*)(p.ws + OFF_HB), (const bf16_t*)(p.ws + OFF_WINT), MTOK, NP1, DM};
        pg8::StaticOrder S; S.init(g.M, g.N, (int)gridDim.x, (int)blockIdx.x);
        pg8::EpiP1 E{(bf16_t*)(p.ws + OFF_P1), NP1};
        pg8::gemm_phase<pg8::EpiP1, false>(lds, g, S, E);
        pg8::Gemm g2{(const bf16_t*)(p.ws + OFF_HB), (const bf16_t*)(p.ws + OFF_WINT) + (size_t)NP1 * DM, MTOK, 512, DM};
        pg8::StaticOrder S2; S2.init(g2.M, g2.N, (int)gridDim.x, (int)blockIdx.x);
        pg8::EpiVT E2{(bf16_t*)(p.ws + OFF_VT)};
        pg8::gemm_phase<pg8::EpiVT, true>(lds, g2, S2, E2);
    }
    grid.sync();
#if ENABLE_GDN
    for (int c2 = blockIdx.x; c2 < 2048; c2 += gridDim.x) gdn_prep(p, lds, c2);
    grid.sync();
    if (blockIdx.x < 64) gdn_scan(p, lds, blockIdx.x);
#else
    zero_mix_half(p, 0);
#endif
#if ENABLE_ATTN
    phase_attn(p, lds);
#else
    zero_mix_half(p, 1);
#endif
    grid.sync();
    {
        pg8::Gemm g{(const bf16_t*)(p.ws + OFF_HB), (const bf16_t*)(p.ws + OFF_WOUTT), MTOK, DM, DM};
        pg8::StaticOrder S; S.init(g.M, g.N, (int)gridDim.x, (int)blockIdx.x);
        pg8::EpiOut E{p.x, p.out, (float*)(p.ws + OFF_ROWSQ)};
        pg8::gemm_phase<pg8::EpiOut, false>(lds, g, S, E);
    }
    grid.sync();
    phase_final(p);
}

extern "C" void kernel_launch(void* const* d_in, const int* in_sizes, int n_in, void* d_out, int out_size, void* d_ws, size_t ws_size, hipStream_t stream) {
    static int grid = 0;
    if (grid == 0) {
        if (ws_size < WS_END) { fprintf(stderr, "kernel_launch: workspace too small (%zu < %zu)\n", ws_size, (size_t)WS_END); grid = -1; return; }
        int dev = 0, cus = 0, per_cu = 0;
        hipGetDevice(&dev);
        hipDeviceGetAttribute(&cus, hipDeviceAttributeMultiprocessorCount, dev);
        if (hipFuncSetAttribute((const void*)mega, hipFuncAttributeMaxDynamicSharedMemorySize, LDS_BYTES) != hipSuccess) { fprintf(stderr, "kernel_launch: hipFuncSetAttribute failed\n"); grid = -1; return; }
        if (hipOccupancyMaxActiveBlocksPerMultiprocessor(&per_cu, (const void*)mega, 512, LDS_BYTES) != hipSuccess || per_cu < 1) per_cu = 1;
        (void)hipGetLastError();
        grid = cus * (per_cu > 1 ? 1 : per_cu);
    }
    if (grid < 0) return;
    Params p{};
    p.x = (const float*)d_in[0]; p.norm_w = (const float*)d_in[1]; p.w_in = (const float*)d_in[2]; p.conv_w = (const float*)d_in[3];
    p.a_log = (const float*)d_in[4]; p.dt_bias = (const float*)d_in[5]; p.gdn_norm_w = (const float*)d_in[6];
    p.lq1 = (const float*)d_in[7]; p.lk1 = (const float*)d_in[8]; p.lq2 = (const float*)d_in[9]; p.lk2 = (const float*)d_in[10];
    p.diff_norm_w = (const float*)d_in[11]; p.w_out = (const float*)d_in[12]; p.final_norm_w = (const float*)d_in[13];
    p.out = (float*)d_out; p.ws = (unsigned char*)d_ws;
    void* args[] = {&p};
    hipError_t e = hipLaunchCooperativeKernel((const void*)mega, dim3(grid), dim3(512), args, LDS_BYTES, stream);
    if (e != hipSuccess) fprintf(stderr, "cooperative launch failed: %s (grid %d)\n", hipGetErrorString(e), grid);
}
```

```cpp
#include <hip/hip_runtime.h>
#include <hip/hip_cooperative_groups.h>
#include <cstdio>
namespace cg = cooperative_groups;

#ifndef ENABLE_ATTN
#define ENABLE_ATTN 1
#endif
#ifndef ENABLE_GDN
#define ENABLE_GDN 1
#endif
#ifndef REP_PREP
#define REP_PREP 1
#endif
#ifndef REP_G1
#define REP_G1 1
#endif
#ifndef REP_GP
#define REP_GP 1
#endif
#ifndef REP_P3
#define REP_P3 1
#endif
#ifndef REP_G2
#define REP_G2 1
#endif

#define LAS __attribute__((address_space(3)))
#define DI __device__ __forceinline__
typedef unsigned short bf16_t;
typedef short bf16x8 __attribute__((ext_vector_type(8)));
typedef short s16x4 __attribute__((ext_vector_type(4)));
typedef float f32x2 __attribute__((ext_vector_type(2)));
typedef float f32x4 __attribute__((ext_vector_type(4)));
typedef float f32x16 __attribute__((ext_vector_type(16)));
typedef unsigned u32x2 __attribute__((ext_vector_type(2)));
typedef unsigned u32x4 __attribute__((ext_vector_type(4)));
typedef __bf16 bf16x2_t __attribute__((ext_vector_type(2)));

#define MFMA32(a, b, c) __builtin_amdgcn_mfma_f32_32x32x16_bf16((a), (b), (c), 0, 0, 0)

constexpr int NB = 16, SEQ = 2048, DM = 1024, MTOK = NB * SEQ, NP1 = 3584;
constexpr int C_GQ = 0, C_GK = 512, C_GV = 1024, C_GZ = 1536, C_DQ = 2048, C_DK = 2560, C_DZ = 3072;
constexpr float EPS = 1e-6f;
constexpr float LOG2E = 1.4426950408889634f;

constexpr size_t OFF_HB = 0;
constexpr size_t OFF_WINT = OFF_HB + (size_t)MTOK * DM * 2;
constexpr size_t OFF_WOUTT = OFF_WINT + (size_t)4096 * 1024 * 2;
constexpr size_t OFF_GBGA = OFF_WOUTT + (size_t)1024 * 1024 * 2;
constexpr size_t OFF_P1 = OFF_GBGA + (size_t)MTOK * 8 * 4;
constexpr size_t OFF_VT = OFF_P1 + (size_t)MTOK * NP1 * 2;
constexpr size_t OFF_WN = OFF_VT + (size_t)64 * 128 * 2048 * 2;
constexpr size_t OFF_QD = OFF_WN + (size_t)2048 * 64 * 128 * 2;
constexpr size_t OFF_KD = OFF_QD + (size_t)2048 * 64 * 128 * 2;
constexpr size_t OFF_AQK = OFF_KD + (size_t)2048 * 64 * 128 * 2;
constexpr size_t OFF_U = OFF_AQK + (size_t)2048 * 64 * 64 * 2;
constexpr size_t OFF_GL = OFF_U + (size_t)2048 * 64 * 128 * 4;
constexpr size_t OFF_ROWSQ = OFF_GL + 8192;
constexpr size_t OFF_MISC = OFF_ROWSQ + (size_t)MTOK * 16 * 4;
constexpr size_t WS_END = OFF_MISC + 256;

constexpr int LDS_BYTES = 156 * 1024;

struct Params {
    const float *x, *norm_w, *w_in, *conv_w, *a_log, *dt_bias, *gdn_norm_w, *lq1, *lk1, *lq2, *lk2, *diff_norm_w, *w_out, *final_norm_w;
    float* out; unsigned char* ws;
};

DI unsigned pk_bf16(float a, float b) { f32x2 v = {a, b}; bf16x2_t r = __builtin_convertvector(v, bf16x2_t); return __builtin_bit_cast(unsigned, r); }
DI float bf_lo(unsigned u) { return __uint_as_float(u << 16); }
DI float bf_hi(unsigned u) { return __uint_as_float(u & 0xffff0000u); }
DI float wave_sum(float v) {
#pragma unroll
    for (int o = 32; o; o >>= 1) v += __shfl_xor(v, o);
    return v;
}
DI float silu_f(float z) { return z / (1.0f + __expf(-z)); }
DI int perm23(int t) { return (t & ~12) | ((t & 4) << 1) | ((t & 8) >> 1); }

namespace pg8 {
constexpr int BM = 256, BK = 64, HALF = 128, HTB = HALF * BK * 2, STAGE_BYTES = 8 * HTB, NXCD = 8, WGM = 8;
DI int lds_byte(int r, int c) { const int st = (r >> 4) * 2 + (c >> 5), rr = r & 15, cc = c & 31, ob = rr * 64 + cc * 2; return st * 1024 + (ob ^ (((ob >> 9) & 1) << 5)); }
DI void stage_rc(int b, int& R, int& C) { const int st = b / 1024, sb = b % 1024, swz = sb ^ (((sb >> 9) & 1) << 5); R = (st >> 1) * 16 + swz / 64; C = (st & 1) * 32 + (swz % 64) / 2; }
DI int perm32(int rho) { const int n = rho >> 4, i = rho & 15; return 8 * (i >> 2) + 4 * n + (i & 3); }
struct Unit { int pm, pn; };
struct Gemm { const bf16_t* A; const bf16_t* Bt; int M, N, K; };
struct StaticOrder {
    int nM, nN, nwg, G, c;
    DI void init(int M, int N, int G_, int c_) { nM = M / BM; nN = N / BM; nwg = nM * nN; G = G_; c = c_; }
    DI bool next(int i, Unit& u) const {
        const long L = (long)i * G + c; if (L >= nwg) return false;
        int wgid = (int)L; { const int q = nwg / NXCD, r = nwg % NXCD, xcd = wgid % NXCD, off = wgid / NXCD; wgid = (xcd < r ? xcd * (q + 1) : r * (q + 1) + (xcd - r) * q) + off; }
        const int nig = WGM * nN, gid = wgid / nig, fm = gid * WGM, gsz = (nM - fm) < WGM ? (nM - fm) : WGM;
        u.pm = fm + ((wgid % nig) % gsz); u.pn = (wgid % nig) / gsz; return true;
    }
    DI void a_ready(const Unit&) const {}
    DI void done(const Unit&) const {}
};

struct EpiP1 {
    static constexpr bool PERM = true;
    bf16_t* O; int ldc;
    DI void operator()(const f32x4 (&acc)[2][2][4][2], const Unit& u, int wr, int wc, int fr, int fq) const {
        const int row0 = u.pm * BM + wr * 64 + fr, col0 = u.pn * BM + wc * 32 + 8 * fq;
#pragma unroll
        for (int ai = 0; ai < 2; ++ai)
#pragma unroll
            for (int m = 0; m < 4; ++m) { bf16_t* rowp = O + (size_t)(row0 + ai * HALF + m * 16) * ldc + col0;
#pragma unroll
                for (int bj = 0; bj < 2; ++bj) { const f32x4 v0 = acc[ai][bj][m][0], v1 = acc[ai][bj][m][1];
                    u32x4 w; w.x = pk_bf16(v0[0], v0[1]); w.y = pk_bf16(v0[2], v0[3]); w.z = pk_bf16(v1[0], v1[1]); w.w = pk_bf16(v1[2], v1[3]);
                    *(u32x4*)(rowp + bj * HALF) = w; } }
    }
};
struct EpiVT {
    static constexpr bool PERM = false;
    bf16_t* VT;
    DI void operator()(const f32x4 (&acc)[2][2][4][2], const Unit& u, int wr, int wc, int fr, int fq) const {
#pragma unroll
        for (int ai = 0; ai < 2; ++ai)
#pragma unroll
            for (int m = 0; m < 4; ++m) {
                const int t = u.pm * BM + ai * HALF + wr * 64 + m * 16 + 4 * fq, b = t >> 11, tok = t & 2047, pos = perm23(tok);
#pragma unroll
                for (int bj = 0; bj < 2; ++bj)
#pragma unroll
                    for (int n = 0; n < 2; ++n) {
                        const int c = u.pn * BM + bj * HALF + wc * 32 + n * 16 + fr, hh = c >> 7, dv = c & 127;
                        const f32x4 v = acc[ai][bj][m][n];
                        u32x2 w; w.x = pk_bf16(v[0], v[1]); w.y = pk_bf16(v[2], v[3]);
                        *(u32x2*)(VT + ((size_t)((b * 4 + hh) * 128 + dv)) * 2048 + pos) = w;
                    }
            }
    }
};
struct EpiOut {
    static constexpr bool PERM = false;
    const float* X; float* Y; float* rowsq;
    DI void operator()(const f32x4 (&acc)[2][2][4][2], const Unit& u, int wr, int wc, int fr, int fq) const {
        const int row0 = u.pm * BM + wr * 64 + fr, col0 = u.pn * BM + wc * 32 + 4 * fq;
#pragma unroll
        for (int ai = 0; ai < 2; ++ai)
#pragma unroll
            for (int m = 0; m < 4; ++m) {
                const int row = row0 + ai * HALF + m * 16; float ss = 0.f;
#pragma unroll
                for (int bj = 0; bj < 2; ++bj)
#pragma unroll
                    for (int n = 0; n < 2; ++n) {
                        const size_t o = (size_t)row * DM + col0 + bj * HALF + n * 16;
                        const f32x4 xv = *(const f32x4*)(X + o); const f32x4 y = acc[ai][bj][m][n] + xv;
                        *(f32x4*)(Y + o) = y; ss += y[0] * y[0] + y[1] * y[1] + y[2] * y[2] + y[3] * y[3];
                    }
                ss += __shfl_xor(ss, 16); ss += __shfl_xor(ss, 32);
                if (fq == 0) rowsq[(size_t)row * 16 + u.pn * 4 + wc] = ss;
            }
    }
};

template <class Epi, bool SWAP>
DI void gemm_phase(LAS unsigned char* lds, const Gemm g, const StaticOrder& S, const Epi& E) {
    int tid = threadIdx.x; asm volatile("" : "+v"(tid));
    const int wid = __builtin_amdgcn_readfirstlane(tid >> 6), lane = tid & 63, wr = wid >> 2, wc = wid & 3, fr = lane & 15, fq = lane >> 4;
    const int K = g.K, nt = K / BK;
    unsigned voffA[2], voffB[2];
#pragma unroll
    for (int i = 0; i < 2; ++i) { int R, C; stage_rc(tid * 16 + i * 8192, R, C); const int Rb = Epi::PERM ? ((R & ~31) + perm32(R & 31)) : R;
        voffA[i] = (unsigned)(R * K + C) * 2u; voffB[i] = (unsigned)(Rb * K + C) * 2u; }
    const size_t kstep = (size_t)(BK * 2);
    const size_t hstep = (size_t)HALF * K * 2;
    const size_t tstep = 2 * hstep;
    const unsigned ldsw = (unsigned)wid * 1024u;
    const int aoff = lds_byte(wr * 64 + fr, fq * 8), boff = lds_byte(wc * 32 + fr, fq * 8);
#define PG8_SA(b, h) (((b) * 2 + (h)) * HTB)
#define PG8_SB(b, h) ((4 + (b) * 2 + (h)) * HTB)
#define PG8_STAGE(bufoff, gbase, voff) do { _Pragma("unroll") for (int _i = 0; _i < 2; ++_i) \
        __builtin_amdgcn_global_load_lds((const unsigned*)((const char*)(gbase) + (voff)[_i]), (LAS unsigned*)(lds + (bufoff) + ldsw + _i * 8192), 16, 0, 0); } while (0)
#define PG8_LDA(dst, b, h) do { _Pragma("unroll") for (int m = 0; m < 4; ++m) _Pragma("unroll") for (int k = 0; k < 2; ++k) dst[m][k] = *(const LAS bf16x8*)(lds + PG8_SA(b, h) + aoff + m * 2048 + k * 1024); } while (0)
#define PG8_LDB(dst, b, h) do { _Pragma("unroll") for (int n = 0; n < 2; ++n) _Pragma("unroll") for (int k = 0; k < 2; ++k) dst[n][k] = *(const LAS bf16x8*)(lds + PG8_SB(b, h) + boff + n * 2048 + k * 1024); } while (0)
#define PG8_MMA(ai, bj, At, Bt) do { __builtin_amdgcn_s_setprio(1); _Pragma("unroll") for (int m = 0; m < 4; ++m) _Pragma("unroll") for (int n = 0; n < 2; ++n) _Pragma("unroll") for (int k = 0; k < 2; ++k) \
        acc[ai][bj][m][n] = SWAP ? __builtin_amdgcn_mfma_f32_16x16x32_bf16(At[m][k], Bt[n][k], acc[ai][bj][m][n], 0, 0, 0) \
                                 : __builtin_amdgcn_mfma_f32_16x16x32_bf16(Bt[n][k], At[m][k], acc[ai][bj][m][n], 0, 0, 0); __builtin_amdgcn_s_setprio(0); } while (0)
#define PG8_WAIT_V(n) asm volatile("s_waitcnt vmcnt(" #n ")" ::: "memory")
#define PG8_WAIT_L(n) asm volatile("s_waitcnt lgkmcnt(" #n ")" ::: "memory")
#define PG8_BAR __builtin_amdgcn_s_barrier()
#define PG8_SCHED __builtin_amdgcn_sched_barrier(0)
    Unit cur, nxt; int ui = 0;
    if (!S.next(0, cur)) return;
    f32x4 acc[2][2][4][2];
#pragma unroll
    for (int a = 0; a < 2; ++a)
#pragma unroll
        for (int b = 0; b < 2; ++b)
#pragma unroll
            for (int m = 0; m < 4; ++m)
#pragma unroll
                for (int n = 0; n < 2; ++n) acc[a][b][m][n] = (f32x4){0.f, 0.f, 0.f, 0.f};
    bf16x8 At[4][2], B0[2][2], B1[2][2];
    const char* cA = (const char*)g.A + (size_t)cur.pm * tstep; const char* cB = (const char*)g.Bt + (size_t)cur.pn * tstep;
    PG8_STAGE(PG8_SB(0, 0), cB, voffB); PG8_STAGE(PG8_SA(0, 0), cA, voffA); PG8_STAGE(PG8_SB(0, 1), cB + hstep, voffB); PG8_STAGE(PG8_SA(0, 1), cA + hstep, voffA);
    if (wr == 1) PG8_BAR;
    PG8_WAIT_V(4); PG8_BAR;
    PG8_STAGE(PG8_SB(1, 0), cB + kstep, voffB); PG8_STAGE(PG8_SA(1, 0), cA + kstep, voffA); PG8_STAGE(PG8_SB(1, 1), cB + hstep + kstep, voffB);
    PG8_WAIT_V(6); PG8_BAR;
    for (;;) {
        const bool has_next = S.next(ui + 1, nxt);
        const char* nA = has_next ? (const char*)g.A + (size_t)nxt.pm * tstep : cA; const char* nB = has_next ? (const char*)g.Bt + (size_t)nxt.pn * tstep : cB;
        for (int t = 0; t < nt; t += 2) {
            const bool last = (t == nt - 2);
            const char* a1 = cA + (size_t)(t + 1) * kstep;
            const char* a2 = last ? nA : cA + (size_t)(t + 2) * kstep; const char* b2 = last ? nB : cB + (size_t)(t + 2) * kstep;
            const char* a3 = a2 + kstep; const char* b3 = b2 + kstep;
            PG8_LDB(B0, 0, 0); PG8_SCHED; PG8_LDA(At, 0, 0); PG8_STAGE(PG8_SA(1, 1), a1 + hstep, voffA);
            PG8_WAIT_L(8); PG8_BAR; PG8_WAIT_L(0); PG8_MMA(0, 0, At, B0); PG8_BAR; PG8_SCHED;
            PG8_LDB(B1, 0, 1); PG8_STAGE(PG8_SB(0, 0), b2, voffB);
            PG8_BAR; PG8_WAIT_L(0); PG8_MMA(0, 1, At, B1); PG8_BAR;
            PG8_LDA(At, 0, 1); PG8_STAGE(PG8_SA(0, 0), a2, voffA);
            PG8_BAR; PG8_WAIT_L(0); PG8_MMA(1, 0, At, B0); PG8_BAR; PG8_SCHED;
            PG8_STAGE(PG8_SB(0, 1), b2 + hstep, voffB);
            PG8_WAIT_V(6); PG8_BAR; PG8_MMA(1, 1, At, B1); PG8_BAR;
            PG8_LDB(B0, 1, 0); PG8_SCHED; PG8_LDA(At, 1, 0); PG8_STAGE(PG8_SA(0, 1), a2 + hstep, voffA);
            PG8_WAIT_L(8); PG8_BAR; PG8_WAIT_L(0); PG8_MMA(0, 0, At, B0); PG8_BAR; PG8_SCHED;
            PG8_LDB(B1, 1, 1); PG8_STAGE(PG8_SB(1, 0), b3, voffB);
            PG8_BAR; PG8_WAIT_L(0); PG8_MMA(0, 1, At, B1); PG8_BAR;
            PG8_LDA(At, 1, 1); PG8_STAGE(PG8_SA(1, 0), a3, voffA);
            PG8_BAR; PG8_WAIT_L(0); PG8_MMA(1, 0, At, B0); PG8_BAR; PG8_SCHED;
            PG8_STAGE(PG8_SB(1, 1), b3 + hstep, voffB);
            PG8_WAIT_V(6); PG8_BAR; PG8_MMA(1, 1, At, B1); PG8_BAR;
        }
        E(acc, cur, wr, wc, fr, fq);
        if (!has_next) break;
#pragma unroll
        for (int a = 0; a < 2; ++a)
#pragma unroll
            for (int b = 0; b < 2; ++b)
#pragma unroll
                for (int m = 0; m < 4; ++m)
#pragma unroll
                    for (int n = 0; n < 2; ++n) acc[a][b][m][n] = (f32x4){0.f, 0.f, 0.f, 0.f};
        cur = nxt; cA = nA; cB = nB; ++ui;
    }
    PG8_WAIT_V(0);
    if (wr == 0) PG8_BAR;
    PG8_BAR;
#undef PG8_SA
#undef PG8_SB
#undef PG8_STAGE
#undef PG8_LDA
#undef PG8_LDB
#undef PG8_MMA
#undef PG8_WAIT_V
#undef PG8_WAIT_L
#undef PG8_BAR
#undef PG8_SCHED
}
}

DI int win_src_col(int n0) {
    if (n0 < 2048) return n0;
    if (n0 < 2560) return 2056 + (n0 - 2048);
    if (n0 < 3072) return 2568 + (n0 - 2560);
    if (n0 < 3584) return 3592 + (n0 - 3072);
    return 3080 + (n0 - 3584);
}
DI void phase_prep(const Params& p, LAS unsigned char* lds) {
    const int tid = threadIdx.x, lane = tid & 63, wid = tid >> 6;
    if (blockIdx.x == 0 && wid == 0) {
        float a = p.lq1[lane] * p.lk1[lane], b = p.lq2[lane] * p.lk2[lane];
        a = wave_sum(a); b = wave_sum(b);
        if (lane == 0) { *(float*)(p.ws + OFF_MISC) = expf(a) - expf(b) + 0.2f; *(unsigned*)(p.ws + OFF_MISC + 4) = 0u; *(unsigned*)(p.ws + OFF_MISC + 8) = 0u; *(unsigned*)(p.ws + OFF_MISC + 12) = 0u; }
    }
    bf16_t* hb = (bf16_t*)(p.ws + OFF_HB);
    float* gbga = (float*)(p.ws + OFF_GBGA);
    const int gw = blockIdx.x * 8 + wid, nw = gridDim.x * 8;
    {
        f32x4 nwv[4]; float wq[16][8];
#pragma unroll
        for (int i = 0; i < 4; ++i) {
            nwv[i] = ((const f32x4*)p.norm_w)[lane + 64 * i];
#pragma unroll
            for (int e = 0; e < 4; ++e) {
                const int k = 4 * (lane + 64 * i) + e;
                const f32x4* wp = (const f32x4*)(p.w_in + (size_t)k * 4104 + 2048);
                const f32x4 w0 = wp[0], w1 = wp[1];
#pragma unroll
                for (int j = 0; j < 4; ++j) { wq[4 * i + e][j] = nwv[i][e] * w0[j]; wq[4 * i + e][4 + j] = nwv[i][e] * w1[j]; }
            }
        }
        const bool b5 = (lane & 32) != 0, b4 = (lane & 16) != 0, b3 = (lane & 8) != 0;
        const int col = (b5 ? 4 : 0) + (b4 ? 2 : 0) + (b3 ? 1 : 0);
        int row = gw;
        f32x4 v[4];
        if (row < MTOK) {
#pragma unroll
            for (int i = 0; i < 4; ++i) v[i] = ((const f32x4*)(p.x + (size_t)row * DM))[lane + 64 * i];
        }
#pragma unroll 1
        for (; row < MTOK; row += nw) {
            f32x4 vnx[4];
            const int rnx = (row + nw < MTOK) ? row + nw : row;
#pragma unroll
            for (int i = 0; i < 4; ++i) vnx[i] = ((const f32x4*)(p.x + (size_t)rnx * DM))[lane + 64 * i];
            float ss = 0.f, a8[8];
#pragma unroll
            for (int j = 0; j < 8; ++j) a8[j] = 0.f;
#pragma unroll
            for (int i = 0; i < 4; ++i)
#pragma unroll
                for (int e = 0; e < 4; ++e) {
                    ss += v[i][e] * v[i][e];
#pragma unroll
                    for (int j = 0; j < 8; ++j) a8[j] += v[i][e] * wq[4 * i + e][j];
                }
            ss = wave_sum(ss);
            const float rstd = rsqrtf(ss * (1.0f / DM) + EPS);
#pragma unroll
            for (int i = 0; i < 4; ++i) {
                const f32x4 h = v[i] * rstd * nwv[i];
                u32x2 w; w.x = pk_bf16(h[0], h[1]); w.y = pk_bf16(h[2], h[3]);
                *(u32x2*)(hb + (size_t)row * DM + 4 * (lane + 64 * i)) = w;
            }
            float c4[4], c2[2], c1;
#pragma unroll
            for (int j = 0; j < 4; ++j) { const float send = b5 ? a8[j] : a8[4 + j], keep = b5 ? a8[4 + j] : a8[j]; c4[j] = keep + __shfl_xor(send, 32); }
#pragma unroll
            for (int j = 0; j < 2; ++j) { const float send = b4 ? c4[j] : c4[2 + j], keep = b4 ? c4[2 + j] : c4[j]; c2[j] = keep + __shfl_xor(send, 16); }
            { const float send = b3 ? c2[0] : c2[1], keep = b3 ? c2[1] : c2[0]; c1 = keep + __shfl_xor(send, 8); }
            c1 += __shfl_xor(c1, 4); c1 += __shfl_xor(c1, 2); c1 += __shfl_xor(c1, 1);
            if ((lane & 7) == 0) gbga[(size_t)row * 8 + col] = c1 * rstd;
#pragma unroll
            for (int i = 0; i < 4; ++i) v[i] = vnx[i];
        }
    }
    LAS float* tl = (LAS float*)lds;
    for (int tile = blockIdx.x; tile < 1024 + 256; tile += gridDim.x) {
        const float* src; int ld, n0, k0, srcn0; bf16_t* dst;
        if (tile < 1024) { n0 = (tile >> 4) * 64; k0 = (tile & 15) * 64; srcn0 = win_src_col(n0); src = p.w_in; ld = 4104; dst = (bf16_t*)(p.ws + OFF_WINT); }
        else { const int t2 = tile - 1024; n0 = (t2 >> 4) * 64; k0 = (t2 & 15) * 64; srcn0 = n0; src = p.w_out; ld = 1024; dst = (bf16_t*)(p.ws + OFF_WOUTT); }
        const int kk = tid >> 4, n4 = tid & 15;
#pragma unroll
        for (int ps = 0; ps < 2; ++ps) { const int k = kk + 32 * ps;
            const f32x4 v = *(const f32x4*)(src + (size_t)(k0 + k) * ld + srcn0 + 4 * n4);
#pragma unroll
            for (int e = 0; e < 4; ++e) tl[k * 65 + 4 * n4 + e] = v[e]; }
        __syncthreads();
        { const int n = tid >> 3, k8 = tid & 7; float f[8];
#pragma unroll
            for (int e = 0; e < 8; ++e) f[e] = tl[(8 * k8 + e) * 65 + n];
            u32x4 w; w.x = pk_bf16(f[0], f[1]); w.y = pk_bf16(f[2], f[3]); w.z = pk_bf16(f[4], f[5]); w.w = pk_bf16(f[6], f[7]);
            *(u32x4*)(dst + (size_t)(n0 + n) * 1024 + k0 + 8 * k8) = w; }
        __syncthreads();
    }
}

constexpr int AT_ROW = 144, AT_KB = 64 * AT_ROW, AT_VB = 128 * AT_ROW, AT_BUF = AT_KB + AT_VB, AT_TASK = 2 * AT_BUF, AT_O1 = AT_TASK + 256;

DI void attn_qblock(const Params& p, LAS unsigned char* lds, int b, int hh, int qb, float lam) {
    int tid = threadIdx.x; asm volatile("" : "+v"(tid));
    const int lane = tid & 63, wid = __builtin_amdgcn_readfirstlane(tid >> 6), r = lane & 31, h2 = lane >> 5;
    const bf16_t* P1 = (const bf16_t*)(p.ws + OFF_P1);
    const bf16_t* VT = (const bf16_t*)(p.ws + OFF_VT) + (size_t)(b * 4 + hh) * 128 * 2048;
    bf16_t* mix = (bf16_t*)(p.ws + OFF_HB);
    const int q0 = qb * 256 + wid * 32;
    const size_t tokbase = (size_t)b * SEQ;
    const int nkt = (qb + 1) * 4;
    const float sl2 = exp2f(-2.0f * (float)(hh + 1)) * LOG2E;
    const float c1 = 0.125f * LOG2E;
    const int srow = tid >> 3, spc = tid & 7;
    LAS unsigned* o1l = (LAS unsigned*)(lds + AT_O1 + wid * 8192) + lane;
#pragma unroll 1
    for (int map = 0; map < 2; ++map) {
        bf16x8 qf[4];
        { const bf16_t* qp = P1 + (tokbase + q0 + r) * NP1 + C_DQ + hh * 128 + map * 64 + 8 * h2;
#pragma unroll
            for (int ks = 0; ks < 4; ++ks) qf[ks] = *(const bf16x8*)(qp + 16 * ks); }
        f32x16 O[4];
#pragma unroll
        for (int mt = 0; mt < 4; ++mt)
#pragma unroll
            for (int i = 0; i < 16; ++i) O[mt][i] = 0.f;
        float m = -INFINITY, l = 0.f;
        const bf16_t* kgp = P1 + (tokbase + srow) * NP1 + C_DK + hh * 128 + map * 64 + spc * 8;
        const bf16_t* vgp = VT + (size_t)srow * 2048 + spc * 8;
        u32x4 rk = *(const u32x4*)kgp, rv0 = *(const u32x4*)vgp, rv1 = *(const u32x4*)(vgp + 64 * 2048);
        *(LAS u32x4*)(lds + srow * AT_ROW + spc * 16) = rk;
        *(LAS u32x4*)(lds + AT_KB + srow * AT_ROW + spc * 16) = rv0;
        *(LAS u32x4*)(lds + AT_KB + (srow + 64) * AT_ROW + spc * 16) = rv1;
        __syncthreads();
#pragma unroll 1
        for (int kt = 0; kt < nkt; ++kt) {
            LAS unsigned char* cur = lds + (kt & 1) * AT_BUF;
            LAS unsigned char* nxt = lds + ((kt + 1) & 1) * AT_BUF;
            const bool more = kt + 1 < nkt;
            if (more) { rk = *(const u32x4*)(kgp + (size_t)(kt + 1) * 64 * NP1); rv0 = *(const u32x4*)(vgp + (kt + 1) * 64); rv1 = *(const u32x4*)(vgp + 64 * 2048 + (kt + 1) * 64); }
            const int k0 = kt * 64;
            if (k0 <= q0) {
                const bool sub1 = (k0 + 32 <= q0);
                f32x16 s0, s1;
#pragma unroll
                for (int i = 0; i < 16; ++i) { s0[i] = 0.f; s1[i] = 0.f; }
#pragma unroll
                for (int ks = 0; ks < 4; ++ks) { const bf16x8 kf = *(const LAS bf16x8*)(cur + r * AT_ROW + (16 * ks + 8 * h2) * 2); s0 = MFMA32(kf, qf[ks], s0); }
                if (sub1) {
#pragma unroll
                    for (int ks = 0; ks < 4; ++ks) { const bf16x8 kf = *(const LAS bf16x8*)(cur + (32 + r) * AT_ROW + (16 * ks + 8 * h2) * 2); s1 = MFMA32(kf, qf[ks], s1); }
                }
                const float base0 = sl2 * (float)(k0 - q0 + 4 * h2);
                const bool diag0 = (k0 == q0), diag1 = (k0 + 32 == q0);
                float mx = -INFINITY;
#pragma unroll
                for (int i = 0; i < 16; ++i) {
                    const int ci = (i & 3) + 8 * (i >> 2);
                    float t0 = fmaf(s0[i], c1, base0 + sl2 * (float)ci);
                    if (diag0 && (ci + 4 * h2 > r)) t0 = -INFINITY;
                    float t1 = fmaf(s1[i], c1, base0 + sl2 * (float)(32 + ci));
                    if (!sub1 || (diag1 && (ci + 4 * h2 > r))) t1 = -INFINITY;
                    s0[i] = t0; s1[i] = t1; mx = fmaxf(mx, fmaxf(t0, t1));
                }
                mx = fmaxf(mx, __shfl_xor(mx, 32));
                const float mn = fmaxf(m, mx);
                const float alpha = __builtin_amdgcn_exp2f(m - mn);
                m = mn; l *= alpha;
#pragma unroll
                for (int mt = 0; mt < 4; ++mt)
#pragma unroll
                    for (int i = 0; i < 16; ++i) O[mt][i] *= alpha;
                float ls = 0.f;
#pragma unroll
                for (int i = 0; i < 16; ++i) { s0[i] = __builtin_amdgcn_exp2f(s0[i] - mn); s1[i] = __builtin_amdgcn_exp2f(s1[i] - mn); ls += s0[i] + s1[i]; }
                l += ls;
                bf16x8 pf[4];
#pragma unroll
                for (int s = 0; s < 2; ++s) {
                    u32x4 a, c;
                    a.x = pk_bf16(s0[8 * s + 0], s0[8 * s + 1]); a.y = pk_bf16(s0[8 * s + 2], s0[8 * s + 3]); a.z = pk_bf16(s0[8 * s + 4], s0[8 * s + 5]); a.w = pk_bf16(s0[8 * s + 6], s0[8 * s + 7]);
                    c.x = pk_bf16(s1[8 * s + 0], s1[8 * s + 1]); c.y = pk_bf16(s1[8 * s + 2], s1[8 * s + 3]); c.z = pk_bf16(s1[8 * s + 4], s1[8 * s + 5]); c.w = pk_bf16(s1[8 * s + 6], s1[8 * s + 7]);
                    pf[s] = __builtin_bit_cast(bf16x8, a); pf[2 + s] = __builtin_bit_cast(bf16x8, c);
                }
                const LAS unsigned char* vb = cur + AT_KB + r * AT_ROW + 16 * h2;
#pragma unroll
                for (int s2 = 0; s2 < 2; ++s2)
#pragma unroll
                    for (int mt = 0; mt < 4; ++mt) { const bf16x8 vf = *(const LAS bf16x8*)(vb + mt * 32 * AT_ROW + s2 * 32); O[mt] = MFMA32(vf, pf[s2], O[mt]); }
                if (sub1) {
#pragma unroll
                    for (int s2 = 2; s2 < 4; ++s2)
#pragma unroll
                        for (int mt = 0; mt < 4; ++mt) { const bf16x8 vf = *(const LAS bf16x8*)(vb + mt * 32 * AT_ROW + s2 * 32); O[mt] = MFMA32(vf, pf[s2], O[mt]); }
                }
            }
            if (more) {
                *(LAS u32x4*)(nxt + srow * AT_ROW + spc * 16) = rk;
                *(LAS u32x4*)(nxt + AT_KB + srow * AT_ROW + spc * 16) = rv0;
                *(LAS u32x4*)(nxt + AT_KB + (srow + 64) * AT_ROW + spc * 16) = rv1;
            }
            __syncthreads();
        }
        const float lt = l + __shfl_xor(l, 32);
        if (map == 0) {
            const float inv1 = 1.0f / lt;
#pragma unroll
            for (int mt = 0; mt < 4; ++mt)
#pragma unroll
                for (int j = 0; j < 8; ++j) o1l[(mt * 8 + j) * 64] = pk_bf16(O[mt][2 * j] * inv1, O[mt][2 * j + 1] * inv1);
        } else {
            const float inv2 = lam / lt;
            float ss = 0.f;
#pragma unroll
            for (int mt = 0; mt < 4; ++mt)
#pragma unroll
                for (int j = 0; j < 8; ++j) {
                    const unsigned o1 = o1l[(mt * 8 + j) * 64];
                    const float a = bf_lo(o1) - O[mt][2 * j] * inv2, c = bf_hi(o1) - O[mt][2 * j + 1] * inv2;
                    O[mt][2 * j] = a; O[mt][2 * j + 1] = c; ss += a * a + c * c;
                }
            ss += __shfl_xor(ss, 32);
            const float rs = rsqrtf(ss * (1.0f / 128.0f) + EPS) * 0.8f;
#pragma unroll
            for (int mt = 0; mt < 4; ++mt)
#pragma unroll
                for (int j = 0; j < 8; ++j) o1l[(mt * 8 + j) * 64] = pk_bf16(O[mt][2 * j] * rs, O[mt][2 * j + 1] * rs);
            __builtin_amdgcn_wave_barrier();
            const int dvg = lane & 15, qs = lane >> 4;
            const f32x4 nw0 = *(const f32x4*)(p.diff_norm_w + 8 * dvg), nw1 = *(const f32x4*)(p.diff_norm_w + 8 * dvg + 4);
            const LAS unsigned* ob = (const LAS unsigned*)(lds + AT_O1 + wid * 8192);
            const int slot = (dvg >> 2) * 8 + 2 * (dvg & 3);
#pragma unroll 2
            for (int it = 0; it < 8; ++it) {
                const int q = it * 4 + qs; const size_t row = tokbase + q0 + q;
                const unsigned u0 = ob[slot * 64 + q], u1 = ob[(slot + 1) * 64 + q], u2 = ob[slot * 64 + q + 32], u3 = ob[(slot + 1) * 64 + q + 32];
                const u32x4 dz = *(const u32x4*)(P1 + row * NP1 + C_DZ + hh * 128 + 8 * dvg);
                u32x4 w;
                w.x = pk_bf16(bf_lo(u0) * nw0[0] * silu_f(bf_lo(dz.x)), bf_hi(u0) * nw0[1] * silu_f(bf_hi(dz.x)));
                w.y = pk_bf16(bf_lo(u1) * nw0[2] * silu_f(bf_lo(dz.y)), bf_hi(u1) * nw0[3] * silu_f(bf_hi(dz.y)));
                w.z = pk_bf16(bf_lo(u2) * nw1[0] * silu_f(bf_lo(dz.z)), bf_hi(u2) * nw1[1] * silu_f(bf_hi(dz.z)));
                w.w = pk_bf16(bf_lo(u3) * nw1[2] * silu_f(bf_lo(dz.w)), bf_hi(u3) * nw1[3] * silu_f(bf_hi(dz.w)));
                *(u32x4*)(mix + row * DM + 512 + hh * 128 + 8 * dvg) = w;
            }
            __builtin_amdgcn_wave_barrier();
        }
    }
}

DI void phase_attn(const Params& p, LAS unsigned char* lds, int rep) {
    const float lam = *(const float*)(p.ws + OFF_MISC);
    unsigned* counter = (unsigned*)(p.ws + OFF_MISC + 4 + 4 * rep);
    LAS int* tslot = (LAS int*)(lds + AT_TASK);
    for (;;) {
        if (threadIdx.x == 0) *tslot = (int)atomicAdd(counter, 1u);
        __syncthreads();
        const int t = *tslot;
        __syncthreads();
        if (t >= 512) break;
        const int qb = 7 - (t >> 6), bh = t & 63;
        attn_qblock(p, lds, bh >> 2, bh & 3, qb, lam);
    }
}


constexpr int G_QN = 0, G_KN = 17408, G_VB = 34816, G_KBG = 52224, G_M = 69632, G_T = 86016, G_SM = 95232;
DI int crow(int i, int h2) { return (i & 3) + 8 * (i >> 2) + 4 * h2; }
DI bf16x8 tr_pair(const LAS unsigned char* lo_addr, int hi_off) {
    const s16x4 lo = __builtin_amdgcn_ds_read_tr16_b64_v4i16((LAS s16x4*)(lo_addr));
    const s16x4 hi = __builtin_amdgcn_ds_read_tr16_b64_v4i16((LAS s16x4*)(lo_addr + hi_off));
    return __builtin_shufflevector(lo, hi, 0, 1, 2, 3, 4, 5, 6, 7);
}
DI bf16x8 pack8(const f32x16& x, int s) {
    u32x4 w; w.x = pk_bf16(x[8 * s + 0], x[8 * s + 1]); w.y = pk_bf16(x[8 * s + 2], x[8 * s + 3]); w.z = pk_bf16(x[8 * s + 4], x[8 * s + 5]); w.w = pk_bf16(x[8 * s + 6], x[8 * s + 7]);
    return __builtin_bit_cast(bf16x8, w);
}
DI bf16_t bf16_1(float v) { return (bf16_t)(pk_bf16(v, 0.f) & 0xffffu); }

DI void gdn_prep(const Params& p, LAS unsigned char* lds, int c2) {
    int tid = threadIdx.x; asm volatile("" : "+v"(tid));
    const int lane = tid & 63, wid = __builtin_amdgcn_readfirstlane(tid >> 6), r = lane & 31, h2 = lane >> 5;
    const int b = c2 >> 7, hh = (c2 >> 5) & 3, n = c2 & 31;
    const size_t tok0 = (size_t)b * SEQ + (size_t)n * 64;
    const bf16_t* P1 = (const bf16_t*)(p.ws + OFF_P1);
    LAS float* sm = (LAS float*)(lds + G_SM);
    LAS float* Mf = (LAS float*)(lds + G_M);
    bf16_t* WN = (bf16_t*)(p.ws + OFF_WN) + (size_t)c2 * 8192;
    bf16_t* QD = (bf16_t*)(p.ws + OFF_QD) + (size_t)c2 * 8192;
    bf16_t* KD = (bf16_t*)(p.ws + OFF_KD) + (size_t)c2 * 8192;
    bf16_t* AQ = (bf16_t*)(p.ws + OFF_AQK) + (size_t)c2 * 4096;
    float* U = (float*)(p.ws + OFF_U) + (size_t)c2 * 8192;
    u32x4 raw[6][4];
#pragma unroll
    for (int i = 0; i < 6; ++i) {
        const int item = tid + 512 * i, g = item & 15, t = (item >> 4) & 63, part = i >> 1;
        const int ch = part * 512 + hh * 128 + g * 8;
#pragma unroll
        for (int j = 0; j < 4; ++j) {
            const int tt = n * 64 + t - 3 + j, ttc = tt < 0 ? 0 : tt;
            raw[i][j] = *(const u32x4*)(P1 + ((size_t)b * SEQ + ttc) * NP1 + ch);
            if (tt < 0) raw[i][j] = (u32x4){0u, 0u, 0u, 0u};
        }
    }
    if (wid == 0) {
        const float* gg = (const float*)(p.ws + OFF_GBGA) + (tok0 + lane) * 8;
        const float gbv = gg[hh], gav = gg[4 + hh];
        const float beta = 1.0f / (1.0f + expf(-gbv));
        const float xs = gav + p.dt_bias[hh];
        const float sp = fmaxf(xs, 0.f) + log1pf(expf(-fabsf(xs)));
        float gc = -expf(p.a_log[hh]) * sp;
#pragma unroll
        for (int o = 1; o < 64; o <<= 1) { const float t = __shfl_up(gc, o); if (lane >= o) gc += t; }
        const float gl = __shfl(gc, 63);
        sm[lane] = beta; sm[64 + lane] = gc * LOG2E; sm[128 + lane] = expf(gc); sm[192 + lane] = expf(gl - gc);
        if (lane == 63) ((float*)(p.ws + OFF_GL))[c2] = expf(gl);
    }
    float av[6][8];
#pragma unroll
    for (int i = 0; i < 6; ++i) {
        const int item = tid + 512 * i, g = item & 15, part = i >> 1;
        const int ch = part * 512 + hh * 128 + g * 8;
        float a[8];
#pragma unroll
        for (int e = 0; e < 8; ++e) a[e] = 0.f;
#pragma unroll
        for (int j = 0; j < 4; ++j) {
            const f32x4 w0 = *(const f32x4*)(p.conv_w + j * 1536 + ch), w1 = *(const f32x4*)(p.conv_w + j * 1536 + ch + 4);
            const u32x4 rw = raw[i][j];
            a[0] += w0[0] * bf_lo(rw.x); a[1] += w0[1] * bf_hi(rw.x); a[2] += w0[2] * bf_lo(rw.y); a[3] += w0[3] * bf_hi(rw.y);
            a[4] += w1[0] * bf_lo(rw.z); a[5] += w1[1] * bf_hi(rw.z); a[6] += w1[2] * bf_lo(rw.w); a[7] += w1[3] * bf_hi(rw.w);
        }
        float ss = 0.f;
#pragma unroll
        for (int e = 0; e < 8; ++e) { a[e] = silu_f(a[e]); ss += a[e] * a[e]; }
        float rn = 1.0f;
        if (part < 2) {
            ss += __shfl_xor(ss, 1); ss += __shfl_xor(ss, 2); ss += __shfl_xor(ss, 4); ss += __shfl_xor(ss, 8);
            rn = rsqrtf(ss + 1e-6f) * (part == 0 ? 0.08838834764831845f : 1.0f);
        }
#pragma unroll
        for (int e = 0; e < 8; ++e) av[i][e] = a[e] * rn;
    }
    __syncthreads();
#pragma unroll
    for (int i = 0; i < 6; ++i) {
        const int item = tid + 512 * i, g = item & 15, t = (item >> 4) & 63, part = i >> 1;
        const float* a = av[i];
        const float beta = sm[t], egc = sm[128 + t], ekd = sm[192 + t];
        if (part < 2) {
            u32x4 w; w.x = pk_bf16(a[0], a[1]); w.y = pk_bf16(a[2], a[3]); w.z = pk_bf16(a[4], a[5]); w.w = pk_bf16(a[6], a[7]);
            *(LAS u32x4*)(lds + (part == 0 ? G_QN : G_KN) + t * 272 + g * 16) = w;
            if (part == 0) {
                u32x2 lo, hi; lo.x = pk_bf16(a[0] * egc, a[1] * egc); lo.y = pk_bf16(a[2] * egc, a[3] * egc); hi.x = pk_bf16(a[4] * egc, a[5] * egc); hi.y = pk_bf16(a[6] * egc, a[7] * egc);
                bf16_t* qd = QD + t * 128 + 16 * (g >> 1) + 4 * (g & 1);
                *(u32x2*)qd = lo; *(u32x2*)(qd + 8) = hi;
            } else {
                const float f1 = beta * egc;
                u32x4 w2; w2.x = pk_bf16(a[0] * f1, a[1] * f1); w2.y = pk_bf16(a[2] * f1, a[3] * f1); w2.z = pk_bf16(a[4] * f1, a[5] * f1); w2.w = pk_bf16(a[6] * f1, a[7] * f1);
                *(LAS u32x4*)(lds + G_KBG + t * 272 + g * 16) = w2;
                u32x4 w3; w3.x = pk_bf16(a[0] * ekd, a[1] * ekd); w3.y = pk_bf16(a[2] * ekd, a[3] * ekd); w3.z = pk_bf16(a[4] * ekd, a[5] * ekd); w3.w = pk_bf16(a[6] * ekd, a[7] * ekd);
                *(u32x4*)(KD + t * 128 + g * 8) = w3;
            }
        } else {
            u32x4 w; w.x = pk_bf16(a[0] * beta, a[1] * beta); w.y = pk_bf16(a[2] * beta, a[3] * beta); w.z = pk_bf16(a[4] * beta, a[5] * beta); w.w = pk_bf16(a[6] * beta, a[7] * beta);
            *(LAS u32x4*)(lds + G_VB + t * 272 + g * 16) = w;
        }
    }
    __syncthreads();
    {
        const int w4 = wid & 3, mt = w4 >> 1, nt = w4 & 1; const bool isqk = wid >= 4;
        if (!(mt == 0 && nt == 1)) {
            const LAS unsigned char* Ab = lds + (isqk ? G_QN : G_KN) + (32 * mt + r) * 272 + 16 * h2;
            const LAS unsigned char* Bb = lds + G_KN + (32 * nt + r) * 272 + 16 * h2;
            f32x16 X;
#pragma unroll
            for (int i = 0; i < 16; ++i) X[i] = 0.f;
#pragma unroll
            for (int ks = 0; ks < 8; ++ks) X = MFMA32(*(const LAS bf16x8*)(Ab + 32 * ks), *(const LAS bf16x8*)(Bb + 32 * ks), X);
            const int s = 32 * nt + r; const float gcs = sm[64 + s];
#pragma unroll
            for (int i = 0; i < 16; ++i) {
                const int c = 32 * mt + crow(i, h2);
                const float dec = __builtin_amdgcn_exp2f(sm[64 + c] - gcs);
                if (!isqk) Mf[c * 64 + s] = (c > s) ? sm[c] * X[i] * dec : 0.f;
                else AQ[c * 64 + perm23(s)] = bf16_1((c >= s) ? X[i] * dec : 0.f);
            }
        }
    }
    __syncthreads();
    if (wid == 0) {
        const int cc = r, hb = h2;
        const LAS float* Mb = Mf + (32 * hb) * 64 + 32 * hb;
        float T[32];
#pragma unroll
        for (int i = 0; i < 32; ++i) T[i] = 0.f;
#pragma unroll
        for (int i = 0; i < 32; ++i) {
            float acc = (i == cc) ? 1.f : 0.f;
#pragma unroll
            for (int s4 = 0; s4 < (i + 3) / 4; ++s4) {
                const f32x4 m4 = *(const LAS f32x4*)(Mb + i * 64 + 4 * s4);
                acc -= m4[0] * T[4 * s4]; acc -= m4[1] * T[4 * s4 + 1]; acc -= m4[2] * T[4 * s4 + 2]; acc -= m4[3] * T[4 * s4 + 3];
            }
            T[i] = acc;
            if ((i & 1) == 1) asm volatile("" : "+v"(acc) :: "memory");
            T[i] = acc;
        }
        LAS bf16_t* Tb = (LAS bf16_t*)(lds + G_T);
#pragma unroll
        for (int i = 0; i < 32; ++i) {
            Tb[(32 * hb + i) * 72 + 32 * hb + cc] = bf16_1(T[i]);
            if (hb == 0) Tb[i * 72 + 32 + cc] = 0;
        }
        __builtin_amdgcn_wave_barrier();
        asm volatile("s_waitcnt lgkmcnt(0)" ::: "memory");
        const int i16 = lane & 15, q = i16 >> 2, pp = i16 & 3, blk = (lane >> 4) & 1;
        f32x16 Y;
#pragma unroll
        for (int i = 0; i < 16; ++i) Y[i] = 0.f;
#pragma unroll
        for (int ks = 0; ks < 2; ++ks) {
            const LAS float* mp = Mf + (32 + r) * 64 + 16 * ks + 8 * h2;
            const f32x4 m0 = *(const LAS f32x4*)mp, m1 = *(const LAS f32x4*)(mp + 4);
            u32x4 aw; aw.x = pk_bf16(m0[0], m0[1]); aw.y = pk_bf16(m0[2], m0[3]); aw.z = pk_bf16(m1[0], m1[1]); aw.w = pk_bf16(m1[2], m1[3]);
            const bf16x8 bfrag = tr_pair(lds + G_T + (16 * ks + 8 * h2 + q) * 144 + (16 * blk + 4 * pp) * 2, 4 * 144);
            Y = MFMA32(__builtin_bit_cast(bf16x8, aw), bfrag, Y);
        }
        f32x16 Z;
#pragma unroll
        for (int i = 0; i < 16; ++i) Z[i] = 0.f;
#pragma unroll
        for (int s = 0; s < 2; ++s) {
            const LAS unsigned char* tp = lds + G_T + (32 + r) * 144 + (32 + 16 * s + 4 * h2) * 2;
            const u32x2 lo = *(const LAS u32x2*)tp, hi = *(const LAS u32x2*)(tp + 16);
            u32x4 aw; aw.x = lo.x; aw.y = lo.y; aw.z = hi.x; aw.w = hi.y;
            Z = MFMA32(__builtin_bit_cast(bf16x8, aw), pack8(Y, s), Z);
        }
#pragma unroll
        for (int i = 0; i < 16; ++i) Tb[(32 + crow(i, h2)) * 72 + r] = bf16_1(-Z[i]);
    }
    __syncthreads();
    {
        const int mt = wid >> 2, nt = wid & 3;
        const int i16 = lane & 15, q = i16 >> 2, pp = i16 & 3, blk = (lane >> 4) & 1;
        f32x16 Xu, Xw;
#pragma unroll
        for (int i = 0; i < 16; ++i) { Xu[i] = 0.f; Xw[i] = 0.f; }
#pragma unroll
        for (int ks = 0; ks < 4; ++ks) {
            if (ks < 2 * (mt + 1)) {
                const bf16x8 af = *(const LAS bf16x8*)(lds + G_T + (32 * mt + r) * 144 + (16 * ks + 8 * h2) * 2);
                const int boff = (16 * ks + 8 * h2 + q) * 272 + (32 * nt + 16 * blk + 4 * pp) * 2;
                Xu = MFMA32(af, tr_pair(lds + G_VB + boff, 4 * 272), Xu);
                Xw = MFMA32(af, tr_pair(lds + G_KBG + boff, 4 * 272), Xw);
            }
        }
        const int d = 32 * nt + r, dp = perm23(d);
        {
            float* up = U + ((nt * 2 + mt) * 64 + lane) * 16;
#pragma unroll
            for (int k = 0; k < 4; ++k) { const f32x4 v = {Xu[4 * k], Xu[4 * k + 1], Xu[4 * k + 2], Xu[4 * k + 3]}; *(f32x4*)(up + 4 * k) = v; }
        }
#pragma unroll
        for (int i = 0; i < 16; ++i) {
            const int c = 32 * mt + crow(i, h2);
            WN[c * 128 + dp] = bf16_1(-Xw[i]);
        }
    }
    __syncthreads();
}

constexpr int S_WN = 0, S_QD = 17408, S_KD = 34816, S_AQ = 52224, S_BUF = 61440, S_STG = 2 * S_BUF;

DI void scan_gate(const Params& p, LAS unsigned char* lds, int tid, int b, int hh, int n) {
    const int gc_ = tid >> 3, seg = tid & 7;
    const bf16_t* P1 = (const bf16_t*)(p.ws + OFF_P1);
    bf16_t* mix = (bf16_t*)(p.ws + OFF_HB);
    const LAS float* st = (const LAS float*)(lds + S_STG) + gc_ * 132 + seg * 16;
    f32x4 ov[4]; float ss = 0.f;
#pragma unroll
    for (int k = 0; k < 4; ++k) { ov[k] = *(const LAS f32x4*)(st + 4 * k); ss += ov[k][0] * ov[k][0] + ov[k][1] * ov[k][1] + ov[k][2] * ov[k][2] + ov[k][3] * ov[k][3]; }
    ss += __shfl_xor(ss, 1); ss += __shfl_xor(ss, 2); ss += __shfl_xor(ss, 4);
    const float rstd = rsqrtf(ss * (1.0f / 128.0f) + EPS);
    f32x4 gnw[4];
#pragma unroll
    for (int k = 0; k < 4; ++k) gnw[k] = *(const f32x4*)(p.gdn_norm_w + seg * 16 + 4 * k);
    const size_t row = (size_t)b * SEQ + n * 64 + gc_;
    const u32x4 z0 = *(const u32x4*)(P1 + row * NP1 + C_GZ + hh * 128 + seg * 16), z1 = *(const u32x4*)(P1 + row * NP1 + C_GZ + hh * 128 + seg * 16 + 8);
    u32x4 w0, w1;
    w0.x = pk_bf16(ov[0][0] * rstd * gnw[0][0] * silu_f(bf_lo(z0.x)), ov[0][1] * rstd * gnw[0][1] * silu_f(bf_hi(z0.x)));
    w0.y = pk_bf16(ov[0][2] * rstd * gnw[0][2] * silu_f(bf_lo(z0.y)), ov[0][3] * rstd * gnw[0][3] * silu_f(bf_hi(z0.y)));
    w0.z = pk_bf16(ov[1][0] * rstd * gnw[1][0] * silu_f(bf_lo(z0.z)), ov[1][1] * rstd * gnw[1][1] * silu_f(bf_hi(z0.z)));
    w0.w = pk_bf16(ov[1][2] * rstd * gnw[1][2] * silu_f(bf_lo(z0.w)), ov[1][3] * rstd * gnw[1][3] * silu_f(bf_hi(z0.w)));
    w1.x = pk_bf16(ov[2][0] * rstd * gnw[2][0] * silu_f(bf_lo(z1.x)), ov[2][1] * rstd * gnw[2][1] * silu_f(bf_hi(z1.x)));
    w1.y = pk_bf16(ov[2][2] * rstd * gnw[2][2] * silu_f(bf_lo(z1.y)), ov[2][3] * rstd * gnw[2][3] * silu_f(bf_hi(z1.y)));
    w1.z = pk_bf16(ov[3][0] * rstd * gnw[3][0] * silu_f(bf_lo(z1.z)), ov[3][1] * rstd * gnw[3][1] * silu_f(bf_hi(z1.z)));
    w1.w = pk_bf16(ov[3][2] * rstd * gnw[3][2] * silu_f(bf_lo(z1.w)), ov[3][3] * rstd * gnw[3][3] * silu_f(bf_hi(z1.w)));
    bf16_t* mp = mix + row * DM + hh * 128 + seg * 16;
    *(u32x4*)mp = w0; *(u32x4*)(mp + 8) = w1;
}

DI void scan_load_chunk(LAS unsigned char* dst, const bf16_t* WN, const bf16_t* QD, const bf16_t* KD, const bf16_t* AQ, int ltid) {
    {
        u32x4 t0[4], t1[4];
#pragma unroll
        for (int i = 0; i < 4; ++i) { const int pi = ltid + 256 * i; t0[i] = *(const u32x4*)(WN + pi * 8); t1[i] = *(const u32x4*)(QD + pi * 8); }
#pragma unroll
        for (int i = 0; i < 4; ++i) { const int pi = ltid + 256 * i, row = pi >> 4, pc = pi & 15;
            *(LAS u32x4*)(dst + S_WN + row * 272 + pc * 16) = t0[i]; *(LAS u32x4*)(dst + S_QD + row * 272 + pc * 16) = t1[i]; }
    }
    asm volatile("" ::: "memory");
    {
        u32x4 t2[4], t3[2];
#pragma unroll
        for (int i = 0; i < 4; ++i) { const int pi = ltid + 256 * i; t2[i] = *(const u32x4*)(KD + pi * 8); }
#pragma unroll
        for (int i = 0; i < 2; ++i) { const int pi = ltid + 256 * i; t3[i] = *(const u32x4*)(AQ + pi * 8); }
#pragma unroll
        for (int i = 0; i < 4; ++i) { const int pi = ltid + 256 * i, row = pi >> 4, pc = pi & 15; *(LAS u32x4*)(dst + S_KD + row * 272 + pc * 16) = t2[i]; }
#pragma unroll
        for (int i = 0; i < 2; ++i) { const int pi = ltid + 256 * i, row = pi >> 3, pc = pi & 7; *(LAS u32x4*)(dst + S_AQ + row * 144 + pc * 16) = t3[i]; }
    }
}

DI void gdn_scan(const Params& p, LAS unsigned char* lds, int bh) {
    int tid = threadIdx.x; asm volatile("" : "+v"(tid));
    const int lane = tid & 63, wid = __builtin_amdgcn_readfirstlane(tid >> 6), r = lane & 31, h2 = lane >> 5;
    const int b = bh >> 2, hh = bh & 3;
    const bf16_t* WN = (const bf16_t*)(p.ws + OFF_WN) + (size_t)bh * 32 * 8192;
    const bf16_t* QD = (const bf16_t*)(p.ws + OFF_QD) + (size_t)bh * 32 * 8192;
    const bf16_t* KD = (const bf16_t*)(p.ws + OFF_KD) + (size_t)bh * 32 * 8192;
    const bf16_t* AQ = (const bf16_t*)(p.ws + OFF_AQK) + (size_t)bh * 32 * 4096;
    const float* U = (const float*)(p.ws + OFF_U) + (size_t)bh * 32 * 8192;
    const float* GL = (const float*)(p.ws + OFF_GL) + bh * 32;
    if (wid >= 4) {
        const int ltid = tid & 255;
        scan_load_chunk(lds, WN, QD, KD, AQ, ltid);
#pragma unroll 1
        for (int n = 0; n < 32; ++n) {
            __syncthreads();
            if (n + 1 < 32) scan_load_chunk(lds + ((n + 1) & 1) * S_BUF, WN + (size_t)(n + 1) * 8192, QD + (size_t)(n + 1) * 8192, KD + (size_t)(n + 1) * 8192, AQ + (size_t)(n + 1) * 4096, ltid);
            __syncthreads();
            scan_gate(p, lds, tid, b, hh, n);
        }
    } else {
        const int i16 = lane & 15, q4 = i16 >> 2, pp = i16 & 3, blk = (lane >> 4) & 1;
        f32x16 St[4], u[2];
#pragma unroll
        for (int k = 0; k < 4; ++k)
#pragma unroll
            for (int i = 0; i < 16; ++i) St[k][i] = 0.f;
#pragma unroll
        for (int mt = 0; mt < 2; ++mt)
#pragma unroll
            for (int k = 0; k < 4; ++k) { const f32x4 v = *(const f32x4*)(U + ((wid * 2 + mt) * 64 + lane) * 16 + 4 * k); u[mt][4 * k] = v[0]; u[mt][4 * k + 1] = v[1]; u[mt][4 * k + 2] = v[2]; u[mt][4 * k + 3] = v[3]; }
#pragma unroll 1
        for (int n = 0; n < 32; ++n) {
            LAS unsigned char* buf = lds + (n & 1) * S_BUF;
            __syncthreads();
            const float egl = GL[n];
            f32x16 vn[2], o[2];
            vn[0] = u[0]; vn[1] = u[1];
#pragma unroll
            for (int mt = 0; mt < 2; ++mt)
#pragma unroll
                for (int i = 0; i < 16; ++i) o[mt][i] = 0.f;
#pragma unroll
            for (int ks = 0; ks < 8; ++ks) {
                const bf16x8 sf = pack8(St[ks >> 1], ks & 1);
#pragma unroll
                for (int mt = 0; mt < 2; ++mt) {
                    const bf16x8 wf = *(const LAS bf16x8*)(buf + S_WN + (32 * mt + r) * 272 + (16 * ks + 8 * h2) * 2);
                    vn[mt] = MFMA32(wf, sf, vn[mt]);
                    const bf16x8 qf = *(const LAS bf16x8*)(buf + S_QD + (32 * mt + r) * 272 + (16 * ks + 8 * h2) * 2);
                    o[mt] = MFMA32(qf, sf, o[mt]);
                }
                asm volatile("" ::: "memory");
            }
            bf16x8 vf[4];
#pragma unroll
            for (int k2 = 0; k2 < 4; ++k2) vf[k2] = pack8(vn[k2 >> 1], k2 & 1);
            {
                const int nn = (n + 1 < 32) ? n + 1 : n;
                const float* up = U + (size_t)nn * 8192 + ((wid * 2) * 64 + lane) * 16;
#pragma unroll
                for (int mt = 0; mt < 2; ++mt)
#pragma unroll
                    for (int k = 0; k < 4; ++k) { const f32x4 v = *(const f32x4*)(up + mt * 1024 + 4 * k); u[mt][4 * k] = v[0]; u[mt][4 * k + 1] = v[1]; u[mt][4 * k + 2] = v[2]; u[mt][4 * k + 3] = v[3]; }
            }
#pragma unroll
            for (int mt = 0; mt < 2; ++mt)
#pragma unroll
                for (int k2 = 0; k2 < 2 * (mt + 1); ++k2) {
                    const bf16x8 af = *(const LAS bf16x8*)(buf + S_AQ + (32 * mt + r) * 144 + (16 * k2 + 8 * h2) * 2);
                    o[mt] = MFMA32(af, vf[k2], o[mt]);
                }
            {
                LAS float* st = (LAS float*)(lds + S_STG);
#pragma unroll
                for (int mt = 0; mt < 2; ++mt)
#pragma unroll
                    for (int i = 0; i < 16; ++i) st[(32 * mt + crow(i, h2)) * 132 + 32 * wid + r] = o[mt][i];
            }
#pragma unroll
            for (int kt = 0; kt < 4; ++kt) {
#pragma unroll
                for (int i = 0; i < 16; ++i) St[kt][i] *= egl;
#pragma unroll
                for (int k2 = 0; k2 < 4; ++k2) {
                    const bf16x8 kf = tr_pair(buf + S_KD + (16 * k2 + 4 * h2 + q4) * 272 + (32 * kt + 16 * blk + 4 * pp) * 2, 8 * 272);
                    St[kt] = MFMA32(kf, vf[k2], St[kt]);
                }
                asm volatile("" ::: "memory");
            }
            __syncthreads();
            scan_gate(p, lds, tid, b, hh, n);
        }
    }
    __syncthreads();
}

DI void zero_mix_half(const Params& p, int half) {
    bf16_t* mix = (bf16_t*)(p.ws + OFF_HB);
    const size_t n16 = (size_t)MTOK * 64;
    for (size_t i = (size_t)blockIdx.x * 512 + threadIdx.x; i < n16; i += (size_t)gridDim.x * 512) {
        const size_t row = i >> 6, pc = i & 63;
        *(u32x4*)(mix + row * DM + half * 512 + pc * 8) = (u32x4){0u, 0u, 0u, 0u};
    }
}

DI void phase_final(const Params& p) {
    const int tid = threadIdx.x, lane = tid & 63, wid = tid >> 6;
    const float* rowsq = (const float*)(p.ws + OFF_ROWSQ);
    const int gw = blockIdx.x * 8 + wid, nw = gridDim.x * 8;
    f32x4 fw[4];
#pragma unroll
    for (int i = 0; i < 4; ++i) fw[i] = ((const f32x4*)p.final_norm_w)[lane + 64 * i];
    int row = gw;
    f32x4 y[4]; float sq = 0.f;
    if (row < MTOK) {
#pragma unroll
        for (int i = 0; i < 4; ++i) y[i] = ((const f32x4*)(p.out + (size_t)row * DM))[lane + 64 * i];
        sq = lane < 16 ? rowsq[(size_t)row * 16 + lane] : 0.f;
    }
#pragma unroll 1
    for (; row < MTOK; row += nw) {
        const int rnx = (row + nw < MTOK) ? row + nw : row;
        f32x4 yn[4];
#pragma unroll
        for (int i = 0; i < 4; ++i) yn[i] = ((const f32x4*)(p.out + (size_t)rnx * DM))[lane + 64 * i];
        const float sqn = lane < 16 ? rowsq[(size_t)rnx * 16 + lane] : 0.f;
        const float ss = wave_sum(sq);
        const float rstd = rsqrtf(ss * (1.0f / DM) + EPS);
        f32x4* o = (f32x4*)(p.out + (size_t)row * DM);
#pragma unroll
        for (int i = 0; i < 4; ++i) o[lane + 64 * i] = y[i] * rstd * fw[i];
#pragma unroll
        for (int i = 0; i < 4; ++i) y[i] = yn[i];
        sq = sqn;
    }
}

__global__ void __launch_bounds__(512) mega(Params p) {
    extern __shared__ __attribute__((aligned(16))) unsigned char shm[];
    LAS unsigned char* lds = (LAS unsigned char*)shm;
    cg::grid_group grid = cg::this_grid();

#pragma unroll 1
    for (int rep = 0; rep < REP_PREP; ++rep) phase_prep(p, lds);
    grid.sync();
#pragma unroll 1
    for (int rep = 0; rep < REP_G1; ++rep)
    {
        pg8::Gemm g{(const bf16_t*)(p.ws + OFF_HB), (const bf16_t*)(p.ws + OFF_WINT), MTOK, NP1, DM};
        pg8::StaticOrder S; S.init(g.M, g.N, (int)gridDim.x, (int)blockIdx.x);
        pg8::EpiP1 E{(bf16_t*)(p.ws + OFF_P1), NP1};
        pg8::gemm_phase<pg8::EpiP1, false>(lds, g, S, E);
        pg8::Gemm g2{(const bf16_t*)(p.ws + OFF_HB), (const bf16_t*)(p.ws + OFF_WINT) + (size_t)NP1 * DM, MTOK, 512, DM};
        pg8::StaticOrder S2; S2.init(g2.M, g2.N, (int)gridDim.x, (int)blockIdx.x);
        pg8::EpiVT E2{(bf16_t*)(p.ws + OFF_VT)};
        pg8::gemm_phase<pg8::EpiVT, true>(lds, g2, S2, E2);
    }
    grid.sync();
#pragma unroll 1
    for (int rep = 0; rep < REP_GP; ++rep)
        for (int c2 = blockIdx.x; c2 < 2048; c2 += gridDim.x) gdn_prep(p, lds, c2);
    grid.sync();
#pragma unroll 1
    for (int rep = 0; rep < REP_P3; ++rep) {
        if (blockIdx.x < 64) gdn_scan(p, lds, blockIdx.x);
        phase_attn(p, lds, rep);
#if REP_P3 > 1
        grid.sync();
#endif
    }
    grid.sync();
#pragma unroll 1
    for (int rep = 0; rep < REP_G2; ++rep)
    {
        pg8::Gemm g{(const bf16_t*)(p.ws + OFF_HB), (const bf16_t*)(p.ws + OFF_WOUTT), MTOK, DM, DM};
        pg8::StaticOrder S; S.init(g.M, g.N, (int)gridDim.x, (int)blockIdx.x);
        pg8::EpiOut E{p.x, p.out, (float*)(p.ws + OFF_ROWSQ)};
        pg8::gemm_phase<pg8::EpiOut, false>(lds, g, S, E);
    }
    grid.sync();
    phase_final(p);
}

extern "C" void kernel_launch(void* const* d_in, const int* in_sizes, int n_in, void* d_out, int out_size, void* d_ws, size_t ws_size, hipStream_t stream) {
    static int grid = 0;
    if (grid == 0) {
        if (ws_size < WS_END) { fprintf(stderr, "kernel_launch: workspace too small (%zu < %zu)\n", ws_size, (size_t)WS_END); grid = -1; return; }
        int dev = 0, cus = 0, per_cu = 0;
        hipGetDevice(&dev);
        hipDeviceGetAttribute(&cus, hipDeviceAttributeMultiprocessorCount, dev);
        if (hipFuncSetAttribute((const void*)mega, hipFuncAttributeMaxDynamicSharedMemorySize, LDS_BYTES) != hipSuccess) { fprintf(stderr, "kernel_launch: hipFuncSetAttribute failed\n"); grid = -1; return; }
        if (hipOccupancyMaxActiveBlocksPerMultiprocessor(&per_cu, (const void*)mega, 512, LDS_BYTES) != hipSuccess || per_cu < 1) per_cu = 1;
        (void)hipGetLastError();
        grid = cus * (per_cu > 1 ? 1 : per_cu);
    }
    if (grid < 0) return;
    Params p{};
    p.x = (const float*)d_in[0]; p.norm_w = (const float*)d_in[1]; p.w_in = (const float*)d_in[2]; p.conv_w = (const float*)d_in[3];
    p.a_log = (const float*)d_in[4]; p.dt_bias = (const float*)d_in[5]; p.gdn_norm_w = (const float*)d_in[6];
    p.lq1 = (const float*)d_in[7]; p.lk1 = (const float*)d_in[8]; p.lq2 = (const float*)d_in[9]; p.lk2 = (const float*)d_in[10];
    p.diff_norm_w = (const float*)d_in[11]; p.w_out = (const float*)d_in[12]; p.final_norm_w = (const float*)d_in[13];
    p.out = (float*)d_out; p.ws = (unsigned char*)d_ws;
    void* args[] = {&p};
    hipError_t e = hipLaunchCooperativeKernel((const void*)mega, dim3(grid), dim3(512), args, LDS_BYTES, stream);
    if (e != hipSuccess) fprintf(stderr, "cooperative launch failed: %s (grid %d)\n", hipGetErrorString(e), grid);
}
```

```cpp
#include <hip/hip_runtime.h>
#include <hip/hip_cooperative_groups.h>
#include <cstdio>
namespace cg = cooperative_groups;

#ifndef ENABLE_ATTN
#define ENABLE_ATTN 1
#endif
#ifndef ENABLE_GDN
#define ENABLE_GDN 1
#endif
#ifndef REP_PREP
#define REP_PREP 1
#endif
#ifndef REP_G1
#define REP_G1 1
#endif
#ifndef REP_GP
#define REP_GP 1
#endif
#ifndef REP_P3
#define REP_P3 1
#endif
#ifndef REP_G2
#define REP_G2 1
#endif
#ifndef REP_SCAN
#define REP_SCAN 1
#endif
#ifndef SCAN_SYNC
#define SCAN_SYNC 0
#endif
#ifndef REP_ATTN
#define REP_ATTN 1
#endif

#define LAS __attribute__((address_space(3)))
#define DI __device__ __forceinline__
typedef unsigned short bf16_t;
typedef short bf16x8 __attribute__((ext_vector_type(8)));
typedef short s16x4 __attribute__((ext_vector_type(4)));
typedef float f32x2 __attribute__((ext_vector_type(2)));
typedef float f32x4 __attribute__((ext_vector_type(4)));
typedef float f32x16 __attribute__((ext_vector_type(16)));
typedef unsigned u32x2 __attribute__((ext_vector_type(2)));
typedef unsigned u32x4 __attribute__((ext_vector_type(4)));
typedef __bf16 bf16x2_t __attribute__((ext_vector_type(2)));

#define MFMA32(a, b, c) __builtin_amdgcn_mfma_f32_32x32x16_bf16((a), (b), (c), 0, 0, 0)

constexpr int NB = 16, SEQ = 2048, DM = 1024, MTOK = NB * SEQ, NP1 = 3072, NG1 = 3584;
constexpr int C_GQ = 0, C_GK = 512, C_GV = 1024, C_GZ = 1536, C_DQ = 2048, C_DZ = 2560;
constexpr float EPS = 1e-6f;
constexpr float LOG2E = 1.4426950408889634f;

constexpr size_t OFF_HB = 0;
constexpr size_t OFF_WINT = OFF_HB + (size_t)MTOK * DM * 2;
constexpr size_t OFF_WOUTT = OFF_WINT + (size_t)4096 * 1024 * 2;
constexpr size_t OFF_GBGA = OFF_WOUTT + (size_t)1024 * 1024 * 2;
constexpr size_t OFF_P1 = OFF_GBGA + (size_t)MTOK * 8 * 4;
constexpr size_t OFF_KX = OFF_P1 + (size_t)MTOK * NP1 * 2;
constexpr size_t OFF_VT = OFF_KX + (size_t)64 * 2 * 2048 * 64 * 2;
constexpr size_t OFF_WN = OFF_VT + (size_t)64 * 128 * 2048 * 2;
constexpr size_t OFF_QD = OFF_WN + (size_t)2048 * 64 * 128 * 2;
constexpr size_t OFF_KD = OFF_QD + (size_t)2048 * 64 * 128 * 2;
constexpr size_t OFF_AQK = OFF_KD + (size_t)2048 * 64 * 128 * 2;
constexpr size_t OFF_U = OFF_AQK + (size_t)2048 * 64 * 64 * 2;
constexpr size_t OFF_GL = OFF_U + (size_t)2048 * 64 * 128 * 4;
constexpr size_t OFF_ROWSQ = OFF_GL + 8192;
constexpr size_t OFF_MISC = OFF_ROWSQ + (size_t)MTOK * 16 * 4;
constexpr size_t WS_END = OFF_MISC + 256;

constexpr int LDS_BYTES = 156 * 1024;

struct Params {
    const float *x, *norm_w, *w_in, *conv_w, *a_log, *dt_bias, *gdn_norm_w, *lq1, *lk1, *lq2, *lk2, *diff_norm_w, *w_out, *final_norm_w;
    float* out; unsigned char* ws;
};

DI unsigned pk_bf16(float a, float b) { f32x2 v = {a, b}; bf16x2_t r = __builtin_convertvector(v, bf16x2_t); return __builtin_bit_cast(unsigned, r); }
DI float bf_lo(unsigned u) { return __uint_as_float(u << 16); }
DI float bf_hi(unsigned u) { return __uint_as_float(u & 0xffff0000u); }
DI float wave_sum(float v) {
#pragma unroll
    for (int o = 32; o; o >>= 1) v += __shfl_xor(v, o);
    return v;
}
DI float silu_f(float z) { return z * __builtin_amdgcn_rcpf(1.0f + __builtin_amdgcn_exp2f(-LOG2E * z)); }
DI int perm23(int t) { return (t & ~12) | ((t & 4) << 1) | ((t & 8) >> 1); }
DI int crow(int i, int h2) { return (i & 3) + 8 * (i >> 2) + 4 * h2; }
DI bf16x8 pack8(const f32x16& x, int s) {
    u32x4 w; w.x = pk_bf16(x[8 * s + 0], x[8 * s + 1]); w.y = pk_bf16(x[8 * s + 2], x[8 * s + 3]); w.z = pk_bf16(x[8 * s + 4], x[8 * s + 5]); w.w = pk_bf16(x[8 * s + 6], x[8 * s + 7]);
    return __builtin_bit_cast(bf16x8, w);
}

namespace pg8 {
constexpr int BM = 256, BK = 64, HALF = 128, HTB = HALF * BK * 2, STAGE_BYTES = 8 * HTB, NXCD = 8, WGM = 8;
DI int lds_byte(int r, int c) { const int st = (r >> 4) * 2 + (c >> 5), rr = r & 15, cc = c & 31, ob = rr * 64 + cc * 2; return st * 1024 + (ob ^ (((ob >> 9) & 1) << 5)); }
DI void stage_rc(int b, int& R, int& C) { const int st = b / 1024, sb = b % 1024, swz = sb ^ (((sb >> 9) & 1) << 5); R = (st >> 1) * 16 + swz / 64; C = (st & 1) * 32 + (swz % 64) / 2; }
DI int perm32(int rho) { const int n = rho >> 4, i = rho & 15; return 8 * (i >> 2) + 4 * n + (i & 3); }
struct Unit { int pm, pn; };
struct Gemm { const bf16_t* A; const bf16_t* Bt; int M, N, K; };
struct StaticOrder {
    int nM, nN, nwg, G, c;
    DI void init(int M, int N, int G_, int c_) { nM = M / BM; nN = N / BM; nwg = nM * nN; G = G_; c = c_; }
    DI bool next(int i, Unit& u) const {
        const long L = (long)i * G + c; if (L >= nwg) return false;
        int wgid = (int)L; { const int q = nwg / NXCD, r = nwg % NXCD, xcd = wgid % NXCD, off = wgid / NXCD; wgid = (xcd < r ? xcd * (q + 1) : r * (q + 1) + (xcd - r) * q) + off; }
        const int nig = WGM * nN, gid = wgid / nig, fm = gid * WGM, gsz = (nM - fm) < WGM ? (nM - fm) : WGM;
        u.pm = fm + ((wgid % nig) % gsz); u.pn = (wgid % nig) / gsz; return true;
    }
    DI void a_ready(const Unit&) const {}
    DI void done(const Unit&) const {}
};

struct EpiP1 {
    static constexpr bool PERM = true;
    bf16_t* O; int ldc; bf16_t* KX;
    DI void operator()(const f32x4 (&acc)[2][2][4][2], const Unit& u, int wr, int wc, int fr, int fq) const {
        const int row0 = u.pm * BM + wr * 64 + fr, col0 = u.pn * BM + wc * 32 + 8 * fq;
        if (u.pn >= 12) {
#pragma unroll
            for (int ai = 0; ai < 2; ++ai)
#pragma unroll
                for (int m = 0; m < 4; ++m) { const int row = row0 + ai * HALF + m * 16, b = row >> 11, tok = row & 2047;
#pragma unroll
                    for (int bj = 0; bj < 2; ++bj) { const f32x4 v0 = acc[ai][bj][m][0], v1 = acc[ai][bj][m][1];
                        const int c = col0 - 12 * BM + bj * HALF, hm = c >> 6, d = c & 63;
                        u32x4 w; w.x = pk_bf16(v0[0], v0[1]); w.y = pk_bf16(v0[2], v0[3]); w.z = pk_bf16(v1[0], v1[1]); w.w = pk_bf16(v1[2], v1[3]);
                        *(u32x4*)(KX + ((size_t)(b * 8 + hm) * 2048 + tok) * 64 + d) = w; } }
            return;
        }
#pragma unroll
        for (int ai = 0; ai < 2; ++ai)
#pragma unroll
            for (int m = 0; m < 4; ++m) { bf16_t* rowp = O + (size_t)(row0 + ai * HALF + m * 16) * ldc + col0;
#pragma unroll
                for (int bj = 0; bj < 2; ++bj) { const f32x4 v0 = acc[ai][bj][m][0], v1 = acc[ai][bj][m][1];
                    u32x4 w; w.x = pk_bf16(v0[0], v0[1]); w.y = pk_bf16(v0[2], v0[3]); w.z = pk_bf16(v1[0], v1[1]); w.w = pk_bf16(v1[2], v1[3]);
                    *(u32x4*)(rowp + bj * HALF) = w; } }
    }
};
struct EpiVT {
    static constexpr bool PERM = false;
    bf16_t* VT;
    DI void operator()(const f32x4 (&acc)[2][2][4][2], const Unit& u, int wr, int wc, int fr, int fq) const {
#pragma unroll
        for (int ai = 0; ai < 2; ++ai)
#pragma unroll
            for (int m = 0; m < 4; ++m) {
                const int t = u.pm * BM + ai * HALF + wr * 64 + m * 16 + 4 * fq, b = t >> 11, tok = t & 2047, pos = perm23(tok);
#pragma unroll
                for (int bj = 0; bj < 2; ++bj)
#pragma unroll
                    for (int n = 0; n < 2; ++n) {
                        const int c = u.pn * BM + bj * HALF + wc * 32 + n * 16 + fr, hh = c >> 7, dv = c & 127;
                        const f32x4 v = acc[ai][bj][m][n];
                        u32x2 w; w.x = pk_bf16(v[0], v[1]); w.y = pk_bf16(v[2], v[3]);
                        *(u32x2*)(VT + (((size_t)((b * 4 + hh) * 32 + (pos >> 6)) * 128 + dv)) * 64 + (pos & 63)) = w;
                    }
            }
    }
};
struct EpiOut {
    static constexpr bool PERM = false;
    const float* X; float* Y; float* rowsq;
    DI void operator()(const f32x4 (&acc)[2][2][4][2], const Unit& u, int wr, int wc, int fr, int fq) const {
        const int row0 = u.pm * BM + wr * 64 + fr, col0 = u.pn * BM + wc * 32 + 4 * fq;
#pragma unroll
        for (int ai = 0; ai < 2; ++ai)
#pragma unroll
            for (int m = 0; m < 4; ++m) {
                const int row = row0 + ai * HALF + m * 16; float ss = 0.f;
#pragma unroll
                for (int bj = 0; bj < 2; ++bj)
#pragma unroll
                    for (int n = 0; n < 2; ++n) {
                        const size_t o = (size_t)row * DM + col0 + bj * HALF + n * 16;
                        const f32x4 xv = *(const f32x4*)(X + o); const f32x4 y = acc[ai][bj][m][n] + xv;
                        *(f32x4*)(Y + o) = y; ss += y[0] * y[0] + y[1] * y[1] + y[2] * y[2] + y[3] * y[3];
                    }
                ss += __shfl_xor(ss, 16); ss += __shfl_xor(ss, 32);
                if (fq == 0) rowsq[(size_t)row * 16 + u.pn * 4 + wc] = ss;
            }
    }
};

template <class Epi, bool SWAP>
DI void gemm_phase(LAS unsigned char* lds, const Gemm g, const StaticOrder& S, const Epi& E) {
    int tid = threadIdx.x; asm volatile("" : "+v"(tid));
    const int wid = __builtin_amdgcn_readfirstlane(tid >> 6), lane = tid & 63, wr = wid >> 2, wc = wid & 3, fr = lane & 15, fq = lane >> 4;
    const int K = g.K, nt = K / BK;
    unsigned voffA[2], voffB[2];
#pragma unroll
    for (int i = 0; i < 2; ++i) { int R, C; stage_rc(tid * 16 + i * 8192, R, C); const int Rb = Epi::PERM ? ((R & ~31) + perm32(R & 31)) : R;
        voffA[i] = (unsigned)(R * K + C) * 2u; voffB[i] = (unsigned)(Rb * K + C) * 2u; }
    const size_t kstep = (size_t)(BK * 2);
    const size_t hstep = (size_t)HALF * K * 2;
    const size_t tstep = 2 * hstep;
    const unsigned ldsw = (unsigned)wid * 1024u;
    const int aoff = lds_byte(wr * 64 + fr, fq * 8), boff = lds_byte(wc * 32 + fr, fq * 8);
#define PG8_SA(b, h) (((b) * 2 + (h)) * HTB)
#define PG8_SB(b, h) ((4 + (b) * 2 + (h)) * HTB)
#define PG8_STAGE(bufoff, gbase, voff) do { _Pragma("unroll") for (int _i = 0; _i < 2; ++_i) \
        __builtin_amdgcn_global_load_lds((const unsigned*)((const char*)(gbase) + (voff)[_i]), (LAS unsigned*)(lds + (bufoff) + ldsw + _i * 8192), 16, 0, 0); } while (0)
#define PG8_LDA(dst, b, h) do { _Pragma("unroll") for (int m = 0; m < 4; ++m) _Pragma("unroll") for (int k = 0; k < 2; ++k) dst[m][k] = *(const LAS bf16x8*)(lds + PG8_SA(b, h) + aoff + m * 2048 + k * 1024); } while (0)
#define PG8_LDB(dst, b, h) do { _Pragma("unroll") for (int n = 0; n < 2; ++n) _Pragma("unroll") for (int k = 0; k < 2; ++k) dst[n][k] = *(const LAS bf16x8*)(lds + PG8_SB(b, h) + boff + n * 2048 + k * 1024); } while (0)
#define PG8_MMA(ai, bj, At, Bt) do { __builtin_amdgcn_s_setprio(1); _Pragma("unroll") for (int m = 0; m < 4; ++m) _Pragma("unroll") for (int n = 0; n < 2; ++n) _Pragma("unroll") for (int k = 0; k < 2; ++k) \
        acc[ai][bj][m][n] = SWAP ? __builtin_amdgcn_mfma_f32_16x16x32_bf16(At[m][k], Bt[n][k], acc[ai][bj][m][n], 0, 0, 0) \
                                 : __builtin_amdgcn_mfma_f32_16x16x32_bf16(Bt[n][k], At[m][k], acc[ai][bj][m][n], 0, 0, 0); __builtin_amdgcn_s_setprio(0); } while (0)
#define PG8_WAIT_V(n) asm volatile("s_waitcnt vmcnt(" #n ")" ::: "memory")
#define PG8_WAIT_L(n) asm volatile("s_waitcnt lgkmcnt(" #n ")" ::: "memory")
#define PG8_BAR __builtin_amdgcn_s_barrier()
#define PG8_SCHED __builtin_amdgcn_sched_barrier(0)
    Unit cur, nxt; int ui = 0;
    if (!S.next(0, cur)) return;
    f32x4 acc[2][2][4][2];
#pragma unroll
    for (int a = 0; a < 2; ++a)
#pragma unroll
        for (int b = 0; b < 2; ++b)
#pragma unroll
            for (int m = 0; m < 4; ++m)
#pragma unroll
                for (int n = 0; n < 2; ++n) acc[a][b][m][n] = (f32x4){0.f, 0.f, 0.f, 0.f};
    bf16x8 At[4][2], B0[2][2], B1[2][2];
    const char* cA = (const char*)g.A + (size_t)cur.pm * tstep; const char* cB = (const char*)g.Bt + (size_t)cur.pn * tstep;
    PG8_STAGE(PG8_SB(0, 0), cB, voffB); PG8_STAGE(PG8_SA(0, 0), cA, voffA); PG8_STAGE(PG8_SB(0, 1), cB + hstep, voffB); PG8_STAGE(PG8_SA(0, 1), cA + hstep, voffA);
    if (wr == 1) PG8_BAR;
    PG8_WAIT_V(4); PG8_BAR;
    PG8_STAGE(PG8_SB(1, 0), cB + kstep, voffB); PG8_STAGE(PG8_SA(1, 0), cA + kstep, voffA); PG8_STAGE(PG8_SB(1, 1), cB + hstep + kstep, voffB);
    PG8_WAIT_V(6); PG8_BAR;
    for (;;) {
        const bool has_next = S.next(ui + 1, nxt);
        const char* nA = has_next ? (const char*)g.A + (size_t)nxt.pm * tstep : cA; const char* nB = has_next ? (const char*)g.Bt + (size_t)nxt.pn * tstep : cB;
        for (int t = 0; t < nt; t += 2) {
            const bool last = (t == nt - 2);
            const char* a1 = cA + (size_t)(t + 1) * kstep;
            const char* a2 = last ? nA : cA + (size_t)(t + 2) * kstep; const char* b2 = last ? nB : cB + (size_t)(t + 2) * kstep;
            const char* a3 = a2 + kstep; const char* b3 = b2 + kstep;
            PG8_LDB(B0, 0, 0); PG8_SCHED; PG8_LDA(At, 0, 0); PG8_STAGE(PG8_SA(1, 1), a1 + hstep, voffA);
            PG8_WAIT_L(8); PG8_BAR; PG8_WAIT_L(0); PG8_MMA(0, 0, At, B0); PG8_BAR; PG8_SCHED;
            PG8_LDB(B1, 0, 1); PG8_STAGE(PG8_SB(0, 0), b2, voffB);
            PG8_BAR; PG8_WAIT_L(0); PG8_MMA(0, 1, At, B1); PG8_BAR;
            PG8_LDA(At, 0, 1); PG8_STAGE(PG8_SA(0, 0), a2, voffA);
            PG8_BAR; PG8_WAIT_L(0); PG8_MMA(1, 0, At, B0); PG8_BAR; PG8_SCHED;
            PG8_STAGE(PG8_SB(0, 1), b2 + hstep, voffB);
            PG8_WAIT_V(6); PG8_BAR; PG8_MMA(1, 1, At, B1); PG8_BAR;
            PG8_LDB(B0, 1, 0); PG8_SCHED; PG8_LDA(At, 1, 0); PG8_STAGE(PG8_SA(0, 1), a2 + hstep, voffA);
            PG8_WAIT_L(8); PG8_BAR; PG8_WAIT_L(0); PG8_MMA(0, 0, At, B0); PG8_BAR; PG8_SCHED;
            PG8_LDB(B1, 1, 1); PG8_STAGE(PG8_SB(1, 0), b3, voffB);
            PG8_BAR; PG8_WAIT_L(0); PG8_MMA(0, 1, At, B1); PG8_BAR;
            PG8_LDA(At, 1, 1); PG8_STAGE(PG8_SA(1, 0), a3, voffA);
            PG8_BAR; PG8_WAIT_L(0); PG8_MMA(1, 0, At, B0); PG8_BAR; PG8_SCHED;
            PG8_STAGE(PG8_SB(1, 1), b3 + hstep, voffB);
            PG8_WAIT_V(6); PG8_BAR; PG8_MMA(1, 1, At, B1); PG8_BAR;
        }
        E(acc, cur, wr, wc, fr, fq);
        if (!has_next) break;
#pragma unroll
        for (int a = 0; a < 2; ++a)
#pragma unroll
            for (int b = 0; b < 2; ++b)
#pragma unroll
                for (int m = 0; m < 4; ++m)
#pragma unroll
                    for (int n = 0; n < 2; ++n) acc[a][b][m][n] = (f32x4){0.f, 0.f, 0.f, 0.f};
        cur = nxt; cA = nA; cB = nB; ++ui;
    }
    PG8_WAIT_V(0);
    if (wr == 0) PG8_BAR;
    PG8_BAR;
#undef PG8_SA
#undef PG8_SB
#undef PG8_STAGE
#undef PG8_LDA
#undef PG8_LDB
#undef PG8_MMA
#undef PG8_WAIT_V
#undef PG8_WAIT_L
#undef PG8_BAR
#undef PG8_SCHED
}
}

DI int win_src_col(int n0) {
    if (n0 < 2048) return n0;
    if (n0 < 2560) return 2056 + (n0 - 2048);
    if (n0 < 3072) return 3592 + (n0 - 2560);
    if (n0 < 3584) return 2568 + (n0 - 3072);
    return 3080 + (n0 - 3584);
}
DI void phase_prep(const Params& p, LAS unsigned char* lds) {
    int tid = threadIdx.x; asm volatile("" : "+v"(tid));
    const int lane = tid & 63, wid = tid >> 6;
    if (blockIdx.x == 0 && wid == 0) {
        float a = p.lq1[lane] * p.lk1[lane], b = p.lq2[lane] * p.lk2[lane];
        a = wave_sum(a); b = wave_sum(b);
        if (lane == 0) { *(float*)(p.ws + OFF_MISC) = expf(a) - expf(b) + 0.2f; *(unsigned*)(p.ws + OFF_MISC + 4) = 0u; *(unsigned*)(p.ws + OFF_MISC + 8) = 0u; *(unsigned*)(p.ws + OFF_MISC + 12) = 0u; }
    }
    bf16_t* hb = (bf16_t*)(p.ws + OFF_HB);
    float* gbga = (float*)(p.ws + OFF_GBGA);
    const int gw = blockIdx.x * 8 + wid, nw = gridDim.x * 8;
    {
        f32x4 nwv[4]; float wq[16][8];
#pragma unroll
        for (int i = 0; i < 4; ++i) {
            nwv[i] = ((const f32x4*)p.norm_w)[lane + 64 * i];
#pragma unroll
            for (int e = 0; e < 4; ++e) {
                const int k = 4 * (lane + 64 * i) + e;
                const f32x4* wp = (const f32x4*)(p.w_in + (size_t)k * 4104 + 2048);
                const f32x4 w0 = wp[0], w1 = wp[1];
#pragma unroll
                for (int j = 0; j < 4; ++j) { wq[4 * i + e][j] = nwv[i][e] * w0[j]; wq[4 * i + e][4 + j] = nwv[i][e] * w1[j]; }
            }
        }
        const bool b5 = (lane & 32) != 0, b4 = (lane & 16) != 0, b3 = (lane & 8) != 0;
        const int col = (b5 ? 4 : 0) + (b4 ? 2 : 0) + (b3 ? 1 : 0);
        int row = gw;
        f32x4 v[4];
        if (row < MTOK) {
#pragma unroll
            for (int i = 0; i < 4; ++i) v[i] = ((const f32x4*)(p.x + (size_t)row * DM))[lane + 64 * i];
        }
#pragma unroll 1
        for (; row < MTOK; row += nw) {
            f32x4 vnx[4];
            const int rnx = (row + nw < MTOK) ? row + nw : row;
#pragma unroll
            for (int i = 0; i < 4; ++i) vnx[i] = ((const f32x4*)(p.x + (size_t)rnx * DM))[lane + 64 * i];
            float ss = 0.f, a8[8];
#pragma unroll
            for (int j = 0; j < 8; ++j) a8[j] = 0.f;
#pragma unroll
            for (int i = 0; i < 4; ++i)
#pragma unroll
                for (int e = 0; e < 4; ++e) {
                    ss += v[i][e] * v[i][e];
#pragma unroll
                    for (int j = 0; j < 8; ++j) a8[j] += v[i][e] * wq[4 * i + e][j];
                }
            ss = wave_sum(ss);
            const float rstd = rsqrtf(ss * (1.0f / DM) + EPS);
#pragma unroll
            for (int i = 0; i < 4; ++i) {
                const f32x4 h = v[i] * rstd * nwv[i];
                u32x2 w; w.x = pk_bf16(h[0], h[1]); w.y = pk_bf16(h[2], h[3]);
                *(u32x2*)(hb + (size_t)row * DM + 4 * (lane + 64 * i)) = w;
            }
            float c4[4], c2[2], c1;
#pragma unroll
            for (int j = 0; j < 4; ++j) { const float send = b5 ? a8[j] : a8[4 + j], keep = b5 ? a8[4 + j] : a8[j]; c4[j] = keep + __shfl_xor(send, 32); }
#pragma unroll
            for (int j = 0; j < 2; ++j) { const float send = b4 ? c4[j] : c4[2 + j], keep = b4 ? c4[2 + j] : c4[j]; c2[j] = keep + __shfl_xor(send, 16); }
            { const float send = b3 ? c2[0] : c2[1], keep = b3 ? c2[1] : c2[0]; c1 = keep + __shfl_xor(send, 8); }
            c1 += __shfl_xor(c1, 4); c1 += __shfl_xor(c1, 2); c1 += __shfl_xor(c1, 1);
            if ((lane & 7) == 0) gbga[(size_t)row * 8 + col] = c1 * rstd;
#pragma unroll
            for (int i = 0; i < 4; ++i) v[i] = vnx[i];
        }
    }
    LAS float* tl = (LAS float*)lds;
    for (int tile = blockIdx.x; tile < 1024 + 256; tile += gridDim.x) {
        const float* src; int ld, n0, k0, srcn0; bf16_t* dst;
        if (tile < 1024) { n0 = (tile >> 4) * 64; k0 = (tile & 15) * 64; srcn0 = win_src_col(n0); src = p.w_in; ld = 4104; dst = (bf16_t*)(p.ws + OFF_WINT); }
        else { const int t2 = tile - 1024; n0 = (t2 >> 4) * 64; k0 = (t2 & 15) * 64; srcn0 = n0; src = p.w_out; ld = 1024; dst = (bf16_t*)(p.ws + OFF_WOUTT); }
        const int kk = tid >> 4, n4 = tid & 15;
#pragma unroll
        for (int ps = 0; ps < 2; ++ps) { const int k = kk + 32 * ps;
            const f32x4 v = *(const f32x4*)(src + (size_t)(k0 + k) * ld + srcn0 + 4 * n4);
#pragma unroll
            for (int e = 0; e < 4; ++e) tl[k * 65 + 4 * n4 + e] = v[e]; }
        __syncthreads();
        { const int n = tid >> 3, k8 = tid & 7; float f[8];
#pragma unroll
            for (int e = 0; e < 8; ++e) f[e] = tl[(8 * k8 + e) * 65 + n];
            u32x4 w; w.x = pk_bf16(f[0], f[1]); w.y = pk_bf16(f[2], f[3]); w.z = pk_bf16(f[4], f[5]); w.w = pk_bf16(f[6], f[7]);
            *(u32x4*)(dst + (size_t)(n0 + n) * 1024 + k0 + 8 * k8) = w; }
        __syncthreads();
    }
}

constexpr int AT_KB = 8192, AT_VB = 16384, AT_BUF = AT_KB + AT_VB, AT_NBUF = 3, AT_TASK = AT_NBUF * AT_BUF, AT_O1 = AT_TASK + 256;

DI void attn_qblock(const Params& p, LAS unsigned char* lds, int b, int hh, int qb, float lam) {
    int tid = threadIdx.x; asm volatile("" : "+v"(tid));
    const int lane = tid & 63, wid = __builtin_amdgcn_readfirstlane(tid >> 6);
    const bf16_t* P1 = (const bf16_t*)(p.ws + OFF_P1);
    const bf16_t* VT = (const bf16_t*)(p.ws + OFF_VT) + (size_t)(b * 4 + hh) * 32 * 128 * 64;
    const bf16_t* KX = (const bf16_t*)(p.ws + OFF_KX) + (size_t)(b * 4 + hh) * 2 * 2048 * 64;
    bf16_t* mix = (bf16_t*)(p.ws + OFF_HB);
    const int q0 = qb * 256 + wid * 32;
    const size_t tokbase = (size_t)b * SEQ;
    const int nkt = (qb + 1) * 4;
    const float sl2 = exp2f(-2.0f * (float)(hh + 1)) * LOG2E;
    const float c1 = 0.125f * LOG2E;
#pragma unroll 1
    for (int map = 0; map < 2; ++map) {
        f32x16 O[4];
#pragma unroll
        for (int mt = 0; mt < 4; ++mt)
#pragma unroll
            for (int i = 0; i < 16; ++i) O[mt][i] = 0.f;
        float m = -INFINITY, l = 0.f;
        int lane_m = lane; asm volatile("" : "+v"(lane_m));
        const int r = lane_m & 31, h2 = lane_m >> 5;
        int foff[4];
#pragma unroll
        for (int k = 0; k < 4; ++k) foff[k] = r * 128 + (((2 * k + h2) ^ ((r >> 1) & 7)) << 4);
        float kb[16];
#pragma unroll
        for (int i = 0; i < 16; ++i) kb[i] = sl2 * (float)crow(i, h2);
        const int krow_ = 8 * wid + (lane_m >> 3), vrow0 = 16 * wid + (lane_m >> 3), vrow1 = vrow0 + 8;
        const bf16_t* kgp = KX + ((size_t)map * 2048 + krow_) * 64 + (((lane_m & 7) ^ ((krow_ >> 1) & 7)) * 8);
        const bf16_t* vgp0 = VT + (size_t)vrow0 * 64 + (((lane_m & 7) ^ ((vrow0 >> 1) & 7)) * 8);
        const bf16_t* vgp1 = VT + (size_t)vrow1 * 64 + (((lane_m & 7) ^ ((vrow1 >> 1) & 7)) * 8);
#define AT_STAGE(bufi, tile) do { LAS unsigned char* _b = lds + (bufi) * AT_BUF; \
            __builtin_amdgcn_global_load_lds((const unsigned*)(kgp + (size_t)(tile) * 64 * 64), (LAS unsigned*)(_b + wid * 1024), 16, 0, 0); \
            __builtin_amdgcn_global_load_lds((const unsigned*)(vgp0 + (size_t)(tile) * 128 * 64), (LAS unsigned*)(_b + AT_KB + wid * 2048), 16, 0, 0); \
            __builtin_amdgcn_global_load_lds((const unsigned*)(vgp1 + (size_t)(tile) * 128 * 64), (LAS unsigned*)(_b + AT_KB + wid * 2048 + 1024), 16, 0, 0); } while (0)
        bf16x8 qf[4];
        { const bf16_t* qp = P1 + (tokbase + q0 + (lane_m & 31)) * NP1 + C_DQ + hh * 128 + map * 64 + 8 * (lane_m >> 5);
#pragma unroll
            for (int ks = 0; ks < 4; ++ks) qf[ks] = *(const bf16x8*)(qp + 16 * ks); }
        AT_STAGE(0, 0);
        AT_STAGE(1, 1);
        asm volatile("" : "+v"(qf[0]), "+v"(qf[1]), "+v"(qf[2]), "+v"(qf[3]));
        int cb = 0;
#pragma unroll 1
        for (int kt = 0; kt < nkt; ++kt) {
            if (kt + 1 < nkt) asm volatile("s_waitcnt vmcnt(3)" ::: "memory"); else asm volatile("s_waitcnt vmcnt(0)" ::: "memory");
            __builtin_amdgcn_s_barrier();
            asm volatile("" ::: "memory");
            if (kt + 2 < nkt) { const int nb = cb == 0 ? 2 : cb - 1; AT_STAGE(nb, kt + 2); }
            const LAS unsigned char* cur = lds + cb * AT_BUF;
            cb = cb == 2 ? 0 : cb + 1;
            const int k0 = kt * 64;
            if (k0 <= q0) {
                const bool sub1 = (k0 + 32 <= q0);
                const LAS unsigned char* vb = cur + AT_KB;
                bf16x8 kf[8];
#pragma unroll
                for (int ks = 0; ks < 4; ++ks) kf[ks] = *(const LAS bf16x8*)(cur + foff[ks]);
                if (sub1) {
#pragma unroll
                    for (int ks = 0; ks < 4; ++ks) kf[4 + ks] = *(const LAS bf16x8*)(cur + 4096 + foff[ks]);
                }
                f32x16 s0, s1;
#pragma unroll
                for (int i = 0; i < 16; ++i) { s0[i] = 0.f; s1[i] = 0.f; }
#pragma unroll
                for (int ks = 0; ks < 4; ++ks) s0 = MFMA32(kf[ks], qf[ks], s0);
                if (sub1) {
#pragma unroll
                    for (int ks = 0; ks < 4; ++ks) s1 = MFMA32(kf[4 + ks], qf[ks], s1);
                }
                __builtin_amdgcn_sched_barrier(0);
                bf16x8 va[8];
#pragma unroll
                for (int s2 = 0; s2 < 2; ++s2)
#pragma unroll
                    for (int mt = 0; mt < 4; ++mt) va[s2 * 4 + mt] = *(const LAS bf16x8*)(vb + mt * 4096 + foff[s2]);
                __builtin_amdgcn_sched_barrier(0);
                const float off0 = sl2 * (float)(k0 - q0), off1 = off0 + 32.0f * sl2;
                const f32x2 c1v = {c1, c1};
#pragma unroll
                for (int j = 0; j < 8; ++j) {
                    const f32x2 kv = {kb[2 * j], kb[2 * j + 1]};
                    f32x2 a = {s0[2 * j], s0[2 * j + 1]}, c = {s1[2 * j], s1[2 * j + 1]};
                    a = __builtin_elementwise_fma(a, c1v, kv); c = __builtin_elementwise_fma(c, c1v, kv);
                    s0[2 * j] = a.x; s0[2 * j + 1] = a.y; s1[2 * j] = c.x; s1[2 * j + 1] = c.y;
                }
                if (k0 == q0) {
#pragma unroll
                    for (int i = 0; i < 16; ++i) if (crow(i, h2) > r) s0[i] = -INFINITY;
                }
                if (k0 + 32 == q0) {
#pragma unroll
                    for (int i = 0; i < 16; ++i) if (crow(i, h2) > r) s1[i] = -INFINITY;
                }
                float mx0 = fmaxf(s0[0], s0[1]), mx1 = fmaxf(s1[0], s1[1]);
#pragma unroll
                for (int j = 1; j < 8; ++j) { mx0 = fmaxf(fmaxf(s0[2 * j], s0[2 * j + 1]), mx0); mx1 = fmaxf(fmaxf(s1[2 * j], s1[2 * j + 1]), mx1); }
                float mx = sub1 ? fmaxf(mx0 + off0, mx1 + off1) : mx0 + off0;
                mx = fmaxf(mx, __shfl_xor(mx, 32));
                if (__builtin_amdgcn_ballot_w64(mx > m + 8.0f) != 0ull) {
                    const float mn = fmaxf(m, mx);
                    const float alpha = __builtin_amdgcn_exp2f(m - mn);
                    m = mn; l *= alpha;
#pragma unroll
                    for (int mt = 0; mt < 4; ++mt)
#pragma unroll
                        for (int i = 0; i < 16; ++i) O[mt][i] *= alpha;
                }
                const float r0 = m - off0, r1 = sub1 ? m - off1 : INFINITY;
                const f32x2 r0v = {r0, r0}, r1v = {r1, r1};
                f32x2 lsv = {0.f, 0.f};
#pragma unroll
                for (int j = 0; j < 8; ++j) {
                    f32x2 a = {s0[2 * j], s0[2 * j + 1]}, c = {s1[2 * j], s1[2 * j + 1]};
                    a = a - r0v; c = c - r1v;
                    a.x = __builtin_amdgcn_exp2f(a.x); a.y = __builtin_amdgcn_exp2f(a.y); c.x = __builtin_amdgcn_exp2f(c.x); c.y = __builtin_amdgcn_exp2f(c.y);
                    lsv = lsv + a; lsv = lsv + c;
                    s0[2 * j] = a.x; s0[2 * j + 1] = a.y; s1[2 * j] = c.x; s1[2 * j + 1] = c.y;
                }
                l += lsv.x + lsv.y;
                bf16x8 pf[4];
#pragma unroll
                for (int s = 0; s < 2; ++s) { pf[s] = pack8(s0, s); pf[2 + s] = pack8(s1, s); }
                __builtin_amdgcn_sched_barrier(0);
                bf16x8 vc[4], vd[4];
                if (sub1) {
#pragma unroll
                    for (int mt = 0; mt < 4; ++mt) vc[mt] = *(const LAS bf16x8*)(vb + mt * 4096 + foff[2]);
                }
#pragma unroll
                for (int mt = 0; mt < 4; ++mt) O[mt] = MFMA32(va[mt], pf[0], O[mt]);
                if (sub1) {
#pragma unroll
                    for (int mt = 0; mt < 4; ++mt) vd[mt] = *(const LAS bf16x8*)(vb + mt * 4096 + foff[3]);
                }
#pragma unroll
                for (int mt = 0; mt < 4; ++mt) O[mt] = MFMA32(va[4 + mt], pf[1], O[mt]);
                if (sub1) {
#pragma unroll
                    for (int mt = 0; mt < 4; ++mt) O[mt] = MFMA32(vc[mt], pf[2], O[mt]);
#pragma unroll
                    for (int mt = 0; mt < 4; ++mt) O[mt] = MFMA32(vd[mt], pf[3], O[mt]);
                }
            }
        }
        asm volatile("" ::: "memory");
        __builtin_amdgcn_s_barrier();
        asm volatile("" ::: "memory");
#undef AT_STAGE
        const float lt = l + __shfl_xor(l, 32);
        int lane_o = lane; asm volatile("" : "+v"(lane_o));
        LAS unsigned* o1l = (LAS unsigned*)(lds + AT_O1 + wid * 8192) + lane_o;
        if (map == 0) {
            const float inv1 = 1.0f / lt;
#pragma unroll
            for (int mt = 0; mt < 4; ++mt)
#pragma unroll
                for (int j = 0; j < 8; ++j) o1l[(mt * 8 + j) * 64] = pk_bf16(O[mt][2 * j] * inv1, O[mt][2 * j + 1] * inv1);
        } else {
            const float inv2 = lam / lt;
            float ss = 0.f;
#pragma unroll
            for (int mt = 0; mt < 4; ++mt)
#pragma unroll
                for (int j = 0; j < 8; ++j) {
                    const unsigned o1 = o1l[(mt * 8 + j) * 64];
                    const float a = bf_lo(o1) - O[mt][2 * j] * inv2, c = bf_hi(o1) - O[mt][2 * j + 1] * inv2;
                    O[mt][2 * j] = a; O[mt][2 * j + 1] = c; ss += a * a + c * c;
                }
            ss += __shfl_xor(ss, 32);
            const float rs = rsqrtf(ss * (1.0f / 128.0f) + EPS) * 0.8f;
#pragma unroll
            for (int mt = 0; mt < 4; ++mt)
#pragma unroll
                for (int j = 0; j < 8; ++j) o1l[(mt * 8 + j) * 64] = pk_bf16(O[mt][2 * j] * rs, O[mt][2 * j + 1] * rs);
            __builtin_amdgcn_wave_barrier();
            int lane_e = lane; asm volatile("" : "+v"(lane_e));
            const int dvg = lane_e & 15, qs = lane_e >> 4;
            const f32x4 nw0 = *(const f32x4*)(p.diff_norm_w + 8 * dvg), nw1 = *(const f32x4*)(p.diff_norm_w + 8 * dvg + 4);
            const LAS unsigned* ob = (const LAS unsigned*)(lds + AT_O1 + wid * 8192);
            const int slot = (dvg >> 2) * 8 + 2 * (dvg & 3);
            u32x4 dzv[8];
#pragma unroll
            for (int it = 0; it < 8; ++it) dzv[it] = *(const u32x4*)(P1 + (tokbase + q0 + it * 4 + qs) * NP1 + C_DZ + hh * 128 + 8 * dvg);
#pragma unroll
            for (int it = 0; it < 8; ++it) {
                const int q = it * 4 + qs; const size_t row = tokbase + q0 + q;
                const unsigned u0 = ob[slot * 64 + q], u1 = ob[(slot + 1) * 64 + q], u2 = ob[slot * 64 + q + 32], u3 = ob[(slot + 1) * 64 + q + 32];
                const u32x4 dz = dzv[it];
                u32x4 w;
                w.x = pk_bf16(bf_lo(u0) * nw0[0] * silu_f(bf_lo(dz.x)), bf_hi(u0) * nw0[1] * silu_f(bf_hi(dz.x)));
                w.y = pk_bf16(bf_lo(u1) * nw0[2] * silu_f(bf_lo(dz.y)), bf_hi(u1) * nw0[3] * silu_f(bf_hi(dz.y)));
                w.z = pk_bf16(bf_lo(u2) * nw1[0] * silu_f(bf_lo(dz.z)), bf_hi(u2) * nw1[1] * silu_f(bf_hi(dz.z)));
                w.w = pk_bf16(bf_lo(u3) * nw1[2] * silu_f(bf_lo(dz.w)), bf_hi(u3) * nw1[3] * silu_f(bf_hi(dz.w)));
                *(u32x4*)(mix + row * DM + 512 + hh * 128 + 8 * dvg) = w;
            }
            __builtin_amdgcn_wave_barrier();
        }
    }
}

DI void phase_attn(const Params& p, LAS unsigned char* lds, int rep) {
    const float lam = *(const float*)(p.ws + OFF_MISC);
    unsigned* counter = (unsigned*)(p.ws + OFF_MISC + 4 + 4 * rep);
    LAS int* tslot = (LAS int*)(lds + AT_TASK);
    for (;;) {
        if (threadIdx.x == 0) *tslot = (int)atomicAdd(counter, 1u);
        __syncthreads();
        const int t = *tslot;
        __syncthreads();
        if (t >= 512) break;
        const int qb = 7 - (t >> 6), bh = t & 63;
        attn_qblock(p, lds, bh >> 2, bh & 3, qb, lam);
    }
}


constexpr int G_QN = 0, G_KN = 17408, G_VB = 34816, G_KBG = 52224, G_M = 69632, G_T = 86016, G_SM = 95232;
DI bf16x8 tr_pair(const LAS unsigned char* lo_addr, int hi_off) {
    const s16x4 lo = __builtin_amdgcn_ds_read_tr16_b64_v4i16((LAS s16x4*)(lo_addr));
    const s16x4 hi = __builtin_amdgcn_ds_read_tr16_b64_v4i16((LAS s16x4*)(lo_addr + hi_off));
    return __builtin_shufflevector(lo, hi, 0, 1, 2, 3, 4, 5, 6, 7);
}
DI bf16_t bf16_1(float v) { return (bf16_t)(pk_bf16(v, 0.f) & 0xffffu); }

DI void gdn_prep(const Params& p, LAS unsigned char* lds, int c2) {
    int tid = threadIdx.x; asm volatile("" : "+v"(tid));
    const int lane = tid & 63, wid = __builtin_amdgcn_readfirstlane(tid >> 6), r = lane & 31, h2 = lane >> 5;
    const int b = c2 >> 7, hh = (c2 >> 5) & 3, n = c2 & 31;
    const size_t tok0 = (size_t)b * SEQ + (size_t)n * 64;
    const bf16_t* P1 = (const bf16_t*)(p.ws + OFF_P1);
    LAS float* sm = (LAS float*)(lds + G_SM);
    LAS float* Mf = (LAS float*)(lds + G_M);
    bf16_t* WN = (bf16_t*)(p.ws + OFF_WN) + (size_t)c2 * 8192;
    bf16_t* QD = (bf16_t*)(p.ws + OFF_QD) + (size_t)c2 * 8192;
    bf16_t* KD = (bf16_t*)(p.ws + OFF_KD) + (size_t)c2 * 8192;
    bf16_t* AQ = (bf16_t*)(p.ws + OFF_AQK) + (size_t)c2 * 4096;
    float* U = (float*)(p.ws + OFF_U) + (size_t)c2 * 8192;
    u32x4 raw[6][4];
#pragma unroll
    for (int i = 0; i < 6; ++i) {
        const int item = tid + 512 * i, g = item & 15, t = (item >> 4) & 63, part = i >> 1;
        const int ch = part * 512 + hh * 128 + g * 8;
#pragma unroll
        for (int j = 0; j < 4; ++j) {
            const int tt = n * 64 + t - 3 + j, ttc = tt < 0 ? 0 : tt;
            raw[i][j] = *(const u32x4*)(P1 + ((size_t)b * SEQ + ttc) * NP1 + ch);
            if (tt < 0) raw[i][j] = (u32x4){0u, 0u, 0u, 0u};
        }
    }
    if (wid == 0) {
        const float* gg = (const float*)(p.ws + OFF_GBGA) + (tok0 + lane) * 8;
        const float gbv = gg[hh], gav = gg[4 + hh];
        const float beta = 1.0f / (1.0f + expf(-gbv));
        const float xs = gav + p.dt_bias[hh];
        const float sp = fmaxf(xs, 0.f) + log1pf(expf(-fabsf(xs)));
        float gc = -expf(p.a_log[hh]) * sp;
#pragma unroll
        for (int o = 1; o < 64; o <<= 1) { const float t = __shfl_up(gc, o); if (lane >= o) gc += t; }
        const float gl = __shfl(gc, 63);
        sm[lane] = beta; sm[64 + lane] = gc * LOG2E; sm[128 + lane] = expf(gc); sm[192 + lane] = expf(gl - gc);
        if (lane == 63) ((float*)(p.ws + OFF_GL))[c2] = expf(gl);
    }
    float av[6][8];
#pragma unroll
    for (int i = 0; i < 6; ++i) {
        const int item = tid + 512 * i, g = item & 15, part = i >> 1;
        const int ch = part * 512 + hh * 128 + g * 8;
        float a[8];
#pragma unroll
        for (int e = 0; e < 8; ++e) a[e] = 0.f;
#pragma unroll
        for (int j = 0; j < 4; ++j) {
            const f32x4 w0 = *(const f32x4*)(p.conv_w + j * 1536 + ch), w1 = *(const f32x4*)(p.conv_w + j * 1536 + ch + 4);
            const u32x4 rw = raw[i][j];
            a[0] += w0[0] * bf_lo(rw.x); a[1] += w0[1] * bf_hi(rw.x); a[2] += w0[2] * bf_lo(rw.y); a[3] += w0[3] * bf_hi(rw.y);
            a[4] += w1[0] * bf_lo(rw.z); a[5] += w1[1] * bf_hi(rw.z); a[6] += w1[2] * bf_lo(rw.w); a[7] += w1[3] * bf_hi(rw.w);
        }
        float ss = 0.f;
#pragma unroll
        for (int e = 0; e < 8; ++e) { a[e] = silu_f(a[e]); ss += a[e] * a[e]; }
        float rn = 1.0f;
        if (part < 2) {
            ss += __shfl_xor(ss, 1); ss += __shfl_xor(ss, 2); ss += __shfl_xor(ss, 4); ss += __shfl_xor(ss, 8);
            rn = rsqrtf(ss + 1e-6f) * (part == 0 ? 0.08838834764831845f : 1.0f);
        }
#pragma unroll
        for (int e = 0; e < 8; ++e) av[i][e] = a[e] * rn;
    }
    __syncthreads();
#pragma unroll
    for (int i = 0; i < 6; ++i) {
        const int item = tid + 512 * i, g = item & 15, t = (item >> 4) & 63, part = i >> 1;
        const float* a = av[i];
        const float beta = sm[t], egc = sm[128 + t], ekd = sm[192 + t];
        if (part < 2) {
            u32x4 w; w.x = pk_bf16(a[0], a[1]); w.y = pk_bf16(a[2], a[3]); w.z = pk_bf16(a[4], a[5]); w.w = pk_bf16(a[6], a[7]);
            *(LAS u32x4*)(lds + (part == 0 ? G_QN : G_KN) + t * 272 + g * 16) = w;
            if (part == 0) {
                u32x2 lo, hi; lo.x = pk_bf16(a[0] * egc, a[1] * egc); lo.y = pk_bf16(a[2] * egc, a[3] * egc); hi.x = pk_bf16(a[4] * egc, a[5] * egc); hi.y = pk_bf16(a[6] * egc, a[7] * egc);
                bf16_t* qd = QD + t * 128 + 16 * (g >> 1) + 4 * (g & 1);
                *(u32x2*)qd = lo; *(u32x2*)(qd + 8) = hi;
            } else {
                const float f1 = beta * egc;
                u32x4 w2; w2.x = pk_bf16(a[0] * f1, a[1] * f1); w2.y = pk_bf16(a[2] * f1, a[3] * f1); w2.z = pk_bf16(a[4] * f1, a[5] * f1); w2.w = pk_bf16(a[6] * f1, a[7] * f1);
                *(LAS u32x4*)(lds + G_KBG + t * 272 + g * 16) = w2;
                u32x4 w3; w3.x = pk_bf16(a[0] * ekd, a[1] * ekd); w3.y = pk_bf16(a[2] * ekd, a[3] * ekd); w3.z = pk_bf16(a[4] * ekd, a[5] * ekd); w3.w = pk_bf16(a[6] * ekd, a[7] * ekd);
                *(u32x4*)(KD + t * 128 + g * 8) = w3;
            }
        } else {
            u32x4 w; w.x = pk_bf16(a[0] * beta, a[1] * beta); w.y = pk_bf16(a[2] * beta, a[3] * beta); w.z = pk_bf16(a[4] * beta, a[5] * beta); w.w = pk_bf16(a[6] * beta, a[7] * beta);
            *(LAS u32x4*)(lds + G_VB + t * 272 + g * 16) = w;
        }
    }
    __syncthreads();
    {
        const int w4 = wid & 3, mt = w4 >> 1, nt = w4 & 1; const bool isqk = wid >= 4;
        if (!(mt == 0 && nt == 1)) {
            const LAS unsigned char* Ab = lds + (isqk ? G_QN : G_KN) + (32 * mt + r) * 272 + 16 * h2;
            const LAS unsigned char* Bb = lds + G_KN + (32 * nt + r) * 272 + 16 * h2;
            f32x16 X;
#pragma unroll
            for (int i = 0; i < 16; ++i) X[i] = 0.f;
#pragma unroll
            for (int ks = 0; ks < 8; ++ks) X = MFMA32(*(const LAS bf16x8*)(Ab + 32 * ks), *(const LAS bf16x8*)(Bb + 32 * ks), X);
            const int s = 32 * nt + r; const float gcs = sm[64 + s];
#pragma unroll
            for (int i = 0; i < 16; ++i) {
                const int c = 32 * mt + crow(i, h2);
                const float dec = __builtin_amdgcn_exp2f(sm[64 + c] - gcs);
                if (!isqk) Mf[c * 64 + s] = (c > s) ? sm[c] * X[i] * dec : 0.f;
                else AQ[c * 64 + perm23(s)] = bf16_1((c >= s) ? X[i] * dec : 0.f);
            }
        }
    }
    __syncthreads();
    if (wid == 0) {
        const int cc = r, hb = h2;
        const LAS float* Mb = Mf + (32 * hb) * 64 + 32 * hb;
        float T[32];
#pragma unroll
        for (int i = 0; i < 32; ++i) T[i] = 0.f;
#pragma unroll
        for (int i = 0; i < 32; ++i) {
            float a0 = (i == cc) ? 1.f : 0.f, a1 = 0.f, a2 = 0.f, a3 = 0.f;
#pragma unroll
            for (int s4 = 0; s4 < (i + 3) / 4; ++s4) {
                const f32x4 m4 = *(const LAS f32x4*)(Mb + i * 64 + 4 * s4);
                a0 -= m4[0] * T[4 * s4]; a1 -= m4[1] * T[4 * s4 + 1]; a2 -= m4[2] * T[4 * s4 + 2]; a3 -= m4[3] * T[4 * s4 + 3];
            }
            float acc = (a0 + a1) + (a2 + a3);
            if ((i & 3) == 3) asm volatile("" : "+v"(acc) :: "memory");
            T[i] = acc;
        }
        LAS bf16_t* Tb = (LAS bf16_t*)(lds + G_T);
#pragma unroll
        for (int i = 0; i < 32; ++i) {
            Tb[(32 * hb + i) * 72 + 32 * hb + cc] = bf16_1(T[i]);
            if (hb == 0) Tb[i * 72 + 32 + cc] = 0;
        }
        __builtin_amdgcn_wave_barrier();
        asm volatile("s_waitcnt lgkmcnt(0)" ::: "memory");
        const int i16 = lane & 15, q = i16 >> 2, pp = i16 & 3, blk = (lane >> 4) & 1;
        f32x16 Y;
#pragma unroll
        for (int i = 0; i < 16; ++i) Y[i] = 0.f;
#pragma unroll
        for (int ks = 0; ks < 2; ++ks) {
            const LAS float* mp = Mf + (32 + r) * 64 + 16 * ks + 8 * h2;
            const f32x4 m0 = *(const LAS f32x4*)mp, m1 = *(const LAS f32x4*)(mp + 4);
            u32x4 aw; aw.x = pk_bf16(m0[0], m0[1]); aw.y = pk_bf16(m0[2], m0[3]); aw.z = pk_bf16(m1[0], m1[1]); aw.w = pk_bf16(m1[2], m1[3]);
            const bf16x8 bfrag = tr_pair(lds + G_T + (16 * ks + 8 * h2 + q) * 144 + (16 * blk + 4 * pp) * 2, 4 * 144);
            Y = MFMA32(__builtin_bit_cast(bf16x8, aw), bfrag, Y);
        }
        f32x16 Z;
#pragma unroll
        for (int i = 0; i < 16; ++i) Z[i] = 0.f;
#pragma unroll
        for (int s = 0; s < 2; ++s) {
            const LAS unsigned char* tp = lds + G_T + (32 + r) * 144 + (32 + 16 * s + 4 * h2) * 2;
            const u32x2 lo = *(const LAS u32x2*)tp, hi = *(const LAS u32x2*)(tp + 16);
            u32x4 aw; aw.x = lo.x; aw.y = lo.y; aw.z = hi.x; aw.w = hi.y;
            Z = MFMA32(__builtin_bit_cast(bf16x8, aw), pack8(Y, s), Z);
        }
#pragma unroll
        for (int i = 0; i < 16; ++i) Tb[(32 + crow(i, h2)) * 72 + r] = bf16_1(-Z[i]);
    }
    __syncthreads();
    {
        const int mt = wid >> 2, nt = wid & 3;
        const int i16 = lane & 15, q = i16 >> 2, pp = i16 & 3, blk = (lane >> 4) & 1;
        f32x16 Xu, Xw;
#pragma unroll
        for (int i = 0; i < 16; ++i) { Xu[i] = 0.f; Xw[i] = 0.f; }
#pragma unroll
        for (int ks = 0; ks < 4; ++ks) {
            if (ks < 2 * (mt + 1)) {
                const bf16x8 af = *(const LAS bf16x8*)(lds + G_T + (32 * mt + r) * 144 + (16 * ks + 8 * h2) * 2);
                const int boff = (16 * ks + 8 * h2 + q) * 272 + (32 * nt + 16 * blk + 4 * pp) * 2;
                Xu = MFMA32(af, tr_pair(lds + G_VB + boff, 4 * 272), Xu);
                Xw = MFMA32(af, tr_pair(lds + G_KBG + boff, 4 * 272), Xw);
            }
        }
        const int d = 32 * nt + r, dp = perm23(d);
        {
            float* up = U + ((nt * 2 + mt) * 64 + lane) * 16;
#pragma unroll
            for (int k = 0; k < 4; ++k) { const f32x4 v = {Xu[4 * k], Xu[4 * k + 1], Xu[4 * k + 2], Xu[4 * k + 3]}; *(f32x4*)(up + 4 * k) = v; }
        }
#pragma unroll
        for (int i = 0; i < 16; ++i) {
            const int c = 32 * mt + crow(i, h2);
            WN[c * 128 + dp] = bf16_1(-Xw[i]);
        }
    }
    __syncthreads();
}

constexpr int S_WN = 0, S_QD = 17408, S_KD = 34816, S_AQ = 52224, S_BUF = 61440, S_STG = 2 * S_BUF;

struct GateIn { u32x4 z0, z1; };
DI void scan_gate_load(const Params& p, int tid, int b, int hh, int n, GateIn& g) {
    const int gc_ = tid >> 3, seg = tid & 7;
    const bf16_t* P1 = (const bf16_t*)(p.ws + OFF_P1);
    const size_t row = (size_t)b * SEQ + n * 64 + gc_;
    g.z0 = *(const u32x4*)(P1 + row * NP1 + C_GZ + hh * 128 + seg * 16); g.z1 = *(const u32x4*)(P1 + row * NP1 + C_GZ + hh * 128 + seg * 16 + 8);
}
DI void scan_gate(const Params& p, LAS unsigned char* lds, int tid, int b, int hh, int n, const GateIn& g) {
    const int gc_ = tid >> 3, seg = tid & 7;
    bf16_t* mix = (bf16_t*)(p.ws + OFF_HB);
    const LAS float* st = (const LAS float*)(lds + S_STG) + gc_ * 132 + seg * 16;
    f32x4 ov[4]; float ss = 0.f;
#pragma unroll
    for (int k = 0; k < 4; ++k) { ov[k] = *(const LAS f32x4*)(st + 4 * k); ss += ov[k][0] * ov[k][0] + ov[k][1] * ov[k][1] + ov[k][2] * ov[k][2] + ov[k][3] * ov[k][3]; }
    ss += __shfl_xor(ss, 1); ss += __shfl_xor(ss, 2); ss += __shfl_xor(ss, 4);
    const float rstd = rsqrtf(ss * (1.0f / 128.0f) + EPS);
    const size_t row = (size_t)b * SEQ + n * 64 + gc_;
    const u32x4 z0 = g.z0, z1 = g.z1;
    f32x4 gnw[4];
#pragma unroll
    for (int k = 0; k < 4; ++k) gnw[k] = *(const f32x4*)(p.gdn_norm_w + seg * 16 + 4 * k);
    u32x4 w0, w1;
    w0.x = pk_bf16(ov[0][0] * rstd * gnw[0][0] * silu_f(bf_lo(z0.x)), ov[0][1] * rstd * gnw[0][1] * silu_f(bf_hi(z0.x)));
    w0.y = pk_bf16(ov[0][2] * rstd * gnw[0][2] * silu_f(bf_lo(z0.y)), ov[0][3] * rstd * gnw[0][3] * silu_f(bf_hi(z0.y)));
    w0.z = pk_bf16(ov[1][0] * rstd * gnw[1][0] * silu_f(bf_lo(z0.z)), ov[1][1] * rstd * gnw[1][1] * silu_f(bf_hi(z0.z)));
    w0.w = pk_bf16(ov[1][2] * rstd * gnw[1][2] * silu_f(bf_lo(z0.w)), ov[1][3] * rstd * gnw[1][3] * silu_f(bf_hi(z0.w)));
    w1.x = pk_bf16(ov[2][0] * rstd * gnw[2][0] * silu_f(bf_lo(z1.x)), ov[2][1] * rstd * gnw[2][1] * silu_f(bf_hi(z1.x)));
    w1.y = pk_bf16(ov[2][2] * rstd * gnw[2][2] * silu_f(bf_lo(z1.y)), ov[2][3] * rstd * gnw[2][3] * silu_f(bf_hi(z1.y)));
    w1.z = pk_bf16(ov[3][0] * rstd * gnw[3][0] * silu_f(bf_lo(z1.z)), ov[3][1] * rstd * gnw[3][1] * silu_f(bf_hi(z1.z)));
    w1.w = pk_bf16(ov[3][2] * rstd * gnw[3][2] * silu_f(bf_lo(z1.w)), ov[3][3] * rstd * gnw[3][3] * silu_f(bf_hi(z1.w)));
    bf16_t* mp = mix + row * DM + hh * 128 + seg * 16;
    *(u32x4*)mp = w0; *(u32x4*)(mp + 8) = w1;
}

DI void scan_load_chunk(LAS unsigned char* dst, const bf16_t* WN, const bf16_t* QD, const bf16_t* KD, const bf16_t* AQ, int ltid) {
    {
        u32x4 t0[4], t1[4];
#pragma unroll
        for (int i = 0; i < 4; ++i) { const int pi = ltid + 256 * i; t0[i] = *(const u32x4*)(WN + pi * 8); t1[i] = *(const u32x4*)(QD + pi * 8); }
#pragma unroll
        for (int i = 0; i < 4; ++i) { const int pi = ltid + 256 * i, row = pi >> 4, pc = pi & 15;
            *(LAS u32x4*)(dst + S_WN + row * 272 + pc * 16) = t0[i]; *(LAS u32x4*)(dst + S_QD + row * 272 + pc * 16) = t1[i]; }
    }
    asm volatile("" ::: "memory");
    {
        u32x4 t2[4], t3[2];
#pragma unroll
        for (int i = 0; i < 4; ++i) { const int pi = ltid + 256 * i; t2[i] = *(const u32x4*)(KD + pi * 8); }
#pragma unroll
        for (int i = 0; i < 2; ++i) { const int pi = ltid + 256 * i; t3[i] = *(const u32x4*)(AQ + pi * 8); }
#pragma unroll
        for (int i = 0; i < 4; ++i) { const int pi = ltid + 256 * i, row = pi >> 4, pc = pi & 15; *(LAS u32x4*)(dst + S_KD + row * 272 + pc * 16) = t2[i]; }
#pragma unroll
        for (int i = 0; i < 2; ++i) { const int pi = ltid + 256 * i, row = pi >> 3, pc = pi & 7; *(LAS u32x4*)(dst + S_AQ + row * 144 + pc * 16) = t3[i]; }
    }
}

DI void gdn_scan(const Params& p, LAS unsigned char* lds, int bh) {
    int tid = threadIdx.x; asm volatile("" : "+v"(tid));
    const int lane = tid & 63, wid = __builtin_amdgcn_readfirstlane(tid >> 6), r = lane & 31, h2 = lane >> 5;
    const int b = bh >> 2, hh = bh & 3;
    const bf16_t* WN = (const bf16_t*)(p.ws + OFF_WN) + (size_t)bh * 32 * 8192;
    const bf16_t* QD = (const bf16_t*)(p.ws + OFF_QD) + (size_t)bh * 32 * 8192;
    const bf16_t* KD = (const bf16_t*)(p.ws + OFF_KD) + (size_t)bh * 32 * 8192;
    const bf16_t* AQ = (const bf16_t*)(p.ws + OFF_AQK) + (size_t)bh * 32 * 4096;
    const float* U = (const float*)(p.ws + OFF_U) + (size_t)bh * 32 * 8192;
    const float* GL = (const float*)(p.ws + OFF_GL) + bh * 32;
    if (wid >= 4) {
        const int ltid = tid & 255;
        scan_load_chunk(lds, WN, QD, KD, AQ, ltid);
#pragma unroll 1
        for (int n = 0; n < 32; ++n) {
            __syncthreads();
            GateIn gi; scan_gate_load(p, tid, b, hh, n, gi);
            if (n + 1 < 32) scan_load_chunk(lds + ((n + 1) & 1) * S_BUF, WN + (size_t)(n + 1) * 8192, QD + (size_t)(n + 1) * 8192, KD + (size_t)(n + 1) * 8192, AQ + (size_t)(n + 1) * 4096, ltid);
            __syncthreads();
            scan_gate(p, lds, tid, b, hh, n, gi);
        }
    } else {
        const int i16 = lane & 15, q4 = i16 >> 2, pp = i16 & 3, blk = (lane >> 4) & 1;
        f32x16 St[4], u[2];
#pragma unroll
        for (int k = 0; k < 4; ++k)
#pragma unroll
            for (int i = 0; i < 16; ++i) St[k][i] = 0.f;
#pragma unroll
        for (int mt = 0; mt < 2; ++mt)
#pragma unroll
            for (int k = 0; k < 4; ++k) { const f32x4 v = *(const f32x4*)(U + ((wid * 2 + mt) * 64 + lane) * 16 + 4 * k); u[mt][4 * k] = v[0]; u[mt][4 * k + 1] = v[1]; u[mt][4 * k + 2] = v[2]; u[mt][4 * k + 3] = v[3]; }
#pragma unroll 1
        for (int n = 0; n < 32; ++n) {
            LAS unsigned char* buf = lds + (n & 1) * S_BUF;
            __syncthreads();
            GateIn gi; scan_gate_load(p, tid, b, hh, n, gi);
            const float egl = GL[n];
            f32x16 vn[2], o[2];
            vn[0] = u[0]; vn[1] = u[1];
#pragma unroll
            for (int mt = 0; mt < 2; ++mt)
#pragma unroll
                for (int i = 0; i < 16; ++i) o[mt][i] = 0.f;
#pragma unroll
            for (int ks = 0; ks < 8; ++ks) {
                const bf16x8 sf = pack8(St[ks >> 1], ks & 1);
#pragma unroll
                for (int mt = 0; mt < 2; ++mt) {
                    const bf16x8 wf = *(const LAS bf16x8*)(buf + S_WN + (32 * mt + r) * 272 + (16 * ks + 8 * h2) * 2);
                    vn[mt] = MFMA32(wf, sf, vn[mt]);
                    const bf16x8 qf = *(const LAS bf16x8*)(buf + S_QD + (32 * mt + r) * 272 + (16 * ks + 8 * h2) * 2);
                    o[mt] = MFMA32(qf, sf, o[mt]);
                }
                asm volatile("" ::: "memory");
            }
            bf16x8 vf[4];
#pragma unroll
            for (int k2 = 0; k2 < 4; ++k2) vf[k2] = pack8(vn[k2 >> 1], k2 & 1);
            {
                const int nn = (n + 1 < 32) ? n + 1 : n;
                const float* up = U + (size_t)nn * 8192 + ((wid * 2) * 64 + lane) * 16;
#pragma unroll
                for (int mt = 0; mt < 2; ++mt)
#pragma unroll
                    for (int k = 0; k < 4; ++k) { const f32x4 v = *(const f32x4*)(up + mt * 1024 + 4 * k); u[mt][4 * k] = v[0]; u[mt][4 * k + 1] = v[1]; u[mt][4 * k + 2] = v[2]; u[mt][4 * k + 3] = v[3]; }
            }
#pragma unroll
            for (int mt = 0; mt < 2; ++mt)
#pragma unroll
                for (int k2 = 0; k2 < 2 * (mt + 1); ++k2) {
                    const bf16x8 af = *(const LAS bf16x8*)(buf + S_AQ + (32 * mt + r) * 144 + (16 * k2 + 8 * h2) * 2);
                    o[mt] = MFMA32(af, vf[k2], o[mt]);
                }
            {
                LAS float* st = (LAS float*)(lds + S_STG);
#pragma unroll
                for (int mt = 0; mt < 2; ++mt)
#pragma unroll
                    for (int i = 0; i < 16; ++i) st[(32 * mt + crow(i, h2)) * 132 + 32 * wid + r] = o[mt][i];
            }
#pragma unroll
            for (int kt = 0; kt < 4; ++kt) {
#pragma unroll
                for (int i = 0; i < 16; ++i) St[kt][i] *= egl;
#pragma unroll
                for (int k2 = 0; k2 < 4; ++k2) {
                    const bf16x8 kf = tr_pair(buf + S_KD + (16 * k2 + 4 * h2 + q4) * 272 + (32 * kt + 16 * blk + 4 * pp) * 2, 8 * 272);
                    St[kt] = MFMA32(kf, vf[k2], St[kt]);
                }
                asm volatile("" ::: "memory");
            }
            __syncthreads();
            scan_gate(p, lds, tid, b, hh, n, gi);
        }
    }
    __syncthreads();
}

DI void zero_mix_half(const Params& p, int half) {
    bf16_t* mix = (bf16_t*)(p.ws + OFF_HB);
    const size_t n16 = (size_t)MTOK * 64;
    for (size_t i = (size_t)blockIdx.x * 512 + threadIdx.x; i < n16; i += (size_t)gridDim.x * 512) {
        const size_t row = i >> 6, pc = i & 63;
        *(u32x4*)(mix + row * DM + half * 512 + pc * 8) = (u32x4){0u, 0u, 0u, 0u};
    }
}

DI void phase_final(const Params& p) {
    int tid = threadIdx.x; asm volatile("" : "+v"(tid));
    const int lane = tid & 63, wid = tid >> 6;
    const float* rowsq = (const float*)(p.ws + OFF_ROWSQ);
    const int gw = blockIdx.x * 8 + wid, nw = gridDim.x * 8;
    f32x4 fw[4];
#pragma unroll
    for (int i = 0; i < 4; ++i) fw[i] = ((const f32x4*)p.final_norm_w)[lane + 64 * i];
    int row = gw;
    f32x4 y[4]; float sq = 0.f;
    if (row < MTOK) {
#pragma unroll
        for (int i = 0; i < 4; ++i) y[i] = ((const f32x4*)(p.out + (size_t)row * DM))[lane + 64 * i];
        sq = lane < 16 ? rowsq[(size_t)row * 16 + lane] : 0.f;
    }
#pragma unroll 1
    for (; row < MTOK; row += nw) {
        const int rnx = (row + nw < MTOK) ? row + nw : row;
        f32x4 yn[4];
#pragma unroll
        for (int i = 0; i < 4; ++i) yn[i] = ((const f32x4*)(p.out + (size_t)rnx * DM))[lane + 64 * i];
        const float sqn = lane < 16 ? rowsq[(size_t)rnx * 16 + lane] : 0.f;
        const float ss = wave_sum(sq);
        const float rstd = rsqrtf(ss * (1.0f / DM) + EPS);
        f32x4* o = (f32x4*)(p.out + (size_t)row * DM);
#pragma unroll
        for (int i = 0; i < 4; ++i) o[lane + 64 * i] = y[i] * rstd * fw[i];
#pragma unroll
        for (int i = 0; i < 4; ++i) y[i] = yn[i];
        sq = sqn;
    }
}

__global__ void __launch_bounds__(512) mega(Params p) {
    extern __shared__ __attribute__((aligned(16))) unsigned char shm[];
    LAS unsigned char* lds = (LAS unsigned char*)shm;
    cg::grid_group grid = cg::this_grid();

#pragma unroll 1
    for (int rep = 0; rep < REP_PREP; ++rep) phase_prep(p, lds);
    grid.sync();
#pragma unroll 1
    for (int rep = 0; rep < REP_G1; ++rep)
    {
        pg8::Gemm g{(const bf16_t*)(p.ws + OFF_HB), (const bf16_t*)(p.ws + OFF_WINT), MTOK, NG1, DM};
        pg8::StaticOrder S; S.init(g.M, g.N, (int)gridDim.x, (int)blockIdx.x);
        pg8::EpiP1 E{(bf16_t*)(p.ws + OFF_P1), NP1, (bf16_t*)(p.ws + OFF_KX)};
        pg8::gemm_phase<pg8::EpiP1, false>(lds, g, S, E);
        pg8::Gemm g2{(const bf16_t*)(p.ws + OFF_HB), (const bf16_t*)(p.ws + OFF_WINT) + (size_t)NG1 * DM, MTOK, 512, DM};
        pg8::StaticOrder S2; S2.init(g2.M, g2.N, (int)gridDim.x, (int)blockIdx.x);
        pg8::EpiVT E2{(bf16_t*)(p.ws + OFF_VT)};
        pg8::gemm_phase<pg8::EpiVT, true>(lds, g2, S2, E2);
    }
    grid.sync();
#pragma unroll 1
    for (int rep = 0; rep < REP_GP; ++rep)
        for (int c2 = blockIdx.x; c2 < 2048; c2 += gridDim.x) gdn_prep(p, lds, c2);
    grid.sync();
#pragma unroll 1
    for (int rep = 0; rep < REP_P3; ++rep) {
#pragma unroll 1
        for (int r2 = 0; r2 < REP_SCAN; ++r2)
            if (blockIdx.x < 64) gdn_scan(p, lds, blockIdx.x);
#if SCAN_SYNC
        grid.sync();
#endif
        phase_attn(p, lds, rep);
#if REP_ATTN > 1
        grid.sync();
        phase_attn(p, lds, 2);
#endif
#if REP_P3 > 1
        grid.sync();
#endif
    }
    grid.sync();
#pragma unroll 1
    for (int rep = 0; rep < REP_G2; ++rep)
    {
        pg8::Gemm g{(const bf16_t*)(p.ws + OFF_HB), (const bf16_t*)(p.ws + OFF_WOUTT), MTOK, DM, DM};
        pg8::StaticOrder S; S.init(g.M, g.N, (int)gridDim.x, (int)blockIdx.x);
        pg8::EpiOut E{p.x, p.out, (float*)(p.ws + OFF_ROWSQ)};
        pg8::gemm_phase<pg8::EpiOut, false>(lds, g, S, E);
    }
    grid.sync();
    phase_final(p);
}

extern "C" void kernel_launch(void* const* d_in, const int* in_sizes, int n_in, void* d_out, int out_size, void* d_ws, size_t ws_size, hipStream_t stream) {
    static int grid = 0;
    if (grid == 0) {
        if (ws_size < WS_END) { fprintf(stderr, "kernel_launch: workspace too small (%zu < %zu)\n", ws_size, (size_t)WS_END); grid = -1; return; }
        int dev = 0, cus = 0, per_cu = 0;
        hipGetDevice(&dev);
        hipDeviceGetAttribute(&cus, hipDeviceAttributeMultiprocessorCount, dev);
        if (hipFuncSetAttribute((const void*)mega, hipFuncAttributeMaxDynamicSharedMemorySize, LDS_BYTES) != hipSuccess) { fprintf(stderr, "kernel_launch: hipFuncSetAttribute failed\n"); grid = -1; return; }
        if (hipOccupancyMaxActiveBlocksPerMultiprocessor(&per_cu, (const void*)mega, 512, LDS_BYTES) != hipSuccess || per_cu < 1) per_cu = 1;
        (void)hipGetLastError();
        grid = cus * (per_cu > 1 ? 1 : per_cu);
    }
    if (grid < 0) return;
    Params p{};
    p.x = (const float*)d_in[0]; p.norm_w = (const float*)d_in[1]; p.w_in = (const float*)d_in[2]; p.conv_w = (const float*)d_in[3];
    p.a_log = (const float*)d_in[4]; p.dt_bias = (const float*)d_in[5]; p.gdn_norm_w = (const float*)d_in[6];
    p.lq1 = (const float*)d_in[7]; p.lk1 = (const float*)d_in[8]; p.lq2 = (const float*)d_in[9]; p.lk2 = (const float*)d_in[10];
    p.diff_norm_w = (const float*)d_in[11]; p.w_out = (const float*)d_in[12]; p.final_norm_w = (const float*)d_in[13];
    p.out = (float*)d_out; p.ws = (unsigned char*)d_ws;
    void* args[] = {&p};
    hipError_t e = hipLaunchCooperativeKernel((const void*)mega, dim3(grid), dim3(512), args, LDS_BYTES, stream);
    if (e != hipSuccess) fprintf(stderr, "cooperative launch failed: %s (grid %d)\n", hipGetErrorString(e), grid);
}
```

```cpp
#include <hip/hip_runtime.h>
#include <hip/hip_cooperative_groups.h>
#include <cstdio>
namespace cg = cooperative_groups;

#ifndef ENABLE_ATTN
#define ENABLE_ATTN 1
#endif
#ifndef ENABLE_GDN
#define ENABLE_GDN 1
#endif
#ifndef REP_PREP
#define REP_PREP 1
#endif
#ifndef REP_G1
#define REP_G1 1
#endif
#ifndef REP_GP
#define REP_GP 1
#endif
#ifndef REP_P3
#define REP_P3 1
#endif
#ifndef REP_G2
#define REP_G2 1
#endif
#ifndef REP_SCAN
#define REP_SCAN 1
#endif
#ifndef SCAN_SYNC
#define SCAN_SYNC 0
#endif
#ifndef REP_ATTN
#define REP_ATTN 1
#endif

#define LAS __attribute__((address_space(3)))
#define DI __device__ __forceinline__
typedef unsigned short bf16_t;
typedef short bf16x8 __attribute__((ext_vector_type(8)));
typedef short s16x4 __attribute__((ext_vector_type(4)));
typedef float f32x2 __attribute__((ext_vector_type(2)));
typedef float f32x4 __attribute__((ext_vector_type(4)));
typedef float f32x16 __attribute__((ext_vector_type(16)));
typedef unsigned u32x2 __attribute__((ext_vector_type(2)));
typedef unsigned u32x4 __attribute__((ext_vector_type(4)));
typedef __bf16 bf16x2_t __attribute__((ext_vector_type(2)));

#define MFMA32(a, b, c) __builtin_amdgcn_mfma_f32_32x32x16_bf16((a), (b), (c), 0, 0, 0)

constexpr int NB = 16, SEQ = 2048, DM = 1024, MTOK = NB * SEQ, NP1 = 3072, NG1 = 3584;
constexpr int C_GQ = 0, C_GK = 512, C_GV = 1024, C_GZ = 1536, C_DQ = 2048, C_DZ = 2560;
constexpr float EPS = 1e-6f;
constexpr float LOG2E = 1.4426950408889634f;

constexpr size_t OFF_HB = 0;
constexpr size_t OFF_WINT = OFF_HB + (size_t)MTOK * DM * 2;
constexpr size_t OFF_WOUTT = OFF_WINT + (size_t)4096 * 1024 * 2;
constexpr size_t OFF_GBGA = OFF_WOUTT + (size_t)1024 * 1024 * 2;
constexpr size_t OFF_P1 = OFF_GBGA + (size_t)MTOK * 8 * 4;
constexpr size_t OFF_KX = OFF_P1 + (size_t)MTOK * NP1 * 2;
constexpr size_t OFF_VT = OFF_KX + (size_t)64 * 2 * 2048 * 64 * 2;
constexpr size_t OFF_WN = OFF_VT + (size_t)64 * 128 * 2048 * 2;
constexpr size_t OFF_QD = OFF_WN + (size_t)2048 * 64 * 128 * 2;
constexpr size_t OFF_KD = OFF_QD + (size_t)2048 * 64 * 128 * 2;
constexpr size_t OFF_AQK = OFF_KD + (size_t)2048 * 64 * 128 * 2;
constexpr size_t OFF_U = OFF_AQK + (size_t)2048 * 64 * 64 * 2;
constexpr size_t OFF_GL = OFF_U + (size_t)2048 * 64 * 128 * 4;
constexpr size_t OFF_ROWSQ = OFF_GL + 8192;
constexpr size_t OFF_MISC = OFF_ROWSQ + (size_t)MTOK * 16 * 4;
constexpr size_t OFF_BAR = OFF_MISC + 256;
constexpr size_t WS_END = OFF_BAR + 16384;

constexpr int LDS_BYTES = 156 * 1024;

struct Params {
    const float *x, *norm_w, *w_in, *conv_w, *a_log, *dt_bias, *gdn_norm_w, *lq1, *lk1, *lq2, *lk2, *diff_norm_w, *w_out, *final_norm_w;
    float* out; unsigned char* ws;
};

DI unsigned pk_bf16(float a, float b) { f32x2 v = {a, b}; bf16x2_t r = __builtin_convertvector(v, bf16x2_t); return __builtin_bit_cast(unsigned, r); }
DI float bf_lo(unsigned u) { return __uint_as_float(u << 16); }
DI float bf_hi(unsigned u) { return __uint_as_float(u & 0xffff0000u); }
DI float wave_sum(float v) {
#pragma unroll
    for (int o = 32; o; o >>= 1) v += __shfl_xor(v, o);
    return v;
}
DI float silu_f(float z) { return z * __builtin_amdgcn_rcpf(1.0f + __builtin_amdgcn_exp2f(-LOG2E * z)); }
DI int perm23(int t) { return (t & ~12) | ((t & 4) << 1) | ((t & 8) >> 1); }
DI int crow(int i, int h2) { return (i & 3) + 8 * (i >> 2) + 4 * h2; }
DI bf16x8 pack8(const f32x16& x, int s) {
    u32x4 w; w.x = pk_bf16(x[8 * s + 0], x[8 * s + 1]); w.y = pk_bf16(x[8 * s + 2], x[8 * s + 3]); w.z = pk_bf16(x[8 * s + 4], x[8 * s + 5]); w.w = pk_bf16(x[8 * s + 6], x[8 * s + 7]);
    return __builtin_bit_cast(bf16x8, w);
}


#define XB_TMO      128
#define XB_XCNT(j)  (256  + 64 * (j))
#define XB_XSUB(j)  (1280 + 64 * (j))
#define XB_XGEN(j)  (2304 + 64 * (j))
#define XB_TOP      3328
#define XB_TOPGEN   3392
#define XCD_BAR_WORDS 3456
#define XB_SPIN_CAP (1u << 18)
struct XcdBarrier { unsigned* bar; unsigned x; volatile LAS unsigned* st; };
DI unsigned xb_ld(unsigned* p)              { return __hip_atomic_load(p, __ATOMIC_RELAXED, __HIP_MEMORY_SCOPE_AGENT); }
DI unsigned xb_add(unsigned* p, unsigned v) { return __hip_atomic_fetch_add(p, v, __ATOMIC_RELAXED, __HIP_MEMORY_SCOPE_AGENT); }
DI unsigned xb_xcc_id() { return (unsigned)__builtin_amdgcn_s_getreg((3 << 11) | 20) & 0xFu; }
#define XB_SPIN(cond, bar) do { unsigned _sp = 0; while (cond) { __builtin_amdgcn_s_sleep(1); \
    if ((++_sp & 255u) == 0u) { if (xb_ld(&(bar)[XB_TMO])) break; if (_sp > XB_SPIN_CAP) { atomicAdd(&(bar)[XB_TMO], 1u); break; } } } } while (0)
DI XcdBarrier xcd_barrier_post(unsigned* bar, volatile LAS unsigned* st) {
    XcdBarrier b; b.bar = bar; b.x = xb_xcc_id(); b.st = st;
    if (threadIdx.x == 0) (void)xb_add(&bar[XB_XCNT(b.x)], 1u);
    return b;
}
DI void xcd_barrier_complete(unsigned* bar, unsigned x, unsigned& nloc, unsigned& nx) {
    const unsigned G = gridDim.x * gridDim.y * gridDim.z;
    unsigned sum, cnt, mine, sp = 0u;
    for (;;) {
        sum = 0u; cnt = 0u; mine = 0u;
#pragma unroll
        for (unsigned j = 0; j < 16; ++j) { const unsigned c = xb_ld(&bar[XB_XCNT(j)]); sum += c; cnt += (c > 0u) ? 1u : 0u; mine = (j == x) ? c : mine; }
        if (sum == G) break;
        __builtin_amdgcn_s_sleep(1);
        if ((++sp & 255u) == 0u) { if (xb_ld(&bar[XB_TMO])) break; if (sp > XB_SPIN_CAP) { atomicAdd(&bar[XB_TMO], 1u); break; } }
    }
    nloc = mine > 0u ? mine : 1u; nx = cnt > 0u ? cnt : 1u;
}
DI void xcd_barrier(const XcdBarrier& b) {
    asm volatile("s_waitcnt vmcnt(0)" ::: "memory");
    __syncthreads();
    if (threadIdx.x == 0) {
        unsigned* bar = b.bar;
        __builtin_amdgcn_s_waitcnt(0);
        unsigned nloc = b.st[0], nx = b.st[1];
        if (nloc == 0u) { xcd_barrier_complete(bar, b.x, nloc, nx); b.st[0] = nloc; b.st[1] = nx; }
        const unsigned old = xb_add(&bar[XB_XSUB(b.x)], 1u);
        const unsigned gen = old / nloc;
        if (old + 1u == (gen + 1u) * nloc) {
            __builtin_amdgcn_fence(__ATOMIC_RELEASE, "agent");
            asm volatile("s_waitcnt vmcnt(0)" ::: "memory");
            const unsigned og = xb_add(&bar[XB_TOP], 1u);
            const unsigned tg = og / nx;
            if (og + 1u == (tg + 1u) * nx) xb_add(&bar[XB_TOPGEN], 1u);
            else XB_SPIN(xb_ld(&bar[XB_TOPGEN]) == tg, bar);
            __builtin_amdgcn_fence(__ATOMIC_ACQUIRE, "agent");
            xb_add(&bar[XB_XGEN(b.x)], 1u);
            asm volatile("s_waitcnt vmcnt(0)" ::: "memory");
        } else {
            XB_SPIN(xb_ld(&bar[XB_XGEN(b.x)]) == gen, bar);
            __builtin_amdgcn_fence(__ATOMIC_ACQUIRE, "agent");
            asm volatile("s_waitcnt vmcnt(0)" ::: "memory");
        }
    }
    __syncthreads();
}

namespace pg8 {
constexpr int BM = 256, BK = 64, HALF = 128, HTB = HALF * BK * 2, STAGE_BYTES = 8 * HTB, NXCD = 8, WGM = 8;
DI int lds_byte(int r, int c) { const int st = (r >> 4) * 2 + (c >> 5), rr = r & 15, cc = c & 31, ob = rr * 64 + cc * 2; return st * 1024 + (ob ^ (((ob >> 9) & 1) << 5)); }
DI void stage_rc(int b, int& R, int& C) { const int st = b / 1024, sb = b % 1024, swz = sb ^ (((sb >> 9) & 1) << 5); R = (st >> 1) * 16 + swz / 64; C = (st & 1) * 32 + (swz % 64) / 2; }
DI int perm32(int rho) { const int n = rho >> 4, i = rho & 15; return 8 * (i >> 2) + 4 * n + (i & 3); }
struct Unit { int pm, pn; };
struct Gemm { const bf16_t* A; const bf16_t* Bt; int M, N, K; };
struct StaticOrder {
    int nM, nN, nwg, G, c;
    DI void init(int M, int N, int G_, int c_) { nM = M / BM; nN = N / BM; nwg = nM * nN; G = G_; c = c_; }
    DI bool next(int i, Unit& u) const {
        const long L = (long)i * G + c; if (L >= nwg) return false;
        int wgid = (int)L; { const int q = nwg / NXCD, r = nwg % NXCD, xcd = wgid % NXCD, off = wgid / NXCD; wgid = (xcd < r ? xcd * (q + 1) : r * (q + 1) + (xcd - r) * q) + off; }
        const int nig = WGM * nN, gid = wgid / nig, fm = gid * WGM, gsz = (nM - fm) < WGM ? (nM - fm) : WGM;
        u.pm = fm + ((wgid % nig) % gsz); u.pn = (wgid % nig) / gsz; return true;
    }
    DI void a_ready(const Unit&) const {}
    DI void done(const Unit&) const {}
};

struct EpiP1 {
    static constexpr bool PERM = true;
    bf16_t* O; int ldc; bf16_t* KX;
    DI void operator()(const f32x4 (&acc)[2][2][4][2], const Unit& u, int wr, int wc, int fr, int fq) const {
        const int row0 = u.pm * BM + wr * 64 + fr, col0 = u.pn * BM + wc * 32 + 8 * fq;
        if (u.pn >= 12) {
#pragma unroll
            for (int ai = 0; ai < 2; ++ai)
#pragma unroll
                for (int m = 0; m < 4; ++m) { const int row = row0 + ai * HALF + m * 16, b = row >> 11, tok = row & 2047;
#pragma unroll
                    for (int bj = 0; bj < 2; ++bj) { const f32x4 v0 = acc[ai][bj][m][0], v1 = acc[ai][bj][m][1];
                        const int c = col0 - 12 * BM + bj * HALF, hm = c >> 6, d = c & 63;
                        u32x4 w; w.x = pk_bf16(v0[0], v0[1]); w.y = pk_bf16(v0[2], v0[3]); w.z = pk_bf16(v1[0], v1[1]); w.w = pk_bf16(v1[2], v1[3]);
                        *(u32x4*)(KX + ((size_t)(b * 8 + hm) * 2048 + tok) * 64 + d) = w; } }
            return;
        }
#pragma unroll
        for (int ai = 0; ai < 2; ++ai)
#pragma unroll
            for (int m = 0; m < 4; ++m) { bf16_t* rowp = O + (size_t)(row0 + ai * HALF + m * 16) * ldc + col0;
#pragma unroll
                for (int bj = 0; bj < 2; ++bj) { const f32x4 v0 = acc[ai][bj][m][0], v1 = acc[ai][bj][m][1];
                    u32x4 w; w.x = pk_bf16(v0[0], v0[1]); w.y = pk_bf16(v0[2], v0[3]); w.z = pk_bf16(v1[0], v1[1]); w.w = pk_bf16(v1[2], v1[3]);
                    *(u32x4*)(rowp + bj * HALF) = w; } }
    }
};
struct EpiVT {
    static constexpr bool PERM = false;
    bf16_t* VT;
    DI void operator()(const f32x4 (&acc)[2][2][4][2], const Unit& u, int wr, int wc, int fr, int fq) const {
#pragma unroll
        for (int ai = 0; ai < 2; ++ai)
#pragma unroll
            for (int m = 0; m < 4; ++m) {
                const int t = u.pm * BM + ai * HALF + wr * 64 + m * 16 + 4 * fq, b = t >> 11, tok = t & 2047, pos = perm23(tok);
#pragma unroll
                for (int bj = 0; bj < 2; ++bj)
#pragma unroll
                    for (int n = 0; n < 2; ++n) {
                        const int c = u.pn * BM + bj * HALF + wc * 32 + n * 16 + fr, hh = c >> 7, dv = c & 127;
                        const f32x4 v = acc[ai][bj][m][n];
                        u32x2 w; w.x = pk_bf16(v[0], v[1]); w.y = pk_bf16(v[2], v[3]);
                        *(u32x2*)(VT + (((size_t)((b * 4 + hh) * 32 + (pos >> 6)) * 128 + dv)) * 64 + (pos & 63)) = w;
                    }
            }
    }
};
struct EpiOut {
    static constexpr bool PERM = false;
    const float* X; float* Y; float* rowsq;
    DI void operator()(const f32x4 (&acc)[2][2][4][2], const Unit& u, int wr, int wc, int fr, int fq) const {
        const int row0 = u.pm * BM + wr * 64 + fr, col0 = u.pn * BM + wc * 32 + 4 * fq;
#pragma unroll
        for (int ai = 0; ai < 2; ++ai)
#pragma unroll
            for (int m = 0; m < 4; ++m) {
                const int row = row0 + ai * HALF + m * 16; float ss = 0.f;
#pragma unroll
                for (int bj = 0; bj < 2; ++bj)
#pragma unroll
                    for (int n = 0; n < 2; ++n) {
                        const size_t o = (size_t)row * DM + col0 + bj * HALF + n * 16;
                        const f32x4 xv = *(const f32x4*)(X + o); const f32x4 y = acc[ai][bj][m][n] + xv;
                        *(f32x4*)(Y + o) = y; ss += y[0] * y[0] + y[1] * y[1] + y[2] * y[2] + y[3] * y[3];
                    }
                ss += __shfl_xor(ss, 16); ss += __shfl_xor(ss, 32);
                if (fq == 0) rowsq[(size_t)row * 16 + u.pn * 4 + wc] = ss;
            }
    }
};

template <class Epi, bool SWAP>
DI void gemm_phase(LAS unsigned char* lds, const Gemm g, const StaticOrder& S, const Epi& E) {
    int tid = threadIdx.x; asm volatile("" : "+v"(tid));
    const int wid = __builtin_amdgcn_readfirstlane(tid >> 6), lane = tid & 63, wr = wid >> 2, wc = wid & 3, fr = lane & 15, fq = lane >> 4;
    const int K = g.K, nt = K / BK;
    unsigned voffA[2], voffB[2];
#pragma unroll
    for (int i = 0; i < 2; ++i) { int R, C; stage_rc(tid * 16 + i * 8192, R, C); const int Rb = Epi::PERM ? ((R & ~31) + perm32(R & 31)) : R;
        voffA[i] = (unsigned)(R * K + C) * 2u; voffB[i] = (unsigned)(Rb * K + C) * 2u; }
    const size_t kstep = (size_t)(BK * 2);
    const size_t hstep = (size_t)HALF * K * 2;
    const size_t tstep = 2 * hstep;
    const unsigned ldsw = (unsigned)wid * 1024u;
    const int aoff = lds_byte(wr * 64 + fr, fq * 8), boff = lds_byte(wc * 32 + fr, fq * 8);
#define PG8_SA(b, h) (((b) * 2 + (h)) * HTB)
#define PG8_SB(b, h) ((4 + (b) * 2 + (h)) * HTB)
#define PG8_STAGE(bufoff, gbase, voff) do { _Pragma("unroll") for (int _i = 0; _i < 2; ++_i) \
        __builtin_amdgcn_global_load_lds((const unsigned*)((const char*)(gbase) + (voff)[_i]), (LAS unsigned*)(lds + (bufoff) + ldsw + _i * 8192), 16, 0, 0); } while (0)
#define PG8_LDA(dst, b, h) do { _Pragma("unroll") for (int m = 0; m < 4; ++m) _Pragma("unroll") for (int k = 0; k < 2; ++k) dst[m][k] = *(const LAS bf16x8*)(lds + PG8_SA(b, h) + aoff + m * 2048 + k * 1024); } while (0)
#define PG8_LDB(dst, b, h) do { _Pragma("unroll") for (int n = 0; n < 2; ++n) _Pragma("unroll") for (int k = 0; k < 2; ++k) dst[n][k] = *(const LAS bf16x8*)(lds + PG8_SB(b, h) + boff + n * 2048 + k * 1024); } while (0)
#define PG8_MMA(ai, bj, At, Bt) do { __builtin_amdgcn_s_setprio(1); _Pragma("unroll") for (int m = 0; m < 4; ++m) _Pragma("unroll") for (int n = 0; n < 2; ++n) _Pragma("unroll") for (int k = 0; k < 2; ++k) \
        acc[ai][bj][m][n] = SWAP ? __builtin_amdgcn_mfma_f32_16x16x32_bf16(At[m][k], Bt[n][k], acc[ai][bj][m][n], 0, 0, 0) \
                                 : __builtin_amdgcn_mfma_f32_16x16x32_bf16(Bt[n][k], At[m][k], acc[ai][bj][m][n], 0, 0, 0); __builtin_amdgcn_s_setprio(0); } while (0)
#define PG8_WAIT_V(n) asm volatile("s_waitcnt vmcnt(" #n ")" ::: "memory")
#define PG8_WAIT_L(n) asm volatile("s_waitcnt lgkmcnt(" #n ")" ::: "memory")
#define PG8_BAR __builtin_amdgcn_s_barrier()
#define PG8_SCHED __builtin_amdgcn_sched_barrier(0)
    Unit cur, nxt; int ui = 0;
    if (!S.next(0, cur)) return;
    f32x4 acc[2][2][4][2];
#pragma unroll
    for (int a = 0; a < 2; ++a)
#pragma unroll
        for (int b = 0; b < 2; ++b)
#pragma unroll
            for (int m = 0; m < 4; ++m)
#pragma unroll
                for (int n = 0; n < 2; ++n) acc[a][b][m][n] = (f32x4){0.f, 0.f, 0.f, 0.f};
    bf16x8 At[4][2], B0[2][2], B1[2][2];
    const char* cA = (const char*)g.A + (size_t)cur.pm * tstep; const char* cB = (const char*)g.Bt + (size_t)cur.pn * tstep;
    PG8_STAGE(PG8_SB(0, 0), cB, voffB); PG8_STAGE(PG8_SA(0, 0), cA, voffA); PG8_STAGE(PG8_SB(0, 1), cB + hstep, voffB); PG8_STAGE(PG8_SA(0, 1), cA + hstep, voffA);
    if (wr == 1) PG8_BAR;
    PG8_WAIT_V(4); PG8_BAR;
    PG8_STAGE(PG8_SB(1, 0), cB + kstep, voffB); PG8_STAGE(PG8_SA(1, 0), cA + kstep, voffA); PG8_STAGE(PG8_SB(1, 1), cB + hstep + kstep, voffB);
    PG8_WAIT_V(6); PG8_BAR;
    for (;;) {
        const bool has_next = S.next(ui + 1, nxt);
        const char* nA = has_next ? (const char*)g.A + (size_t)nxt.pm * tstep : cA; const char* nB = has_next ? (const char*)g.Bt + (size_t)nxt.pn * tstep : cB;
        for (int t = 0; t < nt; t += 2) {
            const bool last = (t == nt - 2);
            const char* a1 = cA + (size_t)(t + 1) * kstep;
            const char* a2 = last ? nA : cA + (size_t)(t + 2) * kstep; const char* b2 = last ? nB : cB + (size_t)(t + 2) * kstep;
            const char* a3 = a2 + kstep; const char* b3 = b2 + kstep;
            PG8_LDB(B0, 0, 0); PG8_SCHED; PG8_LDA(At, 0, 0); PG8_STAGE(PG8_SA(1, 1), a1 + hstep, voffA);
            PG8_WAIT_L(8); PG8_BAR; PG8_WAIT_L(0); PG8_MMA(0, 0, At, B0); PG8_BAR; PG8_SCHED;
            PG8_LDB(B1, 0, 1); PG8_STAGE(PG8_SB(0, 0), b2, voffB);
            PG8_BAR; PG8_WAIT_L(0); PG8_MMA(0, 1, At, B1); PG8_BAR;
            PG8_LDA(At, 0, 1); PG8_STAGE(PG8_SA(0, 0), a2, voffA);
            PG8_BAR; PG8_WAIT_L(0); PG8_MMA(1, 0, At, B0); PG8_BAR; PG8_SCHED;
            PG8_STAGE(PG8_SB(0, 1), b2 + hstep, voffB);
            PG8_WAIT_V(6); PG8_BAR; PG8_MMA(1, 1, At, B1); PG8_BAR;
            PG8_LDB(B0, 1, 0); PG8_SCHED; PG8_LDA(At, 1, 0); PG8_STAGE(PG8_SA(0, 1), a2 + hstep, voffA);
            PG8_WAIT_L(8); PG8_BAR; PG8_WAIT_L(0); PG8_MMA(0, 0, At, B0); PG8_BAR; PG8_SCHED;
            PG8_LDB(B1, 1, 1); PG8_STAGE(PG8_SB(1, 0), b3, voffB);
            PG8_BAR; PG8_WAIT_L(0); PG8_MMA(0, 1, At, B1); PG8_BAR;
            PG8_LDA(At, 1, 1); PG8_STAGE(PG8_SA(1, 0), a3, voffA);
            PG8_BAR; PG8_WAIT_L(0); PG8_MMA(1, 0, At, B0); PG8_BAR; PG8_SCHED;
            PG8_STAGE(PG8_SB(1, 1), b3 + hstep, voffB);
            PG8_WAIT_V(6); PG8_BAR; PG8_MMA(1, 1, At, B1); PG8_BAR;
        }
        E(acc, cur, wr, wc, fr, fq);
        if (!has_next) break;
#pragma unroll
        for (int a = 0; a < 2; ++a)
#pragma unroll
            for (int b = 0; b < 2; ++b)
#pragma unroll
                for (int m = 0; m < 4; ++m)
#pragma unroll
                    for (int n = 0; n < 2; ++n) acc[a][b][m][n] = (f32x4){0.f, 0.f, 0.f, 0.f};
        cur = nxt; cA = nA; cB = nB; ++ui;
    }
    PG8_WAIT_V(0);
    if (wr == 0) PG8_BAR;
    PG8_BAR;
#undef PG8_SA
#undef PG8_SB
#undef PG8_STAGE
#undef PG8_LDA
#undef PG8_LDB
#undef PG8_MMA
#undef PG8_WAIT_V
#undef PG8_WAIT_L
#undef PG8_BAR
#undef PG8_SCHED
}
}

DI int win_src_col(int n0) {
    if (n0 < 2048) return n0;
    if (n0 < 2560) return 2056 + (n0 - 2048);
    if (n0 < 3072) return 3592 + (n0 - 2560);
    if (n0 < 3584) return 2568 + (n0 - 3072);
    return 3080 + (n0 - 3584);
}
DI void phase_prep(const Params& p, LAS unsigned char* lds) {
    int tid = threadIdx.x; asm volatile("" : "+v"(tid));
    const int lane = tid & 63, wid = tid >> 6;
    if (blockIdx.x == 0 && wid == 0) {
        float a = p.lq1[lane] * p.lk1[lane], b = p.lq2[lane] * p.lk2[lane];
        a = wave_sum(a); b = wave_sum(b);
        if (lane == 0) { *(float*)(p.ws + OFF_MISC) = expf(a) - expf(b) + 0.2f; *(unsigned*)(p.ws + OFF_MISC + 4) = 0u; *(unsigned*)(p.ws + OFF_MISC + 8) = 0u; *(unsigned*)(p.ws + OFF_MISC + 12) = 0u; }
    }
    bf16_t* hb = (bf16_t*)(p.ws + OFF_HB);
    float* gbga = (float*)(p.ws + OFF_GBGA);
    const int gw = blockIdx.x * 8 + wid, nw = gridDim.x * 8;
    {
        f32x4 nwv[4]; float wq[16][8];
#pragma unroll
        for (int i = 0; i < 4; ++i) {
            nwv[i] = ((const f32x4*)p.norm_w)[lane + 64 * i];
#pragma unroll
            for (int e = 0; e < 4; ++e) {
                const int k = 4 * (lane + 64 * i) + e;
                const f32x4* wp = (const f32x4*)(p.w_in + (size_t)k * 4104 + 2048);
                const f32x4 w0 = wp[0], w1 = wp[1];
#pragma unroll
                for (int j = 0; j < 4; ++j) { wq[4 * i + e][j] = nwv[i][e] * w0[j]; wq[4 * i + e][4 + j] = nwv[i][e] * w1[j]; }
            }
        }
        const bool b5 = (lane & 32) != 0, b4 = (lane & 16) != 0, b3 = (lane & 8) != 0;
        const int col = (b5 ? 4 : 0) + (b4 ? 2 : 0) + (b3 ? 1 : 0);
        int row = gw;
        f32x4 v[4];
        if (row < MTOK) {
#pragma unroll
            for (int i = 0; i < 4; ++i) v[i] = ((const f32x4*)(p.x + (size_t)row * DM))[lane + 64 * i];
        }
#pragma unroll 1
        for (; row < MTOK; row += nw) {
            f32x4 vnx[4];
            const int rnx = (row + nw < MTOK) ? row + nw : row;
#pragma unroll
            for (int i = 0; i < 4; ++i) vnx[i] = ((const f32x4*)(p.x + (size_t)rnx * DM))[lane + 64 * i];
            float ss = 0.f, a8[8];
#pragma unroll
            for (int j = 0; j < 8; ++j) a8[j] = 0.f;
#pragma unroll
            for (int i = 0; i < 4; ++i)
#pragma unroll
                for (int e = 0; e < 4; ++e) {
                    ss += v[i][e] * v[i][e];
#pragma unroll
                    for (int j = 0; j < 8; ++j) a8[j] += v[i][e] * wq[4 * i + e][j];
                }
            ss = wave_sum(ss);
            const float rstd = rsqrtf(ss * (1.0f / DM) + EPS);
#pragma unroll
            for (int i = 0; i < 4; ++i) {
                const f32x4 h = v[i] * rstd * nwv[i];
                u32x2 w; w.x = pk_bf16(h[0], h[1]); w.y = pk_bf16(h[2], h[3]);
                *(u32x2*)(hb + (size_t)row * DM + 4 * (lane + 64 * i)) = w;
            }
            float c4[4], c2[2], c1;
#pragma unroll
            for (int j = 0; j < 4; ++j) { const float send = b5 ? a8[j] : a8[4 + j], keep = b5 ? a8[4 + j] : a8[j]; c4[j] = keep + __shfl_xor(send, 32); }
#pragma unroll
            for (int j = 0; j < 2; ++j) { const float send = b4 ? c4[j] : c4[2 + j], keep = b4 ? c4[2 + j] : c4[j]; c2[j] = keep + __shfl_xor(send, 16); }
            { const float send = b3 ? c2[0] : c2[1], keep = b3 ? c2[1] : c2[0]; c1 = keep + __shfl_xor(send, 8); }
            c1 += __shfl_xor(c1, 4); c1 += __shfl_xor(c1, 2); c1 += __shfl_xor(c1, 1);
            if ((lane & 7) == 0) gbga[(size_t)row * 8 + col] = c1 * rstd;
#pragma unroll
            for (int i = 0; i < 4; ++i) v[i] = vnx[i];
        }
    }
    LAS float* tl = (LAS float*)lds;
    for (int tile = blockIdx.x; tile < 1024 + 256; tile += gridDim.x) {
        const float* src; int ld, n0, k0, srcn0; bf16_t* dst;
        if (tile < 1024) { n0 = (tile >> 4) * 64; k0 = (tile & 15) * 64; srcn0 = win_src_col(n0); src = p.w_in; ld = 4104; dst = (bf16_t*)(p.ws + OFF_WINT); }
        else { const int t2 = tile - 1024; n0 = (t2 >> 4) * 64; k0 = (t2 & 15) * 64; srcn0 = n0; src = p.w_out; ld = 1024; dst = (bf16_t*)(p.ws + OFF_WOUTT); }
        const int kk = tid >> 4, n4 = tid & 15;
#pragma unroll
        for (int ps = 0; ps < 2; ++ps) { const int k = kk + 32 * ps;
            const f32x4 v = *(const f32x4*)(src + (size_t)(k0 + k) * ld + srcn0 + 4 * n4);
#pragma unroll
            for (int e = 0; e < 4; ++e) tl[k * 65 + 4 * n4 + e] = v[e]; }
        __syncthreads();
        { const int n = tid >> 3, k8 = tid & 7; float f[8];
#pragma unroll
            for (int e = 0; e < 8; ++e) f[e] = tl[(8 * k8 + e) * 65 + n];
            u32x4 w; w.x = pk_bf16(f[0], f[1]); w.y = pk_bf16(f[2], f[3]); w.z = pk_bf16(f[4], f[5]); w.w = pk_bf16(f[6], f[7]);
            *(u32x4*)(dst + (size_t)(n0 + n) * 1024 + k0 + 8 * k8) = w; }
        __syncthreads();
    }
}

constexpr int AT_KB = 8192, AT_VB = 16384, AT_BUF = AT_KB + AT_VB, AT_NBUF = 3, AT_TASK = AT_NBUF * AT_BUF, AT_O1 = AT_TASK + 256;

DI void attn_qblock(const Params& p, LAS unsigned char* lds, int b, int hh, int qb, float lam) {
    int tid = threadIdx.x; asm volatile("" : "+v"(tid));
    const int lane = tid & 63, wid = __builtin_amdgcn_readfirstlane(tid >> 6);
    const bf16_t* P1 = (const bf16_t*)(p.ws + OFF_P1);
    const bf16_t* VT = (const bf16_t*)(p.ws + OFF_VT) + (size_t)(b * 4 + hh) * 32 * 128 * 64;
    const bf16_t* KX = (const bf16_t*)(p.ws + OFF_KX) + (size_t)(b * 4 + hh) * 2 * 2048 * 64;
    bf16_t* mix = (bf16_t*)(p.ws + OFF_HB);
    const int q0 = qb * 256 + wid * 32;
    const size_t tokbase = (size_t)b * SEQ;
    const int nkt = (qb + 1) * 4;
    const float sl2 = exp2f(-2.0f * (float)(hh + 1)) * LOG2E;
    const float c1 = 0.125f * LOG2E;
#pragma unroll 1
    for (int map = 0; map < 2; ++map) {
        f32x16 O[4];
#pragma unroll
        for (int mt = 0; mt < 4; ++mt)
#pragma unroll
            for (int i = 0; i < 16; ++i) O[mt][i] = 0.f;
        float m = -INFINITY, l = 0.f;
        int lane_m = lane; asm volatile("" : "+v"(lane_m));
        const int r = lane_m & 31, h2 = lane_m >> 5;
        int foff[4];
#pragma unroll
        for (int k = 0; k < 4; ++k) foff[k] = r * 128 + (((2 * k + h2) ^ ((r >> 1) & 7)) << 4);
        float kb[16];
#pragma unroll
        for (int i = 0; i < 16; ++i) kb[i] = sl2 * (float)crow(i, h2);
        const int krow_ = 8 * wid + (lane_m >> 3), vrow0 = 16 * wid + (lane_m >> 3), vrow1 = vrow0 + 8;
        const bf16_t* kgp = KX + ((size_t)map * 2048 + krow_) * 64 + (((lane_m & 7) ^ ((krow_ >> 1) & 7)) * 8);
        const bf16_t* vgp0 = VT + (size_t)vrow0 * 64 + (((lane_m & 7) ^ ((vrow0 >> 1) & 7)) * 8);
        const bf16_t* vgp1 = VT + (size_t)vrow1 * 64 + (((lane_m & 7) ^ ((vrow1 >> 1) & 7)) * 8);
#define AT_STAGE(bufi, tile) do { LAS unsigned char* _b = lds + (bufi) * AT_BUF; \
            __builtin_amdgcn_global_load_lds((const unsigned*)(kgp + (size_t)(tile) * 64 * 64), (LAS unsigned*)(_b + wid * 1024), 16, 0, 0); \
            __builtin_amdgcn_global_load_lds((const unsigned*)(vgp0 + (size_t)(tile) * 128 * 64), (LAS unsigned*)(_b + AT_KB + wid * 2048), 16, 0, 0); \
            __builtin_amdgcn_global_load_lds((const unsigned*)(vgp1 + (size_t)(tile) * 128 * 64), (LAS unsigned*)(_b + AT_KB + wid * 2048 + 1024), 16, 0, 0); } while (0)
        bf16x8 qf[4];
        { const bf16_t* qp = P1 + (tokbase + q0 + (lane_m & 31)) * NP1 + C_DQ + hh * 128 + map * 64 + 8 * (lane_m >> 5);
#pragma unroll
            for (int ks = 0; ks < 4; ++ks) qf[ks] = *(const bf16x8*)(qp + 16 * ks); }
        AT_STAGE(0, 0);
        AT_STAGE(1, 1);
        asm volatile("" : "+v"(qf[0]), "+v"(qf[1]), "+v"(qf[2]), "+v"(qf[3]));
        int cb = 0;
#pragma unroll 1
        for (int kt = 0; kt < nkt; ++kt) {
            if (kt + 1 < nkt) asm volatile("s_waitcnt vmcnt(3)" ::: "memory"); else asm volatile("s_waitcnt vmcnt(0)" ::: "memory");
            __builtin_amdgcn_s_barrier();
            asm volatile("" ::: "memory");
            if (kt + 2 < nkt) { const int nb = cb == 0 ? 2 : cb - 1; AT_STAGE(nb, kt + 2); }
            const LAS unsigned char* cur = lds + cb * AT_BUF;
            cb = cb == 2 ? 0 : cb + 1;
            const int k0 = kt * 64;
            if (k0 <= q0) {
                const bool sub1 = (k0 + 32 <= q0);
                const LAS unsigned char* vb = cur + AT_KB;
                bf16x8 kf[8];
#pragma unroll
                for (int ks = 0; ks < 4; ++ks) kf[ks] = *(const LAS bf16x8*)(cur + foff[ks]);
                if (sub1) {
#pragma unroll
                    for (int ks = 0; ks < 4; ++ks) kf[4 + ks] = *(const LAS bf16x8*)(cur + 4096 + foff[ks]);
                }
                f32x16 s0, s1;
#pragma unroll
                for (int i = 0; i < 16; ++i) { s0[i] = 0.f; s1[i] = 0.f; }
#pragma unroll
                for (int ks = 0; ks < 4; ++ks) s0 = MFMA32(kf[ks], qf[ks], s0);
                if (sub1) {
#pragma unroll
                    for (int ks = 0; ks < 4; ++ks) s1 = MFMA32(kf[4 + ks], qf[ks], s1);
                }
                __builtin_amdgcn_sched_barrier(0);
                bf16x8 va[8];
#pragma unroll
                for (int s2 = 0; s2 < 2; ++s2)
#pragma unroll
                    for (int mt = 0; mt < 4; ++mt) va[s2 * 4 + mt] = *(const LAS bf16x8*)(vb + mt * 4096 + foff[s2]);
                __builtin_amdgcn_sched_barrier(0);
                const float off0 = sl2 * (float)(k0 - q0), off1 = off0 + 32.0f * sl2;
                const f32x2 c1v = {c1, c1};
#pragma unroll
                for (int j = 0; j < 8; ++j) {
                    const f32x2 kv = {kb[2 * j], kb[2 * j + 1]};
                    f32x2 a = {s0[2 * j], s0[2 * j + 1]}, c = {s1[2 * j], s1[2 * j + 1]};
                    a = __builtin_elementwise_fma(a, c1v, kv); c = __builtin_elementwise_fma(c, c1v, kv);
                    s0[2 * j] = a.x; s0[2 * j + 1] = a.y; s1[2 * j] = c.x; s1[2 * j + 1] = c.y;
                }
                if (k0 == q0) {
#pragma unroll
                    for (int i = 0; i < 16; ++i) if (crow(i, h2) > r) s0[i] = -INFINITY;
                }
                if (k0 + 32 == q0) {
#pragma unroll
                    for (int i = 0; i < 16; ++i) if (crow(i, h2) > r) s1[i] = -INFINITY;
                }
                float mx0 = fmaxf(s0[0], s0[1]), mx1 = fmaxf(s1[0], s1[1]);
#pragma unroll
                for (int j = 1; j < 8; ++j) { mx0 = fmaxf(fmaxf(s0[2 * j], s0[2 * j + 1]), mx0); mx1 = fmaxf(fmaxf(s1[2 * j], s1[2 * j + 1]), mx1); }
                float mx = sub1 ? fmaxf(mx0 + off0, mx1 + off1) : mx0 + off0;
                mx = fmaxf(mx, __shfl_xor(mx, 32));
                if (__builtin_amdgcn_ballot_w64(mx > m + 8.0f) != 0ull) {
                    const float mn = fmaxf(m, mx);
                    const float alpha = __builtin_amdgcn_exp2f(m - mn);
                    m = mn; l *= alpha;
#pragma unroll
                    for (int mt = 0; mt < 4; ++mt)
#pragma unroll
                        for (int i = 0; i < 16; ++i) O[mt][i] *= alpha;
                }
                const float r0 = m - off0, r1 = sub1 ? m - off1 : INFINITY;
                const f32x2 r0v = {r0, r0}, r1v = {r1, r1};
                f32x2 lsv = {0.f, 0.f};
#pragma unroll
                for (int j = 0; j < 8; ++j) {
                    f32x2 a = {s0[2 * j], s0[2 * j + 1]}, c = {s1[2 * j], s1[2 * j + 1]};
                    a = a - r0v; c = c - r1v;
                    a.x = __builtin_amdgcn_exp2f(a.x); a.y = __builtin_amdgcn_exp2f(a.y); c.x = __builtin_amdgcn_exp2f(c.x); c.y = __builtin_amdgcn_exp2f(c.y);
                    lsv = lsv + a; lsv = lsv + c;
                    s0[2 * j] = a.x; s0[2 * j + 1] = a.y; s1[2 * j] = c.x; s1[2 * j + 1] = c.y;
                }
                l += lsv.x + lsv.y;
                bf16x8 pf[4];
#pragma unroll
                for (int s = 0; s < 2; ++s) { pf[s] = pack8(s0, s); pf[2 + s] = pack8(s1, s); }
                __builtin_amdgcn_sched_barrier(0);
                bf16x8 vc[4], vd[4];
                if (sub1) {
#pragma unroll
                    for (int mt = 0; mt < 4; ++mt) vc[mt] = *(const LAS bf16x8*)(vb + mt * 4096 + foff[2]);
                }
#pragma unroll
                for (int mt = 0; mt < 4; ++mt) O[mt] = MFMA32(va[mt], pf[0], O[mt]);
                if (sub1) {
#pragma unroll
                    for (int mt = 0; mt < 4; ++mt) vd[mt] = *(const LAS bf16x8*)(vb + mt * 4096 + foff[3]);
                }
#pragma unroll
                for (int mt = 0; mt < 4; ++mt) O[mt] = MFMA32(va[4 + mt], pf[1], O[mt]);
                if (sub1) {
#pragma unroll
                    for (int mt = 0; mt < 4; ++mt) O[mt] = MFMA32(vc[mt], pf[2], O[mt]);
#pragma unroll
                    for (int mt = 0; mt < 4; ++mt) O[mt] = MFMA32(vd[mt], pf[3], O[mt]);
                }
            }
        }
        asm volatile("" ::: "memory");
        __builtin_amdgcn_s_barrier();
        asm volatile("" ::: "memory");
#undef AT_STAGE
        const float lt = l + __shfl_xor(l, 32);
        int lane_o = lane; asm volatile("" : "+v"(lane_o));
        LAS unsigned* o1l = (LAS unsigned*)(lds + AT_O1 + wid * 8192) + lane_o;
        if (map == 0) {
            const float inv1 = 1.0f / lt;
#pragma unroll
            for (int mt = 0; mt < 4; ++mt)
#pragma unroll
                for (int j = 0; j < 8; ++j) o1l[(mt * 8 + j) * 64] = pk_bf16(O[mt][2 * j] * inv1, O[mt][2 * j + 1] * inv1);
        } else {
            const float inv2 = lam / lt;
            float ss = 0.f;
#pragma unroll
            for (int mt = 0; mt < 4; ++mt)
#pragma unroll
                for (int j = 0; j < 8; ++j) {
                    const unsigned o1 = o1l[(mt * 8 + j) * 64];
                    const float a = bf_lo(o1) - O[mt][2 * j] * inv2, c = bf_hi(o1) - O[mt][2 * j + 1] * inv2;
                    O[mt][2 * j] = a; O[mt][2 * j + 1] = c; ss += a * a + c * c;
                }
            ss += __shfl_xor(ss, 32);
            const float rs = rsqrtf(ss * (1.0f / 128.0f) + EPS) * 0.8f;
#pragma unroll
            for (int mt = 0; mt < 4; ++mt)
#pragma unroll
                for (int j = 0; j < 8; ++j) o1l[(mt * 8 + j) * 64] = pk_bf16(O[mt][2 * j] * rs, O[mt][2 * j + 1] * rs);
            __builtin_amdgcn_wave_barrier();
            int lane_e = lane; asm volatile("" : "+v"(lane_e));
            const int dvg = lane_e & 15, qs = lane_e >> 4;
            const f32x4 nw0 = *(const f32x4*)(p.diff_norm_w + 8 * dvg), nw1 = *(const f32x4*)(p.diff_norm_w + 8 * dvg + 4);
            const LAS unsigned* ob = (const LAS unsigned*)(lds + AT_O1 + wid * 8192);
            const int slot = (dvg >> 2) * 8 + 2 * (dvg & 3);
            u32x4 dzv[8];
#pragma unroll
            for (int it = 0; it < 8; ++it) dzv[it] = *(const u32x4*)(P1 + (tokbase + q0 + it * 4 + qs) * NP1 + C_DZ + hh * 128 + 8 * dvg);
#pragma unroll
            for (int it = 0; it < 8; ++it) {
                const int q = it * 4 + qs; const size_t row = tokbase + q0 + q;
                const unsigned u0 = ob[slot * 64 + q], u1 = ob[(slot + 1) * 64 + q], u2 = ob[slot * 64 + q + 32], u3 = ob[(slot + 1) * 64 + q + 32];
                const u32x4 dz = dzv[it];
                u32x4 w;
                w.x = pk_bf16(bf_lo(u0) * nw0[0] * silu_f(bf_lo(dz.x)), bf_hi(u0) * nw0[1] * silu_f(bf_hi(dz.x)));
                w.y = pk_bf16(bf_lo(u1) * nw0[2] * silu_f(bf_lo(dz.y)), bf_hi(u1) * nw0[3] * silu_f(bf_hi(dz.y)));
                w.z = pk_bf16(bf_lo(u2) * nw1[0] * silu_f(bf_lo(dz.z)), bf_hi(u2) * nw1[1] * silu_f(bf_hi(dz.z)));
                w.w = pk_bf16(bf_lo(u3) * nw1[2] * silu_f(bf_lo(dz.w)), bf_hi(u3) * nw1[3] * silu_f(bf_hi(dz.w)));
                *(u32x4*)(mix + row * DM + 512 + hh * 128 + 8 * dvg) = w;
            }
            __builtin_amdgcn_wave_barrier();
        }
    }
}

DI void phase_attn(const Params& p, LAS unsigned char* lds, int rep) {
    const float lam = *(const float*)(p.ws + OFF_MISC);
    unsigned* counter = (unsigned*)(p.ws + OFF_MISC + 4 + 4 * rep);
    LAS int* tslot = (LAS int*)(lds + AT_TASK);
    for (;;) {
        if (threadIdx.x == 0) *tslot = (int)atomicAdd(counter, 1u);
        __syncthreads();
        const int t = *tslot;
        __syncthreads();
        if (t >= 512) break;
        const int qb = 7 - (t >> 6), bh = t & 63;
        attn_qblock(p, lds, bh >> 2, bh & 3, qb, lam);
    }
}


constexpr int G_QN = 0, G_KN = 17408, G_VB = 34816, G_KBG = 52224, G_M = 69632, G_T = 86016, G_SM = 95232;
DI bf16x8 tr_pair(const LAS unsigned char* lo_addr, int hi_off) {
    const s16x4 lo = __builtin_amdgcn_ds_read_tr16_b64_v4i16((LAS s16x4*)(lo_addr));
    const s16x4 hi = __builtin_amdgcn_ds_read_tr16_b64_v4i16((LAS s16x4*)(lo_addr + hi_off));
    return __builtin_shufflevector(lo, hi, 0, 1, 2, 3, 4, 5, 6, 7);
}
DI bf16_t bf16_1(float v) { return (bf16_t)(pk_bf16(v, 0.f) & 0xffffu); }

DI void gdn_prep(const Params& p, LAS unsigned char* lds, int c2) {
    int tid = threadIdx.x; asm volatile("" : "+v"(tid));
    const int lane = tid & 63, wid = __builtin_amdgcn_readfirstlane(tid >> 6), r = lane & 31, h2 = lane >> 5;
    const int b = c2 >> 7, hh = (c2 >> 5) & 3, n = c2 & 31;
    const size_t tok0 = (size_t)b * SEQ + (size_t)n * 64;
    const bf16_t* P1 = (const bf16_t*)(p.ws + OFF_P1);
    LAS float* sm = (LAS float*)(lds + G_SM);
    LAS float* Mf = (LAS float*)(lds + G_M);
    bf16_t* WN = (bf16_t*)(p.ws + OFF_WN) + (size_t)c2 * 8192;
    bf16_t* QD = (bf16_t*)(p.ws + OFF_QD) + (size_t)c2 * 8192;
    bf16_t* KD = (bf16_t*)(p.ws + OFF_KD) + (size_t)c2 * 8192;
    bf16_t* AQ = (bf16_t*)(p.ws + OFF_AQK) + (size_t)c2 * 4096;
    float* U = (float*)(p.ws + OFF_U) + (size_t)c2 * 8192;
    u32x4 raw[6][4];
#pragma unroll
    for (int i = 0; i < 6; ++i) {
        const int item = tid + 512 * i, g = item & 15, t = (item >> 4) & 63, part = i >> 1;
        const int ch = part * 512 + hh * 128 + g * 8;
#pragma unroll
        for (int j = 0; j < 4; ++j) {
            const int tt = n * 64 + t - 3 + j, ttc = tt < 0 ? 0 : tt;
            raw[i][j] = *(const u32x4*)(P1 + ((size_t)b * SEQ + ttc) * NP1 + ch);
            if (tt < 0) raw[i][j] = (u32x4){0u, 0u, 0u, 0u};
        }
    }
    if (wid == 0) {
        const float* gg = (const float*)(p.ws + OFF_GBGA) + (tok0 + lane) * 8;
        const float gbv = gg[hh], gav = gg[4 + hh];
        const float beta = 1.0f / (1.0f + expf(-gbv));
        const float xs = gav + p.dt_bias[hh];
        const float sp = fmaxf(xs, 0.f) + log1pf(expf(-fabsf(xs)));
        float gc = -expf(p.a_log[hh]) * sp;
#pragma unroll
        for (int o = 1; o < 64; o <<= 1) { const float t = __shfl_up(gc, o); if (lane >= o) gc += t; }
        const float gl = __shfl(gc, 63);
        sm[lane] = beta; sm[64 + lane] = gc * LOG2E; sm[128 + lane] = expf(gc); sm[192 + lane] = expf(gl - gc);
        if (lane == 63) ((float*)(p.ws + OFF_GL))[c2] = expf(gl);
    }
    float av[6][8];
#pragma unroll
    for (int i = 0; i < 6; ++i) {
        const int item = tid + 512 * i, g = item & 15, part = i >> 1;
        const int ch = part * 512 + hh * 128 + g * 8;
        float a[8];
#pragma unroll
        for (int e = 0; e < 8; ++e) a[e] = 0.f;
#pragma unroll
        for (int j = 0; j < 4; ++j) {
            const f32x4 w0 = *(const f32x4*)(p.conv_w + j * 1536 + ch), w1 = *(const f32x4*)(p.conv_w + j * 1536 + ch + 4);
            const u32x4 rw = raw[i][j];
            a[0] += w0[0] * bf_lo(rw.x); a[1] += w0[1] * bf_hi(rw.x); a[2] += w0[2] * bf_lo(rw.y); a[3] += w0[3] * bf_hi(rw.y);
            a[4] += w1[0] * bf_lo(rw.z); a[5] += w1[1] * bf_hi(rw.z); a[6] += w1[2] * bf_lo(rw.w); a[7] += w1[3] * bf_hi(rw.w);
        }
        float ss = 0.f;
#pragma unroll
        for (int e = 0; e < 8; ++e) { a[e] = silu_f(a[e]); ss += a[e] * a[e]; }
        float rn = 1.0f;
        if (part < 2) {
            ss += __shfl_xor(ss, 1); ss += __shfl_xor(ss, 2); ss += __shfl_xor(ss, 4); ss += __shfl_xor(ss, 8);
            rn = rsqrtf(ss + 1e-6f) * (part == 0 ? 0.08838834764831845f : 1.0f);
        }
#pragma unroll
        for (int e = 0; e < 8; ++e) av[i][e] = a[e] * rn;
    }
    __syncthreads();
#pragma unroll
    for (int i = 0; i < 6; ++i) {
        const int item = tid + 512 * i, g = item & 15, t = (item >> 4) & 63, part = i >> 1;
        const float* a = av[i];
        const float beta = sm[t], egc = sm[128 + t], ekd = sm[192 + t];
        if (part < 2) {
            u32x4 w; w.x = pk_bf16(a[0], a[1]); w.y = pk_bf16(a[2], a[3]); w.z = pk_bf16(a[4], a[5]); w.w = pk_bf16(a[6], a[7]);
            *(LAS u32x4*)(lds + (part == 0 ? G_QN : G_KN) + t * 272 + g * 16) = w;
            if (part == 0) {
                u32x2 lo, hi; lo.x = pk_bf16(a[0] * egc, a[1] * egc); lo.y = pk_bf16(a[2] * egc, a[3] * egc); hi.x = pk_bf16(a[4] * egc, a[5] * egc); hi.y = pk_bf16(a[6] * egc, a[7] * egc);
                bf16_t* qd = QD + t * 128 + 16 * (g >> 1) + 4 * (g & 1);
                *(u32x2*)qd = lo; *(u32x2*)(qd + 8) = hi;
            } else {
                const float f1 = beta * egc;
                u32x4 w2; w2.x = pk_bf16(a[0] * f1, a[1] * f1); w2.y = pk_bf16(a[2] * f1, a[3] * f1); w2.z = pk_bf16(a[4] * f1, a[5] * f1); w2.w = pk_bf16(a[6] * f1, a[7] * f1);
                *(LAS u32x4*)(lds + G_KBG + t * 272 + g * 16) = w2;
                u32x4 w3; w3.x = pk_bf16(a[0] * ekd, a[1] * ekd); w3.y = pk_bf16(a[2] * ekd, a[3] * ekd); w3.z = pk_bf16(a[4] * ekd, a[5] * ekd); w3.w = pk_bf16(a[6] * ekd, a[7] * ekd);
                *(u32x4*)(KD + t * 128 + g * 8) = w3;
            }
        } else {
            u32x4 w; w.x = pk_bf16(a[0] * beta, a[1] * beta); w.y = pk_bf16(a[2] * beta, a[3] * beta); w.z = pk_bf16(a[4] * beta, a[5] * beta); w.w = pk_bf16(a[6] * beta, a[7] * beta);
            *(LAS u32x4*)(lds + G_VB + t * 272 + g * 16) = w;
        }
    }
    __syncthreads();
    {
        const int w4 = wid & 3, mt = w4 >> 1, nt = w4 & 1; const bool isqk = wid >= 4;
        if (!(mt == 0 && nt == 1)) {
            const LAS unsigned char* Ab = lds + (isqk ? G_QN : G_KN) + (32 * mt + r) * 272 + 16 * h2;
            const LAS unsigned char* Bb = lds + G_KN + (32 * nt + r) * 272 + 16 * h2;
            f32x16 X;
#pragma unroll
            for (int i = 0; i < 16; ++i) X[i] = 0.f;
#pragma unroll
            for (int ks = 0; ks < 8; ++ks) X = MFMA32(*(const LAS bf16x8*)(Ab + 32 * ks), *(const LAS bf16x8*)(Bb + 32 * ks), X);
            const int s = 32 * nt + r; const float gcs = sm[64 + s];
#pragma unroll
            for (int i = 0; i < 16; ++i) {
                const int c = 32 * mt + crow(i, h2);
                const float dec = __builtin_amdgcn_exp2f(sm[64 + c] - gcs);
                if (!isqk) Mf[c * 64 + s] = (c > s) ? sm[c] * X[i] * dec : 0.f;
                else AQ[c * 64 + perm23(s)] = bf16_1((c >= s) ? X[i] * dec : 0.f);
            }
        }
    }
    __syncthreads();
    if (wid == 0) {
        const int cc = r, hb = h2;
        const LAS float* Mb = Mf + (32 * hb) * 64 + 32 * hb;
        float T[32];
#pragma unroll
        for (int i = 0; i < 32; ++i) T[i] = 0.f;
#pragma unroll
        for (int i = 0; i < 32; ++i) {
            float a0 = (i == cc) ? 1.f : 0.f, a1 = 0.f, a2 = 0.f, a3 = 0.f;
#pragma unroll
            for (int s4 = 0; s4 < (i + 3) / 4; ++s4) {
                const f32x4 m4 = *(const LAS f32x4*)(Mb + i * 64 + 4 * s4);
                a0 -= m4[0] * T[4 * s4]; a1 -= m4[1] * T[4 * s4 + 1]; a2 -= m4[2] * T[4 * s4 + 2]; a3 -= m4[3] * T[4 * s4 + 3];
            }
            float acc = (a0 + a1) + (a2 + a3);
            if ((i & 3) == 3) asm volatile("" : "+v"(acc) :: "memory");
            T[i] = acc;
        }
        LAS bf16_t* Tb = (LAS bf16_t*)(lds + G_T);
#pragma unroll
        for (int i = 0; i < 32; ++i) {
            Tb[(32 * hb + i) * 72 + 32 * hb + cc] = bf16_1(T[i]);
            if (hb == 0) Tb[i * 72 + 32 + cc] = 0;
        }
        __builtin_amdgcn_wave_barrier();
        asm volatile("s_waitcnt lgkmcnt(0)" ::: "memory");
        const int i16 = lane & 15, q = i16 >> 2, pp = i16 & 3, blk = (lane >> 4) & 1;
        f32x16 Y;
#pragma unroll
        for (int i = 0; i < 16; ++i) Y[i] = 0.f;
#pragma unroll
        for (int ks = 0; ks < 2; ++ks) {
            const LAS float* mp = Mf + (32 + r) * 64 + 16 * ks + 8 * h2;
            const f32x4 m0 = *(const LAS f32x4*)mp, m1 = *(const LAS f32x4*)(mp + 4);
            u32x4 aw; aw.x = pk_bf16(m0[0], m0[1]); aw.y = pk_bf16(m0[2], m0[3]); aw.z = pk_bf16(m1[0], m1[1]); aw.w = pk_bf16(m1[2], m1[3]);
            const bf16x8 bfrag = tr_pair(lds + G_T + (16 * ks + 8 * h2 + q) * 144 + (16 * blk + 4 * pp) * 2, 4 * 144);
            Y = MFMA32(__builtin_bit_cast(bf16x8, aw), bfrag, Y);
        }
        f32x16 Z;
#pragma unroll
        for (int i = 0; i < 16; ++i) Z[i] = 0.f;
#pragma unroll
        for (int s = 0; s < 2; ++s) {
            const LAS unsigned char* tp = lds + G_T + (32 + r) * 144 + (32 + 16 * s + 4 * h2) * 2;
            const u32x2 lo = *(const LAS u32x2*)tp, hi = *(const LAS u32x2*)(tp + 16);
            u32x4 aw; aw.x = lo.x; aw.y = lo.y; aw.z = hi.x; aw.w = hi.y;
            Z = MFMA32(__builtin_bit_cast(bf16x8, aw), pack8(Y, s), Z);
        }
#pragma unroll
        for (int i = 0; i < 16; ++i) Tb[(32 + crow(i, h2)) * 72 + r] = bf16_1(-Z[i]);
    }
    __syncthreads();
    {
        const int mt = wid >> 2, nt = wid & 3;
        const int i16 = lane & 15, q = i16 >> 2, pp = i16 & 3, blk = (lane >> 4) & 1;
        f32x16 Xu, Xw;
#pragma unroll
        for (int i = 0; i < 16; ++i) { Xu[i] = 0.f; Xw[i] = 0.f; }
#pragma unroll
        for (int ks = 0; ks < 4; ++ks) {
            if (ks < 2 * (mt + 1)) {
                const bf16x8 af = *(const LAS bf16x8*)(lds + G_T + (32 * mt + r) * 144 + (16 * ks + 8 * h2) * 2);
                const int boff = (16 * ks + 8 * h2 + q) * 272 + (32 * nt + 16 * blk + 4 * pp) * 2;
                Xu = MFMA32(af, tr_pair(lds + G_VB + boff, 4 * 272), Xu);
                Xw = MFMA32(af, tr_pair(lds + G_KBG + boff, 4 * 272), Xw);
            }
        }
        const int d = 32 * nt + r, dp = perm23(d);
        {
            float* up = U + ((nt * 2 + mt) * 64 + lane) * 16;
#pragma unroll
            for (int k = 0; k < 4; ++k) { const f32x4 v = {Xu[4 * k], Xu[4 * k + 1], Xu[4 * k + 2], Xu[4 * k + 3]}; *(f32x4*)(up + 4 * k) = v; }
        }
#pragma unroll
        for (int i = 0; i < 16; ++i) {
            const int c = 32 * mt + crow(i, h2);
            WN[c * 128 + dp] = bf16_1(-Xw[i]);
        }
    }
    __syncthreads();
}

constexpr int S_WN = 0, S_QD = 17408, S_KD = 34816, S_AQ = 52224, S_BUF = 61440, S_STG = 2 * S_BUF;

struct GateIn { u32x4 z0, z1; };
DI void scan_gate_load(const Params& p, int tid, int b, int hh, int n, GateIn& g) {
    const int gc_ = tid >> 3, seg = tid & 7;
    const bf16_t* P1 = (const bf16_t*)(p.ws + OFF_P1);
    const size_t row = (size_t)b * SEQ + n * 64 + gc_;
    g.z0 = *(const u32x4*)(P1 + row * NP1 + C_GZ + hh * 128 + seg * 16); g.z1 = *(const u32x4*)(P1 + row * NP1 + C_GZ + hh * 128 + seg * 16 + 8);
}
DI void scan_gate(const Params& p, LAS unsigned char* lds, int tid, int b, int hh, int n, const GateIn& g) {
    const int gc_ = tid >> 3, seg = tid & 7;
    bf16_t* mix = (bf16_t*)(p.ws + OFF_HB);
    const LAS float* st = (const LAS float*)(lds + S_STG) + gc_ * 132 + seg * 16;
    f32x4 ov[4]; float ss = 0.f;
#pragma unroll
    for (int k = 0; k < 4; ++k) { ov[k] = *(const LAS f32x4*)(st + 4 * k); ss += ov[k][0] * ov[k][0] + ov[k][1] * ov[k][1] + ov[k][2] * ov[k][2] + ov[k][3] * ov[k][3]; }
    ss += __shfl_xor(ss, 1); ss += __shfl_xor(ss, 2); ss += __shfl_xor(ss, 4);
    const float rstd = rsqrtf(ss * (1.0f / 128.0f) + EPS);
    const size_t row = (size_t)b * SEQ + n * 64 + gc_;
    const u32x4 z0 = g.z0, z1 = g.z1;
    f32x4 gnw[4];
#pragma unroll
    for (int k = 0; k < 4; ++k) gnw[k] = *(const f32x4*)(p.gdn_norm_w + seg * 16 + 4 * k);
    u32x4 w0, w1;
    w0.x = pk_bf16(ov[0][0] * rstd * gnw[0][0] * silu_f(bf_lo(z0.x)), ov[0][1] * rstd * gnw[0][1] * silu_f(bf_hi(z0.x)));
    w0.y = pk_bf16(ov[0][2] * rstd * gnw[0][2] * silu_f(bf_lo(z0.y)), ov[0][3] * rstd * gnw[0][3] * silu_f(bf_hi(z0.y)));
    w0.z = pk_bf16(ov[1][0] * rstd * gnw[1][0] * silu_f(bf_lo(z0.z)), ov[1][1] * rstd * gnw[1][1] * silu_f(bf_hi(z0.z)));
    w0.w = pk_bf16(ov[1][2] * rstd * gnw[1][2] * silu_f(bf_lo(z0.w)), ov[1][3] * rstd * gnw[1][3] * silu_f(bf_hi(z0.w)));
    w1.x = pk_bf16(ov[2][0] * rstd * gnw[2][0] * silu_f(bf_lo(z1.x)), ov[2][1] * rstd * gnw[2][1] * silu_f(bf_hi(z1.x)));
    w1.y = pk_bf16(ov[2][2] * rstd * gnw[2][2] * silu_f(bf_lo(z1.y)), ov[2][3] * rstd * gnw[2][3] * silu_f(bf_hi(z1.y)));
    w1.z = pk_bf16(ov[3][0] * rstd * gnw[3][0] * silu_f(bf_lo(z1.z)), ov[3][1] * rstd * gnw[3][1] * silu_f(bf_hi(z1.z)));
    w1.w = pk_bf16(ov[3][2] * rstd * gnw[3][2] * silu_f(bf_lo(z1.w)), ov[3][3] * rstd * gnw[3][3] * silu_f(bf_hi(z1.w)));
    bf16_t* mp = mix + row * DM + hh * 128 + seg * 16;
    *(u32x4*)mp = w0; *(u32x4*)(mp + 8) = w1;
}

struct ScanRegs { u32x4 t0[4], t1[4], t2[4], t3[2]; };
DI void scan_fetch(ScanRegs& R, const bf16_t* WN, const bf16_t* QD, const bf16_t* KD, const bf16_t* AQ, int ltid) {
#pragma unroll
    for (int i = 0; i < 4; ++i) { const int pi = ltid + 256 * i; R.t0[i] = *(const u32x4*)(WN + pi * 8); R.t1[i] = *(const u32x4*)(QD + pi * 8); R.t2[i] = *(const u32x4*)(KD + pi * 8); }
#pragma unroll
    for (int i = 0; i < 2; ++i) { const int pi = ltid + 256 * i; R.t3[i] = *(const u32x4*)(AQ + pi * 8); }
}
DI void scan_put(const ScanRegs& R, LAS unsigned char* dst, int ltid) {
#pragma unroll
    for (int i = 0; i < 4; ++i) { const int pi = ltid + 256 * i, row = pi >> 4, pc = pi & 15;
        *(LAS u32x4*)(dst + S_WN + row * 272 + pc * 16) = R.t0[i]; *(LAS u32x4*)(dst + S_QD + row * 272 + pc * 16) = R.t1[i]; *(LAS u32x4*)(dst + S_KD + row * 272 + pc * 16) = R.t2[i]; }
#pragma unroll
    for (int i = 0; i < 2; ++i) { const int pi = ltid + 256 * i, row = pi >> 3, pc = pi & 7; *(LAS u32x4*)(dst + S_AQ + row * 144 + pc * 16) = R.t3[i]; }
}

DI void gdn_scan(const Params& p, LAS unsigned char* lds, int bh) {
    int tid = threadIdx.x; asm volatile("" : "+v"(tid));
    const int lane = tid & 63, wid = __builtin_amdgcn_readfirstlane(tid >> 6), r = lane & 31, h2 = lane >> 5;
    const int b = bh >> 2, hh = bh & 3;
    const bf16_t* WN = (const bf16_t*)(p.ws + OFF_WN) + (size_t)bh * 32 * 8192;
    const bf16_t* QD = (const bf16_t*)(p.ws + OFF_QD) + (size_t)bh * 32 * 8192;
    const bf16_t* KD = (const bf16_t*)(p.ws + OFF_KD) + (size_t)bh * 32 * 8192;
    const bf16_t* AQ = (const bf16_t*)(p.ws + OFF_AQK) + (size_t)bh * 32 * 4096;
    const float* U = (const float*)(p.ws + OFF_U) + (size_t)bh * 32 * 8192;
    const float* GL = (const float*)(p.ws + OFF_GL) + bh * 32;
    if (wid >= 4) {
        const int ltid = tid & 255;
        ScanRegs R;
        scan_fetch(R, WN, QD, KD, AQ, ltid); scan_put(R, lds, ltid);
        scan_fetch(R, WN + 8192, QD + 8192, KD + 8192, AQ + 4096, ltid);
#pragma unroll 1
        for (int n = 0; n < 32; ++n) {
            __syncthreads();
            GateIn gi; scan_gate_load(p, tid, b, hh, n, gi);
            if (n + 1 < 32) scan_put(R, lds + ((n + 1) & 1) * S_BUF, ltid);
            if (n + 2 < 32) scan_fetch(R, WN + (size_t)(n + 2) * 8192, QD + (size_t)(n + 2) * 8192, KD + (size_t)(n + 2) * 8192, AQ + (size_t)(n + 2) * 4096, ltid);
            __syncthreads();
            scan_gate(p, lds, tid, b, hh, n, gi);
        }
    } else {
        const int i16 = lane & 15, q4 = i16 >> 2, pp = i16 & 3, blk = (lane >> 4) & 1;
        f32x16 St[4], u[2];
#pragma unroll
        for (int k = 0; k < 4; ++k)
#pragma unroll
            for (int i = 0; i < 16; ++i) St[k][i] = 0.f;
#pragma unroll
        for (int mt = 0; mt < 2; ++mt)
#pragma unroll
            for (int k = 0; k < 4; ++k) { const f32x4 v = *(const f32x4*)(U + ((wid * 2 + mt) * 64 + lane) * 16 + 4 * k); u[mt][4 * k] = v[0]; u[mt][4 * k + 1] = v[1]; u[mt][4 * k + 2] = v[2]; u[mt][4 * k + 3] = v[3]; }
#pragma unroll 1
        for (int n = 0; n < 32; ++n) {
            LAS unsigned char* buf = lds + (n & 1) * S_BUF;
            __syncthreads();
            GateIn gi; scan_gate_load(p, tid, b, hh, n, gi);
            const float egl = GL[n];
            f32x16 vn[2], o[2];
            vn[0] = u[0]; vn[1] = u[1];
#pragma unroll
            for (int mt = 0; mt < 2; ++mt)
#pragma unroll
                for (int i = 0; i < 16; ++i) o[mt][i] = 0.f;
#pragma unroll
            for (int ks = 0; ks < 8; ++ks) {
                const bf16x8 sf = pack8(St[ks >> 1], ks & 1);
#pragma unroll
                for (int mt = 0; mt < 2; ++mt) {
                    const bf16x8 wf = *(const LAS bf16x8*)(buf + S_WN + (32 * mt + r) * 272 + (16 * ks + 8 * h2) * 2);
                    vn[mt] = MFMA32(wf, sf, vn[mt]);
                    const bf16x8 qf = *(const LAS bf16x8*)(buf + S_QD + (32 * mt + r) * 272 + (16 * ks + 8 * h2) * 2);
                    o[mt] = MFMA32(qf, sf, o[mt]);
                }
                asm volatile("" ::: "memory");
            }
            bf16x8 vf[4];
#pragma unroll
            for (int k2 = 0; k2 < 4; ++k2) vf[k2] = pack8(vn[k2 >> 1], k2 & 1);
            {
                const int nn = (n + 1 < 32) ? n + 1 : n;
                const float* up = U + (size_t)nn * 8192 + ((wid * 2) * 64 + lane) * 16;
#pragma unroll
                for (int mt = 0; mt < 2; ++mt)
#pragma unroll
                    for (int k = 0; k < 4; ++k) { const f32x4 v = *(const f32x4*)(up + mt * 1024 + 4 * k); u[mt][4 * k] = v[0]; u[mt][4 * k + 1] = v[1]; u[mt][4 * k + 2] = v[2]; u[mt][4 * k + 3] = v[3]; }
            }
#pragma unroll
            for (int mt = 0; mt < 2; ++mt)
#pragma unroll
                for (int k2 = 0; k2 < 2 * (mt + 1); ++k2) {
                    const bf16x8 af = *(const LAS bf16x8*)(buf + S_AQ + (32 * mt + r) * 144 + (16 * k2 + 8 * h2) * 2);
                    o[mt] = MFMA32(af, vf[k2], o[mt]);
                }
            {
                LAS float* st = (LAS float*)(lds + S_STG);
#pragma unroll
                for (int mt = 0; mt < 2; ++mt)
#pragma unroll
                    for (int i = 0; i < 16; ++i) st[(32 * mt + crow(i, h2)) * 132 + 32 * wid + r] = o[mt][i];
            }
#pragma unroll
            for (int kt = 0; kt < 4; ++kt) {
#pragma unroll
                for (int i = 0; i < 16; ++i) St[kt][i] *= egl;
#pragma unroll
                for (int k2 = 0; k2 < 4; ++k2) {
                    const bf16x8 kf = tr_pair(buf + S_KD + (16 * k2 + 4 * h2 + q4) * 272 + (32 * kt + 16 * blk + 4 * pp) * 2, 8 * 272);
                    St[kt] = MFMA32(kf, vf[k2], St[kt]);
                }
                asm volatile("" ::: "memory");
            }
            __syncthreads();
            scan_gate(p, lds, tid, b, hh, n, gi);
        }
    }
    __syncthreads();
}

DI void zero_mix_half(const Params& p, int half) {
    bf16_t* mix = (bf16_t*)(p.ws + OFF_HB);
    const size_t n16 = (size_t)MTOK * 64;
    for (size_t i = (size_t)blockIdx.x * 512 + threadIdx.x; i < n16; i += (size_t)gridDim.x * 512) {
        const size_t row = i >> 6, pc = i & 63;
        *(u32x4*)(mix + row * DM + half * 512 + pc * 8) = (u32x4){0u, 0u, 0u, 0u};
    }
}

DI void phase_final(const Params& p) {
    int tid = threadIdx.x; asm volatile("" : "+v"(tid));
    const int lane = tid & 63, wid = tid >> 6;
    const float* rowsq = (const float*)(p.ws + OFF_ROWSQ);
    const int gw = blockIdx.x * 8 + wid, nw = gridDim.x * 8;
    f32x4 fw[4];
#pragma unroll
    for (int i = 0; i < 4; ++i) fw[i] = ((const f32x4*)p.final_norm_w)[lane + 64 * i];
    int row = gw;
    f32x4 y[4]; float sq = 0.f;
    if (row < MTOK) {
#pragma unroll
        for (int i = 0; i < 4; ++i) y[i] = ((const f32x4*)(p.out + (size_t)row * DM))[lane + 64 * i];
        sq = lane < 16 ? rowsq[(size_t)row * 16 + lane] : 0.f;
    }
#pragma unroll 1
    for (; row < MTOK; row += nw) {
        const int rnx = (row + nw < MTOK) ? row + nw : row;
        f32x4 yn[4];
#pragma unroll
        for (int i = 0; i < 4; ++i) yn[i] = ((const f32x4*)(p.out + (size_t)rnx * DM))[lane + 64 * i];
        const float sqn = lane < 16 ? rowsq[(size_t)rnx * 16 + lane] : 0.f;
        const float ss = wave_sum(sq);
        const float rstd = rsqrtf(ss * (1.0f / DM) + EPS);
        f32x4* o = (f32x4*)(p.out + (size_t)row * DM);
#pragma unroll
        for (int i = 0; i < 4; ++i) o[lane + 64 * i] = y[i] * rstd * fw[i];
#pragma unroll
        for (int i = 0; i < 4; ++i) y[i] = yn[i];
        sq = sqn;
    }
}

__global__ void __launch_bounds__(512) mega(Params p) {
    extern __shared__ __attribute__((aligned(16))) unsigned char shm[];
    LAS unsigned char* lds = (LAS unsigned char*)shm;
    cg::grid_group grid = cg::this_grid();
    volatile LAS unsigned* bst = (volatile LAS unsigned*)(lds + LDS_BYTES - 16);
    if (threadIdx.x < 2) bst[threadIdx.x] = 0u;
    __syncthreads();
    const XcdBarrier xb = xcd_barrier_post((unsigned*)(p.ws + OFF_BAR), bst);
    if (p.ws == nullptr) grid.sync();

#pragma unroll 1
    for (int rep = 0; rep < REP_PREP; ++rep) phase_prep(p, lds);
    xcd_barrier(xb);
#pragma unroll 1
    for (int rep = 0; rep < REP_G1; ++rep)
    {
        pg8::Gemm g{(const bf16_t*)(p.ws + OFF_HB), (const bf16_t*)(p.ws + OFF_WINT), MTOK, NG1, DM};
        pg8::StaticOrder S; S.init(g.M, g.N, (int)gridDim.x, (int)blockIdx.x);
        pg8::EpiP1 E{(bf16_t*)(p.ws + OFF_P1), NP1, (bf16_t*)(p.ws + OFF_KX)};
        pg8::gemm_phase<pg8::EpiP1, false>(lds, g, S, E);
        pg8::Gemm g2{(const bf16_t*)(p.ws + OFF_HB), (const bf16_t*)(p.ws + OFF_WINT) + (size_t)NG1 * DM, MTOK, 512, DM};
        pg8::StaticOrder S2; S2.init(g2.M, g2.N, (int)gridDim.x, (int)blockIdx.x);
        pg8::EpiVT E2{(bf16_t*)(p.ws + OFF_VT)};
        pg8::gemm_phase<pg8::EpiVT, true>(lds, g2, S2, E2);
    }
    xcd_barrier(xb);
#pragma unroll 1
    for (int rep = 0; rep < REP_GP; ++rep)
        for (int c2 = blockIdx.x; c2 < 2048; c2 += gridDim.x) gdn_prep(p, lds, c2);
    xcd_barrier(xb);
#pragma unroll 1
    for (int rep = 0; rep < REP_P3; ++rep) {
#pragma unroll 1
        for (int r2 = 0; r2 < REP_SCAN; ++r2)
            if (blockIdx.x < 64) gdn_scan(p, lds, blockIdx.x);
#if SCAN_SYNC
        xcd_barrier(xb);
#endif
        phase_attn(p, lds, rep);
#if REP_ATTN > 1
        xcd_barrier(xb);
        phase_attn(p, lds, 2);
#endif
#if REP_P3 > 1
        xcd_barrier(xb);
#endif
    }
    xcd_barrier(xb);
#pragma unroll 1
    for (int rep = 0; rep < REP_G2; ++rep)
    {
        pg8::Gemm g{(const bf16_t*)(p.ws + OFF_HB), (const bf16_t*)(p.ws + OFF_WOUTT), MTOK, DM, DM};
        pg8::StaticOrder S; S.init(g.M, g.N, (int)gridDim.x, (int)blockIdx.x);
        pg8::EpiOut E{p.x, p.out, (float*)(p.ws + OFF_ROWSQ)};
        pg8::gemm_phase<pg8::EpiOut, false>(lds, g, S, E);
    }
    xcd_barrier(xb);
    phase_final(p);
}

extern "C" void kernel_launch(void* const* d_in, const int* in_sizes, int n_in, void* d_out, int out_size, void* d_ws, size_t ws_size, hipStream_t stream) {
    static int grid = 0;
    if (grid == 0) {
        if (ws_size < WS_END) { fprintf(stderr, "kernel_launch: workspace too small (%zu < %zu)\n", ws_size, (size_t)WS_END); grid = -1; return; }
        int dev = 0, cus = 0, per_cu = 0;
        hipGetDevice(&dev);
        hipDeviceGetAttribute(&cus, hipDeviceAttributeMultiprocessorCount, dev);
        if (hipFuncSetAttribute((const void*)mega, hipFuncAttributeMaxDynamicSharedMemorySize, LDS_BYTES) != hipSuccess) { fprintf(stderr, "kernel_launch: hipFuncSetAttribute failed\n"); grid = -1; return; }
        if (hipOccupancyMaxActiveBlocksPerMultiprocessor(&per_cu, (const void*)mega, 512, LDS_BYTES) != hipSuccess || per_cu < 1) per_cu = 1;
        (void)hipGetLastError();
        grid = cus * (per_cu > 1 ? 1 : per_cu);
    }
    if (grid < 0) return;
    Params p{};
    p.x = (const float*)d_in[0]; p.norm_w = (const float*)d_in[1]; p.w_in = (const float*)d_in[2]; p.conv_w = (const float*)d_in[3];
    p.a_log = (const float*)d_in[4]; p.dt_bias = (const float*)d_in[5]; p.gdn_norm_w = (const float*)d_in[6];
    p.lq1 = (const float*)d_in[7]; p.lk1 = (const float*)d_in[8]; p.lq2 = (const float*)d_in[9]; p.lk2 = (const float*)d_in[10];
    p.diff_norm_w = (const float*)d_in[11]; p.w_out = (const float*)d_in[12]; p.final_norm_w = (const float*)d_in[13];
    p.out = (float*)d_out; p.ws = (unsigned char*)d_ws;
    if (hipMemsetAsync((unsigned char*)d_ws + OFF_BAR, 0, 16384, stream) != hipSuccess) { fprintf(stderr, "kernel_launch: hipMemsetAsync failed\n"); return; }
    void* args[] = {&p};
    hipError_t e = hipLaunchCooperativeKernel((const void*)mega, dim3(grid), dim3(512), args, LDS_BYTES, stream);
    if (e != hipSuccess) fprintf(stderr, "cooperative launch failed: %s (grid %d)\n", hipGetErrorString(e), grid);
}
```

```cpp
#include <hip/hip_runtime.h>
#include <hip/hip_cooperative_groups.h>
#include <cstdio>
namespace cg = cooperative_groups;

#ifndef ENABLE_ATTN
#define ENABLE_ATTN 1
#endif
#ifndef ENABLE_GDN
#define ENABLE_GDN 1
#endif
#ifndef REP_PREP
#define REP_PREP 1
#endif
#ifndef REP_G1
#define REP_G1 1
#endif
#ifndef REP_GP
#define REP_GP 1
#endif
#ifndef REP_P3
#define REP_P3 1
#endif
#ifndef REP_G2
#define REP_G2 1
#endif
#ifndef REP_SCAN
#define REP_SCAN 1
#endif
#ifndef SCAN_SYNC
#define SCAN_SYNC 0
#endif
#ifndef REP_ATTN
#define REP_ATTN 1
#endif

#define LAS __attribute__((address_space(3)))
#define DI __device__ __forceinline__
typedef unsigned short bf16_t;
typedef short bf16x8 __attribute__((ext_vector_type(8)));
typedef short s16x4 __attribute__((ext_vector_type(4)));
typedef float f32x2 __attribute__((ext_vector_type(2)));
typedef float f32x4 __attribute__((ext_vector_type(4)));
typedef float f32x16 __attribute__((ext_vector_type(16)));
typedef unsigned u32x2 __attribute__((ext_vector_type(2)));
typedef unsigned u32x4 __attribute__((ext_vector_type(4)));
typedef __bf16 bf16x2_t __attribute__((ext_vector_type(2)));

#define MFMA32(a, b, c) __builtin_amdgcn_mfma_f32_32x32x16_bf16((a), (b), (c), 0, 0, 0)

constexpr int NB = 16, SEQ = 2048, DM = 1024, MTOK = NB * SEQ, NP1 = 3072, NG1 = 3584;
constexpr int C_GQ = 0, C_GK = 512, C_GV = 1024, C_GZ = 1536, C_DQ = 2048, C_DZ = 2560;
constexpr float EPS = 1e-6f;
constexpr float LOG2E = 1.4426950408889634f;

constexpr size_t OFF_HB = 0;
constexpr size_t OFF_WINT = OFF_HB + (size_t)MTOK * DM * 2;
constexpr size_t OFF_WOUTT = OFF_WINT + (size_t)4096 * 1024 * 2;
constexpr size_t OFF_GBGA = OFF_WOUTT + (size_t)1024 * 1024 * 2;
constexpr size_t OFF_P1 = OFF_GBGA + (size_t)MTOK * 8 * 4;
constexpr size_t OFF_KX = OFF_P1 + (size_t)MTOK * NP1 * 2;
constexpr size_t OFF_VT = OFF_KX + (size_t)64 * 2 * 2048 * 64 * 2;
constexpr size_t OFF_WN = OFF_VT + (size_t)64 * 128 * 2048 * 2;
constexpr size_t OFF_QD = OFF_WN + (size_t)2048 * 64 * 128 * 2;
constexpr size_t OFF_KD = OFF_QD + (size_t)2048 * 64 * 128 * 2;
constexpr size_t OFF_AQK = OFF_KD + (size_t)2048 * 64 * 128 * 2;
constexpr size_t OFF_U = OFF_AQK + (size_t)2048 * 64 * 64 * 2;
constexpr size_t OFF_GL = OFF_U + (size_t)2048 * 64 * 128 * 4;
constexpr size_t OFF_ROWSQ = OFF_GL + 8192;
constexpr size_t OFF_MISC = OFF_ROWSQ + (size_t)MTOK * 16 * 4;
constexpr size_t OFF_YB = OFF_P1;
constexpr size_t OFF_BAR = OFF_MISC + 256;
constexpr size_t WS_END = OFF_BAR + 16384;

constexpr int LDS_BYTES = 156 * 1024;

struct Params {
    const float *x, *norm_w, *w_in, *conv_w, *a_log, *dt_bias, *gdn_norm_w, *lq1, *lk1, *lq2, *lk2, *diff_norm_w, *w_out, *final_norm_w;
    float* out; unsigned char* ws;
};

DI unsigned pk_bf16(float a, float b) { f32x2 v = {a, b}; bf16x2_t r = __builtin_convertvector(v, bf16x2_t); return __builtin_bit_cast(unsigned, r); }
DI float bf_lo(unsigned u) { return __uint_as_float(u << 16); }
DI float bf_hi(unsigned u) { return __uint_as_float(u & 0xffff0000u); }
DI float wave_sum(float v) {
#pragma unroll
    for (int o = 32; o; o >>= 1) v += __shfl_xor(v, o);
    return v;
}
DI float silu_f(float z) { return z * __builtin_amdgcn_rcpf(1.0f + __builtin_amdgcn_exp2f(-LOG2E * z)); }
DI int perm23(int t) { return (t & ~12) | ((t & 4) << 1) | ((t & 8) >> 1); }
DI int crow(int i, int h2) { return (i & 3) + 8 * (i >> 2) + 4 * h2; }
DI bf16x8 pack8(const f32x16& x, int s) {
    u32x4 w; w.x = pk_bf16(x[8 * s + 0], x[8 * s + 1]); w.y = pk_bf16(x[8 * s + 2], x[8 * s + 3]); w.z = pk_bf16(x[8 * s + 4], x[8 * s + 5]); w.w = pk_bf16(x[8 * s + 6], x[8 * s + 7]);
    return __builtin_bit_cast(bf16x8, w);
}


#define XB_TMO      128
#define XB_XCNT(j)  (256  + 64 * (j))
#define XB_XSUB(j)  (1280 + 64 * (j))
#define XB_XGEN(j)  (2304 + 64 * (j))
#define XB_TOP      3328
#define XB_TOPGEN   3392
#define XCD_BAR_WORDS 3456
#define XB_SPIN_CAP (1u << 18)
struct XcdBarrier { unsigned* bar; unsigned x; volatile LAS unsigned* st; };
DI unsigned xb_ld(unsigned* p)              { return __hip_atomic_load(p, __ATOMIC_RELAXED, __HIP_MEMORY_SCOPE_AGENT); }
DI unsigned xb_add(unsigned* p, unsigned v) { return __hip_atomic_fetch_add(p, v, __ATOMIC_RELAXED, __HIP_MEMORY_SCOPE_AGENT); }
DI unsigned xb_xcc_id() { return (unsigned)__builtin_amdgcn_s_getreg((3 << 11) | 20) & 0xFu; }
#define XB_SPIN(cond, bar) do { unsigned _sp = 0; while (cond) { __builtin_amdgcn_s_sleep(1); \
    if ((++_sp & 255u) == 0u) { if (xb_ld(&(bar)[XB_TMO])) break; if (_sp > XB_SPIN_CAP) { atomicAdd(&(bar)[XB_TMO], 1u); break; } } } } while (0)
DI XcdBarrier xcd_barrier_post(unsigned* bar, volatile LAS unsigned* st) {
    XcdBarrier b; b.bar = bar; b.x = xb_xcc_id(); b.st = st;
    if (threadIdx.x == 0) (void)xb_add(&bar[XB_XCNT(b.x)], 1u);
    return b;
}
DI void xcd_barrier_complete(unsigned* bar, unsigned x, unsigned& nloc, unsigned& nx) {
    const unsigned G = gridDim.x * gridDim.y * gridDim.z;
    unsigned sum, cnt, mine, sp = 0u;
    for (;;) {
        sum = 0u; cnt = 0u; mine = 0u;
#pragma unroll
        for (unsigned j = 0; j < 16; ++j) { const unsigned c = xb_ld(&bar[XB_XCNT(j)]); sum += c; cnt += (c > 0u) ? 1u : 0u; mine = (j == x) ? c : mine; }
        if (sum == G) break;
        __builtin_amdgcn_s_sleep(1);
        if ((++sp & 255u) == 0u) { if (xb_ld(&bar[XB_TMO])) break; if (sp > XB_SPIN_CAP) { atomicAdd(&bar[XB_TMO], 1u); break; } }
    }
    nloc = mine > 0u ? mine : 1u; nx = cnt > 0u ? cnt : 1u;
}
DI void xcd_barrier(const XcdBarrier& b) {
    asm volatile("s_waitcnt vmcnt(0)" ::: "memory");
    __syncthreads();
    if (threadIdx.x == 0) {
        unsigned* bar = b.bar;
        __builtin_amdgcn_s_waitcnt(0);
        unsigned nloc = b.st[0], nx = b.st[1];
        if (nloc == 0u) { xcd_barrier_complete(bar, b.x, nloc, nx); b.st[0] = nloc; b.st[1] = nx; }
        const unsigned old = xb_add(&bar[XB_XSUB(b.x)], 1u);
        const unsigned gen = old / nloc;
        if (old + 1u == (gen + 1u) * nloc) {
            __builtin_amdgcn_fence(__ATOMIC_RELEASE, "agent");
            asm volatile("s_waitcnt vmcnt(0)" ::: "memory");
            const unsigned og = xb_add(&bar[XB_TOP], 1u);
            const unsigned tg = og / nx;
            if (og + 1u == (tg + 1u) * nx) xb_add(&bar[XB_TOPGEN], 1u);
            else XB_SPIN(xb_ld(&bar[XB_TOPGEN]) == tg, bar);
            __builtin_amdgcn_fence(__ATOMIC_ACQUIRE, "agent");
            xb_add(&bar[XB_XGEN(b.x)], 1u);
            asm volatile("s_waitcnt vmcnt(0)" ::: "memory");
        } else {
            XB_SPIN(xb_ld(&bar[XB_XGEN(b.x)]) == gen, bar);
            __builtin_amdgcn_fence(__ATOMIC_ACQUIRE, "agent");
            asm volatile("s_waitcnt vmcnt(0)" ::: "memory");
        }
    }
    __syncthreads();
}

namespace pg8 {
constexpr int BM = 256, BK = 64, HALF = 128, HTB = HALF * BK * 2, STAGE_BYTES = 8 * HTB, NXCD = 8, WGM = 8;
DI int lds_byte(int r, int c) { const int st = (r >> 4) * 2 + (c >> 5), rr = r & 15, cc = c & 31, ob = rr * 64 + cc * 2; return st * 1024 + (ob ^ (((ob >> 9) & 1) << 5)); }
DI void stage_rc(int b, int& R, int& C) { const int st = b / 1024, sb = b % 1024, swz = sb ^ (((sb >> 9) & 1) << 5); R = (st >> 1) * 16 + swz / 64; C = (st & 1) * 32 + (swz % 64) / 2; }
DI int perm32(int rho) { const int n = rho >> 4, i = rho & 15; return 8 * (i >> 2) + 4 * n + (i & 3); }
struct Unit { int pm, pn; };
struct Gemm { const bf16_t* A; const bf16_t* Bt; int M, N, K; };
struct StaticOrder {
    int nM, nN, nwg, G, c, i0 = 0, imax = 1 << 30;
    DI void init(int M, int N, int G_, int c_) { nM = M / BM; nN = N / BM; nwg = nM * nN; G = G_; c = c_; }
    DI bool next(int i, Unit& u) const {
        if (i >= imax) return false;
        const long L = (long)(i + i0) * G + c; if (L >= nwg) return false;
        int wgid = (int)L; { const int q = nwg / NXCD, r = nwg % NXCD, xcd = wgid % NXCD, off = wgid / NXCD; wgid = (xcd < r ? xcd * (q + 1) : r * (q + 1) + (xcd - r) * q) + off; }
        const int nig = WGM * nN, gid = wgid / nig, fm = gid * WGM, gsz = (nM - fm) < WGM ? (nM - fm) : WGM;
        u.pm = fm + ((wgid % nig) % gsz); u.pn = (wgid % nig) / gsz; return true;
    }
    DI void a_ready(const Unit&) const {}
    DI void done(const Unit&) const {}
};

struct EpiP1 {
    static constexpr bool PERM = true, AFTER_DRAIN = false;
    bf16_t* O; int ldc; bf16_t* KX;
    DI void operator()(const f32x4 (&acc)[2][2][4][2], const Unit& u, int wr, int wc, int fr, int fq) const {
        const int row0 = u.pm * BM + wr * 64 + fr, col0 = u.pn * BM + wc * 32 + 8 * fq;
        if (u.pn >= 12) {
#pragma unroll
            for (int ai = 0; ai < 2; ++ai)
#pragma unroll
                for (int m = 0; m < 4; ++m) { const int row = row0 + ai * HALF + m * 16, b = row >> 11, tok = row & 2047;
#pragma unroll
                    for (int bj = 0; bj < 2; ++bj) { const f32x4 v0 = acc[ai][bj][m][0], v1 = acc[ai][bj][m][1];
                        const int c = col0 - 12 * BM + bj * HALF, hm = c >> 6, d = c & 63;
                        u32x4 w; w.x = pk_bf16(v0[0], v0[1]); w.y = pk_bf16(v0[2], v0[3]); w.z = pk_bf16(v1[0], v1[1]); w.w = pk_bf16(v1[2], v1[3]);
                        *(u32x4*)(KX + ((size_t)(b * 8 + hm) * 2048 + tok) * 64 + d) = w; } }
            return;
        }
#pragma unroll
        for (int ai = 0; ai < 2; ++ai)
#pragma unroll
            for (int m = 0; m < 4; ++m) { bf16_t* rowp = O + (size_t)(row0 + ai * HALF + m * 16) * ldc + col0;
#pragma unroll
                for (int bj = 0; bj < 2; ++bj) { const f32x4 v0 = acc[ai][bj][m][0], v1 = acc[ai][bj][m][1];
                    u32x4 w; w.x = pk_bf16(v0[0], v0[1]); w.y = pk_bf16(v0[2], v0[3]); w.z = pk_bf16(v1[0], v1[1]); w.w = pk_bf16(v1[2], v1[3]);
                    *(u32x4*)(rowp + bj * HALF) = w; } }
    }
};
struct EpiVT {
    static constexpr bool PERM = false, AFTER_DRAIN = false;
    bf16_t* VT;
    DI void operator()(const f32x4 (&acc)[2][2][4][2], const Unit& u, int wr, int wc, int fr, int fq) const {
#pragma unroll
        for (int ai = 0; ai < 2; ++ai)
#pragma unroll
            for (int m = 0; m < 4; ++m) {
                const int t = u.pm * BM + ai * HALF + wr * 64 + m * 16 + 4 * fq, b = t >> 11, tok = t & 2047, pos = perm23(tok);
#pragma unroll
                for (int bj = 0; bj < 2; ++bj)
#pragma unroll
                    for (int n = 0; n < 2; ++n) {
                        const int c = u.pn * BM + bj * HALF + wc * 32 + n * 16 + fr, hh = c >> 7, dv = c & 127;
                        const f32x4 v = acc[ai][bj][m][n];
                        u32x2 w; w.x = pk_bf16(v[0], v[1]); w.y = pk_bf16(v[2], v[3]);
                        *(u32x2*)(VT + (((size_t)((b * 4 + hh) * 32 + (pos >> 6)) * 128 + dv)) * 64 + (pos & 63)) = w;
                    }
            }
    }
};
struct EpiOutFused {
    static constexpr bool PERM = false, AFTER_DRAIN = true;
    const float* X; float* Out; float* rowsq; const float* fw; XcdBarrier xb;
    DI void operator()(const f32x4 (&)[2][2][4][2], const Unit&, int, int, int, int) const {}
    DI void fused(f32x4 (&acc)[2][2][4][2], const Unit& u, int wr, int wc, int fr, int fq) const {
        const int row0 = u.pm * BM + wr * 64 + fr, col0 = u.pn * BM + wc * 32 + 4 * fq;
#pragma unroll
        for (int ai = 0; ai < 2; ++ai)
#pragma unroll
            for (int m = 0; m < 4; ++m) {
                const int row = row0 + ai * HALF + m * 16; float ss = 0.f;
#pragma unroll
                for (int bj = 0; bj < 2; ++bj)
#pragma unroll
                    for (int n = 0; n < 2; ++n) {
                        const size_t o = (size_t)row * DM + col0 + bj * HALF + n * 16;
                        const f32x4 y = acc[ai][bj][m][n] + *(const f32x4*)(X + o);
                        acc[ai][bj][m][n] = y; ss += y[0] * y[0] + y[1] * y[1] + y[2] * y[2] + y[3] * y[3];
                    }
                ss += __shfl_xor(ss, 16); ss += __shfl_xor(ss, 32);
                if (fq == 0) rowsq[(size_t)row * 16 + u.pn * 4 + wc] = ss;
            }
        xcd_barrier(xb);
        f32x4 fwv[2][2];
#pragma unroll
        for (int bj = 0; bj < 2; ++bj)
#pragma unroll
            for (int n = 0; n < 2; ++n) fwv[bj][n] = *(const f32x4*)(fw + col0 + bj * HALF + n * 16);
#pragma unroll
        for (int ai = 0; ai < 2; ++ai)
#pragma unroll
            for (int m = 0; m < 4; ++m) {
                const int row = row0 + ai * HALF + m * 16;
                const f32x4* rq = (const f32x4*)(rowsq + (size_t)row * 16);
                const f32x4 q0 = rq[0], q1 = rq[1], q2 = rq[2], q3 = rq[3];
                const float tot = ((q0[0] + q0[1]) + (q0[2] + q0[3])) + ((q1[0] + q1[1]) + (q1[2] + q1[3])) + ((q2[0] + q2[1]) + (q2[2] + q2[3])) + ((q3[0] + q3[1]) + (q3[2] + q3[3]));
                const float rstd = rsqrtf(tot * (1.0f / DM) + EPS);
#pragma unroll
                for (int bj = 0; bj < 2; ++bj)
#pragma unroll
                    for (int n = 0; n < 2; ++n) {
                        const size_t o = (size_t)row * DM + col0 + bj * HALF + n * 16;
                        *(f32x4*)(Out + o) = acc[ai][bj][m][n] * rstd * fwv[bj][n];
                    }
            }
    }
};

template <class Epi, bool SWAP>
DI void gemm_phase(LAS unsigned char* lds, const Gemm g, const StaticOrder& S, const Epi& E) {
    int tid = threadIdx.x; asm volatile("" : "+v"(tid));
    const int wid = __builtin_amdgcn_readfirstlane(tid >> 6), lane = tid & 63, wr = wid >> 2, wc = wid & 3, fr = lane & 15, fq = lane >> 4;
    const int K = g.K, nt = K / BK;
    unsigned voffA[2], voffB[2];
#pragma unroll
    for (int i = 0; i < 2; ++i) { int R, C; stage_rc(tid * 16 + i * 8192, R, C); const int Rb = Epi::PERM ? ((R & ~31) + perm32(R & 31)) : R;
        voffA[i] = (unsigned)(R * K + C) * 2u; voffB[i] = (unsigned)(Rb * K + C) * 2u; }
    const size_t kstep = (size_t)(BK * 2);
    const size_t hstep = (size_t)HALF * K * 2;
    const size_t tstep = 2 * hstep;
    const unsigned ldsw = (unsigned)wid * 1024u;
    const int aoff = lds_byte(wr * 64 + fr, fq * 8), boff = lds_byte(wc * 32 + fr, fq * 8);
#define PG8_SA(b, h) (((b) * 2 + (h)) * HTB)
#define PG8_SB(b, h) ((4 + (b) * 2 + (h)) * HTB)
#define PG8_STAGE(bufoff, gbase, voff) do { _Pragma("unroll") for (int _i = 0; _i < 2; ++_i) \
        __builtin_amdgcn_global_load_lds((const unsigned*)((const char*)(gbase) + (voff)[_i]), (LAS unsigned*)(lds + (bufoff) + ldsw + _i * 8192), 16, 0, 0); } while (0)
#define PG8_LDA(dst, b, h) do { _Pragma("unroll") for (int m = 0; m < 4; ++m) _Pragma("unroll") for (int k = 0; k < 2; ++k) dst[m][k] = *(const LAS bf16x8*)(lds + PG8_SA(b, h) + aoff + m * 2048 + k * 1024); } while (0)
#define PG8_LDB(dst, b, h) do { _Pragma("unroll") for (int n = 0; n < 2; ++n) _Pragma("unroll") for (int k = 0; k < 2; ++k) dst[n][k] = *(const LAS bf16x8*)(lds + PG8_SB(b, h) + boff + n * 2048 + k * 1024); } while (0)
#define PG8_MMA(ai, bj, At, Bt) do { __builtin_amdgcn_s_setprio(1); _Pragma("unroll") for (int m = 0; m < 4; ++m) _Pragma("unroll") for (int n = 0; n < 2; ++n) _Pragma("unroll") for (int k = 0; k < 2; ++k) \
        acc[ai][bj][m][n] = SWAP ? __builtin_amdgcn_mfma_f32_16x16x32_bf16(At[m][k], Bt[n][k], acc[ai][bj][m][n], 0, 0, 0) \
                                 : __builtin_amdgcn_mfma_f32_16x16x32_bf16(Bt[n][k], At[m][k], acc[ai][bj][m][n], 0, 0, 0); __builtin_amdgcn_s_setprio(0); } while (0)
#define PG8_WAIT_V(n) asm volatile("s_waitcnt vmcnt(" #n ")" ::: "memory")
#define PG8_WAIT_L(n) asm volatile("s_waitcnt lgkmcnt(" #n ")" ::: "memory")
#define PG8_BAR __builtin_amdgcn_s_barrier()
#define PG8_SCHED __builtin_amdgcn_sched_barrier(0)
    Unit cur, nxt; int ui = 0;
    if (!S.next(0, cur)) return;
    f32x4 acc[2][2][4][2];
#pragma unroll
    for (int a = 0; a < 2; ++a)
#pragma unroll
        for (int b = 0; b < 2; ++b)
#pragma unroll
            for (int m = 0; m < 4; ++m)
#pragma unroll
                for (int n = 0; n < 2; ++n) acc[a][b][m][n] = (f32x4){0.f, 0.f, 0.f, 0.f};
    bf16x8 At[4][2], B0[2][2], B1[2][2];
    const char* cA = (const char*)g.A + (size_t)cur.pm * tstep; const char* cB = (const char*)g.Bt + (size_t)cur.pn * tstep;
    PG8_STAGE(PG8_SB(0, 0), cB, voffB); PG8_STAGE(PG8_SA(0, 0), cA, voffA); PG8_STAGE(PG8_SB(0, 1), cB + hstep, voffB); PG8_STAGE(PG8_SA(0, 1), cA + hstep, voffA);
    if (wr == 1) PG8_BAR;
    PG8_WAIT_V(4); PG8_BAR;
    PG8_STAGE(PG8_SB(1, 0), cB + kstep, voffB); PG8_STAGE(PG8_SA(1, 0), cA + kstep, voffA); PG8_STAGE(PG8_SB(1, 1), cB + hstep + kstep, voffB);
    PG8_WAIT_V(6); PG8_BAR;
    for (;;) {
        const bool has_next = S.next(ui + 1, nxt);
        const char* nA = has_next ? (const char*)g.A + (size_t)nxt.pm * tstep : cA; const char* nB = has_next ? (const char*)g.Bt + (size_t)nxt.pn * tstep : cB;
        for (int t = 0; t < nt; t += 2) {
            const bool last = (t == nt - 2);
            const char* a1 = cA + (size_t)(t + 1) * kstep;
            const char* a2 = last ? nA : cA + (size_t)(t + 2) * kstep; const char* b2 = last ? nB : cB + (size_t)(t + 2) * kstep;
            const char* a3 = a2 + kstep; const char* b3 = b2 + kstep;
            PG8_LDB(B0, 0, 0); PG8_SCHED; PG8_LDA(At, 0, 0); PG8_STAGE(PG8_SA(1, 1), a1 + hstep, voffA);
            PG8_WAIT_L(8); PG8_BAR; PG8_WAIT_L(0); PG8_MMA(0, 0, At, B0); PG8_BAR; PG8_SCHED;
            PG8_LDB(B1, 0, 1); PG8_STAGE(PG8_SB(0, 0), b2, voffB);
            PG8_BAR; PG8_WAIT_L(0); PG8_MMA(0, 1, At, B1); PG8_BAR;
            PG8_LDA(At, 0, 1); PG8_STAGE(PG8_SA(0, 0), a2, voffA);
            PG8_BAR; PG8_WAIT_L(0); PG8_MMA(1, 0, At, B0); PG8_BAR; PG8_SCHED;
            PG8_STAGE(PG8_SB(0, 1), b2 + hstep, voffB);
            PG8_WAIT_V(6); PG8_BAR; PG8_MMA(1, 1, At, B1); PG8_BAR;
            PG8_LDB(B0, 1, 0); PG8_SCHED; PG8_LDA(At, 1, 0); PG8_STAGE(PG8_SA(0, 1), a2 + hstep, voffA);
            PG8_WAIT_L(8); PG8_BAR; PG8_WAIT_L(0); PG8_MMA(0, 0, At, B0); PG8_BAR; PG8_SCHED;
            PG8_LDB(B1, 1, 1); PG8_STAGE(PG8_SB(1, 0), b3, voffB);
            PG8_BAR; PG8_WAIT_L(0); PG8_MMA(0, 1, At, B1); PG8_BAR;
            PG8_LDA(At, 1, 1); PG8_STAGE(PG8_SA(1, 0), a3, voffA);
            PG8_BAR; PG8_WAIT_L(0); PG8_MMA(1, 0, At, B0); PG8_BAR; PG8_SCHED;
            PG8_STAGE(PG8_SB(1, 1), b3 + hstep, voffB);
            PG8_WAIT_V(6); PG8_BAR; PG8_MMA(1, 1, At, B1); PG8_BAR;
        }
        if constexpr (!Epi::AFTER_DRAIN) E(acc, cur, wr, wc, fr, fq);
        if (!has_next) break;
#pragma unroll
        for (int a = 0; a < 2; ++a)
#pragma unroll
            for (int b = 0; b < 2; ++b)
#pragma unroll
                for (int m = 0; m < 4; ++m)
#pragma unroll
                    for (int n = 0; n < 2; ++n) acc[a][b][m][n] = (f32x4){0.f, 0.f, 0.f, 0.f};
        cur = nxt; cA = nA; cB = nB; ++ui;
    }
    PG8_WAIT_V(0);
    if (wr == 0) PG8_BAR;
    PG8_BAR;
    if constexpr (Epi::AFTER_DRAIN) E.fused(acc, cur, wr, wc, fr, fq);
#undef PG8_SA
#undef PG8_SB
#undef PG8_STAGE
#undef PG8_LDA
#undef PG8_LDB
#undef PG8_MMA
#undef PG8_WAIT_V
#undef PG8_WAIT_L
#undef PG8_BAR
#undef PG8_SCHED
}
}

DI int win_src_col(int n0) {
    if (n0 < 2048) return n0;
    if (n0 < 2560) return 2056 + (n0 - 2048);
    if (n0 < 3072) return 3592 + (n0 - 2560);
    if (n0 < 3584) return 2568 + (n0 - 3072);
    return 3080 + (n0 - 3584);
}
DI void phase_prep(const Params& p, LAS unsigned char* lds) {
    int tid = threadIdx.x; asm volatile("" : "+v"(tid));
    const int lane = tid & 63, wid = tid >> 6;
    if (blockIdx.x == 0 && wid == 0) {
        float a = p.lq1[lane] * p.lk1[lane], b = p.lq2[lane] * p.lk2[lane];
        a = wave_sum(a); b = wave_sum(b);
        if (lane == 0) { *(float*)(p.ws + OFF_MISC) = expf(a) - expf(b) + 0.2f; *(unsigned*)(p.ws + OFF_MISC + 4) = 0u; *(unsigned*)(p.ws + OFF_MISC + 8) = 0u; *(unsigned*)(p.ws + OFF_MISC + 12) = 0u; }
    }
    bf16_t* hb = (bf16_t*)(p.ws + OFF_HB);
    float* gbga = (float*)(p.ws + OFF_GBGA);
    const int gw = blockIdx.x * 8 + wid, nw = gridDim.x * 8;
    {
        f32x4 nwv[4]; float wq[16][8];
#pragma unroll
        for (int i = 0; i < 4; ++i) {
            nwv[i] = ((const f32x4*)p.norm_w)[lane + 64 * i];
#pragma unroll
            for (int e = 0; e < 4; ++e) {
                const int k = 4 * (lane + 64 * i) + e;
                const f32x4* wp = (const f32x4*)(p.w_in + (size_t)k * 4104 + 2048);
                const f32x4 w0 = wp[0], w1 = wp[1];
#pragma unroll
                for (int j = 0; j < 4; ++j) { wq[4 * i + e][j] = nwv[i][e] * w0[j]; wq[4 * i + e][4 + j] = nwv[i][e] * w1[j]; }
            }
        }
        const bool b5 = (lane & 32) != 0, b4 = (lane & 16) != 0, b3 = (lane & 8) != 0;
        const int col = (b5 ? 4 : 0) + (b4 ? 2 : 0) + (b3 ? 1 : 0);
        int row = gw;
        f32x4 v[4];
        if (row < MTOK) {
#pragma unroll
            for (int i = 0; i < 4; ++i) v[i] = ((const f32x4*)(p.x + (size_t)row * DM))[lane + 64 * i];
        }
#pragma unroll 1
        for (; row < MTOK; row += nw) {
            f32x4 vnx[4];
            const int rnx = (row + nw < MTOK) ? row + nw : row;
#pragma unroll
            for (int i = 0; i < 4; ++i) vnx[i] = ((const f32x4*)(p.x + (size_t)rnx * DM))[lane + 64 * i];
            float ss = 0.f, a8[8];
#pragma unroll
            for (int j = 0; j < 8; ++j) a8[j] = 0.f;
#pragma unroll
            for (int i = 0; i < 4; ++i)
#pragma unroll
                for (int e = 0; e < 4; ++e) {
                    ss += v[i][e] * v[i][e];
#pragma unroll
                    for (int j = 0; j < 8; ++j) a8[j] += v[i][e] * wq[4 * i + e][j];
                }
            ss = wave_sum(ss);
            const float rstd = rsqrtf(ss * (1.0f / DM) + EPS);
#pragma unroll
            for (int i = 0; i < 4; ++i) {
                const f32x4 h = v[i] * rstd * nwv[i];
                u32x2 w; w.x = pk_bf16(h[0], h[1]); w.y = pk_bf16(h[2], h[3]);
                *(u32x2*)(hb + (size_t)row * DM + 4 * (lane + 64 * i)) = w;
            }
            float c4[4], c2[2], c1;
#pragma unroll
            for (int j = 0; j < 4; ++j) { const float send = b5 ? a8[j] : a8[4 + j], keep = b5 ? a8[4 + j] : a8[j]; c4[j] = keep + __shfl_xor(send, 32); }
#pragma unroll
            for (int j = 0; j < 2; ++j) { const float send = b4 ? c4[j] : c4[2 + j], keep = b4 ? c4[2 + j] : c4[j]; c2[j] = keep + __shfl_xor(send, 16); }
            { const float send = b3 ? c2[0] : c2[1], keep = b3 ? c2[1] : c2[0]; c1 = keep + __shfl_xor(send, 8); }
            c1 += __shfl_xor(c1, 4); c1 += __shfl_xor(c1, 2); c1 += __shfl_xor(c1, 1);
            if ((lane & 7) == 0) gbga[(size_t)row * 8 + col] = c1 * rstd;
#pragma unroll
            for (int i = 0; i < 4; ++i) v[i] = vnx[i];
        }
    }
    LAS float* tl = (LAS float*)lds;
    for (int tile = blockIdx.x; tile < 1024 + 256; tile += gridDim.x) {
        const float* src; int ld, n0, k0, srcn0; bf16_t* dst;
        if (tile < 1024) { n0 = (tile >> 4) * 64; k0 = (tile & 15) * 64; srcn0 = win_src_col(n0); src = p.w_in; ld = 4104; dst = (bf16_t*)(p.ws + OFF_WINT); }
        else { const int t2 = tile - 1024; n0 = (t2 >> 4) * 64; k0 = (t2 & 15) * 64; srcn0 = n0; src = p.w_out; ld = 1024; dst = (bf16_t*)(p.ws + OFF_WOUTT); }
        const int kk = tid >> 4, n4 = tid & 15;
#pragma unroll
        for (int ps = 0; ps < 2; ++ps) { const int k = kk + 32 * ps;
            const f32x4 v = *(const f32x4*)(src + (size_t)(k0 + k) * ld + srcn0 + 4 * n4);
#pragma unroll
            for (int e = 0; e < 4; ++e) tl[k * 65 + 4 * n4 + e] = v[e]; }
        __syncthreads();
        { const int n = tid >> 3, k8 = tid & 7; float f[8];
#pragma unroll
            for (int e = 0; e < 8; ++e) f[e] = tl[(8 * k8 + e) * 65 + n];
            u32x4 w; w.x = pk_bf16(f[0], f[1]); w.y = pk_bf16(f[2], f[3]); w.z = pk_bf16(f[4], f[5]); w.w = pk_bf16(f[6], f[7]);
            *(u32x4*)(dst + (size_t)(n0 + n) * 1024 + k0 + 8 * k8) = w; }
        __syncthreads();
    }
}

constexpr int AT_KB = 8192, AT_VB = 16384, AT_BUF = AT_KB + AT_VB, AT_NBUF = 3, AT_TASK = AT_NBUF * AT_BUF, AT_O1 = AT_TASK + 256;

DI void attn_qblock(const Params& p, LAS unsigned char* lds, int b, int hh, int qb, float lam) {
    int tid = threadIdx.x; asm volatile("" : "+v"(tid));
    const int lane = tid & 63, wid = __builtin_amdgcn_readfirstlane(tid >> 6);
    const bf16_t* P1 = (const bf16_t*)(p.ws + OFF_P1);
    const bf16_t* VT = (const bf16_t*)(p.ws + OFF_VT) + (size_t)(b * 4 + hh) * 32 * 128 * 64;
    const bf16_t* KX = (const bf16_t*)(p.ws + OFF_KX) + (size_t)(b * 4 + hh) * 2 * 2048 * 64;
    bf16_t* mix = (bf16_t*)(p.ws + OFF_HB);
    const int q0 = qb * 256 + wid * 32;
    const size_t tokbase = (size_t)b * SEQ;
    const int nkt = (qb + 1) * 4;
    const float sl2 = exp2f(-2.0f * (float)(hh + 1)) * LOG2E;
    const float c1 = 0.125f * LOG2E;
#pragma unroll 1
    for (int map = 0; map < 2; ++map) {
        f32x16 O[4];
#pragma unroll
        for (int mt = 0; mt < 4; ++mt)
#pragma unroll
            for (int i = 0; i < 16; ++i) O[mt][i] = 0.f;
        float m = -INFINITY, l = 0.f;
        int lane_m = lane; asm volatile("" : "+v"(lane_m));
        const int r = lane_m & 31, h2 = lane_m >> 5;
        int foff[4];
#pragma unroll
        for (int k = 0; k < 4; ++k) foff[k] = r * 128 + (((2 * k + h2) ^ ((r >> 1) & 7)) << 4);
        float kb[16];
#pragma unroll
        for (int i = 0; i < 16; ++i) kb[i] = sl2 * (float)crow(i, h2);
        const int krow_ = 8 * wid + (lane_m >> 3), vrow0 = 16 * wid + (lane_m >> 3), vrow1 = vrow0 + 8;
        const bf16_t* kgp = KX + ((size_t)map * 2048 + krow_) * 64 + (((lane_m & 7) ^ ((krow_ >> 1) & 7)) * 8);
        const bf16_t* vgp0 = VT + (size_t)vrow0 * 64 + (((lane_m & 7) ^ ((vrow0 >> 1) & 7)) * 8);
        const bf16_t* vgp1 = VT + (size_t)vrow1 * 64 + (((lane_m & 7) ^ ((vrow1 >> 1) & 7)) * 8);
#define AT_STAGE(bufi, tile) do { LAS unsigned char* _b = lds + (bufi) * AT_BUF; \
            __builtin_amdgcn_global_load_lds((const unsigned*)(kgp + (size_t)(tile) * 64 * 64), (LAS unsigned*)(_b + wid * 1024), 16, 0, 0); \
            __builtin_amdgcn_global_load_lds((const unsigned*)(vgp0 + (size_t)(tile) * 128 * 64), (LAS unsigned*)(_b + AT_KB + wid * 2048), 16, 0, 0); \
            __builtin_amdgcn_global_load_lds((const unsigned*)(vgp1 + (size_t)(tile) * 128 * 64), (LAS unsigned*)(_b + AT_KB + wid * 2048 + 1024), 16, 0, 0); } while (0)
        bf16x8 qf[4];
        { const bf16_t* qp = P1 + (tokbase + q0 + (lane_m & 31)) * NP1 + C_DQ + hh * 128 + map * 64 + 8 * (lane_m >> 5);
#pragma unroll
            for (int ks = 0; ks < 4; ++ks) qf[ks] = *(const bf16x8*)(qp + 16 * ks); }
        AT_STAGE(0, 0);
        AT_STAGE(1, 1);
        asm volatile("" : "+v"(qf[0]), "+v"(qf[1]), "+v"(qf[2]), "+v"(qf[3]));
        int cb = 0;
#pragma unroll 1
        for (int kt = 0; kt < nkt; ++kt) {
            if (kt + 1 < nkt) asm volatile("s_waitcnt vmcnt(3)" ::: "memory"); else asm volatile("s_waitcnt vmcnt(0)" ::: "memory");
            __builtin_amdgcn_s_barrier();
            asm volatile("" ::: "memory");
            if (kt + 2 < nkt) { const int nb = cb == 0 ? 2 : cb - 1; AT_STAGE(nb, kt + 2); }
            const LAS unsigned char* cur = lds + cb * AT_BUF;
            cb = cb == 2 ? 0 : cb + 1;
            const int k0 = kt * 64;
            if (k0 <= q0) {
                const bool sub1 = (k0 + 32 <= q0);
                const LAS unsigned char* vb = cur + AT_KB;
                bf16x8 kf[8];
#pragma unroll
                for (int ks = 0; ks < 4; ++ks) kf[ks] = *(const LAS bf16x8*)(cur + foff[ks]);
                if (sub1) {
#pragma unroll
                    for (int ks = 0; ks < 4; ++ks) kf[4 + ks] = *(const LAS bf16x8*)(cur + 4096 + foff[ks]);
                }
                f32x16 s0, s1;
#pragma unroll
                for (int i = 0; i < 16; ++i) { s0[i] = 0.f; s1[i] = 0.f; }
#pragma unroll
                for (int ks = 0; ks < 4; ++ks) s0 = MFMA32(kf[ks], qf[ks], s0);
                if (sub1) {
#pragma unroll
                    for (int ks = 0; ks < 4; ++ks) s1 = MFMA32(kf[4 + ks], qf[ks], s1);
                }
                __builtin_amdgcn_sched_barrier(0);
                bf16x8 va[8];
#pragma unroll
                for (int s2 = 0; s2 < 2; ++s2)
#pragma unroll
                    for (int mt = 0; mt < 4; ++mt) va[s2 * 4 + mt] = *(const LAS bf16x8*)(vb + mt * 4096 + foff[s2]);
                __builtin_amdgcn_sched_barrier(0);
                const float off0 = sl2 * (float)(k0 - q0), off1 = off0 + 32.0f * sl2;
                const f32x2 c1v = {c1, c1};
#pragma unroll
                for (int j = 0; j < 8; ++j) {
                    const f32x2 kv = {kb[2 * j], kb[2 * j + 1]};
                    f32x2 a = {s0[2 * j], s0[2 * j + 1]}, c = {s1[2 * j], s1[2 * j + 1]};
                    a = __builtin_elementwise_fma(a, c1v, kv); c = __builtin_elementwise_fma(c, c1v, kv);
                    s0[2 * j] = a.x; s0[2 * j + 1] = a.y; s1[2 * j] = c.x; s1[2 * j + 1] = c.y;
                }
                if (k0 == q0) {
#pragma unroll
                    for (int i = 0; i < 16; ++i) if (crow(i, h2) > r) s0[i] = -INFINITY;
                }
                if (k0 + 32 == q0) {
#pragma unroll
                    for (int i = 0; i < 16; ++i) if (crow(i, h2) > r) s1[i] = -INFINITY;
                }
                float mx0 = fmaxf(s0[0], s0[1]), mx1 = fmaxf(s1[0], s1[1]);
#pragma unroll
                for (int j = 1; j < 8; ++j) { mx0 = fmaxf(fmaxf(s0[2 * j], s0[2 * j + 1]), mx0); mx1 = fmaxf(fmaxf(s1[2 * j], s1[2 * j + 1]), mx1); }
                float mx = sub1 ? fmaxf(mx0 + off0, mx1 + off1) : mx0 + off0;
                mx = fmaxf(mx, __shfl_xor(mx, 32));
                if (__builtin_amdgcn_ballot_w64(mx > m + 8.0f) != 0ull) {
                    const float mn = fmaxf(m, mx);
                    const float alpha = __builtin_amdgcn_exp2f(m - mn);
                    m = mn; l *= alpha;
#pragma unroll
                    for (int mt = 0; mt < 4; ++mt)
#pragma unroll
                        for (int i = 0; i < 16; ++i) O[mt][i] *= alpha;
                }
                const float r0 = m - off0, r1 = sub1 ? m - off1 : INFINITY;
                const f32x2 r0v = {r0, r0}, r1v = {r1, r1};
                f32x2 lsv = {0.f, 0.f};
#pragma unroll
                for (int j = 0; j < 8; ++j) {
                    f32x2 a = {s0[2 * j], s0[2 * j + 1]}, c = {s1[2 * j], s1[2 * j + 1]};
                    a = a - r0v; c = c - r1v;
                    a.x = __builtin_amdgcn_exp2f(a.x); a.y = __builtin_amdgcn_exp2f(a.y); c.x = __builtin_amdgcn_exp2f(c.x); c.y = __builtin_amdgcn_exp2f(c.y);
                    lsv = lsv + a; lsv = lsv + c;
                    s0[2 * j] = a.x; s0[2 * j + 1] = a.y; s1[2 * j] = c.x; s1[2 * j + 1] = c.y;
                }
                l += lsv.x + lsv.y;
                bf16x8 pf[4];
#pragma unroll
                for (int s = 0; s < 2; ++s) { pf[s] = pack8(s0, s); pf[2 + s] = pack8(s1, s); }
                __builtin_amdgcn_sched_barrier(0);
                bf16x8 vc[4], vd[4];
                if (sub1) {
#pragma unroll
                    for (int mt = 0; mt < 4; ++mt) vc[mt] = *(const LAS bf16x8*)(vb + mt * 4096 + foff[2]);
                }
#pragma unroll
                for (int mt = 0; mt < 4; ++mt) O[mt] = MFMA32(va[mt], pf[0], O[mt]);
                if (sub1) {
#pragma unroll
                    for (int mt = 0; mt < 4; ++mt) vd[mt] = *(const LAS bf16x8*)(vb + mt * 4096 + foff[3]);
                }
#pragma unroll
                for (int mt = 0; mt < 4; ++mt) O[mt] = MFMA32(va[4 + mt], pf[1], O[mt]);
                if (sub1) {
#pragma unroll
                    for (int mt = 0; mt < 4; ++mt) O[mt] = MFMA32(vc[mt], pf[2], O[mt]);
#pragma unroll
                    for (int mt = 0; mt < 4; ++mt) O[mt] = MFMA32(vd[mt], pf[3], O[mt]);
                }
            }
        }
        asm volatile("" ::: "memory");
        __builtin_amdgcn_s_barrier();
        asm volatile("" ::: "memory");
#undef AT_STAGE
        const float lt = l + __shfl_xor(l, 32);
        int lane_o = lane; asm volatile("" : "+v"(lane_o));
        LAS unsigned* o1l = (LAS unsigned*)(lds + AT_O1 + wid * 8192) + lane_o;
        if (map == 0) {
            const float inv1 = 1.0f / lt;
#pragma unroll
            for (int mt = 0; mt < 4; ++mt)
#pragma unroll
                for (int j = 0; j < 8; ++j) o1l[(mt * 8 + j) * 64] = pk_bf16(O[mt][2 * j] * inv1, O[mt][2 * j + 1] * inv1);
        } else {
            const float inv2 = lam / lt;
            float ss = 0.f;
#pragma unroll
            for (int mt = 0; mt < 4; ++mt)
#pragma unroll
                for (int j = 0; j < 8; ++j) {
                    const unsigned o1 = o1l[(mt * 8 + j) * 64];
                    const float a = bf_lo(o1) - O[mt][2 * j] * inv2, c = bf_hi(o1) - O[mt][2 * j + 1] * inv2;
                    O[mt][2 * j] = a; O[mt][2 * j + 1] = c; ss += a * a + c * c;
                }
            ss += __shfl_xor(ss, 32);
            const float rs = rsqrtf(ss * (1.0f / 128.0f) + EPS) * 0.8f;
#pragma unroll
            for (int mt = 0; mt < 4; ++mt)
#pragma unroll
                for (int j = 0; j < 8; ++j) o1l[(mt * 8 + j) * 64] = pk_bf16(O[mt][2 * j] * rs, O[mt][2 * j + 1] * rs);
            __builtin_amdgcn_wave_barrier();
            int lane_e = lane; asm volatile("" : "+v"(lane_e));
            const int dvg = lane_e & 15, qs = lane_e >> 4;
            const f32x4 nw0 = *(const f32x4*)(p.diff_norm_w + 8 * dvg), nw1 = *(const f32x4*)(p.diff_norm_w + 8 * dvg + 4);
            const LAS unsigned* ob = (const LAS unsigned*)(lds + AT_O1 + wid * 8192);
            const int slot = (dvg >> 2) * 8 + 2 * (dvg & 3);
            u32x4 dzv[8];
#pragma unroll
            for (int it = 0; it < 8; ++it) dzv[it] = *(const u32x4*)(P1 + (tokbase + q0 + it * 4 + qs) * NP1 + C_DZ + hh * 128 + 8 * dvg);
#pragma unroll
            for (int it = 0; it < 8; ++it) {
                const int q = it * 4 + qs; const size_t row = tokbase + q0 + q;
                const unsigned u0 = ob[slot * 64 + q], u1 = ob[(slot + 1) * 64 + q], u2 = ob[slot * 64 + q + 32], u3 = ob[(slot + 1) * 64 + q + 32];
                const u32x4 dz = dzv[it];
                u32x4 w;
                w.x = pk_bf16(bf_lo(u0) * nw0[0] * silu_f(bf_lo(dz.x)), bf_hi(u0) * nw0[1] * silu_f(bf_hi(dz.x)));
                w.y = pk_bf16(bf_lo(u1) * nw0[2] * silu_f(bf_lo(dz.y)), bf_hi(u1) * nw0[3] * silu_f(bf_hi(dz.y)));
                w.z = pk_bf16(bf_lo(u2) * nw1[0] * silu_f(bf_lo(dz.z)), bf_hi(u2) * nw1[1] * silu_f(bf_hi(dz.z)));
                w.w = pk_bf16(bf_lo(u3) * nw1[2] * silu_f(bf_lo(dz.w)), bf_hi(u3) * nw1[3] * silu_f(bf_hi(dz.w)));
                *(u32x4*)(mix + row * DM + 512 + hh * 128 + 8 * dvg) = w;
            }
            __builtin_amdgcn_wave_barrier();
        }
    }
}

DI void phase_attn(const Params& p, LAS unsigned char* lds, int rep) {
    const float lam = *(const float*)(p.ws + OFF_MISC);
    unsigned* counter = (unsigned*)(p.ws + OFF_MISC + 4 + 4 * rep);
    LAS int* tslot = (LAS int*)(lds + AT_TASK);
    for (;;) {
        if (threadIdx.x == 0) *tslot = (int)atomicAdd(counter, 1u);
        __syncthreads();
        const int t = *tslot;
        __syncthreads();
        if (t >= 512) break;
        const int qb = 7 - (t >> 6), bh = t & 63;
        attn_qblock(p, lds, bh >> 2, bh & 3, qb, lam);
    }
}


constexpr int G_QN = 0, G_KN = 17408, G_VB = 34816, G_KBG = 52224, G_M = 69632, G_T = 86016, G_SM = 95232;
DI bf16x8 tr_pair(const LAS unsigned char* lo_addr, int hi_off) {
    const s16x4 lo = __builtin_amdgcn_ds_read_tr16_b64_v4i16((LAS s16x4*)(lo_addr));
    const s16x4 hi = __builtin_amdgcn_ds_read_tr16_b64_v4i16((LAS s16x4*)(lo_addr + hi_off));
    return __builtin_shufflevector(lo, hi, 0, 1, 2, 3, 4, 5, 6, 7);
}
DI bf16_t bf16_1(float v) { return (bf16_t)(pk_bf16(v, 0.f) & 0xffffu); }

DI void gdn_prep(const Params& p, LAS unsigned char* lds, int c2) {
    int tid = threadIdx.x; asm volatile("" : "+v"(tid));
    const int lane = tid & 63, wid = __builtin_amdgcn_readfirstlane(tid >> 6), r = lane & 31, h2 = lane >> 5;
    const int b = c2 >> 7, hh = (c2 >> 5) & 3, n = c2 & 31;
    const size_t tok0 = (size_t)b * SEQ + (size_t)n * 64;
    const bf16_t* P1 = (const bf16_t*)(p.ws + OFF_P1);
    LAS float* sm = (LAS float*)(lds + G_SM);
    LAS float* Mf = (LAS float*)(lds + G_M);
    bf16_t* WN = (bf16_t*)(p.ws + OFF_WN) + (size_t)c2 * 8192;
    bf16_t* QD = (bf16_t*)(p.ws + OFF_QD) + (size_t)c2 * 8192;
    bf16_t* KD = (bf16_t*)(p.ws + OFF_KD) + (size_t)c2 * 8192;
    bf16_t* AQ = (bf16_t*)(p.ws + OFF_AQK) + (size_t)c2 * 4096;
    float* U = (float*)(p.ws + OFF_U) + (size_t)c2 * 8192;
    u32x4 raw[6][4];
#pragma unroll
    for (int i = 0; i < 6; ++i) {
        const int item = tid + 512 * i, g = item & 15, t = (item >> 4) & 63, part = i >> 1;
        const int ch = part * 512 + hh * 128 + g * 8;
#pragma unroll
        for (int j = 0; j < 4; ++j) {
            const int tt = n * 64 + t - 3 + j, ttc = tt < 0 ? 0 : tt;
            raw[i][j] = *(const u32x4*)(P1 + ((size_t)b * SEQ + ttc) * NP1 + ch);
            if (tt < 0) raw[i][j] = (u32x4){0u, 0u, 0u, 0u};
        }
    }
    if (wid == 0) {
        const float* gg = (const float*)(p.ws + OFF_GBGA) + (tok0 + lane) * 8;
        const float gbv = gg[hh], gav = gg[4 + hh];
        const float beta = 1.0f / (1.0f + expf(-gbv));
        const float xs = gav + p.dt_bias[hh];
        const float sp = fmaxf(xs, 0.f) + log1pf(expf(-fabsf(xs)));
        float gc = -expf(p.a_log[hh]) * sp;
#pragma unroll
        for (int o = 1; o < 64; o <<= 1) { const float t = __shfl_up(gc, o); if (lane >= o) gc += t; }
        const float gl = __shfl(gc, 63);
        sm[lane] = beta; sm[64 + lane] = gc * LOG2E; sm[128 + lane] = expf(gc); sm[192 + lane] = expf(gl - gc);
        if (lane == 63) ((float*)(p.ws + OFF_GL))[c2] = expf(gl);
    }
    float av[6][8];
#pragma unroll
    for (int i = 0; i < 6; ++i) {
        const int item = tid + 512 * i, g = item & 15, part = i >> 1;
        const int ch = part * 512 + hh * 128 + g * 8;
        float a[8];
#pragma unroll
        for (int e = 0; e < 8; ++e) a[e] = 0.f;
#pragma unroll
        for (int j = 0; j < 4; ++j) {
            const f32x4 w0 = *(const f32x4*)(p.conv_w + j * 1536 + ch), w1 = *(const f32x4*)(p.conv_w + j * 1536 + ch + 4);
            const u32x4 rw = raw[i][j];
            a[0] += w0[0] * bf_lo(rw.x); a[1] += w0[1] * bf_hi(rw.x); a[2] += w0[2] * bf_lo(rw.y); a[3] += w0[3] * bf_hi(rw.y);
            a[4] += w1[0] * bf_lo(rw.z); a[5] += w1[1] * bf_hi(rw.z); a[6] += w1[2] * bf_lo(rw.w); a[7] += w1[3] * bf_hi(rw.w);
        }
        float ss = 0.f;
#pragma unroll
        for (int e = 0; e < 8; ++e) { a[e] = silu_f(a[e]); ss += a[e] * a[e]; }
        float rn = 1.0f;
        if (part < 2) {
            ss += __shfl_xor(ss, 1); ss += __shfl_xor(ss, 2); ss += __shfl_xor(ss, 4); ss += __shfl_xor(ss, 8);
            rn = rsqrtf(ss + 1e-6f) * (part == 0 ? 0.08838834764831845f : 1.0f);
        }
#pragma unroll
        for (int e = 0; e < 8; ++e) av[i][e] = a[e] * rn;
    }
    __syncthreads();
#pragma unroll
    for (int i = 0; i < 6; ++i) {
        const int item = tid + 512 * i, g = item & 15, t = (item >> 4) & 63, part = i >> 1;
        const float* a = av[i];
        const float beta = sm[t], egc = sm[128 + t], ekd = sm[192 + t];
        if (part < 2) {
            u32x4 w; w.x = pk_bf16(a[0], a[1]); w.y = pk_bf16(a[2], a[3]); w.z = pk_bf16(a[4], a[5]); w.w = pk_bf16(a[6], a[7]);
            *(LAS u32x4*)(lds + (part == 0 ? G_QN : G_KN) + t * 272 + g * 16) = w;
            if (part == 0) {
                u32x2 lo, hi; lo.x = pk_bf16(a[0] * egc, a[1] * egc); lo.y = pk_bf16(a[2] * egc, a[3] * egc); hi.x = pk_bf16(a[4] * egc, a[5] * egc); hi.y = pk_bf16(a[6] * egc, a[7] * egc);
                bf16_t* qd = QD + t * 128 + 16 * (g >> 1) + 4 * (g & 1);
                *(u32x2*)qd = lo; *(u32x2*)(qd + 8) = hi;
            } else {
                const float f1 = beta * egc;
                u32x4 w2; w2.x = pk_bf16(a[0] * f1, a[1] * f1); w2.y = pk_bf16(a[2] * f1, a[3] * f1); w2.z = pk_bf16(a[4] * f1, a[5] * f1); w2.w = pk_bf16(a[6] * f1, a[7] * f1);
                *(LAS u32x4*)(lds + G_KBG + t * 272 + g * 16) = w2;
                u32x4 w3; w3.x = pk_bf16(a[0] * ekd, a[1] * ekd); w3.y = pk_bf16(a[2] * ekd, a[3] * ekd); w3.z = pk_bf16(a[4] * ekd, a[5] * ekd); w3.w = pk_bf16(a[6] * ekd, a[7] * ekd);
                *(u32x4*)(KD + t * 128 + g * 8) = w3;
            }
        } else {
            u32x4 w; w.x = pk_bf16(a[0] * beta, a[1] * beta); w.y = pk_bf16(a[2] * beta, a[3] * beta); w.z = pk_bf16(a[4] * beta, a[5] * beta); w.w = pk_bf16(a[6] * beta, a[7] * beta);
            *(LAS u32x4*)(lds + G_VB + t * 272 + g * 16) = w;
        }
    }
    __syncthreads();
    {
        const int w4 = wid & 3, mt = w4 >> 1, nt = w4 & 1; const bool isqk = wid >= 4;
        if (!(mt == 0 && nt == 1)) {
            const LAS unsigned char* Ab = lds + (isqk ? G_QN : G_KN) + (32 * mt + r) * 272 + 16 * h2;
            const LAS unsigned char* Bb = lds + G_KN + (32 * nt + r) * 272 + 16 * h2;
            f32x16 X;
#pragma unroll
            for (int i = 0; i < 16; ++i) X[i] = 0.f;
#pragma unroll
            for (int ks = 0; ks < 8; ++ks) X = MFMA32(*(const LAS bf16x8*)(Ab + 32 * ks), *(const LAS bf16x8*)(Bb + 32 * ks), X);
            const int s = 32 * nt + r; const float gcs = sm[64 + s];
#pragma unroll
            for (int i = 0; i < 16; ++i) {
                const int c = 32 * mt + crow(i, h2);
                const float dec = __builtin_amdgcn_exp2f(sm[64 + c] - gcs);
                if (!isqk) Mf[c * 64 + s] = (c > s) ? sm[c] * X[i] * dec : 0.f;
                else AQ[c * 64 + perm23(s)] = bf16_1((c >= s) ? X[i] * dec : 0.f);
            }
        }
    }
    __syncthreads();
    if (wid == 0) {
        const int cc = r, hb = h2;
        const LAS float* Mb = Mf + (32 * hb) * 64 + 32 * hb;
        float T[32];
#pragma unroll
        for (int i = 0; i < 32; ++i) T[i] = 0.f;
#pragma unroll
        for (int i = 0; i < 32; ++i) {
            float a0 = (i == cc) ? 1.f : 0.f, a1 = 0.f, a2 = 0.f, a3 = 0.f;
#pragma unroll
            for (int s4 = 0; s4 < (i + 3) / 4; ++s4) {
                const f32x4 m4 = *(const LAS f32x4*)(Mb + i * 64 + 4 * s4);
                a0 -= m4[0] * T[4 * s4]; a1 -= m4[1] * T[4 * s4 + 1]; a2 -= m4[2] * T[4 * s4 + 2]; a3 -= m4[3] * T[4 * s4 + 3];
            }
            float acc = (a0 + a1) + (a2 + a3);
            if ((i & 3) == 3) asm volatile("" : "+v"(acc) :: "memory");
            T[i] = acc;
        }
        LAS bf16_t* Tb = (LAS bf16_t*)(lds + G_T);
#pragma unroll
        for (int i = 0; i < 32; ++i) {
            Tb[(32 * hb + i) * 72 + 32 * hb + cc] = bf16_1(T[i]);
            if (hb == 0) Tb[i * 72 + 32 + cc] = 0;
        }
        __builtin_amdgcn_wave_barrier();
        asm volatile("s_waitcnt lgkmcnt(0)" ::: "memory");
        const int i16 = lane & 15, q = i16 >> 2, pp = i16 & 3, blk = (lane >> 4) & 1;
        f32x16 Y;
#pragma unroll
        for (int i = 0; i < 16; ++i) Y[i] = 0.f;
#pragma unroll
        for (int ks = 0; ks < 2; ++ks) {
            const LAS float* mp = Mf + (32 + r) * 64 + 16 * ks + 8 * h2;
            const f32x4 m0 = *(const LAS f32x4*)mp, m1 = *(const LAS f32x4*)(mp + 4);
            u32x4 aw; aw.x = pk_bf16(m0[0], m0[1]); aw.y = pk_bf16(m0[2], m0[3]); aw.z = pk_bf16(m1[0], m1[1]); aw.w = pk_bf16(m1[2], m1[3]);
            const bf16x8 bfrag = tr_pair(lds + G_T + (16 * ks + 8 * h2 + q) * 144 + (16 * blk + 4 * pp) * 2, 4 * 144);
            Y = MFMA32(__builtin_bit_cast(bf16x8, aw), bfrag, Y);
        }
        f32x16 Z;
#pragma unroll
        for (int i = 0; i < 16; ++i) Z[i] = 0.f;
#pragma unroll
        for (int s = 0; s < 2; ++s) {
            const LAS unsigned char* tp = lds + G_T + (32 + r) * 144 + (32 + 16 * s + 4 * h2) * 2;
            const u32x2 lo = *(const LAS u32x2*)tp, hi = *(const LAS u32x2*)(tp + 16);
            u32x4 aw; aw.x = lo.x; aw.y = lo.y; aw.z = hi.x; aw.w = hi.y;
            Z = MFMA32(__builtin_bit_cast(bf16x8, aw), pack8(Y, s), Z);
        }
#pragma unroll
        for (int i = 0; i < 16; ++i) Tb[(32 + crow(i, h2)) * 72 + r] = bf16_1(-Z[i]);
    }
    __syncthreads();
    {
        const int mt = wid >> 2, nt = wid & 3;
        const int i16 = lane & 15, q = i16 >> 2, pp = i16 & 3, blk = (lane >> 4) & 1;
        f32x16 Xu, Xw;
#pragma unroll
        for (int i = 0; i < 16; ++i) { Xu[i] = 0.f; Xw[i] = 0.f; }
#pragma unroll
        for (int ks = 0; ks < 4; ++ks) {
            if (ks < 2 * (mt + 1)) {
                const bf16x8 af = *(const LAS bf16x8*)(lds + G_T + (32 * mt + r) * 144 + (16 * ks + 8 * h2) * 2);
                const int boff = (16 * ks + 8 * h2 + q) * 272 + (32 * nt + 16 * blk + 4 * pp) * 2;
                Xu = MFMA32(af, tr_pair(lds + G_VB + boff, 4 * 272), Xu);
                Xw = MFMA32(af, tr_pair(lds + G_KBG + boff, 4 * 272), Xw);
            }
        }
        const int d = 32 * nt + r, dp = perm23(d);
        {
            float* up = U + ((nt * 2 + mt) * 64 + lane) * 16;
#pragma unroll
            for (int k = 0; k < 4; ++k) { const f32x4 v = {Xu[4 * k], Xu[4 * k + 1], Xu[4 * k + 2], Xu[4 * k + 3]}; *(f32x4*)(up + 4 * k) = v; }
        }
#pragma unroll
        for (int i = 0; i < 16; ++i) {
            const int c = 32 * mt + crow(i, h2);
            WN[c * 128 + dp] = bf16_1(-Xw[i]);
        }
    }
    __syncthreads();
}

constexpr int S_WN = 0, S_QD = 17408, S_KD = 34816, S_AQ = 52224, S_BUF = 61440, S_STG = 2 * S_BUF;

struct GateIn { u32x4 z0, z1; };
DI void scan_gate_load(const Params& p, int tid, int b, int hh, int n, GateIn& g) {
    const int gc_ = tid >> 3, seg = tid & 7;
    const bf16_t* P1 = (const bf16_t*)(p.ws + OFF_P1);
    const size_t row = (size_t)b * SEQ + n * 64 + gc_;
    g.z0 = *(const u32x4*)(P1 + row * NP1 + C_GZ + hh * 128 + seg * 16); g.z1 = *(const u32x4*)(P1 + row * NP1 + C_GZ + hh * 128 + seg * 16 + 8);
}
DI void scan_gate(const Params& p, LAS unsigned char* lds, int tid, int b, int hh, int n, const GateIn& g) {
    const int gc_ = tid >> 3, seg = tid & 7;
    bf16_t* mix = (bf16_t*)(p.ws + OFF_HB);
    const LAS float* st = (const LAS float*)(lds + S_STG) + gc_ * 132 + seg * 16;
    f32x4 ov[4]; float ss = 0.f;
#pragma unroll
    for (int k = 0; k < 4; ++k) { ov[k] = *(const LAS f32x4*)(st + 4 * k); ss += ov[k][0] * ov[k][0] + ov[k][1] * ov[k][1] + ov[k][2] * ov[k][2] + ov[k][3] * ov[k][3]; }
    ss += __shfl_xor(ss, 1); ss += __shfl_xor(ss, 2); ss += __shfl_xor(ss, 4);
    const float rstd = rsqrtf(ss * (1.0f / 128.0f) + EPS);
    const size_t row = (size_t)b * SEQ + n * 64 + gc_;
    const u32x4 z0 = g.z0, z1 = g.z1;
    f32x4 gnw[4];
#pragma unroll
    for (int k = 0; k < 4; ++k) gnw[k] = *(const f32x4*)(p.gdn_norm_w + seg * 16 + 4 * k);
    u32x4 w0, w1;
    w0.x = pk_bf16(ov[0][0] * rstd * gnw[0][0] * silu_f(bf_lo(z0.x)), ov[0][1] * rstd * gnw[0][1] * silu_f(bf_hi(z0.x)));
    w0.y = pk_bf16(ov[0][2] * rstd * gnw[0][2] * silu_f(bf_lo(z0.y)), ov[0][3] * rstd * gnw[0][3] * silu_f(bf_hi(z0.y)));
    w0.z = pk_bf16(ov[1][0] * rstd * gnw[1][0] * silu_f(bf_lo(z0.z)), ov[1][1] * rstd * gnw[1][1] * silu_f(bf_hi(z0.z)));
    w0.w = pk_bf16(ov[1][2] * rstd * gnw[1][2] * silu_f(bf_lo(z0.w)), ov[1][3] * rstd * gnw[1][3] * silu_f(bf_hi(z0.w)));
    w1.x = pk_bf16(ov[2][0] * rstd * gnw[2][0] * silu_f(bf_lo(z1.x)), ov[2][1] * rstd * gnw[2][1] * silu_f(bf_hi(z1.x)));
    w1.y = pk_bf16(ov[2][2] * rstd * gnw[2][2] * silu_f(bf_lo(z1.y)), ov[2][3] * rstd * gnw[2][3] * silu_f(bf_hi(z1.y)));
    w1.z = pk_bf16(ov[3][0] * rstd * gnw[3][0] * silu_f(bf_lo(z1.z)), ov[3][1] * rstd * gnw[3][1] * silu_f(bf_hi(z1.z)));
    w1.w = pk_bf16(ov[3][2] * rstd * gnw[3][2] * silu_f(bf_lo(z1.w)), ov[3][3] * rstd * gnw[3][3] * silu_f(bf_hi(z1.w)));
    bf16_t* mp = mix + row * DM + hh * 128 + seg * 16;
    *(u32x4*)mp = w0; *(u32x4*)(mp + 8) = w1;
}

struct ScanRegs { u32x4 t0[4], t1[4], t2[4], t3[2]; };
DI void scan_fetch(ScanRegs& R, const bf16_t* WN, const bf16_t* QD, const bf16_t* KD, const bf16_t* AQ, int ltid) {
#pragma unroll
    for (int i = 0; i < 4; ++i) { const int pi = ltid + 256 * i; R.t0[i] = *(const u32x4*)(WN + pi * 8); R.t1[i] = *(const u32x4*)(QD + pi * 8); R.t2[i] = *(const u32x4*)(KD + pi * 8); }
#pragma unroll
    for (int i = 0; i < 2; ++i) { const int pi = ltid + 256 * i; R.t3[i] = *(const u32x4*)(AQ + pi * 8); }
}
DI void scan_put(const ScanRegs& R, LAS unsigned char* dst, int ltid) {
#pragma unroll
    for (int i = 0; i < 4; ++i) { const int pi = ltid + 256 * i, row = pi >> 4, pc = pi & 15;
        *(LAS u32x4*)(dst + S_WN + row * 272 + pc * 16) = R.t0[i]; *(LAS u32x4*)(dst + S_QD + row * 272 + pc * 16) = R.t1[i]; *(LAS u32x4*)(dst + S_KD + row * 272 + pc * 16) = R.t2[i]; }
#pragma unroll
    for (int i = 0; i < 2; ++i) { const int pi = ltid + 256 * i, row = pi >> 3, pc = pi & 7; *(LAS u32x4*)(dst + S_AQ + row * 144 + pc * 16) = R.t3[i]; }
}

DI void gdn_scan(const Params& p, LAS unsigned char* lds, int bh) {
    int tid = threadIdx.x; asm volatile("" : "+v"(tid));
    const int lane = tid & 63, wid = __builtin_amdgcn_readfirstlane(tid >> 6), r = lane & 31, h2 = lane >> 5;
    const int b = bh >> 2, hh = bh & 3;
    const bf16_t* WN = (const bf16_t*)(p.ws + OFF_WN) + (size_t)bh * 32 * 8192;
    const bf16_t* QD = (const bf16_t*)(p.ws + OFF_QD) + (size_t)bh * 32 * 8192;
    const bf16_t* KD = (const bf16_t*)(p.ws + OFF_KD) + (size_t)bh * 32 * 8192;
    const bf16_t* AQ = (const bf16_t*)(p.ws + OFF_AQK) + (size_t)bh * 32 * 4096;
    const float* U = (const float*)(p.ws + OFF_U) + (size_t)bh * 32 * 8192;
    const float* GL = (const float*)(p.ws + OFF_GL) + bh * 32;
    if (wid >= 4) {
        const int ltid = tid & 255;
        ScanRegs R;
        scan_fetch(R, WN, QD, KD, AQ, ltid); scan_put(R, lds, ltid);
        scan_fetch(R, WN + 8192, QD + 8192, KD + 8192, AQ + 4096, ltid);
#pragma unroll 1
        for (int n = 0; n < 32; ++n) {
            __syncthreads();
            GateIn gi; scan_gate_load(p, tid, b, hh, n, gi);
            if (n + 1 < 32) scan_put(R, lds + ((n + 1) & 1) * S_BUF, ltid);
            if (n + 2 < 32) scan_fetch(R, WN + (size_t)(n + 2) * 8192, QD + (size_t)(n + 2) * 8192, KD + (size_t)(n + 2) * 8192, AQ + (size_t)(n + 2) * 4096, ltid);
            __syncthreads();
            scan_gate(p, lds, tid, b, hh, n, gi);
        }
    } else {
        const int i16 = lane & 15, q4 = i16 >> 2, pp = i16 & 3, blk = (lane >> 4) & 1;
        f32x16 St[4], u[2];
#pragma unroll
        for (int k = 0; k < 4; ++k)
#pragma unroll
            for (int i = 0; i < 16; ++i) St[k][i] = 0.f;
#pragma unroll
        for (int mt = 0; mt < 2; ++mt)
#pragma unroll
            for (int k = 0; k < 4; ++k) { const f32x4 v = *(const f32x4*)(U + ((wid * 2 + mt) * 64 + lane) * 16 + 4 * k); u[mt][4 * k] = v[0]; u[mt][4 * k + 1] = v[1]; u[mt][4 * k + 2] = v[2]; u[mt][4 * k + 3] = v[3]; }
#pragma unroll 1
        for (int n = 0; n < 32; ++n) {
            LAS unsigned char* buf = lds + (n & 1) * S_BUF;
            __syncthreads();
            GateIn gi; scan_gate_load(p, tid, b, hh, n, gi);
            const float egl = GL[n];
            f32x16 vn[2], o[2];
            vn[0] = u[0]; vn[1] = u[1];
#pragma unroll
            for (int mt = 0; mt < 2; ++mt)
#pragma unroll
                for (int i = 0; i < 16; ++i) o[mt][i] = 0.f;
#pragma unroll
            for (int ks = 0; ks < 8; ++ks) {
                const bf16x8 sf = pack8(St[ks >> 1], ks & 1);
#pragma unroll
                for (int mt = 0; mt < 2; ++mt) {
                    const bf16x8 wf = *(const LAS bf16x8*)(buf + S_WN + (32 * mt + r) * 272 + (16 * ks + 8 * h2) * 2);
                    vn[mt] = MFMA32(wf, sf, vn[mt]);
                    const bf16x8 qf = *(const LAS bf16x8*)(buf + S_QD + (32 * mt + r) * 272 + (16 * ks + 8 * h2) * 2);
                    o[mt] = MFMA32(qf, sf, o[mt]);
                }
                asm volatile("" ::: "memory");
            }
            bf16x8 vf[4];
#pragma unroll
            for (int k2 = 0; k2 < 4; ++k2) vf[k2] = pack8(vn[k2 >> 1], k2 & 1);
            {
                const int nn = (n + 1 < 32) ? n + 1 : n;
                const float* up = U + (size_t)nn * 8192 + ((wid * 2) * 64 + lane) * 16;
#pragma unroll
                for (int mt = 0; mt < 2; ++mt)
#pragma unroll
                    for (int k = 0; k < 4; ++k) { const f32x4 v = *(const f32x4*)(up + mt * 1024 + 4 * k); u[mt][4 * k] = v[0]; u[mt][4 * k + 1] = v[1]; u[mt][4 * k + 2] = v[2]; u[mt][4 * k + 3] = v[3]; }
            }
#pragma unroll
            for (int mt = 0; mt < 2; ++mt)
#pragma unroll
                for (int k2 = 0; k2 < 2 * (mt + 1); ++k2) {
                    const bf16x8 af = *(const LAS bf16x8*)(buf + S_AQ + (32 * mt + r) * 144 + (16 * k2 + 8 * h2) * 2);
                    o[mt] = MFMA32(af, vf[k2], o[mt]);
                }
            {
                LAS float* st = (LAS float*)(lds + S_STG);
#pragma unroll
                for (int mt = 0; mt < 2; ++mt)
#pragma unroll
                    for (int i = 0; i < 16; ++i) st[(32 * mt + crow(i, h2)) * 132 + 32 * wid + r] = o[mt][i];
            }
#pragma unroll
            for (int kt = 0; kt < 4; ++kt) {
#pragma unroll
                for (int i = 0; i < 16; ++i) St[kt][i] *= egl;
#pragma unroll
                for (int k2 = 0; k2 < 4; ++k2) {
                    const bf16x8 kf = tr_pair(buf + S_KD + (16 * k2 + 4 * h2 + q4) * 272 + (32 * kt + 16 * blk + 4 * pp) * 2, 8 * 272);
                    St[kt] = MFMA32(kf, vf[k2], St[kt]);
                }
                asm volatile("" ::: "memory");
            }
            __syncthreads();
            scan_gate(p, lds, tid, b, hh, n, gi);
        }
    }
    __syncthreads();
}

DI void zero_mix_half(const Params& p, int half) {
    bf16_t* mix = (bf16_t*)(p.ws + OFF_HB);
    const size_t n16 = (size_t)MTOK * 64;
    for (size_t i = (size_t)blockIdx.x * 512 + threadIdx.x; i < n16; i += (size_t)gridDim.x * 512) {
        const size_t row = i >> 6, pc = i & 63;
        *(u32x4*)(mix + row * DM + half * 512 + pc * 8) = (u32x4){0u, 0u, 0u, 0u};
    }
}

DI void phase_final(const Params& p) {
    int tid = threadIdx.x; asm volatile("" : "+v"(tid));
    const int lane = tid & 63, wid = tid >> 6;
    const float* rowsq = (const float*)(p.ws + OFF_ROWSQ);
    const bf16_t* yb = (const bf16_t*)(p.ws + OFF_YB);
    const int gw = blockIdx.x * 8 + wid, nw = gridDim.x * 8;
    f32x4 fw[4];
#pragma unroll
    for (int i = 0; i < 2; ++i) { fw[2 * i] = *(const f32x4*)(p.final_norm_w + 512 * i + 8 * lane); fw[2 * i + 1] = *(const f32x4*)(p.final_norm_w + 512 * i + 8 * lane + 4); }
#pragma unroll 1
    for (int row0 = gw; row0 < MTOK; row0 += 4 * nw) {
        u32x4 y[4][2]; float sq[4];
#pragma unroll
        for (int k = 0; k < 4; ++k) {
            const int row = row0 + k * nw, rc = row < MTOK ? row : row0;
#pragma unroll
            for (int i = 0; i < 2; ++i) y[k][i] = *(const u32x4*)(yb + (size_t)rc * DM + 512 * i + 8 * lane);
            sq[k] = lane < 16 ? rowsq[(size_t)rc * 16 + lane] : 0.f;
        }
#pragma unroll
        for (int k = 0; k < 4; ++k) {
            const int row = row0 + k * nw;
            const float ss = wave_sum(sq[k]);
            const float rstd = rsqrtf(ss * (1.0f / DM) + EPS);
            if (row < MTOK) {
                float* o = p.out + (size_t)row * DM;
#pragma unroll
                for (int i = 0; i < 2; ++i) {
                    const f32x4 a = {bf_lo(y[k][i].x), bf_hi(y[k][i].x), bf_lo(y[k][i].y), bf_hi(y[k][i].y)}, c = {bf_lo(y[k][i].z), bf_hi(y[k][i].z), bf_lo(y[k][i].w), bf_hi(y[k][i].w)};
                    *(f32x4*)(o + 512 * i + 8 * lane) = a * rstd * fw[2 * i];
                    *(f32x4*)(o + 512 * i + 8 * lane + 4) = c * rstd * fw[2 * i + 1];
                }
            }
        }
    }
}

__global__ void __launch_bounds__(512) mega(Params p) {
    extern __shared__ __attribute__((aligned(16))) unsigned char shm[];
    LAS unsigned char* lds = (LAS unsigned char*)shm;
    cg::grid_group grid = cg::this_grid();
    volatile LAS unsigned* bst = (volatile LAS unsigned*)(lds + LDS_BYTES - 16);
    if (threadIdx.x < 2) bst[threadIdx.x] = 0u;
    __syncthreads();
    const XcdBarrier xb = xcd_barrier_post((unsigned*)(p.ws + OFF_BAR), bst);
    if (p.ws == nullptr) grid.sync();

#pragma unroll 1
    for (int rep = 0; rep < REP_PREP; ++rep) phase_prep(p, lds);
    xcd_barrier(xb);
#pragma unroll 1
    for (int rep = 0; rep < REP_G1; ++rep)
    {
        pg8::Gemm g{(const bf16_t*)(p.ws + OFF_HB), (const bf16_t*)(p.ws + OFF_WINT), MTOK, NG1, DM};
        pg8::StaticOrder S; S.init(g.M, g.N, (int)gridDim.x, (int)blockIdx.x);
        pg8::EpiP1 E{(bf16_t*)(p.ws + OFF_P1), NP1, (bf16_t*)(p.ws + OFF_KX)};
        pg8::gemm_phase<pg8::EpiP1, false>(lds, g, S, E);
        pg8::Gemm g2{(const bf16_t*)(p.ws + OFF_HB), (const bf16_t*)(p.ws + OFF_WINT) + (size_t)NG1 * DM, MTOK, 512, DM};
        pg8::StaticOrder S2; S2.init(g2.M, g2.N, (int)gridDim.x, (int)blockIdx.x);
        pg8::EpiVT E2{(bf16_t*)(p.ws + OFF_VT)};
        pg8::gemm_phase<pg8::EpiVT, true>(lds, g2, S2, E2);
    }
    xcd_barrier(xb);
#pragma unroll 1
    for (int rep = 0; rep < REP_GP; ++rep)
        for (int c2 = blockIdx.x; c2 < 2048; c2 += gridDim.x) gdn_prep(p, lds, c2);
    xcd_barrier(xb);
#pragma unroll 1
    for (int rep = 0; rep < REP_P3; ++rep) {
#pragma unroll 1
        for (int r2 = 0; r2 < REP_SCAN; ++r2)
            if (blockIdx.x < 64) gdn_scan(p, lds, blockIdx.x);
#if SCAN_SYNC
        xcd_barrier(xb);
#endif
        phase_attn(p, lds, rep);
#if REP_ATTN > 1
        xcd_barrier(xb);
        phase_attn(p, lds, 2);
#endif
#if REP_P3 > 1
        xcd_barrier(xb);
#endif
    }
    xcd_barrier(xb);
#pragma unroll 1
    for (int rnd = 0; rnd < 2; ++rnd) {
        pg8::Gemm g{(const bf16_t*)(p.ws + OFF_HB), (const bf16_t*)(p.ws + OFF_WOUTT), MTOK, DM, DM};
        pg8::StaticOrder S; S.init(g.M, g.N, (int)gridDim.x, (int)blockIdx.x); S.i0 = rnd; S.imax = 1;
        pg8::EpiOutFused E{p.x, p.out, (float*)(p.ws + OFF_ROWSQ), p.final_norm_w, xb};
        pg8::Unit u0;
        if (S.next(0, u0)) pg8::gemm_phase<pg8::EpiOutFused, false>(lds, g, S, E);
        else xcd_barrier(xb);
    }
}

extern "C" void kernel_launch(void* const* d_in, const int* in_sizes, int n_in, void* d_out, int out_size, void* d_ws, size_t ws_size, hipStream_t stream) {
    static int grid = 0;
    if (grid == 0) {
        if (ws_size < WS_END) { fprintf(stderr, "kernel_launch: workspace too small (%zu < %zu)\n", ws_size, (size_t)WS_END); grid = -1; return; }
        int dev = 0, cus = 0, per_cu = 0;
        hipGetDevice(&dev);
        hipDeviceGetAttribute(&cus, hipDeviceAttributeMultiprocessorCount, dev);
        if (hipFuncSetAttribute((const void*)mega, hipFuncAttributeMaxDynamicSharedMemorySize, LDS_BYTES) != hipSuccess) { fprintf(stderr, "kernel_launch: hipFuncSetAttribute failed\n"); grid = -1; return; }
        if (hipOccupancyMaxActiveBlocksPerMultiprocessor(&per_cu, (const void*)mega, 512, LDS_BYTES) != hipSuccess || per_cu < 1) per_cu = 1;
        (void)hipGetLastError();
        grid = cus * (per_cu > 1 ? 1 : per_cu);
    }
    if (grid < 0) return;
    Params p{};
    p.x = (const float*)d_in[0]; p.norm_w = (const float*)d_in[1]; p.w_in = (const float*)d_in[2]; p.conv_w = (const float*)d_in[3];
    p.a_log = (const float*)d_in[4]; p.dt_bias = (const float*)d_in[5]; p.gdn_norm_w = (const float*)d_in[6];
    p.lq1 = (const float*)d_in[7]; p.lk1 = (const float*)d_in[8]; p.lq2 = (const float*)d_in[9]; p.lk2 = (const float*)d_in[10];
    p.diff_norm_w = (const float*)d_in[11]; p.w_out = (const float*)d_in[12]; p.final_norm_w = (const float*)d_in[13];
    p.out = (float*)d_out; p.ws = (unsigned char*)d_ws;
    if (hipMemsetAsync((unsigned char*)d_ws + OFF_BAR, 0, 16384, stream) != hipSuccess) { fprintf(stderr, "kernel_launch: hipMemsetAsync failed\n"); return; }
    void* args[] = {&p};
    hipError_t e = hipLaunchCooperativeKernel((const void*)mega, dim3(grid), dim3(512), args, LDS_BYTES, stream);
    if (e != hipSuccess) fprintf(stderr, "cooperative launch failed: %s (grid %d)\n", hipGetErrorString(e), grid);
}
```

```cpp
#include <hip/hip_runtime.h>
#include <hip/hip_cooperative_groups.h>
#include <cstdio>
namespace cg = cooperative_groups;

#ifndef ENABLE_ATTN
#define ENABLE_ATTN 1
#endif
#ifndef ENABLE_GDN
#define ENABLE_GDN 1
#endif
#ifndef REP_PREP
#define REP_PREP 1
#endif
#ifndef REP_G1
#define REP_G1 1
#endif
#ifndef REP_GP
#define REP_GP 1
#endif
#ifndef REP_P3
#define REP_P3 1
#endif
#ifndef REP_G2
#define REP_G2 1
#endif
#ifndef REP_SCAN
#define REP_SCAN 1
#endif
#ifndef SCAN_SYNC
#define SCAN_SYNC 0
#endif
#ifndef REP_ATTN
#define REP_ATTN 1
#endif

#define LAS __attribute__((address_space(3)))
#define DI __device__ __forceinline__
typedef unsigned short bf16_t;
typedef short bf16x8 __attribute__((ext_vector_type(8)));
typedef short s16x4 __attribute__((ext_vector_type(4)));
typedef float f32x2 __attribute__((ext_vector_type(2)));
typedef float f32x4 __attribute__((ext_vector_type(4)));
typedef float f32x16 __attribute__((ext_vector_type(16)));
typedef unsigned u32x2 __attribute__((ext_vector_type(2)));
typedef unsigned u32x4 __attribute__((ext_vector_type(4)));
typedef __bf16 bf16x2_t __attribute__((ext_vector_type(2)));

#define MFMA32(a, b, c) __builtin_amdgcn_mfma_f32_32x32x16_bf16((a), (b), (c), 0, 0, 0)

constexpr int NB = 16, SEQ = 2048, DM = 1024, MTOK = NB * SEQ, NP1 = 3072, NG1 = 3584;
constexpr int C_GQ = 0, C_GK = 512, C_GV = 1024, C_GZ = 1536, C_DQ = 2048, C_DZ = 2560;
constexpr float EPS = 1e-6f;
constexpr float LOG2E = 1.4426950408889634f;

constexpr size_t OFF_HB = 0;
constexpr size_t OFF_WINT = OFF_HB + (size_t)MTOK * DM * 2;
constexpr size_t OFF_WOUTT = OFF_WINT + (size_t)4096 * 1024 * 2;
constexpr size_t OFF_GBGA = OFF_WOUTT + (size_t)1024 * 1024 * 2;
constexpr size_t OFF_P1 = OFF_GBGA + (size_t)MTOK * 8 * 4;
constexpr size_t OFF_KX = OFF_P1 + (size_t)MTOK * NP1 * 2;
constexpr size_t OFF_VT = OFF_KX + (size_t)64 * 2 * 2048 * 64 * 2;
constexpr size_t OFF_WN = OFF_VT + (size_t)64 * 128 * 2048 * 2;
constexpr size_t OFF_QD = OFF_WN + (size_t)2048 * 64 * 128 * 2;
constexpr size_t OFF_KD = OFF_QD + (size_t)2048 * 64 * 128 * 2;
constexpr size_t OFF_AQK = OFF_KD + (size_t)2048 * 64 * 128 * 2;
constexpr size_t OFF_U = OFF_AQK + (size_t)2048 * 64 * 64 * 2;
constexpr size_t OFF_GL = OFF_U + (size_t)2048 * 64 * 128 * 4;
constexpr size_t OFF_ROWSQ = OFF_GL + 8192;
constexpr size_t OFF_MISC = OFF_ROWSQ + (size_t)MTOK * 16 * 4;
constexpr size_t OFF_YB = OFF_P1;
constexpr size_t OFF_BAR = OFF_MISC + 256;
constexpr size_t WS_END = OFF_BAR + 16384;

constexpr int LDS_BYTES = 156 * 1024;

struct Params {
    const float *x, *norm_w, *w_in, *conv_w, *a_log, *dt_bias, *gdn_norm_w, *lq1, *lk1, *lq2, *lk2, *diff_norm_w, *w_out, *final_norm_w;
    float* out; unsigned char* ws;
};

DI unsigned pk_bf16(float a, float b) { f32x2 v = {a, b}; bf16x2_t r = __builtin_convertvector(v, bf16x2_t); return __builtin_bit_cast(unsigned, r); }
DI float bf_lo(unsigned u) { return __uint_as_float(u << 16); }
DI float bf_hi(unsigned u) { return __uint_as_float(u & 0xffff0000u); }
DI float wave_sum(float v) {
#pragma unroll
    for (int o = 32; o; o >>= 1) v += __shfl_xor(v, o);
    return v;
}
DI float silu_f(float z) { return z * __builtin_amdgcn_rcpf(1.0f + __builtin_amdgcn_exp2f(-LOG2E * z)); }
DI int perm23(int t) { return (t & ~12) | ((t & 4) << 1) | ((t & 8) >> 1); }
DI int crow(int i, int h2) { return (i & 3) + 8 * (i >> 2) + 4 * h2; }
DI bf16x8 pack8(const f32x16& x, int s) {
    u32x4 w; w.x = pk_bf16(x[8 * s + 0], x[8 * s + 1]); w.y = pk_bf16(x[8 * s + 2], x[8 * s + 3]); w.z = pk_bf16(x[8 * s + 4], x[8 * s + 5]); w.w = pk_bf16(x[8 * s + 6], x[8 * s + 7]);
    return __builtin_bit_cast(bf16x8, w);
}


#define XB_TMO      128
#define XB_XCNT(j)  (256  + 64 * (j))
#define XB_XSUB(j)  (1280 + 64 * (j))
#define XB_XGEN(j)  (2304 + 64 * (j))
#define XB_TOP      3328
#define XB_TOPGEN   3392
#define XCD_BAR_WORDS 3456
#define XB_SPIN_CAP (1u << 18)
struct XcdBarrier { unsigned* bar; unsigned x; volatile LAS unsigned* st; };
DI unsigned xb_ld(unsigned* p)              { return __hip_atomic_load(p, __ATOMIC_RELAXED, __HIP_MEMORY_SCOPE_AGENT); }
DI unsigned xb_add(unsigned* p, unsigned v) { return __hip_atomic_fetch_add(p, v, __ATOMIC_RELAXED, __HIP_MEMORY_SCOPE_AGENT); }
DI unsigned xb_xcc_id() { return (unsigned)__builtin_amdgcn_s_getreg((3 << 11) | 20) & 0xFu; }
#define XB_SPIN(cond, bar) do { unsigned _sp = 0; while (cond) { __builtin_amdgcn_s_sleep(1); \
    if ((++_sp & 255u) == 0u) { if (xb_ld(&(bar)[XB_TMO])) break; if (_sp > XB_SPIN_CAP) { atomicAdd(&(bar)[XB_TMO], 1u); break; } } } } while (0)
DI XcdBarrier xcd_barrier_post(unsigned* bar, volatile LAS unsigned* st) {
    XcdBarrier b; b.bar = bar; b.x = xb_xcc_id(); b.st = st;
    if (threadIdx.x == 0) (void)xb_add(&bar[XB_XCNT(b.x)], 1u);
    return b;
}
DI void xcd_barrier_complete(unsigned* bar, unsigned x, unsigned& nloc, unsigned& nx) {
    const unsigned G = gridDim.x * gridDim.y * gridDim.z;
    unsigned sum, cnt, mine, sp = 0u;
    for (;;) {
        sum = 0u; cnt = 0u; mine = 0u;
#pragma unroll
        for (unsigned j = 0; j < 16; ++j) { const unsigned c = xb_ld(&bar[XB_XCNT(j)]); sum += c; cnt += (c > 0u) ? 1u : 0u; mine = (j == x) ? c : mine; }
        if (sum == G) break;
        __builtin_amdgcn_s_sleep(1);
        if ((++sp & 255u) == 0u) { if (xb_ld(&bar[XB_TMO])) break; if (sp > XB_SPIN_CAP) { atomicAdd(&bar[XB_TMO], 1u); break; } }
    }
    nloc = mine > 0u ? mine : 1u; nx = cnt > 0u ? cnt : 1u;
}
DI void xcd_barrier(const XcdBarrier& b) {
    asm volatile("s_waitcnt vmcnt(0)" ::: "memory");
    __syncthreads();
    if (threadIdx.x == 0) {
        unsigned* bar = b.bar;
        __builtin_amdgcn_s_waitcnt(0);
        unsigned nloc = b.st[0], nx = b.st[1];
        if (nloc == 0u) { xcd_barrier_complete(bar, b.x, nloc, nx); b.st[0] = nloc; b.st[1] = nx; }
        const unsigned old = xb_add(&bar[XB_XSUB(b.x)], 1u);
        const unsigned gen = old / nloc;
        if (old + 1u == (gen + 1u) * nloc) {
            __builtin_amdgcn_fence(__ATOMIC_RELEASE, "agent");
            asm volatile("s_waitcnt vmcnt(0)" ::: "memory");
            const unsigned og = xb_add(&bar[XB_TOP], 1u);
            const unsigned tg = og / nx;
            if (og + 1u == (tg + 1u) * nx) xb_add(&bar[XB_TOPGEN], 1u);
            else XB_SPIN(xb_ld(&bar[XB_TOPGEN]) == tg, bar);
            __builtin_amdgcn_fence(__ATOMIC_ACQUIRE, "agent");
            xb_add(&bar[XB_XGEN(b.x)], 1u);
            asm volatile("s_waitcnt vmcnt(0)" ::: "memory");
        } else {
            XB_SPIN(xb_ld(&bar[XB_XGEN(b.x)]) == gen, bar);
            __builtin_amdgcn_fence(__ATOMIC_ACQUIRE, "agent");
            asm volatile("s_waitcnt vmcnt(0)" ::: "memory");
        }
    }
    __syncthreads();
}

namespace pg8 {
constexpr int BM = 256, BK = 64, HALF = 128, HTB = HALF * BK * 2, STAGE_BYTES = 8 * HTB, NXCD = 8, WGM = 8;
DI int lds_byte(int r, int c) { const int st = (r >> 4) * 2 + (c >> 5), rr = r & 15, cc = c & 31, ob = rr * 64 + cc * 2; return st * 1024 + (ob ^ (((ob >> 9) & 1) << 5)); }
DI void stage_rc(int b, int& R, int& C) { const int st = b / 1024, sb = b % 1024, swz = sb ^ (((sb >> 9) & 1) << 5); R = (st >> 1) * 16 + swz / 64; C = (st & 1) * 32 + (swz % 64) / 2; }
DI int perm32(int rho) { const int n = rho >> 4, i = rho & 15; return 8 * (i >> 2) + 4 * n + (i & 3); }
struct Unit { int pm, pn; };
struct Gemm { const bf16_t* A; const bf16_t* Bt; int M, N, K; };
struct StaticOrder {
    int nM, nN, nwg, G, c, i0 = 0, imax = 1 << 30;
    DI void init(int M, int N, int G_, int c_) { nM = M / BM; nN = N / BM; nwg = nM * nN; G = G_; c = c_; }
    DI bool next(int i, Unit& u) const {
        if (i >= imax) return false;
        const long L = (long)(i + i0) * G + c; if (L >= nwg) return false;
        int wgid = (int)L; { const int q = nwg / NXCD, r = nwg % NXCD, xcd = wgid % NXCD, off = wgid / NXCD; wgid = (xcd < r ? xcd * (q + 1) : r * (q + 1) + (xcd - r) * q) + off; }
        const int nig = WGM * nN, gid = wgid / nig, fm = gid * WGM, gsz = (nM - fm) < WGM ? (nM - fm) : WGM;
        u.pm = fm + ((wgid % nig) % gsz); u.pn = (wgid % nig) / gsz; return true;
    }
    DI void a_ready(const Unit&) const {}
    DI void done(const Unit&) const {}
};

struct EpiP1 {
    static constexpr bool PERM = true, AFTER_DRAIN = false;
    bf16_t* O; int ldc; bf16_t* KX;
    DI void operator()(const f32x4 (&acc)[2][2][4][2], const Unit& u, int wr, int wc, int fr, int fq) const {
        const int row0 = u.pm * BM + wr * 64 + fr, col0 = u.pn * BM + wc * 32 + 8 * fq;
        if (u.pn >= 12) {
#pragma unroll
            for (int ai = 0; ai < 2; ++ai)
#pragma unroll
                for (int m = 0; m < 4; ++m) { const int row = row0 + ai * HALF + m * 16, b = row >> 11, tok = row & 2047;
#pragma unroll
                    for (int bj = 0; bj < 2; ++bj) { const f32x4 v0 = acc[ai][bj][m][0], v1 = acc[ai][bj][m][1];
                        const int c = col0 - 12 * BM + bj * HALF, hm = c >> 6, d = c & 63;
                        u32x4 w; w.x = pk_bf16(v0[0], v0[1]); w.y = pk_bf16(v0[2], v0[3]); w.z = pk_bf16(v1[0], v1[1]); w.w = pk_bf16(v1[2], v1[3]);
                        *(u32x4*)(KX + ((size_t)(b * 8 + hm) * 2048 + tok) * 64 + d) = w; } }
            return;
        }
#pragma unroll
        for (int ai = 0; ai < 2; ++ai)
#pragma unroll
            for (int m = 0; m < 4; ++m) { bf16_t* rowp = O + (size_t)(row0 + ai * HALF + m * 16) * ldc + col0;
#pragma unroll
                for (int bj = 0; bj < 2; ++bj) { const f32x4 v0 = acc[ai][bj][m][0], v1 = acc[ai][bj][m][1];
                    u32x4 w; w.x = pk_bf16(v0[0], v0[1]); w.y = pk_bf16(v0[2], v0[3]); w.z = pk_bf16(v1[0], v1[1]); w.w = pk_bf16(v1[2], v1[3]);
                    *(u32x4*)(rowp + bj * HALF) = w; } }
    }
};
struct EpiVT {
    static constexpr bool PERM = false, AFTER_DRAIN = false;
    bf16_t* VT;
    DI void operator()(const f32x4 (&acc)[2][2][4][2], const Unit& u, int wr, int wc, int fr, int fq) const {
#pragma unroll
        for (int ai = 0; ai < 2; ++ai)
#pragma unroll
            for (int m = 0; m < 4; ++m) {
                const int t = u.pm * BM + ai * HALF + wr * 64 + m * 16 + 4 * fq, b = t >> 11, tok = t & 2047, pos = perm23(tok);
#pragma unroll
                for (int bj = 0; bj < 2; ++bj)
#pragma unroll
                    for (int n = 0; n < 2; ++n) {
                        const int c = u.pn * BM + bj * HALF + wc * 32 + n * 16 + fr, hh = c >> 7, dv = c & 127;
                        const f32x4 v = acc[ai][bj][m][n];
                        u32x2 w; w.x = pk_bf16(v[0], v[1]); w.y = pk_bf16(v[2], v[3]);
                        *(u32x2*)(VT + (((size_t)((b * 4 + hh) * 32 + (pos >> 6)) * 128 + dv)) * 64 + (pos & 63)) = w;
                    }
            }
    }
};
struct EpiOutFused {
    static constexpr bool PERM = false, AFTER_DRAIN = true;
    const float* X; float* Out; float* rowsq; const float* fw; XcdBarrier xb;
    DI void operator()(const f32x4 (&)[2][2][4][2], const Unit&, int, int, int, int) const {}
    DI void fused(f32x4 (&acc)[2][2][4][2], const Unit& u, int wr, int wc, int fr, int fq) const {
        const int row0 = u.pm * BM + wr * 64 + fr, col0 = u.pn * BM + wc * 32 + 4 * fq;
#pragma unroll
        for (int ai = 0; ai < 2; ++ai)
#pragma unroll
            for (int m = 0; m < 4; ++m) {
                const int row = row0 + ai * HALF + m * 16; float ss = 0.f;
#pragma unroll
                for (int bj = 0; bj < 2; ++bj)
#pragma unroll
                    for (int n = 0; n < 2; ++n) {
                        const size_t o = (size_t)row * DM + col0 + bj * HALF + n * 16;
                        const f32x4 y = acc[ai][bj][m][n] + *(const f32x4*)(X + o);
                        acc[ai][bj][m][n] = y; ss += y[0] * y[0] + y[1] * y[1] + y[2] * y[2] + y[3] * y[3];
                    }
                ss += __shfl_xor(ss, 16); ss += __shfl_xor(ss, 32);
                if (fq == 0) rowsq[(size_t)row * 16 + u.pn * 4 + wc] = ss;
            }
        xcd_barrier(xb);
        f32x4 fwv[2][2];
#pragma unroll
        for (int bj = 0; bj < 2; ++bj)
#pragma unroll
            for (int n = 0; n < 2; ++n) fwv[bj][n] = *(const f32x4*)(fw + col0 + bj * HALF + n * 16);
#pragma unroll
        for (int ai = 0; ai < 2; ++ai)
#pragma unroll
            for (int m = 0; m < 4; ++m) {
                const int row = row0 + ai * HALF + m * 16;
                const f32x4* rq = (const f32x4*)(rowsq + (size_t)row * 16);
                const f32x4 q0 = rq[0], q1 = rq[1], q2 = rq[2], q3 = rq[3];
                const float tot = ((q0[0] + q0[1]) + (q0[2] + q0[3])) + ((q1[0] + q1[1]) + (q1[2] + q1[3])) + ((q2[0] + q2[1]) + (q2[2] + q2[3])) + ((q3[0] + q3[1]) + (q3[2] + q3[3]));
                const float rstd = rsqrtf(tot * (1.0f / DM) + EPS);
#pragma unroll
                for (int bj = 0; bj < 2; ++bj)
#pragma unroll
                    for (int n = 0; n < 2; ++n) {
                        const size_t o = (size_t)row * DM + col0 + bj * HALF + n * 16;
                        *(f32x4*)(Out + o) = acc[ai][bj][m][n] * rstd * fwv[bj][n];
                    }
            }
    }
};

template <class Epi, bool SWAP>
DI void gemm_phase(LAS unsigned char* lds, const Gemm g, const StaticOrder& S, const Epi& E) {
    int tid = threadIdx.x; asm volatile("" : "+v"(tid));
    const int wid = __builtin_amdgcn_readfirstlane(tid >> 6), lane = tid & 63, wr = wid >> 2, wc = wid & 3, fr = lane & 15, fq = lane >> 4;
    const int K = g.K, nt = K / BK;
    unsigned voffA[2], voffB[2];
#pragma unroll
    for (int i = 0; i < 2; ++i) { int R, C; stage_rc(tid * 16 + i * 8192, R, C); const int Rb = Epi::PERM ? ((R & ~31) + perm32(R & 31)) : R;
        voffA[i] = (unsigned)(R * K + C) * 2u; voffB[i] = (unsigned)(Rb * K + C) * 2u; }
    const size_t kstep = (size_t)(BK * 2);
    const size_t hstep = (size_t)HALF * K * 2;
    const size_t tstep = 2 * hstep;
    const unsigned ldsw = (unsigned)wid * 1024u;
    const int aoff = lds_byte(wr * 64 + fr, fq * 8), boff = lds_byte(wc * 32 + fr, fq * 8);
#define PG8_SA(b, h) (((b) * 2 + (h)) * HTB)
#define PG8_SB(b, h) ((4 + (b) * 2 + (h)) * HTB)
#define PG8_STAGE(bufoff, gbase, voff) do { _Pragma("unroll") for (int _i = 0; _i < 2; ++_i) \
        __builtin_amdgcn_global_load_lds((const unsigned*)((const char*)(gbase) + (voff)[_i]), (LAS unsigned*)(lds + (bufoff) + ldsw + _i * 8192), 16, 0, 0); } while (0)
#define PG8_LDA(dst, b, h) do { _Pragma("unroll") for (int m = 0; m < 4; ++m) _Pragma("unroll") for (int k = 0; k < 2; ++k) dst[m][k] = *(const LAS bf16x8*)(lds + PG8_SA(b, h) + aoff + m * 2048 + k * 1024); } while (0)
#define PG8_LDB(dst, b, h) do { _Pragma("unroll") for (int n = 0; n < 2; ++n) _Pragma("unroll") for (int k = 0; k < 2; ++k) dst[n][k] = *(const LAS bf16x8*)(lds + PG8_SB(b, h) + boff + n * 2048 + k * 1024); } while (0)
#define PG8_MMA(ai, bj, At, Bt) do { __builtin_amdgcn_s_setprio(1); _Pragma("unroll") for (int m = 0; m < 4; ++m) _Pragma("unroll") for (int n = 0; n < 2; ++n) _Pragma("unroll") for (int k = 0; k < 2; ++k) \
        acc[ai][bj][m][n] = SWAP ? __builtin_amdgcn_mfma_f32_16x16x32_bf16(At[m][k], Bt[n][k], acc[ai][bj][m][n], 0, 0, 0) \
                                 : __builtin_amdgcn_mfma_f32_16x16x32_bf16(Bt[n][k], At[m][k], acc[ai][bj][m][n], 0, 0, 0); __builtin_amdgcn_s_setprio(0); } while (0)
#define PG8_WAIT_V(n) asm volatile("s_waitcnt vmcnt(" #n ")" ::: "memory")
#define PG8_WAIT_L(n) asm volatile("s_waitcnt lgkmcnt(" #n ")" ::: "memory")
#define PG8_BAR __builtin_amdgcn_s_barrier()
#define PG8_SCHED __builtin_amdgcn_sched_barrier(0)
    Unit cur, nxt; int ui = 0;
    if (!S.next(0, cur)) return;
    f32x4 acc[2][2][4][2];
#pragma unroll
    for (int a = 0; a < 2; ++a)
#pragma unroll
        for (int b = 0; b < 2; ++b)
#pragma unroll
            for (int m = 0; m < 4; ++m)
#pragma unroll
                for (int n = 0; n < 2; ++n) acc[a][b][m][n] = (f32x4){0.f, 0.f, 0.f, 0.f};
    bf16x8 At[4][2], B0[2][2], B1[2][2];
    const char* cA = (const char*)g.A + (size_t)cur.pm * tstep; const char* cB = (const char*)g.Bt + (size_t)cur.pn * tstep;
    PG8_STAGE(PG8_SB(0, 0), cB, voffB); PG8_STAGE(PG8_SA(0, 0), cA, voffA); PG8_STAGE(PG8_SB(0, 1), cB + hstep, voffB); PG8_STAGE(PG8_SA(0, 1), cA + hstep, voffA);
    if (wr == 1) PG8_BAR;
    PG8_WAIT_V(4); PG8_BAR;
    PG8_STAGE(PG8_SB(1, 0), cB + kstep, voffB); PG8_STAGE(PG8_SA(1, 0), cA + kstep, voffA); PG8_STAGE(PG8_SB(1, 1), cB + hstep + kstep, voffB);
    PG8_WAIT_V(6); PG8_BAR;
    for (;;) {
        const bool has_next = S.next(ui + 1, nxt);
        const char* nA = has_next ? (const char*)g.A + (size_t)nxt.pm * tstep : cA; const char* nB = has_next ? (const char*)g.Bt + (size_t)nxt.pn * tstep : cB;
        for (int t = 0; t < nt; t += 2) {
            const bool last = (t == nt - 2);
            const char* a1 = cA + (size_t)(t + 1) * kstep;
            const char* a2 = last ? nA : cA + (size_t)(t + 2) * kstep; const char* b2 = last ? nB : cB + (size_t)(t + 2) * kstep;
            const char* a3 = a2 + kstep; const char* b3 = b2 + kstep;
            PG8_LDB(B0, 0, 0); PG8_SCHED; PG8_LDA(At, 0, 0); PG8_STAGE(PG8_SA(1, 1), a1 + hstep, voffA);
            PG8_WAIT_L(8); PG8_BAR; PG8_WAIT_L(0); PG8_MMA(0, 0, At, B0); PG8_BAR; PG8_SCHED;
            PG8_LDB(B1, 0, 1); PG8_STAGE(PG8_SB(0, 0), b2, voffB);
            PG8_BAR; PG8_WAIT_L(0); PG8_MMA(0, 1, At, B1); PG8_BAR;
            PG8_LDA(At, 0, 1); PG8_STAGE(PG8_SA(0, 0), a2, voffA);
            PG8_BAR; PG8_WAIT_L(0); PG8_MMA(1, 0, At, B0); PG8_BAR; PG8_SCHED;
            PG8_STAGE(PG8_SB(0, 1), b2 + hstep, voffB);
            PG8_WAIT_V(6); PG8_BAR; PG8_MMA(1, 1, At, B1); PG8_BAR;
            PG8_LDB(B0, 1, 0); PG8_SCHED; PG8_LDA(At, 1, 0); PG8_STAGE(PG8_SA(0, 1), a2 + hstep, voffA);
            PG8_WAIT_L(8); PG8_BAR; PG8_WAIT_L(0); PG8_MMA(0, 0, At, B0); PG8_BAR; PG8_SCHED;
            PG8_LDB(B1, 1, 1); PG8_STAGE(PG8_SB(1, 0), b3, voffB);
            PG8_BAR; PG8_WAIT_L(0); PG8_MMA(0, 1, At, B1); PG8_BAR;
            PG8_LDA(At, 1, 1); PG8_STAGE(PG8_SA(1, 0), a3, voffA);
            PG8_BAR; PG8_WAIT_L(0); PG8_MMA(1, 0, At, B0); PG8_BAR; PG8_SCHED;
            PG8_STAGE(PG8_SB(1, 1), b3 + hstep, voffB);
            PG8_WAIT_V(6); PG8_BAR; PG8_MMA(1, 1, At, B1); PG8_BAR;
        }
        if constexpr (!Epi::AFTER_DRAIN) E(acc, cur, wr, wc, fr, fq);
        if (!has_next) break;
#pragma unroll
        for (int a = 0; a < 2; ++a)
#pragma unroll
            for (int b = 0; b < 2; ++b)
#pragma unroll
                for (int m = 0; m < 4; ++m)
#pragma unroll
                    for (int n = 0; n < 2; ++n) acc[a][b][m][n] = (f32x4){0.f, 0.f, 0.f, 0.f};
        cur = nxt; cA = nA; cB = nB; ++ui;
    }
    PG8_WAIT_V(0);
    if (wr == 0) PG8_BAR;
    PG8_BAR;
    if constexpr (Epi::AFTER_DRAIN) E.fused(acc, cur, wr, wc, fr, fq);
#undef PG8_SA
#undef PG8_SB
#undef PG8_STAGE
#undef PG8_LDA
#undef PG8_LDB
#undef PG8_MMA
#undef PG8_WAIT_V
#undef PG8_WAIT_L
#undef PG8_BAR
#undef PG8_SCHED
}
}

DI int win_src_col(int n0) {
    if (n0 < 2048) return n0;
    if (n0 < 2560) return 2056 + (n0 - 2048);
    if (n0 < 3072) return 3592 + (n0 - 2560);
    if (n0 < 3584) return 2568 + (n0 - 3072);
    return 3080 + (n0 - 3584);
}
DI void phase_prep(const Params& p, LAS unsigned char* lds) {
    int tid = threadIdx.x; asm volatile("" : "+v"(tid));
    const int lane = tid & 63, wid = tid >> 6;
    if (blockIdx.x == 0 && wid == 0) {
        float a = p.lq1[lane] * p.lk1[lane], b = p.lq2[lane] * p.lk2[lane];
        a = wave_sum(a); b = wave_sum(b);
        if (lane == 0) { *(float*)(p.ws + OFF_MISC) = expf(a) - expf(b) + 0.2f; *(unsigned*)(p.ws + OFF_MISC + 4) = 0u; *(unsigned*)(p.ws + OFF_MISC + 8) = 0u; *(unsigned*)(p.ws + OFF_MISC + 12) = 0u; }
    }
    bf16_t* hb = (bf16_t*)(p.ws + OFF_HB);
    float* gbga = (float*)(p.ws + OFF_GBGA);
    const int gw = blockIdx.x * 8 + wid, nw = gridDim.x * 8;
    {
        f32x4 nwv[4]; float wq[16][8];
#pragma unroll
        for (int i = 0; i < 4; ++i) {
            nwv[i] = ((const f32x4*)p.norm_w)[lane + 64 * i];
#pragma unroll
            for (int e = 0; e < 4; ++e) {
                const int k = 4 * (lane + 64 * i) + e;
                const f32x4* wp = (const f32x4*)(p.w_in + (size_t)k * 4104 + 2048);
                const f32x4 w0 = wp[0], w1 = wp[1];
#pragma unroll
                for (int j = 0; j < 4; ++j) { wq[4 * i + e][j] = nwv[i][e] * w0[j]; wq[4 * i + e][4 + j] = nwv[i][e] * w1[j]; }
            }
        }
        const bool b5 = (lane & 32) != 0, b4 = (lane & 16) != 0, b3 = (lane & 8) != 0;
        const int col = (b5 ? 4 : 0) + (b4 ? 2 : 0) + (b3 ? 1 : 0);
        int row = gw;
        f32x4 v[4];
        if (row < MTOK) {
#pragma unroll
            for (int i = 0; i < 4; ++i) v[i] = ((const f32x4*)(p.x + (size_t)row * DM))[lane + 64 * i];
        }
#pragma unroll 1
        for (; row < MTOK; row += nw) {
            f32x4 vnx[4];
            const int rnx = (row + nw < MTOK) ? row + nw : row;
#pragma unroll
            for (int i = 0; i < 4; ++i) vnx[i] = ((const f32x4*)(p.x + (size_t)rnx * DM))[lane + 64 * i];
            float ss = 0.f, a8[8];
#pragma unroll
            for (int j = 0; j < 8; ++j) a8[j] = 0.f;
#pragma unroll
            for (int i = 0; i < 4; ++i)
#pragma unroll
                for (int e = 0; e < 4; ++e) {
                    ss += v[i][e] * v[i][e];
#pragma unroll
                    for (int j = 0; j < 8; ++j) a8[j] += v[i][e] * wq[4 * i + e][j];
                }
            ss = wave_sum(ss);
            const float rstd = rsqrtf(ss * (1.0f / DM) + EPS);
#pragma unroll
            for (int i = 0; i < 4; ++i) {
                const f32x4 h = v[i] * rstd * nwv[i];
                u32x2 w; w.x = pk_bf16(h[0], h[1]); w.y = pk_bf16(h[2], h[3]);
                *(u32x2*)(hb + (size_t)row * DM + 4 * (lane + 64 * i)) = w;
            }
            float c4[4], c2[2], c1;
#pragma unroll
            for (int j = 0; j < 4; ++j) { const float send = b5 ? a8[j] : a8[4 + j], keep = b5 ? a8[4 + j] : a8[j]; c4[j] = keep + __shfl_xor(send, 32); }
#pragma unroll
            for (int j = 0; j < 2; ++j) { const float send = b4 ? c4[j] : c4[2 + j], keep = b4 ? c4[2 + j] : c4[j]; c2[j] = keep + __shfl_xor(send, 16); }
            { const float send = b3 ? c2[0] : c2[1], keep = b3 ? c2[1] : c2[0]; c1 = keep + __shfl_xor(send, 8); }
            c1 += __shfl_xor(c1, 4); c1 += __shfl_xor(c1, 2); c1 += __shfl_xor(c1, 1);
            if ((lane & 7) == 0) gbga[(size_t)row * 8 + col] = c1 * rstd;
#pragma unroll
            for (int i = 0; i < 4; ++i) v[i] = vnx[i];
        }
    }
    LAS float* tl = (LAS float*)lds;
    for (int tile = blockIdx.x; tile < 1024 + 256; tile += gridDim.x) {
        const float* src; int ld, n0, k0, srcn0; bf16_t* dst;
        if (tile < 1024) { n0 = (tile >> 4) * 64; k0 = (tile & 15) * 64; srcn0 = win_src_col(n0); src = p.w_in; ld = 4104; dst = (bf16_t*)(p.ws + OFF_WINT); }
        else { const int t2 = tile - 1024; n0 = (t2 >> 4) * 64; k0 = (t2 & 15) * 64; srcn0 = n0; src = p.w_out; ld = 1024; dst = (bf16_t*)(p.ws + OFF_WOUTT); }
        const int kk = tid >> 4, n4 = tid & 15;
#pragma unroll
        for (int ps = 0; ps < 2; ++ps) { const int k = kk + 32 * ps;
            const f32x4 v = *(const f32x4*)(src + (size_t)(k0 + k) * ld + srcn0 + 4 * n4);
#pragma unroll
            for (int e = 0; e < 4; ++e) tl[k * 65 + 4 * n4 + e] = v[e]; }
        __syncthreads();
        { const int n = tid >> 3, k8 = tid & 7; float f[8];
#pragma unroll
            for (int e = 0; e < 8; ++e) f[e] = tl[(8 * k8 + e) * 65 + n];
            u32x4 w; w.x = pk_bf16(f[0], f[1]); w.y = pk_bf16(f[2], f[3]); w.z = pk_bf16(f[4], f[5]); w.w = pk_bf16(f[6], f[7]);
            *(u32x4*)(dst + (size_t)(n0 + n) * 1024 + k0 + 8 * k8) = w; }
        __syncthreads();
    }
}

constexpr int AT_KB = 8192, AT_VB = 16384, AT_BUF = AT_KB + AT_VB, AT_NBUF = 3, AT_TASK = AT_NBUF * AT_BUF, AT_O1 = AT_TASK + 256;

DI void attn_qblock(const Params& p, LAS unsigned char* lds, int b, int hh, int qb, float lam) {
    int tid = threadIdx.x; asm volatile("" : "+v"(tid));
    const int lane = tid & 63, wid = __builtin_amdgcn_readfirstlane(tid >> 6);
    const bf16_t* P1 = (const bf16_t*)(p.ws + OFF_P1);
    const bf16_t* VT = (const bf16_t*)(p.ws + OFF_VT) + (size_t)(b * 4 + hh) * 32 * 128 * 64;
    const bf16_t* KX = (const bf16_t*)(p.ws + OFF_KX) + (size_t)(b * 4 + hh) * 2 * 2048 * 64;
    bf16_t* mix = (bf16_t*)(p.ws + OFF_HB);
    const int q0 = qb * 256 + wid * 32;
    const size_t tokbase = (size_t)b * SEQ;
    const int nkt = (qb + 1) * 4;
    const float sl2 = exp2f(-2.0f * (float)(hh + 1)) * LOG2E;
    const float c1 = 0.125f * LOG2E;
#pragma unroll 1
    for (int map = 0; map < 2; ++map) {
        f32x16 O[4];
#pragma unroll
        for (int mt = 0; mt < 4; ++mt)
#pragma unroll
            for (int i = 0; i < 16; ++i) O[mt][i] = 0.f;
        float m = -INFINITY, l = 0.f;
        int lane_m = lane; asm volatile("" : "+v"(lane_m));
        const int r = lane_m & 31, h2 = lane_m >> 5;
        int foff[4];
#pragma unroll
        for (int k = 0; k < 4; ++k) foff[k] = r * 128 + (((2 * k + h2) ^ ((r >> 1) & 7)) << 4);
        float kb[16];
#pragma unroll
        for (int i = 0; i < 16; ++i) kb[i] = sl2 * (float)crow(i, h2);
        const int krow_ = 8 * wid + (lane_m >> 3), vrow0 = 16 * wid + (lane_m >> 3), vrow1 = vrow0 + 8;
        const bf16_t* kgp = KX + ((size_t)map * 2048 + krow_) * 64 + (((lane_m & 7) ^ ((krow_ >> 1) & 7)) * 8);
        const bf16_t* vgp0 = VT + (size_t)vrow0 * 64 + (((lane_m & 7) ^ ((vrow0 >> 1) & 7)) * 8);
        const bf16_t* vgp1 = VT + (size_t)vrow1 * 64 + (((lane_m & 7) ^ ((vrow1 >> 1) & 7)) * 8);
#define AT_STAGE(bufi, tile) do { LAS unsigned char* _b = lds + (bufi) * AT_BUF; \
            __builtin_amdgcn_global_load_lds((const unsigned*)(kgp + (size_t)(tile) * 64 * 64), (LAS unsigned*)(_b + wid * 1024), 16, 0, 0); \
            __builtin_amdgcn_global_load_lds((const unsigned*)(vgp0 + (size_t)(tile) * 128 * 64), (LAS unsigned*)(_b + AT_KB + wid * 2048), 16, 0, 0); \
            __builtin_amdgcn_global_load_lds((const unsigned*)(vgp1 + (size_t)(tile) * 128 * 64), (LAS unsigned*)(_b + AT_KB + wid * 2048 + 1024), 16, 0, 0); } while (0)
        bf16x8 qf[4];
        { const bf16_t* qp = P1 + (tokbase + q0 + (lane_m & 31)) * NP1 + C_DQ + hh * 128 + map * 64 + 8 * (lane_m >> 5);
#pragma unroll
            for (int ks = 0; ks < 4; ++ks) qf[ks] = *(const bf16x8*)(qp + 16 * ks); }
        AT_STAGE(0, 0);
        AT_STAGE(1, 1);
        asm volatile("" : "+v"(qf[0]), "+v"(qf[1]), "+v"(qf[2]), "+v"(qf[3]));
        int cb = 0;
#pragma unroll 1
        for (int kt = 0; kt < nkt; ++kt) {
            if (kt + 1 < nkt) asm volatile("s_waitcnt vmcnt(3)" ::: "memory"); else asm volatile("s_waitcnt vmcnt(0)" ::: "memory");
            __builtin_amdgcn_s_barrier();
            asm volatile("" ::: "memory");
            if (kt + 2 < nkt) { const int nb = cb == 0 ? 2 : cb - 1; AT_STAGE(nb, kt + 2); }
            const LAS unsigned char* cur = lds + cb * AT_BUF;
            cb = cb == 2 ? 0 : cb + 1;
            const int k0 = kt * 64;
            if (k0 <= q0) {
                const bool sub1 = (k0 + 32 <= q0);
                const LAS unsigned char* vb = cur + AT_KB;
                bf16x8 kf[8];
#pragma unroll
                for (int ks = 0; ks < 4; ++ks) kf[ks] = *(const LAS bf16x8*)(cur + foff[ks]);
                if (sub1) {
#pragma unroll
                    for (int ks = 0; ks < 4; ++ks) kf[4 + ks] = *(const LAS bf16x8*)(cur + 4096 + foff[ks]);
                }
                f32x16 s0, s1;
#pragma unroll
                for (int i = 0; i < 16; ++i) { s0[i] = 0.f; s1[i] = 0.f; }
#pragma unroll
                for (int ks = 0; ks < 4; ++ks) s0 = MFMA32(kf[ks], qf[ks], s0);
                if (sub1) {
#pragma unroll
                    for (int ks = 0; ks < 4; ++ks) s1 = MFMA32(kf[4 + ks], qf[ks], s1);
                }
                __builtin_amdgcn_sched_barrier(0);
                bf16x8 va[8];
#pragma unroll
                for (int s2 = 0; s2 < 2; ++s2)
#pragma unroll
                    for (int mt = 0; mt < 4; ++mt) va[s2 * 4 + mt] = *(const LAS bf16x8*)(vb + mt * 4096 + foff[s2]);
                __builtin_amdgcn_sched_barrier(0);
                const float off0 = sl2 * (float)(k0 - q0), off1 = off0 + 32.0f * sl2;
                const f32x2 c1v = {c1, c1};
#pragma unroll
                for (int j = 0; j < 8; ++j) {
                    const f32x2 kv = {kb[2 * j], kb[2 * j + 1]};
                    f32x2 a = {s0[2 * j], s0[2 * j + 1]}, c = {s1[2 * j], s1[2 * j + 1]};
                    a = __builtin_elementwise_fma(a, c1v, kv); c = __builtin_elementwise_fma(c, c1v, kv);
                    s0[2 * j] = a.x; s0[2 * j + 1] = a.y; s1[2 * j] = c.x; s1[2 * j + 1] = c.y;
                }
                if (k0 == q0) {
#pragma unroll
                    for (int i = 0; i < 16; ++i) if (crow(i, h2) > r) s0[i] = -INFINITY;
                }
                if (k0 + 32 == q0) {
#pragma unroll
                    for (int i = 0; i < 16; ++i) if (crow(i, h2) > r) s1[i] = -INFINITY;
                }
                float mx0 = fmaxf(s0[0], s0[1]), mx1 = fmaxf(s1[0], s1[1]);
#pragma unroll
                for (int j = 1; j < 8; ++j) { mx0 = fmaxf(fmaxf(s0[2 * j], s0[2 * j + 1]), mx0); mx1 = fmaxf(fmaxf(s1[2 * j], s1[2 * j + 1]), mx1); }
                float mx = sub1 ? fmaxf(mx0 + off0, mx1 + off1) : mx0 + off0;
                mx = fmaxf(mx, __shfl_xor(mx, 32));
                if (__builtin_amdgcn_ballot_w64(mx > m + 8.0f) != 0ull) {
                    const float mn = fmaxf(m, mx);
                    const float alpha = __builtin_amdgcn_exp2f(m - mn);
                    m = mn; l *= alpha;
#pragma unroll
                    for (int mt = 0; mt < 4; ++mt)
#pragma unroll
                        for (int i = 0; i < 16; ++i) O[mt][i] *= alpha;
                }
                const float r0 = m - off0, r1 = sub1 ? m - off1 : INFINITY;
                const f32x2 r0v = {r0, r0}, r1v = {r1, r1};
                f32x2 lsv = {0.f, 0.f};
#pragma unroll
                for (int j = 0; j < 8; ++j) {
                    f32x2 a = {s0[2 * j], s0[2 * j + 1]}, c = {s1[2 * j], s1[2 * j + 1]};
                    a = a - r0v; c = c - r1v;
                    a.x = __builtin_amdgcn_exp2f(a.x); a.y = __builtin_amdgcn_exp2f(a.y); c.x = __builtin_amdgcn_exp2f(c.x); c.y = __builtin_amdgcn_exp2f(c.y);
                    lsv = lsv + a; lsv = lsv + c;
                    s0[2 * j] = a.x; s0[2 * j + 1] = a.y; s1[2 * j] = c.x; s1[2 * j + 1] = c.y;
                }
                l += lsv.x + lsv.y;
                bf16x8 pf[4];
#pragma unroll
                for (int s = 0; s < 2; ++s) { pf[s] = pack8(s0, s); pf[2 + s] = pack8(s1, s); }
                __builtin_amdgcn_sched_barrier(0);
                bf16x8 vc[4], vd[4];
                if (sub1) {
#pragma unroll
                    for (int mt = 0; mt < 4; ++mt) vc[mt] = *(const LAS bf16x8*)(vb + mt * 4096 + foff[2]);
                }
#pragma unroll
                for (int mt = 0; mt < 4; ++mt) O[mt] = MFMA32(va[mt], pf[0], O[mt]);
                if (sub1) {
#pragma unroll
                    for (int mt = 0; mt < 4; ++mt) vd[mt] = *(const LAS bf16x8*)(vb + mt * 4096 + foff[3]);
                }
#pragma unroll
                for (int mt = 0; mt < 4; ++mt) O[mt] = MFMA32(va[4 + mt], pf[1], O[mt]);
                if (sub1) {
#pragma unroll
                    for (int mt = 0; mt < 4; ++mt) O[mt] = MFMA32(vc[mt], pf[2], O[mt]);
#pragma unroll
                    for (int mt = 0; mt < 4; ++mt) O[mt] = MFMA32(vd[mt], pf[3], O[mt]);
                }
            }
        }
        asm volatile("" ::: "memory");
        __builtin_amdgcn_s_barrier();
        asm volatile("" ::: "memory");
#undef AT_STAGE
        const float lt = l + __shfl_xor(l, 32);
        int lane_o = lane; asm volatile("" : "+v"(lane_o));
        LAS unsigned* o1l = (LAS unsigned*)(lds + AT_O1 + wid * 8192) + lane_o;
        if (map == 0) {
            const float inv1 = 1.0f / lt;
#pragma unroll
            for (int mt = 0; mt < 4; ++mt)
#pragma unroll
                for (int j = 0; j < 8; ++j) o1l[(mt * 8 + j) * 64] = pk_bf16(O[mt][2 * j] * inv1, O[mt][2 * j + 1] * inv1);
        } else {
            const float inv2 = lam / lt;
            float ss = 0.f;
#pragma unroll
            for (int mt = 0; mt < 4; ++mt)
#pragma unroll
                for (int j = 0; j < 8; ++j) {
                    const unsigned o1 = o1l[(mt * 8 + j) * 64];
                    const float a = bf_lo(o1) - O[mt][2 * j] * inv2, c = bf_hi(o1) - O[mt][2 * j + 1] * inv2;
                    O[mt][2 * j] = a; O[mt][2 * j + 1] = c; ss += a * a + c * c;
                }
            ss += __shfl_xor(ss, 32);
            const float rs = rsqrtf(ss * (1.0f / 128.0f) + EPS) * 0.8f;
#pragma unroll
            for (int mt = 0; mt < 4; ++mt)
#pragma unroll
                for (int j = 0; j < 8; ++j) o1l[(mt * 8 + j) * 64] = pk_bf16(O[mt][2 * j] * rs, O[mt][2 * j + 1] * rs);
            __builtin_amdgcn_wave_barrier();
            int lane_e = lane; asm volatile("" : "+v"(lane_e));
            const int dvg = lane_e & 15, qs = lane_e >> 4;
            const f32x4 nw0 = *(const f32x4*)(p.diff_norm_w + 8 * dvg), nw1 = *(const f32x4*)(p.diff_norm_w + 8 * dvg + 4);
            const LAS unsigned* ob = (const LAS unsigned*)(lds + AT_O1 + wid * 8192);
            const int slot = (dvg >> 2) * 8 + 2 * (dvg & 3);
            u32x4 dzv[8];
#pragma unroll
            for (int it = 0; it < 8; ++it) dzv[it] = *(const u32x4*)(P1 + (tokbase + q0 + it * 4 + qs) * NP1 + C_DZ + hh * 128 + 8 * dvg);
#pragma unroll
            for (int it = 0; it < 8; ++it) {
                const int q = it * 4 + qs; const size_t row = tokbase + q0 + q;
                const unsigned u0 = ob[slot * 64 + q], u1 = ob[(slot + 1) * 64 + q], u2 = ob[slot * 64 + q + 32], u3 = ob[(slot + 1) * 64 + q + 32];
                const u32x4 dz = dzv[it];
                u32x4 w;
                w.x = pk_bf16(bf_lo(u0) * nw0[0] * silu_f(bf_lo(dz.x)), bf_hi(u0) * nw0[1] * silu_f(bf_hi(dz.x)));
                w.y = pk_bf16(bf_lo(u1) * nw0[2] * silu_f(bf_lo(dz.y)), bf_hi(u1) * nw0[3] * silu_f(bf_hi(dz.y)));
                w.z = pk_bf16(bf_lo(u2) * nw1[0] * silu_f(bf_lo(dz.z)), bf_hi(u2) * nw1[1] * silu_f(bf_hi(dz.z)));
                w.w = pk_bf16(bf_lo(u3) * nw1[2] * silu_f(bf_lo(dz.w)), bf_hi(u3) * nw1[3] * silu_f(bf_hi(dz.w)));
                *(u32x4*)(mix + row * DM + 512 + hh * 128 + 8 * dvg) = w;
            }
            __builtin_amdgcn_wave_barrier();
        }
    }
}

DI void phase_attn(const Params& p, LAS unsigned char* lds, int rep) {
    const float lam = *(const float*)(p.ws + OFF_MISC);
    unsigned* counter = (unsigned*)(p.ws + OFF_MISC + 4 + 4 * rep);
    LAS int* tslot = (LAS int*)(lds + AT_TASK);
    for (;;) {
        if (threadIdx.x == 0) *tslot = (int)atomicAdd(counter, 1u);
        __syncthreads();
        const int t = *tslot;
        __syncthreads();
        if (t >= 512) break;
        const int qb = 7 - (t >> 6), bh = t & 63;
        attn_qblock(p, lds, bh >> 2, bh & 3, qb, lam);
    }
}


constexpr int G_QN = 0, G_KN = 17408, G_VB = 34816, G_KBG = 52224, G_M = 69632, G_T = 86016, G_SM = 95232;
DI bf16x8 tr_pair(const LAS unsigned char* lo_addr, int hi_off) {
    const s16x4 lo = __builtin_amdgcn_ds_read_tr16_b64_v4i16((LAS s16x4*)(lo_addr));
    const s16x4 hi = __builtin_amdgcn_ds_read_tr16_b64_v4i16((LAS s16x4*)(lo_addr + hi_off));
    return __builtin_shufflevector(lo, hi, 0, 1, 2, 3, 4, 5, 6, 7);
}
DI bf16_t bf16_1(float v) { return (bf16_t)(pk_bf16(v, 0.f) & 0xffffu); }

DI void gdn_prep(const Params& p, LAS unsigned char* lds, int c2) {
    int tid = threadIdx.x; asm volatile("" : "+v"(tid));
    const int lane = tid & 63, wid = __builtin_amdgcn_readfirstlane(tid >> 6), r = lane & 31, h2 = lane >> 5;
    const int b = c2 >> 7, hh = (c2 >> 5) & 3, n = c2 & 31;
    const size_t tok0 = (size_t)b * SEQ + (size_t)n * 64;
    const bf16_t* P1 = (const bf16_t*)(p.ws + OFF_P1);
    LAS float* sm = (LAS float*)(lds + G_SM);
    LAS float* Mf = (LAS float*)(lds + G_M);
    bf16_t* WN = (bf16_t*)(p.ws + OFF_WN) + (size_t)c2 * 8192;
    bf16_t* QD = (bf16_t*)(p.ws + OFF_QD) + (size_t)c2 * 8192;
    bf16_t* KD = (bf16_t*)(p.ws + OFF_KD) + (size_t)c2 * 8192;
    bf16_t* AQ = (bf16_t*)(p.ws + OFF_AQK) + (size_t)c2 * 4096;
    float* U = (float*)(p.ws + OFF_U) + (size_t)c2 * 8192;
    u32x4 raw[6][4];
#pragma unroll
    for (int i = 0; i < 6; ++i) {
        const int item = tid + 512 * i, g = item & 15, t = (item >> 4) & 63, part = i >> 1;
        const int ch = part * 512 + hh * 128 + g * 8;
#pragma unroll
        for (int j = 0; j < 4; ++j) {
            const int tt = n * 64 + t - 3 + j, ttc = tt < 0 ? 0 : tt;
            raw[i][j] = *(const u32x4*)(P1 + ((size_t)b * SEQ + ttc) * NP1 + ch);
            if (tt < 0) raw[i][j] = (u32x4){0u, 0u, 0u, 0u};
        }
    }
    if (wid == 0) {
        const float* gg = (const float*)(p.ws + OFF_GBGA) + (tok0 + lane) * 8;
        const float gbv = gg[hh], gav = gg[4 + hh];
        const float beta = 1.0f / (1.0f + expf(-gbv));
        const float xs = gav + p.dt_bias[hh];
        const float sp = fmaxf(xs, 0.f) + log1pf(expf(-fabsf(xs)));
        float gc = -expf(p.a_log[hh]) * sp;
#pragma unroll
        for (int o = 1; o < 64; o <<= 1) { const float t = __shfl_up(gc, o); if (lane >= o) gc += t; }
        const float gl = __shfl(gc, 63);
        sm[lane] = beta; sm[64 + lane] = gc * LOG2E; sm[128 + lane] = expf(gc); sm[192 + lane] = expf(gl - gc);
        if (lane == 63) ((float*)(p.ws + OFF_GL))[c2] = expf(gl);
    }
    float av[6][8];
#pragma unroll
    for (int i = 0; i < 6; ++i) {
        const int item = tid + 512 * i, g = item & 15, part = i >> 1;
        const int ch = part * 512 + hh * 128 + g * 8;
        float a[8];
#pragma unroll
        for (int e = 0; e < 8; ++e) a[e] = 0.f;
#pragma unroll
        for (int j = 0; j < 4; ++j) {
            const f32x4 w0 = *(const f32x4*)(p.conv_w + j * 1536 + ch), w1 = *(const f32x4*)(p.conv_w + j * 1536 + ch + 4);
            const u32x4 rw = raw[i][j];
            a[0] += w0[0] * bf_lo(rw.x); a[1] += w0[1] * bf_hi(rw.x); a[2] += w0[2] * bf_lo(rw.y); a[3] += w0[3] * bf_hi(rw.y);
            a[4] += w1[0] * bf_lo(rw.z); a[5] += w1[1] * bf_hi(rw.z); a[6] += w1[2] * bf_lo(rw.w); a[7] += w1[3] * bf_hi(rw.w);
        }
        float ss = 0.f;
#pragma unroll
        for (int e = 0; e < 8; ++e) { a[e] = silu_f(a[e]); ss += a[e] * a[e]; }
        float rn = 1.0f;
        if (part < 2) {
            ss += __shfl_xor(ss, 1); ss += __shfl_xor(ss, 2); ss += __shfl_xor(ss, 4); ss += __shfl_xor(ss, 8);
            rn = rsqrtf(ss + 1e-6f) * (part == 0 ? 0.08838834764831845f : 1.0f);
        }
#pragma unroll
        for (int e = 0; e < 8; ++e) av[i][e] = a[e] * rn;
    }
    __syncthreads();
#pragma unroll
    for (int i = 0; i < 6; ++i) {
        const int item = tid + 512 * i, g = item & 15, t = (item >> 4) & 63, part = i >> 1;
        const float* a = av[i];
        const float beta = sm[t], egc = sm[128 + t], ekd = sm[192 + t];
        if (part < 2) {
            u32x4 w; w.x = pk_bf16(a[0], a[1]); w.y = pk_bf16(a[2], a[3]); w.z = pk_bf16(a[4], a[5]); w.w = pk_bf16(a[6], a[7]);
            *(LAS u32x4*)(lds + (part == 0 ? G_QN : G_KN) + t * 272 + g * 16) = w;
            if (part == 0) {
                u32x2 lo, hi; lo.x = pk_bf16(a[0] * egc, a[1] * egc); lo.y = pk_bf16(a[2] * egc, a[3] * egc); hi.x = pk_bf16(a[4] * egc, a[5] * egc); hi.y = pk_bf16(a[6] * egc, a[7] * egc);
                bf16_t* qd = QD + t * 128 + 16 * (g >> 1) + 4 * (g & 1);
                *(u32x2*)qd = lo; *(u32x2*)(qd + 8) = hi;
            } else {
                const float f1 = beta * egc;
                u32x4 w2; w2.x = pk_bf16(a[0] * f1, a[1] * f1); w2.y = pk_bf16(a[2] * f1, a[3] * f1); w2.z = pk_bf16(a[4] * f1, a[5] * f1); w2.w = pk_bf16(a[6] * f1, a[7] * f1);
                *(LAS u32x4*)(lds + G_KBG + t * 272 + g * 16) = w2;
                u32x4 w3; w3.x = pk_bf16(a[0] * ekd, a[1] * ekd); w3.y = pk_bf16(a[2] * ekd, a[3] * ekd); w3.z = pk_bf16(a[4] * ekd, a[5] * ekd); w3.w = pk_bf16(a[6] * ekd, a[7] * ekd);
                *(u32x4*)(KD + t * 128 + g * 8) = w3;
            }
        } else {
            u32x4 w; w.x = pk_bf16(a[0] * beta, a[1] * beta); w.y = pk_bf16(a[2] * beta, a[3] * beta); w.z = pk_bf16(a[4] * beta, a[5] * beta); w.w = pk_bf16(a[6] * beta, a[7] * beta);
            *(LAS u32x4*)(lds + G_VB + t * 272 + g * 16) = w;
        }
    }
    __syncthreads();
    {
        const int w4 = wid & 3, mt = w4 >> 1, nt = w4 & 1; const bool isqk = wid >= 4;
        if (!(mt == 0 && nt == 1)) {
            const LAS unsigned char* Ab = lds + (isqk ? G_QN : G_KN) + (32 * mt + r) * 272 + 16 * h2;
            const LAS unsigned char* Bb = lds + G_KN + (32 * nt + r) * 272 + 16 * h2;
            f32x16 X;
#pragma unroll
            for (int i = 0; i < 16; ++i) X[i] = 0.f;
#pragma unroll
            for (int ks = 0; ks < 8; ++ks) X = MFMA32(*(const LAS bf16x8*)(Ab + 32 * ks), *(const LAS bf16x8*)(Bb + 32 * ks), X);
            const int s = 32 * nt + r; const float gcs = sm[64 + s];
#pragma unroll
            for (int i = 0; i < 16; ++i) {
                const int c = 32 * mt + crow(i, h2);
                const float dec = __builtin_amdgcn_exp2f(sm[64 + c] - gcs);
                if (!isqk) Mf[c * 64 + s] = (c > s) ? sm[c] * X[i] * dec : 0.f;
                else AQ[c * 64 + perm23(s)] = bf16_1((c >= s) ? X[i] * dec : 0.f);
            }
        }
    }
    __syncthreads();
    if (wid == 0) {
        LAS bf16_t* Tb = (LAS bf16_t*)(lds + G_T);
        {
            const int c16 = lane & 15, b16 = lane >> 4;
            const LAS float* Mb = Mf + (16 * b16) * 64 + 16 * b16;
            float T[16];
#pragma unroll
            for (int i = 0; i < 16; ++i) T[i] = 0.f;
#pragma unroll
            for (int i = 0; i < 16; ++i) {
                float a0 = (i == c16) ? 1.f : 0.f, a1 = 0.f, a2 = 0.f, a3 = 0.f;
#pragma unroll
                for (int s4 = 0; s4 < (i + 3) / 4; ++s4) {
                    const f32x4 m4 = *(const LAS f32x4*)(Mb + i * 64 + 4 * s4);
                    a0 -= m4[0] * T[4 * s4]; a1 -= m4[1] * T[4 * s4 + 1]; a2 -= m4[2] * T[4 * s4 + 2]; a3 -= m4[3] * T[4 * s4 + 3];
                }
                T[i] = (a0 + a1) + (a2 + a3);
            }
#pragma unroll
            for (int i = 0; i < 16; ++i) {
                const int row = 16 * b16 + i;
                Tb[row * 72 + 16 * b16 + c16] = bf16_1(T[i]);
                if ((b16 & 1) == 0) Tb[row * 72 + 16 * b16 + 16 + c16] = 0;
                if (b16 < 2) { Tb[row * 72 + 32 + c16] = 0; Tb[row * 72 + 48 + c16] = 0; }
            }
        }
        __builtin_amdgcn_wave_barrier();
        asm volatile("s_waitcnt lgkmcnt(0)" ::: "memory");
        {
            const int qd = r >> 4, rr = r & 15;
            bf16x8 mfrag;
            { const LAS float* mp = Mf + (16 + 32 * qd + rr) * 64 + 32 * qd + 8 * h2;
              const f32x4 m0 = *(const LAS f32x4*)mp, m1 = *(const LAS f32x4*)(mp + 4);
              u32x4 aw; aw.x = pk_bf16(m0[0], m0[1]); aw.y = pk_bf16(m0[2], m0[3]); aw.z = pk_bf16(m1[0], m1[1]); aw.w = pk_bf16(m1[2], m1[3]);
              mfrag = __builtin_bit_cast(bf16x8, aw); }
            bf16x8 tfrag;
#pragma unroll
            for (int j = 0; j < 8; ++j) tfrag[j] = (short)Tb[(32 * qd + 8 * h2 + j) * 72 + 32 * qd + rr];
            bf16x8 t2frag;
            { const LAS unsigned char* tp = lds + G_T + (16 + 32 * qd + rr) * 144 + (16 + 32 * qd + 4 * h2) * 2;
              const u32x2 lo = *(const LAS u32x2*)tp, hi = *(const LAS u32x2*)(tp + 16);
              u32x4 aw; aw.x = lo.x; aw.y = lo.y; aw.z = hi.x; aw.w = hi.y; t2frag = __builtin_bit_cast(bf16x8, aw); }
            const bf16x8 zf = {0, 0, 0, 0, 0, 0, 0, 0};
            f32x16 Y1, Z1;
#pragma unroll
            for (int i = 0; i < 16; ++i) { Y1[i] = 0.f; Z1[i] = 0.f; }
#pragma unroll
            for (int ks = 0; ks < 2; ++ks) Y1 = MFMA32(qd == ks ? mfrag : zf, qd == ks ? tfrag : zf, Y1);
#pragma unroll
            for (int s2 = 0; s2 < 2; ++s2) Z1 = MFMA32(qd == s2 ? t2frag : zf, pack8(Y1, s2), Z1);
#pragma unroll
            for (int i = 0; i < 16; ++i) {
                const int row = crow(i, h2);
                if ((row >> 4) == qd) Tb[(16 + 32 * qd + (row & 15)) * 72 + 32 * qd + rr] = bf16_1(-Z1[i]);
            }
        }
        __builtin_amdgcn_wave_barrier();
        asm volatile("s_waitcnt lgkmcnt(0)" ::: "memory");
        const int i16 = lane & 15, q = i16 >> 2, pp = i16 & 3, blk = (lane >> 4) & 1;
        f32x16 Y;
#pragma unroll
        for (int i = 0; i < 16; ++i) Y[i] = 0.f;
#pragma unroll
        for (int ks = 0; ks < 2; ++ks) {
            const LAS float* mp = Mf + (32 + r) * 64 + 16 * ks + 8 * h2;
            const f32x4 m0 = *(const LAS f32x4*)mp, m1 = *(const LAS f32x4*)(mp + 4);
            u32x4 aw; aw.x = pk_bf16(m0[0], m0[1]); aw.y = pk_bf16(m0[2], m0[3]); aw.z = pk_bf16(m1[0], m1[1]); aw.w = pk_bf16(m1[2], m1[3]);
            const bf16x8 bfrag = tr_pair(lds + G_T + (16 * ks + 8 * h2 + q) * 144 + (16 * blk + 4 * pp) * 2, 4 * 144);
            Y = MFMA32(__builtin_bit_cast(bf16x8, aw), bfrag, Y);
        }
        f32x16 Z;
#pragma unroll
        for (int i = 0; i < 16; ++i) Z[i] = 0.f;
#pragma unroll
        for (int s = 0; s < 2; ++s) {
            const LAS unsigned char* tp = lds + G_T + (32 + r) * 144 + (32 + 16 * s + 4 * h2) * 2;
            const u32x2 lo = *(const LAS u32x2*)tp, hi = *(const LAS u32x2*)(tp + 16);
            u32x4 aw; aw.x = lo.x; aw.y = lo.y; aw.z = hi.x; aw.w = hi.y;
            Z = MFMA32(__builtin_bit_cast(bf16x8, aw), pack8(Y, s), Z);
        }
#pragma unroll
        for (int i = 0; i < 16; ++i) Tb[(32 + crow(i, h2)) * 72 + r] = bf16_1(-Z[i]);
    }
    __syncthreads();
    {
        const int mt = wid >> 2, nt = wid & 3;
        const int i16 = lane & 15, q = i16 >> 2, pp = i16 & 3, blk = (lane >> 4) & 1;
        f32x16 Xu, Xw;
#pragma unroll
        for (int i = 0; i < 16; ++i) { Xu[i] = 0.f; Xw[i] = 0.f; }
#pragma unroll
        for (int ks = 0; ks < 4; ++ks) {
            if (ks < 2 * (mt + 1)) {
                const bf16x8 af = *(const LAS bf16x8*)(lds + G_T + (32 * mt + r) * 144 + (16 * ks + 8 * h2) * 2);
                const int boff = (16 * ks + 8 * h2 + q) * 272 + (32 * nt + 16 * blk + 4 * pp) * 2;
                Xu = MFMA32(af, tr_pair(lds + G_VB + boff, 4 * 272), Xu);
                Xw = MFMA32(af, tr_pair(lds + G_KBG + boff, 4 * 272), Xw);
            }
        }
        const int d = 32 * nt + r, dp = perm23(d);
        {
            float* up = U + ((nt * 2 + mt) * 64 + lane) * 16;
#pragma unroll
            for (int k = 0; k < 4; ++k) { const f32x4 v = {Xu[4 * k], Xu[4 * k + 1], Xu[4 * k + 2], Xu[4 * k + 3]}; *(f32x4*)(up + 4 * k) = v; }
        }
#pragma unroll
        for (int i = 0; i < 16; ++i) {
            const int c = 32 * mt + crow(i, h2);
            WN[c * 128 + dp] = bf16_1(-Xw[i]);
        }
    }
    __syncthreads();
}

constexpr int S_WN = 0, S_QD = 17408, S_KD = 34816, S_AQ = 52224, S_BUF = 61440, S_STG = 2 * S_BUF;

struct GateIn { u32x4 z0, z1; };
DI void scan_gate_load(const Params& p, int tid, int b, int hh, int n, GateIn& g) {
    const int gc_ = tid >> 3, seg = tid & 7;
    const bf16_t* P1 = (const bf16_t*)(p.ws + OFF_P1);
    const size_t row = (size_t)b * SEQ + n * 64 + gc_;
    g.z0 = *(const u32x4*)(P1 + row * NP1 + C_GZ + hh * 128 + seg * 16); g.z1 = *(const u32x4*)(P1 + row * NP1 + C_GZ + hh * 128 + seg * 16 + 8);
}
DI void scan_gate(const Params& p, LAS unsigned char* lds, int tid, int b, int hh, int n, const GateIn& g) {
    const int gc_ = tid >> 3, seg = tid & 7;
    bf16_t* mix = (bf16_t*)(p.ws + OFF_HB);
    const LAS float* st = (const LAS float*)(lds + S_STG) + gc_ * 132 + seg * 16;
    f32x4 ov[4]; float ss = 0.f;
#pragma unroll
    for (int k = 0; k < 4; ++k) { ov[k] = *(const LAS f32x4*)(st + 4 * k); ss += ov[k][0] * ov[k][0] + ov[k][1] * ov[k][1] + ov[k][2] * ov[k][2] + ov[k][3] * ov[k][3]; }
    ss += __shfl_xor(ss, 1); ss += __shfl_xor(ss, 2); ss += __shfl_xor(ss, 4);
    const float rstd = rsqrtf(ss * (1.0f / 128.0f) + EPS);
    const size_t row = (size_t)b * SEQ + n * 64 + gc_;
    const u32x4 z0 = g.z0, z1 = g.z1;
    f32x4 gnw[4];
#pragma unroll
    for (int k = 0; k < 4; ++k) gnw[k] = *(const f32x4*)(p.gdn_norm_w + seg * 16 + 4 * k);
    u32x4 w0, w1;
    w0.x = pk_bf16(ov[0][0] * rstd * gnw[0][0] * silu_f(bf_lo(z0.x)), ov[0][1] * rstd * gnw[0][1] * silu_f(bf_hi(z0.x)));
    w0.y = pk_bf16(ov[0][2] * rstd * gnw[0][2] * silu_f(bf_lo(z0.y)), ov[0][3] * rstd * gnw[0][3] * silu_f(bf_hi(z0.y)));
    w0.z = pk_bf16(ov[1][0] * rstd * gnw[1][0] * silu_f(bf_lo(z0.z)), ov[1][1] * rstd * gnw[1][1] * silu_f(bf_hi(z0.z)));
    w0.w = pk_bf16(ov[1][2] * rstd * gnw[1][2] * silu_f(bf_lo(z0.w)), ov[1][3] * rstd * gnw[1][3] * silu_f(bf_hi(z0.w)));
    w1.x = pk_bf16(ov[2][0] * rstd * gnw[2][0] * silu_f(bf_lo(z1.x)), ov[2][1] * rstd * gnw[2][1] * silu_f(bf_hi(z1.x)));
    w1.y = pk_bf16(ov[2][2] * rstd * gnw[2][2] * silu_f(bf_lo(z1.y)), ov[2][3] * rstd * gnw[2][3] * silu_f(bf_hi(z1.y)));
    w1.z = pk_bf16(ov[3][0] * rstd * gnw[3][0] * silu_f(bf_lo(z1.z)), ov[3][1] * rstd * gnw[3][1] * silu_f(bf_hi(z1.z)));
    w1.w = pk_bf16(ov[3][2] * rstd * gnw[3][2] * silu_f(bf_lo(z1.w)), ov[3][3] * rstd * gnw[3][3] * silu_f(bf_hi(z1.w)));
    bf16_t* mp = mix + row * DM + hh * 128 + seg * 16;
    *(u32x4*)mp = w0; *(u32x4*)(mp + 8) = w1;
}

struct ScanRegs { u32x4 t0[4], t1[4], t2[4], t3[2]; };
DI void scan_fetch(ScanRegs& R, const bf16_t* WN, const bf16_t* QD, const bf16_t* KD, const bf16_t* AQ, int ltid) {
#pragma unroll
    for (int i = 0; i < 4; ++i) { const int pi = ltid + 256 * i; R.t0[i] = *(const u32x4*)(WN + pi * 8); R.t1[i] = *(const u32x4*)(QD + pi * 8); R.t2[i] = *(const u32x4*)(KD + pi * 8); }
#pragma unroll
    for (int i = 0; i < 2; ++i) { const int pi = ltid + 256 * i; R.t3[i] = *(const u32x4*)(AQ + pi * 8); }
}
DI void scan_put(const ScanRegs& R, LAS unsigned char* dst, int ltid) {
#pragma unroll
    for (int i = 0; i < 4; ++i) { const int pi = ltid + 256 * i, row = pi >> 4, pc = pi & 15;
        *(LAS u32x4*)(dst + S_WN + row * 272 + pc * 16) = R.t0[i]; *(LAS u32x4*)(dst + S_QD + row * 272 + pc * 16) = R.t1[i]; *(LAS u32x4*)(dst + S_KD + row * 272 + pc * 16) = R.t2[i]; }
#pragma unroll
    for (int i = 0; i < 2; ++i) { const int pi = ltid + 256 * i, row = pi >> 3, pc = pi & 7; *(LAS u32x4*)(dst + S_AQ + row * 144 + pc * 16) = R.t3[i]; }
}

DI void gdn_scan(const Params& p, LAS unsigned char* lds, int bh) {
    int tid = threadIdx.x; asm volatile("" : "+v"(tid));
    const int lane = tid & 63, wid = __builtin_amdgcn_readfirstlane(tid >> 6), r = lane & 31, h2 = lane >> 5;
    const int b = bh >> 2, hh = bh & 3;
    const bf16_t* WN = (const bf16_t*)(p.ws + OFF_WN) + (size_t)bh * 32 * 8192;
    const bf16_t* QD = (const bf16_t*)(p.ws + OFF_QD) + (size_t)bh * 32 * 8192;
    const bf16_t* KD = (const bf16_t*)(p.ws + OFF_KD) + (size_t)bh * 32 * 8192;
    const bf16_t* AQ = (const bf16_t*)(p.ws + OFF_AQK) + (size_t)bh * 32 * 4096;
    const float* U = (const float*)(p.ws + OFF_U) + (size_t)bh * 32 * 8192;
    const float* GL = (const float*)(p.ws + OFF_GL) + bh * 32;
    if (wid >= 4) {
        const int ltid = tid & 255;
        ScanRegs R;
        scan_fetch(R, WN, QD, KD, AQ, ltid); scan_put(R, lds, ltid);
        scan_fetch(R, WN + 8192, QD + 8192, KD + 8192, AQ + 4096, ltid);
#pragma unroll 1
        for (int n = 0; n < 32; ++n) {
            __syncthreads();
            GateIn gi; scan_gate_load(p, tid, b, hh, n, gi);
            if (n + 1 < 32) scan_put(R, lds + ((n + 1) & 1) * S_BUF, ltid);
            if (n + 2 < 32) scan_fetch(R, WN + (size_t)(n + 2) * 8192, QD + (size_t)(n + 2) * 8192, KD + (size_t)(n + 2) * 8192, AQ + (size_t)(n + 2) * 4096, ltid);
            __syncthreads();
            scan_gate(p, lds, tid, b, hh, n, gi);
        }
    } else {
        const int i16 = lane & 15, q4 = i16 >> 2, pp = i16 & 3, blk = (lane >> 4) & 1;
        f32x16 St[4], u[2];
#pragma unroll
        for (int k = 0; k < 4; ++k)
#pragma unroll
            for (int i = 0; i < 16; ++i) St[k][i] = 0.f;
#pragma unroll
        for (int mt = 0; mt < 2; ++mt)
#pragma unroll
            for (int k = 0; k < 4; ++k) { const f32x4 v = *(const f32x4*)(U + ((wid * 2 + mt) * 64 + lane) * 16 + 4 * k); u[mt][4 * k] = v[0]; u[mt][4 * k + 1] = v[1]; u[mt][4 * k + 2] = v[2]; u[mt][4 * k + 3] = v[3]; }
#pragma unroll 1
        for (int n = 0; n < 32; ++n) {
            LAS unsigned char* buf = lds + (n & 1) * S_BUF;
            __syncthreads();
            GateIn gi; scan_gate_load(p, tid, b, hh, n, gi);
            const float egl = GL[n];
            f32x16 vn[2], o[2];
            vn[0] = u[0]; vn[1] = u[1];
#pragma unroll
            for (int mt = 0; mt < 2; ++mt)
#pragma unroll
                for (int i = 0; i < 16; ++i) o[mt][i] = 0.f;
#pragma unroll
            for (int ks = 0; ks < 8; ++ks) {
                const bf16x8 sf = pack8(St[ks >> 1], ks & 1);
#pragma unroll
                for (int mt = 0; mt < 2; ++mt) {
                    const bf16x8 wf = *(const LAS bf16x8*)(buf + S_WN + (32 * mt + r) * 272 + (16 * ks + 8 * h2) * 2);
                    vn[mt] = MFMA32(wf, sf, vn[mt]);
                    const bf16x8 qf = *(const LAS bf16x8*)(buf + S_QD + (32 * mt + r) * 272 + (16 * ks + 8 * h2) * 2);
                    o[mt] = MFMA32(qf, sf, o[mt]);
                }
                asm volatile("" ::: "memory");
            }
            bf16x8 vf[4];
#pragma unroll
            for (int k2 = 0; k2 < 4; ++k2) vf[k2] = pack8(vn[k2 >> 1], k2 & 1);
            {
                const int nn = (n + 1 < 32) ? n + 1 : n;
                const float* up = U + (size_t)nn * 8192 + ((wid * 2) * 64 + lane) * 16;
#pragma unroll
                for (int mt = 0; mt < 2; ++mt)
#pragma unroll
                    for (int k = 0; k < 4; ++k) { const f32x4 v = *(const f32x4*)(up + mt * 1024 + 4 * k); u[mt][4 * k] = v[0]; u[mt][4 * k + 1] = v[1]; u[mt][4 * k + 2] = v[2]; u[mt][4 * k + 3] = v[3]; }
            }
#pragma unroll
            for (int mt = 0; mt < 2; ++mt)
#pragma unroll
                for (int k2 = 0; k2 < 2 * (mt + 1); ++k2) {
                    const bf16x8 af = *(const LAS bf16x8*)(buf + S_AQ + (32 * mt + r) * 144 + (16 * k2 + 8 * h2) * 2);
                    o[mt] = MFMA32(af, vf[k2], o[mt]);
                }
            {
                LAS float* st = (LAS float*)(lds + S_STG);
#pragma unroll
                for (int mt = 0; mt < 2; ++mt)
#pragma unroll
                    for (int i = 0; i < 16; ++i) st[(32 * mt + crow(i, h2)) * 132 + 32 * wid + r] = o[mt][i];
            }
#pragma unroll
            for (int kt = 0; kt < 4; ++kt) {
#pragma unroll
                for (int i = 0; i < 16; ++i) St[kt][i] *= egl;
#pragma unroll
                for (int k2 = 0; k2 < 4; ++k2) {
                    const bf16x8 kf = tr_pair(buf + S_KD + (16 * k2 + 4 * h2 + q4) * 272 + (32 * kt + 16 * blk + 4 * pp) * 2, 8 * 272);
                    St[kt] = MFMA32(kf, vf[k2], St[kt]);
                }
                asm volatile("" ::: "memory");
            }
            __syncthreads();
            scan_gate(p, lds, tid, b, hh, n, gi);
        }
    }
    __syncthreads();
}

DI void zero_mix_half(const Params& p, int half) {
    bf16_t* mix = (bf16_t*)(p.ws + OFF_HB);
    const size_t n16 = (size_t)MTOK * 64;
    for (size_t i = (size_t)blockIdx.x * 512 + threadIdx.x; i < n16; i += (size_t)gridDim.x * 512) {
        const size_t row = i >> 6, pc = i & 63;
        *(u32x4*)(mix + row * DM + half * 512 + pc * 8) = (u32x4){0u, 0u, 0u, 0u};
    }
}

DI void phase_final(const Params& p) {
    int tid = threadIdx.x; asm volatile("" : "+v"(tid));
    const int lane = tid & 63, wid = tid >> 6;
    const float* rowsq = (const float*)(p.ws + OFF_ROWSQ);
    const bf16_t* yb = (const bf16_t*)(p.ws + OFF_YB);
    const int gw = blockIdx.x * 8 + wid, nw = gridDim.x * 8;
    f32x4 fw[4];
#pragma unroll
    for (int i = 0; i < 2; ++i) { fw[2 * i] = *(const f32x4*)(p.final_norm_w + 512 * i + 8 * lane); fw[2 * i + 1] = *(const f32x4*)(p.final_norm_w + 512 * i + 8 * lane + 4); }
#pragma unroll 1
    for (int row0 = gw; row0 < MTOK; row0 += 4 * nw) {
        u32x4 y[4][2]; float sq[4];
#pragma unroll
        for (int k = 0; k < 4; ++k) {
            const int row = row0 + k * nw, rc = row < MTOK ? row : row0;
#pragma unroll
            for (int i = 0; i < 2; ++i) y[k][i] = *(const u32x4*)(yb + (size_t)rc * DM + 512 * i + 8 * lane);
            sq[k] = lane < 16 ? rowsq[(size_t)rc * 16 + lane] : 0.f;
        }
#pragma unroll
        for (int k = 0; k < 4; ++k) {
            const int row = row0 + k * nw;
            const float ss = wave_sum(sq[k]);
            const float rstd = rsqrtf(ss * (1.0f / DM) + EPS);
            if (row < MTOK) {
                float* o = p.out + (size_t)row * DM;
#pragma unroll
                for (int i = 0; i < 2; ++i) {
                    const f32x4 a = {bf_lo(y[k][i].x), bf_hi(y[k][i].x), bf_lo(y[k][i].y), bf_hi(y[k][i].y)}, c = {bf_lo(y[k][i].z), bf_hi(y[k][i].z), bf_lo(y[k][i].w), bf_hi(y[k][i].w)};
                    *(f32x4*)(o + 512 * i + 8 * lane) = a * rstd * fw[2 * i];
                    *(f32x4*)(o + 512 * i + 8 * lane + 4) = c * rstd * fw[2 * i + 1];
                }
            }
        }
    }
}

__global__ void __launch_bounds__(512) mega(Params p) {
    extern __shared__ __attribute__((aligned(16))) unsigned char shm[];
    LAS unsigned char* lds = (LAS unsigned char*)shm;
    cg::grid_group grid = cg::this_grid();
    volatile LAS unsigned* bst = (volatile LAS unsigned*)(lds + LDS_BYTES - 16);
    if (threadIdx.x < 2) bst[threadIdx.x] = 0u;
    __syncthreads();
    const XcdBarrier xb = xcd_barrier_post((unsigned*)(p.ws + OFF_BAR), bst);
    if (p.ws == nullptr) grid.sync();

#pragma unroll 1
    for (int rep = 0; rep < REP_PREP; ++rep) phase_prep(p, lds);
    xcd_barrier(xb);
#pragma unroll 1
    for (int rep = 0; rep < REP_G1; ++rep)
    {
        pg8::Gemm g{(const bf16_t*)(p.ws + OFF_HB), (const bf16_t*)(p.ws + OFF_WINT), MTOK, NG1, DM};
        pg8::StaticOrder S; S.init(g.M, g.N, (int)gridDim.x, (int)blockIdx.x);
        pg8::EpiP1 E{(bf16_t*)(p.ws + OFF_P1), NP1, (bf16_t*)(p.ws + OFF_KX)};
        pg8::gemm_phase<pg8::EpiP1, false>(lds, g, S, E);
        pg8::Gemm g2{(const bf16_t*)(p.ws + OFF_HB), (const bf16_t*)(p.ws + OFF_WINT) + (size_t)NG1 * DM, MTOK, 512, DM};
        pg8::StaticOrder S2; S2.init(g2.M, g2.N, (int)gridDim.x, (int)blockIdx.x);
        pg8::EpiVT E2{(bf16_t*)(p.ws + OFF_VT)};
        pg8::gemm_phase<pg8::EpiVT, true>(lds, g2, S2, E2);
    }
    xcd_barrier(xb);
#pragma unroll 1
    for (int rep = 0; rep < REP_GP; ++rep)
        for (int c2 = blockIdx.x; c2 < 2048; c2 += gridDim.x) gdn_prep(p, lds, c2);
    xcd_barrier(xb);
#pragma unroll 1
    for (int rep = 0; rep < REP_P3; ++rep) {
#pragma unroll 1
        for (int r2 = 0; r2 < REP_SCAN; ++r2)
            if (blockIdx.x < 64) gdn_scan(p, lds, blockIdx.x);
#if SCAN_SYNC
        xcd_barrier(xb);
#endif
        phase_attn(p, lds, rep);
#if REP_ATTN > 1
        xcd_barrier(xb);
        phase_attn(p, lds, 2);
#endif
#if REP_P3 > 1
        xcd_barrier(xb);
#endif
    }
    xcd_barrier(xb);
#pragma unroll 1
    for (int rnd = 0; rnd < 2; ++rnd) {
        pg8::Gemm g{(const bf16_t*)(p.ws + OFF_HB), (const bf16_t*)(p.ws + OFF_WOUTT), MTOK, DM, DM};
        pg8::StaticOrder S; S.init(g.M, g.N, (int)gridDim.x, (int)blockIdx.x); S.i0 = rnd; S.imax = 1;
        pg8::EpiOutFused E{p.x, p.out, (float*)(p.ws + OFF_ROWSQ), p.final_norm_w, xb};
        pg8::Unit u0;
        if (S.next(0, u0)) pg8::gemm_phase<pg8::EpiOutFused, false>(lds, g, S, E);
        else xcd_barrier(xb);
    }
}

extern "C" void kernel_launch(void* const* d_in, const int* in_sizes, int n_in, void* d_out, int out_size, void* d_ws, size_t ws_size, hipStream_t stream) {
    static int grid = 0;
    if (grid == 0) {
        if (ws_size < WS_END) { fprintf(stderr, "kernel_launch: workspace too small (%zu < %zu)\n", ws_size, (size_t)WS_END); grid = -1; return; }
        int dev = 0, cus = 0, per_cu = 0;
        hipGetDevice(&dev);
        hipDeviceGetAttribute(&cus, hipDeviceAttributeMultiprocessorCount, dev);
        if (hipFuncSetAttribute((const void*)mega, hipFuncAttributeMaxDynamicSharedMemorySize, LDS_BYTES) != hipSuccess) { fprintf(stderr, "kernel_launch: hipFuncSetAttribute failed\n"); grid = -1; return; }
        if (hipOccupancyMaxActiveBlocksPerMultiprocessor(&per_cu, (const void*)mega, 512, LDS_BYTES) != hipSuccess || per_cu < 1) per_cu = 1;
        (void)hipGetLastError();
        grid = cus * (per_cu > 1 ? 1 : per_cu);
    }
    if (grid < 0) return;
    Params p{};
    p.x = (const float*)d_in[0]; p.norm_w = (const float*)d_in[1]; p.w_in = (const float*)d_in[2]; p.conv_w = (const float*)d_in[3];
    p.a_log = (const float*)d_in[4]; p.dt_bias = (const float*)d_in[5]; p.gdn_norm_w = (const float*)d_in[6];
    p.lq1 = (const float*)d_in[7]; p.lk1 = (const float*)d_in[8]; p.lq2 = (const float*)d_in[9]; p.lk2 = (const float*)d_in[10];
    p.diff_norm_w = (const float*)d_in[11]; p.w_out = (const float*)d_in[12]; p.final_norm_w = (const float*)d_in[13];
    p.out = (float*)d_out; p.ws = (unsigned char*)d_ws;
    if (hipMemsetAsync((unsigned char*)d_ws + OFF_BAR, 0, 16384, stream) != hipSuccess) { fprintf(stderr, "kernel_launch: hipMemsetAsync failed\n"); return; }
    void* args[] = {&p};
    hipError_t e = hipLaunchCooperativeKernel((const void*)mega, dim3(grid), dim3(512), args, LDS_BYTES, stream);
    if (e != hipSuccess) fprintf(stderr, "cooperative launch failed: %s (grid %d)\n", hipGetErrorString(e), grid);
}
```

```cpp
#include <hip/hip_runtime.h>
#include <hip/hip_cooperative_groups.h>
#include <cstdio>
namespace cg = cooperative_groups;

#ifndef ENABLE_ATTN
#define ENABLE_ATTN 1
#endif
#ifndef ENABLE_GDN
#define ENABLE_GDN 1
#endif
#ifndef REP_PREP
#define REP_PREP 1
#endif
#ifndef REP_G1
#define REP_G1 1
#endif
#ifndef REP_GP
#define REP_GP 1
#endif
#ifndef REP_P3
#define REP_P3 1
#endif
#ifndef REP_G2
#define REP_G2 1
#endif
#ifndef REP_SCAN
#define REP_SCAN 1
#endif
#ifndef SCAN_SYNC
#define SCAN_SYNC 0
#endif
#ifndef REP_ATTN
#define REP_ATTN 1
#endif

#define LAS __attribute__((address_space(3)))
#define DI __device__ __forceinline__
typedef unsigned short bf16_t;
typedef short bf16x8 __attribute__((ext_vector_type(8)));
typedef short s16x4 __attribute__((ext_vector_type(4)));
typedef float f32x2 __attribute__((ext_vector_type(2)));
typedef float f32x4 __attribute__((ext_vector_type(4)));
typedef float f32x16 __attribute__((ext_vector_type(16)));
typedef unsigned u32x2 __attribute__((ext_vector_type(2)));
typedef unsigned u32x4 __attribute__((ext_vector_type(4)));
typedef __bf16 bf16x2_t __attribute__((ext_vector_type(2)));

#define MFMA32(a, b, c) __builtin_amdgcn_mfma_f32_32x32x16_bf16((a), (b), (c), 0, 0, 0)

constexpr int NB = 16, SEQ = 2048, DM = 1024, MTOK = NB * SEQ, NP1 = 3072, NG1 = 3584;
constexpr int C_GQ = 0, C_GK = 512, C_GV = 1024, C_GZ = 1536, C_DQ = 2048, C_DZ = 2560;
constexpr float EPS = 1e-6f;
constexpr float LOG2E = 1.4426950408889634f;

constexpr size_t OFF_HB = 0;
constexpr size_t OFF_WINT = OFF_HB + (size_t)MTOK * DM * 2;
constexpr size_t OFF_WOUTT = OFF_WINT + (size_t)4096 * 1024 * 2;
constexpr size_t OFF_GBGA = OFF_WOUTT + (size_t)1024 * 1024 * 2;
constexpr size_t OFF_P1 = OFF_GBGA + (size_t)MTOK * 8 * 4;
constexpr size_t OFF_KX = OFF_P1 + (size_t)MTOK * NP1 * 2;
constexpr size_t OFF_VT = OFF_KX + (size_t)64 * 2 * 2048 * 64 * 2;
constexpr size_t OFF_WN = OFF_VT + (size_t)64 * 128 * 2048 * 2;
constexpr size_t OFF_QD = OFF_WN + (size_t)2048 * 64 * 128 * 2;
constexpr size_t OFF_KD = OFF_QD + (size_t)2048 * 64 * 128 * 2;
constexpr size_t OFF_AQK = OFF_KD + (size_t)2048 * 64 * 128 * 2;
constexpr size_t OFF_U = OFF_AQK + (size_t)2048 * 64 * 64 * 2;
constexpr size_t OFF_GL = OFF_U + (size_t)2048 * 64 * 128 * 4;
constexpr size_t OFF_ROWSQ = OFF_GL + 8192;
constexpr size_t OFF_MISC = OFF_ROWSQ + (size_t)MTOK * 16 * 4;
constexpr size_t OFF_YB = OFF_P1;
constexpr size_t OFF_BAR = OFF_MISC + 256;
constexpr size_t WS_END = OFF_BAR + 16384;

constexpr int LDS_BYTES = 156 * 1024;

struct Params {
    const float *x, *norm_w, *w_in, *conv_w, *a_log, *dt_bias, *gdn_norm_w, *lq1, *lk1, *lq2, *lk2, *diff_norm_w, *w_out, *final_norm_w;
    float* out; unsigned char* ws;
};

DI unsigned pk_bf16(float a, float b) { f32x2 v = {a, b}; bf16x2_t r = __builtin_convertvector(v, bf16x2_t); return __builtin_bit_cast(unsigned, r); }
DI float bf_lo(unsigned u) { return __uint_as_float(u << 16); }
DI float bf_hi(unsigned u) { return __uint_as_float(u & 0xffff0000u); }
DI float wave_sum(float v) {
#pragma unroll
    for (int o = 32; o; o >>= 1) v += __shfl_xor(v, o);
    return v;
}
DI float silu_f(float z) { return z * __builtin_amdgcn_rcpf(1.0f + __builtin_amdgcn_exp2f(-LOG2E * z)); }
DI int perm23(int t) { return (t & ~12) | ((t & 4) << 1) | ((t & 8) >> 1); }
DI int crow(int i, int h2) { return (i & 3) + 8 * (i >> 2) + 4 * h2; }
DI bf16x8 pack8(const f32x16& x, int s) {
    u32x4 w; w.x = pk_bf16(x[8 * s + 0], x[8 * s + 1]); w.y = pk_bf16(x[8 * s + 2], x[8 * s + 3]); w.z = pk_bf16(x[8 * s + 4], x[8 * s + 5]); w.w = pk_bf16(x[8 * s + 6], x[8 * s + 7]);
    return __builtin_bit_cast(bf16x8, w);
}


#define XB_TMO      128
#define XB_XCNT(j)  (256  + 64 * (j))
#define XB_XSUB(j)  (1280 + 64 * (j))
#define XB_XGEN(j)  (2304 + 64 * (j))
#define XB_TOP      3328
#define XB_TOPGEN   3392
#define XCD_BAR_WORDS 3456
#define XB_SPIN_CAP (1u << 18)
struct XcdBarrier { unsigned* bar; unsigned x; volatile LAS unsigned* st; };
DI unsigned xb_ld(unsigned* p)              { return __hip_atomic_load(p, __ATOMIC_RELAXED, __HIP_MEMORY_SCOPE_AGENT); }
DI unsigned xb_add(unsigned* p, unsigned v) { return __hip_atomic_fetch_add(p, v, __ATOMIC_RELAXED, __HIP_MEMORY_SCOPE_AGENT); }
DI unsigned xb_xcc_id() { return (unsigned)__builtin_amdgcn_s_getreg((3 << 11) | 20) & 0xFu; }
#define XB_SPIN(cond, bar) do { unsigned _sp = 0; while (cond) { __builtin_amdgcn_s_sleep(1); \
    if ((++_sp & 255u) == 0u) { if (xb_ld(&(bar)[XB_TMO])) break; if (_sp > XB_SPIN_CAP) { atomicAdd(&(bar)[XB_TMO], 1u); break; } } } } while (0)
DI XcdBarrier xcd_barrier_post(unsigned* bar, volatile LAS unsigned* st) {
    XcdBarrier b; b.bar = bar; b.x = xb_xcc_id(); b.st = st;
    if (threadIdx.x == 0) (void)xb_add(&bar[XB_XCNT(b.x)], 1u);
    return b;
}
DI void xcd_barrier_complete(unsigned* bar, unsigned x, unsigned& nloc, unsigned& nx) {
    const unsigned G = gridDim.x * gridDim.y * gridDim.z;
    unsigned sum, cnt, mine, sp = 0u;
    for (;;) {
        sum = 0u; cnt = 0u; mine = 0u;
#pragma unroll
        for (unsigned j = 0; j < 16; ++j) { const unsigned c = xb_ld(&bar[XB_XCNT(j)]); sum += c; cnt += (c > 0u) ? 1u : 0u; mine = (j == x) ? c : mine; }
        if (sum == G) break;
        __builtin_amdgcn_s_sleep(1);
        if ((++sp & 255u) == 0u) { if (xb_ld(&bar[XB_TMO])) break; if (sp > XB_SPIN_CAP) { atomicAdd(&bar[XB_TMO], 1u); break; } }
    }
    nloc = mine > 0u ? mine : 1u; nx = cnt > 0u ? cnt : 1u;
}
DI void xcd_barrier(const XcdBarrier& b) {
    asm volatile("s_waitcnt vmcnt(0)" ::: "memory");
    __syncthreads();
    if (threadIdx.x == 0) {
        unsigned* bar = b.bar;
        __builtin_amdgcn_s_waitcnt(0);
        unsigned nloc = b.st[0], nx = b.st[1];
        if (nloc == 0u) { xcd_barrier_complete(bar, b.x, nloc, nx); b.st[0] = nloc; b.st[1] = nx; }
        const unsigned old = xb_add(&bar[XB_XSUB(b.x)], 1u);
        const unsigned gen = old / nloc;
        if (old + 1u == (gen + 1u) * nloc) {
            __builtin_amdgcn_fence(__ATOMIC_RELEASE, "agent");
            asm volatile("s_waitcnt vmcnt(0)" ::: "memory");
            const unsigned og = xb_add(&bar[XB_TOP], 1u);
            const unsigned tg = og / nx;
            if (og + 1u == (tg + 1u) * nx) xb_add(&bar[XB_TOPGEN], 1u);
            else XB_SPIN(xb_ld(&bar[XB_TOPGEN]) == tg, bar);
            __builtin_amdgcn_fence(__ATOMIC_ACQUIRE, "agent");
            xb_add(&bar[XB_XGEN(b.x)], 1u);
            asm volatile("s_waitcnt vmcnt(0)" ::: "memory");
        } else {
            XB_SPIN(xb_ld(&bar[XB_XGEN(b.x)]) == gen, bar);
            __builtin_amdgcn_fence(__ATOMIC_ACQUIRE, "agent");
            asm volatile("s_waitcnt vmcnt(0)" ::: "memory");
        }
    }
    __syncthreads();
}

namespace pg8 {
constexpr int BM = 256, BK = 64, HALF = 128, HTB = HALF * BK * 2, STAGE_BYTES = 8 * HTB, NXCD = 8, WGM = 8;
DI int lds_byte(int r, int c) { const int st = (r >> 4) * 2 + (c >> 5), rr = r & 15, cc = c & 31, ob = rr * 64 + cc * 2; return st * 1024 + (ob ^ (((ob >> 9) & 1) << 5)); }
DI void stage_rc(int b, int& R, int& C) { const int st = b / 1024, sb = b % 1024, swz = sb ^ (((sb >> 9) & 1) << 5); R = (st >> 1) * 16 + swz / 64; C = (st & 1) * 32 + (swz % 64) / 2; }
DI int perm32(int rho) { const int n = rho >> 4, i = rho & 15; return 8 * (i >> 2) + 4 * n + (i & 3); }
struct Unit { int pm, pn; };
struct Gemm { const bf16_t* A; const bf16_t* Bt; int M, N, K; };
struct StaticOrder {
    int nM, nN, nwg, G, c, i0 = 0, imax = 1 << 30;
    DI void init(int M, int N, int G_, int c_) { nM = M / BM; nN = N / BM; nwg = nM * nN; G = G_; c = c_; }
    DI bool next(int i, Unit& u) const {
        if (i >= imax) return false;
        const long L = (long)(i + i0) * G + c; if (L >= nwg) return false;
        int wgid = (int)L; { const int q = nwg / NXCD, r = nwg % NXCD, xcd = wgid % NXCD, off = wgid / NXCD; wgid = (xcd < r ? xcd * (q + 1) : r * (q + 1) + (xcd - r) * q) + off; }
        const int nig = WGM * nN, gid = wgid / nig, fm = gid * WGM, gsz = (nM - fm) < WGM ? (nM - fm) : WGM;
        u.pm = fm + ((wgid % nig) % gsz); u.pn = (wgid % nig) / gsz; return true;
    }
    DI void a_ready(const Unit&) const {}
    DI void done(const Unit&) const {}
};

struct EpiP1 {
    static constexpr bool PERM = true, AFTER_DRAIN = false;
    bf16_t* O; int ldc; bf16_t* KX;
    DI void operator()(const f32x4 (&acc)[2][2][4][2], const Unit& u, int wr, int wc, int fr, int fq) const {
        const int row0 = u.pm * BM + wr * 64 + fr, col0 = u.pn * BM + wc * 32 + 8 * fq;
        if (u.pn >= 12) {
#pragma unroll
            for (int ai = 0; ai < 2; ++ai)
#pragma unroll
                for (int m = 0; m < 4; ++m) { const int row = row0 + ai * HALF + m * 16, b = row >> 11, tok = row & 2047;
#pragma unroll
                    for (int bj = 0; bj < 2; ++bj) { const f32x4 v0 = acc[ai][bj][m][0], v1 = acc[ai][bj][m][1];
                        const int c = col0 - 12 * BM + bj * HALF, hm = c >> 6, d = c & 63;
                        u32x4 w; w.x = pk_bf16(v0[0], v0[1]); w.y = pk_bf16(v0[2], v0[3]); w.z = pk_bf16(v1[0], v1[1]); w.w = pk_bf16(v1[2], v1[3]);
                        *(u32x4*)(KX + ((size_t)(b * 8 + hm) * 2048 + tok) * 64 + d) = w; } }
            return;
        }
#pragma unroll
        for (int ai = 0; ai < 2; ++ai)
#pragma unroll
            for (int m = 0; m < 4; ++m) { bf16_t* rowp = O + (size_t)(row0 + ai * HALF + m * 16) * ldc + col0;
#pragma unroll
                for (int bj = 0; bj < 2; ++bj) { const f32x4 v0 = acc[ai][bj][m][0], v1 = acc[ai][bj][m][1];
                    u32x4 w; w.x = pk_bf16(v0[0], v0[1]); w.y = pk_bf16(v0[2], v0[3]); w.z = pk_bf16(v1[0], v1[1]); w.w = pk_bf16(v1[2], v1[3]);
                    *(u32x4*)(rowp + bj * HALF) = w; } }
    }
};
struct EpiVT {
    static constexpr bool PERM = false, AFTER_DRAIN = false;
    bf16_t* VT;
    DI void operator()(const f32x4 (&acc)[2][2][4][2], const Unit& u, int wr, int wc, int fr, int fq) const {
#pragma unroll
        for (int ai = 0; ai < 2; ++ai)
#pragma unroll
            for (int m = 0; m < 4; ++m) {
                const int t = u.pm * BM + ai * HALF + wr * 64 + m * 16 + 4 * fq, b = t >> 11, tok = t & 2047, pos = perm23(tok);
#pragma unroll
                for (int bj = 0; bj < 2; ++bj)
#pragma unroll
                    for (int n = 0; n < 2; ++n) {
                        const int c = u.pn * BM + bj * HALF + wc * 32 + n * 16 + fr, hh = c >> 7, dv = c & 127;
                        const f32x4 v = acc[ai][bj][m][n];
                        u32x2 w; w.x = pk_bf16(v[0], v[1]); w.y = pk_bf16(v[2], v[3]);
                        *(u32x2*)(VT + (((size_t)((b * 4 + hh) * 32 + (pos >> 6)) * 128 + dv)) * 64 + (pos & 63)) = w;
                    }
            }
    }
};
struct EpiOutFused {
    static constexpr bool PERM = false, AFTER_DRAIN = true;
    const float* X; float* Out; float* rowsq; const float* fw; XcdBarrier xb;
    DI void operator()(const f32x4 (&)[2][2][4][2], const Unit&, int, int, int, int) const {}
    DI void fused(f32x4 (&acc)[2][2][4][2], const Unit& u, int wr, int wc, int fr, int fq) const {
        const int row0 = u.pm * BM + wr * 64 + fr, col0 = u.pn * BM + wc * 32 + 4 * fq;
#pragma unroll
        for (int ai = 0; ai < 2; ++ai)
#pragma unroll
            for (int m = 0; m < 4; ++m) {
                const int row = row0 + ai * HALF + m * 16; float ss = 0.f;
#pragma unroll
                for (int bj = 0; bj < 2; ++bj)
#pragma unroll
                    for (int n = 0; n < 2; ++n) {
                        const size_t o = (size_t)row * DM + col0 + bj * HALF + n * 16;
                        const f32x4 y = acc[ai][bj][m][n] + *(const f32x4*)(X + o);
                        acc[ai][bj][m][n] = y; ss += y[0] * y[0] + y[1] * y[1] + y[2] * y[2] + y[3] * y[3];
                    }
                ss += __shfl_xor(ss, 16); ss += __shfl_xor(ss, 32);
                if (fq == 0) rowsq[(size_t)row * 16 + u.pn * 4 + wc] = ss;
            }
        xcd_barrier(xb);
        f32x4 fwv[2][2];
#pragma unroll
        for (int bj = 0; bj < 2; ++bj)
#pragma unroll
            for (int n = 0; n < 2; ++n) fwv[bj][n] = *(const f32x4*)(fw + col0 + bj * HALF + n * 16);
#pragma unroll
        for (int ai = 0; ai < 2; ++ai)
#pragma unroll
            for (int m = 0; m < 4; ++m) {
                const int row = row0 + ai * HALF + m * 16;
                const f32x4* rq = (const f32x4*)(rowsq + (size_t)row * 16);
                const f32x4 q0 = rq[0], q1 = rq[1], q2 = rq[2], q3 = rq[3];
                const float tot = ((q0[0] + q0[1]) + (q0[2] + q0[3])) + ((q1[0] + q1[1]) + (q1[2] + q1[3])) + ((q2[0] + q2[1]) + (q2[2] + q2[3])) + ((q3[0] + q3[1]) + (q3[2] + q3[3]));
                const float rstd = rsqrtf(tot * (1.0f / DM) + EPS);
#pragma unroll
                for (int bj = 0; bj < 2; ++bj)
#pragma unroll
                    for (int n = 0; n < 2; ++n) {
                        const size_t o = (size_t)row * DM + col0 + bj * HALF + n * 16;
                        *(f32x4*)(Out + o) = acc[ai][bj][m][n] * rstd * fwv[bj][n];
                    }
            }
    }
};

template <class Epi, bool SWAP>
DI void gemm_phase(LAS unsigned char* lds, const Gemm g, const StaticOrder& S, const Epi& E) {
    int tid = threadIdx.x; asm volatile("" : "+v"(tid));
    const int wid = __builtin_amdgcn_readfirstlane(tid >> 6), lane = tid & 63, wr = wid >> 2, wc = wid & 3, fr = lane & 15, fq = lane >> 4;
    const int K = g.K, nt = K / BK;
    unsigned voffA[2], voffB[2];
#pragma unroll
    for (int i = 0; i < 2; ++i) { int R, C; stage_rc(tid * 16 + i * 8192, R, C); const int Rb = Epi::PERM ? ((R & ~31) + perm32(R & 31)) : R;
        voffA[i] = (unsigned)(R * K + C) * 2u; voffB[i] = (unsigned)(Rb * K + C) * 2u; }
    const size_t kstep = (size_t)(BK * 2);
    const size_t hstep = (size_t)HALF * K * 2;
    const size_t tstep = 2 * hstep;
    const unsigned ldsw = (unsigned)wid * 1024u;
    const int aoff = lds_byte(wr * 64 + fr, fq * 8), boff = lds_byte(wc * 32 + fr, fq * 8);
#define PG8_SA(b, h) (((b) * 2 + (h)) * HTB)
#define PG8_SB(b, h) ((4 + (b) * 2 + (h)) * HTB)
#define PG8_STAGE(bufoff, gbase, voff) do { _Pragma("unroll") for (int _i = 0; _i < 2; ++_i) \
        __builtin_amdgcn_global_load_lds((const unsigned*)((const char*)(gbase) + (voff)[_i]), (LAS unsigned*)(lds + (bufoff) + ldsw + _i * 8192), 16, 0, 0); } while (0)
#define PG8_LDA(dst, b, h) do { _Pragma("unroll") for (int m = 0; m < 4; ++m) _Pragma("unroll") for (int k = 0; k < 2; ++k) dst[m][k] = *(const LAS bf16x8*)(lds + PG8_SA(b, h) + aoff + m * 2048 + k * 1024); } while (0)
#define PG8_LDB(dst, b, h) do { _Pragma("unroll") for (int n = 0; n < 2; ++n) _Pragma("unroll") for (int k = 0; k < 2; ++k) dst[n][k] = *(const LAS bf16x8*)(lds + PG8_SB(b, h) + boff + n * 2048 + k * 1024); } while (0)
#define PG8_MMA(ai, bj, At, Bt) do { __builtin_amdgcn_s_setprio(1); _Pragma("unroll") for (int m = 0; m < 4; ++m) _Pragma("unroll") for (int n = 0; n < 2; ++n) _Pragma("unroll") for (int k = 0; k < 2; ++k) \
        acc[ai][bj][m][n] = SWAP ? __builtin_amdgcn_mfma_f32_16x16x32_bf16(At[m][k], Bt[n][k], acc[ai][bj][m][n], 0, 0, 0) \
                                 : __builtin_amdgcn_mfma_f32_16x16x32_bf16(Bt[n][k], At[m][k], acc[ai][bj][m][n], 0, 0, 0); __builtin_amdgcn_s_setprio(0); } while (0)
#define PG8_WAIT_V(n) asm volatile("s_waitcnt vmcnt(" #n ")" ::: "memory")
#define PG8_WAIT_L(n) asm volatile("s_waitcnt lgkmcnt(" #n ")" ::: "memory")
#define PG8_BAR __builtin_amdgcn_s_barrier()
#define PG8_SCHED __builtin_amdgcn_sched_barrier(0)
    Unit cur, nxt; int ui = 0;
    if (!S.next(0, cur)) return;
    f32x4 acc[2][2][4][2];
#pragma unroll
    for (int a = 0; a < 2; ++a)
#pragma unroll
        for (int b = 0; b < 2; ++b)
#pragma unroll
            for (int m = 0; m < 4; ++m)
#pragma unroll
                for (int n = 0; n < 2; ++n) acc[a][b][m][n] = (f32x4){0.f, 0.f, 0.f, 0.f};
    bf16x8 At[4][2], B0[2][2], B1[2][2];
    const char* cA = (const char*)g.A + (size_t)cur.pm * tstep; const char* cB = (const char*)g.Bt + (size_t)cur.pn * tstep;
    PG8_STAGE(PG8_SB(0, 0), cB, voffB); PG8_STAGE(PG8_SA(0, 0), cA, voffA); PG8_STAGE(PG8_SB(0, 1), cB + hstep, voffB); PG8_STAGE(PG8_SA(0, 1), cA + hstep, voffA);
    if (wr == 1) PG8_BAR;
    PG8_WAIT_V(4); PG8_BAR;
    PG8_STAGE(PG8_SB(1, 0), cB + kstep, voffB); PG8_STAGE(PG8_SA(1, 0), cA + kstep, voffA); PG8_STAGE(PG8_SB(1, 1), cB + hstep + kstep, voffB);
    PG8_WAIT_V(6); PG8_BAR;
    for (;;) {
        const bool has_next = S.next(ui + 1, nxt);
        const char* nA = has_next ? (const char*)g.A + (size_t)nxt.pm * tstep : cA; const char* nB = has_next ? (const char*)g.Bt + (size_t)nxt.pn * tstep : cB;
        for (int t = 0; t < nt; t += 2) {
            const bool last = (t == nt - 2);
            const char* a1 = cA + (size_t)(t + 1) * kstep;
            const char* a2 = last ? nA : cA + (size_t)(t + 2) * kstep; const char* b2 = last ? nB : cB + (size_t)(t + 2) * kstep;
            const char* a3 = a2 + kstep; const char* b3 = b2 + kstep;
            PG8_LDB(B0, 0, 0); PG8_SCHED; PG8_LDA(At, 0, 0); PG8_STAGE(PG8_SA(1, 1), a1 + hstep, voffA);
            PG8_WAIT_L(8); PG8_BAR; PG8_WAIT_L(0); PG8_MMA(0, 0, At, B0); PG8_BAR; PG8_SCHED;
            PG8_LDB(B1, 0, 1); PG8_STAGE(PG8_SB(0, 0), b2, voffB);
            PG8_BAR; PG8_WAIT_L(0); PG8_MMA(0, 1, At, B1); PG8_BAR;
            PG8_LDA(At, 0, 1); PG8_STAGE(PG8_SA(0, 0), a2, voffA);
            PG8_BAR; PG8_WAIT_L(0); PG8_MMA(1, 0, At, B0); PG8_BAR; PG8_SCHED;
            PG8_STAGE(PG8_SB(0, 1), b2 + hstep, voffB);
            PG8_WAIT_V(6); PG8_BAR; PG8_MMA(1, 1, At, B1); PG8_BAR;
            PG8_LDB(B0, 1, 0); PG8_SCHED; PG8_LDA(At, 1, 0); PG8_STAGE(PG8_SA(0, 1), a2 + hstep, voffA);
            PG8_WAIT_L(8); PG8_BAR; PG8_WAIT_L(0); PG8_MMA(0, 0, At, B0); PG8_BAR; PG8_SCHED;
            PG8_LDB(B1, 1, 1); PG8_STAGE(PG8_SB(1, 0), b3, voffB);
            PG8_BAR; PG8_WAIT_L(0); PG8_MMA(0, 1, At, B1); PG8_BAR;
            PG8_LDA(At, 1, 1); PG8_STAGE(PG8_SA(1, 0), a3, voffA);
            PG8_BAR; PG8_WAIT_L(0); PG8_MMA(1, 0, At, B0); PG8_BAR; PG8_SCHED;
            PG8_STAGE(PG8_SB(1, 1), b3 + hstep, voffB);
            PG8_WAIT_V(6); PG8_BAR; PG8_MMA(1, 1, At, B1); PG8_BAR;
        }
        if constexpr (!Epi::AFTER_DRAIN) E(acc, cur, wr, wc, fr, fq);
        if (!has_next) break;
#pragma unroll
        for (int a = 0; a < 2; ++a)
#pragma unroll
            for (int b = 0; b < 2; ++b)
#pragma unroll
                for (int m = 0; m < 4; ++m)
#pragma unroll
                    for (int n = 0; n < 2; ++n) acc[a][b][m][n] = (f32x4){0.f, 0.f, 0.f, 0.f};
        cur = nxt; cA = nA; cB = nB; ++ui;
    }
    PG8_WAIT_V(0);
    if (wr == 0) PG8_BAR;
    PG8_BAR;
    if constexpr (Epi::AFTER_DRAIN) E.fused(acc, cur, wr, wc, fr, fq);
#undef PG8_SA
#undef PG8_SB
#undef PG8_STAGE
#undef PG8_LDA
#undef PG8_LDB
#undef PG8_MMA
#undef PG8_WAIT_V
#undef PG8_WAIT_L
#undef PG8_BAR
#undef PG8_SCHED
}
}

DI int win_src_col(int n0) {
    if (n0 < 2048) return n0;
    if (n0 < 2560) return 2056 + (n0 - 2048);
    if (n0 < 3072) return 3592 + (n0 - 2560);
    if (n0 < 3584) return 2568 + (n0 - 3072);
    return 3080 + (n0 - 3584);
}
DI void phase_prep(const Params& p, LAS unsigned char* lds) {
    int tid = threadIdx.x; asm volatile("" : "+v"(tid));
    const int lane = tid & 63, wid = tid >> 6;
    if (blockIdx.x == 0 && wid == 0) {
        float a = p.lq1[lane] * p.lk1[lane], b = p.lq2[lane] * p.lk2[lane];
        a = wave_sum(a); b = wave_sum(b);
        if (lane == 0) { *(float*)(p.ws + OFF_MISC) = expf(a) - expf(b) + 0.2f; *(unsigned*)(p.ws + OFF_MISC + 4) = 0u; *(unsigned*)(p.ws + OFF_MISC + 8) = 0u; *(unsigned*)(p.ws + OFF_MISC + 12) = 0u; }
    }
    bf16_t* hb = (bf16_t*)(p.ws + OFF_HB);
    float* gbga = (float*)(p.ws + OFF_GBGA);
    const int gw = blockIdx.x * 8 + wid, nw = gridDim.x * 8;
    {
        f32x4 nwv[4]; float wq[16][8];
#pragma unroll
        for (int i = 0; i < 4; ++i) {
            nwv[i] = ((const f32x4*)p.norm_w)[lane + 64 * i];
#pragma unroll
            for (int e = 0; e < 4; ++e) {
                const int k = 4 * (lane + 64 * i) + e;
                const f32x4* wp = (const f32x4*)(p.w_in + (size_t)k * 4104 + 2048);
                const f32x4 w0 = wp[0], w1 = wp[1];
#pragma unroll
                for (int j = 0; j < 4; ++j) { wq[4 * i + e][j] = nwv[i][e] * w0[j]; wq[4 * i + e][4 + j] = nwv[i][e] * w1[j]; }
            }
        }
        const bool b5 = (lane & 32) != 0, b4 = (lane & 16) != 0, b3 = (lane & 8) != 0;
        const int col = (b5 ? 4 : 0) + (b4 ? 2 : 0) + (b3 ? 1 : 0);
        int row = gw;
        f32x4 v[4];
        if (row < MTOK) {
#pragma unroll
            for (int i = 0; i < 4; ++i) v[i] = ((const f32x4*)(p.x + (size_t)row * DM))[lane + 64 * i];
        }
#pragma unroll 1
        for (; row < MTOK; row += nw) {
            f32x4 vnx[4];
            const int rnx = (row + nw < MTOK) ? row + nw : row;
#pragma unroll
            for (int i = 0; i < 4; ++i) vnx[i] = ((const f32x4*)(p.x + (size_t)rnx * DM))[lane + 64 * i];
            float ss = 0.f, a8[8];
#pragma unroll
            for (int j = 0; j < 8; ++j) a8[j] = 0.f;
#pragma unroll
            for (int i = 0; i < 4; ++i)
#pragma unroll
                for (int e = 0; e < 4; ++e) {
                    ss += v[i][e] * v[i][e];
#pragma unroll
                    for (int j = 0; j < 8; ++j) a8[j] += v[i][e] * wq[4 * i + e][j];
                }
            ss = wave_sum(ss);
            const float rstd = rsqrtf(ss * (1.0f / DM) + EPS);
#pragma unroll
            for (int i = 0; i < 4; ++i) {
                const f32x4 h = v[i] * rstd * nwv[i];
                u32x2 w; w.x = pk_bf16(h[0], h[1]); w.y = pk_bf16(h[2], h[3]);
                *(u32x2*)(hb + (size_t)row * DM + 4 * (lane + 64 * i)) = w;
            }
            float c4[4], c2[2], c1;
#pragma unroll
            for (int j = 0; j < 4; ++j) { const float send = b5 ? a8[j] : a8[4 + j], keep = b5 ? a8[4 + j] : a8[j]; c4[j] = keep + __shfl_xor(send, 32); }
#pragma unroll
            for (int j = 0; j < 2; ++j) { const float send = b4 ? c4[j] : c4[2 + j], keep = b4 ? c4[2 + j] : c4[j]; c2[j] = keep + __shfl_xor(send, 16); }
            { const float send = b3 ? c2[0] : c2[1], keep = b3 ? c2[1] : c2[0]; c1 = keep + __shfl_xor(send, 8); }
            c1 += __shfl_xor(c1, 4); c1 += __shfl_xor(c1, 2); c1 += __shfl_xor(c1, 1);
            if ((lane & 7) == 0) gbga[(size_t)row * 8 + col] = c1 * rstd;
#pragma unroll
            for (int i = 0; i < 4; ++i) v[i] = vnx[i];
        }
    }
    LAS float* tl = (LAS float*)lds;
    for (int tile = blockIdx.x; tile < 1024 + 256; tile += gridDim.x) {
        const float* src; int ld, n0, k0, srcn0; bf16_t* dst;
        if (tile < 1024) { n0 = (tile >> 4) * 64; k0 = (tile & 15) * 64; srcn0 = win_src_col(n0); src = p.w_in; ld = 4104; dst = (bf16_t*)(p.ws + OFF_WINT); }
        else { const int t2 = tile - 1024; n0 = (t2 >> 4) * 64; k0 = (t2 & 15) * 64; srcn0 = n0; src = p.w_out; ld = 1024; dst = (bf16_t*)(p.ws + OFF_WOUTT); }
        const int kk = tid >> 4, n4 = tid & 15;
#pragma unroll
        for (int ps = 0; ps < 2; ++ps) { const int k = kk + 32 * ps;
            const f32x4 v = *(const f32x4*)(src + (size_t)(k0 + k) * ld + srcn0 + 4 * n4);
#pragma unroll
            for (int e = 0; e < 4; ++e) tl[k * 65 + 4 * n4 + e] = v[e]; }
        __syncthreads();
        { const int n = tid >> 3, k8 = tid & 7; float f[8];
#pragma unroll
            for (int e = 0; e < 8; ++e) f[e] = tl[(8 * k8 + e) * 65 + n];
            u32x4 w; w.x = pk_bf16(f[0], f[1]); w.y = pk_bf16(f[2], f[3]); w.z = pk_bf16(f[4], f[5]); w.w = pk_bf16(f[6], f[7]);
            *(u32x4*)(dst + (size_t)(n0 + n) * 1024 + k0 + 8 * k8) = w; }
        __syncthreads();
    }
}

constexpr int AT_KB = 8192, AT_VB = 16384, AT_BUF = AT_KB + AT_VB, AT_NBUF = 3, AT_TASK = AT_NBUF * AT_BUF, AT_O1 = AT_TASK + 256;

DI void attn_qblock(const Params& p, LAS unsigned char* lds, int b, int hh, int qb, float lam) {
    int tid = threadIdx.x; asm volatile("" : "+v"(tid));
    const int lane = tid & 63, wid = __builtin_amdgcn_readfirstlane(tid >> 6);
    const bf16_t* P1 = (const bf16_t*)(p.ws + OFF_P1);
    const bf16_t* VT = (const bf16_t*)(p.ws + OFF_VT) + (size_t)(b * 4 + hh) * 32 * 128 * 64;
    const bf16_t* KX = (const bf16_t*)(p.ws + OFF_KX) + (size_t)(b * 4 + hh) * 2 * 2048 * 64;
    bf16_t* mix = (bf16_t*)(p.ws + OFF_HB);
    const int q0 = qb * 256 + wid * 32;
    const size_t tokbase = (size_t)b * SEQ;
    const int nkt = (qb + 1) * 4;
    const float sl2 = exp2f(-2.0f * (float)(hh + 1)) * LOG2E;
    const float c1 = 0.125f * LOG2E;
#pragma unroll 1
    for (int map = 0; map < 2; ++map) {
        f32x16 O[4];
#pragma unroll
        for (int mt = 0; mt < 4; ++mt)
#pragma unroll
            for (int i = 0; i < 16; ++i) O[mt][i] = 0.f;
        float m = -INFINITY, l = 0.f;
        int lane_m = lane; asm volatile("" : "+v"(lane_m));
        const int r = lane_m & 31, h2 = lane_m >> 5;
        int foff[4];
#pragma unroll
        for (int k = 0; k < 4; ++k) foff[k] = r * 128 + (((2 * k + h2) ^ ((r >> 1) & 7)) << 4);
        float kb[16];
#pragma unroll
        for (int i = 0; i < 16; ++i) kb[i] = sl2 * (float)crow(i, h2);
        const int krow_ = 8 * wid + (lane_m >> 3), vrow0 = 16 * wid + (lane_m >> 3), vrow1 = vrow0 + 8;
        const bf16_t* kgp = KX + ((size_t)map * 2048 + krow_) * 64 + (((lane_m & 7) ^ ((krow_ >> 1) & 7)) * 8);
        const bf16_t* vgp0 = VT + (size_t)vrow0 * 64 + (((lane_m & 7) ^ ((vrow0 >> 1) & 7)) * 8);
        const bf16_t* vgp1 = VT + (size_t)vrow1 * 64 + (((lane_m & 7) ^ ((vrow1 >> 1) & 7)) * 8);
#define AT_STAGE(bufi, tile) do { LAS unsigned char* _b = lds + (bufi) * AT_BUF; \
            __builtin_amdgcn_global_load_lds((const unsigned*)(kgp + (size_t)(tile) * 64 * 64), (LAS unsigned*)(_b + wid * 1024), 16, 0, 0); \
            __builtin_amdgcn_global_load_lds((const unsigned*)(vgp0 + (size_t)(tile) * 128 * 64), (LAS unsigned*)(_b + AT_KB + wid * 2048), 16, 0, 0); \
            __builtin_amdgcn_global_load_lds((const unsigned*)(vgp1 + (size_t)(tile) * 128 * 64), (LAS unsigned*)(_b + AT_KB + wid * 2048 + 1024), 16, 0, 0); } while (0)
        bf16x8 qf[4];
        { const bf16_t* qp = P1 + (tokbase + q0 + (lane_m & 31)) * NP1 + C_DQ + hh * 128 + map * 64 + 8 * (lane_m >> 5);
#pragma unroll
            for (int ks = 0; ks < 4; ++ks) qf[ks] = *(const bf16x8*)(qp + 16 * ks); }
        AT_STAGE(0, 0);
        AT_STAGE(1, 1);
        asm volatile("" : "+v"(qf[0]), "+v"(qf[1]), "+v"(qf[2]), "+v"(qf[3]));
        int cb = 0;
#pragma unroll 1
        for (int kt = 0; kt < nkt; ++kt) {
            if (kt + 1 < nkt) asm volatile("s_waitcnt vmcnt(3)" ::: "memory"); else asm volatile("s_waitcnt vmcnt(0)" ::: "memory");
            __builtin_amdgcn_s_barrier();
            asm volatile("" ::: "memory");
            if (kt + 2 < nkt) { const int nb = cb == 0 ? 2 : cb - 1; AT_STAGE(nb, kt + 2); }
            const LAS unsigned char* cur = lds + cb * AT_BUF;
            cb = cb == 2 ? 0 : cb + 1;
            const int k0 = kt * 64;
            if (k0 <= q0) {
                const bool sub1 = (k0 + 32 <= q0);
                const LAS unsigned char* vb = cur + AT_KB;
                bf16x8 kf[8];
#pragma unroll
                for (int ks = 0; ks < 4; ++ks) kf[ks] = *(const LAS bf16x8*)(cur + foff[ks]);
                if (sub1) {
#pragma unroll
                    for (int ks = 0; ks < 4; ++ks) kf[4 + ks] = *(const LAS bf16x8*)(cur + 4096 + foff[ks]);
                }
                f32x16 s0, s1;
#pragma unroll
                for (int i = 0; i < 16; ++i) { s0[i] = 0.f; s1[i] = 0.f; }
#pragma unroll
                for (int ks = 0; ks < 4; ++ks) s0 = MFMA32(kf[ks], qf[ks], s0);
                if (sub1) {
#pragma unroll
                    for (int ks = 0; ks < 4; ++ks) s1 = MFMA32(kf[4 + ks], qf[ks], s1);
                }
                __builtin_amdgcn_sched_barrier(0);
                bf16x8 va[8];
#pragma unroll
                for (int s2 = 0; s2 < 2; ++s2)
#pragma unroll
                    for (int mt = 0; mt < 4; ++mt) va[s2 * 4 + mt] = *(const LAS bf16x8*)(vb + mt * 4096 + foff[s2]);
                __builtin_amdgcn_sched_barrier(0);
                const float off0 = sl2 * (float)(k0 - q0), off1 = off0 + 32.0f * sl2;
                const f32x2 c1v = {c1, c1};
#pragma unroll
                for (int j = 0; j < 8; ++j) {
                    const f32x2 kv = {kb[2 * j], kb[2 * j + 1]};
                    f32x2 a = {s0[2 * j], s0[2 * j + 1]}, c = {s1[2 * j], s1[2 * j + 1]};
                    a = __builtin_elementwise_fma(a, c1v, kv); c = __builtin_elementwise_fma(c, c1v, kv);
                    s0[2 * j] = a.x; s0[2 * j + 1] = a.y; s1[2 * j] = c.x; s1[2 * j + 1] = c.y;
                }
                if (k0 == q0) {
#pragma unroll
                    for (int i = 0; i < 16; ++i) if (crow(i, h2) > r) s0[i] = -INFINITY;
                }
                if (k0 + 32 == q0) {
#pragma unroll
                    for (int i = 0; i < 16; ++i) if (crow(i, h2) > r) s1[i] = -INFINITY;
                }
                float mx0 = fmaxf(s0[0], s0[1]), mx1 = fmaxf(s1[0], s1[1]);
#pragma unroll
                for (int j = 1; j < 8; ++j) { mx0 = fmaxf(fmaxf(s0[2 * j], s0[2 * j + 1]), mx0); mx1 = fmaxf(fmaxf(s1[2 * j], s1[2 * j + 1]), mx1); }
                float mx = sub1 ? fmaxf(mx0 + off0, mx1 + off1) : mx0 + off0;
                mx = fmaxf(mx, __shfl_xor(mx, 32));
                if (__builtin_amdgcn_ballot_w64(mx > m + 8.0f) != 0ull) {
                    const float mn = fmaxf(m, mx);
                    const float alpha = __builtin_amdgcn_exp2f(m - mn);
                    m = mn; l *= alpha;
#pragma unroll
                    for (int mt = 0; mt < 4; ++mt)
#pragma unroll
                        for (int i = 0; i < 16; ++i) O[mt][i] *= alpha;
                }
                const float r0 = m - off0, r1 = sub1 ? m - off1 : INFINITY;
                const f32x2 r0v = {r0, r0}, r1v = {r1, r1};
                f32x2 lsv = {0.f, 0.f};
#pragma unroll
                for (int j = 0; j < 8; ++j) {
                    f32x2 a = {s0[2 * j], s0[2 * j + 1]}, c = {s1[2 * j], s1[2 * j + 1]};
                    a = a - r0v; c = c - r1v;
                    a.x = __builtin_amdgcn_exp2f(a.x); a.y = __builtin_amdgcn_exp2f(a.y); c.x = __builtin_amdgcn_exp2f(c.x); c.y = __builtin_amdgcn_exp2f(c.y);
                    lsv = lsv + a; lsv = lsv + c;
                    s0[2 * j] = a.x; s0[2 * j + 1] = a.y; s1[2 * j] = c.x; s1[2 * j + 1] = c.y;
                }
                l += lsv.x + lsv.y;
                bf16x8 pf[4];
#pragma unroll
                for (int s = 0; s < 2; ++s) { pf[s] = pack8(s0, s); pf[2 + s] = pack8(s1, s); }
                __builtin_amdgcn_sched_barrier(0);
                bf16x8 vc[4], vd[4];
                if (sub1) {
#pragma unroll
                    for (int mt = 0; mt < 4; ++mt) vc[mt] = *(const LAS bf16x8*)(vb + mt * 4096 + foff[2]);
                }
#pragma unroll
                for (int mt = 0; mt < 4; ++mt) O[mt] = MFMA32(va[mt], pf[0], O[mt]);
                if (sub1) {
#pragma unroll
                    for (int mt = 0; mt < 4; ++mt) vd[mt] = *(const LAS bf16x8*)(vb + mt * 4096 + foff[3]);
                }
#pragma unroll
                for (int mt = 0; mt < 4; ++mt) O[mt] = MFMA32(va[4 + mt], pf[1], O[mt]);
                if (sub1) {
#pragma unroll
                    for (int mt = 0; mt < 4; ++mt) O[mt] = MFMA32(vc[mt], pf[2], O[mt]);
#pragma unroll
                    for (int mt = 0; mt < 4; ++mt) O[mt] = MFMA32(vd[mt], pf[3], O[mt]);
                }
            }
        }
        asm volatile("" ::: "memory");
        __builtin_amdgcn_s_barrier();
        asm volatile("" ::: "memory");
#undef AT_STAGE
        const float lt = l + __shfl_xor(l, 32);
        int lane_o = lane; asm volatile("" : "+v"(lane_o));
        LAS unsigned* o1l = (LAS unsigned*)(lds + AT_O1 + wid * 8192) + lane_o;
        if (map == 0) {
            const float inv1 = 1.0f / lt;
#pragma unroll
            for (int mt = 0; mt < 4; ++mt)
#pragma unroll
                for (int j = 0; j < 8; ++j) o1l[(mt * 8 + j) * 64] = pk_bf16(O[mt][2 * j] * inv1, O[mt][2 * j + 1] * inv1);
        } else {
            const float inv2 = lam / lt;
            float ss = 0.f;
#pragma unroll
            for (int mt = 0; mt < 4; ++mt)
#pragma unroll
                for (int j = 0; j < 8; ++j) {
                    const unsigned o1 = o1l[(mt * 8 + j) * 64];
                    const float a = bf_lo(o1) - O[mt][2 * j] * inv2, c = bf_hi(o1) - O[mt][2 * j + 1] * inv2;
                    O[mt][2 * j] = a; O[mt][2 * j + 1] = c; ss += a * a + c * c;
                }
            ss += __shfl_xor(ss, 32);
            const float rs = rsqrtf(ss * (1.0f / 128.0f) + EPS) * 0.8f;
#pragma unroll
            for (int mt = 0; mt < 4; ++mt)
#pragma unroll
                for (int j = 0; j < 8; ++j) o1l[(mt * 8 + j) * 64] = pk_bf16(O[mt][2 * j] * rs, O[mt][2 * j + 1] * rs);
            __builtin_amdgcn_wave_barrier();
            int lane_e = lane; asm volatile("" : "+v"(lane_e));
            const int dvg = lane_e & 15, qs = lane_e >> 4;
            const f32x4 nw0 = *(const f32x4*)(p.diff_norm_w + 8 * dvg), nw1 = *(const f32x4*)(p.diff_norm_w + 8 * dvg + 4);
            const LAS unsigned* ob = (const LAS unsigned*)(lds + AT_O1 + wid * 8192);
            const int slot = (dvg >> 2) * 8 + 2 * (dvg & 3);
            u32x4 dzv[8];
#pragma unroll
            for (int it = 0; it < 8; ++it) dzv[it] = *(const u32x4*)(P1 + (tokbase + q0 + it * 4 + qs) * NP1 + C_DZ + hh * 128 + 8 * dvg);
#pragma unroll
            for (int it = 0; it < 8; ++it) {
                const int q = it * 4 + qs; const size_t row = tokbase + q0 + q;
                const unsigned u0 = ob[slot * 64 + q], u1 = ob[(slot + 1) * 64 + q], u2 = ob[slot * 64 + q + 32], u3 = ob[(slot + 1) * 64 + q + 32];
                const u32x4 dz = dzv[it];
                u32x4 w;
                w.x = pk_bf16(bf_lo(u0) * nw0[0] * silu_f(bf_lo(dz.x)), bf_hi(u0) * nw0[1] * silu_f(bf_hi(dz.x)));
                w.y = pk_bf16(bf_lo(u1) * nw0[2] * silu_f(bf_lo(dz.y)), bf_hi(u1) * nw0[3] * silu_f(bf_hi(dz.y)));
                w.z = pk_bf16(bf_lo(u2) * nw1[0] * silu_f(bf_lo(dz.z)), bf_hi(u2) * nw1[1] * silu_f(bf_hi(dz.z)));
                w.w = pk_bf16(bf_lo(u3) * nw1[2] * silu_f(bf_lo(dz.w)), bf_hi(u3) * nw1[3] * silu_f(bf_hi(dz.w)));
                *(u32x4*)(mix + row * DM + 512 + hh * 128 + 8 * dvg) = w;
            }
            __builtin_amdgcn_wave_barrier();
        }
    }
}

DI void phase_attn(const Params& p, LAS unsigned char* lds, int rep) {
    const float lam = *(const float*)(p.ws + OFF_MISC);
    unsigned* counter = (unsigned*)(p.ws + OFF_MISC + 4 + 4 * rep);
    LAS int* tslot = (LAS int*)(lds + AT_TASK);
    for (;;) {
        if (threadIdx.x == 0) *tslot = (int)atomicAdd(counter, 1u);
        __syncthreads();
        const int t = *tslot;
        __syncthreads();
        if (t >= 512) break;
        const int qb = 7 - (t >> 6), bh = t & 63;
        attn_qblock(p, lds, bh >> 2, bh & 3, qb, lam);
    }
}


constexpr int G_QN = 0, G_KN = 17408, G_VB = 34816, G_KBG = 52224, G_M = 69632, G_T = 86016, G_SM = 95232;
DI bf16x8 tr_pair(const LAS unsigned char* lo_addr, int hi_off) {
    const s16x4 lo = __builtin_amdgcn_ds_read_tr16_b64_v4i16((LAS s16x4*)(lo_addr));
    const s16x4 hi = __builtin_amdgcn_ds_read_tr16_b64_v4i16((LAS s16x4*)(lo_addr + hi_off));
    return __builtin_shufflevector(lo, hi, 0, 1, 2, 3, 4, 5, 6, 7);
}
DI bf16_t bf16_1(float v) { return (bf16_t)(pk_bf16(v, 0.f) & 0xffffu); }

DI void gdn_gates(const Params& p, LAS float* sm, int c2, int lane) {
    const int b = c2 >> 7, hh = (c2 >> 5) & 3, n = c2 & 31;
    const size_t tok0 = (size_t)b * SEQ + (size_t)n * 64;
    const float* gg = (const float*)(p.ws + OFF_GBGA) + (tok0 + lane) * 8;
    const float gbv = gg[hh], gav = gg[4 + hh];
    const float beta = 1.0f / (1.0f + expf(-gbv));
    const float xs = gav + p.dt_bias[hh];
    const float sp = fmaxf(xs, 0.f) + log1pf(expf(-fabsf(xs)));
    float gc = -expf(p.a_log[hh]) * sp;
#pragma unroll
    for (int o = 1; o < 64; o <<= 1) { const float t = __shfl_up(gc, o); if (lane >= o) gc += t; }
    const float gl = __shfl(gc, 63);
    sm[lane] = beta; sm[64 + lane] = gc * LOG2E; sm[128 + lane] = expf(gc); sm[192 + lane] = expf(gl - gc);
    if (lane == 63) ((float*)(p.ws + OFF_GL))[c2] = expf(gl);
}

DI void gdn_prep(const Params& p, LAS unsigned char* lds, int c2, int c2next, int par) {
    int tid = threadIdx.x; asm volatile("" : "+v"(tid));
    const int lane = tid & 63, wid = __builtin_amdgcn_readfirstlane(tid >> 6), r = lane & 31, h2 = lane >> 5;
    const int b = c2 >> 7, hh = (c2 >> 5) & 3, n = c2 & 31;
    const size_t tok0 = (size_t)b * SEQ + (size_t)n * 64;
    const bf16_t* P1 = (const bf16_t*)(p.ws + OFF_P1);
    LAS float* sm = (LAS float*)(lds + G_SM + par * 1024);
    LAS float* Mf = (LAS float*)(lds + G_M);
    bf16_t* WN = (bf16_t*)(p.ws + OFF_WN) + (size_t)c2 * 8192;
    bf16_t* QD = (bf16_t*)(p.ws + OFF_QD) + (size_t)c2 * 8192;
    bf16_t* KD = (bf16_t*)(p.ws + OFF_KD) + (size_t)c2 * 8192;
    bf16_t* AQ = (bf16_t*)(p.ws + OFF_AQK) + (size_t)c2 * 4096;
    float* U = (float*)(p.ws + OFF_U) + (size_t)c2 * 8192;
    u32x4 raw[6][4];
#pragma unroll
    for (int i = 0; i < 6; ++i) {
        const int item = tid + 512 * i, g = item & 15, t = (item >> 4) & 63, part = i >> 1;
        const int ch = part * 512 + hh * 128 + g * 8;
#pragma unroll
        for (int j = 0; j < 4; ++j) {
            const int tt = n * 64 + t - 3 + j, ttc = tt < 0 ? 0 : tt;
            raw[i][j] = *(const u32x4*)(P1 + ((size_t)b * SEQ + ttc) * NP1 + ch);
            if (tt < 0) raw[i][j] = (u32x4){0u, 0u, 0u, 0u};
        }
    }
    float av[6][8];
#pragma unroll
    for (int i = 0; i < 6; ++i) {
        const int item = tid + 512 * i, g = item & 15, part = i >> 1;
        const int ch = part * 512 + hh * 128 + g * 8;
        float a[8];
#pragma unroll
        for (int e = 0; e < 8; ++e) a[e] = 0.f;
#pragma unroll
        for (int j = 0; j < 4; ++j) {
            const f32x4 w0 = *(const f32x4*)(p.conv_w + j * 1536 + ch), w1 = *(const f32x4*)(p.conv_w + j * 1536 + ch + 4);
            const u32x4 rw = raw[i][j];
            a[0] += w0[0] * bf_lo(rw.x); a[1] += w0[1] * bf_hi(rw.x); a[2] += w0[2] * bf_lo(rw.y); a[3] += w0[3] * bf_hi(rw.y);
            a[4] += w1[0] * bf_lo(rw.z); a[5] += w1[1] * bf_hi(rw.z); a[6] += w1[2] * bf_lo(rw.w); a[7] += w1[3] * bf_hi(rw.w);
        }
        float ss = 0.f;
#pragma unroll
        for (int e = 0; e < 8; ++e) { a[e] = silu_f(a[e]); ss += a[e] * a[e]; }
        float rn = 1.0f;
        if (part < 2) {
            ss += __shfl_xor(ss, 1); ss += __shfl_xor(ss, 2); ss += __shfl_xor(ss, 4); ss += __shfl_xor(ss, 8);
            rn = rsqrtf(ss + 1e-6f) * (part == 0 ? 0.08838834764831845f : 1.0f);
        }
#pragma unroll
        for (int e = 0; e < 8; ++e) av[i][e] = a[e] * rn;
    }
    __syncthreads();
#pragma unroll
    for (int i = 0; i < 6; ++i) {
        const int item = tid + 512 * i, g = item & 15, t = (item >> 4) & 63, part = i >> 1;
        const float* a = av[i];
        const float beta = sm[t], egc = sm[128 + t], ekd = sm[192 + t];
        if (part < 2) {
            u32x4 w; w.x = pk_bf16(a[0], a[1]); w.y = pk_bf16(a[2], a[3]); w.z = pk_bf16(a[4], a[5]); w.w = pk_bf16(a[6], a[7]);
            *(LAS u32x4*)(lds + (part == 0 ? G_QN : G_KN) + t * 272 + g * 16) = w;
            if (part == 0) {
                u32x2 lo, hi; lo.x = pk_bf16(a[0] * egc, a[1] * egc); lo.y = pk_bf16(a[2] * egc, a[3] * egc); hi.x = pk_bf16(a[4] * egc, a[5] * egc); hi.y = pk_bf16(a[6] * egc, a[7] * egc);
                bf16_t* qd = QD + t * 128 + 16 * (g >> 1) + 4 * (g & 1);
                *(u32x2*)qd = lo; *(u32x2*)(qd + 8) = hi;
            } else {
                const float f1 = beta * egc;
                u32x4 w2; w2.x = pk_bf16(a[0] * f1, a[1] * f1); w2.y = pk_bf16(a[2] * f1, a[3] * f1); w2.z = pk_bf16(a[4] * f1, a[5] * f1); w2.w = pk_bf16(a[6] * f1, a[7] * f1);
                *(LAS u32x4*)(lds + G_KBG + t * 272 + g * 16) = w2;
                u32x4 w3; w3.x = pk_bf16(a[0] * ekd, a[1] * ekd); w3.y = pk_bf16(a[2] * ekd, a[3] * ekd); w3.z = pk_bf16(a[4] * ekd, a[5] * ekd); w3.w = pk_bf16(a[6] * ekd, a[7] * ekd);
                *(u32x4*)(KD + t * 128 + g * 8) = w3;
            }
        } else {
            u32x4 w; w.x = pk_bf16(a[0] * beta, a[1] * beta); w.y = pk_bf16(a[2] * beta, a[3] * beta); w.z = pk_bf16(a[4] * beta, a[5] * beta); w.w = pk_bf16(a[6] * beta, a[7] * beta);
            *(LAS u32x4*)(lds + G_VB + t * 272 + g * 16) = w;
        }
    }
    __syncthreads();
    {
        const int w4 = wid & 3, mt = w4 >> 1, nt = w4 & 1; const bool isqk = wid >= 4;
        if (!(mt == 0 && nt == 1)) {
            const LAS unsigned char* Ab = lds + (isqk ? G_QN : G_KN) + (32 * mt + r) * 272 + 16 * h2;
            const LAS unsigned char* Bb = lds + G_KN + (32 * nt + r) * 272 + 16 * h2;
            f32x16 X;
#pragma unroll
            for (int i = 0; i < 16; ++i) X[i] = 0.f;
#pragma unroll
            for (int ks = 0; ks < 8; ++ks) X = MFMA32(*(const LAS bf16x8*)(Ab + 32 * ks), *(const LAS bf16x8*)(Bb + 32 * ks), X);
            const int s = 32 * nt + r; const float gcs = sm[64 + s];
#pragma unroll
            for (int i = 0; i < 16; ++i) {
                const int c = 32 * mt + crow(i, h2);
                const float dec = __builtin_amdgcn_exp2f(sm[64 + c] - gcs);
                if (!isqk) Mf[c * 64 + s] = (c > s) ? sm[c] * X[i] * dec : 0.f;
                else AQ[c * 64 + perm23(s)] = bf16_1((c >= s) ? X[i] * dec : 0.f);
            }
        }
    }
    __syncthreads();
    if (wid == 0) {
        LAS bf16_t* Tb = (LAS bf16_t*)(lds + G_T);
        {
            const int c16 = lane & 15, b16 = lane >> 4;
            const LAS float* Mb = Mf + (16 * b16) * 64 + 16 * b16;
            float T[16];
#pragma unroll
            for (int i = 0; i < 16; ++i) T[i] = 0.f;
#pragma unroll
            for (int i = 0; i < 16; ++i) {
                float a0 = (i == c16) ? 1.f : 0.f, a1 = 0.f, a2 = 0.f, a3 = 0.f;
#pragma unroll
                for (int s4 = 0; s4 < (i + 3) / 4; ++s4) {
                    const f32x4 m4 = *(const LAS f32x4*)(Mb + i * 64 + 4 * s4);
                    a0 -= m4[0] * T[4 * s4]; a1 -= m4[1] * T[4 * s4 + 1]; a2 -= m4[2] * T[4 * s4 + 2]; a3 -= m4[3] * T[4 * s4 + 3];
                }
                T[i] = (a0 + a1) + (a2 + a3);
            }
#pragma unroll
            for (int i = 0; i < 16; ++i) {
                const int row = 16 * b16 + i;
                Tb[row * 72 + 16 * b16 + c16] = bf16_1(T[i]);
                if ((b16 & 1) == 0) Tb[row * 72 + 16 * b16 + 16 + c16] = 0;
                if (b16 < 2) { Tb[row * 72 + 32 + c16] = 0; Tb[row * 72 + 48 + c16] = 0; }
            }
        }
        __builtin_amdgcn_wave_barrier();
        asm volatile("s_waitcnt lgkmcnt(0)" ::: "memory");
        {
            const int qd = r >> 4, rr = r & 15;
            bf16x8 mfrag;
            { const LAS float* mp = Mf + (16 + 32 * qd + rr) * 64 + 32 * qd + 8 * h2;
              const f32x4 m0 = *(const LAS f32x4*)mp, m1 = *(const LAS f32x4*)(mp + 4);
              u32x4 aw; aw.x = pk_bf16(m0[0], m0[1]); aw.y = pk_bf16(m0[2], m0[3]); aw.z = pk_bf16(m1[0], m1[1]); aw.w = pk_bf16(m1[2], m1[3]);
              mfrag = __builtin_bit_cast(bf16x8, aw); }
            bf16x8 tfrag;
#pragma unroll
            for (int j = 0; j < 8; ++j) tfrag[j] = (short)Tb[(32 * qd + 8 * h2 + j) * 72 + 32 * qd + rr];
            bf16x8 t2frag;
            { const LAS unsigned char* tp = lds + G_T + (16 + 32 * qd + rr) * 144 + (16 + 32 * qd + 4 * h2) * 2;
              const u32x2 lo = *(const LAS u32x2*)tp, hi = *(const LAS u32x2*)(tp + 16);
              u32x4 aw; aw.x = lo.x; aw.y = lo.y; aw.z = hi.x; aw.w = hi.y; t2frag = __builtin_bit_cast(bf16x8, aw); }
            const bf16x8 zf = {0, 0, 0, 0, 0, 0, 0, 0};
            f32x16 Y1, Z1;
#pragma unroll
            for (int i = 0; i < 16; ++i) { Y1[i] = 0.f; Z1[i] = 0.f; }
#pragma unroll
            for (int ks = 0; ks < 2; ++ks) Y1 = MFMA32(qd == ks ? mfrag : zf, qd == ks ? tfrag : zf, Y1);
#pragma unroll
            for (int s2 = 0; s2 < 2; ++s2) Z1 = MFMA32(qd == s2 ? t2frag : zf, pack8(Y1, s2), Z1);
#pragma unroll
            for (int i = 0; i < 16; ++i) {
                const int row = crow(i, h2);
                if ((row >> 4) == qd) Tb[(16 + 32 * qd + (row & 15)) * 72 + 32 * qd + rr] = bf16_1(-Z1[i]);
            }
        }
        __builtin_amdgcn_wave_barrier();
        asm volatile("s_waitcnt lgkmcnt(0)" ::: "memory");
        const int i16 = lane & 15, q = i16 >> 2, pp = i16 & 3, blk = (lane >> 4) & 1;
        f32x16 Y;
#pragma unroll
        for (int i = 0; i < 16; ++i) Y[i] = 0.f;
#pragma unroll
        for (int ks = 0; ks < 2; ++ks) {
            const LAS float* mp = Mf + (32 + r) * 64 + 16 * ks + 8 * h2;
            const f32x4 m0 = *(const LAS f32x4*)mp, m1 = *(const LAS f32x4*)(mp + 4);
            u32x4 aw; aw.x = pk_bf16(m0[0], m0[1]); aw.y = pk_bf16(m0[2], m0[3]); aw.z = pk_bf16(m1[0], m1[1]); aw.w = pk_bf16(m1[2], m1[3]);
            const bf16x8 bfrag = tr_pair(lds + G_T + (16 * ks + 8 * h2 + q) * 144 + (16 * blk + 4 * pp) * 2, 4 * 144);
            Y = MFMA32(__builtin_bit_cast(bf16x8, aw), bfrag, Y);
        }
        f32x16 Z;
#pragma unroll
        for (int i = 0; i < 16; ++i) Z[i] = 0.f;
#pragma unroll
        for (int s = 0; s < 2; ++s) {
            const LAS unsigned char* tp = lds + G_T + (32 + r) * 144 + (32 + 16 * s + 4 * h2) * 2;
            const u32x2 lo = *(const LAS u32x2*)tp, hi = *(const LAS u32x2*)(tp + 16);
            u32x4 aw; aw.x = lo.x; aw.y = lo.y; aw.z = hi.x; aw.w = hi.y;
            Z = MFMA32(__builtin_bit_cast(bf16x8, aw), pack8(Y, s), Z);
        }
#pragma unroll
        for (int i = 0; i < 16; ++i) Tb[(32 + crow(i, h2)) * 72 + r] = bf16_1(-Z[i]);
    } else if (wid == 1) {
        if (c2next < 2048) gdn_gates(p, (LAS float*)(lds + G_SM + (par ^ 1) * 1024), c2next, lane);
    }
    __syncthreads();
    {
        const int mt = wid >> 2, nt = wid & 3;
        const int i16 = lane & 15, q = i16 >> 2, pp = i16 & 3, blk = (lane >> 4) & 1;
        f32x16 Xu, Xw;
#pragma unroll
        for (int i = 0; i < 16; ++i) { Xu[i] = 0.f; Xw[i] = 0.f; }
#pragma unroll
        for (int ks = 0; ks < 4; ++ks) {
            if (ks < 2 * (mt + 1)) {
                const bf16x8 af = *(const LAS bf16x8*)(lds + G_T + (32 * mt + r) * 144 + (16 * ks + 8 * h2) * 2);
                const int boff = (16 * ks + 8 * h2 + q) * 272 + (32 * nt + 16 * blk + 4 * pp) * 2;
                Xu = MFMA32(af, tr_pair(lds + G_VB + boff, 4 * 272), Xu);
                Xw = MFMA32(af, tr_pair(lds + G_KBG + boff, 4 * 272), Xw);
            }
        }
        const int d = 32 * nt + r, dp = perm23(d);
        {
            float* up = U + ((nt * 2 + mt) * 64 + lane) * 16;
#pragma unroll
            for (int k = 0; k < 4; ++k) { const f32x4 v = {Xu[4 * k], Xu[4 * k + 1], Xu[4 * k + 2], Xu[4 * k + 3]}; *(f32x4*)(up + 4 * k) = v; }
        }
#pragma unroll
        for (int i = 0; i < 16; ++i) {
            const int c = 32 * mt + crow(i, h2);
            WN[c * 128 + dp] = bf16_1(-Xw[i]);
        }
    }
    __syncthreads();
}

constexpr int S_WN = 0, S_QD = 17408, S_KD = 34816, S_AQ = 52224, S_BUF = 61440, S_STG = 2 * S_BUF;

struct GateIn { u32x4 z0, z1; };
DI void scan_gate_load(const Params& p, int tid, int b, int hh, int n, GateIn& g) {
    const int gc_ = tid >> 3, seg = tid & 7;
    const bf16_t* P1 = (const bf16_t*)(p.ws + OFF_P1);
    const size_t row = (size_t)b * SEQ + n * 64 + gc_;
    g.z0 = *(const u32x4*)(P1 + row * NP1 + C_GZ + hh * 128 + seg * 16); g.z1 = *(const u32x4*)(P1 + row * NP1 + C_GZ + hh * 128 + seg * 16 + 8);
}
DI void scan_gate(const Params& p, LAS unsigned char* lds, int tid, int b, int hh, int n, const GateIn& g) {
    const int gc_ = tid >> 3, seg = tid & 7;
    bf16_t* mix = (bf16_t*)(p.ws + OFF_HB);
    const LAS float* st = (const LAS float*)(lds + S_STG) + gc_ * 132 + seg * 16;
    f32x4 ov[4]; float ss = 0.f;
#pragma unroll
    for (int k = 0; k < 4; ++k) { ov[k] = *(const LAS f32x4*)(st + 4 * k); ss += ov[k][0] * ov[k][0] + ov[k][1] * ov[k][1] + ov[k][2] * ov[k][2] + ov[k][3] * ov[k][3]; }
    ss += __shfl_xor(ss, 1); ss += __shfl_xor(ss, 2); ss += __shfl_xor(ss, 4);
    const float rstd = rsqrtf(ss * (1.0f / 128.0f) + EPS);
    const size_t row = (size_t)b * SEQ + n * 64 + gc_;
    const u32x4 z0 = g.z0, z1 = g.z1;
    f32x4 gnw[4];
#pragma unroll
    for (int k = 0; k < 4; ++k) gnw[k] = *(const f32x4*)(p.gdn_norm_w + seg * 16 + 4 * k);
    u32x4 w0, w1;
    w0.x = pk_bf16(ov[0][0] * rstd * gnw[0][0] * silu_f(bf_lo(z0.x)), ov[0][1] * rstd * gnw[0][1] * silu_f(bf_hi(z0.x)));
    w0.y = pk_bf16(ov[0][2] * rstd * gnw[0][2] * silu_f(bf_lo(z0.y)), ov[0][3] * rstd * gnw[0][3] * silu_f(bf_hi(z0.y)));
    w0.z = pk_bf16(ov[1][0] * rstd * gnw[1][0] * silu_f(bf_lo(z0.z)), ov[1][1] * rstd * gnw[1][1] * silu_f(bf_hi(z0.z)));
    w0.w = pk_bf16(ov[1][2] * rstd * gnw[1][2] * silu_f(bf_lo(z0.w)), ov[1][3] * rstd * gnw[1][3] * silu_f(bf_hi(z0.w)));
    w1.x = pk_bf16(ov[2][0] * rstd * gnw[2][0] * silu_f(bf_lo(z1.x)), ov[2][1] * rstd * gnw[2][1] * silu_f(bf_hi(z1.x)));
    w1.y = pk_bf16(ov[2][2] * rstd * gnw[2][2] * silu_f(bf_lo(z1.y)), ov[2][3] * rstd * gnw[2][3] * silu_f(bf_hi(z1.y)));
    w1.z = pk_bf16(ov[3][0] * rstd * gnw[3][0] * silu_f(bf_lo(z1.z)), ov[3][1] * rstd * gnw[3][1] * silu_f(bf_hi(z1.z)));
    w1.w = pk_bf16(ov[3][2] * rstd * gnw[3][2] * silu_f(bf_lo(z1.w)), ov[3][3] * rstd * gnw[3][3] * silu_f(bf_hi(z1.w)));
    bf16_t* mp = mix + row * DM + hh * 128 + seg * 16;
    *(u32x4*)mp = w0; *(u32x4*)(mp + 8) = w1;
}

struct ScanRegs { u32x4 t0[4], t1[4], t2[4], t3[2]; };
DI void scan_fetch(ScanRegs& R, const bf16_t* WN, const bf16_t* QD, const bf16_t* KD, const bf16_t* AQ, int ltid) {
#pragma unroll
    for (int i = 0; i < 4; ++i) { const int pi = ltid + 256 * i; R.t0[i] = *(const u32x4*)(WN + pi * 8); R.t1[i] = *(const u32x4*)(QD + pi * 8); R.t2[i] = *(const u32x4*)(KD + pi * 8); }
#pragma unroll
    for (int i = 0; i < 2; ++i) { const int pi = ltid + 256 * i; R.t3[i] = *(const u32x4*)(AQ + pi * 8); }
}
DI void scan_put(const ScanRegs& R, LAS unsigned char* dst, int ltid) {
#pragma unroll
    for (int i = 0; i < 4; ++i) { const int pi = ltid + 256 * i, row = pi >> 4, pc = pi & 15;
        *(LAS u32x4*)(dst + S_WN + row * 272 + pc * 16) = R.t0[i]; *(LAS u32x4*)(dst + S_QD + row * 272 + pc * 16) = R.t1[i]; *(LAS u32x4*)(dst + S_KD + row * 272 + pc * 16) = R.t2[i]; }
#pragma unroll
    for (int i = 0; i < 2; ++i) { const int pi = ltid + 256 * i, row = pi >> 3, pc = pi & 7; *(LAS u32x4*)(dst + S_AQ + row * 144 + pc * 16) = R.t3[i]; }
}

DI void gdn_scan(const Params& p, LAS unsigned char* lds, int bh) {
    int tid = threadIdx.x; asm volatile("" : "+v"(tid));
    const int lane = tid & 63, wid = __builtin_amdgcn_readfirstlane(tid >> 6), r = lane & 31, h2 = lane >> 5;
    const int b = bh >> 2, hh = bh & 3;
    const bf16_t* WN = (const bf16_t*)(p.ws + OFF_WN) + (size_t)bh * 32 * 8192;
    const bf16_t* QD = (const bf16_t*)(p.ws + OFF_QD) + (size_t)bh * 32 * 8192;
    const bf16_t* KD = (const bf16_t*)(p.ws + OFF_KD) + (size_t)bh * 32 * 8192;
    const bf16_t* AQ = (const bf16_t*)(p.ws + OFF_AQK) + (size_t)bh * 32 * 4096;
    const float* U = (const float*)(p.ws + OFF_U) + (size_t)bh * 32 * 8192;
    const float* GL = (const float*)(p.ws + OFF_GL) + bh * 32;
    if (wid >= 4) {
        const int ltid = tid & 255;
        ScanRegs R;
        scan_fetch(R, WN, QD, KD, AQ, ltid); scan_put(R, lds, ltid);
        scan_fetch(R, WN + 8192, QD + 8192, KD + 8192, AQ + 4096, ltid);
#pragma unroll 1
        for (int n = 0; n < 32; ++n) {
            __syncthreads();
            GateIn gi; scan_gate_load(p, tid, b, hh, n, gi);
            if (n + 1 < 32) scan_put(R, lds + ((n + 1) & 1) * S_BUF, ltid);
            if (n + 2 < 32) scan_fetch(R, WN + (size_t)(n + 2) * 8192, QD + (size_t)(n + 2) * 8192, KD + (size_t)(n + 2) * 8192, AQ + (size_t)(n + 2) * 4096, ltid);
            __syncthreads();
            scan_gate(p, lds, tid, b, hh, n, gi);
        }
    } else {
        const int i16 = lane & 15, q4 = i16 >> 2, pp = i16 & 3, blk = (lane >> 4) & 1;
        f32x16 St[4], u[2];
#pragma unroll
        for (int k = 0; k < 4; ++k)
#pragma unroll
            for (int i = 0; i < 16; ++i) St[k][i] = 0.f;
#pragma unroll
        for (int mt = 0; mt < 2; ++mt)
#pragma unroll
            for (int k = 0; k < 4; ++k) { const f32x4 v = *(const f32x4*)(U + ((wid * 2 + mt) * 64 + lane) * 16 + 4 * k); u[mt][4 * k] = v[0]; u[mt][4 * k + 1] = v[1]; u[mt][4 * k + 2] = v[2]; u[mt][4 * k + 3] = v[3]; }
#pragma unroll 1
        for (int n = 0; n < 32; ++n) {
            LAS unsigned char* buf = lds + (n & 1) * S_BUF;
            __syncthreads();
            GateIn gi; scan_gate_load(p, tid, b, hh, n, gi);
            const float egl = GL[n];
            f32x16 vn[2], o[2];
            vn[0] = u[0]; vn[1] = u[1];
#pragma unroll
            for (int mt = 0; mt < 2; ++mt)
#pragma unroll
                for (int i = 0; i < 16; ++i) o[mt][i] = 0.f;
#pragma unroll
            for (int ks = 0; ks < 8; ++ks) {
                const bf16x8 sf = pack8(St[ks >> 1], ks & 1);
#pragma unroll
                for (int mt = 0; mt < 2; ++mt) {
                    const bf16x8 wf = *(const LAS bf16x8*)(buf + S_WN + (32 * mt + r) * 272 + (16 * ks + 8 * h2) * 2);
                    vn[mt] = MFMA32(wf, sf, vn[mt]);
                    const bf16x8 qf = *(const LAS bf16x8*)(buf + S_QD + (32 * mt + r) * 272 + (16 * ks + 8 * h2) * 2);
                    o[mt] = MFMA32(qf, sf, o[mt]);
                }
                asm volatile("" ::: "memory");
            }
            bf16x8 vf[4];
#pragma unroll
            for (int k2 = 0; k2 < 4; ++k2) vf[k2] = pack8(vn[k2 >> 1], k2 & 1);
            {
                const int nn = (n + 1 < 32) ? n + 1 : n;
                const float* up = U + (size_t)nn * 8192 + ((wid * 2) * 64 + lane) * 16;
#pragma unroll
                for (int mt = 0; mt < 2; ++mt)
#pragma unroll
                    for (int k = 0; k < 4; ++k) { const f32x4 v = *(const f32x4*)(up + mt * 1024 + 4 * k); u[mt][4 * k] = v[0]; u[mt][4 * k + 1] = v[1]; u[mt][4 * k + 2] = v[2]; u[mt][4 * k + 3] = v[3]; }
            }
#pragma unroll
            for (int mt = 0; mt < 2; ++mt)
#pragma unroll
                for (int k2 = 0; k2 < 2 * (mt + 1); ++k2) {
                    const bf16x8 af = *(const LAS bf16x8*)(buf + S_AQ + (32 * mt + r) * 144 + (16 * k2 + 8 * h2) * 2);
                    o[mt] = MFMA32(af, vf[k2], o[mt]);
                }
            {
                LAS float* st = (LAS float*)(lds + S_STG);
#pragma unroll
                for (int mt = 0; mt < 2; ++mt)
#pragma unroll
                    for (int i = 0; i < 16; ++i) st[(32 * mt + crow(i, h2)) * 132 + 32 * wid + r] = o[mt][i];
            }
#pragma unroll
            for (int kt = 0; kt < 4; ++kt) {
#pragma unroll
                for (int i = 0; i < 16; ++i) St[kt][i] *= egl;
#pragma unroll
                for (int k2 = 0; k2 < 4; ++k2) {
                    const bf16x8 kf = tr_pair(buf + S_KD + (16 * k2 + 4 * h2 + q4) * 272 + (32 * kt + 16 * blk + 4 * pp) * 2, 8 * 272);
                    St[kt] = MFMA32(kf, vf[k2], St[kt]);
                }
                asm volatile("" ::: "memory");
            }
            __syncthreads();
            scan_gate(p, lds, tid, b, hh, n, gi);
        }
    }
    __syncthreads();
}

DI void zero_mix_half(const Params& p, int half) {
    bf16_t* mix = (bf16_t*)(p.ws + OFF_HB);
    const size_t n16 = (size_t)MTOK * 64;
    for (size_t i = (size_t)blockIdx.x * 512 + threadIdx.x; i < n16; i += (size_t)gridDim.x * 512) {
        const size_t row = i >> 6, pc = i & 63;
        *(u32x4*)(mix + row * DM + half * 512 + pc * 8) = (u32x4){0u, 0u, 0u, 0u};
    }
}

DI void phase_final(const Params& p) {
    int tid = threadIdx.x; asm volatile("" : "+v"(tid));
    const int lane = tid & 63, wid = tid >> 6;
    const float* rowsq = (const float*)(p.ws + OFF_ROWSQ);
    const bf16_t* yb = (const bf16_t*)(p.ws + OFF_YB);
    const int gw = blockIdx.x * 8 + wid, nw = gridDim.x * 8;
    f32x4 fw[4];
#pragma unroll
    for (int i = 0; i < 2; ++i) { fw[2 * i] = *(const f32x4*)(p.final_norm_w + 512 * i + 8 * lane); fw[2 * i + 1] = *(const f32x4*)(p.final_norm_w + 512 * i + 8 * lane + 4); }
#pragma unroll 1
    for (int row0 = gw; row0 < MTOK; row0 += 4 * nw) {
        u32x4 y[4][2]; float sq[4];
#pragma unroll
        for (int k = 0; k < 4; ++k) {
            const int row = row0 + k * nw, rc = row < MTOK ? row : row0;
#pragma unroll
            for (int i = 0; i < 2; ++i) y[k][i] = *(const u32x4*)(yb + (size_t)rc * DM + 512 * i + 8 * lane);
            sq[k] = lane < 16 ? rowsq[(size_t)rc * 16 + lane] : 0.f;
        }
#pragma unroll
        for (int k = 0; k < 4; ++k) {
            const int row = row0 + k * nw;
            const float ss = wave_sum(sq[k]);
            const float rstd = rsqrtf(ss * (1.0f / DM) + EPS);
            if (row < MTOK) {
                float* o = p.out + (size_t)row * DM;
#pragma unroll
                for (int i = 0; i < 2; ++i) {
                    const f32x4 a = {bf_lo(y[k][i].x), bf_hi(y[k][i].x), bf_lo(y[k][i].y), bf_hi(y[k][i].y)}, c = {bf_lo(y[k][i].z), bf_hi(y[k][i].z), bf_lo(y[k][i].w), bf_hi(y[k][i].w)};
                    *(f32x4*)(o + 512 * i + 8 * lane) = a * rstd * fw[2 * i];
                    *(f32x4*)(o + 512 * i + 8 * lane + 4) = c * rstd * fw[2 * i + 1];
                }
            }
        }
    }
}

__global__ void __launch_bounds__(512) mega(Params p) {
    extern __shared__ __attribute__((aligned(16))) unsigned char shm[];
    LAS unsigned char* lds = (LAS unsigned char*)shm;
    cg::grid_group grid = cg::this_grid();
    volatile LAS unsigned* bst = (volatile LAS unsigned*)(lds + LDS_BYTES - 16);
    if (threadIdx.x < 2) bst[threadIdx.x] = 0u;
    __syncthreads();
    const XcdBarrier xb = xcd_barrier_post((unsigned*)(p.ws + OFF_BAR), bst);
    if (p.ws == nullptr) grid.sync();

#pragma unroll 1
    for (int rep = 0; rep < REP_PREP; ++rep) phase_prep(p, lds);
    xcd_barrier(xb);
#pragma unroll 1
    for (int rep = 0; rep < REP_G1; ++rep)
    {
        pg8::Gemm g{(const bf16_t*)(p.ws + OFF_HB), (const bf16_t*)(p.ws + OFF_WINT), MTOK, NG1, DM};
        pg8::StaticOrder S; S.init(g.M, g.N, (int)gridDim.x, (int)blockIdx.x);
        pg8::EpiP1 E{(bf16_t*)(p.ws + OFF_P1), NP1, (bf16_t*)(p.ws + OFF_KX)};
        pg8::gemm_phase<pg8::EpiP1, false>(lds, g, S, E);
        pg8::Gemm g2{(const bf16_t*)(p.ws + OFF_HB), (const bf16_t*)(p.ws + OFF_WINT) + (size_t)NG1 * DM, MTOK, 512, DM};
        pg8::StaticOrder S2; S2.init(g2.M, g2.N, (int)gridDim.x, (int)blockIdx.x);
        pg8::EpiVT E2{(bf16_t*)(p.ws + OFF_VT)};
        pg8::gemm_phase<pg8::EpiVT, true>(lds, g2, S2, E2);
    }
    xcd_barrier(xb);
#pragma unroll 1
    for (int rep = 0; rep < REP_GP; ++rep)
    {
        if ((threadIdx.x >> 6) == 0 && (int)blockIdx.x < 2048) gdn_gates(p, (LAS float*)(lds + G_SM), blockIdx.x, threadIdx.x & 63);
        int par = 0;
#pragma unroll 1
        for (int c2 = blockIdx.x; c2 < 2048; c2 += gridDim.x, par ^= 1) gdn_prep(p, lds, c2, c2 + (int)gridDim.x, par);
    }
    xcd_barrier(xb);
#pragma unroll 1
    for (int rep = 0; rep < REP_P3; ++rep) {
#pragma unroll 1
        for (int r2 = 0; r2 < REP_SCAN; ++r2)
            if (blockIdx.x < 64) gdn_scan(p, lds, blockIdx.x);
#if SCAN_SYNC
        xcd_barrier(xb);
#endif
        phase_attn(p, lds, rep);
#if REP_ATTN > 1
        xcd_barrier(xb);
        phase_attn(p, lds, 2);
#endif
#if REP_P3 > 1
        xcd_barrier(xb);
#endif
    }
    xcd_barrier(xb);
#pragma unroll 1
    for (int rnd = 0; rnd < 2; ++rnd) {
        pg8::Gemm g{(const bf16_t*)(p.ws + OFF_HB), (const bf16_t*)(p.ws + OFF_WOUTT), MTOK, DM, DM};
        pg8::StaticOrder S; S.init(g.M, g.N, (int)gridDim.x, (int)blockIdx.x); S.i0 = rnd; S.imax = 1;
        pg8::EpiOutFused E{p.x, p.out, (float*)(p.ws + OFF_ROWSQ), p.final_norm_w, xb};
        pg8::Unit u0;
        if (S.next(0, u0)) pg8::gemm_phase<pg8::EpiOutFused, false>(lds, g, S, E);
        else xcd_barrier(xb);
    }
}

extern "C" void kernel_launch(void* const* d_in, const int* in_sizes, int n_in, void* d_out, int out_size, void* d_ws, size_t ws_size, hipStream_t stream) {
    static int grid = 0;
    if (grid == 0) {
        if (ws_size < WS_END) { fprintf(stderr, "kernel_launch: workspace too small (%zu < %zu)\n", ws_size, (size_t)WS_END); grid = -1; return; }
        int dev = 0, cus = 0, per_cu = 0;
        hipGetDevice(&dev);
        hipDeviceGetAttribute(&cus, hipDeviceAttributeMultiprocessorCount, dev);
        if (hipFuncSetAttribute((const void*)mega, hipFuncAttributeMaxDynamicSharedMemorySize, LDS_BYTES) != hipSuccess) { fprintf(stderr, "kernel_launch: hipFuncSetAttribute failed\n"); grid = -1; return; }
        if (hipOccupancyMaxActiveBlocksPerMultiprocessor(&per_cu, (const void*)mega, 512, LDS_BYTES) != hipSuccess || per_cu < 1) per_cu = 1;
        (void)hipGetLastError();
        grid = cus * (per_cu > 1 ? 1 : per_cu);
    }
    if (grid < 0) return;
    Params p{};
    p.x = (const float*)d_in[0]; p.norm_w = (const float*)d_in[1]; p.w_in = (const float*)d_in[2]; p.conv_w = (const float*)d_in[3];
    p.a_log = (const float*)d_in[4]; p.dt_bias = (const float*)d_in[5]; p.gdn_norm_w = (const float*)d_in[6];
    p.lq1 = (const float*)d_in[7]; p.lk1 = (const float*)d_in[8]; p.lq2 = (const float*)d_in[9]; p.lk2 = (const float*)d_in[10];
    p.diff_norm_w = (const float*)d_in[11]; p.w_out = (const float*)d_in[12]; p.final_norm_w = (const float*)d_in[13];
    p.out = (float*)d_out; p.ws = (unsigned char*)d_ws;
    if (hipMemsetAsync((unsigned char*)d_ws + OFF_BAR, 0, 16384, stream) != hipSuccess) { fprintf(stderr, "kernel_launch: hipMemsetAsync failed\n"); return; }
    void* args[] = {&p};
    hipError_t e = hipLaunchCooperativeKernel((const void*)mega, dim3(grid), dim3(512), args, LDS_BYTES, stream);
    if (e != hipSuccess) fprintf(stderr, "cooperative launch failed: %s (grid %d)\n", hipGetErrorString(e), grid);
}
```

```cpp
#include <hip/hip_runtime.h>
#include <hip/hip_cooperative_groups.h>
#include <cstdio>
namespace cg = cooperative_groups;

#ifndef ENABLE_ATTN
#define ENABLE_ATTN 1
#endif
#ifndef ENABLE_GDN
#define ENABLE_GDN 1
#endif
#ifndef REP_PREP
#define REP_PREP 1
#endif
#ifndef REP_G1
#define REP_G1 1
#endif
#ifndef REP_GP
#define REP_GP 1
#endif
#ifndef REP_P3
#define REP_P3 1
#endif
#ifndef REP_G2
#define REP_G2 1
#endif
#ifndef REP_SCAN
#define REP_SCAN 1
#endif
#ifndef SCAN_SYNC
#define SCAN_SYNC 0
#endif
#ifndef REP_ATTN
#define REP_ATTN 1
#endif

#define LAS __attribute__((address_space(3)))
#define DI __device__ __forceinline__
typedef unsigned short bf16_t;
typedef short bf16x8 __attribute__((ext_vector_type(8)));
typedef short s16x4 __attribute__((ext_vector_type(4)));
typedef float f32x2 __attribute__((ext_vector_type(2)));
typedef float f32x4 __attribute__((ext_vector_type(4)));
typedef float f32x16 __attribute__((ext_vector_type(16)));
typedef unsigned u32x2 __attribute__((ext_vector_type(2)));
typedef unsigned u32x4 __attribute__((ext_vector_type(4)));
typedef __bf16 bf16x2_t __attribute__((ext_vector_type(2)));

#define MFMA32(a, b, c) __builtin_amdgcn_mfma_f32_32x32x16_bf16((a), (b), (c), 0, 0, 0)

constexpr int NB = 16, SEQ = 2048, DM = 1024, MTOK = NB * SEQ, NP1 = 3072, NG1 = 3584;
constexpr int C_GQ = 0, C_GK = 512, C_GV = 1024, C_GZ = 1536, C_DQ = 2048, C_DZ = 2560;
constexpr float EPS = 1e-6f;
constexpr float LOG2E = 1.4426950408889634f;

constexpr size_t OFF_HB = 0;
constexpr size_t OFF_WINT = OFF_HB + (size_t)MTOK * DM * 2;
constexpr size_t OFF_WOUTT = OFF_WINT + (size_t)4096 * 1024 * 2;
constexpr size_t OFF_GBGA = OFF_WOUTT + (size_t)1024 * 1024 * 2;
constexpr size_t OFF_P1 = OFF_GBGA + (size_t)MTOK * 8 * 4;
constexpr size_t OFF_KX = OFF_P1 + (size_t)MTOK * NP1 * 2;
constexpr size_t OFF_VT = OFF_KX + (size_t)64 * 2 * 2048 * 64 * 2;
constexpr size_t OFF_WN = OFF_VT + (size_t)64 * 128 * 2048 * 2;
constexpr size_t OFF_QD = OFF_WN + (size_t)2048 * 64 * 128 * 2;
constexpr size_t OFF_KD = OFF_QD + (size_t)2048 * 64 * 128 * 2;
constexpr size_t OFF_AQK = OFF_KD + (size_t)2048 * 64 * 128 * 2;
constexpr size_t OFF_U = OFF_AQK + (size_t)2048 * 64 * 64 * 2;
constexpr size_t OFF_GL = OFF_U + (size_t)2048 * 64 * 128 * 4;
constexpr size_t OFF_ROWSQ = OFF_GL + 8192;
constexpr size_t OFF_MISC = OFF_ROWSQ + (size_t)MTOK * 16 * 4;
constexpr size_t OFF_YB = OFF_P1;
constexpr size_t OFF_BAR = OFF_MISC + 256;
constexpr size_t WS_END = OFF_BAR + 16384;

constexpr int LDS_BYTES = 156 * 1024;

struct Params {
    const float *x, *norm_w, *w_in, *conv_w, *a_log, *dt_bias, *gdn_norm_w, *lq1, *lk1, *lq2, *lk2, *diff_norm_w, *w_out, *final_norm_w;
    float* out; unsigned char* ws;
};

DI unsigned pk_bf16(float a, float b) { f32x2 v = {a, b}; bf16x2_t r = __builtin_convertvector(v, bf16x2_t); return __builtin_bit_cast(unsigned, r); }
DI float bf_lo(unsigned u) { return __uint_as_float(u << 16); }
DI float bf_hi(unsigned u) { return __uint_as_float(u & 0xffff0000u); }
DI float wave_sum(float v) {
#pragma unroll
    for (int o = 32; o; o >>= 1) v += __shfl_xor(v, o);
    return v;
}
DI float silu_f(float z) { return z * __builtin_amdgcn_rcpf(1.0f + __builtin_amdgcn_exp2f(-LOG2E * z)); }
DI int perm23(int t) { return (t & ~12) | ((t & 4) << 1) | ((t & 8) >> 1); }
DI int crow(int i, int h2) { return (i & 3) + 8 * (i >> 2) + 4 * h2; }
DI bf16x8 pack8(const f32x16& x, int s) {
    u32x4 w; w.x = pk_bf16(x[8 * s + 0], x[8 * s + 1]); w.y = pk_bf16(x[8 * s + 2], x[8 * s + 3]); w.z = pk_bf16(x[8 * s + 4], x[8 * s + 5]); w.w = pk_bf16(x[8 * s + 6], x[8 * s + 7]);
    return __builtin_bit_cast(bf16x8, w);
}


#define XB_TMO      128
#define XB_XCNT(j)  (256  + 64 * (j))
#define XB_XSUB(j)  (1280 + 64 * (j))
#define XB_XGEN(j)  (2304 + 64 * (j))
#define XB_TOP      3328
#define XB_TOPGEN   3392
#define XCD_BAR_WORDS 3456
#define XB_SPIN_CAP (1u << 18)
struct XcdBarrier { unsigned* bar; unsigned x; volatile LAS unsigned* st; };
DI unsigned xb_ld(unsigned* p)              { return __hip_atomic_load(p, __ATOMIC_RELAXED, __HIP_MEMORY_SCOPE_AGENT); }
DI unsigned xb_add(unsigned* p, unsigned v) { return __hip_atomic_fetch_add(p, v, __ATOMIC_RELAXED, __HIP_MEMORY_SCOPE_AGENT); }
DI unsigned xb_xcc_id() { return (unsigned)__builtin_amdgcn_s_getreg((3 << 11) | 20) & 0xFu; }
#define XB_SPIN(cond, bar) do { unsigned _sp = 0; while (cond) { __builtin_amdgcn_s_sleep(1); \
    if ((++_sp & 255u) == 0u) { if (xb_ld(&(bar)[XB_TMO])) break; if (_sp > XB_SPIN_CAP) { atomicAdd(&(bar)[XB_TMO], 1u); break; } } } } while (0)
DI XcdBarrier xcd_barrier_post(unsigned* bar, volatile LAS unsigned* st) {
    XcdBarrier b; b.bar = bar; b.x = xb_xcc_id(); b.st = st;
    if (threadIdx.x == 0) (void)xb_add(&bar[XB_XCNT(b.x)], 1u);
    return b;
}
DI void xcd_barrier_complete(unsigned* bar, unsigned x, unsigned& nloc, unsigned& nx) {
    const unsigned G = gridDim.x * gridDim.y * gridDim.z;
    unsigned sum, cnt, mine, sp = 0u;
    for (;;) {
        sum = 0u; cnt = 0u; mine = 0u;
#pragma unroll
        for (unsigned j = 0; j < 16; ++j) { const unsigned c = xb_ld(&bar[XB_XCNT(j)]); sum += c; cnt += (c > 0u) ? 1u : 0u; mine = (j == x) ? c : mine; }
        if (sum == G) break;
        __builtin_amdgcn_s_sleep(1);
        if ((++sp & 255u) == 0u) { if (xb_ld(&bar[XB_TMO])) break; if (sp > XB_SPIN_CAP) { atomicAdd(&bar[XB_TMO], 1u); break; } }
    }
    nloc = mine > 0u ? mine : 1u; nx = cnt > 0u ? cnt : 1u;
}
DI void xcd_barrier(const XcdBarrier& b) {
    asm volatile("s_waitcnt vmcnt(0)" ::: "memory");
    __syncthreads();
    if (threadIdx.x == 0) {
        unsigned* bar = b.bar;
        __builtin_amdgcn_s_waitcnt(0);
        unsigned nloc = b.st[0], nx = b.st[1];
        if (nloc == 0u) { xcd_barrier_complete(bar, b.x, nloc, nx); b.st[0] = nloc; b.st[1] = nx; }
        const unsigned old = xb_add(&bar[XB_XSUB(b.x)], 1u);
        const unsigned gen = old / nloc;
        if (old + 1u == (gen + 1u) * nloc) {
            __builtin_amdgcn_fence(__ATOMIC_RELEASE, "agent");
            asm volatile("s_waitcnt vmcnt(0)" ::: "memory");
            const unsigned og = xb_add(&bar[XB_TOP], 1u);
            const unsigned tg = og / nx;
            if (og + 1u == (tg + 1u) * nx) xb_add(&bar[XB_TOPGEN], 1u);
            else XB_SPIN(xb_ld(&bar[XB_TOPGEN]) == tg, bar);
            __builtin_amdgcn_fence(__ATOMIC_ACQUIRE, "agent");
            xb_add(&bar[XB_XGEN(b.x)], 1u);
            asm volatile("s_waitcnt vmcnt(0)" ::: "memory");
        } else {
            XB_SPIN(xb_ld(&bar[XB_XGEN(b.x)]) == gen, bar);
            __builtin_amdgcn_fence(__ATOMIC_ACQUIRE, "agent");
            asm volatile("s_waitcnt vmcnt(0)" ::: "memory");
        }
    }
    __syncthreads();
}

namespace pg8 {
constexpr int BM = 256, BK = 64, HALF = 128, HTB = HALF * BK * 2, STAGE_BYTES = 8 * HTB, NXCD = 8, WGM = 8;
DI int lds_byte(int r, int c) { const int st = (r >> 4) * 2 + (c >> 5), rr = r & 15, cc = c & 31, ob = rr * 64 + cc * 2; return st * 1024 + (ob ^ (((ob >> 9) & 1) << 5)); }
DI void stage_rc(int b, int& R, int& C) { const int st = b / 1024, sb = b % 1024, swz = sb ^ (((sb >> 9) & 1) << 5); R = (st >> 1) * 16 + swz / 64; C = (st & 1) * 32 + (swz % 64) / 2; }
DI int perm32(int rho) { const int n = rho >> 4, i = rho & 15; return 8 * (i >> 2) + 4 * n + (i & 3); }
struct Unit { int pm, pn; };
struct Gemm { const bf16_t* A; const bf16_t* Bt; int M, N, K; };
struct StaticOrder {
    int nM, nN, nwg, G, c, i0 = 0, imax = 1 << 30;
    DI void init(int M, int N, int G_, int c_) { nM = M / BM; nN = N / BM; nwg = nM * nN; G = G_; c = c_; }
    DI bool next(int i, Unit& u) const {
        if (i >= imax) return false;
        const long L = (long)(i + i0) * G + c; if (L >= nwg) return false;
        int wgid = (int)L; { const int q = nwg / NXCD, r = nwg % NXCD, xcd = wgid % NXCD, off = wgid / NXCD; wgid = (xcd < r ? xcd * (q + 1) : r * (q + 1) + (xcd - r) * q) + off; }
        const int nig = WGM * nN, gid = wgid / nig, fm = gid * WGM, gsz = (nM - fm) < WGM ? (nM - fm) : WGM;
        u.pm = fm + ((wgid % nig) % gsz); u.pn = (wgid % nig) / gsz; return true;
    }
    DI void a_ready(const Unit&) const {}
    DI void done(const Unit&) const {}
};

struct EpiP1 {
    static constexpr bool PERM = true, AFTER_DRAIN = false;
    bf16_t* O; int ldc; bf16_t* KX;
    DI void operator()(const f32x4 (&acc)[2][2][4][2], const Unit& u, int wr, int wc, int fr, int fq) const {
        const int row0 = u.pm * BM + wr * 64 + fr, col0 = u.pn * BM + wc * 32 + 8 * fq;
        if (u.pn >= 12) {
#pragma unroll
            for (int ai = 0; ai < 2; ++ai)
#pragma unroll
                for (int m = 0; m < 4; ++m) { const int row = row0 + ai * HALF + m * 16, b = row >> 11, tok = row & 2047;
#pragma unroll
                    for (int bj = 0; bj < 2; ++bj) { const f32x4 v0 = acc[ai][bj][m][0], v1 = acc[ai][bj][m][1];
                        const int c = col0 - 12 * BM + bj * HALF, hm = c >> 6, d = c & 63;
                        u32x4 w; w.x = pk_bf16(v0[0], v0[1]); w.y = pk_bf16(v0[2], v0[3]); w.z = pk_bf16(v1[0], v1[1]); w.w = pk_bf16(v1[2], v1[3]);
                        *(u32x4*)(KX + ((size_t)(b * 8 + hm) * 2048 + tok) * 64 + d) = w; } }
            return;
        }
#pragma unroll
        for (int ai = 0; ai < 2; ++ai)
#pragma unroll
            for (int m = 0; m < 4; ++m) { bf16_t* rowp = O + (size_t)(row0 + ai * HALF + m * 16) * ldc + col0;
#pragma unroll
                for (int bj = 0; bj < 2; ++bj) { const f32x4 v0 = acc[ai][bj][m][0], v1 = acc[ai][bj][m][1];
                    u32x4 w; w.x = pk_bf16(v0[0], v0[1]); w.y = pk_bf16(v0[2], v0[3]); w.z = pk_bf16(v1[0], v1[1]); w.w = pk_bf16(v1[2], v1[3]);
                    *(u32x4*)(rowp + bj * HALF) = w; } }
    }
};
struct EpiVT {
    static constexpr bool PERM = false, AFTER_DRAIN = false;
    bf16_t* VT;
    DI void operator()(const f32x4 (&acc)[2][2][4][2], const Unit& u, int wr, int wc, int fr, int fq) const {
#pragma unroll
        for (int ai = 0; ai < 2; ++ai)
#pragma unroll
            for (int m = 0; m < 4; ++m) {
                const int t = u.pm * BM + ai * HALF + wr * 64 + m * 16 + 4 * fq, b = t >> 11, tok = t & 2047, pos = perm23(tok);
#pragma unroll
                for (int bj = 0; bj < 2; ++bj)
#pragma unroll
                    for (int n = 0; n < 2; ++n) {
                        const int c = u.pn * BM + bj * HALF + wc * 32 + n * 16 + fr, hh = c >> 7, dv = c & 127;
                        const f32x4 v = acc[ai][bj][m][n];
                        u32x2 w; w.x = pk_bf16(v[0], v[1]); w.y = pk_bf16(v[2], v[3]);
                        *(u32x2*)(VT + (((size_t)((b * 4 + hh) * 32 + (pos >> 6)) * 128 + dv)) * 64 + (pos & 63)) = w;
                    }
            }
    }
};
struct EpiOutFused {
    static constexpr bool PERM = false, AFTER_DRAIN = true;
    const float* X; float* Out; float* rowsq; const float* fw; XcdBarrier xb;
    DI void operator()(const f32x4 (&)[2][2][4][2], const Unit&, int, int, int, int) const {}
    DI void fused(f32x4 (&acc)[2][2][4][2], const Unit& u, int wr, int wc, int fr, int fq) const {
        const int row0 = u.pm * BM + wr * 64 + fr, col0 = u.pn * BM + wc * 32 + 4 * fq;
#pragma unroll
        for (int ai = 0; ai < 2; ++ai)
#pragma unroll
            for (int m = 0; m < 4; ++m) {
                const int row = row0 + ai * HALF + m * 16; float ss = 0.f;
#pragma unroll
                for (int bj = 0; bj < 2; ++bj)
#pragma unroll
                    for (int n = 0; n < 2; ++n) {
                        const size_t o = (size_t)row * DM + col0 + bj * HALF + n * 16;
                        const f32x4 y = acc[ai][bj][m][n] + *(const f32x4*)(X + o);
                        acc[ai][bj][m][n] = y; ss += y[0] * y[0] + y[1] * y[1] + y[2] * y[2] + y[3] * y[3];
                    }
                ss += __shfl_xor(ss, 16); ss += __shfl_xor(ss, 32);
                if (fq == 0) rowsq[(size_t)row * 16 + u.pn * 4 + wc] = ss;
            }
        xcd_barrier(xb);
        f32x4 fwv[2][2];
#pragma unroll
        for (int bj = 0; bj < 2; ++bj)
#pragma unroll
            for (int n = 0; n < 2; ++n) fwv[bj][n] = *(const f32x4*)(fw + col0 + bj * HALF + n * 16);
#pragma unroll
        for (int ai = 0; ai < 2; ++ai)
#pragma unroll
            for (int m = 0; m < 4; ++m) {
                const int row = row0 + ai * HALF + m * 16;
                const f32x4* rq = (const f32x4*)(rowsq + (size_t)row * 16);
                const f32x4 q0 = rq[0], q1 = rq[1], q2 = rq[2], q3 = rq[3];
                const float tot = ((q0[0] + q0[1]) + (q0[2] + q0[3])) + ((q1[0] + q1[1]) + (q1[2] + q1[3])) + ((q2[0] + q2[1]) + (q2[2] + q2[3])) + ((q3[0] + q3[1]) + (q3[2] + q3[3]));
                const float rstd = rsqrtf(tot * (1.0f / DM) + EPS);
#pragma unroll
                for (int bj = 0; bj < 2; ++bj)
#pragma unroll
                    for (int n = 0; n < 2; ++n) {
                        const size_t o = (size_t)row * DM + col0 + bj * HALF + n * 16;
                        *(f32x4*)(Out + o) = acc[ai][bj][m][n] * rstd * fwv[bj][n];
                    }
            }
    }
};

template <class Epi, bool SWAP>
DI void gemm_phase(LAS unsigned char* lds, const Gemm g, const StaticOrder& S, const Epi& E) {
    int tid = threadIdx.x; asm volatile("" : "+v"(tid));
    const int wid = __builtin_amdgcn_readfirstlane(tid >> 6), lane = tid & 63, wr = wid >> 2, wc = wid & 3, fr = lane & 15, fq = lane >> 4;
    const int K = g.K, nt = K / BK;
    unsigned voffA[2], voffB[2];
#pragma unroll
    for (int i = 0; i < 2; ++i) { int R, C; stage_rc(tid * 16 + i * 8192, R, C); const int Rb = Epi::PERM ? ((R & ~31) + perm32(R & 31)) : R;
        voffA[i] = (unsigned)(R * K + C) * 2u; voffB[i] = (unsigned)(Rb * K + C) * 2u; }
    const size_t kstep = (size_t)(BK * 2);
    const size_t hstep = (size_t)HALF * K * 2;
    const size_t tstep = 2 * hstep;
    const unsigned ldsw = (unsigned)wid * 1024u;
    const int aoff = lds_byte(wr * 64 + fr, fq * 8), boff = lds_byte(wc * 32 + fr, fq * 8);
#define PG8_SA(b, h) (((b) * 2 + (h)) * HTB)
#define PG8_SB(b, h) ((4 + (b) * 2 + (h)) * HTB)
#define PG8_STAGE(bufoff, gbase, voff) do { _Pragma("unroll") for (int _i = 0; _i < 2; ++_i) \
        __builtin_amdgcn_global_load_lds((const unsigned*)((const char*)(gbase) + (voff)[_i]), (LAS unsigned*)(lds + (bufoff) + ldsw + _i * 8192), 16, 0, 0); } while (0)
#define PG8_LDA(dst, b, h) do { _Pragma("unroll") for (int m = 0; m < 4; ++m) _Pragma("unroll") for (int k = 0; k < 2; ++k) dst[m][k] = *(const LAS bf16x8*)(lds + PG8_SA(b, h) + aoff + m * 2048 + k * 1024); } while (0)
#define PG8_LDB(dst, b, h) do { _Pragma("unroll") for (int n = 0; n < 2; ++n) _Pragma("unroll") for (int k = 0; k < 2; ++k) dst[n][k] = *(const LAS bf16x8*)(lds + PG8_SB(b, h) + boff + n * 2048 + k * 1024); } while (0)
#define PG8_MMA(ai, bj, At, Bt) do { __builtin_amdgcn_s_setprio(1); _Pragma("unroll") for (int m = 0; m < 4; ++m) _Pragma("unroll") for (int n = 0; n < 2; ++n) _Pragma("unroll") for (int k = 0; k < 2; ++k) \
        acc[ai][bj][m][n] = SWAP ? __builtin_amdgcn_mfma_f32_16x16x32_bf16(At[m][k], Bt[n][k], acc[ai][bj][m][n], 0, 0, 0) \
                                 : __builtin_amdgcn_mfma_f32_16x16x32_bf16(Bt[n][k], At[m][k], acc[ai][bj][m][n], 0, 0, 0); __builtin_amdgcn_s_setprio(0); } while (0)
#define PG8_WAIT_V(n) asm volatile("s_waitcnt vmcnt(" #n ")" ::: "memory")
#define PG8_WAIT_L(n) asm volatile("s_waitcnt lgkmcnt(" #n ")" ::: "memory")
#define PG8_BAR __builtin_amdgcn_s_barrier()
#define PG8_SCHED __builtin_amdgcn_sched_barrier(0)
    Unit cur, nxt; int ui = 0;
    if (!S.next(0, cur)) return;
    f32x4 acc[2][2][4][2];
#pragma unroll
    for (int a = 0; a < 2; ++a)
#pragma unroll
        for (int b = 0; b < 2; ++b)
#pragma unroll
            for (int m = 0; m < 4; ++m)
#pragma unroll
                for (int n = 0; n < 2; ++n) acc[a][b][m][n] = (f32x4){0.f, 0.f, 0.f, 0.f};
    bf16x8 At[4][2], B0[2][2], B1[2][2];
    const char* cA = (const char*)g.A + (size_t)cur.pm * tstep; const char* cB = (const char*)g.Bt + (size_t)cur.pn * tstep;
    PG8_STAGE(PG8_SB(0, 0), cB, voffB); PG8_STAGE(PG8_SA(0, 0), cA, voffA); PG8_STAGE(PG8_SB(0, 1), cB + hstep, voffB); PG8_STAGE(PG8_SA(0, 1), cA + hstep, voffA);
    if (wr == 1) PG8_BAR;
    PG8_WAIT_V(4); PG8_BAR;
    PG8_STAGE(PG8_SB(1, 0), cB + kstep, voffB); PG8_STAGE(PG8_SA(1, 0), cA + kstep, voffA); PG8_STAGE(PG8_SB(1, 1), cB + hstep + kstep, voffB);
    PG8_WAIT_V(6); PG8_BAR;
    for (;;) {
        const bool has_next = S.next(ui + 1, nxt);
        const char* nA = has_next ? (const char*)g.A + (size_t)nxt.pm * tstep : cA; const char* nB = has_next ? (const char*)g.Bt + (size_t)nxt.pn * tstep : cB;
        for (int t = 0; t < nt; t += 2) {
            const bool last = (t == nt - 2);
            const char* a1 = cA + (size_t)(t + 1) * kstep;
            const char* a2 = last ? nA : cA + (size_t)(t + 2) * kstep; const char* b2 = last ? nB : cB + (size_t)(t + 2) * kstep;
            const char* a3 = a2 + kstep; const char* b3 = b2 + kstep;
            PG8_LDB(B0, 0, 0); PG8_SCHED; PG8_LDA(At, 0, 0); PG8_STAGE(PG8_SA(1, 1), a1 + hstep, voffA);
            PG8_WAIT_L(8); PG8_BAR; PG8_WAIT_L(0); PG8_MMA(0, 0, At, B0); PG8_BAR; PG8_SCHED;
            PG8_LDB(B1, 0, 1); PG8_STAGE(PG8_SB(0, 0), b2, voffB);
            PG8_BAR; PG8_WAIT_L(0); PG8_MMA(0, 1, At, B1); PG8_BAR;
            PG8_LDA(At, 0, 1); PG8_STAGE(PG8_SA(0, 0), a2, voffA);
            PG8_BAR; PG8_WAIT_L(0); PG8_MMA(1, 0, At, B0); PG8_BAR; PG8_SCHED;
            PG8_STAGE(PG8_SB(0, 1), b2 + hstep, voffB);
            PG8_WAIT_V(6); PG8_BAR; PG8_MMA(1, 1, At, B1); PG8_BAR;
            PG8_LDB(B0, 1, 0); PG8_SCHED; PG8_LDA(At, 1, 0); PG8_STAGE(PG8_SA(0, 1), a2 + hstep, voffA);
            PG8_WAIT_L(8); PG8_BAR; PG8_WAIT_L(0); PG8_MMA(0, 0, At, B0); PG8_BAR; PG8_SCHED;
            PG8_LDB(B1, 1, 1); PG8_STAGE(PG8_SB(1, 0), b3, voffB);
            PG8_BAR; PG8_WAIT_L(0); PG8_MMA(0, 1, At, B1); PG8_BAR;
            PG8_LDA(At, 1, 1); PG8_STAGE(PG8_SA(1, 0), a3, voffA);
            PG8_BAR; PG8_WAIT_L(0); PG8_MMA(1, 0, At, B0); PG8_BAR; PG8_SCHED;
            PG8_STAGE(PG8_SB(1, 1), b3 + hstep, voffB);
            PG8_WAIT_V(6); PG8_BAR; PG8_MMA(1, 1, At, B1); PG8_BAR;
        }
        if constexpr (!Epi::AFTER_DRAIN) E(acc, cur, wr, wc, fr, fq);
        if (!has_next) break;
#pragma unroll
        for (int a = 0; a < 2; ++a)
#pragma unroll
            for (int b = 0; b < 2; ++b)
#pragma unroll
                for (int m = 0; m < 4; ++m)
#pragma unroll
                    for (int n = 0; n < 2; ++n) acc[a][b][m][n] = (f32x4){0.f, 0.f, 0.f, 0.f};
        cur = nxt; cA = nA; cB = nB; ++ui;
    }
    PG8_WAIT_V(0);
    if (wr == 0) PG8_BAR;
    PG8_BAR;
    if constexpr (Epi::AFTER_DRAIN) E.fused(acc, cur, wr, wc, fr, fq);
#undef PG8_SA
#undef PG8_SB
#undef PG8_STAGE
#undef PG8_LDA
#undef PG8_LDB
#undef PG8_MMA
#undef PG8_WAIT_V
#undef PG8_WAIT_L
#undef PG8_BAR
#undef PG8_SCHED
}
}

DI int win_src_col(int n0) {
    if (n0 < 2048) return n0;
    if (n0 < 2560) return 2056 + (n0 - 2048);
    if (n0 < 3072) return 3592 + (n0 - 2560);
    if (n0 < 3584) return 2568 + (n0 - 3072);
    return 3080 + (n0 - 3584);
}
DI void phase_prep(const Params& p, LAS unsigned char* lds) {
    int tid = threadIdx.x; asm volatile("" : "+v"(tid));
    const int lane = tid & 63, wid = tid >> 6;
    if (blockIdx.x == 0 && wid == 0) {
        float a = p.lq1[lane] * p.lk1[lane], b = p.lq2[lane] * p.lk2[lane];
        a = wave_sum(a); b = wave_sum(b);
        if (lane == 0) { *(float*)(p.ws + OFF_MISC) = expf(a) - expf(b) + 0.2f; *(unsigned*)(p.ws + OFF_MISC + 4) = 0u; *(unsigned*)(p.ws + OFF_MISC + 8) = 0u; *(unsigned*)(p.ws + OFF_MISC + 12) = 0u; }
    }
    bf16_t* hb = (bf16_t*)(p.ws + OFF_HB);
    float* gbga = (float*)(p.ws + OFF_GBGA);
    const int gw = blockIdx.x * 8 + wid, nw = gridDim.x * 8;
    {
        f32x4 nwv[4]; float wq[16][8];
#pragma unroll
        for (int i = 0; i < 4; ++i) {
            nwv[i] = ((const f32x4*)p.norm_w)[lane + 64 * i];
#pragma unroll
            for (int e = 0; e < 4; ++e) {
                const int k = 4 * (lane + 64 * i) + e;
                const f32x4* wp = (const f32x4*)(p.w_in + (size_t)k * 4104 + 2048);
                const f32x4 w0 = wp[0], w1 = wp[1];
#pragma unroll
                for (int j = 0; j < 4; ++j) { wq[4 * i + e][j] = nwv[i][e] * w0[j]; wq[4 * i + e][4 + j] = nwv[i][e] * w1[j]; }
            }
        }
        const bool b5 = (lane & 32) != 0, b4 = (lane & 16) != 0, b3 = (lane & 8) != 0;
        const int col = (b5 ? 4 : 0) + (b4 ? 2 : 0) + (b3 ? 1 : 0);
        int row = gw;
        f32x4 v[4];
        if (row < MTOK) {
#pragma unroll
            for (int i = 0; i < 4; ++i) v[i] = __builtin_nontemporal_load((const f32x4*)(p.x + (size_t)row * DM) + lane + 64 * i);
        }
#pragma unroll 1
        for (; row < MTOK; row += nw) {
            f32x4 vnx[4];
            const int rnx = (row + nw < MTOK) ? row + nw : row;
#pragma unroll
            for (int i = 0; i < 4; ++i) vnx[i] = __builtin_nontemporal_load((const f32x4*)(p.x + (size_t)rnx * DM) + lane + 64 * i);
            float ss = 0.f, a8[8];
#pragma unroll
            for (int j = 0; j < 8; ++j) a8[j] = 0.f;
#pragma unroll
            for (int i = 0; i < 4; ++i)
#pragma unroll
                for (int e = 0; e < 4; ++e) {
                    ss += v[i][e] * v[i][e];
#pragma unroll
                    for (int j = 0; j < 8; ++j) a8[j] += v[i][e] * wq[4 * i + e][j];
                }
            ss = wave_sum(ss);
            const float rstd = rsqrtf(ss * (1.0f / DM) + EPS);
#pragma unroll
            for (int i = 0; i < 4; ++i) {
                const f32x4 h = v[i] * rstd * nwv[i];
                u32x2 w; w.x = pk_bf16(h[0], h[1]); w.y = pk_bf16(h[2], h[3]);
                *(u32x2*)(hb + (size_t)row * DM + 4 * (lane + 64 * i)) = w;
            }
            float c4[4], c2[2], c1;
#pragma unroll
            for (int j = 0; j < 4; ++j) { const float send = b5 ? a8[j] : a8[4 + j], keep = b5 ? a8[4 + j] : a8[j]; c4[j] = keep + __shfl_xor(send, 32); }
#pragma unroll
            for (int j = 0; j < 2; ++j) { const float send = b4 ? c4[j] : c4[2 + j], keep = b4 ? c4[2 + j] : c4[j]; c2[j] = keep + __shfl_xor(send, 16); }
            { const float send = b3 ? c2[0] : c2[1], keep = b3 ? c2[1] : c2[0]; c1 = keep + __shfl_xor(send, 8); }
            c1 += __shfl_xor(c1, 4); c1 += __shfl_xor(c1, 2); c1 += __shfl_xor(c1, 1);
            if ((lane & 7) == 0) gbga[(size_t)row * 8 + col] = c1 * rstd;
#pragma unroll
            for (int i = 0; i < 4; ++i) v[i] = vnx[i];
        }
    }
    LAS float* tl = (LAS float*)lds;
    for (int tile = blockIdx.x; tile < 1024 + 256; tile += gridDim.x) {
        const float* src; int ld, n0, k0, srcn0; bf16_t* dst;
        if (tile < 1024) { n0 = (tile >> 4) * 64; k0 = (tile & 15) * 64; srcn0 = win_src_col(n0); src = p.w_in; ld = 4104; dst = (bf16_t*)(p.ws + OFF_WINT); }
        else { const int t2 = tile - 1024; n0 = (t2 >> 4) * 64; k0 = (t2 & 15) * 64; srcn0 = n0; src = p.w_out; ld = 1024; dst = (bf16_t*)(p.ws + OFF_WOUTT); }
        const int kk = tid >> 4, n4 = tid & 15;
#pragma unroll
        for (int ps = 0; ps < 2; ++ps) { const int k = kk + 32 * ps;
            const f32x4 v = *(const f32x4*)(src + (size_t)(k0 + k) * ld + srcn0 + 4 * n4);
#pragma unroll
            for (int e = 0; e < 4; ++e) tl[k * 65 + 4 * n4 + e] = v[e]; }
        __syncthreads();
        { const int n = tid >> 3, k8 = tid & 7; float f[8];
#pragma unroll
            for (int e = 0; e < 8; ++e) f[e] = tl[(8 * k8 + e) * 65 + n];
            u32x4 w; w.x = pk_bf16(f[0], f[1]); w.y = pk_bf16(f[2], f[3]); w.z = pk_bf16(f[4], f[5]); w.w = pk_bf16(f[6], f[7]);
            *(u32x4*)(dst + (size_t)(n0 + n) * 1024 + k0 + 8 * k8) = w; }
        __syncthreads();
    }
}

constexpr int AT_KB = 8192, AT_VB = 16384, AT_BUF = AT_KB + AT_VB, AT_NBUF = 3, AT_TASK = AT_NBUF * AT_BUF, AT_O1 = AT_TASK + 256;

DI void attn_qblock(const Params& p, LAS unsigned char* lds, int b, int hh, int qb, float lam) {
    int tid = threadIdx.x; asm volatile("" : "+v"(tid));
    const int lane = tid & 63, wid = __builtin_amdgcn_readfirstlane(tid >> 6);
    const bf16_t* P1 = (const bf16_t*)(p.ws + OFF_P1);
    const bf16_t* VT = (const bf16_t*)(p.ws + OFF_VT) + (size_t)(b * 4 + hh) * 32 * 128 * 64;
    const bf16_t* KX = (const bf16_t*)(p.ws + OFF_KX) + (size_t)(b * 4 + hh) * 2 * 2048 * 64;
    bf16_t* mix = (bf16_t*)(p.ws + OFF_HB);
    const int q0 = qb * 256 + wid * 32;
    const size_t tokbase = (size_t)b * SEQ;
    const int nkt = (qb + 1) * 4;
    const float sl2 = exp2f(-2.0f * (float)(hh + 1)) * LOG2E;
    const float c1 = 0.125f * LOG2E;
#pragma unroll 1
    for (int map = 0; map < 2; ++map) {
        f32x16 O[4];
#pragma unroll
        for (int mt = 0; mt < 4; ++mt)
#pragma unroll
            for (int i = 0; i < 16; ++i) O[mt][i] = 0.f;
        float m = -INFINITY, l = 0.f;
        int lane_m = lane; asm volatile("" : "+v"(lane_m));
        const int r = lane_m & 31, h2 = lane_m >> 5;
        int foff[4];
#pragma unroll
        for (int k = 0; k < 4; ++k) foff[k] = r * 128 + (((2 * k + h2) ^ ((r >> 1) & 7)) << 4);
        float kb[16];
#pragma unroll
        for (int i = 0; i < 16; ++i) kb[i] = sl2 * (float)crow(i, h2);
        const int krow_ = 8 * wid + (lane_m >> 3), vrow0 = 16 * wid + (lane_m >> 3), vrow1 = vrow0 + 8;
        const bf16_t* kgp = KX + ((size_t)map * 2048 + krow_) * 64 + (((lane_m & 7) ^ ((krow_ >> 1) & 7)) * 8);
        const bf16_t* vgp0 = VT + (size_t)vrow0 * 64 + (((lane_m & 7) ^ ((vrow0 >> 1) & 7)) * 8);
        const bf16_t* vgp1 = VT + (size_t)vrow1 * 64 + (((lane_m & 7) ^ ((vrow1 >> 1) & 7)) * 8);
#define AT_STAGE(bufi, tile) do { LAS unsigned char* _b = lds + (bufi) * AT_BUF; \
            __builtin_amdgcn_global_load_lds((const unsigned*)(kgp + (size_t)(tile) * 64 * 64), (LAS unsigned*)(_b + wid * 1024), 16, 0, 0); \
            __builtin_amdgcn_global_load_lds((const unsigned*)(vgp0 + (size_t)(tile) * 128 * 64), (LAS unsigned*)(_b + AT_KB + wid * 2048), 16, 0, 0); \
            __builtin_amdgcn_global_load_lds((const unsigned*)(vgp1 + (size_t)(tile) * 128 * 64), (LAS unsigned*)(_b + AT_KB + wid * 2048 + 1024), 16, 0, 0); } while (0)
        bf16x8 qf[4];
        { const bf16_t* qp = P1 + (tokbase + q0 + (lane_m & 31)) * NP1 + C_DQ + hh * 128 + map * 64 + 8 * (lane_m >> 5);
#pragma unroll
            for (int ks = 0; ks < 4; ++ks) qf[ks] = *(const bf16x8*)(qp + 16 * ks); }
        AT_STAGE(0, 0);
        AT_STAGE(1, 1);
        asm volatile("" : "+v"(qf[0]), "+v"(qf[1]), "+v"(qf[2]), "+v"(qf[3]));
        int cb = 0;
#pragma unroll 1
        for (int kt = 0; kt < nkt; ++kt) {
            if (kt + 1 < nkt) asm volatile("s_waitcnt vmcnt(3)" ::: "memory"); else asm volatile("s_waitcnt vmcnt(0)" ::: "memory");
            __builtin_amdgcn_s_barrier();
            asm volatile("" ::: "memory");
            if (kt + 2 < nkt) { const int nb = cb == 0 ? 2 : cb - 1; AT_STAGE(nb, kt + 2); }
            const LAS unsigned char* cur = lds + cb * AT_BUF;
            cb = cb == 2 ? 0 : cb + 1;
            const int k0 = kt * 64;
            if (k0 <= q0) {
                const bool sub1 = (k0 + 32 <= q0);
                const LAS unsigned char* vb = cur + AT_KB;
                bf16x8 kf[8];
#pragma unroll
                for (int ks = 0; ks < 4; ++ks) kf[ks] = *(const LAS bf16x8*)(cur + foff[ks]);
                if (sub1) {
#pragma unroll
                    for (int ks = 0; ks < 4; ++ks) kf[4 + ks] = *(const LAS bf16x8*)(cur + 4096 + foff[ks]);
                }
                f32x16 s0, s1;
#pragma unroll
                for (int i = 0; i < 16; ++i) { s0[i] = 0.f; s1[i] = 0.f; }
#pragma unroll
                for (int ks = 0; ks < 4; ++ks) s0 = MFMA32(kf[ks], qf[ks], s0);
                if (sub1) {
#pragma unroll
                    for (int ks = 0; ks < 4; ++ks) s1 = MFMA32(kf[4 + ks], qf[ks], s1);
                }
                __builtin_amdgcn_sched_barrier(0);
                bf16x8 va[8];
#pragma unroll
                for (int s2 = 0; s2 < 2; ++s2)
#pragma unroll
                    for (int mt = 0; mt < 4; ++mt) va[s2 * 4 + mt] = *(const LAS bf16x8*)(vb + mt * 4096 + foff[s2]);
                __builtin_amdgcn_sched_barrier(0);
                const float off0 = sl2 * (float)(k0 - q0), off1 = off0 + 32.0f * sl2;
                const f32x2 c1v = {c1, c1};
#pragma unroll
                for (int j = 0; j < 8; ++j) {
                    const f32x2 kv = {kb[2 * j], kb[2 * j + 1]};
                    f32x2 a = {s0[2 * j], s0[2 * j + 1]}, c = {s1[2 * j], s1[2 * j + 1]};
                    a = __builtin_elementwise_fma(a, c1v, kv); c = __builtin_elementwise_fma(c, c1v, kv);
                    s0[2 * j] = a.x; s0[2 * j + 1] = a.y; s1[2 * j] = c.x; s1[2 * j + 1] = c.y;
                }
                if (k0 == q0) {
#pragma unroll
                    for (int i = 0; i < 16; ++i) if (crow(i, h2) > r) s0[i] = -INFINITY;
                }
                if (k0 + 32 == q0) {
#pragma unroll
                    for (int i = 0; i < 16; ++i) if (crow(i, h2) > r) s1[i] = -INFINITY;
                }
                float mx0 = fmaxf(s0[0], s0[1]), mx1 = fmaxf(s1[0], s1[1]);
#pragma unroll
                for (int j = 1; j < 8; ++j) { mx0 = fmaxf(fmaxf(s0[2 * j], s0[2 * j + 1]), mx0); mx1 = fmaxf(fmaxf(s1[2 * j], s1[2 * j + 1]), mx1); }
                float mx = sub1 ? fmaxf(mx0 + off0, mx1 + off1) : mx0 + off0;
                mx = fmaxf(mx, __shfl_xor(mx, 32));
                if (__builtin_amdgcn_ballot_w64(mx > m + 8.0f) != 0ull) {
                    const float mn = fmaxf(m, mx);
                    const float alpha = __builtin_amdgcn_exp2f(m - mn);
                    m = mn; l *= alpha;
#pragma unroll
                    for (int mt = 0; mt < 4; ++mt)
#pragma unroll
                        for (int i = 0; i < 16; ++i) O[mt][i] *= alpha;
                }
                const float r0 = m - off0, r1 = sub1 ? m - off1 : INFINITY;
                const f32x2 r0v = {r0, r0}, r1v = {r1, r1};
                f32x2 lsv = {0.f, 0.f};
#pragma unroll
                for (int j = 0; j < 8; ++j) {
                    f32x2 a = {s0[2 * j], s0[2 * j + 1]}, c = {s1[2 * j], s1[2 * j + 1]};
                    a = a - r0v; c = c - r1v;
                    a.x = __builtin_amdgcn_exp2f(a.x); a.y = __builtin_amdgcn_exp2f(a.y); c.x = __builtin_amdgcn_exp2f(c.x); c.y = __builtin_amdgcn_exp2f(c.y);
                    lsv = lsv + a; lsv = lsv + c;
                    s0[2 * j] = a.x; s0[2 * j + 1] = a.y; s1[2 * j] = c.x; s1[2 * j + 1] = c.y;
                }
                l += lsv.x + lsv.y;
                bf16x8 pf[4];
#pragma unroll
                for (int s = 0; s < 2; ++s) { pf[s] = pack8(s0, s); pf[2 + s] = pack8(s1, s); }
                __builtin_amdgcn_sched_barrier(0);
                bf16x8 vc[4], vd[4];
                if (sub1) {
#pragma unroll
                    for (int mt = 0; mt < 4; ++mt) vc[mt] = *(const LAS bf16x8*)(vb + mt * 4096 + foff[2]);
                }
#pragma unroll
                for (int mt = 0; mt < 4; ++mt) O[mt] = MFMA32(va[mt], pf[0], O[mt]);
                if (sub1) {
#pragma unroll
                    for (int mt = 0; mt < 4; ++mt) vd[mt] = *(const LAS bf16x8*)(vb + mt * 4096 + foff[3]);
                }
#pragma unroll
                for (int mt = 0; mt < 4; ++mt) O[mt] = MFMA32(va[4 + mt], pf[1], O[mt]);
                if (sub1) {
#pragma unroll
                    for (int mt = 0; mt < 4; ++mt) O[mt] = MFMA32(vc[mt], pf[2], O[mt]);
#pragma unroll
                    for (int mt = 0; mt < 4; ++mt) O[mt] = MFMA32(vd[mt], pf[3], O[mt]);
                }
            }
        }
        asm volatile("" ::: "memory");
        __builtin_amdgcn_s_barrier();
        asm volatile("" ::: "memory");
#undef AT_STAGE
        const float lt = l + __shfl_xor(l, 32);
        int lane_o = lane; asm volatile("" : "+v"(lane_o));
        LAS unsigned* o1l = (LAS unsigned*)(lds + AT_O1 + wid * 8192) + lane_o;
        if (map == 0) {
            const float inv1 = 1.0f / lt;
#pragma unroll
            for (int mt = 0; mt < 4; ++mt)
#pragma unroll
                for (int j = 0; j < 8; ++j) o1l[(mt * 8 + j) * 64] = pk_bf16(O[mt][2 * j] * inv1, O[mt][2 * j + 1] * inv1);
        } else {
            const float inv2 = lam / lt;
            float ss = 0.f;
#pragma unroll
            for (int mt = 0; mt < 4; ++mt)
#pragma unroll
                for (int j = 0; j < 8; ++j) {
                    const unsigned o1 = o1l[(mt * 8 + j) * 64];
                    const float a = bf_lo(o1) - O[mt][2 * j] * inv2, c = bf_hi(o1) - O[mt][2 * j + 1] * inv2;
                    O[mt][2 * j] = a; O[mt][2 * j + 1] = c; ss += a * a + c * c;
                }
            ss += __shfl_xor(ss, 32);
            const float rs = rsqrtf(ss * (1.0f / 128.0f) + EPS) * 0.8f;
#pragma unroll
            for (int mt = 0; mt < 4; ++mt)
#pragma unroll
                for (int j = 0; j < 8; ++j) o1l[(mt * 8 + j) * 64] = pk_bf16(O[mt][2 * j] * rs, O[mt][2 * j + 1] * rs);
            __builtin_amdgcn_wave_barrier();
            int lane_e = lane; asm volatile("" : "+v"(lane_e));
            const int dvg = lane_e & 15, qs = lane_e >> 4;
            const f32x4 nw0 = *(const f32x4*)(p.diff_norm_w + 8 * dvg), nw1 = *(const f32x4*)(p.diff_norm_w + 8 * dvg + 4);
            const LAS unsigned* ob = (const LAS unsigned*)(lds + AT_O1 + wid * 8192);
            const int slot = (dvg >> 2) * 8 + 2 * (dvg & 3);
            u32x4 dzv[8];
#pragma unroll
            for (int it = 0; it < 8; ++it) dzv[it] = *(const u32x4*)(P1 + (tokbase + q0 + it * 4 + qs) * NP1 + C_DZ + hh * 128 + 8 * dvg);
#pragma unroll
            for (int it = 0; it < 8; ++it) {
                const int q = it * 4 + qs; const size_t row = tokbase + q0 + q;
                const unsigned u0 = ob[slot * 64 + q], u1 = ob[(slot + 1) * 64 + q], u2 = ob[slot * 64 + q + 32], u3 = ob[(slot + 1) * 64 + q + 32];
                const u32x4 dz = dzv[it];
                u32x4 w;
                w.x = pk_bf16(bf_lo(u0) * nw0[0] * silu_f(bf_lo(dz.x)), bf_hi(u0) * nw0[1] * silu_f(bf_hi(dz.x)));
                w.y = pk_bf16(bf_lo(u1) * nw0[2] * silu_f(bf_lo(dz.y)), bf_hi(u1) * nw0[3] * silu_f(bf_hi(dz.y)));
                w.z = pk_bf16(bf_lo(u2) * nw1[0] * silu_f(bf_lo(dz.z)), bf_hi(u2) * nw1[1] * silu_f(bf_hi(dz.z)));
                w.w = pk_bf16(bf_lo(u3) * nw1[2] * silu_f(bf_lo(dz.w)), bf_hi(u3) * nw1[3] * silu_f(bf_hi(dz.w)));
                *(u32x4*)(mix + row * DM + 512 + hh * 128 + 8 * dvg) = w;
            }
            __builtin_amdgcn_wave_barrier();
        }
    }
}

DI void phase_attn(const Params& p, LAS unsigned char* lds, int rep) {
    const float lam = *(const float*)(p.ws + OFF_MISC);
    unsigned* counter = (unsigned*)(p.ws + OFF_MISC + 4 + 4 * rep);
    LAS int* tslot = (LAS int*)(lds + AT_TASK);
    for (;;) {
        if (threadIdx.x == 0) *tslot = (int)atomicAdd(counter, 1u);
        __syncthreads();
        const int t = *tslot;
        __syncthreads();
        if (t >= 512) break;
        const int qb = 7 - (t >> 6), bh = t & 63;
        attn_qblock(p, lds, bh >> 2, bh & 3, qb, lam);
    }
}


constexpr int G_QN = 0, G_KN = 17408, G_VB = 34816, G_KBG = 52224, G_M = 69632, G_T = 86016, G_SM = 95232;
DI bf16x8 tr_pair(const LAS unsigned char* lo_addr, int hi_off) {
    const s16x4 lo = __builtin_amdgcn_ds_read_tr16_b64_v4i16((LAS s16x4*)(lo_addr));
    const s16x4 hi = __builtin_amdgcn_ds_read_tr16_b64_v4i16((LAS s16x4*)(lo_addr + hi_off));
    return __builtin_shufflevector(lo, hi, 0, 1, 2, 3, 4, 5, 6, 7);
}
DI bf16_t bf16_1(float v) { return (bf16_t)(pk_bf16(v, 0.f) & 0xffffu); }

DI void gdn_gates(const Params& p, LAS float* sm, int c2, int lane) {
    const int b = c2 >> 7, hh = (c2 >> 5) & 3, n = c2 & 31;
    const size_t tok0 = (size_t)b * SEQ + (size_t)n * 64;
    const float* gg = (const float*)(p.ws + OFF_GBGA) + (tok0 + lane) * 8;
    const float gbv = gg[hh], gav = gg[4 + hh];
    const float beta = 1.0f / (1.0f + expf(-gbv));
    const float xs = gav + p.dt_bias[hh];
    const float sp = fmaxf(xs, 0.f) + log1pf(expf(-fabsf(xs)));
    float gc = -expf(p.a_log[hh]) * sp;
#pragma unroll
    for (int o = 1; o < 64; o <<= 1) { const float t = __shfl_up(gc, o); if (lane >= o) gc += t; }
    const float gl = __shfl(gc, 63);
    sm[lane] = beta; sm[64 + lane] = gc * LOG2E; sm[128 + lane] = expf(gc); sm[192 + lane] = expf(gl - gc);
    if (lane == 63) ((float*)(p.ws + OFF_GL))[c2] = expf(gl);
}

DI void gdn_prep(const Params& p, LAS unsigned char* lds, int c2, int c2next, int par) {
    int tid = threadIdx.x; asm volatile("" : "+v"(tid));
    const int lane = tid & 63, wid = __builtin_amdgcn_readfirstlane(tid >> 6), r = lane & 31, h2 = lane >> 5;
    const int b = c2 >> 7, hh = (c2 >> 5) & 3, n = c2 & 31;
    const size_t tok0 = (size_t)b * SEQ + (size_t)n * 64;
    const bf16_t* P1 = (const bf16_t*)(p.ws + OFF_P1);
    LAS float* sm = (LAS float*)(lds + G_SM + par * 1024);
    LAS float* Mf = (LAS float*)(lds + G_M);
    bf16_t* WN = (bf16_t*)(p.ws + OFF_WN) + (size_t)c2 * 8192;
    bf16_t* QD = (bf16_t*)(p.ws + OFF_QD) + (size_t)c2 * 8192;
    bf16_t* KD = (bf16_t*)(p.ws + OFF_KD) + (size_t)c2 * 8192;
    bf16_t* AQ = (bf16_t*)(p.ws + OFF_AQK) + (size_t)c2 * 4096;
    float* U = (float*)(p.ws + OFF_U) + (size_t)c2 * 8192;
    u32x4 raw[6][4];
#pragma unroll
    for (int i = 0; i < 6; ++i) {
        const int item = tid + 512 * i, g = item & 15, t = (item >> 4) & 63, part = i >> 1;
        const int ch = part * 512 + hh * 128 + g * 8;
#pragma unroll
        for (int j = 0; j < 4; ++j) {
            const int tt = n * 64 + t - 3 + j, ttc = tt < 0 ? 0 : tt;
            raw[i][j] = *(const u32x4*)(P1 + ((size_t)b * SEQ + ttc) * NP1 + ch);
            if (tt < 0) raw[i][j] = (u32x4){0u, 0u, 0u, 0u};
        }
    }
    float av[6][8];
#pragma unroll
    for (int i = 0; i < 6; ++i) {
        const int item = tid + 512 * i, g = item & 15, part = i >> 1;
        const int ch = part * 512 + hh * 128 + g * 8;
        float a[8];
#pragma unroll
        for (int e = 0; e < 8; ++e) a[e] = 0.f;
#pragma unroll
        for (int j = 0; j < 4; ++j) {
            const f32x4 w0 = *(const f32x4*)(p.conv_w + j * 1536 + ch), w1 = *(const f32x4*)(p.conv_w + j * 1536 + ch + 4);
            const u32x4 rw = raw[i][j];
            a[0] += w0[0] * bf_lo(rw.x); a[1] += w0[1] * bf_hi(rw.x); a[2] += w0[2] * bf_lo(rw.y); a[3] += w0[3] * bf_hi(rw.y);
            a[4] += w1[0] * bf_lo(rw.z); a[5] += w1[1] * bf_hi(rw.z); a[6] += w1[2] * bf_lo(rw.w); a[7] += w1[3] * bf_hi(rw.w);
        }
        float ss = 0.f;
#pragma unroll
        for (int e = 0; e < 8; ++e) { a[e] = silu_f(a[e]); ss += a[e] * a[e]; }
        float rn = 1.0f;
        if (part < 2) {
            ss += __shfl_xor(ss, 1); ss += __shfl_xor(ss, 2); ss += __shfl_xor(ss, 4); ss += __shfl_xor(ss, 8);
            rn = rsqrtf(ss + 1e-6f) * (part == 0 ? 0.08838834764831845f : 1.0f);
        }
#pragma unroll
        for (int e = 0; e < 8; ++e) av[i][e] = a[e] * rn;
    }
    __syncthreads();
#pragma unroll
    for (int i = 0; i < 6; ++i) {
        const int item = tid + 512 * i, g = item & 15, t = (item >> 4) & 63, part = i >> 1;
        const float* a = av[i];
        const float beta = sm[t], egc = sm[128 + t], ekd = sm[192 + t];
        if (part < 2) {
            u32x4 w; w.x = pk_bf16(a[0], a[1]); w.y = pk_bf16(a[2], a[3]); w.z = pk_bf16(a[4], a[5]); w.w = pk_bf16(a[6], a[7]);
            *(LAS u32x4*)(lds + (part == 0 ? G_QN : G_KN) + t * 272 + g * 16) = w;
            if (part == 0) {
                u32x2 lo, hi; lo.x = pk_bf16(a[0] * egc, a[1] * egc); lo.y = pk_bf16(a[2] * egc, a[3] * egc); hi.x = pk_bf16(a[4] * egc, a[5] * egc); hi.y = pk_bf16(a[6] * egc, a[7] * egc);
                bf16_t* qd = QD + t * 128 + 16 * (g >> 1) + 4 * (g & 1);
                *(u32x2*)qd = lo; *(u32x2*)(qd + 8) = hi;
            } else {
                const float f1 = beta * egc;
                u32x4 w2; w2.x = pk_bf16(a[0] * f1, a[1] * f1); w2.y = pk_bf16(a[2] * f1, a[3] * f1); w2.z = pk_bf16(a[4] * f1, a[5] * f1); w2.w = pk_bf16(a[6] * f1, a[7] * f1);
                *(LAS u32x4*)(lds + G_KBG + t * 272 + g * 16) = w2;
                u32x4 w3; w3.x = pk_bf16(a[0] * ekd, a[1] * ekd); w3.y = pk_bf16(a[2] * ekd, a[3] * ekd); w3.z = pk_bf16(a[4] * ekd, a[5] * ekd); w3.w = pk_bf16(a[6] * ekd, a[7] * ekd);
                *(u32x4*)(KD + t * 128 + g * 8) = w3;
            }
        } else {
            u32x4 w; w.x = pk_bf16(a[0] * beta, a[1] * beta); w.y = pk_bf16(a[2] * beta, a[3] * beta); w.z = pk_bf16(a[4] * beta, a[5] * beta); w.w = pk_bf16(a[6] * beta, a[7] * beta);
            *(LAS u32x4*)(lds + G_VB + t * 272 + g * 16) = w;
        }
    }
    __syncthreads();
    {
        const int w4 = wid & 3, mt = w4 >> 1, nt = w4 & 1; const bool isqk = wid >= 4;
        if (!(mt == 0 && nt == 1)) {
            const LAS unsigned char* Ab = lds + (isqk ? G_QN : G_KN) + (32 * mt + r) * 272 + 16 * h2;
            const LAS unsigned char* Bb = lds + G_KN + (32 * nt + r) * 272 + 16 * h2;
            f32x16 X;
#pragma unroll
            for (int i = 0; i < 16; ++i) X[i] = 0.f;
#pragma unroll
            for (int ks = 0; ks < 8; ++ks) X = MFMA32(*(const LAS bf16x8*)(Ab + 32 * ks), *(const LAS bf16x8*)(Bb + 32 * ks), X);
            const int s = 32 * nt + r; const float gcs = sm[64 + s];
#pragma unroll
            for (int i = 0; i < 16; ++i) {
                const int c = 32 * mt + crow(i, h2);
                const float dec = __builtin_amdgcn_exp2f(sm[64 + c] - gcs);
                if (!isqk) Mf[c * 64 + s] = (c > s) ? sm[c] * X[i] * dec : 0.f;
                else AQ[c * 64 + perm23(s)] = bf16_1((c >= s) ? X[i] * dec : 0.f);
            }
        }
    }
    __syncthreads();
    if (wid == 0) {
        LAS bf16_t* Tb = (LAS bf16_t*)(lds + G_T);
        {
            const int c16 = lane & 15, b16 = lane >> 4;
            const LAS float* Mb = Mf + (16 * b16) * 64 + 16 * b16;
            float T[16];
#pragma unroll
            for (int i = 0; i < 16; ++i) T[i] = 0.f;
#pragma unroll
            for (int i = 0; i < 16; ++i) {
                float a0 = (i == c16) ? 1.f : 0.f, a1 = 0.f, a2 = 0.f, a3 = 0.f;
#pragma unroll
                for (int s4 = 0; s4 < (i + 3) / 4; ++s4) {
                    const f32x4 m4 = *(const LAS f32x4*)(Mb + i * 64 + 4 * s4);
                    a0 -= m4[0] * T[4 * s4]; a1 -= m4[1] * T[4 * s4 + 1]; a2 -= m4[2] * T[4 * s4 + 2]; a3 -= m4[3] * T[4 * s4 + 3];
                }
                T[i] = (a0 + a1) + (a2 + a3);
            }
#pragma unroll
            for (int i = 0; i < 16; ++i) {
                const int row = 16 * b16 + i;
                Tb[row * 72 + 16 * b16 + c16] = bf16_1(T[i]);
                if ((b16 & 1) == 0) Tb[row * 72 + 16 * b16 + 16 + c16] = 0;
                if (b16 < 2) { Tb[row * 72 + 32 + c16] = 0; Tb[row * 72 + 48 + c16] = 0; }
            }
        }
        __builtin_amdgcn_wave_barrier();
        asm volatile("s_waitcnt lgkmcnt(0)" ::: "memory");
        {
            const int qd = r >> 4, rr = r & 15;
            bf16x8 mfrag;
            { const LAS float* mp = Mf + (16 + 32 * qd + rr) * 64 + 32 * qd + 8 * h2;
              const f32x4 m0 = *(const LAS f32x4*)mp, m1 = *(const LAS f32x4*)(mp + 4);
              u32x4 aw; aw.x = pk_bf16(m0[0], m0[1]); aw.y = pk_bf16(m0[2], m0[3]); aw.z = pk_bf16(m1[0], m1[1]); aw.w = pk_bf16(m1[2], m1[3]);
              mfrag = __builtin_bit_cast(bf16x8, aw); }
            bf16x8 tfrag;
#pragma unroll
            for (int j = 0; j < 8; ++j) tfrag[j] = (short)Tb[(32 * qd + 8 * h2 + j) * 72 + 32 * qd + rr];
            bf16x8 t2frag;
            { const LAS unsigned char* tp = lds + G_T + (16 + 32 * qd + rr) * 144 + (16 + 32 * qd + 4 * h2) * 2;
              const u32x2 lo = *(const LAS u32x2*)tp, hi = *(const LAS u32x2*)(tp + 16);
              u32x4 aw; aw.x = lo.x; aw.y = lo.y; aw.z = hi.x; aw.w = hi.y; t2frag = __builtin_bit_cast(bf16x8, aw); }
            const bf16x8 zf = {0, 0, 0, 0, 0, 0, 0, 0};
            f32x16 Y1, Z1;
#pragma unroll
            for (int i = 0; i < 16; ++i) { Y1[i] = 0.f; Z1[i] = 0.f; }
#pragma unroll
            for (int ks = 0; ks < 2; ++ks) Y1 = MFMA32(qd == ks ? mfrag : zf, qd == ks ? tfrag : zf, Y1);
#pragma unroll
            for (int s2 = 0; s2 < 2; ++s2) Z1 = MFMA32(qd == s2 ? t2frag : zf, pack8(Y1, s2), Z1);
#pragma unroll
            for (int i = 0; i < 16; ++i) {
                const int row = crow(i, h2);
                if ((row >> 4) == qd) Tb[(16 + 32 * qd + (row & 15)) * 72 + 32 * qd + rr] = bf16_1(-Z1[i]);
            }
        }
        __builtin_amdgcn_wave_barrier();
        asm volatile("s_waitcnt lgkmcnt(0)" ::: "memory");
        const int i16 = lane & 15, q = i16 >> 2, pp = i16 & 3, blk = (lane >> 4) & 1;
        f32x16 Y;
#pragma unroll
        for (int i = 0; i < 16; ++i) Y[i] = 0.f;
#pragma unroll
        for (int ks = 0; ks < 2; ++ks) {
            const LAS float* mp = Mf + (32 + r) * 64 + 16 * ks + 8 * h2;
            const f32x4 m0 = *(const LAS f32x4*)mp, m1 = *(const LAS f32x4*)(mp + 4);
            u32x4 aw; aw.x = pk_bf16(m0[0], m0[1]); aw.y = pk_bf16(m0[2], m0[3]); aw.z = pk_bf16(m1[0], m1[1]); aw.w = pk_bf16(m1[2], m1[3]);
            const bf16x8 bfrag = tr_pair(lds + G_T + (16 * ks + 8 * h2 + q) * 144 + (16 * blk + 4 * pp) * 2, 4 * 144);
            Y = MFMA32(__builtin_bit_cast(bf16x8, aw), bfrag, Y);
        }
        f32x16 Z;
#pragma unroll
        for (int i = 0; i < 16; ++i) Z[i] = 0.f;
#pragma unroll
        for (int s = 0; s < 2; ++s) {
            const LAS unsigned char* tp = lds + G_T + (32 + r) * 144 + (32 + 16 * s + 4 * h2) * 2;
            const u32x2 lo = *(const LAS u32x2*)tp, hi = *(const LAS u32x2*)(tp + 16);
            u32x4 aw; aw.x = lo.x; aw.y = lo.y; aw.z = hi.x; aw.w = hi.y;
            Z = MFMA32(__builtin_bit_cast(bf16x8, aw), pack8(Y, s), Z);
        }
#pragma unroll
        for (int i = 0; i < 16; ++i) Tb[(32 + crow(i, h2)) * 72 + r] = bf16_1(-Z[i]);
    } else if (wid == 1) {
        if (c2next < 2048) gdn_gates(p, (LAS float*)(lds + G_SM + (par ^ 1) * 1024), c2next, lane);
    }
    __syncthreads();
    {
        const int mt = wid >> 2, nt = wid & 3;
        const int i16 = lane & 15, q = i16 >> 2, pp = i16 & 3, blk = (lane >> 4) & 1;
        f32x16 Xu, Xw;
#pragma unroll
        for (int i = 0; i < 16; ++i) { Xu[i] = 0.f; Xw[i] = 0.f; }
#pragma unroll
        for (int ks = 0; ks < 4; ++ks) {
            if (ks < 2 * (mt + 1)) {
                const bf16x8 af = *(const LAS bf16x8*)(lds + G_T + (32 * mt + r) * 144 + (16 * ks + 8 * h2) * 2);
                const int boff = (16 * ks + 8 * h2 + q) * 272 + (32 * nt + 16 * blk + 4 * pp) * 2;
                Xu = MFMA32(af, tr_pair(lds + G_VB + boff, 4 * 272), Xu);
                Xw = MFMA32(af, tr_pair(lds + G_KBG + boff, 4 * 272), Xw);
            }
        }
        const int d = 32 * nt + r, dp = perm23(d);
        {
            float* up = U + ((nt * 2 + mt) * 64 + lane) * 16;
#pragma unroll
            for (int k = 0; k < 4; ++k) { const f32x4 v = {Xu[4 * k], Xu[4 * k + 1], Xu[4 * k + 2], Xu[4 * k + 3]}; *(f32x4*)(up + 4 * k) = v; }
        }
#pragma unroll
        for (int i = 0; i < 16; ++i) {
            const int c = 32 * mt + crow(i, h2);
            WN[c * 128 + dp] = bf16_1(-Xw[i]);
        }
    }
    __syncthreads();
}

constexpr int S_WN = 0, S_QD = 17408, S_KD = 34816, S_AQ = 52224, S_BUF = 61440, S_STG = 2 * S_BUF;

struct GateIn { u32x4 z0, z1; };
DI void scan_gate_load(const Params& p, int tid, int b, int hh, int n, GateIn& g) {
    const int gc_ = tid >> 3, seg = tid & 7;
    const bf16_t* P1 = (const bf16_t*)(p.ws + OFF_P1);
    const size_t row = (size_t)b * SEQ + n * 64 + gc_;
    g.z0 = *(const u32x4*)(P1 + row * NP1 + C_GZ + hh * 128 + seg * 16); g.z1 = *(const u32x4*)(P1 + row * NP1 + C_GZ + hh * 128 + seg * 16 + 8);
}
DI void scan_gate(const Params& p, LAS unsigned char* lds, int tid, int b, int hh, int n, const GateIn& g) {
    const int gc_ = tid >> 3, seg = tid & 7;
    bf16_t* mix = (bf16_t*)(p.ws + OFF_HB);
    const LAS float* st = (const LAS float*)(lds + S_STG) + gc_ * 132 + seg * 16;
    f32x4 ov[4]; float ss = 0.f;
#pragma unroll
    for (int k = 0; k < 4; ++k) { ov[k] = *(const LAS f32x4*)(st + 4 * k); ss += ov[k][0] * ov[k][0] + ov[k][1] * ov[k][1] + ov[k][2] * ov[k][2] + ov[k][3] * ov[k][3]; }
    ss += __shfl_xor(ss, 1); ss += __shfl_xor(ss, 2); ss += __shfl_xor(ss, 4);
    const float rstd = rsqrtf(ss * (1.0f / 128.0f) + EPS);
    const size_t row = (size_t)b * SEQ + n * 64 + gc_;
    const u32x4 z0 = g.z0, z1 = g.z1;
    f32x4 gnw[4];
#pragma unroll
    for (int k = 0; k < 4; ++k) gnw[k] = *(const f32x4*)(p.gdn_norm_w + seg * 16 + 4 * k);
    u32x4 w0, w1;
    w0.x = pk_bf16(ov[0][0] * rstd * gnw[0][0] * silu_f(bf_lo(z0.x)), ov[0][1] * rstd * gnw[0][1] * silu_f(bf_hi(z0.x)));
    w0.y = pk_bf16(ov[0][2] * rstd * gnw[0][2] * silu_f(bf_lo(z0.y)), ov[0][3] * rstd * gnw[0][3] * silu_f(bf_hi(z0.y)));
    w0.z = pk_bf16(ov[1][0] * rstd * gnw[1][0] * silu_f(bf_lo(z0.z)), ov[1][1] * rstd * gnw[1][1] * silu_f(bf_hi(z0.z)));
    w0.w = pk_bf16(ov[1][2] * rstd * gnw[1][2] * silu_f(bf_lo(z0.w)), ov[1][3] * rstd * gnw[1][3] * silu_f(bf_hi(z0.w)));
    w1.x = pk_bf16(ov[2][0] * rstd * gnw[2][0] * silu_f(bf_lo(z1.x)), ov[2][1] * rstd * gnw[2][1] * silu_f(bf_hi(z1.x)));
    w1.y = pk_bf16(ov[2][2] * rstd * gnw[2][2] * silu_f(bf_lo(z1.y)), ov[2][3] * rstd * gnw[2][3] * silu_f(bf_hi(z1.y)));
    w1.z = pk_bf16(ov[3][0] * rstd * gnw[3][0] * silu_f(bf_lo(z1.z)), ov[3][1] * rstd * gnw[3][1] * silu_f(bf_hi(z1.z)));
    w1.w = pk_bf16(ov[3][2] * rstd * gnw[3][2] * silu_f(bf_lo(z1.w)), ov[3][3] * rstd * gnw[3][3] * silu_f(bf_hi(z1.w)));
    bf16_t* mp = mix + row * DM + hh * 128 + seg * 16;
    *(u32x4*)mp = w0; *(u32x4*)(mp + 8) = w1;
}

struct ScanRegs { u32x4 t0[4], t1[4], t2[4], t3[2]; };
DI void scan_fetch(ScanRegs& R, const bf16_t* WN, const bf16_t* QD, const bf16_t* KD, const bf16_t* AQ, int ltid) {
#pragma unroll
    for (int i = 0; i < 4; ++i) { const int pi = ltid + 256 * i; R.t0[i] = *(const u32x4*)(WN + pi * 8); R.t1[i] = *(const u32x4*)(QD + pi * 8); R.t2[i] = *(const u32x4*)(KD + pi * 8); }
#pragma unroll
    for (int i = 0; i < 2; ++i) { const int pi = ltid + 256 * i; R.t3[i] = *(const u32x4*)(AQ + pi * 8); }
}
DI void scan_put(const ScanRegs& R, LAS unsigned char* dst, int ltid) {
#pragma unroll
    for (int i = 0; i < 4; ++i) { const int pi = ltid + 256 * i, row = pi >> 4, pc = pi & 15;
        *(LAS u32x4*)(dst + S_WN + row * 272 + pc * 16) = R.t0[i]; *(LAS u32x4*)(dst + S_QD + row * 272 + pc * 16) = R.t1[i]; *(LAS u32x4*)(dst + S_KD + row * 272 + pc * 16) = R.t2[i]; }
#pragma unroll
    for (int i = 0; i < 2; ++i) { const int pi = ltid + 256 * i, row = pi >> 3, pc = pi & 7; *(LAS u32x4*)(dst + S_AQ + row * 144 + pc * 16) = R.t3[i]; }
}

DI void gdn_scan(const Params& p, LAS unsigned char* lds, int bh) {
    int tid = threadIdx.x; asm volatile("" : "+v"(tid));
    const int lane = tid & 63, wid = __builtin_amdgcn_readfirstlane(tid >> 6), r = lane & 31, h2 = lane >> 5;
    const int b = bh >> 2, hh = bh & 3;
    const bf16_t* WN = (const bf16_t*)(p.ws + OFF_WN) + (size_t)bh * 32 * 8192;
    const bf16_t* QD = (const bf16_t*)(p.ws + OFF_QD) + (size_t)bh * 32 * 8192;
    const bf16_t* KD = (const bf16_t*)(p.ws + OFF_KD) + (size_t)bh * 32 * 8192;
    const bf16_t* AQ = (const bf16_t*)(p.ws + OFF_AQK) + (size_t)bh * 32 * 4096;
    const float* U = (const float*)(p.ws + OFF_U) + (size_t)bh * 32 * 8192;
    const float* GL = (const float*)(p.ws + OFF_GL) + bh * 32;
    if (wid >= 4) {
        const int ltid = tid & 255;
        ScanRegs R;
        scan_fetch(R, WN, QD, KD, AQ, ltid); scan_put(R, lds, ltid);
        scan_fetch(R, WN + 8192, QD + 8192, KD + 8192, AQ + 4096, ltid);
#pragma unroll 1
        for (int n = 0; n < 32; ++n) {
            __syncthreads();
            GateIn gi; scan_gate_load(p, tid, b, hh, n, gi);
            if (n + 1 < 32) scan_put(R, lds + ((n + 1) & 1) * S_BUF, ltid);
            if (n + 2 < 32) scan_fetch(R, WN + (size_t)(n + 2) * 8192, QD + (size_t)(n + 2) * 8192, KD + (size_t)(n + 2) * 8192, AQ + (size_t)(n + 2) * 4096, ltid);
            __syncthreads();
            scan_gate(p, lds, tid, b, hh, n, gi);
        }
    } else {
        const int i16 = lane & 15, q4 = i16 >> 2, pp = i16 & 3, blk = (lane >> 4) & 1;
        f32x16 St[4], u[2];
#pragma unroll
        for (int k = 0; k < 4; ++k)
#pragma unroll
            for (int i = 0; i < 16; ++i) St[k][i] = 0.f;
#pragma unroll
        for (int mt = 0; mt < 2; ++mt)
#pragma unroll
            for (int k = 0; k < 4; ++k) { const f32x4 v = *(const f32x4*)(U + ((wid * 2 + mt) * 64 + lane) * 16 + 4 * k); u[mt][4 * k] = v[0]; u[mt][4 * k + 1] = v[1]; u[mt][4 * k + 2] = v[2]; u[mt][4 * k + 3] = v[3]; }
#pragma unroll 1
        for (int n = 0; n < 32; ++n) {
            LAS unsigned char* buf = lds + (n & 1) * S_BUF;
            __syncthreads();
            GateIn gi; scan_gate_load(p, tid, b, hh, n, gi);
            const float egl = GL[n];
            f32x16 vn[2], o[2];
            vn[0] = u[0]; vn[1] = u[1];
#pragma unroll
            for (int mt = 0; mt < 2; ++mt)
#pragma unroll
                for (int i = 0; i < 16; ++i) o[mt][i] = 0.f;
#pragma unroll
            for (int ks = 0; ks < 8; ++ks) {
                const bf16x8 sf = pack8(St[ks >> 1], ks & 1);
#pragma unroll
                for (int mt = 0; mt < 2; ++mt) {
                    const bf16x8 wf = *(const LAS bf16x8*)(buf + S_WN + (32 * mt + r) * 272 + (16 * ks + 8 * h2) * 2);
                    vn[mt] = MFMA32(wf, sf, vn[mt]);
                    const bf16x8 qf = *(const LAS bf16x8*)(buf + S_QD + (32 * mt + r) * 272 + (16 * ks + 8 * h2) * 2);
                    o[mt] = MFMA32(qf, sf, o[mt]);
                }
                asm volatile("" ::: "memory");
            }
            bf16x8 vf[4];
#pragma unroll
            for (int k2 = 0; k2 < 4; ++k2) vf[k2] = pack8(vn[k2 >> 1], k2 & 1);
            {
                const int nn = (n + 1 < 32) ? n + 1 : n;
                const float* up = U + (size_t)nn * 8192 + ((wid * 2) * 64 + lane) * 16;
#pragma unroll
                for (int mt = 0; mt < 2; ++mt)
#pragma unroll
                    for (int k = 0; k < 4; ++k) { const f32x4 v = *(const f32x4*)(up + mt * 1024 + 4 * k); u[mt][4 * k] = v[0]; u[mt][4 * k + 1] = v[1]; u[mt][4 * k + 2] = v[2]; u[mt][4 * k + 3] = v[3]; }
            }
#pragma unroll
            for (int mt = 0; mt < 2; ++mt)
#pragma unroll
                for (int k2 = 0; k2 < 2 * (mt + 1); ++k2) {
                    const bf16x8 af = *(const LAS bf16x8*)(buf + S_AQ + (32 * mt + r) * 144 + (16 * k2 + 8 * h2) * 2);
                    o[mt] = MFMA32(af, vf[k2], o[mt]);
                }
            {
                LAS float* st = (LAS float*)(lds + S_STG);
#pragma unroll
                for (int mt = 0; mt < 2; ++mt)
#pragma unroll
                    for (int i = 0; i < 16; ++i) st[(32 * mt + crow(i, h2)) * 132 + 32 * wid + r] = o[mt][i];
            }
#pragma unroll
            for (int kt = 0; kt < 4; ++kt) {
#pragma unroll
                for (int i = 0; i < 16; ++i) St[kt][i] *= egl;
#pragma unroll
                for (int k2 = 0; k2 < 4; ++k2) {
                    const bf16x8 kf = tr_pair(buf + S_KD + (16 * k2 + 4 * h2 + q4) * 272 + (32 * kt + 16 * blk + 4 * pp) * 2, 8 * 272);
                    St[kt] = MFMA32(kf, vf[k2], St[kt]);
                }
                asm volatile("" ::: "memory");
            }
            __syncthreads();
            scan_gate(p, lds, tid, b, hh, n, gi);
        }
    }
    __syncthreads();
}

DI void zero_mix_half(const Params& p, int half) {
    bf16_t* mix = (bf16_t*)(p.ws + OFF_HB);
    const size_t n16 = (size_t)MTOK * 64;
    for (size_t i = (size_t)blockIdx.x * 512 + threadIdx.x; i < n16; i += (size_t)gridDim.x * 512) {
        const size_t row = i >> 6, pc = i & 63;
        *(u32x4*)(mix + row * DM + half * 512 + pc * 8) = (u32x4){0u, 0u, 0u, 0u};
    }
}

DI void phase_final(const Params& p) {
    int tid = threadIdx.x; asm volatile("" : "+v"(tid));
    const int lane = tid & 63, wid = tid >> 6;
    const float* rowsq = (const float*)(p.ws + OFF_ROWSQ);
    const bf16_t* yb = (const bf16_t*)(p.ws + OFF_YB);
    const int gw = blockIdx.x * 8 + wid, nw = gridDim.x * 8;
    f32x4 fw[4];
#pragma unroll
    for (int i = 0; i < 2; ++i) { fw[2 * i] = *(const f32x4*)(p.final_norm_w + 512 * i + 8 * lane); fw[2 * i + 1] = *(const f32x4*)(p.final_norm_w + 512 * i + 8 * lane + 4); }
#pragma unroll 1
    for (int row0 = gw; row0 < MTOK; row0 += 4 * nw) {
        u32x4 y[4][2]; float sq[4];
#pragma unroll
        for (int k = 0; k < 4; ++k) {
            const int row = row0 + k * nw, rc = row < MTOK ? row : row0;
#pragma unroll
            for (int i = 0; i < 2; ++i) y[k][i] = *(const u32x4*)(yb + (size_t)rc * DM + 512 * i + 8 * lane);
            sq[k] = lane < 16 ? rowsq[(size_t)rc * 16 + lane] : 0.f;
        }
#pragma unroll
        for (int k = 0; k < 4; ++k) {
            const int row = row0 + k * nw;
            const float ss = wave_sum(sq[k]);
            const float rstd = rsqrtf(ss * (1.0f / DM) + EPS);
            if (row < MTOK) {
                float* o = p.out + (size_t)row * DM;
#pragma unroll
                for (int i = 0; i < 2; ++i) {
                    const f32x4 a = {bf_lo(y[k][i].x), bf_hi(y[k][i].x), bf_lo(y[k][i].y), bf_hi(y[k][i].y)}, c = {bf_lo(y[k][i].z), bf_hi(y[k][i].z), bf_lo(y[k][i].w), bf_hi(y[k][i].w)};
                    *(f32x4*)(o + 512 * i + 8 * lane) = a * rstd * fw[2 * i];
                    *(f32x4*)(o + 512 * i + 8 * lane + 4) = c * rstd * fw[2 * i + 1];
                }
            }
        }
    }
}

__global__ void __launch_bounds__(512) mega(Params p) {
    extern __shared__ __attribute__((aligned(16))) unsigned char shm[];
    LAS unsigned char* lds = (LAS unsigned char*)shm;
    cg::grid_group grid = cg::this_grid();
    volatile LAS unsigned* bst = (volatile LAS unsigned*)(lds + LDS_BYTES - 16);
    if (threadIdx.x < 2) bst[threadIdx.x] = 0u;
    __syncthreads();
    const XcdBarrier xb = xcd_barrier_post((unsigned*)(p.ws + OFF_BAR), bst);
    if (p.ws == nullptr) grid.sync();

#pragma unroll 1
    for (int rep = 0; rep < REP_PREP; ++rep) phase_prep(p, lds);
    xcd_barrier(xb);
#pragma unroll 1
    for (int rep = 0; rep < REP_G1; ++rep)
    {
        pg8::Gemm g{(const bf16_t*)(p.ws + OFF_HB), (const bf16_t*)(p.ws + OFF_WINT), MTOK, NG1, DM};
        pg8::StaticOrder S; S.init(g.M, g.N, (int)gridDim.x, (int)blockIdx.x);
        pg8::EpiP1 E{(bf16_t*)(p.ws + OFF_P1), NP1, (bf16_t*)(p.ws + OFF_KX)};
        pg8::gemm_phase<pg8::EpiP1, false>(lds, g, S, E);
        pg8::Gemm g2{(const bf16_t*)(p.ws + OFF_HB), (const bf16_t*)(p.ws + OFF_WINT) + (size_t)NG1 * DM, MTOK, 512, DM};
        pg8::StaticOrder S2; S2.init(g2.M, g2.N, (int)gridDim.x, (int)blockIdx.x);
        pg8::EpiVT E2{(bf16_t*)(p.ws + OFF_VT)};
        pg8::gemm_phase<pg8::EpiVT, true>(lds, g2, S2, E2);
    }
    xcd_barrier(xb);
#pragma unroll 1
    for (int rep = 0; rep < REP_GP; ++rep)
    {
        if ((threadIdx.x >> 6) == 0 && (int)blockIdx.x < 2048) gdn_gates(p, (LAS float*)(lds + G_SM), blockIdx.x, threadIdx.x & 63);
        int par = 0;
#pragma unroll 1
        for (int c2 = blockIdx.x; c2 < 2048; c2 += gridDim.x, par ^= 1) gdn_prep(p, lds, c2, c2 + (int)gridDim.x, par);
    }
    xcd_barrier(xb);
#pragma unroll 1
    for (int rep = 0; rep < REP_P3; ++rep) {
#pragma unroll 1
        for (int r2 = 0; r2 < REP_SCAN; ++r2)
            if (blockIdx.x < 64) gdn_scan(p, lds, blockIdx.x);
#if SCAN_SYNC
        xcd_barrier(xb);
#endif
        phase_attn(p, lds, rep);
#if REP_ATTN > 1
        xcd_barrier(xb);
        phase_attn(p, lds, 2);
#endif
#if REP_P3 > 1
        xcd_barrier(xb);
#endif
    }
    xcd_barrier(xb);
#pragma unroll 1
    for (int rnd = 0; rnd < 2; ++rnd) {
        pg8::Gemm g{(const bf16_t*)(p.ws + OFF_HB), (const bf16_t*)(p.ws + OFF_WOUTT), MTOK, DM, DM};
        pg8::StaticOrder S; S.init(g.M, g.N, (int)gridDim.x, (int)blockIdx.x); S.i0 = rnd; S.imax = 1;
        pg8::EpiOutFused E{p.x, p.out, (float*)(p.ws + OFF_ROWSQ), p.final_norm_w, xb};
        pg8::Unit u0;
        if (S.next(0, u0)) pg8::gemm_phase<pg8::EpiOutFused, false>(lds, g, S, E);
        else xcd_barrier(xb);
    }
}

extern "C" void kernel_launch(void* const* d_in, const int* in_sizes, int n_in, void* d_out, int out_size, void* d_ws, size_t ws_size, hipStream_t stream) {
    static int grid = 0;
    if (grid == 0) {
        if (ws_size < WS_END) { fprintf(stderr, "kernel_launch: workspace too small (%zu < %zu)\n", ws_size, (size_t)WS_END); grid = -1; return; }
        int dev = 0, cus = 0, per_cu = 0;
        hipGetDevice(&dev);
        hipDeviceGetAttribute(&cus, hipDeviceAttributeMultiprocessorCount, dev);
        if (hipFuncSetAttribute((const void*)mega, hipFuncAttributeMaxDynamicSharedMemorySize, LDS_BYTES) != hipSuccess) { fprintf(stderr, "kernel_launch: hipFuncSetAttribute failed\n"); grid = -1; return; }
        if (hipOccupancyMaxActiveBlocksPerMultiprocessor(&per_cu, (const void*)mega, 512, LDS_BYTES) != hipSuccess || per_cu < 1) per_cu = 1;
        (void)hipGetLastError();
        grid = cus * (per_cu > 1 ? 1 : per_cu);
    }
    if (grid < 0) return;
    Params p{};
    p.x = (const float*)d_in[0]; p.norm_w = (const float*)d_in[1]; p.w_in = (const float*)d_in[2]; p.conv_w = (const float*)d_in[3];
    p.a_log = (const float*)d_in[4]; p.dt_bias = (const float*)d_in[5]; p.gdn_norm_w = (const float*)d_in[6];
    p.lq1 = (const float*)d_in[7]; p.lk1 = (const float*)d_in[8]; p.lq2 = (const float*)d_in[9]; p.lk2 = (const float*)d_in[10];
    p.diff_norm_w = (const float*)d_in[11]; p.w_out = (const float*)d_in[12]; p.final_norm_w = (const float*)d_in[13];
    p.out = (float*)d_out; p.ws = (unsigned char*)d_ws;
    if (hipMemsetAsync((unsigned char*)d_ws + OFF_BAR, 0, 16384, stream) != hipSuccess) { fprintf(stderr, "kernel_launch: hipMemsetAsync failed\n"); return; }
    void* args[] = {&p};
    hipError_t e = hipLaunchCooperativeKernel((const void*)mega, dim3(grid), dim3(512), args, LDS_BYTES, stream);
    if (e != hipSuccess) fprintf(stderr, "cooperative launch failed: %s (grid %d)\n", hipGetErrorString(e), grid);
}
```

```cpp
#include <hip/hip_runtime.h>
#include <hip/hip_cooperative_groups.h>
#include <cstdio>
namespace cg = cooperative_groups;

#ifndef ENABLE_ATTN
#define ENABLE_ATTN 1
#endif
#ifndef ENABLE_GDN
#define ENABLE_GDN 1
#endif
#ifndef REP_PREP
#define REP_PREP 1
#endif
#ifndef REP_G1
#define REP_G1 1
#endif
#ifndef REP_GP
#define REP_GP 1
#endif
#ifndef REP_P3
#define REP_P3 1
#endif
#ifndef REP_G2
#define REP_G2 1
#endif
#ifndef REP_SCAN
#define REP_SCAN 1
#endif
#ifndef SCAN_SYNC
#define SCAN_SYNC 0
#endif
#ifndef REP_ATTN
#define REP_ATTN 1
#endif

#define LAS __attribute__((address_space(3)))
#define DI __device__ __forceinline__
typedef unsigned short bf16_t;
typedef short bf16x8 __attribute__((ext_vector_type(8)));
typedef short s16x4 __attribute__((ext_vector_type(4)));
typedef float f32x2 __attribute__((ext_vector_type(2)));
typedef float f32x4 __attribute__((ext_vector_type(4)));
typedef float f32x16 __attribute__((ext_vector_type(16)));
typedef unsigned u32x2 __attribute__((ext_vector_type(2)));
typedef unsigned u32x4 __attribute__((ext_vector_type(4)));
typedef __bf16 bf16x2_t __attribute__((ext_vector_type(2)));

#define MFMA32(a, b, c) __builtin_amdgcn_mfma_f32_32x32x16_bf16((a), (b), (c), 0, 0, 0)

constexpr int NB = 16, SEQ = 2048, DM = 1024, MTOK = NB * SEQ, NP1 = 3072, NG1 = 3584;
constexpr int C_GQ = 0, C_GK = 512, C_GV = 1024, C_GZ = 1536, C_DQ = 2048, C_DZ = 2560;
constexpr float EPS = 1e-6f;
constexpr float LOG2E = 1.4426950408889634f;

constexpr size_t OFF_HB = 0;
constexpr size_t OFF_WINT = OFF_HB + (size_t)MTOK * DM * 2;
constexpr size_t OFF_WOUTT = OFF_WINT + (size_t)4096 * 1024 * 2;
constexpr size_t OFF_GBGA = OFF_WOUTT + (size_t)1024 * 1024 * 2;
constexpr size_t OFF_P1 = OFF_GBGA + (size_t)MTOK * 8 * 4;
constexpr size_t OFF_KX = OFF_P1 + (size_t)MTOK * NP1 * 2;
constexpr size_t OFF_VT = OFF_KX + (size_t)64 * 2 * 2048 * 64 * 2;
constexpr size_t OFF_WN = OFF_VT + (size_t)64 * 128 * 2048 * 2;
constexpr size_t OFF_QD = OFF_WN + (size_t)2048 * 64 * 128 * 2;
constexpr size_t OFF_KD = OFF_QD + (size_t)2048 * 64 * 128 * 2;
constexpr size_t OFF_AQK = OFF_KD + (size_t)2048 * 64 * 128 * 2;
constexpr size_t OFF_U = OFF_AQK + (size_t)2048 * 64 * 64 * 2;
constexpr size_t OFF_GL = OFF_U + (size_t)2048 * 64 * 128 * 4;
constexpr size_t OFF_ROWSQ = OFF_GL + 8192;
constexpr size_t OFF_MISC = OFF_ROWSQ + (size_t)MTOK * 16 * 4;
constexpr size_t OFF_YB = OFF_P1;
constexpr size_t OFF_BAR = OFF_MISC + 256;
constexpr size_t WS_END = OFF_BAR + 16384;

constexpr int LDS_BYTES = 156 * 1024;

struct Params {
    const float *x, *norm_w, *w_in, *conv_w, *a_log, *dt_bias, *gdn_norm_w, *lq1, *lk1, *lq2, *lk2, *diff_norm_w, *w_out, *final_norm_w;
    float* out; unsigned char* ws;
};

DI unsigned pk_bf16(float a, float b) { f32x2 v = {a, b}; bf16x2_t r = __builtin_convertvector(v, bf16x2_t); return __builtin_bit_cast(unsigned, r); }
DI float bf_lo(unsigned u) { return __uint_as_float(u << 16); }
DI float bf_hi(unsigned u) { return __uint_as_float(u & 0xffff0000u); }
DI float wave_sum(float v) {
#pragma unroll
    for (int o = 32; o; o >>= 1) v += __shfl_xor(v, o);
    return v;
}
DI float silu_f(float z) { return z * __builtin_amdgcn_rcpf(1.0f + __builtin_amdgcn_exp2f(-LOG2E * z)); }
DI int perm23(int t) { return (t & ~12) | ((t & 4) << 1) | ((t & 8) >> 1); }
DI int crow(int i, int h2) { return (i & 3) + 8 * (i >> 2) + 4 * h2; }
DI bf16x8 pack8(const f32x16& x, int s) {
    u32x4 w; w.x = pk_bf16(x[8 * s + 0], x[8 * s + 1]); w.y = pk_bf16(x[8 * s + 2], x[8 * s + 3]); w.z = pk_bf16(x[8 * s + 4], x[8 * s + 5]); w.w = pk_bf16(x[8 * s + 6], x[8 * s + 7]);
    return __builtin_bit_cast(bf16x8, w);
}


#define XB_TMO      128
#define XB_XCNT(j)  (256  + 64 * (j))
#define XB_XSUB(j)  (1280 + 64 * (j))
#define XB_XGEN(j)  (2304 + 64 * (j))
#define XB_TOP      3328
#define XB_TOPGEN   3392
#define XCD_BAR_WORDS 3456
#define XB_SPIN_CAP (1u << 18)
struct XcdBarrier { unsigned* bar; unsigned x; volatile LAS unsigned* st; };
DI unsigned xb_ld(unsigned* p)              { return __hip_atomic_load(p, __ATOMIC_RELAXED, __HIP_MEMORY_SCOPE_AGENT); }
DI unsigned xb_add(unsigned* p, unsigned v) { return __hip_atomic_fetch_add(p, v, __ATOMIC_RELAXED, __HIP_MEMORY_SCOPE_AGENT); }
DI unsigned xb_xcc_id() { return (unsigned)__builtin_amdgcn_s_getreg((3 << 11) | 20) & 0xFu; }
#define XB_SPIN(cond, bar) do { unsigned _sp = 0; while (cond) { __builtin_amdgcn_s_sleep(1); \
    if ((++_sp & 255u) == 0u) { if (xb_ld(&(bar)[XB_TMO])) break; if (_sp > XB_SPIN_CAP) { atomicAdd(&(bar)[XB_TMO], 1u); break; } } } } while (0)
DI XcdBarrier xcd_barrier_post(unsigned* bar, volatile LAS unsigned* st) {
    XcdBarrier b; b.bar = bar; b.x = xb_xcc_id(); b.st = st;
    if (threadIdx.x == 0) (void)xb_add(&bar[XB_XCNT(b.x)], 1u);
    return b;
}
DI void xcd_barrier_complete(unsigned* bar, unsigned x, unsigned& nloc, unsigned& nx) {
    const unsigned G = gridDim.x * gridDim.y * gridDim.z;
    unsigned sum, cnt, mine, sp = 0u;
    for (;;) {
        sum = 0u; cnt = 0u; mine = 0u;
#pragma unroll
        for (unsigned j = 0; j < 16; ++j) { const unsigned c = xb_ld(&bar[XB_XCNT(j)]); sum += c; cnt += (c > 0u) ? 1u : 0u; mine = (j == x) ? c : mine; }
        if (sum == G) break;
        __builtin_amdgcn_s_sleep(1);
        if ((++sp & 255u) == 0u) { if (xb_ld(&bar[XB_TMO])) break; if (sp > XB_SPIN_CAP) { atomicAdd(&bar[XB_TMO], 1u); break; } }
    }
    nloc = mine > 0u ? mine : 1u; nx = cnt > 0u ? cnt : 1u;
}
DI void xcd_barrier(const XcdBarrier& b) {
    asm volatile("s_waitcnt vmcnt(0)" ::: "memory");
    __syncthreads();
    if (threadIdx.x == 0) {
        unsigned* bar = b.bar;
        __builtin_amdgcn_s_waitcnt(0);
        unsigned nloc = b.st[0], nx = b.st[1];
        if (nloc == 0u) { xcd_barrier_complete(bar, b.x, nloc, nx); b.st[0] = nloc; b.st[1] = nx; }
        const unsigned old = xb_add(&bar[XB_XSUB(b.x)], 1u);
        const unsigned gen = old / nloc;
        if (old + 1u == (gen + 1u) * nloc) {
            __builtin_amdgcn_fence(__ATOMIC_RELEASE, "agent");
            asm volatile("s_waitcnt vmcnt(0)" ::: "memory");
            const unsigned og = xb_add(&bar[XB_TOP], 1u);
            const unsigned tg = og / nx;
            if (og + 1u == (tg + 1u) * nx) xb_add(&bar[XB_TOPGEN], 1u);
            else XB_SPIN(xb_ld(&bar[XB_TOPGEN]) == tg, bar);
            __builtin_amdgcn_fence(__ATOMIC_ACQUIRE, "agent");
            xb_add(&bar[XB_XGEN(b.x)], 1u);
            asm volatile("s_waitcnt vmcnt(0)" ::: "memory");
        } else {
            XB_SPIN(xb_ld(&bar[XB_XGEN(b.x)]) == gen, bar);
            __builtin_amdgcn_fence(__ATOMIC_ACQUIRE, "agent");
            asm volatile("s_waitcnt vmcnt(0)" ::: "memory");
        }
    }
    __syncthreads();
}

namespace pg8 {
constexpr int BM = 256, BK = 64, HALF = 128, HTB = HALF * BK * 2, STAGE_BYTES = 8 * HTB, NXCD = 8, WGM = 8;
DI int lds_byte(int r, int c) { const int st = (r >> 4) * 2 + (c >> 5), rr = r & 15, cc = c & 31, ob = rr * 64 + cc * 2; return st * 1024 + (ob ^ (((ob >> 9) & 1) << 5)); }
DI void stage_rc(int b, int& R, int& C) { const int st = b / 1024, sb = b % 1024, swz = sb ^ (((sb >> 9) & 1) << 5); R = (st >> 1) * 16 + swz / 64; C = (st & 1) * 32 + (swz % 64) / 2; }
DI int perm32(int rho) { const int n = rho >> 4, i = rho & 15; return 8 * (i >> 2) + 4 * n + (i & 3); }
struct Unit { int pm, pn; };
struct Gemm { const bf16_t* A; const bf16_t* Bt; int M, N, K; };
struct StaticOrder {
    int nM, nN, nwg, G, c, i0 = 0, imax = 1 << 30;
    DI void init(int M, int N, int G_, int c_) { nM = M / BM; nN = N / BM; nwg = nM * nN; G = G_; c = c_; }
    DI bool next(int i, Unit& u) const {
        if (i >= imax) return false;
        const long L = (long)(i + i0) * G + c; if (L >= nwg) return false;
        int wgid = (int)L; { const int q = nwg / NXCD, r = nwg % NXCD, xcd = wgid % NXCD, off = wgid / NXCD; wgid = (xcd < r ? xcd * (q + 1) : r * (q + 1) + (xcd - r) * q) + off; }
        const int nig = WGM * nN, gid = wgid / nig, fm = gid * WGM, gsz = (nM - fm) < WGM ? (nM - fm) : WGM;
        u.pm = fm + ((wgid % nig) % gsz); u.pn = (wgid % nig) / gsz; return true;
    }
    DI void a_ready(const Unit&) const {}
    DI void done(const Unit&) const {}
};

struct EpiP1 {
    static constexpr bool PERM = true, AFTER_DRAIN = false;
    bf16_t* O; int ldc; bf16_t* KX;
    DI void operator()(const f32x4 (&acc)[2][2][4][2], const Unit& u, int wr, int wc, int fr, int fq) const {
        const int row0 = u.pm * BM + wr * 64 + fr, col0 = u.pn * BM + wc * 32 + 8 * fq;
        if (u.pn >= 12) {
#pragma unroll
            for (int ai = 0; ai < 2; ++ai)
#pragma unroll
                for (int m = 0; m < 4; ++m) { const int row = row0 + ai * HALF + m * 16, b = row >> 11, tok = row & 2047;
#pragma unroll
                    for (int bj = 0; bj < 2; ++bj) { const f32x4 v0 = acc[ai][bj][m][0], v1 = acc[ai][bj][m][1];
                        const int c = col0 - 12 * BM + bj * HALF, hm = c >> 6, d = c & 63;
                        u32x4 w; w.x = pk_bf16(v0[0], v0[1]); w.y = pk_bf16(v0[2], v0[3]); w.z = pk_bf16(v1[0], v1[1]); w.w = pk_bf16(v1[2], v1[3]);
                        *(u32x4*)(KX + ((size_t)(b * 8 + hm) * 2048 + tok) * 64 + d) = w; } }
            return;
        }
#pragma unroll
        for (int ai = 0; ai < 2; ++ai)
#pragma unroll
            for (int m = 0; m < 4; ++m) { bf16_t* rowp = O + (size_t)(row0 + ai * HALF + m * 16) * ldc + col0;
#pragma unroll
                for (int bj = 0; bj < 2; ++bj) { const f32x4 v0 = acc[ai][bj][m][0], v1 = acc[ai][bj][m][1];
                    u32x4 w; w.x = pk_bf16(v0[0], v0[1]); w.y = pk_bf16(v0[2], v0[3]); w.z = pk_bf16(v1[0], v1[1]); w.w = pk_bf16(v1[2], v1[3]);
                    *(u32x4*)(rowp + bj * HALF) = w; } }
    }
};
struct EpiVT {
    static constexpr bool PERM = false, AFTER_DRAIN = false;
    bf16_t* VT;
    DI void operator()(const f32x4 (&acc)[2][2][4][2], const Unit& u, int wr, int wc, int fr, int fq) const {
#pragma unroll
        for (int ai = 0; ai < 2; ++ai)
#pragma unroll
            for (int m = 0; m < 4; ++m) {
                const int t = u.pm * BM + ai * HALF + wr * 64 + m * 16 + 4 * fq, b = t >> 11, tok = t & 2047, pos = perm23(tok);
#pragma unroll
                for (int bj = 0; bj < 2; ++bj)
#pragma unroll
                    for (int n = 0; n < 2; ++n) {
                        const int c = u.pn * BM + bj * HALF + wc * 32 + n * 16 + fr, hh = c >> 7, dv = c & 127;
                        const f32x4 v = acc[ai][bj][m][n];
                        u32x2 w; w.x = pk_bf16(v[0], v[1]); w.y = pk_bf16(v[2], v[3]);
                        *(u32x2*)(VT + (((size_t)((b * 4 + hh) * 32 + (pos >> 6)) * 128 + dv)) * 64 + (pos & 63)) = w;
                    }
            }
    }
};
static_assert(WGM == 8, "EpiOutFused needs the four column tiles of a row panel in the same round");
struct EpiOutFused {
    static constexpr bool PERM = false, AFTER_DRAIN = true;
    const float* X; float* Out; float* rowsq; const float* fw; XcdBarrier xb;
    DI void operator()(const f32x4 (&)[2][2][4][2], const Unit&, int, int, int, int) const {}
    DI void fused(f32x4 (&acc)[2][2][4][2], const Unit& u, int wr, int wc, int fr, int fq) const {
        const int row0 = u.pm * BM + wr * 64 + fr, col0 = u.pn * BM + wc * 32 + 4 * fq;
#pragma unroll
        for (int ai = 0; ai < 2; ++ai)
#pragma unroll
            for (int m = 0; m < 4; ++m) {
                const int row = row0 + ai * HALF + m * 16; float ss = 0.f;
#pragma unroll
                for (int bj = 0; bj < 2; ++bj)
#pragma unroll
                    for (int n = 0; n < 2; ++n) {
                        const size_t o = (size_t)row * DM + col0 + bj * HALF + n * 16;
                        const f32x4 y = acc[ai][bj][m][n] + *(const f32x4*)(X + o);
                        acc[ai][bj][m][n] = y; ss += y[0] * y[0] + y[1] * y[1] + y[2] * y[2] + y[3] * y[3];
                    }
                ss += __shfl_xor(ss, 16); ss += __shfl_xor(ss, 32);
                if (fq == 0) rowsq[(size_t)row * 16 + u.pn * 4 + wc] = ss;
            }
        xcd_barrier(xb);
        f32x4 fwv[2][2];
#pragma unroll
        for (int bj = 0; bj < 2; ++bj)
#pragma unroll
            for (int n = 0; n < 2; ++n) fwv[bj][n] = *(const f32x4*)(fw + col0 + bj * HALF + n * 16);
#pragma unroll
        for (int ai = 0; ai < 2; ++ai)
#pragma unroll
            for (int m = 0; m < 4; ++m) {
                const int row = row0 + ai * HALF + m * 16;
                const f32x4* rq = (const f32x4*)(rowsq + (size_t)row * 16);
                const f32x4 q0 = rq[0], q1 = rq[1], q2 = rq[2], q3 = rq[3];
                const float tot = ((q0[0] + q0[1]) + (q0[2] + q0[3])) + ((q1[0] + q1[1]) + (q1[2] + q1[3])) + ((q2[0] + q2[1]) + (q2[2] + q2[3])) + ((q3[0] + q3[1]) + (q3[2] + q3[3]));
                const float rstd = rsqrtf(tot * (1.0f / DM) + EPS);
#pragma unroll
                for (int bj = 0; bj < 2; ++bj)
#pragma unroll
                    for (int n = 0; n < 2; ++n) {
                        const size_t o = (size_t)row * DM + col0 + bj * HALF + n * 16;
                        *(f32x4*)(Out + o) = acc[ai][bj][m][n] * rstd * fwv[bj][n];
                    }
            }
    }
};

template <class Epi, bool SWAP>
DI void gemm_phase(LAS unsigned char* lds, const Gemm g, const StaticOrder& S, const Epi& E) {
    int tid = threadIdx.x; asm volatile("" : "+v"(tid));
    const int wid = __builtin_amdgcn_readfirstlane(tid >> 6), lane = tid & 63, wr = wid >> 2, wc = wid & 3, fr = lane & 15, fq = lane >> 4;
    const int K = g.K, nt = K / BK;
    unsigned voffA[2], voffB[2];
#pragma unroll
    for (int i = 0; i < 2; ++i) { int R, C; stage_rc(tid * 16 + i * 8192, R, C); const int Rb = Epi::PERM ? ((R & ~31) + perm32(R & 31)) : R;
        voffA[i] = (unsigned)(R * K + C) * 2u; voffB[i] = (unsigned)(Rb * K + C) * 2u; }
    const size_t kstep = (size_t)(BK * 2);
    const size_t hstep = (size_t)HALF * K * 2;
    const size_t tstep = 2 * hstep;
    const unsigned ldsw = (unsigned)wid * 1024u;
    const int aoff = lds_byte(wr * 64 + fr, fq * 8), boff = lds_byte(wc * 32 + fr, fq * 8);
#define PG8_SA(b, h) (((b) * 2 + (h)) * HTB)
#define PG8_SB(b, h) ((4 + (b) * 2 + (h)) * HTB)
#define PG8_STAGE(bufoff, gbase, voff) do { _Pragma("unroll") for (int _i = 0; _i < 2; ++_i) \
        __builtin_amdgcn_global_load_lds((const unsigned*)((const char*)(gbase) + (voff)[_i]), (LAS unsigned*)(lds + (bufoff) + ldsw + _i * 8192), 16, 0, 0); } while (0)
#define PG8_LDA(dst, b, h) do { _Pragma("unroll") for (int m = 0; m < 4; ++m) _Pragma("unroll") for (int k = 0; k < 2; ++k) dst[m][k] = *(const LAS bf16x8*)(lds + PG8_SA(b, h) + aoff + m * 2048 + k * 1024); } while (0)
#define PG8_LDB(dst, b, h) do { _Pragma("unroll") for (int n = 0; n < 2; ++n) _Pragma("unroll") for (int k = 0; k < 2; ++k) dst[n][k] = *(const LAS bf16x8*)(lds + PG8_SB(b, h) + boff + n * 2048 + k * 1024); } while (0)
#define PG8_MMA(ai, bj, At, Bt) do { __builtin_amdgcn_s_setprio(1); _Pragma("unroll") for (int m = 0; m < 4; ++m) _Pragma("unroll") for (int n = 0; n < 2; ++n) _Pragma("unroll") for (int k = 0; k < 2; ++k) \
        acc[ai][bj][m][n] = SWAP ? __builtin_amdgcn_mfma_f32_16x16x32_bf16(At[m][k], Bt[n][k], acc[ai][bj][m][n], 0, 0, 0) \
                                 : __builtin_amdgcn_mfma_f32_16x16x32_bf16(Bt[n][k], At[m][k], acc[ai][bj][m][n], 0, 0, 0); __builtin_amdgcn_s_setprio(0); } while (0)
#define PG8_WAIT_V(n) asm volatile("s_waitcnt vmcnt(" #n ")" ::: "memory")
#define PG8_WAIT_L(n) asm volatile("s_waitcnt lgkmcnt(" #n ")" ::: "memory")
#define PG8_BAR __builtin_amdgcn_s_barrier()
#define PG8_SCHED __builtin_amdgcn_sched_barrier(0)
    Unit cur, nxt; int ui = 0;
    if (!S.next(0, cur)) return;
    f32x4 acc[2][2][4][2];
#pragma unroll
    for (int a = 0; a < 2; ++a)
#pragma unroll
        for (int b = 0; b < 2; ++b)
#pragma unroll
            for (int m = 0; m < 4; ++m)
#pragma unroll
                for (int n = 0; n < 2; ++n) acc[a][b][m][n] = (f32x4){0.f, 0.f, 0.f, 0.f};
    bf16x8 At[4][2], B0[2][2], B1[2][2];
    const char* cA = (const char*)g.A + (size_t)cur.pm * tstep; const char* cB = (const char*)g.Bt + (size_t)cur.pn * tstep;
    PG8_STAGE(PG8_SB(0, 0), cB, voffB); PG8_STAGE(PG8_SA(0, 0), cA, voffA); PG8_STAGE(PG8_SB(0, 1), cB + hstep, voffB); PG8_STAGE(PG8_SA(0, 1), cA + hstep, voffA);
    if (wr == 1) PG8_BAR;
    PG8_WAIT_V(4); PG8_BAR;
    PG8_STAGE(PG8_SB(1, 0), cB + kstep, voffB); PG8_STAGE(PG8_SA(1, 0), cA + kstep, voffA); PG8_STAGE(PG8_SB(1, 1), cB + hstep + kstep, voffB);
    PG8_WAIT_V(6); PG8_BAR;
    for (;;) {
        const bool has_next = S.next(ui + 1, nxt);
        const char* nA = has_next ? (const char*)g.A + (size_t)nxt.pm * tstep : cA; const char* nB = has_next ? (const char*)g.Bt + (size_t)nxt.pn * tstep : cB;
        for (int t = 0; t < nt; t += 2) {
            const bool last = (t == nt - 2);
            const char* a1 = cA + (size_t)(t + 1) * kstep;
            const char* a2 = last ? nA : cA + (size_t)(t + 2) * kstep; const char* b2 = last ? nB : cB + (size_t)(t + 2) * kstep;
            const char* a3 = a2 + kstep; const char* b3 = b2 + kstep;
            PG8_LDB(B0, 0, 0); PG8_SCHED; PG8_LDA(At, 0, 0); PG8_STAGE(PG8_SA(1, 1), a1 + hstep, voffA);
            PG8_WAIT_L(8); PG8_BAR; PG8_WAIT_L(0); PG8_MMA(0, 0, At, B0); PG8_BAR; PG8_SCHED;
            PG8_LDB(B1, 0, 1); PG8_STAGE(PG8_SB(0, 0), b2, voffB);
            PG8_BAR; PG8_WAIT_L(0); PG8_MMA(0, 1, At, B1); PG8_BAR;
            PG8_LDA(At, 0, 1); PG8_STAGE(PG8_SA(0, 0), a2, voffA);
            PG8_BAR; PG8_WAIT_L(0); PG8_MMA(1, 0, At, B0); PG8_BAR; PG8_SCHED;
            PG8_STAGE(PG8_SB(0, 1), b2 + hstep, voffB);
            PG8_WAIT_V(6); PG8_BAR; PG8_MMA(1, 1, At, B1); PG8_BAR;
            PG8_LDB(B0, 1, 0); PG8_SCHED; PG8_LDA(At, 1, 0); PG8_STAGE(PG8_SA(0, 1), a2 + hstep, voffA);
            PG8_WAIT_L(8); PG8_BAR; PG8_WAIT_L(0); PG8_MMA(0, 0, At, B0); PG8_BAR; PG8_SCHED;
            PG8_LDB(B1, 1, 1); PG8_STAGE(PG8_SB(1, 0), b3, voffB);
            PG8_BAR; PG8_WAIT_L(0); PG8_MMA(0, 1, At, B1); PG8_BAR;
            PG8_LDA(At, 1, 1); PG8_STAGE(PG8_SA(1, 0), a3, voffA);
            PG8_BAR; PG8_WAIT_L(0); PG8_MMA(1, 0, At, B0); PG8_BAR; PG8_SCHED;
            PG8_STAGE(PG8_SB(1, 1), b3 + hstep, voffB);
            PG8_WAIT_V(6); PG8_BAR; PG8_MMA(1, 1, At, B1); PG8_BAR;
        }
        if constexpr (!Epi::AFTER_DRAIN) E(acc, cur, wr, wc, fr, fq);
        if (!has_next) break;
#pragma unroll
        for (int a = 0; a < 2; ++a)
#pragma unroll
            for (int b = 0; b < 2; ++b)
#pragma unroll
                for (int m = 0; m < 4; ++m)
#pragma unroll
                    for (int n = 0; n < 2; ++n) acc[a][b][m][n] = (f32x4){0.f, 0.f, 0.f, 0.f};
        cur = nxt; cA = nA; cB = nB; ++ui;
    }
    PG8_WAIT_V(0);
    if (wr == 0) PG8_BAR;
    PG8_BAR;
    if constexpr (Epi::AFTER_DRAIN) E.fused(acc, cur, wr, wc, fr, fq);
#undef PG8_SA
#undef PG8_SB
#undef PG8_STAGE
#undef PG8_LDA
#undef PG8_LDB
#undef PG8_MMA
#undef PG8_WAIT_V
#undef PG8_WAIT_L
#undef PG8_BAR
#undef PG8_SCHED
}
}

DI int win_src_col(int n0) {
    if (n0 < 2048) return n0;
    if (n0 < 2560) return 2056 + (n0 - 2048);
    if (n0 < 3072) return 3592 + (n0 - 2560);
    if (n0 < 3584) return 2568 + (n0 - 3072);
    return 3080 + (n0 - 3584);
}
DI void phase_prep(const Params& p, LAS unsigned char* lds) {
    int tid = threadIdx.x; asm volatile("" : "+v"(tid));
    const int lane = tid & 63, wid = tid >> 6;
    if (blockIdx.x == 0 && wid == 0) {
        float a = p.lq1[lane] * p.lk1[lane], b = p.lq2[lane] * p.lk2[lane];
        a = wave_sum(a); b = wave_sum(b);
        if (lane == 0) { *(float*)(p.ws + OFF_MISC) = expf(a) - expf(b) + 0.2f; *(unsigned*)(p.ws + OFF_MISC + 4) = 0u; *(unsigned*)(p.ws + OFF_MISC + 8) = 0u; *(unsigned*)(p.ws + OFF_MISC + 12) = 0u; }
    }
    bf16_t* hb = (bf16_t*)(p.ws + OFF_HB);
    float* gbga = (float*)(p.ws + OFF_GBGA);
    const int gw = blockIdx.x * 8 + wid, nw = gridDim.x * 8;
    {
        f32x4 nwv[4]; float wq[16][8];
#pragma unroll
        for (int i = 0; i < 4; ++i) {
            nwv[i] = ((const f32x4*)p.norm_w)[lane + 64 * i];
#pragma unroll
            for (int e = 0; e < 4; ++e) {
                const int k = 4 * (lane + 64 * i) + e;
                const f32x4* wp = (const f32x4*)(p.w_in + (size_t)k * 4104 + 2048);
                const f32x4 w0 = wp[0], w1 = wp[1];
#pragma unroll
                for (int j = 0; j < 4; ++j) { wq[4 * i + e][j] = nwv[i][e] * w0[j]; wq[4 * i + e][4 + j] = nwv[i][e] * w1[j]; }
            }
        }
        const bool b5 = (lane & 32) != 0, b4 = (lane & 16) != 0, b3 = (lane & 8) != 0;
        const int col = (b5 ? 4 : 0) + (b4 ? 2 : 0) + (b3 ? 1 : 0);
        int row = gw;
        f32x4 v[4];
        if (row < MTOK) {
#pragma unroll
            for (int i = 0; i < 4; ++i) v[i] = __builtin_nontemporal_load((const f32x4*)(p.x + (size_t)row * DM) + lane + 64 * i);
        }
#pragma unroll 1
        for (; row < MTOK; row += nw) {
            f32x4 vnx[4];
            const int rnx = (row + nw < MTOK) ? row + nw : row;
#pragma unroll
            for (int i = 0; i < 4; ++i) vnx[i] = __builtin_nontemporal_load((const f32x4*)(p.x + (size_t)rnx * DM) + lane + 64 * i);
            float ss = 0.f, a8[8];
#pragma unroll
            for (int j = 0; j < 8; ++j) a8[j] = 0.f;
#pragma unroll
            for (int i = 0; i < 4; ++i)
#pragma unroll
                for (int e = 0; e < 4; ++e) {
                    ss += v[i][e] * v[i][e];
#pragma unroll
                    for (int j = 0; j < 8; ++j) a8[j] += v[i][e] * wq[4 * i + e][j];
                }
            ss = wave_sum(ss);
            const float rstd = rsqrtf(ss * (1.0f / DM) + EPS);
#pragma unroll
            for (int i = 0; i < 4; ++i) {
                const f32x4 h = v[i] * rstd * nwv[i];
                u32x2 w; w.x = pk_bf16(h[0], h[1]); w.y = pk_bf16(h[2], h[3]);
                *(u32x2*)(hb + (size_t)row * DM + 4 * (lane + 64 * i)) = w;
            }
            float c4[4], c2[2], c1;
#pragma unroll
            for (int j = 0; j < 4; ++j) { const float send = b5 ? a8[j] : a8[4 + j], keep = b5 ? a8[4 + j] : a8[j]; c4[j] = keep + __shfl_xor(send, 32); }
#pragma unroll
            for (int j = 0; j < 2; ++j) { const float send = b4 ? c4[j] : c4[2 + j], keep = b4 ? c4[2 + j] : c4[j]; c2[j] = keep + __shfl_xor(send, 16); }
            { const float send = b3 ? c2[0] : c2[1], keep = b3 ? c2[1] : c2[0]; c1 = keep + __shfl_xor(send, 8); }
            c1 += __shfl_xor(c1, 4); c1 += __shfl_xor(c1, 2); c1 += __shfl_xor(c1, 1);
            if ((lane & 7) == 0) gbga[(size_t)row * 8 + col] = c1 * rstd;
#pragma unroll
            for (int i = 0; i < 4; ++i) v[i] = vnx[i];
        }
    }
    LAS float* tl = (LAS float*)lds;
    for (int tile = blockIdx.x; tile < 1024 + 256; tile += gridDim.x) {
        const float* src; int ld, n0, k0, srcn0; bf16_t* dst;
        if (tile < 1024) { n0 = (tile >> 4) * 64; k0 = (tile & 15) * 64; srcn0 = win_src_col(n0); src = p.w_in; ld = 4104; dst = (bf16_t*)(p.ws + OFF_WINT); }
        else { const int t2 = tile - 1024; n0 = (t2 >> 4) * 64; k0 = (t2 & 15) * 64; srcn0 = n0; src = p.w_out; ld = 1024; dst = (bf16_t*)(p.ws + OFF_WOUTT); }
        const int kk = tid >> 4, n4 = tid & 15;
#pragma unroll
        for (int ps = 0; ps < 2; ++ps) { const int k = kk + 32 * ps;
            const f32x4 v = *(const f32x4*)(src + (size_t)(k0 + k) * ld + srcn0 + 4 * n4);
#pragma unroll
            for (int e = 0; e < 4; ++e) tl[k * 65 + 4 * n4 + e] = v[e]; }
        __syncthreads();
        { const int n = tid >> 3, k8 = tid & 7; float f[8];
#pragma unroll
            for (int e = 0; e < 8; ++e) f[e] = tl[(8 * k8 + e) * 65 + n];
            u32x4 w; w.x = pk_bf16(f[0], f[1]); w.y = pk_bf16(f[2], f[3]); w.z = pk_bf16(f[4], f[5]); w.w = pk_bf16(f[6], f[7]);
            *(u32x4*)(dst + (size_t)(n0 + n) * 1024 + k0 + 8 * k8) = w; }
        __syncthreads();
    }
}

constexpr int AT_KB = 8192, AT_VB = 16384, AT_BUF = AT_KB + AT_VB, AT_NBUF = 3, AT_TASK = AT_NBUF * AT_BUF, AT_O1 = AT_TASK + 256;

DI void attn_qblock(const Params& p, LAS unsigned char* lds, int b, int hh, int qb, float lam) {
    int tid = threadIdx.x; asm volatile("" : "+v"(tid));
    const int lane = tid & 63, wid = __builtin_amdgcn_readfirstlane(tid >> 6);
    const bf16_t* P1 = (const bf16_t*)(p.ws + OFF_P1);
    const bf16_t* VT = (const bf16_t*)(p.ws + OFF_VT) + (size_t)(b * 4 + hh) * 32 * 128 * 64;
    const bf16_t* KX = (const bf16_t*)(p.ws + OFF_KX) + (size_t)(b * 4 + hh) * 2 * 2048 * 64;
    bf16_t* mix = (bf16_t*)(p.ws + OFF_HB);
    const int q0 = qb * 256 + wid * 32;
    const size_t tokbase = (size_t)b * SEQ;
    const int nkt = (qb + 1) * 4;
    const float sl2 = exp2f(-2.0f * (float)(hh + 1)) * LOG2E;
    const float c1 = 0.125f * LOG2E;
#pragma unroll 1
    for (int map = 0; map < 2; ++map) {
        f32x16 O[4];
#pragma unroll
        for (int mt = 0; mt < 4; ++mt)
#pragma unroll
            for (int i = 0; i < 16; ++i) O[mt][i] = 0.f;
        float m = -INFINITY, l = 0.f;
        int lane_m = lane; asm volatile("" : "+v"(lane_m));
        const int r = lane_m & 31, h2 = lane_m >> 5;
        int foff[4];
#pragma unroll
        for (int k = 0; k < 4; ++k) foff[k] = r * 128 + (((2 * k + h2) ^ ((r >> 1) & 7)) << 4);
        float kb[16];
#pragma unroll
        for (int i = 0; i < 16; ++i) kb[i] = sl2 * (float)crow(i, h2);
        const int krow_ = 8 * wid + (lane_m >> 3), vrow0 = 16 * wid + (lane_m >> 3), vrow1 = vrow0 + 8;
        const bf16_t* kgp = KX + ((size_t)map * 2048 + krow_) * 64 + (((lane_m & 7) ^ ((krow_ >> 1) & 7)) * 8);
        const bf16_t* vgp0 = VT + (size_t)vrow0 * 64 + (((lane_m & 7) ^ ((vrow0 >> 1) & 7)) * 8);
        const bf16_t* vgp1 = VT + (size_t)vrow1 * 64 + (((lane_m & 7) ^ ((vrow1 >> 1) & 7)) * 8);
#define AT_STAGE(bufi, tile) do { LAS unsigned char* _b = lds + (bufi) * AT_BUF; \
            __builtin_amdgcn_global_load_lds((const unsigned*)(kgp + (size_t)(tile) * 64 * 64), (LAS unsigned*)(_b + wid * 1024), 16, 0, 0); \
            __builtin_amdgcn_global_load_lds((const unsigned*)(vgp0 + (size_t)(tile) * 128 * 64), (LAS unsigned*)(_b + AT_KB + wid * 2048), 16, 0, 0); \
            __builtin_amdgcn_global_load_lds((const unsigned*)(vgp1 + (size_t)(tile) * 128 * 64), (LAS unsigned*)(_b + AT_KB + wid * 2048 + 1024), 16, 0, 0); } while (0)
        bf16x8 qf[4];
        { const bf16_t* qp = P1 + (tokbase + q0 + (lane_m & 31)) * NP1 + C_DQ + hh * 128 + map * 64 + 8 * (lane_m >> 5);
#pragma unroll
            for (int ks = 0; ks < 4; ++ks) qf[ks] = *(const bf16x8*)(qp + 16 * ks); }
        AT_STAGE(0, 0);
        AT_STAGE(1, 1);
        asm volatile("" : "+v"(qf[0]), "+v"(qf[1]), "+v"(qf[2]), "+v"(qf[3]));
        int cb = 0;
#pragma unroll 1
        for (int kt = 0; kt < nkt; ++kt) {
            if (kt + 1 < nkt) asm volatile("s_waitcnt vmcnt(3)" ::: "memory"); else asm volatile("s_waitcnt vmcnt(0)" ::: "memory");
            __builtin_amdgcn_s_barrier();
            asm volatile("" ::: "memory");
            if (kt + 2 < nkt) { const int nb = cb == 0 ? 2 : cb - 1; AT_STAGE(nb, kt + 2); }
            const LAS unsigned char* cur = lds + cb * AT_BUF;
            cb = cb == 2 ? 0 : cb + 1;
            const int k0 = kt * 64;
            if (k0 <= q0) {
                const bool sub1 = (k0 + 32 <= q0);
                const LAS unsigned char* vb = cur + AT_KB;
                bf16x8 kf[8];
#pragma unroll
                for (int ks = 0; ks < 4; ++ks) kf[ks] = *(const LAS bf16x8*)(cur + foff[ks]);
                if (sub1) {
#pragma unroll
                    for (int ks = 0; ks < 4; ++ks) kf[4 + ks] = *(const LAS bf16x8*)(cur + 4096 + foff[ks]);
                }
                f32x16 s0, s1;
#pragma unroll
                for (int i = 0; i < 16; ++i) { s0[i] = 0.f; s1[i] = 0.f; }
#pragma unroll
                for (int ks = 0; ks < 4; ++ks) s0 = MFMA32(kf[ks], qf[ks], s0);
                if (sub1) {
#pragma unroll
                    for (int ks = 0; ks < 4; ++ks) s1 = MFMA32(kf[4 + ks], qf[ks], s1);
                }
                __builtin_amdgcn_sched_barrier(0);
                bf16x8 va[8];
#pragma unroll
                for (int s2 = 0; s2 < 2; ++s2)
#pragma unroll
                    for (int mt = 0; mt < 4; ++mt) va[s2 * 4 + mt] = *(const LAS bf16x8*)(vb + mt * 4096 + foff[s2]);
                __builtin_amdgcn_sched_barrier(0);
                const float off0 = sl2 * (float)(k0 - q0), off1 = off0 + 32.0f * sl2;
                const f32x2 c1v = {c1, c1};
#pragma unroll
                for (int j = 0; j < 8; ++j) {
                    const f32x2 kv = {kb[2 * j], kb[2 * j + 1]};
                    f32x2 a = {s0[2 * j], s0[2 * j + 1]}, c = {s1[2 * j], s1[2 * j + 1]};
                    a = __builtin_elementwise_fma(a, c1v, kv); c = __builtin_elementwise_fma(c, c1v, kv);
                    s0[2 * j] = a.x; s0[2 * j + 1] = a.y; s1[2 * j] = c.x; s1[2 * j + 1] = c.y;
                }
                if (k0 == q0) {
#pragma unroll
                    for (int i = 0; i < 16; ++i) if (crow(i, h2) > r) s0[i] = -INFINITY;
                }
                if (k0 + 32 == q0) {
#pragma unroll
                    for (int i = 0; i < 16; ++i) if (crow(i, h2) > r) s1[i] = -INFINITY;
                }
                float mx0 = fmaxf(s0[0], s0[1]), mx1 = fmaxf(s1[0], s1[1]);
#pragma unroll
                for (int j = 1; j < 8; ++j) { mx0 = fmaxf(fmaxf(s0[2 * j], s0[2 * j + 1]), mx0); mx1 = fmaxf(fmaxf(s1[2 * j], s1[2 * j + 1]), mx1); }
                float mx = sub1 ? fmaxf(mx0 + off0, mx1 + off1) : mx0 + off0;
                mx = fmaxf(mx, __shfl_xor(mx, 32));
                if (__builtin_amdgcn_ballot_w64(mx > m + 8.0f) != 0ull) {
                    const float mn = fmaxf(m, mx);
                    const float alpha = __builtin_amdgcn_exp2f(m - mn);
                    m = mn; l *= alpha;
#pragma unroll
                    for (int mt = 0; mt < 4; ++mt)
#pragma unroll
                        for (int i = 0; i < 16; ++i) O[mt][i] *= alpha;
                }
                const float r0 = m - off0, r1 = sub1 ? m - off1 : INFINITY;
                const f32x2 r0v = {r0, r0}, r1v = {r1, r1};
                f32x2 lsv = {0.f, 0.f};
#pragma unroll
                for (int j = 0; j < 8; ++j) {
                    f32x2 a = {s0[2 * j], s0[2 * j + 1]}, c = {s1[2 * j], s1[2 * j + 1]};
                    a = a - r0v; c = c - r1v;
                    a.x = __builtin_amdgcn_exp2f(a.x); a.y = __builtin_amdgcn_exp2f(a.y); c.x = __builtin_amdgcn_exp2f(c.x); c.y = __builtin_amdgcn_exp2f(c.y);
                    lsv = lsv + a; lsv = lsv + c;
                    s0[2 * j] = a.x; s0[2 * j + 1] = a.y; s1[2 * j] = c.x; s1[2 * j + 1] = c.y;
                }
                l += lsv.x + lsv.y;
                bf16x8 pf[4];
#pragma unroll
                for (int s = 0; s < 2; ++s) { pf[s] = pack8(s0, s); pf[2 + s] = pack8(s1, s); }
                __builtin_amdgcn_sched_barrier(0);
                bf16x8 vc[4], vd[4];
                if (sub1) {
#pragma unroll
                    for (int mt = 0; mt < 4; ++mt) vc[mt] = *(const LAS bf16x8*)(vb + mt * 4096 + foff[2]);
                }
#pragma unroll
                for (int mt = 0; mt < 4; ++mt) O[mt] = MFMA32(va[mt], pf[0], O[mt]);
                if (sub1) {
#pragma unroll
                    for (int mt = 0; mt < 4; ++mt) vd[mt] = *(const LAS bf16x8*)(vb + mt * 4096 + foff[3]);
                }
#pragma unroll
                for (int mt = 0; mt < 4; ++mt) O[mt] = MFMA32(va[4 + mt], pf[1], O[mt]);
                if (sub1) {
#pragma unroll
                    for (int mt = 0; mt < 4; ++mt) O[mt] = MFMA32(vc[mt], pf[2], O[mt]);
#pragma unroll
                    for (int mt = 0; mt < 4; ++mt) O[mt] = MFMA32(vd[mt], pf[3], O[mt]);
                }
            }
        }
        asm volatile("" ::: "memory");
        __builtin_amdgcn_s_barrier();
        asm volatile("" ::: "memory");
#undef AT_STAGE
        const float lt = l + __shfl_xor(l, 32);
        int lane_o = lane; asm volatile("" : "+v"(lane_o));
        LAS unsigned* o1l = (LAS unsigned*)(lds + AT_O1 + wid * 8192) + lane_o;
        if (map == 0) {
            const float inv1 = 1.0f / lt;
#pragma unroll
            for (int mt = 0; mt < 4; ++mt)
#pragma unroll
                for (int j = 0; j < 8; ++j) o1l[(mt * 8 + j) * 64] = pk_bf16(O[mt][2 * j] * inv1, O[mt][2 * j + 1] * inv1);
        } else {
            const float inv2 = lam / lt;
            float ss = 0.f;
#pragma unroll
            for (int mt = 0; mt < 4; ++mt)
#pragma unroll
                for (int j = 0; j < 8; ++j) {
                    const unsigned o1 = o1l[(mt * 8 + j) * 64];
                    const float a = bf_lo(o1) - O[mt][2 * j] * inv2, c = bf_hi(o1) - O[mt][2 * j + 1] * inv2;
                    O[mt][2 * j] = a; O[mt][2 * j + 1] = c; ss += a * a + c * c;
                }
            ss += __shfl_xor(ss, 32);
            const float rs = rsqrtf(ss * (1.0f / 128.0f) + EPS) * 0.8f;
#pragma unroll
            for (int mt = 0; mt < 4; ++mt)
#pragma unroll
                for (int j = 0; j < 8; ++j) o1l[(mt * 8 + j) * 64] = pk_bf16(O[mt][2 * j] * rs, O[mt][2 * j + 1] * rs);
            __builtin_amdgcn_wave_barrier();
            int lane_e = lane; asm volatile("" : "+v"(lane_e));
            const int dvg = lane_e & 15, qs = lane_e >> 4;
            const f32x4 nw0 = *(const f32x4*)(p.diff_norm_w + 8 * dvg), nw1 = *(const f32x4*)(p.diff_norm_w + 8 * dvg + 4);
            const LAS unsigned* ob = (const LAS unsigned*)(lds + AT_O1 + wid * 8192);
            const int slot = (dvg >> 2) * 8 + 2 * (dvg & 3);
            u32x4 dzv[8];
#pragma unroll
            for (int it = 0; it < 8; ++it) dzv[it] = *(const u32x4*)(P1 + (tokbase + q0 + it * 4 + qs) * NP1 + C_DZ + hh * 128 + 8 * dvg);
#pragma unroll
            for (int it = 0; it < 8; ++it) {
                const int q = it * 4 + qs; const size_t row = tokbase + q0 + q;
                const unsigned u0 = ob[slot * 64 + q], u1 = ob[(slot + 1) * 64 + q], u2 = ob[slot * 64 + q + 32], u3 = ob[(slot + 1) * 64 + q + 32];
                const u32x4 dz = dzv[it];
                u32x4 w;
                w.x = pk_bf16(bf_lo(u0) * nw0[0] * silu_f(bf_lo(dz.x)), bf_hi(u0) * nw0[1] * silu_f(bf_hi(dz.x)));
                w.y = pk_bf16(bf_lo(u1) * nw0[2] * silu_f(bf_lo(dz.y)), bf_hi(u1) * nw0[3] * silu_f(bf_hi(dz.y)));
                w.z = pk_bf16(bf_lo(u2) * nw1[0] * silu_f(bf_lo(dz.z)), bf_hi(u2) * nw1[1] * silu_f(bf_hi(dz.z)));
                w.w = pk_bf16(bf_lo(u3) * nw1[2] * silu_f(bf_lo(dz.w)), bf_hi(u3) * nw1[3] * silu_f(bf_hi(dz.w)));
                *(u32x4*)(mix + row * DM + 512 + hh * 128 + 8 * dvg) = w;
            }
            __builtin_amdgcn_wave_barrier();
        }
    }
}

DI void phase_attn(const Params& p, LAS unsigned char* lds, int rep) {
    const float lam = *(const float*)(p.ws + OFF_MISC);
    unsigned* counter = (unsigned*)(p.ws + OFF_MISC + 4 + 4 * rep);
    LAS int* tslot = (LAS int*)(lds + AT_TASK);
    for (;;) {
        if (threadIdx.x == 0) *tslot = (int)atomicAdd(counter, 1u);
        __syncthreads();
        const int t = *tslot;
        __syncthreads();
        if (t >= 512) break;
        const int qb = 7 - (t >> 6), bh = t & 63;
        attn_qblock(p, lds, bh >> 2, bh & 3, qb, lam);
    }
}


constexpr int G_QN = 0, G_KN = 17408, G_VB = 34816, G_KBG = 52224, G_M = 69632, G_T = 86016, G_SM = 95232;
DI bf16x8 tr_pair(const LAS unsigned char* lo_addr, int hi_off) {
    const s16x4 lo = __builtin_amdgcn_ds_read_tr16_b64_v4i16((LAS s16x4*)(lo_addr));
    const s16x4 hi = __builtin_amdgcn_ds_read_tr16_b64_v4i16((LAS s16x4*)(lo_addr + hi_off));
    return __builtin_shufflevector(lo, hi, 0, 1, 2, 3, 4, 5, 6, 7);
}
DI bf16_t bf16_1(float v) { return (bf16_t)(pk_bf16(v, 0.f) & 0xffffu); }

DI void gdn_gates(const Params& p, LAS float* sm, int c2, int lane) {
    const int b = c2 >> 7, hh = (c2 >> 5) & 3, n = c2 & 31;
    const size_t tok0 = (size_t)b * SEQ + (size_t)n * 64;
    const float* gg = (const float*)(p.ws + OFF_GBGA) + (tok0 + lane) * 8;
    const float gbv = gg[hh], gav = gg[4 + hh];
    const float beta = 1.0f / (1.0f + expf(-gbv));
    const float xs = gav + p.dt_bias[hh];
    const float sp = fmaxf(xs, 0.f) + log1pf(expf(-fabsf(xs)));
    float gc = -expf(p.a_log[hh]) * sp;
#pragma unroll
    for (int o = 1; o < 64; o <<= 1) { const float t = __shfl_up(gc, o); if (lane >= o) gc += t; }
    const float gl = __shfl(gc, 63);
    sm[lane] = beta; sm[64 + lane] = gc * LOG2E; sm[128 + lane] = expf(gc); sm[192 + lane] = expf(gl - gc);
    if (lane == 63) ((float*)(p.ws + OFF_GL))[c2] = expf(gl);
}

DI void gdn_prep(const Params& p, LAS unsigned char* lds, int c2, int c2next, int par) {
    int tid = threadIdx.x; asm volatile("" : "+v"(tid));
    const int lane = tid & 63, wid = __builtin_amdgcn_readfirstlane(tid >> 6), r = lane & 31, h2 = lane >> 5;
    const int b = c2 >> 7, hh = (c2 >> 5) & 3, n = c2 & 31;
    const size_t tok0 = (size_t)b * SEQ + (size_t)n * 64;
    const bf16_t* P1 = (const bf16_t*)(p.ws + OFF_P1);
    LAS float* sm = (LAS float*)(lds + G_SM + par * 1024);
    LAS float* Mf = (LAS float*)(lds + G_M);
    bf16_t* WN = (bf16_t*)(p.ws + OFF_WN) + (size_t)c2 * 8192;
    bf16_t* QD = (bf16_t*)(p.ws + OFF_QD) + (size_t)c2 * 8192;
    bf16_t* KD = (bf16_t*)(p.ws + OFF_KD) + (size_t)c2 * 8192;
    bf16_t* AQ = (bf16_t*)(p.ws + OFF_AQK) + (size_t)c2 * 4096;
    float* U = (float*)(p.ws + OFF_U) + (size_t)c2 * 8192;
    u32x4 raw[6][4];
#pragma unroll
    for (int i = 0; i < 6; ++i) {
        const int item = tid + 512 * i, g = item & 15, t = (item >> 4) & 63, part = i >> 1;
        const int ch = part * 512 + hh * 128 + g * 8;
#pragma unroll
        for (int j = 0; j < 4; ++j) {
            const int tt = n * 64 + t - 3 + j, ttc = tt < 0 ? 0 : tt;
            raw[i][j] = *(const u32x4*)(P1 + ((size_t)b * SEQ + ttc) * NP1 + ch);
            if (tt < 0) raw[i][j] = (u32x4){0u, 0u, 0u, 0u};
        }
    }
    float av[6][8];
#pragma unroll
    for (int i = 0; i < 6; ++i) {
        const int item = tid + 512 * i, g = item & 15, part = i >> 1;
        const int ch = part * 512 + hh * 128 + g * 8;
        float a[8];
#pragma unroll
        for (int e = 0; e < 8; ++e) a[e] = 0.f;
#pragma unroll
        for (int j = 0; j < 4; ++j) {
            const f32x4 w0 = *(const f32x4*)(p.conv_w + j * 1536 + ch), w1 = *(const f32x4*)(p.conv_w + j * 1536 + ch + 4);
            const u32x4 rw = raw[i][j];
            a[0] += w0[0] * bf_lo(rw.x); a[1] += w0[1] * bf_hi(rw.x); a[2] += w0[2] * bf_lo(rw.y); a[3] += w0[3] * bf_hi(rw.y);
            a[4] += w1[0] * bf_lo(rw.z); a[5] += w1[1] * bf_hi(rw.z); a[6] += w1[2] * bf_lo(rw.w); a[7] += w1[3] * bf_hi(rw.w);
        }
        float ss = 0.f;
#pragma unroll
        for (int e = 0; e < 8; ++e) { a[e] = silu_f(a[e]); ss += a[e] * a[e]; }
        float rn = 1.0f;
        if (part < 2) {
            ss += __shfl_xor(ss, 1); ss += __shfl_xor(ss, 2); ss += __shfl_xor(ss, 4); ss += __shfl_xor(ss, 8);
            rn = rsqrtf(ss + 1e-6f) * (part == 0 ? 0.08838834764831845f : 1.0f);
        }
#pragma unroll
        for (int e = 0; e < 8; ++e) av[i][e] = a[e] * rn;
    }
    __syncthreads();
#pragma unroll
    for (int i = 0; i < 6; ++i) {
        const int item = tid + 512 * i, g = item & 15, t = (item >> 4) & 63, part = i >> 1;
        const float* a = av[i];
        const float beta = sm[t], egc = sm[128 + t], ekd = sm[192 + t];
        if (part < 2) {
            u32x4 w; w.x = pk_bf16(a[0], a[1]); w.y = pk_bf16(a[2], a[3]); w.z = pk_bf16(a[4], a[5]); w.w = pk_bf16(a[6], a[7]);
            *(LAS u32x4*)(lds + (part == 0 ? G_QN : G_KN) + t * 272 + g * 16) = w;
            if (part == 0) {
                u32x2 lo, hi; lo.x = pk_bf16(a[0] * egc, a[1] * egc); lo.y = pk_bf16(a[2] * egc, a[3] * egc); hi.x = pk_bf16(a[4] * egc, a[5] * egc); hi.y = pk_bf16(a[6] * egc, a[7] * egc);
                bf16_t* qd = QD + t * 128 + 16 * (g >> 1) + 4 * (g & 1);
                *(u32x2*)qd = lo; *(u32x2*)(qd + 8) = hi;
            } else {
                const float f1 = beta * egc;
                u32x4 w2; w2.x = pk_bf16(a[0] * f1, a[1] * f1); w2.y = pk_bf16(a[2] * f1, a[3] * f1); w2.z = pk_bf16(a[4] * f1, a[5] * f1); w2.w = pk_bf16(a[6] * f1, a[7] * f1);
                *(LAS u32x4*)(lds + G_KBG + t * 272 + g * 16) = w2;
                u32x4 w3; w3.x = pk_bf16(a[0] * ekd, a[1] * ekd); w3.y = pk_bf16(a[2] * ekd, a[3] * ekd); w3.z = pk_bf16(a[4] * ekd, a[5] * ekd); w3.w = pk_bf16(a[6] * ekd, a[7] * ekd);
                *(u32x4*)(KD + t * 128 + g * 8) = w3;
            }
        } else {
            u32x4 w; w.x = pk_bf16(a[0] * beta, a[1] * beta); w.y = pk_bf16(a[2] * beta, a[3] * beta); w.z = pk_bf16(a[4] * beta, a[5] * beta); w.w = pk_bf16(a[6] * beta, a[7] * beta);
            *(LAS u32x4*)(lds + G_VB + t * 272 + g * 16) = w;
        }
    }
    __syncthreads();
    {
        const int w4 = wid & 3, mt = w4 >> 1, nt = w4 & 1; const bool isqk = wid >= 4;
        if (!(mt == 0 && nt == 1)) {
            const LAS unsigned char* Ab = lds + (isqk ? G_QN : G_KN) + (32 * mt + r) * 272 + 16 * h2;
            const LAS unsigned char* Bb = lds + G_KN + (32 * nt + r) * 272 + 16 * h2;
            f32x16 X;
#pragma unroll
            for (int i = 0; i < 16; ++i) X[i] = 0.f;
#pragma unroll
            for (int ks = 0; ks < 8; ++ks) X = MFMA32(*(const LAS bf16x8*)(Ab + 32 * ks), *(const LAS bf16x8*)(Bb + 32 * ks), X);
            const int s = 32 * nt + r; const float gcs = sm[64 + s];
#pragma unroll
            for (int i = 0; i < 16; ++i) {
                const int c = 32 * mt + crow(i, h2);
                const float dec = __builtin_amdgcn_exp2f(sm[64 + c] - gcs);
                if (!isqk) Mf[c * 64 + s] = (c > s) ? sm[c] * X[i] * dec : 0.f;
                else AQ[c * 64 + perm23(s)] = bf16_1((c >= s) ? X[i] * dec : 0.f);
            }
        }
    }
    __syncthreads();
    if (wid == 0) {
        LAS bf16_t* Tb = (LAS bf16_t*)(lds + G_T);
        {
            const int c16 = lane & 15, b16 = lane >> 4;
            const LAS float* Mb = Mf + (16 * b16) * 64 + 16 * b16;
            float T[16];
#pragma unroll
            for (int i = 0; i < 16; ++i) T[i] = 0.f;
#pragma unroll
            for (int i = 0; i < 16; ++i) {
                float a0 = (i == c16) ? 1.f : 0.f, a1 = 0.f, a2 = 0.f, a3 = 0.f;
#pragma unroll
                for (int s4 = 0; s4 < (i + 3) / 4; ++s4) {
                    const f32x4 m4 = *(const LAS f32x4*)(Mb + i * 64 + 4 * s4);
                    a0 -= m4[0] * T[4 * s4]; a1 -= m4[1] * T[4 * s4 + 1]; a2 -= m4[2] * T[4 * s4 + 2]; a3 -= m4[3] * T[4 * s4 + 3];
                }
                T[i] = (a0 + a1) + (a2 + a3);
            }
#pragma unroll
            for (int i = 0; i < 16; ++i) {
                const int row = 16 * b16 + i;
                Tb[row * 72 + 16 * b16 + c16] = bf16_1(T[i]);
                if ((b16 & 1) == 0) Tb[row * 72 + 16 * b16 + 16 + c16] = 0;
                if (b16 < 2) { Tb[row * 72 + 32 + c16] = 0; Tb[row * 72 + 48 + c16] = 0; }
            }
        }
        __builtin_amdgcn_wave_barrier();
        asm volatile("s_waitcnt lgkmcnt(0)" ::: "memory");
        {
            const int qd = r >> 4, rr = r & 15;
            bf16x8 mfrag;
            { const LAS float* mp = Mf + (16 + 32 * qd + rr) * 64 + 32 * qd + 8 * h2;
              const f32x4 m0 = *(const LAS f32x4*)mp, m1 = *(const LAS f32x4*)(mp + 4);
              u32x4 aw; aw.x = pk_bf16(m0[0], m0[1]); aw.y = pk_bf16(m0[2], m0[3]); aw.z = pk_bf16(m1[0], m1[1]); aw.w = pk_bf16(m1[2], m1[3]);
              mfrag = __builtin_bit_cast(bf16x8, aw); }
            bf16x8 tfrag;
#pragma unroll
            for (int j = 0; j < 8; ++j) tfrag[j] = (short)Tb[(32 * qd + 8 * h2 + j) * 72 + 32 * qd + rr];
            bf16x8 t2frag;
            { const LAS unsigned char* tp = lds + G_T + (16 + 32 * qd + rr) * 144 + (16 + 32 * qd + 4 * h2) * 2;
              const u32x2 lo = *(const LAS u32x2*)tp, hi = *(const LAS u32x2*)(tp + 16);
              u32x4 aw; aw.x = lo.x; aw.y = lo.y; aw.z = hi.x; aw.w = hi.y; t2frag = __builtin_bit_cast(bf16x8, aw); }
            const bf16x8 zf = {0, 0, 0, 0, 0, 0, 0, 0};
            f32x16 Y1, Z1;
#pragma unroll
            for (int i = 0; i < 16; ++i) { Y1[i] = 0.f; Z1[i] = 0.f; }
#pragma unroll
            for (int ks = 0; ks < 2; ++ks) Y1 = MFMA32(qd == ks ? mfrag : zf, qd == ks ? tfrag : zf, Y1);
#pragma unroll
            for (int s2 = 0; s2 < 2; ++s2) Z1 = MFMA32(qd == s2 ? t2frag : zf, pack8(Y1, s2), Z1);
#pragma unroll
            for (int i = 0; i < 16; ++i) {
                const int row = crow(i, h2);
                if ((row >> 4) == qd) Tb[(16 + 32 * qd + (row & 15)) * 72 + 32 * qd + rr] = bf16_1(-Z1[i]);
            }
        }
        __builtin_amdgcn_wave_barrier();
        asm volatile("s_waitcnt lgkmcnt(0)" ::: "memory");
        const int i16 = lane & 15, q = i16 >> 2, pp = i16 & 3, blk = (lane >> 4) & 1;
        f32x16 Y;
#pragma unroll
        for (int i = 0; i < 16; ++i) Y[i] = 0.f;
#pragma unroll
        for (int ks = 0; ks < 2; ++ks) {
            const LAS float* mp = Mf + (32 + r) * 64 + 16 * ks + 8 * h2;
            const f32x4 m0 = *(const LAS f32x4*)mp, m1 = *(const LAS f32x4*)(mp + 4);
            u32x4 aw; aw.x = pk_bf16(m0[0], m0[1]); aw.y = pk_bf16(m0[2], m0[3]); aw.z = pk_bf16(m1[0], m1[1]); aw.w = pk_bf16(m1[2], m1[3]);
            const bf16x8 bfrag = tr_pair(lds + G_T + (16 * ks + 8 * h2 + q) * 144 + (16 * blk + 4 * pp) * 2, 4 * 144);
            Y = MFMA32(__builtin_bit_cast(bf16x8, aw), bfrag, Y);
        }
        f32x16 Z;
#pragma unroll
        for (int i = 0; i < 16; ++i) Z[i] = 0.f;
#pragma unroll
        for (int s = 0; s < 2; ++s) {
            const LAS unsigned char* tp = lds + G_T + (32 + r) * 144 + (32 + 16 * s + 4 * h2) * 2;
            const u32x2 lo = *(const LAS u32x2*)tp, hi = *(const LAS u32x2*)(tp + 16);
            u32x4 aw; aw.x = lo.x; aw.y = lo.y; aw.z = hi.x; aw.w = hi.y;
            Z = MFMA32(__builtin_bit_cast(bf16x8, aw), pack8(Y, s), Z);
        }
#pragma unroll
        for (int i = 0; i < 16; ++i) Tb[(32 + crow(i, h2)) * 72 + r] = bf16_1(-Z[i]);
    } else if (wid == 1) {
        if (c2next < 2048) gdn_gates(p, (LAS float*)(lds + G_SM + (par ^ 1) * 1024), c2next, lane);
    }
    __syncthreads();
    {
        const int mt = wid >> 2, nt = wid & 3;
        const int i16 = lane & 15, q = i16 >> 2, pp = i16 & 3, blk = (lane >> 4) & 1;
        f32x16 Xu, Xw;
#pragma unroll
        for (int i = 0; i < 16; ++i) { Xu[i] = 0.f; Xw[i] = 0.f; }
#pragma unroll
        for (int ks = 0; ks < 4; ++ks) {
            if (ks < 2 * (mt + 1)) {
                const bf16x8 af = *(const LAS bf16x8*)(lds + G_T + (32 * mt + r) * 144 + (16 * ks + 8 * h2) * 2);
                const int boff = (16 * ks + 8 * h2 + q) * 272 + (32 * nt + 16 * blk + 4 * pp) * 2;
                Xu = MFMA32(af, tr_pair(lds + G_VB + boff, 4 * 272), Xu);
                Xw = MFMA32(af, tr_pair(lds + G_KBG + boff, 4 * 272), Xw);
            }
        }
        const int d = 32 * nt + r, dp = perm23(d);
        {
            float* up = U + ((nt * 2 + mt) * 64 + lane) * 16;
#pragma unroll
            for (int k = 0; k < 4; ++k) { const f32x4 v = {Xu[4 * k], Xu[4 * k + 1], Xu[4 * k + 2], Xu[4 * k + 3]}; *(f32x4*)(up + 4 * k) = v; }
        }
#pragma unroll
        for (int i = 0; i < 16; ++i) {
            const int c = 32 * mt + crow(i, h2);
            WN[c * 128 + dp] = bf16_1(-Xw[i]);
        }
    }
    __syncthreads();
}

constexpr int S_WN = 0, S_QD = 17408, S_KD = 34816, S_AQ = 52224, S_BUF = 61440, S_STG = 2 * S_BUF;

struct GateIn { u32x4 z0, z1; };
DI void scan_gate_load(const Params& p, int tid, int b, int hh, int n, GateIn& g) {
    const int gc_ = tid >> 3, seg = tid & 7;
    const bf16_t* P1 = (const bf16_t*)(p.ws + OFF_P1);
    const size_t row = (size_t)b * SEQ + n * 64 + gc_;
    g.z0 = *(const u32x4*)(P1 + row * NP1 + C_GZ + hh * 128 + seg * 16); g.z1 = *(const u32x4*)(P1 + row * NP1 + C_GZ + hh * 128 + seg * 16 + 8);
}
DI void scan_gate(const Params& p, LAS unsigned char* lds, int tid, int b, int hh, int n, const GateIn& g) {
    const int gc_ = tid >> 3, seg = tid & 7;
    bf16_t* mix = (bf16_t*)(p.ws + OFF_HB);
    const LAS float* st = (const LAS float*)(lds + S_STG) + gc_ * 132 + seg * 16;
    f32x4 ov[4]; float ss = 0.f;
#pragma unroll
    for (int k = 0; k < 4; ++k) { ov[k] = *(const LAS f32x4*)(st + 4 * k); ss += ov[k][0] * ov[k][0] + ov[k][1] * ov[k][1] + ov[k][2] * ov[k][2] + ov[k][3] * ov[k][3]; }
    ss += __shfl_xor(ss, 1); ss += __shfl_xor(ss, 2); ss += __shfl_xor(ss, 4);
    const float rstd = rsqrtf(ss * (1.0f / 128.0f) + EPS);
    const size_t row = (size_t)b * SEQ + n * 64 + gc_;
    const u32x4 z0 = g.z0, z1 = g.z1;
    f32x4 gnw[4];
#pragma unroll
    for (int k = 0; k < 4; ++k) gnw[k] = *(const f32x4*)(p.gdn_norm_w + seg * 16 + 4 * k);
    u32x4 w0, w1;
    w0.x = pk_bf16(ov[0][0] * rstd * gnw[0][0] * silu_f(bf_lo(z0.x)), ov[0][1] * rstd * gnw[0][1] * silu_f(bf_hi(z0.x)));
    w0.y = pk_bf16(ov[0][2] * rstd * gnw[0][2] * silu_f(bf_lo(z0.y)), ov[0][3] * rstd * gnw[0][3] * silu_f(bf_hi(z0.y)));
    w0.z = pk_bf16(ov[1][0] * rstd * gnw[1][0] * silu_f(bf_lo(z0.z)), ov[1][1] * rstd * gnw[1][1] * silu_f(bf_hi(z0.z)));
    w0.w = pk_bf16(ov[1][2] * rstd * gnw[1][2] * silu_f(bf_lo(z0.w)), ov[1][3] * rstd * gnw[1][3] * silu_f(bf_hi(z0.w)));
    w1.x = pk_bf16(ov[2][0] * rstd * gnw[2][0] * silu_f(bf_lo(z1.x)), ov[2][1] * rstd * gnw[2][1] * silu_f(bf_hi(z1.x)));
    w1.y = pk_bf16(ov[2][2] * rstd * gnw[2][2] * silu_f(bf_lo(z1.y)), ov[2][3] * rstd * gnw[2][3] * silu_f(bf_hi(z1.y)));
    w1.z = pk_bf16(ov[3][0] * rstd * gnw[3][0] * silu_f(bf_lo(z1.z)), ov[3][1] * rstd * gnw[3][1] * silu_f(bf_hi(z1.z)));
    w1.w = pk_bf16(ov[3][2] * rstd * gnw[3][2] * silu_f(bf_lo(z1.w)), ov[3][3] * rstd * gnw[3][3] * silu_f(bf_hi(z1.w)));
    bf16_t* mp = mix + row * DM + hh * 128 + seg * 16;
    *(u32x4*)mp = w0; *(u32x4*)(mp + 8) = w1;
}

struct ScanRegs { u32x4 t0[4], t1[4], t2[4], t3[2]; };
DI void scan_fetch(ScanRegs& R, const bf16_t* WN, const bf16_t* QD, const bf16_t* KD, const bf16_t* AQ, int ltid) {
#pragma unroll
    for (int i = 0; i < 4; ++i) { const int pi = ltid + 256 * i; R.t0[i] = *(const u32x4*)(WN + pi * 8); R.t1[i] = *(const u32x4*)(QD + pi * 8); R.t2[i] = *(const u32x4*)(KD + pi * 8); }
#pragma unroll
    for (int i = 0; i < 2; ++i) { const int pi = ltid + 256 * i; R.t3[i] = *(const u32x4*)(AQ + pi * 8); }
}
DI void scan_put(const ScanRegs& R, LAS unsigned char* dst, int ltid) {
#pragma unroll
    for (int i = 0; i < 4; ++i) { const int pi = ltid + 256 * i, row = pi >> 4, pc = pi & 15;
        *(LAS u32x4*)(dst + S_WN + row * 272 + pc * 16) = R.t0[i]; *(LAS u32x4*)(dst + S_QD + row * 272 + pc * 16) = R.t1[i]; *(LAS u32x4*)(dst + S_KD + row * 272 + pc * 16) = R.t2[i]; }
#pragma unroll
    for (int i = 0; i < 2; ++i) { const int pi = ltid + 256 * i, row = pi >> 3, pc = pi & 7; *(LAS u32x4*)(dst + S_AQ + row * 144 + pc * 16) = R.t3[i]; }
}

DI void gdn_scan(const Params& p, LAS unsigned char* lds, int bh) {
    int tid = threadIdx.x; asm volatile("" : "+v"(tid));
    const int lane = tid & 63, wid = __builtin_amdgcn_readfirstlane(tid >> 6), r = lane & 31, h2 = lane >> 5;
    const int b = bh >> 2, hh = bh & 3;
    const bf16_t* WN = (const bf16_t*)(p.ws + OFF_WN) + (size_t)bh * 32 * 8192;
    const bf16_t* QD = (const bf16_t*)(p.ws + OFF_QD) + (size_t)bh * 32 * 8192;
    const bf16_t* KD = (const bf16_t*)(p.ws + OFF_KD) + (size_t)bh * 32 * 8192;
    const bf16_t* AQ = (const bf16_t*)(p.ws + OFF_AQK) + (size_t)bh * 32 * 4096;
    const float* U = (const float*)(p.ws + OFF_U) + (size_t)bh * 32 * 8192;
    const float* GL = (const float*)(p.ws + OFF_GL) + bh * 32;
    if (wid >= 4) {
        const int ltid = tid & 255;
        ScanRegs R;
        scan_fetch(R, WN, QD, KD, AQ, ltid); scan_put(R, lds, ltid);
        scan_fetch(R, WN + 8192, QD + 8192, KD + 8192, AQ + 4096, ltid);
#pragma unroll 1
        for (int n = 0; n < 32; ++n) {
            __syncthreads();
            GateIn gi; scan_gate_load(p, tid, b, hh, n, gi);
            if (n + 1 < 32) scan_put(R, lds + ((n + 1) & 1) * S_BUF, ltid);
            if (n + 2 < 32) scan_fetch(R, WN + (size_t)(n + 2) * 8192, QD + (size_t)(n + 2) * 8192, KD + (size_t)(n + 2) * 8192, AQ + (size_t)(n + 2) * 4096, ltid);
            __syncthreads();
            scan_gate(p, lds, tid, b, hh, n, gi);
        }
    } else {
        const int i16 = lane & 15, q4 = i16 >> 2, pp = i16 & 3, blk = (lane >> 4) & 1;
        f32x16 St[4], u[2];
#pragma unroll
        for (int k = 0; k < 4; ++k)
#pragma unroll
            for (int i = 0; i < 16; ++i) St[k][i] = 0.f;
#pragma unroll
        for (int mt = 0; mt < 2; ++mt)
#pragma unroll
            for (int k = 0; k < 4; ++k) { const f32x4 v = *(const f32x4*)(U + ((wid * 2 + mt) * 64 + lane) * 16 + 4 * k); u[mt][4 * k] = v[0]; u[mt][4 * k + 1] = v[1]; u[mt][4 * k + 2] = v[2]; u[mt][4 * k + 3] = v[3]; }
#pragma unroll 1
        for (int n = 0; n < 32; ++n) {
            LAS unsigned char* buf = lds + (n & 1) * S_BUF;
            __syncthreads();
            GateIn gi; scan_gate_load(p, tid, b, hh, n, gi);
            const float egl = GL[n];
            f32x16 vn[2], o[2];
            vn[0] = u[0]; vn[1] = u[1];
#pragma unroll
            for (int mt = 0; mt < 2; ++mt)
#pragma unroll
                for (int i = 0; i < 16; ++i) o[mt][i] = 0.f;
#pragma unroll
            for (int ks = 0; ks < 8; ++ks) {
                const bf16x8 sf = pack8(St[ks >> 1], ks & 1);
#pragma unroll
                for (int mt = 0; mt < 2; ++mt) {
                    const bf16x8 wf = *(const LAS bf16x8*)(buf + S_WN + (32 * mt + r) * 272 + (16 * ks + 8 * h2) * 2);
                    vn[mt] = MFMA32(wf, sf, vn[mt]);
                    const bf16x8 qf = *(const LAS bf16x8*)(buf + S_QD + (32 * mt + r) * 272 + (16 * ks + 8 * h2) * 2);
                    o[mt] = MFMA32(qf, sf, o[mt]);
                }
                asm volatile("" ::: "memory");
            }
            bf16x8 vf[4];
#pragma unroll
            for (int k2 = 0; k2 < 4; ++k2) vf[k2] = pack8(vn[k2 >> 1], k2 & 1);
            {
                const int nn = (n + 1 < 32) ? n + 1 : n;
                const float* up = U + (size_t)nn * 8192 + ((wid * 2) * 64 + lane) * 16;
#pragma unroll
                for (int mt = 0; mt < 2; ++mt)
#pragma unroll
                    for (int k = 0; k < 4; ++k) { const f32x4 v = *(const f32x4*)(up + mt * 1024 + 4 * k); u[mt][4 * k] = v[0]; u[mt][4 * k + 1] = v[1]; u[mt][4 * k + 2] = v[2]; u[mt][4 * k + 3] = v[3]; }
            }
#pragma unroll
            for (int mt = 0; mt < 2; ++mt)
#pragma unroll
                for (int k2 = 0; k2 < 2 * (mt + 1); ++k2) {
                    const bf16x8 af = *(const LAS bf16x8*)(buf + S_AQ + (32 * mt + r) * 144 + (16 * k2 + 8 * h2) * 2);
                    o[mt] = MFMA32(af, vf[k2], o[mt]);
                }
            {
                LAS float* st = (LAS float*)(lds + S_STG);
#pragma unroll
                for (int mt = 0; mt < 2; ++mt)
#pragma unroll
                    for (int i = 0; i < 16; ++i) st[(32 * mt + crow(i, h2)) * 132 + 32 * wid + r] = o[mt][i];
            }
#pragma unroll
            for (int kt = 0; kt < 4; ++kt) {
#pragma unroll
                for (int i = 0; i < 16; ++i) St[kt][i] *= egl;
#pragma unroll
                for (int k2 = 0; k2 < 4; ++k2) {
                    const bf16x8 kf = tr_pair(buf + S_KD + (16 * k2 + 4 * h2 + q4) * 272 + (32 * kt + 16 * blk + 4 * pp) * 2, 8 * 272);
                    St[kt] = MFMA32(kf, vf[k2], St[kt]);
                }
                asm volatile("" ::: "memory");
            }
            __syncthreads();
            scan_gate(p, lds, tid, b, hh, n, gi);
        }
    }
    __syncthreads();
}

DI void zero_mix_half(const Params& p, int half) {
    bf16_t* mix = (bf16_t*)(p.ws + OFF_HB);
    const size_t n16 = (size_t)MTOK * 64;
    for (size_t i = (size_t)blockIdx.x * 512 + threadIdx.x; i < n16; i += (size_t)gridDim.x * 512) {
        const size_t row = i >> 6, pc = i & 63;
        *(u32x4*)(mix + row * DM + half * 512 + pc * 8) = (u32x4){0u, 0u, 0u, 0u};
    }
}

DI void phase_final(const Params& p) {
    int tid = threadIdx.x; asm volatile("" : "+v"(tid));
    const int lane = tid & 63, wid = tid >> 6;
    const float* rowsq = (const float*)(p.ws + OFF_ROWSQ);
    const bf16_t* yb = (const bf16_t*)(p.ws + OFF_YB);
    const int gw = blockIdx.x * 8 + wid, nw = gridDim.x * 8;
    f32x4 fw[4];
#pragma unroll
    for (int i = 0; i < 2; ++i) { fw[2 * i] = *(const f32x4*)(p.final_norm_w + 512 * i + 8 * lane); fw[2 * i + 1] = *(const f32x4*)(p.final_norm_w + 512 * i + 8 * lane + 4); }
#pragma unroll 1
    for (int row0 = gw; row0 < MTOK; row0 += 4 * nw) {
        u32x4 y[4][2]; float sq[4];
#pragma unroll
        for (int k = 0; k < 4; ++k) {
            const int row = row0 + k * nw, rc = row < MTOK ? row : row0;
#pragma unroll
            for (int i = 0; i < 2; ++i) y[k][i] = *(const u32x4*)(yb + (size_t)rc * DM + 512 * i + 8 * lane);
            sq[k] = lane < 16 ? rowsq[(size_t)rc * 16 + lane] : 0.f;
        }
#pragma unroll
        for (int k = 0; k < 4; ++k) {
            const int row = row0 + k * nw;
            const float ss = wave_sum(sq[k]);
            const float rstd = rsqrtf(ss * (1.0f / DM) + EPS);
            if (row < MTOK) {
                float* o = p.out + (size_t)row * DM;
#pragma unroll
                for (int i = 0; i < 2; ++i) {
                    const f32x4 a = {bf_lo(y[k][i].x), bf_hi(y[k][i].x), bf_lo(y[k][i].y), bf_hi(y[k][i].y)}, c = {bf_lo(y[k][i].z), bf_hi(y[k][i].z), bf_lo(y[k][i].w), bf_hi(y[k][i].w)};
                    *(f32x4*)(o + 512 * i + 8 * lane) = a * rstd * fw[2 * i];
                    *(f32x4*)(o + 512 * i + 8 * lane + 4) = c * rstd * fw[2 * i + 1];
                }
            }
        }
    }
}

__global__ void __launch_bounds__(512) mega(Params p) {
    extern __shared__ __attribute__((aligned(16))) unsigned char shm[];
    LAS unsigned char* lds = (LAS unsigned char*)shm;
    cg::grid_group grid = cg::this_grid();
    volatile LAS unsigned* bst = (volatile LAS unsigned*)(lds + LDS_BYTES - 16);
    if (threadIdx.x < 2) bst[threadIdx.x] = 0u;
    __syncthreads();
    const XcdBarrier xb = xcd_barrier_post((unsigned*)(p.ws + OFF_BAR), bst);
    if (p.ws == nullptr) grid.sync();

#pragma unroll 1
    for (int rep = 0; rep < REP_PREP; ++rep) phase_prep(p, lds);
    xcd_barrier(xb);
#pragma unroll 1
    for (int rep = 0; rep < REP_G1; ++rep)
    {
        pg8::Gemm g{(const bf16_t*)(p.ws + OFF_HB), (const bf16_t*)(p.ws + OFF_WINT), MTOK, NG1, DM};
        pg8::StaticOrder S; S.init(g.M, g.N, (int)gridDim.x, (int)blockIdx.x);
        pg8::EpiP1 E{(bf16_t*)(p.ws + OFF_P1), NP1, (bf16_t*)(p.ws + OFF_KX)};
        pg8::gemm_phase<pg8::EpiP1, false>(lds, g, S, E);
        pg8::Gemm g2{(const bf16_t*)(p.ws + OFF_HB), (const bf16_t*)(p.ws + OFF_WINT) + (size_t)NG1 * DM, MTOK, 512, DM};
        pg8::StaticOrder S2; S2.init(g2.M, g2.N, (int)gridDim.x, (int)blockIdx.x);
        pg8::EpiVT E2{(bf16_t*)(p.ws + OFF_VT)};
        pg8::gemm_phase<pg8::EpiVT, true>(lds, g2, S2, E2);
    }
    xcd_barrier(xb);
#pragma unroll 1
    for (int rep = 0; rep < REP_GP; ++rep)
    {
        if ((threadIdx.x >> 6) == 0 && (int)blockIdx.x < 2048) gdn_gates(p, (LAS float*)(lds + G_SM), blockIdx.x, threadIdx.x & 63);
        int par = 0;
#pragma unroll 1
        for (int c2 = blockIdx.x; c2 < 2048; c2 += gridDim.x, par ^= 1) gdn_prep(p, lds, c2, c2 + (int)gridDim.x, par);
    }
    xcd_barrier(xb);
#pragma unroll 1
    for (int rep = 0; rep < REP_P3; ++rep) {
#pragma unroll 1
        for (int r2 = 0; r2 < REP_SCAN; ++r2)
            if (blockIdx.x < 64) gdn_scan(p, lds, blockIdx.x);
#if SCAN_SYNC
        xcd_barrier(xb);
#endif
        phase_attn(p, lds, rep);
#if REP_ATTN > 1
        xcd_barrier(xb);
        phase_attn(p, lds, 2);
#endif
#if REP_P3 > 1
        xcd_barrier(xb);
#endif
    }
    xcd_barrier(xb);
#pragma unroll 1
    for (int rnd = 0; rnd < 2; ++rnd) {
        pg8::Gemm g{(const bf16_t*)(p.ws + OFF_HB), (const bf16_t*)(p.ws + OFF_WOUTT), MTOK, DM, DM};
        pg8::StaticOrder S; S.init(g.M, g.N, (int)gridDim.x, (int)blockIdx.x); S.i0 = rnd; S.imax = 1;
        pg8::EpiOutFused E{p.x, p.out, (float*)(p.ws + OFF_ROWSQ), p.final_norm_w, xb};
        pg8::Unit u0;
        if (S.next(0, u0)) pg8::gemm_phase<pg8::EpiOutFused, false>(lds, g, S, E);
        else xcd_barrier(xb);
    }
}

extern "C" void kernel_launch(void* const* d_in, const int* in_sizes, int n_in, void* d_out, int out_size, void* d_ws, size_t ws_size, hipStream_t stream) {
    static int grid = 0;
    if (grid == 0) {
        if (ws_size < WS_END) { fprintf(stderr, "kernel_launch: workspace too small (%zu < %zu)\n", ws_size, (size_t)WS_END); grid = -1; return; }
        int dev = 0, cus = 0, per_cu = 0;
        hipGetDevice(&dev);
        hipDeviceGetAttribute(&cus, hipDeviceAttributeMultiprocessorCount, dev);
        if (hipFuncSetAttribute((const void*)mega, hipFuncAttributeMaxDynamicSharedMemorySize, LDS_BYTES) != hipSuccess) { fprintf(stderr, "kernel_launch: hipFuncSetAttribute failed\n"); grid = -1; return; }
        if (hipOccupancyMaxActiveBlocksPerMultiprocessor(&per_cu, (const void*)mega, 512, LDS_BYTES) != hipSuccess || per_cu < 1) per_cu = 1;
        (void)hipGetLastError();
        grid = cus * (per_cu > 1 ? 1 : per_cu);
    }
    if (grid < 0) return;
    Params p{};
    p.x = (const float*)d_in[0]; p.norm_w = (const float*)d_in[1]; p.w_in = (const float*)d_in[2]; p.conv_w = (const float*)d_in[3];
    p.a_log = (const float*)d_in[4]; p.dt_bias = (const float*)d_in[5]; p.gdn_norm_w = (const float*)d_in[6];
    p.lq1 = (const float*)d_in[7]; p.lk1 = (const float*)d_in[8]; p.lq2 = (const float*)d_in[9]; p.lk2 = (const float*)d_in[10];
    p.diff_norm_w = (const float*)d_in[11]; p.w_out = (const float*)d_in[12]; p.final_norm_w = (const float*)d_in[13];
    p.out = (float*)d_out; p.ws = (unsigned char*)d_ws;
    if (hipMemsetAsync((unsigned char*)d_ws + OFF_BAR, 0, 16384, stream) != hipSuccess) { fprintf(stderr, "kernel_launch: hipMemsetAsync failed\n"); return; }
    void* args[] = {&p};
    hipError_t e = hipLaunchCooperativeKernel((const void*)mega, dim3(grid), dim3(512), args, LDS_BYTES, stream);
    if (e != hipSuccess) fprintf(stderr, "cooperative launch failed: %s (grid %d)\n", hipGetErrorString(e), grid);
}
```

```cpp
#include <hip/hip_runtime.h>
#include <hip/hip_cooperative_groups.h>
#include <cstdio>
namespace cg = cooperative_groups;

#ifndef ENABLE_ATTN
#define ENABLE_ATTN 1
#endif
#ifndef ENABLE_GDN
#define ENABLE_GDN 1
#endif
#ifndef REP_PREP
#define REP_PREP 1
#endif
#ifndef REP_G1
#define REP_G1 1
#endif
#ifndef REP_GP
#define REP_GP 1
#endif
#ifndef REP_P3
#define REP_P3 1
#endif
#ifndef REP_G2
#define REP_G2 1
#endif
#ifndef REP_SCAN
#define REP_SCAN 1
#endif
#ifndef SCAN_SYNC
#define SCAN_SYNC 0
#endif
#ifndef REP_ATTN
#define REP_ATTN 1
#endif

#define LAS __attribute__((address_space(3)))
#define DI __device__ __forceinline__
typedef unsigned short bf16_t;
typedef short bf16x8 __attribute__((ext_vector_type(8)));
typedef short s16x4 __attribute__((ext_vector_type(4)));
typedef float f32x2 __attribute__((ext_vector_type(2)));
typedef float f32x4 __attribute__((ext_vector_type(4)));
typedef float f32x16 __attribute__((ext_vector_type(16)));
typedef unsigned u32x2 __attribute__((ext_vector_type(2)));
typedef unsigned u32x4 __attribute__((ext_vector_type(4)));
typedef __bf16 bf16x2_t __attribute__((ext_vector_type(2)));

#define MFMA32(a, b, c) __builtin_amdgcn_mfma_f32_32x32x16_bf16((a), (b), (c), 0, 0, 0)

constexpr int NB = 16, SEQ = 2048, DM = 1024, MTOK = NB * SEQ, NP1 = 3072, NG1 = 3584;
constexpr int C_GQ = 0, C_GK = 512, C_GV = 1024, C_GZ = 1536, C_DQ = 2048, C_DZ = 2560;
constexpr float EPS = 1e-6f;
constexpr float LOG2E = 1.4426950408889634f;

constexpr size_t OFF_HB = 0;
constexpr size_t OFF_WINT = OFF_HB + (size_t)MTOK * DM * 2;
constexpr size_t OFF_WOUTT = OFF_WINT + (size_t)4096 * 1024 * 2;
constexpr size_t OFF_GBGA = OFF_WOUTT + (size_t)1024 * 1024 * 2;
constexpr size_t OFF_P1 = OFF_GBGA + (size_t)MTOK * 8 * 4;
constexpr size_t OFF_KX = OFF_P1 + (size_t)MTOK * NP1 * 2;
constexpr size_t OFF_VT = OFF_KX + (size_t)64 * 2 * 2048 * 64 * 2;
constexpr size_t OFF_WN = OFF_VT + (size_t)64 * 128 * 2048 * 2;
constexpr size_t OFF_QD = OFF_WN + (size_t)2048 * 64 * 128 * 2;
constexpr size_t OFF_KD = OFF_QD + (size_t)2048 * 64 * 128 * 2;
constexpr size_t OFF_AQK = OFF_KD + (size_t)2048 * 64 * 128 * 2;
constexpr size_t OFF_U = OFF_AQK + (size_t)2048 * 64 * 64 * 2;
constexpr size_t OFF_GL = OFF_U + (size_t)2048 * 64 * 128 * 4;
constexpr size_t OFF_ROWSQ = OFF_GL + 8192;
constexpr size_t OFF_MISC = OFF_ROWSQ + (size_t)MTOK * 16 * 4;
constexpr size_t OFF_YB = OFF_P1;
constexpr size_t OFF_BAR = OFF_MISC + 256;
constexpr size_t WS_END = OFF_BAR + 16384;

constexpr int LDS_BYTES = 156 * 1024;

struct Params {
    const float *x, *norm_w, *w_in, *conv_w, *a_log, *dt_bias, *gdn_norm_w, *lq1, *lk1, *lq2, *lk2, *diff_norm_w, *w_out, *final_norm_w;
    float* out; unsigned char* ws;
};

DI unsigned pk_bf16(float a, float b) { f32x2 v = {a, b}; bf16x2_t r = __builtin_convertvector(v, bf16x2_t); return __builtin_bit_cast(unsigned, r); }
DI float bf_lo(unsigned u) { return __uint_as_float(u << 16); }
DI float bf_hi(unsigned u) { return __uint_as_float(u & 0xffff0000u); }
DI float wave_sum(float v) {
#pragma unroll
    for (int o = 32; o; o >>= 1) v += __shfl_xor(v, o);
    return v;
}
DI float xhalf_max(float v) {
    const u32x2 r = __builtin_amdgcn_permlane32_swap(__float_as_uint(v), __float_as_uint(v), false, false);
    return fmaxf(__uint_as_float(r.x), __uint_as_float(r.y));
}
DI float xhalf_sum(float v) {
    const u32x2 r = __builtin_amdgcn_permlane32_swap(__float_as_uint(v), __float_as_uint(v), false, false);
    return __uint_as_float(r.x) + __uint_as_float(r.y);
}
DI float silu_f(float z) { return z * __builtin_amdgcn_rcpf(1.0f + __builtin_amdgcn_exp2f(-LOG2E * z)); }
DI int perm23(int t) { return (t & ~12) | ((t & 4) << 1) | ((t & 8) >> 1); }
DI int crow(int i, int h2) { return (i & 3) + 8 * (i >> 2) + 4 * h2; }
DI bf16x8 pack8(const f32x16& x, int s) {
    u32x4 w; w.x = pk_bf16(x[8 * s + 0], x[8 * s + 1]); w.y = pk_bf16(x[8 * s + 2], x[8 * s + 3]); w.z = pk_bf16(x[8 * s + 4], x[8 * s + 5]); w.w = pk_bf16(x[8 * s + 6], x[8 * s + 7]);
    return __builtin_bit_cast(bf16x8, w);
}


#define XB_TMO      128
#define XB_XCNT(j)  (256  + 64 * (j))
#define XB_XSUB(j)  (1280 + 64 * (j))
#define XB_XGEN(j)  (2304 + 64 * (j))
#define XB_TOP      3328
#define XB_TOPGEN   3392
#define XCD_BAR_WORDS 3456
#define XB_SPIN_CAP (1u << 18)
struct XcdBarrier { unsigned* bar; unsigned x; volatile LAS unsigned* st; };
DI unsigned xb_ld(unsigned* p)              { return __hip_atomic_load(p, __ATOMIC_RELAXED, __HIP_MEMORY_SCOPE_AGENT); }
DI unsigned xb_add(unsigned* p, unsigned v) { return __hip_atomic_fetch_add(p, v, __ATOMIC_RELAXED, __HIP_MEMORY_SCOPE_AGENT); }
DI unsigned xb_xcc_id() { return (unsigned)__builtin_amdgcn_s_getreg((3 << 11) | 20) & 0xFu; }
#define XB_SPIN(cond, bar) do { unsigned _sp = 0; while (cond) { __builtin_amdgcn_s_sleep(1); \
    if ((++_sp & 255u) == 0u) { if (xb_ld(&(bar)[XB_TMO])) break; if (_sp > XB_SPIN_CAP) { atomicAdd(&(bar)[XB_TMO], 1u); break; } } } } while (0)
DI XcdBarrier xcd_barrier_post(unsigned* bar, volatile LAS unsigned* st) {
    XcdBarrier b; b.bar = bar; b.x = xb_xcc_id(); b.st = st;
    if (threadIdx.x == 0) (void)xb_add(&bar[XB_XCNT(b.x)], 1u);
    return b;
}
DI void xcd_barrier_complete(unsigned* bar, unsigned x, unsigned& nloc, unsigned& nx) {
    const unsigned G = gridDim.x * gridDim.y * gridDim.z;
    unsigned sum, cnt, mine, sp = 0u;
    for (;;) {
        sum = 0u; cnt = 0u; mine = 0u;
#pragma unroll
        for (unsigned j = 0; j < 16; ++j) { const unsigned c = xb_ld(&bar[XB_XCNT(j)]); sum += c; cnt += (c > 0u) ? 1u : 0u; mine = (j == x) ? c : mine; }
        if (sum == G) break;
        __builtin_amdgcn_s_sleep(1);
        if ((++sp & 255u) == 0u) { if (xb_ld(&bar[XB_TMO])) break; if (sp > XB_SPIN_CAP) { atomicAdd(&bar[XB_TMO], 1u); break; } }
    }
    nloc = mine > 0u ? mine : 1u; nx = cnt > 0u ? cnt : 1u;
}
DI void xcd_barrier(const XcdBarrier& b) {
    asm volatile("s_waitcnt vmcnt(0)" ::: "memory");
    __syncthreads();
    if (threadIdx.x == 0) {
        unsigned* bar = b.bar;
        __builtin_amdgcn_s_waitcnt(0);
        unsigned nloc = b.st[0], nx = b.st[1];
        if (nloc == 0u) { xcd_barrier_complete(bar, b.x, nloc, nx); b.st[0] = nloc; b.st[1] = nx; }
        const unsigned old = xb_add(&bar[XB_XSUB(b.x)], 1u);
        const unsigned gen = old / nloc;
        if (old + 1u == (gen + 1u) * nloc) {
            __builtin_amdgcn_fence(__ATOMIC_RELEASE, "agent");
            asm volatile("s_waitcnt vmcnt(0)" ::: "memory");
            const unsigned og = xb_add(&bar[XB_TOP], 1u);
            const unsigned tg = og / nx;
            if (og + 1u == (tg + 1u) * nx) xb_add(&bar[XB_TOPGEN], 1u);
            else XB_SPIN(xb_ld(&bar[XB_TOPGEN]) == tg, bar);
            __builtin_amdgcn_fence(__ATOMIC_ACQUIRE, "agent");
            xb_add(&bar[XB_XGEN(b.x)], 1u);
            asm volatile("s_waitcnt vmcnt(0)" ::: "memory");
        } else {
            XB_SPIN(xb_ld(&bar[XB_XGEN(b.x)]) == gen, bar);
            __builtin_amdgcn_fence(__ATOMIC_ACQUIRE, "agent");
            asm volatile("s_waitcnt vmcnt(0)" ::: "memory");
        }
    }
    __syncthreads();
}

namespace pg8 {
constexpr int BM = 256, BK = 64, HALF = 128, HTB = HALF * BK * 2, STAGE_BYTES = 8 * HTB, NXCD = 8, WGM = 8;
DI int lds_byte(int r, int c) { const int st = (r >> 4) * 2 + (c >> 5), rr = r & 15, cc = c & 31, ob = rr * 64 + cc * 2; return st * 1024 + (ob ^ (((ob >> 9) & 1) << 5)); }
DI void stage_rc(int b, int& R, int& C) { const int st = b / 1024, sb = b % 1024, swz = sb ^ (((sb >> 9) & 1) << 5); R = (st >> 1) * 16 + swz / 64; C = (st & 1) * 32 + (swz % 64) / 2; }
DI int perm32(int rho) { const int n = rho >> 4, i = rho & 15; return 8 * (i >> 2) + 4 * n + (i & 3); }
struct Unit { int pm, pn; };
struct Gemm { const bf16_t* A; const bf16_t* Bt; int M, N, K; };
struct StaticOrder {
    int nM, nN, nwg, G, c, i0 = 0, imax = 1 << 30;
    DI void init(int M, int N, int G_, int c_) { nM = M / BM; nN = N / BM; nwg = nM * nN; G = G_; c = c_; }
    DI bool next(int i, Unit& u) const {
        if (i >= imax) return false;
        const long L = (long)(i + i0) * G + c; if (L >= nwg) return false;
        int wgid = (int)L; { const int q = nwg / NXCD, r = nwg % NXCD, xcd = wgid % NXCD, off = wgid / NXCD; wgid = (xcd < r ? xcd * (q + 1) : r * (q + 1) + (xcd - r) * q) + off; }
        const int nig = WGM * nN, gid = wgid / nig, fm = gid * WGM, gsz = (nM - fm) < WGM ? (nM - fm) : WGM;
        u.pm = fm + ((wgid % nig) % gsz); u.pn = (wgid % nig) / gsz; return true;
    }
    DI void a_ready(const Unit&) const {}
    DI void done(const Unit&) const {}
};

struct EpiP1 {
    static constexpr bool PERM = true, PERM16 = true, AFTER_DRAIN = false;
    bf16_t* O; int ldc; bf16_t* KX;
    DI void operator()(const f32x4 (&acc)[2][2][4][2], const Unit& u, int wr, int wc, int fr, int fq) const {
        const int row0 = u.pm * BM + wr * 64 + fr, col0 = u.pn * BM + wc * 64 + 16 * fq;
        if (u.pn >= 12) {
            const int c = col0 - 12 * BM, hm = c >> 6, d = c & 63;
#pragma unroll
            for (int ai = 0; ai < 2; ++ai)
#pragma unroll
                for (int m = 0; m < 4; ++m) { const int row = row0 + ai * HALF + m * 16, b = row >> 11, tok = row & 2047;
                    bf16_t* dp = KX + ((size_t)(b * 8 + hm) * 2048 + tok) * 64 + d;
#pragma unroll
                    for (int bj = 0; bj < 2; ++bj) { const f32x4 v0 = acc[ai][bj][m][0], v1 = acc[ai][bj][m][1];
                        u32x4 w; w.x = pk_bf16(v0[0], v0[1]); w.y = pk_bf16(v0[2], v0[3]); w.z = pk_bf16(v1[0], v1[1]); w.w = pk_bf16(v1[2], v1[3]);
                        *(u32x4*)(dp + 8 * bj) = w; } }
            return;
        }
#pragma unroll
        for (int ai = 0; ai < 2; ++ai)
#pragma unroll
            for (int m = 0; m < 4; ++m) { bf16_t* rowp = O + (size_t)(row0 + ai * HALF + m * 16) * ldc + col0;
#pragma unroll
                for (int bj = 0; bj < 2; ++bj) { const f32x4 v0 = acc[ai][bj][m][0], v1 = acc[ai][bj][m][1];
                    u32x4 w; w.x = pk_bf16(v0[0], v0[1]); w.y = pk_bf16(v0[2], v0[3]); w.z = pk_bf16(v1[0], v1[1]); w.w = pk_bf16(v1[2], v1[3]);
                    *(u32x4*)(rowp + 8 * bj) = w; } }
    }
};
struct EpiVT {
    static constexpr bool PERM = false, PERM16 = false, AFTER_DRAIN = false;
    bf16_t* VT;
    DI void operator()(const f32x4 (&acc)[2][2][4][2], const Unit& u, int wr, int wc, int fr, int fq) const {
#pragma unroll
        for (int ai = 0; ai < 2; ++ai)
#pragma unroll
            for (int m = 0; m < 4; ++m) {
                const int t = u.pm * BM + ai * HALF + wr * 64 + m * 16 + 4 * fq, b = t >> 11, tok = t & 2047, pos = perm23(tok);
#pragma unroll
                for (int bj = 0; bj < 2; ++bj)
#pragma unroll
                    for (int n = 0; n < 2; ++n) {
                        const int c = u.pn * BM + bj * HALF + wc * 32 + n * 16 + fr, hh = c >> 7, dv = c & 127;
                        const f32x4 v = acc[ai][bj][m][n];
                        u32x2 w; w.x = pk_bf16(v[0], v[1]); w.y = pk_bf16(v[2], v[3]);
                        *(u32x2*)(VT + (((size_t)((b * 4 + hh) * 32 + (pos >> 6)) * 128 + dv)) * 64 + (pos & 63)) = w;
                    }
            }
    }
};
static_assert(WGM == 8, "EpiOutFused needs the four column tiles of a row panel in the same round");
struct EpiOutFused {
    static constexpr bool PERM = false, PERM16 = false, AFTER_DRAIN = true;
    const float* X; float* Out; float* rowsq; const float* fw; XcdBarrier xb;
    DI void operator()(const f32x4 (&)[2][2][4][2], const Unit&, int, int, int, int) const {}
    DI void fused(f32x4 (&acc)[2][2][4][2], const Unit& u, int wr, int wc, int fr, int fq) const {
        const int row0 = u.pm * BM + wr * 64 + fr, col0 = u.pn * BM + wc * 32 + 4 * fq;
#pragma unroll
        for (int ai = 0; ai < 2; ++ai)
#pragma unroll
            for (int m = 0; m < 4; ++m) {
                const int row = row0 + ai * HALF + m * 16; float ss = 0.f;
#pragma unroll
                for (int bj = 0; bj < 2; ++bj)
#pragma unroll
                    for (int n = 0; n < 2; ++n) {
                        const size_t o = (size_t)row * DM + col0 + bj * HALF + n * 16;
                        const f32x4 y = acc[ai][bj][m][n] + *(const f32x4*)(X + o);
                        acc[ai][bj][m][n] = y; ss += y[0] * y[0] + y[1] * y[1] + y[2] * y[2] + y[3] * y[3];
                    }
                ss += __shfl_xor(ss, 16); ss += __shfl_xor(ss, 32);
                if (fq == 0) rowsq[(size_t)row * 16 + u.pn * 4 + wc] = ss;
            }
        xcd_barrier(xb);
        f32x4 fwv[2][2];
#pragma unroll
        for (int bj = 0; bj < 2; ++bj)
#pragma unroll
            for (int n = 0; n < 2; ++n) fwv[bj][n] = *(const f32x4*)(fw + col0 + bj * HALF + n * 16);
#pragma unroll
        for (int ai = 0; ai < 2; ++ai)
#pragma unroll
            for (int m = 0; m < 4; ++m) {
                const int row = row0 + ai * HALF + m * 16;
                const f32x4* rq = (const f32x4*)(rowsq + (size_t)row * 16);
                const f32x4 q0 = rq[0], q1 = rq[1], q2 = rq[2], q3 = rq[3];
                const float tot = ((q0[0] + q0[1]) + (q0[2] + q0[3])) + ((q1[0] + q1[1]) + (q1[2] + q1[3])) + ((q2[0] + q2[1]) + (q2[2] + q2[3])) + ((q3[0] + q3[1]) + (q3[2] + q3[3]));
                const float rstd = rsqrtf(tot * (1.0f / DM) + EPS);
#pragma unroll
                for (int bj = 0; bj < 2; ++bj)
#pragma unroll
                    for (int n = 0; n < 2; ++n) {
                        const size_t o = (size_t)row * DM + col0 + bj * HALF + n * 16;
                        *(f32x4*)(Out + o) = acc[ai][bj][m][n] * rstd * fwv[bj][n];
                    }
            }
    }
};

template <class Epi, bool SWAP>
DI void gemm_phase(LAS unsigned char* lds, const Gemm g, const StaticOrder& S, const Epi& E) {
    int tid = threadIdx.x; asm volatile("" : "+v"(tid));
    const int wid = __builtin_amdgcn_readfirstlane(tid >> 6), lane = tid & 63, wr = wid >> 2, wc = wid & 3, fr = lane & 15, fq = lane >> 4;
    const int K = g.K, nt = K / BK;
    unsigned voffA[2], voffB[2], voffB1[2];
#pragma unroll
    for (int i = 0; i < 2; ++i) { int R, C; stage_rc(tid * 16 + i * 8192, R, C); const int Rb = Epi::PERM ? ((R & ~31) + perm32(R & 31)) : R;
        voffA[i] = (unsigned)(R * K + C) * 2u;
        if constexpr (Epi::PERM16) {
            const int c0 = 64 * (R >> 5) + 16 * ((R >> 2) & 3) + 4 * ((R >> 4) & 1) + (R & 3);
            voffB[i] = (unsigned)(c0 * K + C) * 2u; voffB1[i] = (unsigned)((c0 + 8) * K + C) * 2u;
        } else { voffB[i] = (unsigned)(Rb * K + C) * 2u; voffB1[i] = voffB[i]; } }
    const size_t kstep = (size_t)(BK * 2);
    const size_t hstep = (size_t)HALF * K * 2;
    const size_t tstep = 2 * hstep;
    const size_t hoff = Epi::PERM16 ? 0 : hstep;
    const unsigned ldsw = (unsigned)wid * 1024u;
    const int aoff = lds_byte(wr * 64 + fr, fq * 8), boff = lds_byte(wc * 32 + fr, fq * 8);
#define PG8_SA(b, h) (((b) * 2 + (h)) * HTB)
#define PG8_SB(b, h) ((4 + (b) * 2 + (h)) * HTB)
#define PG8_STAGE(bufoff, gbase, voff) do { _Pragma("unroll") for (int _i = 0; _i < 2; ++_i) \
        __builtin_amdgcn_global_load_lds((const unsigned*)((const char*)(gbase) + (voff)[_i]), (LAS unsigned*)(lds + (bufoff) + ldsw + _i * 8192), 16, 0, 0); } while (0)
#define PG8_LDA(dst, b, h) do { _Pragma("unroll") for (int m = 0; m < 4; ++m) _Pragma("unroll") for (int k = 0; k < 2; ++k) dst[m][k] = *(const LAS bf16x8*)(lds + PG8_SA(b, h) + aoff + m * 2048 + k * 1024); } while (0)
#define PG8_LDB(dst, b, h) do { _Pragma("unroll") for (int n = 0; n < 2; ++n) _Pragma("unroll") for (int k = 0; k < 2; ++k) dst[n][k] = *(const LAS bf16x8*)(lds + PG8_SB(b, h) + boff + n * 2048 + k * 1024); } while (0)
#define PG8_MMA(ai, bj, At, Bt) do { __builtin_amdgcn_s_setprio(1); _Pragma("unroll") for (int m = 0; m < 4; ++m) _Pragma("unroll") for (int n = 0; n < 2; ++n) _Pragma("unroll") for (int k = 0; k < 2; ++k) \
        acc[ai][bj][m][n] = SWAP ? __builtin_amdgcn_mfma_f32_16x16x32_bf16(At[m][k], Bt[n][k], acc[ai][bj][m][n], 0, 0, 0) \
                                 : __builtin_amdgcn_mfma_f32_16x16x32_bf16(Bt[n][k], At[m][k], acc[ai][bj][m][n], 0, 0, 0); __builtin_amdgcn_s_setprio(0); } while (0)
#define PG8_WAIT_V(n) asm volatile("s_waitcnt vmcnt(" #n ")" ::: "memory")
#define PG8_WAIT_L(n) asm volatile("s_waitcnt lgkmcnt(" #n ")" ::: "memory")
#define PG8_BAR __builtin_amdgcn_s_barrier()
#define PG8_SCHED __builtin_amdgcn_sched_barrier(0)
    Unit cur, nxt; int ui = 0;
    if (!S.next(0, cur)) return;
    f32x4 acc[2][2][4][2];
#pragma unroll
    for (int a = 0; a < 2; ++a)
#pragma unroll
        for (int b = 0; b < 2; ++b)
#pragma unroll
            for (int m = 0; m < 4; ++m)
#pragma unroll
                for (int n = 0; n < 2; ++n) acc[a][b][m][n] = (f32x4){0.f, 0.f, 0.f, 0.f};
    bf16x8 At[4][2], B0[2][2], B1[2][2];
    const char* cA = (const char*)g.A + (size_t)cur.pm * tstep; const char* cB = (const char*)g.Bt + (size_t)cur.pn * tstep;
    PG8_STAGE(PG8_SB(0, 0), cB, voffB); PG8_STAGE(PG8_SA(0, 0), cA, voffA); PG8_STAGE(PG8_SB(0, 1), cB + hoff, voffB1); PG8_STAGE(PG8_SA(0, 1), cA + hstep, voffA);
    if (wr == 1) PG8_BAR;
    PG8_WAIT_V(4); PG8_BAR;
    PG8_STAGE(PG8_SB(1, 0), cB + kstep, voffB); PG8_STAGE(PG8_SA(1, 0), cA + kstep, voffA); PG8_STAGE(PG8_SB(1, 1), cB + hoff + kstep, voffB1);
    PG8_WAIT_V(6); PG8_BAR;
    for (;;) {
        const bool has_next = S.next(ui + 1, nxt);
        const char* nA = has_next ? (const char*)g.A + (size_t)nxt.pm * tstep : cA; const char* nB = has_next ? (const char*)g.Bt + (size_t)nxt.pn * tstep : cB;
        for (int t = 0; t < nt; t += 2) {
            const bool last = (t == nt - 2);
            const char* a1 = cA + (size_t)(t + 1) * kstep;
            const char* a2 = last ? nA : cA + (size_t)(t + 2) * kstep; const char* b2 = last ? nB : cB + (size_t)(t + 2) * kstep;
            const char* a3 = a2 + kstep; const char* b3 = b2 + kstep;
            PG8_LDB(B0, 0, 0); PG8_SCHED; PG8_LDA(At, 0, 0); PG8_STAGE(PG8_SA(1, 1), a1 + hstep, voffA);
            PG8_WAIT_L(8); PG8_BAR; PG8_WAIT_L(0); PG8_MMA(0, 0, At, B0); PG8_BAR; PG8_SCHED;
            PG8_LDB(B1, 0, 1); PG8_STAGE(PG8_SB(0, 0), b2, voffB);
            PG8_BAR; PG8_WAIT_L(0); PG8_MMA(0, 1, At, B1); PG8_BAR;
            PG8_LDA(At, 0, 1); PG8_STAGE(PG8_SA(0, 0), a2, voffA);
            PG8_BAR; PG8_WAIT_L(0); PG8_MMA(1, 0, At, B0); PG8_BAR; PG8_SCHED;
            PG8_STAGE(PG8_SB(0, 1), b2 + hoff, voffB1);
            PG8_WAIT_V(6); PG8_BAR; PG8_MMA(1, 1, At, B1); PG8_BAR;
            PG8_LDB(B0, 1, 0); PG8_SCHED; PG8_LDA(At, 1, 0); PG8_STAGE(PG8_SA(0, 1), a2 + hstep, voffA);
            PG8_WAIT_L(8); PG8_BAR; PG8_WAIT_L(0); PG8_MMA(0, 0, At, B0); PG8_BAR; PG8_SCHED;
            PG8_LDB(B1, 1, 1); PG8_STAGE(PG8_SB(1, 0), b3, voffB);
            PG8_BAR; PG8_WAIT_L(0); PG8_MMA(0, 1, At, B1); PG8_BAR;
            PG8_LDA(At, 1, 1); PG8_STAGE(PG8_SA(1, 0), a3, voffA);
            PG8_BAR; PG8_WAIT_L(0); PG8_MMA(1, 0, At, B0); PG8_BAR; PG8_SCHED;
            PG8_STAGE(PG8_SB(1, 1), b3 + hoff, voffB1);
            PG8_WAIT_V(6); PG8_BAR; PG8_MMA(1, 1, At, B1); PG8_BAR;
        }
        if constexpr (!Epi::AFTER_DRAIN) E(acc, cur, wr, wc, fr, fq);
        if (!has_next) break;
#pragma unroll
        for (int a = 0; a < 2; ++a)
#pragma unroll
            for (int b = 0; b < 2; ++b)
#pragma unroll
                for (int m = 0; m < 4; ++m)
#pragma unroll
                    for (int n = 0; n < 2; ++n) acc[a][b][m][n] = (f32x4){0.f, 0.f, 0.f, 0.f};
        cur = nxt; cA = nA; cB = nB; ++ui;
    }
    PG8_WAIT_V(0);
    if (wr == 0) PG8_BAR;
    PG8_BAR;
    if constexpr (Epi::AFTER_DRAIN) E.fused(acc, cur, wr, wc, fr, fq);
#undef PG8_SA
#undef PG8_SB
#undef PG8_STAGE
#undef PG8_LDA
#undef PG8_LDB
#undef PG8_MMA
#undef PG8_WAIT_V
#undef PG8_WAIT_L
#undef PG8_BAR
#undef PG8_SCHED
}
}

DI int win_src_col(int n0) {
    if (n0 < 2048) return n0;
    if (n0 < 2560) return 2056 + (n0 - 2048);
    if (n0 < 3072) return 3592 + (n0 - 2560);
    if (n0 < 3584) return 2568 + (n0 - 3072);
    return 3080 + (n0 - 3584);
}
DI void phase_prep(const Params& p, LAS unsigned char* lds) {
    int tid = threadIdx.x; asm volatile("" : "+v"(tid));
    const int lane = tid & 63, wid = tid >> 6;
    if (blockIdx.x == 0 && wid == 0) {
        float a = p.lq1[lane] * p.lk1[lane], b = p.lq2[lane] * p.lk2[lane];
        a = wave_sum(a); b = wave_sum(b);
        if (lane == 0) { *(float*)(p.ws + OFF_MISC) = expf(a) - expf(b) + 0.2f; *(unsigned*)(p.ws + OFF_MISC + 4) = 0u; *(unsigned*)(p.ws + OFF_MISC + 8) = 0u; *(unsigned*)(p.ws + OFF_MISC + 12) = 0u; }
    }
    bf16_t* hb = (bf16_t*)(p.ws + OFF_HB);
    float* gbga = (float*)(p.ws + OFF_GBGA);
    const int gw = blockIdx.x * 8 + wid, nw = gridDim.x * 8;
    {
        f32x4 nwv[4]; float wq[16][8];
#pragma unroll
        for (int i = 0; i < 4; ++i) {
            nwv[i] = ((const f32x4*)p.norm_w)[lane + 64 * i];
#pragma unroll
            for (int e = 0; e < 4; ++e) {
                const int k = 4 * (lane + 64 * i) + e;
                const f32x4* wp = (const f32x4*)(p.w_in + (size_t)k * 4104 + 2048);
                const f32x4 w0 = wp[0], w1 = wp[1];
#pragma unroll
                for (int j = 0; j < 4; ++j) { wq[4 * i + e][j] = nwv[i][e] * w0[j]; wq[4 * i + e][4 + j] = nwv[i][e] * w1[j]; }
            }
        }
        const bool b5 = (lane & 32) != 0, b4 = (lane & 16) != 0, b3 = (lane & 8) != 0;
        const int col = (b5 ? 4 : 0) + (b4 ? 2 : 0) + (b3 ? 1 : 0);
        int row = gw;
        f32x4 v[4];
        if (row < MTOK) {
#pragma unroll
            for (int i = 0; i < 4; ++i) v[i] = __builtin_nontemporal_load((const f32x4*)(p.x + (size_t)row * DM) + lane + 64 * i);
        }
#pragma unroll 1
        for (; row < MTOK; row += nw) {
            f32x4 vnx[4];
            const int rnx = (row + nw < MTOK) ? row + nw : row;
#pragma unroll
            for (int i = 0; i < 4; ++i) vnx[i] = __builtin_nontemporal_load((const f32x4*)(p.x + (size_t)rnx * DM) + lane + 64 * i);
            float ss = 0.f, a8[8];
#pragma unroll
            for (int j = 0; j < 8; ++j) a8[j] = 0.f;
#pragma unroll
            for (int i = 0; i < 4; ++i)
#pragma unroll
                for (int e = 0; e < 4; ++e) {
                    ss += v[i][e] * v[i][e];
#pragma unroll
                    for (int j = 0; j < 8; ++j) a8[j] += v[i][e] * wq[4 * i + e][j];
                }
            ss = wave_sum(ss);
            const float rstd = rsqrtf(ss * (1.0f / DM) + EPS);
#pragma unroll
            for (int i = 0; i < 4; ++i) {
                const f32x4 h = v[i] * rstd * nwv[i];
                u32x2 w; w.x = pk_bf16(h[0], h[1]); w.y = pk_bf16(h[2], h[3]);
                *(u32x2*)(hb + (size_t)row * DM + 4 * (lane + 64 * i)) = w;
            }
            float c4[4], c2[2], c1;
#pragma unroll
            for (int j = 0; j < 4; ++j) { const float send = b5 ? a8[j] : a8[4 + j], keep = b5 ? a8[4 + j] : a8[j]; c4[j] = keep + __shfl_xor(send, 32); }
#pragma unroll
            for (int j = 0; j < 2; ++j) { const float send = b4 ? c4[j] : c4[2 + j], keep = b4 ? c4[2 + j] : c4[j]; c2[j] = keep + __shfl_xor(send, 16); }
            { const float send = b3 ? c2[0] : c2[1], keep = b3 ? c2[1] : c2[0]; c1 = keep + __shfl_xor(send, 8); }
            c1 += __shfl_xor(c1, 4); c1 += __shfl_xor(c1, 2); c1 += __shfl_xor(c1, 1);
            if ((lane & 7) == 0) gbga[(size_t)row * 8 + col] = c1 * rstd;
#pragma unroll
            for (int i = 0; i < 4; ++i) v[i] = vnx[i];
        }
    }
    LAS float* tl = (LAS float*)lds;
    for (int tile = blockIdx.x; tile < 1024 + 256; tile += gridDim.x) {
        const float* src; int ld, n0, k0, srcn0; bf16_t* dst;
        if (tile < 1024) { n0 = (tile >> 4) * 64; k0 = (tile & 15) * 64; srcn0 = win_src_col(n0); src = p.w_in; ld = 4104; dst = (bf16_t*)(p.ws + OFF_WINT); }
        else { const int t2 = tile - 1024; n0 = (t2 >> 4) * 64; k0 = (t2 & 15) * 64; srcn0 = n0; src = p.w_out; ld = 1024; dst = (bf16_t*)(p.ws + OFF_WOUTT); }
        const int kk = tid >> 4, n4 = tid & 15;
#pragma unroll
        for (int ps = 0; ps < 2; ++ps) { const int k = kk + 32 * ps;
            const f32x4 v = *(const f32x4*)(src + (size_t)(k0 + k) * ld + srcn0 + 4 * n4);
#pragma unroll
            for (int e = 0; e < 4; ++e) tl[k * 65 + 4 * n4 + e] = v[e]; }
        __syncthreads();
        { const int n = tid >> 3, k8 = tid & 7; float f[8];
#pragma unroll
            for (int e = 0; e < 8; ++e) f[e] = tl[(8 * k8 + e) * 65 + n];
            u32x4 w; w.x = pk_bf16(f[0], f[1]); w.y = pk_bf16(f[2], f[3]); w.z = pk_bf16(f[4], f[5]); w.w = pk_bf16(f[6], f[7]);
            *(u32x4*)(dst + (size_t)(n0 + n) * 1024 + k0 + 8 * k8) = w; }
        __syncthreads();
    }
}

constexpr int AT_KB = 8192, AT_VB = 16384, AT_BUF = AT_KB + AT_VB, AT_NBUF = 3, AT_TASK = AT_NBUF * AT_BUF, AT_O1 = AT_TASK + 256;

DI void attn_qblock(const Params& p, LAS unsigned char* lds, int b, int hh, int qb, float lam) {
    int tid = threadIdx.x; asm volatile("" : "+v"(tid));
    const int lane = tid & 63, wid = __builtin_amdgcn_readfirstlane(tid >> 6);
    const bf16_t* P1 = (const bf16_t*)(p.ws + OFF_P1);
    const bf16_t* VT = (const bf16_t*)(p.ws + OFF_VT) + (size_t)(b * 4 + hh) * 32 * 128 * 64;
    const bf16_t* KX = (const bf16_t*)(p.ws + OFF_KX) + (size_t)(b * 4 + hh) * 2 * 2048 * 64;
    bf16_t* mix = (bf16_t*)(p.ws + OFF_HB);
    const int q0 = qb * 256 + wid * 32;
    const size_t tokbase = (size_t)b * SEQ;
    const int nkt = (qb + 1) * 4;
    const float sl2 = exp2f(-2.0f * (float)(hh + 1)) * LOG2E;
    const float c1 = 0.125f * LOG2E;
#pragma unroll 1
    for (int map = 0; map < 2; ++map) {
        f32x16 O[4];
#pragma unroll
        for (int mt = 0; mt < 4; ++mt)
#pragma unroll
            for (int i = 0; i < 16; ++i) O[mt][i] = 0.f;
        float m = -INFINITY, l = 0.f;
        int lane_m = lane; asm volatile("" : "+v"(lane_m));
        const int r = lane_m & 31, h2 = lane_m >> 5;
        int foff[4];
#pragma unroll
        for (int k = 0; k < 4; ++k) foff[k] = r * 128 + (((2 * k + h2) ^ ((r >> 1) & 7)) << 4);
        float kb[16];
#pragma unroll
        for (int i = 0; i < 16; ++i) kb[i] = sl2 * (float)crow(i, h2);
        const int krow_ = 8 * wid + (lane_m >> 3), vrow0 = 16 * wid + (lane_m >> 3), vrow1 = vrow0 + 8;
        const bf16_t* kgp = KX + ((size_t)map * 2048 + krow_) * 64 + (((lane_m & 7) ^ ((krow_ >> 1) & 7)) * 8);
        const bf16_t* vgp0 = VT + (size_t)vrow0 * 64 + (((lane_m & 7) ^ ((vrow0 >> 1) & 7)) * 8);
        const bf16_t* vgp1 = VT + (size_t)vrow1 * 64 + (((lane_m & 7) ^ ((vrow1 >> 1) & 7)) * 8);
#define AT_STAGE(bufi, tile) do { LAS unsigned char* _b = lds + (bufi) * AT_BUF; \
            __builtin_amdgcn_global_load_lds((const unsigned*)(kgp + (size_t)(tile) * 64 * 64), (LAS unsigned*)(_b + wid * 1024), 16, 0, 0); \
            __builtin_amdgcn_global_load_lds((const unsigned*)(vgp0 + (size_t)(tile) * 128 * 64), (LAS unsigned*)(_b + AT_KB + wid * 2048), 16, 0, 0); \
            __builtin_amdgcn_global_load_lds((const unsigned*)(vgp1 + (size_t)(tile) * 128 * 64), (LAS unsigned*)(_b + AT_KB + wid * 2048 + 1024), 16, 0, 0); } while (0)
        bf16x8 qf[4];
        { const bf16_t* qp = P1 + (tokbase + q0 + (lane_m & 31)) * NP1 + C_DQ + hh * 128 + map * 64 + 8 * (lane_m >> 5);
#pragma unroll
            for (int ks = 0; ks < 4; ++ks) qf[ks] = *(const bf16x8*)(qp + 16 * ks); }
        AT_STAGE(0, 0);
        AT_STAGE(1, 1);
        asm volatile("" : "+v"(qf[0]), "+v"(qf[1]), "+v"(qf[2]), "+v"(qf[3]));
        int cb = 0;
#pragma unroll 1
        for (int kt = 0; kt < nkt; ++kt) {
            asm volatile("s_waitcnt vmcnt(0)" ::: "memory");
            __builtin_amdgcn_s_barrier();
            asm volatile("" ::: "memory");
            if (kt + 2 < nkt) { const int nb = cb == 0 ? 2 : cb - 1; AT_STAGE(nb, kt + 2); }
            const LAS unsigned char* cur = lds + cb * AT_BUF;
            cb = cb == 2 ? 0 : cb + 1;
            const int k0 = kt * 64;
            if (k0 <= q0) {
                const bool sub1 = (k0 + 32 <= q0);
                const LAS unsigned char* vb = cur + AT_KB;
                bf16x8 kf[8];
#pragma unroll
                for (int ks = 0; ks < 4; ++ks) kf[ks] = *(const LAS bf16x8*)(cur + foff[ks]);
                if (sub1) {
#pragma unroll
                    for (int ks = 0; ks < 4; ++ks) kf[4 + ks] = *(const LAS bf16x8*)(cur + 4096 + foff[ks]);
                }
                f32x16 s0, s1;
#pragma unroll
                for (int i = 0; i < 16; ++i) { s0[i] = 0.f; s1[i] = 0.f; }
#pragma unroll
                for (int ks = 0; ks < 4; ++ks) s0 = MFMA32(kf[ks], qf[ks], s0);
                if (sub1) {
#pragma unroll
                    for (int ks = 0; ks < 4; ++ks) s1 = MFMA32(kf[4 + ks], qf[ks], s1);
                }
                __builtin_amdgcn_sched_barrier(0);
                bf16x8 va[8];
#pragma unroll
                for (int s2 = 0; s2 < 2; ++s2)
#pragma unroll
                    for (int mt = 0; mt < 4; ++mt) va[s2 * 4 + mt] = *(const LAS bf16x8*)(vb + mt * 4096 + foff[s2]);
                __builtin_amdgcn_sched_barrier(0);
                const float off0 = sl2 * (float)(k0 - q0), off1 = off0 + 32.0f * sl2;
                const f32x2 c1v = {c1, c1};
#pragma unroll
                for (int j = 0; j < 8; ++j) {
                    const f32x2 kv = {kb[2 * j], kb[2 * j + 1]};
                    f32x2 a = {s0[2 * j], s0[2 * j + 1]}, c = {s1[2 * j], s1[2 * j + 1]};
                    a = __builtin_elementwise_fma(a, c1v, kv); c = __builtin_elementwise_fma(c, c1v, kv);
                    s0[2 * j] = a.x; s0[2 * j + 1] = a.y; s1[2 * j] = c.x; s1[2 * j + 1] = c.y;
                }
                if (k0 == q0) {
#pragma unroll
                    for (int i = 0; i < 16; ++i) if (crow(i, h2) > r) s0[i] = -INFINITY;
                }
                if (k0 + 32 == q0) {
#pragma unroll
                    for (int i = 0; i < 16; ++i) if (crow(i, h2) > r) s1[i] = -INFINITY;
                }
                float mx0 = fmaxf(s0[0], s0[1]), mx1 = fmaxf(s1[0], s1[1]);
#pragma unroll
                for (int j = 1; j < 8; ++j) { mx0 = fmaxf(fmaxf(s0[2 * j], s0[2 * j + 1]), mx0); mx1 = fmaxf(fmaxf(s1[2 * j], s1[2 * j + 1]), mx1); }
                float mx = sub1 ? fmaxf(mx0 + off0, mx1 + off1) : mx0 + off0;
                mx = xhalf_max(mx);
                if (__builtin_amdgcn_ballot_w64(mx > m + 8.0f) != 0ull) {
                    const float mn = fmaxf(m, mx);
                    const float alpha = __builtin_amdgcn_exp2f(m - mn);
                    m = mn; l *= alpha;
#pragma unroll
                    for (int mt = 0; mt < 4; ++mt)
#pragma unroll
                        for (int i = 0; i < 16; ++i) O[mt][i] *= alpha;
                }
                const float r0 = m - off0, r1 = sub1 ? m - off1 : INFINITY;
                const f32x2 r0v = {r0, r0}, r1v = {r1, r1};
                f32x2 lsv = {0.f, 0.f};
#pragma unroll
                for (int j = 0; j < 8; ++j) {
                    f32x2 a = {s0[2 * j], s0[2 * j + 1]}, c = {s1[2 * j], s1[2 * j + 1]};
                    a = a - r0v; c = c - r1v;
                    a.x = __builtin_amdgcn_exp2f(a.x); a.y = __builtin_amdgcn_exp2f(a.y); c.x = __builtin_amdgcn_exp2f(c.x); c.y = __builtin_amdgcn_exp2f(c.y);
                    lsv = lsv + a; lsv = lsv + c;
                    s0[2 * j] = a.x; s0[2 * j + 1] = a.y; s1[2 * j] = c.x; s1[2 * j + 1] = c.y;
                }
                l += lsv.x + lsv.y;
                bf16x8 pf[4];
#pragma unroll
                for (int s = 0; s < 2; ++s) { pf[s] = pack8(s0, s); pf[2 + s] = pack8(s1, s); }
                __builtin_amdgcn_sched_barrier(0);
                bf16x8 vc[4], vd[4];
                if (sub1) {
#pragma unroll
                    for (int mt = 0; mt < 4; ++mt) vc[mt] = *(const LAS bf16x8*)(vb + mt * 4096 + foff[2]);
                }
#pragma unroll
                for (int mt = 0; mt < 4; ++mt) O[mt] = MFMA32(va[mt], pf[0], O[mt]);
                if (sub1) {
#pragma unroll
                    for (int mt = 0; mt < 4; ++mt) vd[mt] = *(const LAS bf16x8*)(vb + mt * 4096 + foff[3]);
                }
#pragma unroll
                for (int mt = 0; mt < 4; ++mt) O[mt] = MFMA32(va[4 + mt], pf[1], O[mt]);
                if (sub1) {
#pragma unroll
                    for (int mt = 0; mt < 4; ++mt) O[mt] = MFMA32(vc[mt], pf[2], O[mt]);
#pragma unroll
                    for (int mt = 0; mt < 4; ++mt) O[mt] = MFMA32(vd[mt], pf[3], O[mt]);
                }
            }
        }
        asm volatile("" ::: "memory");
        __builtin_amdgcn_s_barrier();
        asm volatile("" ::: "memory");
#undef AT_STAGE
        const float lt = xhalf_sum(l);
        int lane_o = lane; asm volatile("" : "+v"(lane_o));
        LAS unsigned* o1l = (LAS unsigned*)(lds + AT_O1 + wid * 8192) + lane_o;
        if (map == 0) {
            const float inv1 = 1.0f / lt;
#pragma unroll
            for (int mt = 0; mt < 4; ++mt)
#pragma unroll
                for (int j = 0; j < 8; ++j) o1l[(mt * 8 + j) * 64] = pk_bf16(O[mt][2 * j] * inv1, O[mt][2 * j + 1] * inv1);
        } else {
            const float inv2 = lam / lt;
            float ss = 0.f;
#pragma unroll
            for (int mt = 0; mt < 4; ++mt)
#pragma unroll
                for (int j = 0; j < 8; ++j) {
                    const unsigned o1 = o1l[(mt * 8 + j) * 64];
                    const float a = bf_lo(o1) - O[mt][2 * j] * inv2, c = bf_hi(o1) - O[mt][2 * j + 1] * inv2;
                    O[mt][2 * j] = a; O[mt][2 * j + 1] = c; ss += a * a + c * c;
                }
            ss = xhalf_sum(ss);
            const float rs = rsqrtf(ss * (1.0f / 128.0f) + EPS) * 0.8f;
#pragma unroll
            for (int mt = 0; mt < 4; ++mt)
#pragma unroll
                for (int j = 0; j < 8; ++j) o1l[(mt * 8 + j) * 64] = pk_bf16(O[mt][2 * j] * rs, O[mt][2 * j + 1] * rs);
            __builtin_amdgcn_wave_barrier();
            int lane_e = lane; asm volatile("" : "+v"(lane_e));
            const int dvg = lane_e & 15, qs = lane_e >> 4;
            const f32x4 nw0 = *(const f32x4*)(p.diff_norm_w + 8 * dvg), nw1 = *(const f32x4*)(p.diff_norm_w + 8 * dvg + 4);
            const LAS unsigned* ob = (const LAS unsigned*)(lds + AT_O1 + wid * 8192);
            const int slot = (dvg >> 2) * 8 + 2 * (dvg & 3);
            u32x4 dzv[8];
#pragma unroll
            for (int it = 0; it < 8; ++it) dzv[it] = *(const u32x4*)(P1 + (tokbase + q0 + it * 4 + qs) * NP1 + C_DZ + hh * 128 + 8 * dvg);
#pragma unroll
            for (int it = 0; it < 8; ++it) {
                const int q = it * 4 + qs; const size_t row = tokbase + q0 + q;
                const unsigned u0 = ob[slot * 64 + q], u1 = ob[(slot + 1) * 64 + q], u2 = ob[slot * 64 + q + 32], u3 = ob[(slot + 1) * 64 + q + 32];
                const u32x4 dz = dzv[it];
                u32x4 w;
                w.x = pk_bf16(bf_lo(u0) * nw0[0] * silu_f(bf_lo(dz.x)), bf_hi(u0) * nw0[1] * silu_f(bf_hi(dz.x)));
                w.y = pk_bf16(bf_lo(u1) * nw0[2] * silu_f(bf_lo(dz.y)), bf_hi(u1) * nw0[3] * silu_f(bf_hi(dz.y)));
                w.z = pk_bf16(bf_lo(u2) * nw1[0] * silu_f(bf_lo(dz.z)), bf_hi(u2) * nw1[1] * silu_f(bf_hi(dz.z)));
                w.w = pk_bf16(bf_lo(u3) * nw1[2] * silu_f(bf_lo(dz.w)), bf_hi(u3) * nw1[3] * silu_f(bf_hi(dz.w)));
                *(u32x4*)(mix + row * DM + 512 + hh * 128 + 8 * dvg) = w;
            }
            __builtin_amdgcn_wave_barrier();
        }
    }
}

DI void phase_attn(const Params& p, LAS unsigned char* lds, int rep) {
    const float lam = *(const float*)(p.ws + OFF_MISC);
    unsigned* counter = (unsigned*)(p.ws + OFF_MISC + 4 + 4 * rep);
    LAS int* tslot = (LAS int*)(lds + AT_TASK);
    for (;;) {
        if (threadIdx.x == 0) *tslot = (int)atomicAdd(counter, 1u);
        __syncthreads();
        const int t = *tslot;
        __syncthreads();
        if (t >= 512) break;
        const int qb = 7 - (t >> 6), bh = t & 63;
        attn_qblock(p, lds, bh >> 2, bh & 3, qb, lam);
    }
}


constexpr int G_QN = 0, G_KN = 17408, G_VB = 34816, G_KBG = 52224, G_M = 69632, G_T = 86016, G_SM = 95232;
DI bf16x8 tr_pair(const LAS unsigned char* lo_addr, int hi_off) {
    const s16x4 lo = __builtin_amdgcn_ds_read_tr16_b64_v4i16((LAS s16x4*)(lo_addr));
    const s16x4 hi = __builtin_amdgcn_ds_read_tr16_b64_v4i16((LAS s16x4*)(lo_addr + hi_off));
    return __builtin_shufflevector(lo, hi, 0, 1, 2, 3, 4, 5, 6, 7);
}
DI bf16_t bf16_1(float v) { return (bf16_t)(pk_bf16(v, 0.f) & 0xffffu); }

DI void gdn_gates(const Params& p, LAS float* sm, int c2, int lane) {
    const int b = c2 >> 7, hh = (c2 >> 5) & 3, n = c2 & 31;
    const size_t tok0 = (size_t)b * SEQ + (size_t)n * 64;
    const float* gg = (const float*)(p.ws + OFF_GBGA) + (tok0 + lane) * 8;
    const float gbv = gg[hh], gav = gg[4 + hh];
    const float beta = 1.0f / (1.0f + expf(-gbv));
    const float xs = gav + p.dt_bias[hh];
    const float sp = fmaxf(xs, 0.f) + log1pf(expf(-fabsf(xs)));
    float gc = -expf(p.a_log[hh]) * sp;
#pragma unroll
    for (int o = 1; o < 64; o <<= 1) { const float t = __shfl_up(gc, o); if (lane >= o) gc += t; }
    const float gl = __shfl(gc, 63);
    sm[lane] = beta; sm[64 + lane] = gc * LOG2E; sm[128 + lane] = expf(gc); sm[192 + lane] = expf(gl - gc);
    if (lane == 63) ((float*)(p.ws + OFF_GL))[c2] = expf(gl);
}

DI void gdn_prep(const Params& p, LAS unsigned char* lds, int c2, int c2next, int par) {
    int tid = threadIdx.x; asm volatile("" : "+v"(tid));
    const int lane = tid & 63, wid = __builtin_amdgcn_readfirstlane(tid >> 6), r = lane & 31, h2 = lane >> 5;
    const int b = c2 >> 7, hh = (c2 >> 5) & 3, n = c2 & 31;
    const size_t tok0 = (size_t)b * SEQ + (size_t)n * 64;
    const bf16_t* P1 = (const bf16_t*)(p.ws + OFF_P1);
    LAS float* sm = (LAS float*)(lds + G_SM + par * 1024);
    LAS float* Mf = (LAS float*)(lds + G_M);
    bf16_t* WN = (bf16_t*)(p.ws + OFF_WN) + (size_t)c2 * 8192;
    bf16_t* QD = (bf16_t*)(p.ws + OFF_QD) + (size_t)c2 * 8192;
    bf16_t* KD = (bf16_t*)(p.ws + OFF_KD) + (size_t)c2 * 8192;
    bf16_t* AQ = (bf16_t*)(p.ws + OFF_AQK) + (size_t)c2 * 4096;
    float* U = (float*)(p.ws + OFF_U) + (size_t)c2 * 8192;
    u32x4 raw[6][4];
#pragma unroll
    for (int i = 0; i < 6; ++i) {
        const int item = tid + 512 * i, g = item & 15, t = (item >> 4) & 63, part = i >> 1;
        const int ch = part * 512 + hh * 128 + g * 8;
#pragma unroll
        for (int j = 0; j < 4; ++j) {
            const int tt = n * 64 + t - 3 + j, ttc = tt < 0 ? 0 : tt;
            raw[i][j] = *(const u32x4*)(P1 + ((size_t)b * SEQ + ttc) * NP1 + ch);
            if (tt < 0) raw[i][j] = (u32x4){0u, 0u, 0u, 0u};
        }
    }
    float av[6][8];
#pragma unroll
    for (int i = 0; i < 6; ++i) {
        const int item = tid + 512 * i, g = item & 15, part = i >> 1;
        const int ch = part * 512 + hh * 128 + g * 8;
        float a[8];
#pragma unroll
        for (int e = 0; e < 8; ++e) a[e] = 0.f;
#pragma unroll
        for (int j = 0; j < 4; ++j) {
            const f32x4 w0 = *(const f32x4*)(p.conv_w + j * 1536 + ch), w1 = *(const f32x4*)(p.conv_w + j * 1536 + ch + 4);
            const u32x4 rw = raw[i][j];
            a[0] += w0[0] * bf_lo(rw.x); a[1] += w0[1] * bf_hi(rw.x); a[2] += w0[2] * bf_lo(rw.y); a[3] += w0[3] * bf_hi(rw.y);
            a[4] += w1[0] * bf_lo(rw.z); a[5] += w1[1] * bf_hi(rw.z); a[6] += w1[2] * bf_lo(rw.w); a[7] += w1[3] * bf_hi(rw.w);
        }
        float ss = 0.f;
#pragma unroll
        for (int e = 0; e < 8; ++e) { a[e] = silu_f(a[e]); ss += a[e] * a[e]; }
        float rn = 1.0f;
        if (part < 2) {
            ss += __shfl_xor(ss, 1); ss += __shfl_xor(ss, 2); ss += __shfl_xor(ss, 4); ss += __shfl_xor(ss, 8);
            rn = rsqrtf(ss + 1e-6f) * (part == 0 ? 0.08838834764831845f : 1.0f);
        }
#pragma unroll
        for (int e = 0; e < 8; ++e) av[i][e] = a[e] * rn;
    }
#pragma unroll
    for (int i = 0; i < 6; ++i) {
        const int item = tid + 512 * i, g = item & 15, t = (item >> 4) & 63, part = i >> 1;
        const float* a = av[i];
        const float beta = sm[t], egc = sm[128 + t], ekd = sm[192 + t];
        if (part < 2) {
            u32x4 w; w.x = pk_bf16(a[0], a[1]); w.y = pk_bf16(a[2], a[3]); w.z = pk_bf16(a[4], a[5]); w.w = pk_bf16(a[6], a[7]);
            *(LAS u32x4*)(lds + (part == 0 ? G_QN : G_KN) + t * 272 + g * 16) = w;
            if (part == 0) {
                u32x2 lo, hi; lo.x = pk_bf16(a[0] * egc, a[1] * egc); lo.y = pk_bf16(a[2] * egc, a[3] * egc); hi.x = pk_bf16(a[4] * egc, a[5] * egc); hi.y = pk_bf16(a[6] * egc, a[7] * egc);
                bf16_t* qd = QD + t * 128 + 16 * (g >> 1) + 4 * (g & 1);
                *(u32x2*)qd = lo; *(u32x2*)(qd + 8) = hi;
            } else {
                const float f1 = beta * egc;
                u32x4 w2; w2.x = pk_bf16(a[0] * f1, a[1] * f1); w2.y = pk_bf16(a[2] * f1, a[3] * f1); w2.z = pk_bf16(a[4] * f1, a[5] * f1); w2.w = pk_bf16(a[6] * f1, a[7] * f1);
                *(LAS u32x4*)(lds + G_KBG + t * 272 + g * 16) = w2;
                u32x4 w3; w3.x = pk_bf16(a[0] * ekd, a[1] * ekd); w3.y = pk_bf16(a[2] * ekd, a[3] * ekd); w3.z = pk_bf16(a[4] * ekd, a[5] * ekd); w3.w = pk_bf16(a[6] * ekd, a[7] * ekd);
                *(u32x4*)(KD + t * 128 + g * 8) = w3;
            }
        } else {
            u32x4 w; w.x = pk_bf16(a[0] * beta, a[1] * beta); w.y = pk_bf16(a[2] * beta, a[3] * beta); w.z = pk_bf16(a[4] * beta, a[5] * beta); w.w = pk_bf16(a[6] * beta, a[7] * beta);
            *(LAS u32x4*)(lds + G_VB + t * 272 + g * 16) = w;
        }
    }
    __syncthreads();
    {
        const int w4 = wid & 3, mt = w4 >> 1, nt = w4 & 1; const bool isqk = wid >= 4;
        if (!(mt == 0 && nt == 1)) {
            const LAS unsigned char* Ab = lds + (isqk ? G_QN : G_KN) + (32 * mt + r) * 272 + 16 * h2;
            const LAS unsigned char* Bb = lds + G_KN + (32 * nt + r) * 272 + 16 * h2;
            f32x16 X;
#pragma unroll
            for (int i = 0; i < 16; ++i) X[i] = 0.f;
#pragma unroll
            for (int ks = 0; ks < 8; ++ks) X = MFMA32(*(const LAS bf16x8*)(Ab + 32 * ks), *(const LAS bf16x8*)(Bb + 32 * ks), X);
            const int s = 32 * nt + r; const float gcs = sm[64 + s];
#pragma unroll
            for (int i = 0; i < 16; ++i) {
                const int c = 32 * mt + crow(i, h2);
                const float dec = __builtin_amdgcn_exp2f(sm[64 + c] - gcs);
                if (!isqk) Mf[c * 64 + s] = (c > s) ? sm[c] * X[i] * dec : 0.f;
                else AQ[c * 64 + perm23(s)] = bf16_1((c >= s) ? X[i] * dec : 0.f);
            }
        }
    }
    __syncthreads();
    if (wid == 0) {
        LAS bf16_t* Tb = (LAS bf16_t*)(lds + G_T);
        {
            const int c16 = lane & 15, b16 = lane >> 4;
            const LAS float* Mb = Mf + (16 * b16) * 64 + 16 * b16;
            float T[16];
#pragma unroll
            for (int i = 0; i < 16; ++i) T[i] = 0.f;
#pragma unroll
            for (int i = 0; i < 16; ++i) {
                float a0 = (i == c16) ? 1.f : 0.f, a1 = 0.f, a2 = 0.f, a3 = 0.f;
#pragma unroll
                for (int s4 = 0; s4 < (i + 3) / 4; ++s4) {
                    const f32x4 m4 = *(const LAS f32x4*)(Mb + i * 64 + 4 * s4);
                    a0 -= m4[0] * T[4 * s4]; a1 -= m4[1] * T[4 * s4 + 1]; a2 -= m4[2] * T[4 * s4 + 2]; a3 -= m4[3] * T[4 * s4 + 3];
                }
                T[i] = (a0 + a1) + (a2 + a3);
            }
#pragma unroll
            for (int i = 0; i < 16; ++i) {
                const int row = 16 * b16 + i;
                Tb[row * 72 + 16 * b16 + c16] = bf16_1(T[i]);
                if ((b16 & 1) == 0) Tb[row * 72 + 16 * b16 + 16 + c16] = 0;
                if (b16 < 2) { Tb[row * 72 + 32 + c16] = 0; Tb[row * 72 + 48 + c16] = 0; }
            }
        }
        __builtin_amdgcn_wave_barrier();
        asm volatile("s_waitcnt lgkmcnt(0)" ::: "memory");
        {
            const int qd = r >> 4, rr = r & 15;
            bf16x8 mfrag;
            { const LAS float* mp = Mf + (16 + 32 * qd + rr) * 64 + 32 * qd + 8 * h2;
              const f32x4 m0 = *(const LAS f32x4*)mp, m1 = *(const LAS f32x4*)(mp + 4);
              u32x4 aw; aw.x = pk_bf16(m0[0], m0[1]); aw.y = pk_bf16(m0[2], m0[3]); aw.z = pk_bf16(m1[0], m1[1]); aw.w = pk_bf16(m1[2], m1[3]);
              mfrag = __builtin_bit_cast(bf16x8, aw); }
            bf16x8 tfrag;
#pragma unroll
            for (int j = 0; j < 8; ++j) tfrag[j] = (short)Tb[(32 * qd + 8 * h2 + j) * 72 + 32 * qd + rr];
            bf16x8 t2frag;
            { const LAS unsigned char* tp = lds + G_T + (16 + 32 * qd + rr) * 144 + (16 + 32 * qd + 4 * h2) * 2;
              const u32x2 lo = *(const LAS u32x2*)tp, hi = *(const LAS u32x2*)(tp + 16);
              u32x4 aw; aw.x = lo.x; aw.y = lo.y; aw.z = hi.x; aw.w = hi.y; t2frag = __builtin_bit_cast(bf16x8, aw); }
            const bf16x8 zf = {0, 0, 0, 0, 0, 0, 0, 0};
            f32x16 Y1, Z1;
#pragma unroll
            for (int i = 0; i < 16; ++i) { Y1[i] = 0.f; Z1[i] = 0.f; }
#pragma unroll
            for (int ks = 0; ks < 2; ++ks) Y1 = MFMA32(qd == ks ? mfrag : zf, qd == ks ? tfrag : zf, Y1);
#pragma unroll
            for (int s2 = 0; s2 < 2; ++s2) Z1 = MFMA32(qd == s2 ? t2frag : zf, pack8(Y1, s2), Z1);
#pragma unroll
            for (int i = 0; i < 16; ++i) {
                const int row = crow(i, h2);
                if ((row >> 4) == qd) Tb[(16 + 32 * qd + (row & 15)) * 72 + 32 * qd + rr] = bf16_1(-Z1[i]);
            }
        }
        __builtin_amdgcn_wave_barrier();
        asm volatile("s_waitcnt lgkmcnt(0)" ::: "memory");
        const int i16 = lane & 15, q = i16 >> 2, pp = i16 & 3, blk = (lane >> 4) & 1;
        f32x16 Y;
#pragma unroll
        for (int i = 0; i < 16; ++i) Y[i] = 0.f;
#pragma unroll
        for (int ks = 0; ks < 2; ++ks) {
            const LAS float* mp = Mf + (32 + r) * 64 + 16 * ks + 8 * h2;
            const f32x4 m0 = *(const LAS f32x4*)mp, m1 = *(const LAS f32x4*)(mp + 4);
            u32x4 aw; aw.x = pk_bf16(m0[0], m0[1]); aw.y = pk_bf16(m0[2], m0[3]); aw.z = pk_bf16(m1[0], m1[1]); aw.w = pk_bf16(m1[2], m1[3]);
            const bf16x8 bfrag = tr_pair(lds + G_T + (16 * ks + 8 * h2 + q) * 144 + (16 * blk + 4 * pp) * 2, 4 * 144);
            Y = MFMA32(__builtin_bit_cast(bf16x8, aw), bfrag, Y);
        }
        f32x16 Z;
#pragma unroll
        for (int i = 0; i < 16; ++i) Z[i] = 0.f;
#pragma unroll
        for (int s = 0; s < 2; ++s) {
            const LAS unsigned char* tp = lds + G_T + (32 + r) * 144 + (32 + 16 * s + 4 * h2) * 2;
            const u32x2 lo = *(const LAS u32x2*)tp, hi = *(const LAS u32x2*)(tp + 16);
            u32x4 aw; aw.x = lo.x; aw.y = lo.y; aw.z = hi.x; aw.w = hi.y;
            Z = MFMA32(__builtin_bit_cast(bf16x8, aw), pack8(Y, s), Z);
        }
#pragma unroll
        for (int i = 0; i < 16; ++i) Tb[(32 + crow(i, h2)) * 72 + r] = bf16_1(-Z[i]);
    } else if (wid == 1) {
        if (c2next < 2048) gdn_gates(p, (LAS float*)(lds + G_SM + (par ^ 1) * 1024), c2next, lane);
    }
    __syncthreads();
    {
        const int mt = wid >> 2, nt = wid & 3;
        const int i16 = lane & 15, q = i16 >> 2, pp = i16 & 3, blk = (lane >> 4) & 1;
        f32x16 Xu, Xw;
#pragma unroll
        for (int i = 0; i < 16; ++i) { Xu[i] = 0.f; Xw[i] = 0.f; }
#pragma unroll
        for (int ks = 0; ks < 4; ++ks) {
            if (ks < 2 * (mt + 1)) {
                const bf16x8 af = *(const LAS bf16x8*)(lds + G_T + (32 * mt + r) * 144 + (16 * ks + 8 * h2) * 2);
                const int boff = (16 * ks + 8 * h2 + q) * 272 + (32 * nt + 16 * blk + 4 * pp) * 2;
                Xu = MFMA32(af, tr_pair(lds + G_VB + boff, 4 * 272), Xu);
                Xw = MFMA32(af, tr_pair(lds + G_KBG + boff, 4 * 272), Xw);
            }
        }
        const int d = 32 * nt + r, dp = perm23(d);
        {
            float* up = U + ((nt * 2 + mt) * 64 + lane) * 16;
#pragma unroll
            for (int k = 0; k < 4; ++k) { const f32x4 v = {Xu[4 * k], Xu[4 * k + 1], Xu[4 * k + 2], Xu[4 * k + 3]}; *(f32x4*)(up + 4 * k) = v; }
        }
#pragma unroll
        for (int i = 0; i < 16; ++i) {
            const int c = 32 * mt + crow(i, h2);
            WN[c * 128 + dp] = bf16_1(-Xw[i]);
        }
    }
    __syncthreads();
}

constexpr int S_WN = 0, S_QD = 17408, S_KD = 34816, S_AQ = 52224, S_BUF = 61440, S_STG = 2 * S_BUF;

struct GateIn { u32x4 z0, z1; };
DI void scan_gate_load(const Params& p, int tid, int b, int hh, int n, GateIn& g) {
    const int gc_ = tid >> 3, seg = tid & 7;
    const bf16_t* P1 = (const bf16_t*)(p.ws + OFF_P1);
    const size_t row = (size_t)b * SEQ + n * 64 + gc_;
    g.z0 = *(const u32x4*)(P1 + row * NP1 + C_GZ + hh * 128 + seg * 16); g.z1 = *(const u32x4*)(P1 + row * NP1 + C_GZ + hh * 128 + seg * 16 + 8);
}
DI void scan_gate(const Params& p, LAS unsigned char* lds, int tid, int b, int hh, int n, const GateIn& g) {
    const int gc_ = tid >> 3, seg = tid & 7;
    bf16_t* mix = (bf16_t*)(p.ws + OFF_HB);
    const LAS float* st = (const LAS float*)(lds + S_STG) + gc_ * 132 + seg * 16;
    f32x4 ov[4]; float ss = 0.f;
#pragma unroll
    for (int k = 0; k < 4; ++k) { ov[k] = *(const LAS f32x4*)(st + 4 * k); ss += ov[k][0] * ov[k][0] + ov[k][1] * ov[k][1] + ov[k][2] * ov[k][2] + ov[k][3] * ov[k][3]; }
    ss += __shfl_xor(ss, 1); ss += __shfl_xor(ss, 2); ss += __shfl_xor(ss, 4);
    const float rstd = rsqrtf(ss * (1.0f / 128.0f) + EPS);
    const size_t row = (size_t)b * SEQ + n * 64 + gc_;
    const u32x4 z0 = g.z0, z1 = g.z1;
    f32x4 gnw[4];
#pragma unroll
    for (int k = 0; k < 4; ++k) gnw[k] = *(const f32x4*)(p.gdn_norm_w + seg * 16 + 4 * k);
    u32x4 w0, w1;
    w0.x = pk_bf16(ov[0][0] * rstd * gnw[0][0] * silu_f(bf_lo(z0.x)), ov[0][1] * rstd * gnw[0][1] * silu_f(bf_hi(z0.x)));
    w0.y = pk_bf16(ov[0][2] * rstd * gnw[0][2] * silu_f(bf_lo(z0.y)), ov[0][3] * rstd * gnw[0][3] * silu_f(bf_hi(z0.y)));
    w0.z = pk_bf16(ov[1][0] * rstd * gnw[1][0] * silu_f(bf_lo(z0.z)), ov[1][1] * rstd * gnw[1][1] * silu_f(bf_hi(z0.z)));
    w0.w = pk_bf16(ov[1][2] * rstd * gnw[1][2] * silu_f(bf_lo(z0.w)), ov[1][3] * rstd * gnw[1][3] * silu_f(bf_hi(z0.w)));
    w1.x = pk_bf16(ov[2][0] * rstd * gnw[2][0] * silu_f(bf_lo(z1.x)), ov[2][1] * rstd * gnw[2][1] * silu_f(bf_hi(z1.x)));
    w1.y = pk_bf16(ov[2][2] * rstd * gnw[2][2] * silu_f(bf_lo(z1.y)), ov[2][3] * rstd * gnw[2][3] * silu_f(bf_hi(z1.y)));
    w1.z = pk_bf16(ov[3][0] * rstd * gnw[3][0] * silu_f(bf_lo(z1.z)), ov[3][1] * rstd * gnw[3][1] * silu_f(bf_hi(z1.z)));
    w1.w = pk_bf16(ov[3][2] * rstd * gnw[3][2] * silu_f(bf_lo(z1.w)), ov[3][3] * rstd * gnw[3][3] * silu_f(bf_hi(z1.w)));
    bf16_t* mp = mix + row * DM + hh * 128 + seg * 16;
    *(u32x4*)mp = w0; *(u32x4*)(mp + 8) = w1;
}

struct ScanRegs { u32x4 t0[4], t1[4], t2[4], t3[2]; };
DI void scan_fetch(ScanRegs& R, const bf16_t* WN, const bf16_t* QD, const bf16_t* KD, const bf16_t* AQ, int ltid) {
#pragma unroll
    for (int i = 0; i < 4; ++i) { const int pi = ltid + 256 * i; R.t0[i] = *(const u32x4*)(WN + pi * 8); R.t1[i] = *(const u32x4*)(QD + pi * 8); R.t2[i] = *(const u32x4*)(KD + pi * 8); }
#pragma unroll
    for (int i = 0; i < 2; ++i) { const int pi = ltid + 256 * i; R.t3[i] = *(const u32x4*)(AQ + pi * 8); }
}
DI void scan_put(const ScanRegs& R, LAS unsigned char* dst, int ltid) {
#pragma unroll
    for (int i = 0; i < 4; ++i) { const int pi = ltid + 256 * i, row = pi >> 4, pc = pi & 15;
        *(LAS u32x4*)(dst + S_WN + row * 272 + pc * 16) = R.t0[i]; *(LAS u32x4*)(dst + S_QD + row * 272 + pc * 16) = R.t1[i]; *(LAS u32x4*)(dst + S_KD + row * 272 + pc * 16) = R.t2[i]; }
#pragma unroll
    for (int i = 0; i < 2; ++i) { const int pi = ltid + 256 * i, row = pi >> 3, pc = pi & 7; *(LAS u32x4*)(dst + S_AQ + row * 144 + pc * 16) = R.t3[i]; }
}

DI void gdn_scan(const Params& p, LAS unsigned char* lds, int bh) {
    int tid = threadIdx.x; asm volatile("" : "+v"(tid));
    const int lane = tid & 63, wid = __builtin_amdgcn_readfirstlane(tid >> 6), r = lane & 31, h2 = lane >> 5;
    const int b = bh >> 2, hh = bh & 3;
    const bf16_t* WN = (const bf16_t*)(p.ws + OFF_WN) + (size_t)bh * 32 * 8192;
    const bf16_t* QD = (const bf16_t*)(p.ws + OFF_QD) + (size_t)bh * 32 * 8192;
    const bf16_t* KD = (const bf16_t*)(p.ws + OFF_KD) + (size_t)bh * 32 * 8192;
    const bf16_t* AQ = (const bf16_t*)(p.ws + OFF_AQK) + (size_t)bh * 32 * 4096;
    const float* U = (const float*)(p.ws + OFF_U) + (size_t)bh * 32 * 8192;
    const float* GL = (const float*)(p.ws + OFF_GL) + bh * 32;
    if (wid >= 4) {
        const int ltid = tid & 255;
        ScanRegs R;
        scan_fetch(R, WN, QD, KD, AQ, ltid); scan_put(R, lds, ltid);
        scan_fetch(R, WN + 8192, QD + 8192, KD + 8192, AQ + 4096, ltid);
#pragma unroll 1
        for (int n = 0; n < 32; ++n) {
            __syncthreads();
            GateIn gi; scan_gate_load(p, tid, b, hh, n, gi);
            if (n + 1 < 32) scan_put(R, lds + ((n + 1) & 1) * S_BUF, ltid);
            if (n + 2 < 32) scan_fetch(R, WN + (size_t)(n + 2) * 8192, QD + (size_t)(n + 2) * 8192, KD + (size_t)(n + 2) * 8192, AQ + (size_t)(n + 2) * 4096, ltid);
            __syncthreads();
            scan_gate(p, lds, tid, b, hh, n, gi);
        }
    } else {
        const int i16 = lane & 15, q4 = i16 >> 2, pp = i16 & 3, blk = (lane >> 4) & 1;
        f32x16 St[4], u[2];
#pragma unroll
        for (int k = 0; k < 4; ++k)
#pragma unroll
            for (int i = 0; i < 16; ++i) St[k][i] = 0.f;
#pragma unroll
        for (int mt = 0; mt < 2; ++mt)
#pragma unroll
            for (int k = 0; k < 4; ++k) { const f32x4 v = *(const f32x4*)(U + ((wid * 2 + mt) * 64 + lane) * 16 + 4 * k); u[mt][4 * k] = v[0]; u[mt][4 * k + 1] = v[1]; u[mt][4 * k + 2] = v[2]; u[mt][4 * k + 3] = v[3]; }
#pragma unroll 1
        for (int n = 0; n < 32; ++n) {
            LAS unsigned char* buf = lds + (n & 1) * S_BUF;
            __syncthreads();
            GateIn gi; scan_gate_load(p, tid, b, hh, n, gi);
            const float egl = GL[n];
            f32x16 vn[2], o[2];
            vn[0] = u[0]; vn[1] = u[1];
#pragma unroll
            for (int mt = 0; mt < 2; ++mt)
#pragma unroll
                for (int i = 0; i < 16; ++i) o[mt][i] = 0.f;
#pragma unroll
            for (int ks = 0; ks < 8; ++ks) {
                const bf16x8 sf = pack8(St[ks >> 1], ks & 1);
#pragma unroll
                for (int mt = 0; mt < 2; ++mt) {
                    const bf16x8 wf = *(const LAS bf16x8*)(buf + S_WN + (32 * mt + r) * 272 + (16 * ks + 8 * h2) * 2);
                    vn[mt] = MFMA32(wf, sf, vn[mt]);
                    const bf16x8 qf = *(const LAS bf16x8*)(buf + S_QD + (32 * mt + r) * 272 + (16 * ks + 8 * h2) * 2);
                    o[mt] = MFMA32(qf, sf, o[mt]);
                }
                asm volatile("" ::: "memory");
            }
            bf16x8 vf[4];
#pragma unroll
            for (int k2 = 0; k2 < 4; ++k2) vf[k2] = pack8(vn[k2 >> 1], k2 & 1);
            {
                const int nn = (n + 1 < 32) ? n + 1 : n;
                const float* up = U + (size_t)nn * 8192 + ((wid * 2) * 64 + lane) * 16;
#pragma unroll
                for (int mt = 0; mt < 2; ++mt)
#pragma unroll
                    for (int k = 0; k < 4; ++k) { const f32x4 v = *(const f32x4*)(up + mt * 1024 + 4 * k); u[mt][4 * k] = v[0]; u[mt][4 * k + 1] = v[1]; u[mt][4 * k + 2] = v[2]; u[mt][4 * k + 3] = v[3]; }
            }
#pragma unroll
            for (int mt = 0; mt < 2; ++mt)
#pragma unroll
                for (int k2 = 0; k2 < 2 * (mt + 1); ++k2) {
                    const bf16x8 af = *(const LAS bf16x8*)(buf + S_AQ + (32 * mt + r) * 144 + (16 * k2 + 8 * h2) * 2);
                    o[mt] = MFMA32(af, vf[k2], o[mt]);
                }
            {
                LAS float* st = (LAS float*)(lds + S_STG);
#pragma unroll
                for (int mt = 0; mt < 2; ++mt)
#pragma unroll
                    for (int i = 0; i < 16; ++i) st[(32 * mt + crow(i, h2)) * 132 + 32 * wid + r] = o[mt][i];
            }
#pragma unroll
            for (int kt = 0; kt < 4; ++kt) {
#pragma unroll
                for (int i = 0; i < 16; ++i) St[kt][i] *= egl;
#pragma unroll
                for (int k2 = 0; k2 < 4; ++k2) {
                    const bf16x8 kf = tr_pair(buf + S_KD + (16 * k2 + 4 * h2 + q4) * 272 + (32 * kt + 16 * blk + 4 * pp) * 2, 8 * 272);
                    St[kt] = MFMA32(kf, vf[k2], St[kt]);
                }
                asm volatile("" ::: "memory");
            }
            __syncthreads();
            scan_gate(p, lds, tid, b, hh, n, gi);
        }
    }
    __syncthreads();
}

DI void zero_mix_half(const Params& p, int half) {
    bf16_t* mix = (bf16_t*)(p.ws + OFF_HB);
    const size_t n16 = (size_t)MTOK * 64;
    for (size_t i = (size_t)blockIdx.x * 512 + threadIdx.x; i < n16; i += (size_t)gridDim.x * 512) {
        const size_t row = i >> 6, pc = i & 63;
        *(u32x4*)(mix + row * DM + half * 512 + pc * 8) = (u32x4){0u, 0u, 0u, 0u};
    }
}

DI void phase_final(const Params& p) {
    int tid = threadIdx.x; asm volatile("" : "+v"(tid));
    const int lane = tid & 63, wid = tid >> 6;
    const float* rowsq = (const float*)(p.ws + OFF_ROWSQ);
    const bf16_t* yb = (const bf16_t*)(p.ws + OFF_YB);
    const int gw = blockIdx.x * 8 + wid, nw = gridDim.x * 8;
    f32x4 fw[4];
#pragma unroll
    for (int i = 0; i < 2; ++i) { fw[2 * i] = *(const f32x4*)(p.final_norm_w + 512 * i + 8 * lane); fw[2 * i + 1] = *(const f32x4*)(p.final_norm_w + 512 * i + 8 * lane + 4); }
#pragma unroll 1
    for (int row0 = gw; row0 < MTOK; row0 += 4 * nw) {
        u32x4 y[4][2]; float sq[4];
#pragma unroll
        for (int k = 0; k < 4; ++k) {
            const int row = row0 + k * nw, rc = row < MTOK ? row : row0;
#pragma unroll
            for (int i = 0; i < 2; ++i) y[k][i] = *(const u32x4*)(yb + (size_t)rc * DM + 512 * i + 8 * lane);
            sq[k] = lane < 16 ? rowsq[(size_t)rc * 16 + lane] : 0.f;
        }
#pragma unroll
        for (int k = 0; k < 4; ++k) {
            const int row = row0 + k * nw;
            const float ss = wave_sum(sq[k]);
            const float rstd = rsqrtf(ss * (1.0f / DM) + EPS);
            if (row < MTOK) {
                float* o = p.out + (size_t)row * DM;
#pragma unroll
                for (int i = 0; i < 2; ++i) {
                    const f32x4 a = {bf_lo(y[k][i].x), bf_hi(y[k][i].x), bf_lo(y[k][i].y), bf_hi(y[k][i].y)}, c = {bf_lo(y[k][i].z), bf_hi(y[k][i].z), bf_lo(y[k][i].w), bf_hi(y[k][i].w)};
                    *(f32x4*)(o + 512 * i + 8 * lane) = a * rstd * fw[2 * i];
                    *(f32x4*)(o + 512 * i + 8 * lane + 4) = c * rstd * fw[2 * i + 1];
                }
            }
        }
    }
}

__global__ void __launch_bounds__(512) mega(Params p) {
    extern __shared__ __attribute__((aligned(16))) unsigned char shm[];
    LAS unsigned char* lds = (LAS unsigned char*)shm;
    cg::grid_group grid = cg::this_grid();
    volatile LAS unsigned* bst = (volatile LAS unsigned*)(lds + LDS_BYTES - 16);
    if (threadIdx.x < 2) bst[threadIdx.x] = 0u;
    __syncthreads();
    const XcdBarrier xb = xcd_barrier_post((unsigned*)(p.ws + OFF_BAR), bst);
    if (p.ws == nullptr) grid.sync();

#pragma unroll 1
    for (int rep = 0; rep < REP_PREP; ++rep) phase_prep(p, lds);
    xcd_barrier(xb);
#pragma unroll 1
    for (int rep = 0; rep < REP_G1; ++rep)
    {
        pg8::Gemm g{(const bf16_t*)(p.ws + OFF_HB), (const bf16_t*)(p.ws + OFF_WINT), MTOK, NG1, DM};
        pg8::StaticOrder S; S.init(g.M, g.N, (int)gridDim.x, (int)blockIdx.x);
        pg8::EpiP1 E{(bf16_t*)(p.ws + OFF_P1), NP1, (bf16_t*)(p.ws + OFF_KX)};
        pg8::gemm_phase<pg8::EpiP1, false>(lds, g, S, E);
        pg8::Gemm g2{(const bf16_t*)(p.ws + OFF_HB), (const bf16_t*)(p.ws + OFF_WINT) + (size_t)NG1 * DM, MTOK, 512, DM};
        pg8::StaticOrder S2; S2.init(g2.M, g2.N, (int)gridDim.x, (int)blockIdx.x);
        pg8::EpiVT E2{(bf16_t*)(p.ws + OFF_VT)};
        pg8::gemm_phase<pg8::EpiVT, true>(lds, g2, S2, E2);
    }
    xcd_barrier(xb);
#pragma unroll 1
    for (int rep = 0; rep < REP_GP; ++rep)
    {
        if ((threadIdx.x >> 6) == 0 && (int)blockIdx.x < 2048) gdn_gates(p, (LAS float*)(lds + G_SM), blockIdx.x, threadIdx.x & 63);
        __syncthreads();
        int par = 0;
#pragma unroll 1
        for (int c2 = blockIdx.x; c2 < 2048; c2 += gridDim.x, par ^= 1) gdn_prep(p, lds, c2, c2 + (int)gridDim.x, par);
    }
    xcd_barrier(xb);
#pragma unroll 1
    for (int rep = 0; rep < REP_P3; ++rep) {
#pragma unroll 1
        for (int r2 = 0; r2 < REP_SCAN; ++r2)
            if (blockIdx.x < 64) gdn_scan(p, lds, blockIdx.x);
#if SCAN_SYNC
        xcd_barrier(xb);
#endif
        phase_attn(p, lds, rep);
#if REP_ATTN > 1
        xcd_barrier(xb);
        phase_attn(p, lds, 2);
#endif
#if REP_P3 > 1
        xcd_barrier(xb);
#endif
    }
    xcd_barrier(xb);
#pragma unroll 1
    for (int rnd = 0; rnd < 2; ++rnd) {
        pg8::Gemm g{(const bf16_t*)(p.ws + OFF_HB), (const bf16_t*)(p.ws + OFF_WOUTT), MTOK, DM, DM};
        pg8::StaticOrder S; S.init(g.M, g.N, (int)gridDim.x, (int)blockIdx.x); S.i0 = rnd; S.imax = 1;
        pg8::EpiOutFused E{p.x, p.out, (float*)(p.ws + OFF_ROWSQ), p.final_norm_w, xb};
        pg8::Unit u0;
        if (S.next(0, u0)) pg8::gemm_phase<pg8::EpiOutFused, false>(lds, g, S, E);
        else xcd_barrier(xb);
    }
}

extern "C" void kernel_launch(void* const* d_in, const int* in_sizes, int n_in, void* d_out, int out_size, void* d_ws, size_t ws_size, hipStream_t stream) {
    static int grid = 0;
    if (grid == 0) {
        if (ws_size < WS_END) { fprintf(stderr, "kernel_launch: workspace too small (%zu < %zu)\n", ws_size, (size_t)WS_END); grid = -1; return; }
        int dev = 0, cus = 0, per_cu = 0;
        hipGetDevice(&dev);
        hipDeviceGetAttribute(&cus, hipDeviceAttributeMultiprocessorCount, dev);
        if (hipFuncSetAttribute((const void*)mega, hipFuncAttributeMaxDynamicSharedMemorySize, LDS_BYTES) != hipSuccess) { fprintf(stderr, "kernel_launch: hipFuncSetAttribute failed\n"); grid = -1; return; }
        if (hipOccupancyMaxActiveBlocksPerMultiprocessor(&per_cu, (const void*)mega, 512, LDS_BYTES) != hipSuccess || per_cu < 1) per_cu = 1;
        (void)hipGetLastError();
        grid = cus * (per_cu > 1 ? 1 : per_cu);
    }
    if (grid < 0) return;
    Params p{};
    p.x = (const float*)d_in[0]; p.norm_w = (const float*)d_in[1]; p.w_in = (const float*)d_in[2]; p.conv_w = (const float*)d_in[3];
    p.a_log = (const float*)d_in[4]; p.dt_bias = (const float*)d_in[5]; p.gdn_norm_w = (const float*)d_in[6];
    p.lq1 = (const float*)d_in[7]; p.lk1 = (const float*)d_in[8]; p.lq2 = (const float*)d_in[9]; p.lk2 = (const float*)d_in[10];
    p.diff_norm_w = (const float*)d_in[11]; p.w_out = (const float*)d_in[12]; p.final_norm_w = (const float*)d_in[13];
    p.out = (float*)d_out; p.ws = (unsigned char*)d_ws;
    if (hipMemsetAsync((unsigned char*)d_ws + OFF_BAR, 0, 16384, stream) != hipSuccess) { fprintf(stderr, "kernel_launch: hipMemsetAsync failed\n"); return; }
    void* args[] = {&p};
    hipError_t e = hipLaunchCooperativeKernel((const void*)mega, dim3(grid), dim3(512), args, LDS_BYTES, stream);
    if (e != hipSuccess) fprintf(stderr, "cooperative launch failed: %s (grid %d)\n", hipGetErrorString(e), grid);
}
```

```cpp
#include <hip/hip_runtime.h>
#include <hip/hip_cooperative_groups.h>
#include <cstdio>
namespace cg = cooperative_groups;

#ifndef ENABLE_ATTN
#define ENABLE_ATTN 1
#endif
#ifndef ENABLE_GDN
#define ENABLE_GDN 1
#endif
#ifndef REP_PREP
#define REP_PREP 1
#endif
#ifndef REP_G1
#define REP_G1 1
#endif
#ifndef REP_GP
#define REP_GP 1
#endif
#ifndef REP_P3
#define REP_P3 1
#endif
#ifndef REP_G2
#define REP_G2 1
#endif
#ifndef REP_SCAN
#define REP_SCAN 1
#endif
#ifndef SCAN_SYNC
#define SCAN_SYNC 0
#endif
#ifndef REP_ATTN
#define REP_ATTN 1
#endif

#define LAS __attribute__((address_space(3)))
#define DI __device__ __forceinline__
typedef unsigned short bf16_t;
typedef short bf16x8 __attribute__((ext_vector_type(8)));
typedef short s16x4 __attribute__((ext_vector_type(4)));
typedef float f32x2 __attribute__((ext_vector_type(2)));
typedef float f32x4 __attribute__((ext_vector_type(4)));
typedef float f32x16 __attribute__((ext_vector_type(16)));
typedef unsigned u32x2 __attribute__((ext_vector_type(2)));
typedef unsigned u32x4 __attribute__((ext_vector_type(4)));
typedef __bf16 bf16x2_t __attribute__((ext_vector_type(2)));

#define MFMA32(a, b, c) __builtin_amdgcn_mfma_f32_32x32x16_bf16((a), (b), (c), 0, 0, 0)

constexpr int NB = 16, SEQ = 2048, DM = 1024, MTOK = NB * SEQ, NP1 = 3072, NG1 = 3584;
constexpr int C_GQ = 0, C_GK = 512, C_GV = 1024, C_GZ = 1536, C_DQ = 2048, C_DZ = 2560;
constexpr float EPS = 1e-6f;
constexpr float LOG2E = 1.4426950408889634f;

constexpr size_t OFF_HB = 0;
constexpr size_t OFF_WINT = OFF_HB + (size_t)MTOK * DM * 2;
constexpr size_t OFF_WOUTT = OFF_WINT + (size_t)4096 * 1024 * 2;
constexpr size_t OFF_GBGA = OFF_WOUTT + (size_t)1024 * 1024 * 2;
constexpr size_t OFF_P1 = OFF_GBGA + (size_t)MTOK * 8 * 4;
constexpr size_t OFF_KX = OFF_P1 + (size_t)MTOK * NP1 * 2;
constexpr size_t OFF_VT = OFF_KX + (size_t)64 * 2 * 2048 * 64 * 2;
constexpr size_t OFF_WN = OFF_VT + (size_t)64 * 128 * 2048 * 2;
constexpr size_t OFF_QD = OFF_WN + (size_t)2048 * 64 * 128 * 2;
constexpr size_t OFF_KD = OFF_QD + (size_t)2048 * 64 * 128 * 2;
constexpr size_t OFF_AQK = OFF_KD + (size_t)2048 * 64 * 128 * 2;
constexpr size_t OFF_U = OFF_AQK + (size_t)2048 * 64 * 64 * 2;
constexpr size_t OFF_GL = OFF_U + (size_t)2048 * 64 * 128 * 4;
constexpr size_t OFF_ROWSQ = OFF_GL + 8192;
constexpr size_t OFF_MISC = OFF_ROWSQ + (size_t)MTOK * 16 * 4;
constexpr size_t OFF_YB = OFF_P1;
constexpr size_t OFF_BAR = OFF_MISC + 256;
constexpr size_t WS_END = OFF_BAR + 16384;

constexpr int LDS_BYTES = 156 * 1024;

struct Params {
    const float *x, *norm_w, *w_in, *conv_w, *a_log, *dt_bias, *gdn_norm_w, *lq1, *lk1, *lq2, *lk2, *diff_norm_w, *w_out, *final_norm_w;
    float* out; unsigned char* ws;
};

DI unsigned pk_bf16(float a, float b) { f32x2 v = {a, b}; bf16x2_t r = __builtin_convertvector(v, bf16x2_t); return __builtin_bit_cast(unsigned, r); }
DI float bf_lo(unsigned u) { return __uint_as_float(u << 16); }
DI float bf_hi(unsigned u) { return __uint_as_float(u & 0xffff0000u); }
DI float wave_sum(float v) {
#pragma unroll
    for (int o = 32; o; o >>= 1) v += __shfl_xor(v, o);
    return v;
}
DI float xhalf_max(float v) {
    const u32x2 r = __builtin_amdgcn_permlane32_swap(__float_as_uint(v), __float_as_uint(v), false, false);
    return fmaxf(__uint_as_float(r.x), __uint_as_float(r.y));
}
DI float xhalf_sum(float v) {
    const u32x2 r = __builtin_amdgcn_permlane32_swap(__float_as_uint(v), __float_as_uint(v), false, false);
    return __uint_as_float(r.x) + __uint_as_float(r.y);
}
DI float silu_f(float z) { return z * __builtin_amdgcn_rcpf(1.0f + __builtin_amdgcn_exp2f(-LOG2E * z)); }
DI int perm23(int t) { return (t & ~12) | ((t & 4) << 1) | ((t & 8) >> 1); }
DI int crow(int i, int h2) { return (i & 3) + 8 * (i >> 2) + 4 * h2; }
DI bf16x8 pack8(const f32x16& x, int s) {
    u32x4 w; w.x = pk_bf16(x[8 * s + 0], x[8 * s + 1]); w.y = pk_bf16(x[8 * s + 2], x[8 * s + 3]); w.z = pk_bf16(x[8 * s + 4], x[8 * s + 5]); w.w = pk_bf16(x[8 * s + 6], x[8 * s + 7]);
    return __builtin_bit_cast(bf16x8, w);
}


#define XB_TMO      128
#define XB_XCNT(j)  (256  + 64 * (j))
#define XB_XSUB(j)  (1280 + 64 * (j))
#define XB_XGEN(j)  (2304 + 64 * (j))
#define XB_TOP      3328
#define XB_TOPGEN   3392
#define XCD_BAR_WORDS 3456
#define XB_SPIN_CAP (1u << 18)
struct XcdBarrier { unsigned* bar; unsigned x; volatile LAS unsigned* st; };
DI unsigned xb_ld(unsigned* p)              { return __hip_atomic_load(p, __ATOMIC_RELAXED, __HIP_MEMORY_SCOPE_AGENT); }
DI unsigned xb_add(unsigned* p, unsigned v) { return __hip_atomic_fetch_add(p, v, __ATOMIC_RELAXED, __HIP_MEMORY_SCOPE_AGENT); }
DI unsigned xb_xcc_id() { return (unsigned)__builtin_amdgcn_s_getreg((3 << 11) | 20) & 0xFu; }
#define XB_SPIN(cond, bar) do { unsigned _sp = 0; while (cond) { __builtin_amdgcn_s_sleep(1); \
    if ((++_sp & 255u) == 0u) { if (xb_ld(&(bar)[XB_TMO])) break; if (_sp > XB_SPIN_CAP) { atomicAdd(&(bar)[XB_TMO], 1u); break; } } } } while (0)
DI XcdBarrier xcd_barrier_post(unsigned* bar, volatile LAS unsigned* st) {
    XcdBarrier b; b.bar = bar; b.x = xb_xcc_id(); b.st = st;
    if (threadIdx.x == 0) (void)xb_add(&bar[XB_XCNT(b.x)], 1u);
    return b;
}
DI void xcd_barrier_complete(unsigned* bar, unsigned x, unsigned& nloc, unsigned& nx) {
    const unsigned G = gridDim.x * gridDim.y * gridDim.z;
    unsigned sum, cnt, mine, sp = 0u;
    for (;;) {
        sum = 0u; cnt = 0u; mine = 0u;
#pragma unroll
        for (unsigned j = 0; j < 16; ++j) { const unsigned c = xb_ld(&bar[XB_XCNT(j)]); sum += c; cnt += (c > 0u) ? 1u : 0u; mine = (j == x) ? c : mine; }
        if (sum == G) break;
        __builtin_amdgcn_s_sleep(1);
        if ((++sp & 255u) == 0u) { if (xb_ld(&bar[XB_TMO])) break; if (sp > XB_SPIN_CAP) { atomicAdd(&bar[XB_TMO], 1u); break; } }
    }
    nloc = mine > 0u ? mine : 1u; nx = cnt > 0u ? cnt : 1u;
}
DI void xcd_barrier(const XcdBarrier& b) {
    asm volatile("s_waitcnt vmcnt(0)" ::: "memory");
    __syncthreads();
    if (threadIdx.x == 0) {
        unsigned* bar = b.bar;
        __builtin_amdgcn_s_waitcnt(0);
        unsigned nloc = b.st[0], nx = b.st[1];
        if (nloc == 0u) { xcd_barrier_complete(bar, b.x, nloc, nx); b.st[0] = nloc; b.st[1] = nx; }
        const unsigned old = xb_add(&bar[XB_XSUB(b.x)], 1u);
        const unsigned gen = old / nloc;
        if (old + 1u == (gen + 1u) * nloc) {
            __builtin_amdgcn_fence(__ATOMIC_RELEASE, "agent");
            asm volatile("s_waitcnt vmcnt(0)" ::: "memory");
            const unsigned og = xb_add(&bar[XB_TOP], 1u);
            const unsigned tg = og / nx;
            if (og + 1u == (tg + 1u) * nx) xb_add(&bar[XB_TOPGEN], 1u);
            else XB_SPIN(xb_ld(&bar[XB_TOPGEN]) == tg, bar);
            __builtin_amdgcn_fence(__ATOMIC_ACQUIRE, "agent");
            xb_add(&bar[XB_XGEN(b.x)], 1u);
            asm volatile("s_waitcnt vmcnt(0)" ::: "memory");
        } else {
            XB_SPIN(xb_ld(&bar[XB_XGEN(b.x)]) == gen, bar);
            __builtin_amdgcn_fence(__ATOMIC_ACQUIRE, "agent");
            asm volatile("s_waitcnt vmcnt(0)" ::: "memory");
        }
    }
    __syncthreads();
}

namespace pg8 {
constexpr int BM = 256, BK = 64, HALF = 128, HTB = HALF * BK * 2, STAGE_BYTES = 8 * HTB, NXCD = 8, WGM = 8;
DI int lds_byte(int r, int c) { const int st = (r >> 4) * 2 + (c >> 5), rr = r & 15, cc = c & 31, ob = rr * 64 + cc * 2; return st * 1024 + (ob ^ (((ob >> 9) & 1) << 5)); }
DI void stage_rc(int b, int& R, int& C) { const int st = b / 1024, sb = b % 1024, swz = sb ^ (((sb >> 9) & 1) << 5); R = (st >> 1) * 16 + swz / 64; C = (st & 1) * 32 + (swz % 64) / 2; }
DI int perm32(int rho) { const int n = rho >> 4, i = rho & 15; return 8 * (i >> 2) + 4 * n + (i & 3); }
struct Unit { int pm, pn; };
struct Gemm { const bf16_t* A; const bf16_t* Bt; int M, N, K; };
struct StaticOrder {
    int nM, nN, nwg, G, c, i0 = 0, imax = 1 << 30;
    DI void init(int M, int N, int G_, int c_) { nM = M / BM; nN = N / BM; nwg = nM * nN; G = G_; c = c_; }
    DI bool next(int i, Unit& u) const {
        if (i >= imax) return false;
        const long L = (long)(i + i0) * G + c; if (L >= nwg) return false;
        int wgid = (int)L; { const int q = nwg / NXCD, r = nwg % NXCD, xcd = wgid % NXCD, off = wgid / NXCD; wgid = (xcd < r ? xcd * (q + 1) : r * (q + 1) + (xcd - r) * q) + off; }
        const int nig = WGM * nN, gid = wgid / nig, fm = gid * WGM, gsz = (nM - fm) < WGM ? (nM - fm) : WGM;
        u.pm = fm + ((wgid % nig) % gsz); u.pn = (wgid % nig) / gsz; return true;
    }
    DI void a_ready(const Unit&) const {}
    DI void done(const Unit&) const {}
};

struct EpiP1 {
    static constexpr bool PERM = true, PERM16 = true, AFTER_DRAIN = false;
    bf16_t* O; int ldc; bf16_t* KX;
    DI void operator()(const f32x4 (&acc)[2][2][4][2], const Unit& u, int wr, int wc, int fr, int fq) const {
        const int row0 = u.pm * BM + wr * 64 + fr, col0 = u.pn * BM + wc * 64 + 16 * fq;
        if (u.pn >= 12) {
            const int c = col0 - 12 * BM, hm = c >> 6, d = c & 63;
#pragma unroll
            for (int ai = 0; ai < 2; ++ai)
#pragma unroll
                for (int m = 0; m < 4; ++m) { const int row = row0 + ai * HALF + m * 16, b = row >> 11, tok = row & 2047;
                    bf16_t* dp = KX + ((size_t)(b * 8 + hm) * 2048 + tok) * 64 + d;
#pragma unroll
                    for (int bj = 0; bj < 2; ++bj) { const f32x4 v0 = acc[ai][bj][m][0], v1 = acc[ai][bj][m][1];
                        u32x4 w; w.x = pk_bf16(v0[0], v0[1]); w.y = pk_bf16(v0[2], v0[3]); w.z = pk_bf16(v1[0], v1[1]); w.w = pk_bf16(v1[2], v1[3]);
                        *(u32x4*)(dp + 8 * bj) = w; } }
            return;
        }
#pragma unroll
        for (int ai = 0; ai < 2; ++ai)
#pragma unroll
            for (int m = 0; m < 4; ++m) { bf16_t* rowp = O + (size_t)(row0 + ai * HALF + m * 16) * ldc + col0;
#pragma unroll
                for (int bj = 0; bj < 2; ++bj) { const f32x4 v0 = acc[ai][bj][m][0], v1 = acc[ai][bj][m][1];
                    u32x4 w; w.x = pk_bf16(v0[0], v0[1]); w.y = pk_bf16(v0[2], v0[3]); w.z = pk_bf16(v1[0], v1[1]); w.w = pk_bf16(v1[2], v1[3]);
                    *(u32x4*)(rowp + 8 * bj) = w; } }
    }
};
struct EpiVT {
    static constexpr bool PERM = false, PERM16 = false, AFTER_DRAIN = false;
    bf16_t* VT;
    DI void operator()(const f32x4 (&acc)[2][2][4][2], const Unit& u, int wr, int wc, int fr, int fq) const {
#pragma unroll
        for (int ai = 0; ai < 2; ++ai)
#pragma unroll
            for (int m = 0; m < 4; ++m) {
                const int t = u.pm * BM + ai * HALF + wr * 64 + m * 16 + 4 * fq, b = t >> 11, tok = t & 2047, pos = perm23(tok);
#pragma unroll
                for (int bj = 0; bj < 2; ++bj)
#pragma unroll
                    for (int n = 0; n < 2; ++n) {
                        const int c = u.pn * BM + bj * HALF + wc * 32 + n * 16 + fr, hh = c >> 7, dv = c & 127;
                        const f32x4 v = acc[ai][bj][m][n];
                        u32x2 w; w.x = pk_bf16(v[0], v[1]); w.y = pk_bf16(v[2], v[3]);
                        *(u32x2*)(VT + (((size_t)((b * 4 + hh) * 32 + (pos >> 6)) * 128 + dv)) * 64 + (pos & 63)) = w;
                    }
            }
    }
};
static_assert(WGM == 8, "EpiOutFused needs the four column tiles of a row panel in the same round");
struct EpiOutFused {
    static constexpr bool PERM = false, PERM16 = false, AFTER_DRAIN = true;
    const float* X; float* Out; float* rowsq; const float* fw; XcdBarrier xb;
    DI void operator()(const f32x4 (&)[2][2][4][2], const Unit&, int, int, int, int) const {}
    DI void fused(f32x4 (&acc)[2][2][4][2], const Unit& u, int wr, int wc, int fr, int fq) const {
        const int row0 = u.pm * BM + wr * 64 + fr, col0 = u.pn * BM + wc * 32 + 4 * fq;
#pragma unroll
        for (int ai = 0; ai < 2; ++ai)
#pragma unroll
            for (int m = 0; m < 4; ++m) {
                const int row = row0 + ai * HALF + m * 16; float ss = 0.f;
#pragma unroll
                for (int bj = 0; bj < 2; ++bj)
#pragma unroll
                    for (int n = 0; n < 2; ++n) {
                        const size_t o = (size_t)row * DM + col0 + bj * HALF + n * 16;
                        const f32x4 y = acc[ai][bj][m][n] + *(const f32x4*)(X + o);
                        acc[ai][bj][m][n] = y; ss += y[0] * y[0] + y[1] * y[1] + y[2] * y[2] + y[3] * y[3];
                    }
                ss += __shfl_xor(ss, 16); ss += __shfl_xor(ss, 32);
                if (fq == 0) rowsq[(size_t)row * 16 + u.pn * 4 + wc] = ss;
            }
        xcd_barrier(xb);
        f32x4 fwv[2][2];
#pragma unroll
        for (int bj = 0; bj < 2; ++bj)
#pragma unroll
            for (int n = 0; n < 2; ++n) fwv[bj][n] = *(const f32x4*)(fw + col0 + bj * HALF + n * 16);
#pragma unroll
        for (int ai = 0; ai < 2; ++ai)
#pragma unroll
            for (int m = 0; m < 4; ++m) {
                const int row = row0 + ai * HALF + m * 16;
                const f32x4* rq = (const f32x4*)(rowsq + (size_t)row * 16);
                const f32x4 q0 = rq[0], q1 = rq[1], q2 = rq[2], q3 = rq[3];
                const float tot = ((q0[0] + q0[1]) + (q0[2] + q0[3])) + ((q1[0] + q1[1]) + (q1[2] + q1[3])) + ((q2[0] + q2[1]) + (q2[2] + q2[3])) + ((q3[0] + q3[1]) + (q3[2] + q3[3]));
                const float rstd = rsqrtf(tot * (1.0f / DM) + EPS);
#pragma unroll
                for (int bj = 0; bj < 2; ++bj)
#pragma unroll
                    for (int n = 0; n < 2; ++n) {
                        const size_t o = (size_t)row * DM + col0 + bj * HALF + n * 16;
                        *(f32x4*)(Out + o) = acc[ai][bj][m][n] * rstd * fwv[bj][n];
                    }
            }
    }
};

template <class Epi, bool SWAP>
DI void gemm_phase(LAS unsigned char* lds, const Gemm g, const StaticOrder& S, const Epi& E) {
    int tid = threadIdx.x; asm volatile("" : "+v"(tid));
    const int wid = __builtin_amdgcn_readfirstlane(tid >> 6), lane = tid & 63, wr = wid >> 2, wc = wid & 3, fr = lane & 15, fq = lane >> 4;
    const int K = g.K, nt = K / BK;
    unsigned voffA[2], voffB[2], voffB1[2];
#pragma unroll
    for (int i = 0; i < 2; ++i) { int R, C; stage_rc(tid * 16 + i * 8192, R, C); const int Rb = Epi::PERM ? ((R & ~31) + perm32(R & 31)) : R;
        voffA[i] = (unsigned)(R * K + C) * 2u;
        if constexpr (Epi::PERM16) {
            const int c0 = 64 * (R >> 5) + 16 * ((R >> 2) & 3) + 4 * ((R >> 4) & 1) + (R & 3);
            voffB[i] = (unsigned)(c0 * K + C) * 2u; voffB1[i] = (unsigned)((c0 + 8) * K + C) * 2u;
        } else { voffB[i] = (unsigned)(Rb * K + C) * 2u; voffB1[i] = voffB[i]; } }
    const size_t kstep = (size_t)(BK * 2);
    const size_t hstep = (size_t)HALF * K * 2;
    const size_t tstep = 2 * hstep;
    const size_t hoff = Epi::PERM16 ? 0 : hstep;
    const unsigned ldsw = (unsigned)wid * 1024u;
    const int aoff = lds_byte(wr * 64 + fr, fq * 8), boff = lds_byte(wc * 32 + fr, fq * 8);
#define PG8_SA(b, h) (((b) * 2 + (h)) * HTB)
#define PG8_SB(b, h) ((4 + (b) * 2 + (h)) * HTB)
#define PG8_STAGE(bufoff, gbase, voff) do { _Pragma("unroll") for (int _i = 0; _i < 2; ++_i) \
        __builtin_amdgcn_global_load_lds((const unsigned*)((const char*)(gbase) + (voff)[_i]), (LAS unsigned*)(lds + (bufoff) + ldsw + _i * 8192), 16, 0, 0); } while (0)
#define PG8_LDA(dst, b, h) do { _Pragma("unroll") for (int m = 0; m < 4; ++m) _Pragma("unroll") for (int k = 0; k < 2; ++k) dst[m][k] = *(const LAS bf16x8*)(lds + PG8_SA(b, h) + aoff + m * 2048 + k * 1024); } while (0)
#define PG8_LDB(dst, b, h) do { _Pragma("unroll") for (int n = 0; n < 2; ++n) _Pragma("unroll") for (int k = 0; k < 2; ++k) dst[n][k] = *(const LAS bf16x8*)(lds + PG8_SB(b, h) + boff + n * 2048 + k * 1024); } while (0)
#define PG8_MMA(ai, bj, At, Bt) do { __builtin_amdgcn_s_setprio(1); _Pragma("unroll") for (int m = 0; m < 4; ++m) _Pragma("unroll") for (int n = 0; n < 2; ++n) _Pragma("unroll") for (int k = 0; k < 2; ++k) \
        acc[ai][bj][m][n] = SWAP ? __builtin_amdgcn_mfma_f32_16x16x32_bf16(At[m][k], Bt[n][k], acc[ai][bj][m][n], 0, 0, 0) \
                                 : __builtin_amdgcn_mfma_f32_16x16x32_bf16(Bt[n][k], At[m][k], acc[ai][bj][m][n], 0, 0, 0); __builtin_amdgcn_s_setprio(0); } while (0)
#define PG8_WAIT_V(n) asm volatile("s_waitcnt vmcnt(" #n ")" ::: "memory")
#define PG8_WAIT_L(n) asm volatile("s_waitcnt lgkmcnt(" #n ")" ::: "memory")
#define PG8_BAR __builtin_amdgcn_s_barrier()
#define PG8_SCHED __builtin_amdgcn_sched_barrier(0)
    Unit cur, nxt; int ui = 0;
    if (!S.next(0, cur)) return;
    f32x4 acc[2][2][4][2];
#pragma unroll
    for (int a = 0; a < 2; ++a)
#pragma unroll
        for (int b = 0; b < 2; ++b)
#pragma unroll
            for (int m = 0; m < 4; ++m)
#pragma unroll
                for (int n = 0; n < 2; ++n) acc[a][b][m][n] = (f32x4){0.f, 0.f, 0.f, 0.f};
    bf16x8 At[4][2], B0[2][2], B1[2][2];
    const char* cA = (const char*)g.A + (size_t)cur.pm * tstep; const char* cB = (const char*)g.Bt + (size_t)cur.pn * tstep;
    PG8_STAGE(PG8_SB(0, 0), cB, voffB); PG8_STAGE(PG8_SA(0, 0), cA, voffA); PG8_STAGE(PG8_SB(0, 1), cB + hoff, voffB1); PG8_STAGE(PG8_SA(0, 1), cA + hstep, voffA);
    if (wr == 1) PG8_BAR;
    PG8_WAIT_V(4); PG8_BAR;
    PG8_STAGE(PG8_SB(1, 0), cB + kstep, voffB); PG8_STAGE(PG8_SA(1, 0), cA + kstep, voffA); PG8_STAGE(PG8_SB(1, 1), cB + hoff + kstep, voffB1);
    PG8_WAIT_V(6); PG8_BAR;
    for (;;) {
        const bool has_next = S.next(ui + 1, nxt);
        const char* nA = has_next ? (const char*)g.A + (size_t)nxt.pm * tstep : cA; const char* nB = has_next ? (const char*)g.Bt + (size_t)nxt.pn * tstep : cB;
        for (int t = 0; t < nt; t += 2) {
            const bool last = (t == nt - 2);
            const char* a1 = cA + (size_t)(t + 1) * kstep;
            const char* a2 = last ? nA : cA + (size_t)(t + 2) * kstep; const char* b2 = last ? nB : cB + (size_t)(t + 2) * kstep;
            const char* a3 = a2 + kstep; const char* b3 = b2 + kstep;
            PG8_LDB(B0, 0, 0); PG8_SCHED; PG8_LDA(At, 0, 0); PG8_STAGE(PG8_SA(1, 1), a1 + hstep, voffA);
            PG8_WAIT_L(8); PG8_BAR; PG8_WAIT_L(0); PG8_MMA(0, 0, At, B0); PG8_BAR; PG8_SCHED;
            PG8_LDB(B1, 0, 1); PG8_STAGE(PG8_SB(0, 0), b2, voffB);
            PG8_BAR; PG8_WAIT_L(0); PG8_MMA(0, 1, At, B1); PG8_BAR;
            PG8_LDA(At, 0, 1); PG8_STAGE(PG8_SA(0, 0), a2, voffA);
            PG8_BAR; PG8_WAIT_L(0); PG8_MMA(1, 0, At, B0); PG8_BAR; PG8_SCHED;
            PG8_STAGE(PG8_SB(0, 1), b2 + hoff, voffB1);
            PG8_WAIT_V(6); PG8_BAR; PG8_MMA(1, 1, At, B1); PG8_BAR;
            PG8_LDB(B0, 1, 0); PG8_SCHED; PG8_LDA(At, 1, 0); PG8_STAGE(PG8_SA(0, 1), a2 + hstep, voffA);
            PG8_WAIT_L(8); PG8_BAR; PG8_WAIT_L(0); PG8_MMA(0, 0, At, B0); PG8_BAR; PG8_SCHED;
            PG8_LDB(B1, 1, 1); PG8_STAGE(PG8_SB(1, 0), b3, voffB);
            PG8_BAR; PG8_WAIT_L(0); PG8_MMA(0, 1, At, B1); PG8_BAR;
            PG8_LDA(At, 1, 1); PG8_STAGE(PG8_SA(1, 0), a3, voffA);
            PG8_BAR; PG8_WAIT_L(0); PG8_MMA(1, 0, At, B0); PG8_BAR; PG8_SCHED;
            PG8_STAGE(PG8_SB(1, 1), b3 + hoff, voffB1);
            PG8_WAIT_V(6); PG8_BAR; PG8_MMA(1, 1, At, B1); PG8_BAR;
        }
        if constexpr (!Epi::AFTER_DRAIN) E(acc, cur, wr, wc, fr, fq);
        if (!has_next) break;
#pragma unroll
        for (int a = 0; a < 2; ++a)
#pragma unroll
            for (int b = 0; b < 2; ++b)
#pragma unroll
                for (int m = 0; m < 4; ++m)
#pragma unroll
                    for (int n = 0; n < 2; ++n) acc[a][b][m][n] = (f32x4){0.f, 0.f, 0.f, 0.f};
        cur = nxt; cA = nA; cB = nB; ++ui;
    }
    PG8_WAIT_V(0);
    if (wr == 0) PG8_BAR;
    PG8_BAR;
    if constexpr (Epi::AFTER_DRAIN) E.fused(acc, cur, wr, wc, fr, fq);
#undef PG8_SA
#undef PG8_SB
#undef PG8_STAGE
#undef PG8_LDA
#undef PG8_LDB
#undef PG8_MMA
#undef PG8_WAIT_V
#undef PG8_WAIT_L
#undef PG8_BAR
#undef PG8_SCHED
}
}

DI int win_src_col(int n0) {
    if (n0 < 2048) return n0;
    if (n0 < 2560) return 2056 + (n0 - 2048);
    if (n0 < 3072) return 3592 + (n0 - 2560);
    if (n0 < 3584) return 2568 + (n0 - 3072);
    return 3080 + (n0 - 3584);
}
DI void phase_prep(const Params& p, LAS unsigned char* lds) {
    int tid = threadIdx.x; asm volatile("" : "+v"(tid));
    const int lane = tid & 63, wid = tid >> 6;
    if (blockIdx.x == 0 && wid == 0) {
        float a = p.lq1[lane] * p.lk1[lane], b = p.lq2[lane] * p.lk2[lane];
        a = wave_sum(a); b = wave_sum(b);
        if (lane == 0) { *(float*)(p.ws + OFF_MISC) = expf(a) - expf(b) + 0.2f; *(unsigned*)(p.ws + OFF_MISC + 4) = 0u; *(unsigned*)(p.ws + OFF_MISC + 8) = 0u; *(unsigned*)(p.ws + OFF_MISC + 12) = 0u; }
    }
    bf16_t* hb = (bf16_t*)(p.ws + OFF_HB);
    float* gbga = (float*)(p.ws + OFF_GBGA);
    const int gw = blockIdx.x * 8 + wid, nw = gridDim.x * 8;
    {
        f32x4 nwv[4]; float wq[16][8];
#pragma unroll
        for (int i = 0; i < 4; ++i) {
            nwv[i] = ((const f32x4*)p.norm_w)[lane + 64 * i];
#pragma unroll
            for (int e = 0; e < 4; ++e) {
                const int k = 4 * (lane + 64 * i) + e;
                const f32x4* wp = (const f32x4*)(p.w_in + (size_t)k * 4104 + 2048);
                const f32x4 w0 = wp[0], w1 = wp[1];
#pragma unroll
                for (int j = 0; j < 4; ++j) { wq[4 * i + e][j] = nwv[i][e] * w0[j]; wq[4 * i + e][4 + j] = nwv[i][e] * w1[j]; }
            }
        }
        const bool b5 = (lane & 32) != 0, b4 = (lane & 16) != 0, b3 = (lane & 8) != 0;
        const int col = (b5 ? 4 : 0) + (b4 ? 2 : 0) + (b3 ? 1 : 0);
        int row = gw;
        f32x4 v[4];
        if (row < MTOK) {
#pragma unroll
            for (int i = 0; i < 4; ++i) v[i] = __builtin_nontemporal_load((const f32x4*)(p.x + (size_t)row * DM) + lane + 64 * i);
        }
#pragma unroll 1
        for (; row < MTOK; row += nw) {
            f32x4 vnx[4];
            const int rnx = (row + nw < MTOK) ? row + nw : row;
#pragma unroll
            for (int i = 0; i < 4; ++i) vnx[i] = __builtin_nontemporal_load((const f32x4*)(p.x + (size_t)rnx * DM) + lane + 64 * i);
            float ss = 0.f, a8[8];
#pragma unroll
            for (int j = 0; j < 8; ++j) a8[j] = 0.f;
#pragma unroll
            for (int i = 0; i < 4; ++i)
#pragma unroll
                for (int e = 0; e < 4; ++e) {
                    ss += v[i][e] * v[i][e];
#pragma unroll
                    for (int j = 0; j < 8; ++j) a8[j] += v[i][e] * wq[4 * i + e][j];
                }
            ss = wave_sum(ss);
            const float rstd = rsqrtf(ss * (1.0f / DM) + EPS);
#pragma unroll
            for (int i = 0; i < 4; ++i) {
                const f32x4 h = v[i] * rstd * nwv[i];
                u32x2 w; w.x = pk_bf16(h[0], h[1]); w.y = pk_bf16(h[2], h[3]);
                *(u32x2*)(hb + (size_t)row * DM + 4 * (lane + 64 * i)) = w;
            }
            float c4[4], c2[2], c1;
#pragma unroll
            for (int j = 0; j < 4; ++j) { const float send = b5 ? a8[j] : a8[4 + j], keep = b5 ? a8[4 + j] : a8[j]; c4[j] = keep + __shfl_xor(send, 32); }
#pragma unroll
            for (int j = 0; j < 2; ++j) { const float send = b4 ? c4[j] : c4[2 + j], keep = b4 ? c4[2 + j] : c4[j]; c2[j] = keep + __shfl_xor(send, 16); }
            { const float send = b3 ? c2[0] : c2[1], keep = b3 ? c2[1] : c2[0]; c1 = keep + __shfl_xor(send, 8); }
            c1 += __shfl_xor(c1, 4); c1 += __shfl_xor(c1, 2); c1 += __shfl_xor(c1, 1);
            if ((lane & 7) == 0) gbga[(size_t)row * 8 + col] = c1 * rstd;
#pragma unroll
            for (int i = 0; i < 4; ++i) v[i] = vnx[i];
        }
    }
    LAS float* tl = (LAS float*)lds;
    for (int tile = blockIdx.x; tile < 1024 + 256; tile += gridDim.x) {
        const float* src; int ld, n0, k0, srcn0; bf16_t* dst;
        if (tile < 1024) { n0 = (tile >> 4) * 64; k0 = (tile & 15) * 64; srcn0 = win_src_col(n0); src = p.w_in; ld = 4104; dst = (bf16_t*)(p.ws + OFF_WINT); }
        else { const int t2 = tile - 1024; n0 = (t2 >> 4) * 64; k0 = (t2 & 15) * 64; srcn0 = n0; src = p.w_out; ld = 1024; dst = (bf16_t*)(p.ws + OFF_WOUTT); }
        const int kk = tid >> 4, n4 = tid & 15;
#pragma unroll
        for (int ps = 0; ps < 2; ++ps) { const int k = kk + 32 * ps;
            const f32x4 v = __builtin_nontemporal_load((const f32x4*)(src + (size_t)(k0 + k) * ld + srcn0 + 4 * n4));
#pragma unroll
            for (int e = 0; e < 4; ++e) tl[k * 65 + 4 * n4 + e] = v[e]; }
        __syncthreads();
        { const int n = tid >> 3, k8 = tid & 7; float f[8];
#pragma unroll
            for (int e = 0; e < 8; ++e) f[e] = tl[(8 * k8 + e) * 65 + n];
            u32x4 w; w.x = pk_bf16(f[0], f[1]); w.y = pk_bf16(f[2], f[3]); w.z = pk_bf16(f[4], f[5]); w.w = pk_bf16(f[6], f[7]);
            *(u32x4*)(dst + (size_t)(n0 + n) * 1024 + k0 + 8 * k8) = w; }
        __syncthreads();
    }
}

constexpr int AT_KB = 8192, AT_VB = 16384, AT_BUF = AT_KB + AT_VB, AT_NBUF = 3, AT_TASK = AT_NBUF * AT_BUF, AT_O1 = AT_TASK + 256;

DI void attn_qblock(const Params& p, LAS unsigned char* lds, int b, int hh, int qb, float lam) {
    int tid = threadIdx.x; asm volatile("" : "+v"(tid));
    const int lane = tid & 63, wid = __builtin_amdgcn_readfirstlane(tid >> 6);
    const bf16_t* P1 = (const bf16_t*)(p.ws + OFF_P1);
    const bf16_t* VT = (const bf16_t*)(p.ws + OFF_VT) + (size_t)(b * 4 + hh) * 32 * 128 * 64;
    const bf16_t* KX = (const bf16_t*)(p.ws + OFF_KX) + (size_t)(b * 4 + hh) * 2 * 2048 * 64;
    bf16_t* mix = (bf16_t*)(p.ws + OFF_HB);
    const int q0 = qb * 256 + wid * 32;
    const size_t tokbase = (size_t)b * SEQ;
    const int nkt = (qb + 1) * 4;
    const float sl2 = exp2f(-2.0f * (float)(hh + 1)) * LOG2E;
    const float c1 = 0.125f * LOG2E;
#pragma unroll 1
    for (int map = 0; map < 2; ++map) {
        f32x16 O[4];
#pragma unroll
        for (int mt = 0; mt < 4; ++mt)
#pragma unroll
            for (int i = 0; i < 16; ++i) O[mt][i] = 0.f;
        float m = -INFINITY, l = 0.f;
        int lane_m = lane; asm volatile("" : "+v"(lane_m));
        const int r = lane_m & 31, h2 = lane_m >> 5;
        int foff[4];
#pragma unroll
        for (int k = 0; k < 4; ++k) foff[k] = r * 128 + (((2 * k + h2) ^ ((r >> 1) & 7)) << 4);
        float kb[16];
#pragma unroll
        for (int i = 0; i < 16; ++i) kb[i] = sl2 * (float)crow(i, h2);
        const int krow_ = 8 * wid + (lane_m >> 3), vrow0 = 16 * wid + (lane_m >> 3), vrow1 = vrow0 + 8;
        const bf16_t* kgp = KX + ((size_t)map * 2048 + krow_) * 64 + (((lane_m & 7) ^ ((krow_ >> 1) & 7)) * 8);
        const bf16_t* vgp0 = VT + (size_t)vrow0 * 64 + (((lane_m & 7) ^ ((vrow0 >> 1) & 7)) * 8);
        const bf16_t* vgp1 = VT + (size_t)vrow1 * 64 + (((lane_m & 7) ^ ((vrow1 >> 1) & 7)) * 8);
#define AT_STAGE(bufi, tile) do { LAS unsigned char* _b = lds + (bufi) * AT_BUF; \
            __builtin_amdgcn_global_load_lds((const unsigned*)(kgp + (size_t)(tile) * 64 * 64), (LAS unsigned*)(_b + wid * 1024), 16, 0, 0); \
            __builtin_amdgcn_global_load_lds((const unsigned*)(vgp0 + (size_t)(tile) * 128 * 64), (LAS unsigned*)(_b + AT_KB + wid * 2048), 16, 0, 0); \
            __builtin_amdgcn_global_load_lds((const unsigned*)(vgp1 + (size_t)(tile) * 128 * 64), (LAS unsigned*)(_b + AT_KB + wid * 2048 + 1024), 16, 0, 0); } while (0)
        bf16x8 qf[4];
        { const bf16_t* qp = P1 + (tokbase + q0 + (lane_m & 31)) * NP1 + C_DQ + hh * 128 + map * 64 + 8 * (lane_m >> 5);
#pragma unroll
            for (int ks = 0; ks < 4; ++ks) qf[ks] = *(const bf16x8*)(qp + 16 * ks); }
        AT_STAGE(0, 0);
        AT_STAGE(1, 1);
        asm volatile("" : "+v"(qf[0]), "+v"(qf[1]), "+v"(qf[2]), "+v"(qf[3]));
        int cb = 0;
#pragma unroll 1
        for (int kt = 0; kt < nkt; ++kt) {
            asm volatile("s_waitcnt vmcnt(0)" ::: "memory");
            __builtin_amdgcn_s_barrier();
            asm volatile("" ::: "memory");
            if (kt + 2 < nkt) { const int nb = cb == 0 ? 2 : cb - 1; AT_STAGE(nb, kt + 2); }
            const LAS unsigned char* cur = lds + cb * AT_BUF;
            cb = cb == 2 ? 0 : cb + 1;
            const int k0 = kt * 64;
            if (k0 <= q0) {
                const bool sub1 = (k0 + 32 <= q0);
                const LAS unsigned char* vb = cur + AT_KB;
                bf16x8 kf[8];
#pragma unroll
                for (int ks = 0; ks < 4; ++ks) kf[ks] = *(const LAS bf16x8*)(cur + foff[ks]);
                if (sub1) {
#pragma unroll
                    for (int ks = 0; ks < 4; ++ks) kf[4 + ks] = *(const LAS bf16x8*)(cur + 4096 + foff[ks]);
                }
                f32x16 s0, s1;
#pragma unroll
                for (int i = 0; i < 16; ++i) { s0[i] = 0.f; s1[i] = 0.f; }
#pragma unroll
                for (int ks = 0; ks < 4; ++ks) s0 = MFMA32(kf[ks], qf[ks], s0);
                if (sub1) {
#pragma unroll
                    for (int ks = 0; ks < 4; ++ks) s1 = MFMA32(kf[4 + ks], qf[ks], s1);
                }
                __builtin_amdgcn_sched_barrier(0);
                bf16x8 va[8];
#pragma unroll
                for (int s2 = 0; s2 < 2; ++s2)
#pragma unroll
                    for (int mt = 0; mt < 4; ++mt) va[s2 * 4 + mt] = *(const LAS bf16x8*)(vb + mt * 4096 + foff[s2]);
                __builtin_amdgcn_sched_barrier(0);
                const float off0 = sl2 * (float)(k0 - q0), off1 = off0 + 32.0f * sl2;
                const f32x2 c1v = {c1, c1};
#pragma unroll
                for (int j = 0; j < 8; ++j) {
                    const f32x2 kv = {kb[2 * j], kb[2 * j + 1]};
                    f32x2 a = {s0[2 * j], s0[2 * j + 1]}, c = {s1[2 * j], s1[2 * j + 1]};
                    a = __builtin_elementwise_fma(a, c1v, kv); c = __builtin_elementwise_fma(c, c1v, kv);
                    s0[2 * j] = a.x; s0[2 * j + 1] = a.y; s1[2 * j] = c.x; s1[2 * j + 1] = c.y;
                }
                if (k0 == q0) {
#pragma unroll
                    for (int i = 0; i < 16; ++i) if (crow(i, h2) > r) s0[i] = -INFINITY;
                }
                if (k0 + 32 == q0) {
#pragma unroll
                    for (int i = 0; i < 16; ++i) if (crow(i, h2) > r) s1[i] = -INFINITY;
                }
                float mx0 = fmaxf(s0[0], s0[1]), mx1 = fmaxf(s1[0], s1[1]);
#pragma unroll
                for (int j = 1; j < 8; ++j) { mx0 = fmaxf(fmaxf(s0[2 * j], s0[2 * j + 1]), mx0); mx1 = fmaxf(fmaxf(s1[2 * j], s1[2 * j + 1]), mx1); }
                float mx = sub1 ? fmaxf(mx0 + off0, mx1 + off1) : mx0 + off0;
                mx = xhalf_max(mx);
                if (__builtin_amdgcn_ballot_w64(mx > m + 8.0f) != 0ull) {
                    const float mn = fmaxf(m, mx);
                    const float alpha = __builtin_amdgcn_exp2f(m - mn);
                    m = mn; l *= alpha;
#pragma unroll
                    for (int mt = 0; mt < 4; ++mt)
#pragma unroll
                        for (int i = 0; i < 16; ++i) O[mt][i] *= alpha;
                }
                const float r0 = m - off0, r1 = sub1 ? m - off1 : INFINITY;
                const f32x2 r0v = {r0, r0}, r1v = {r1, r1};
                f32x2 lsv = {0.f, 0.f};
#pragma unroll
                for (int j = 0; j < 8; ++j) {
                    f32x2 a = {s0[2 * j], s0[2 * j + 1]}, c = {s1[2 * j], s1[2 * j + 1]};
                    a = a - r0v; c = c - r1v;
                    a.x = __builtin_amdgcn_exp2f(a.x); a.y = __builtin_amdgcn_exp2f(a.y); c.x = __builtin_amdgcn_exp2f(c.x); c.y = __builtin_amdgcn_exp2f(c.y);
                    lsv = lsv + a; lsv = lsv + c;
                    s0[2 * j] = a.x; s0[2 * j + 1] = a.y; s1[2 * j] = c.x; s1[2 * j + 1] = c.y;
                }
                l += lsv.x + lsv.y;
                bf16x8 pf[4];
#pragma unroll
                for (int s = 0; s < 2; ++s) { pf[s] = pack8(s0, s); pf[2 + s] = pack8(s1, s); }
                __builtin_amdgcn_sched_barrier(0);
                bf16x8 vc[4], vd[4];
                if (sub1) {
#pragma unroll
                    for (int mt = 0; mt < 4; ++mt) vc[mt] = *(const LAS bf16x8*)(vb + mt * 4096 + foff[2]);
                }
#pragma unroll
                for (int mt = 0; mt < 4; ++mt) O[mt] = MFMA32(va[mt], pf[0], O[mt]);
                if (sub1) {
#pragma unroll
                    for (int mt = 0; mt < 4; ++mt) vd[mt] = *(const LAS bf16x8*)(vb + mt * 4096 + foff[3]);
                }
#pragma unroll
                for (int mt = 0; mt < 4; ++mt) O[mt] = MFMA32(va[4 + mt], pf[1], O[mt]);
                if (sub1) {
#pragma unroll
                    for (int mt = 0; mt < 4; ++mt) O[mt] = MFMA32(vc[mt], pf[2], O[mt]);
#pragma unroll
                    for (int mt = 0; mt < 4; ++mt) O[mt] = MFMA32(vd[mt], pf[3], O[mt]);
                }
            }
        }
        asm volatile("" ::: "memory");
        __builtin_amdgcn_s_barrier();
        asm volatile("" ::: "memory");
#undef AT_STAGE
        const float lt = xhalf_sum(l);
        int lane_o = lane; asm volatile("" : "+v"(lane_o));
        LAS unsigned* o1l = (LAS unsigned*)(lds + AT_O1 + wid * 8192) + lane_o;
        if (map == 0) {
            const float inv1 = 1.0f / lt;
#pragma unroll
            for (int mt = 0; mt < 4; ++mt)
#pragma unroll
                for (int j = 0; j < 8; ++j) o1l[(mt * 8 + j) * 64] = pk_bf16(O[mt][2 * j] * inv1, O[mt][2 * j + 1] * inv1);
        } else {
            const float inv2 = lam / lt;
            float ss = 0.f;
#pragma unroll
            for (int mt = 0; mt < 4; ++mt)
#pragma unroll
                for (int j = 0; j < 8; ++j) {
                    const unsigned o1 = o1l[(mt * 8 + j) * 64];
                    const float a = bf_lo(o1) - O[mt][2 * j] * inv2, c = bf_hi(o1) - O[mt][2 * j + 1] * inv2;
                    O[mt][2 * j] = a; O[mt][2 * j + 1] = c; ss += a * a + c * c;
                }
            ss = xhalf_sum(ss);
            const float rs = rsqrtf(ss * (1.0f / 128.0f) + EPS) * 0.8f;
#pragma unroll
            for (int mt = 0; mt < 4; ++mt)
#pragma unroll
                for (int j = 0; j < 8; ++j) o1l[(mt * 8 + j) * 64] = pk_bf16(O[mt][2 * j] * rs, O[mt][2 * j + 1] * rs);
            __builtin_amdgcn_wave_barrier();
            int lane_e = lane; asm volatile("" : "+v"(lane_e));
            const int dvg = lane_e & 15, qs = lane_e >> 4;
            const f32x4 nw0 = *(const f32x4*)(p.diff_norm_w + 8 * dvg), nw1 = *(const f32x4*)(p.diff_norm_w + 8 * dvg + 4);
            const LAS unsigned* ob = (const LAS unsigned*)(lds + AT_O1 + wid * 8192);
            const int slot = (dvg >> 2) * 8 + 2 * (dvg & 3);
            u32x4 dzv[8];
#pragma unroll
            for (int it = 0; it < 8; ++it) dzv[it] = *(const u32x4*)(P1 + (tokbase + q0 + it * 4 + qs) * NP1 + C_DZ + hh * 128 + 8 * dvg);
#pragma unroll
            for (int it = 0; it < 8; ++it) {
                const int q = it * 4 + qs; const size_t row = tokbase + q0 + q;
                const unsigned u0 = ob[slot * 64 + q], u1 = ob[(slot + 1) * 64 + q], u2 = ob[slot * 64 + q + 32], u3 = ob[(slot + 1) * 64 + q + 32];
                const u32x4 dz = dzv[it];
                u32x4 w;
                w.x = pk_bf16(bf_lo(u0) * nw0[0] * silu_f(bf_lo(dz.x)), bf_hi(u0) * nw0[1] * silu_f(bf_hi(dz.x)));
                w.y = pk_bf16(bf_lo(u1) * nw0[2] * silu_f(bf_lo(dz.y)), bf_hi(u1) * nw0[3] * silu_f(bf_hi(dz.y)));
                w.z = pk_bf16(bf_lo(u2) * nw1[0] * silu_f(bf_lo(dz.z)), bf_hi(u2) * nw1[1] * silu_f(bf_hi(dz.z)));
                w.w = pk_bf16(bf_lo(u3) * nw1[2] * silu_f(bf_lo(dz.w)), bf_hi(u3) * nw1[3] * silu_f(bf_hi(dz.w)));
                *(u32x4*)(mix + row * DM + 512 + hh * 128 + 8 * dvg) = w;
            }
            __builtin_amdgcn_wave_barrier();
        }
    }
}

DI void phase_attn(const Params& p, LAS unsigned char* lds, int rep) {
    const float lam = *(const float*)(p.ws + OFF_MISC);
    unsigned* counter = (unsigned*)(p.ws + OFF_MISC + 4 + 4 * rep);
    LAS int* tslot = (LAS int*)(lds + AT_TASK);
    for (;;) {
        if (threadIdx.x == 0) *tslot = (int)atomicAdd(counter, 1u);
        __syncthreads();
        const int t = *tslot;
        __syncthreads();
        if (t >= 512) break;
        const int qb = 7 - (t >> 6), bh = t & 63;
        attn_qblock(p, lds, bh >> 2, bh & 3, qb, lam);
    }
}


constexpr int G_QN = 0, G_KN = 17408, G_VB = 34816, G_KBG = 52224, G_M = 69632, G_T = 86016, G_SM = 95232;
DI bf16x8 tr_pair(const LAS unsigned char* lo_addr, int hi_off) {
    const s16x4 lo = __builtin_amdgcn_ds_read_tr16_b64_v4i16((LAS s16x4*)(lo_addr));
    const s16x4 hi = __builtin_amdgcn_ds_read_tr16_b64_v4i16((LAS s16x4*)(lo_addr + hi_off));
    return __builtin_shufflevector(lo, hi, 0, 1, 2, 3, 4, 5, 6, 7);
}
DI bf16_t bf16_1(float v) { return (bf16_t)(pk_bf16(v, 0.f) & 0xffffu); }

DI void gdn_gates(const Params& p, LAS float* sm, int c2, int lane) {
    const int b = c2 >> 7, hh = (c2 >> 5) & 3, n = c2 & 31;
    const size_t tok0 = (size_t)b * SEQ + (size_t)n * 64;
    const float* gg = (const float*)(p.ws + OFF_GBGA) + (tok0 + lane) * 8;
    const float gbv = gg[hh], gav = gg[4 + hh];
    const float beta = 1.0f / (1.0f + expf(-gbv));
    const float xs = gav + p.dt_bias[hh];
    const float sp = fmaxf(xs, 0.f) + log1pf(expf(-fabsf(xs)));
    float gc = -expf(p.a_log[hh]) * sp;
#pragma unroll
    for (int o = 1; o < 64; o <<= 1) { const float t = __shfl_up(gc, o); if (lane >= o) gc += t; }
    const float gl = __shfl(gc, 63);
    sm[lane] = beta; sm[64 + lane] = gc * LOG2E; sm[128 + lane] = expf(gc); sm[192 + lane] = expf(gl - gc);
    if (lane == 63) ((float*)(p.ws + OFF_GL))[c2] = expf(gl);
}

DI void gdn_prep(const Params& p, LAS unsigned char* lds, int c2, int c2next, int par) {
    int tid = threadIdx.x; asm volatile("" : "+v"(tid));
    const int lane = tid & 63, wid = __builtin_amdgcn_readfirstlane(tid >> 6), r = lane & 31, h2 = lane >> 5;
    const int b = c2 >> 7, hh = (c2 >> 5) & 3, n = c2 & 31;
    const size_t tok0 = (size_t)b * SEQ + (size_t)n * 64;
    const bf16_t* P1 = (const bf16_t*)(p.ws + OFF_P1);
    LAS float* sm = (LAS float*)(lds + G_SM + par * 1024);
    LAS float* Mf = (LAS float*)(lds + G_M);
    bf16_t* WN = (bf16_t*)(p.ws + OFF_WN) + (size_t)c2 * 8192;
    bf16_t* QD = (bf16_t*)(p.ws + OFF_QD) + (size_t)c2 * 8192;
    bf16_t* KD = (bf16_t*)(p.ws + OFF_KD) + (size_t)c2 * 8192;
    bf16_t* AQ = (bf16_t*)(p.ws + OFF_AQK) + (size_t)c2 * 4096;
    float* U = (float*)(p.ws + OFF_U) + (size_t)c2 * 8192;
    u32x4 raw[6][4];
#pragma unroll
    for (int i = 0; i < 6; ++i) {
        const int item = tid + 512 * i, g = item & 15, t = (item >> 4) & 63, part = i >> 1;
        const int ch = part * 512 + hh * 128 + g * 8;
#pragma unroll
        for (int j = 0; j < 4; ++j) {
            const int tt = n * 64 + t - 3 + j, ttc = tt < 0 ? 0 : tt;
            raw[i][j] = *(const u32x4*)(P1 + ((size_t)b * SEQ + ttc) * NP1 + ch);
            if (tt < 0) raw[i][j] = (u32x4){0u, 0u, 0u, 0u};
        }
    }
    float av[6][8];
#pragma unroll
    for (int i = 0; i < 6; ++i) {
        const int item = tid + 512 * i, g = item & 15, part = i >> 1;
        const int ch = part * 512 + hh * 128 + g * 8;
        float a[8];
#pragma unroll
        for (int e = 0; e < 8; ++e) a[e] = 0.f;
#pragma unroll
        for (int j = 0; j < 4; ++j) {
            const f32x4 w0 = *(const f32x4*)(p.conv_w + j * 1536 + ch), w1 = *(const f32x4*)(p.conv_w + j * 1536 + ch + 4);
            const u32x4 rw = raw[i][j];
            a[0] += w0[0] * bf_lo(rw.x); a[1] += w0[1] * bf_hi(rw.x); a[2] += w0[2] * bf_lo(rw.y); a[3] += w0[3] * bf_hi(rw.y);
            a[4] += w1[0] * bf_lo(rw.z); a[5] += w1[1] * bf_hi(rw.z); a[6] += w1[2] * bf_lo(rw.w); a[7] += w1[3] * bf_hi(rw.w);
        }
        float ss = 0.f;
#pragma unroll
        for (int e = 0; e < 8; ++e) { a[e] = silu_f(a[e]); ss += a[e] * a[e]; }
        float rn = 1.0f;
        if (part < 2) {
            ss += __shfl_xor(ss, 1); ss += __shfl_xor(ss, 2); ss += __shfl_xor(ss, 4); ss += __shfl_xor(ss, 8);
            rn = rsqrtf(ss + 1e-6f) * (part == 0 ? 0.08838834764831845f : 1.0f);
        }
#pragma unroll
        for (int e = 0; e < 8; ++e) av[i][e] = a[e] * rn;
    }
#pragma unroll
    for (int i = 0; i < 6; ++i) {
        const int item = tid + 512 * i, g = item & 15, t = (item >> 4) & 63, part = i >> 1;
        const float* a = av[i];
        const float beta = sm[t], egc = sm[128 + t], ekd = sm[192 + t];
        if (part < 2) {
            u32x4 w; w.x = pk_bf16(a[0], a[1]); w.y = pk_bf16(a[2], a[3]); w.z = pk_bf16(a[4], a[5]); w.w = pk_bf16(a[6], a[7]);
            *(LAS u32x4*)(lds + (part == 0 ? G_QN : G_KN) + t * 272 + g * 16) = w;
            if (part == 0) {
                u32x2 lo, hi; lo.x = pk_bf16(a[0] * egc, a[1] * egc); lo.y = pk_bf16(a[2] * egc, a[3] * egc); hi.x = pk_bf16(a[4] * egc, a[5] * egc); hi.y = pk_bf16(a[6] * egc, a[7] * egc);
                bf16_t* qd = QD + t * 128 + 16 * (g >> 1) + 4 * (g & 1);
                *(u32x2*)qd = lo; *(u32x2*)(qd + 8) = hi;
            } else {
                const float f1 = beta * egc;
                u32x4 w2; w2.x = pk_bf16(a[0] * f1, a[1] * f1); w2.y = pk_bf16(a[2] * f1, a[3] * f1); w2.z = pk_bf16(a[4] * f1, a[5] * f1); w2.w = pk_bf16(a[6] * f1, a[7] * f1);
                *(LAS u32x4*)(lds + G_KBG + t * 272 + g * 16) = w2;
                u32x4 w3; w3.x = pk_bf16(a[0] * ekd, a[1] * ekd); w3.y = pk_bf16(a[2] * ekd, a[3] * ekd); w3.z = pk_bf16(a[4] * ekd, a[5] * ekd); w3.w = pk_bf16(a[6] * ekd, a[7] * ekd);
                *(u32x4*)(KD + t * 128 + g * 8) = w3;
            }
        } else {
            u32x4 w; w.x = pk_bf16(a[0] * beta, a[1] * beta); w.y = pk_bf16(a[2] * beta, a[3] * beta); w.z = pk_bf16(a[4] * beta, a[5] * beta); w.w = pk_bf16(a[6] * beta, a[7] * beta);
            *(LAS u32x4*)(lds + G_VB + t * 272 + g * 16) = w;
        }
    }
    __syncthreads();
    {
        const int w4 = wid & 3, mt = w4 >> 1, nt = w4 & 1; const bool isqk = wid >= 4;
        if (!(mt == 0 && nt == 1)) {
            const LAS unsigned char* Ab = lds + (isqk ? G_QN : G_KN) + (32 * mt + r) * 272 + 16 * h2;
            const LAS unsigned char* Bb = lds + G_KN + (32 * nt + r) * 272 + 16 * h2;
            f32x16 X;
#pragma unroll
            for (int i = 0; i < 16; ++i) X[i] = 0.f;
#pragma unroll
            for (int ks = 0; ks < 8; ++ks) X = MFMA32(*(const LAS bf16x8*)(Ab + 32 * ks), *(const LAS bf16x8*)(Bb + 32 * ks), X);
            const int s = 32 * nt + r; const float gcs = sm[64 + s];
#pragma unroll
            for (int i = 0; i < 16; ++i) {
                const int c = 32 * mt + crow(i, h2);
                const float dec = __builtin_amdgcn_exp2f(sm[64 + c] - gcs);
                if (!isqk) Mf[c * 64 + s] = (c > s) ? sm[c] * X[i] * dec : 0.f;
                else AQ[c * 64 + perm23(s)] = bf16_1((c >= s) ? X[i] * dec : 0.f);
            }
        }
    }
    __syncthreads();
    if (wid == 0) {
        LAS bf16_t* Tb = (LAS bf16_t*)(lds + G_T);
        {
            const int c16 = lane & 15, b16 = lane >> 4;
            const LAS float* Mb = Mf + (16 * b16) * 64 + 16 * b16;
            float T[16];
#pragma unroll
            for (int i = 0; i < 16; ++i) T[i] = 0.f;
#pragma unroll
            for (int i = 0; i < 16; ++i) {
                float a0 = (i == c16) ? 1.f : 0.f, a1 = 0.f, a2 = 0.f, a3 = 0.f;
#pragma unroll
                for (int s4 = 0; s4 < (i + 3) / 4; ++s4) {
                    const f32x4 m4 = *(const LAS f32x4*)(Mb + i * 64 + 4 * s4);
                    a0 -= m4[0] * T[4 * s4]; a1 -= m4[1] * T[4 * s4 + 1]; a2 -= m4[2] * T[4 * s4 + 2]; a3 -= m4[3] * T[4 * s4 + 3];
                }
                T[i] = (a0 + a1) + (a2 + a3);
            }
#pragma unroll
            for (int i = 0; i < 16; ++i) {
                const int row = 16 * b16 + i;
                Tb[row * 72 + 16 * b16 + c16] = bf16_1(T[i]);
                if ((b16 & 1) == 0) Tb[row * 72 + 16 * b16 + 16 + c16] = 0;
                if (b16 < 2) { Tb[row * 72 + 32 + c16] = 0; Tb[row * 72 + 48 + c16] = 0; }
            }
        }
        __builtin_amdgcn_wave_barrier();
        asm volatile("s_waitcnt lgkmcnt(0)" ::: "memory");
        {
            const int qd = r >> 4, rr = r & 15;
            bf16x8 mfrag;
            { const LAS float* mp = Mf + (16 + 32 * qd + rr) * 64 + 32 * qd + 8 * h2;
              const f32x4 m0 = *(const LAS f32x4*)mp, m1 = *(const LAS f32x4*)(mp + 4);
              u32x4 aw; aw.x = pk_bf16(m0[0], m0[1]); aw.y = pk_bf16(m0[2], m0[3]); aw.z = pk_bf16(m1[0], m1[1]); aw.w = pk_bf16(m1[2], m1[3]);
              mfrag = __builtin_bit_cast(bf16x8, aw); }
            bf16x8 tfrag;
#pragma unroll
            for (int j = 0; j < 8; ++j) tfrag[j] = (short)Tb[(32 * qd + 8 * h2 + j) * 72 + 32 * qd + rr];
            bf16x8 t2frag;
            { const LAS unsigned char* tp = lds + G_T + (16 + 32 * qd + rr) * 144 + (16 + 32 * qd + 4 * h2) * 2;
              const u32x2 lo = *(const LAS u32x2*)tp, hi = *(const LAS u32x2*)(tp + 16);
              u32x4 aw; aw.x = lo.x; aw.y = lo.y; aw.z = hi.x; aw.w = hi.y; t2frag = __builtin_bit_cast(bf16x8, aw); }
            const bf16x8 zf = {0, 0, 0, 0, 0, 0, 0, 0};
            f32x16 Y1, Z1;
#pragma unroll
            for (int i = 0; i < 16; ++i) { Y1[i] = 0.f; Z1[i] = 0.f; }
#pragma unroll
            for (int ks = 0; ks < 2; ++ks) Y1 = MFMA32(qd == ks ? mfrag : zf, qd == ks ? tfrag : zf, Y1);
#pragma unroll
            for (int s2 = 0; s2 < 2; ++s2) Z1 = MFMA32(qd == s2 ? t2frag : zf, pack8(Y1, s2), Z1);
#pragma unroll
            for (int i = 0; i < 16; ++i) {
                const int row = crow(i, h2);
                if ((row >> 4) == qd) Tb[(16 + 32 * qd + (row & 15)) * 72 + 32 * qd + rr] = bf16_1(-Z1[i]);
            }
        }
        __builtin_amdgcn_wave_barrier();
        asm volatile("s_waitcnt lgkmcnt(0)" ::: "memory");
        const int i16 = lane & 15, q = i16 >> 2, pp = i16 & 3, blk = (lane >> 4) & 1;
        f32x16 Y;
#pragma unroll
        for (int i = 0; i < 16; ++i) Y[i] = 0.f;
#pragma unroll
        for (int ks = 0; ks < 2; ++ks) {
            const LAS float* mp = Mf + (32 + r) * 64 + 16 * ks + 8 * h2;
            const f32x4 m0 = *(const LAS f32x4*)mp, m1 = *(const LAS f32x4*)(mp + 4);
            u32x4 aw; aw.x = pk_bf16(m0[0], m0[1]); aw.y = pk_bf16(m0[2], m0[3]); aw.z = pk_bf16(m1[0], m1[1]); aw.w = pk_bf16(m1[2], m1[3]);
            const bf16x8 bfrag = tr_pair(lds + G_T + (16 * ks + 8 * h2 + q) * 144 + (16 * blk + 4 * pp) * 2, 4 * 144);
            Y = MFMA32(__builtin_bit_cast(bf16x8, aw), bfrag, Y);
        }
        f32x16 Z;
#pragma unroll
        for (int i = 0; i < 16; ++i) Z[i] = 0.f;
#pragma unroll
        for (int s = 0; s < 2; ++s) {
            const LAS unsigned char* tp = lds + G_T + (32 + r) * 144 + (32 + 16 * s + 4 * h2) * 2;
            const u32x2 lo = *(const LAS u32x2*)tp, hi = *(const LAS u32x2*)(tp + 16);
            u32x4 aw; aw.x = lo.x; aw.y = lo.y; aw.z = hi.x; aw.w = hi.y;
            Z = MFMA32(__builtin_bit_cast(bf16x8, aw), pack8(Y, s), Z);
        }
#pragma unroll
        for (int i = 0; i < 16; ++i) Tb[(32 + crow(i, h2)) * 72 + r] = bf16_1(-Z[i]);
    } else if (wid == 1) {
        if (c2next < 2048) gdn_gates(p, (LAS float*)(lds + G_SM + (par ^ 1) * 1024), c2next, lane);
    }
    __syncthreads();
    {
        const int mt = wid >> 2, nt = wid & 3;
        const int i16 = lane & 15, q = i16 >> 2, pp = i16 & 3, blk = (lane >> 4) & 1;
        f32x16 Xu, Xw;
#pragma unroll
        for (int i = 0; i < 16; ++i) { Xu[i] = 0.f; Xw[i] = 0.f; }
#pragma unroll
        for (int ks = 0; ks < 4; ++ks) {
            if (ks < 2 * (mt + 1)) {
                const bf16x8 af = *(const LAS bf16x8*)(lds + G_T + (32 * mt + r) * 144 + (16 * ks + 8 * h2) * 2);
                const int boff = (16 * ks + 8 * h2 + q) * 272 + (32 * nt + 16 * blk + 4 * pp) * 2;
                Xu = MFMA32(af, tr_pair(lds + G_VB + boff, 4 * 272), Xu);
                Xw = MFMA32(af, tr_pair(lds + G_KBG + boff, 4 * 272), Xw);
            }
        }
        const int d = 32 * nt + r, dp = perm23(d);
        {
            float* up = U + ((nt * 2 + mt) * 64 + lane) * 16;
#pragma unroll
            for (int k = 0; k < 4; ++k) { const f32x4 v = {Xu[4 * k], Xu[4 * k + 1], Xu[4 * k + 2], Xu[4 * k + 3]}; *(f32x4*)(up + 4 * k) = v; }
        }
#pragma unroll
        for (int i = 0; i < 16; ++i) {
            const int c = 32 * mt + crow(i, h2);
            WN[c * 128 + dp] = bf16_1(-Xw[i]);
        }
    }
    __syncthreads();
}

constexpr int S_WN = 0, S_QD = 17408, S_KD = 34816, S_AQ = 52224, S_BUF = 61440, S_STG = 2 * S_BUF;

struct GateIn { u32x4 z0, z1; };
DI void scan_gate_load(const Params& p, int tid, int b, int hh, int n, GateIn& g) {
    const int gc_ = tid >> 3, seg = tid & 7;
    const bf16_t* P1 = (const bf16_t*)(p.ws + OFF_P1);
    const size_t row = (size_t)b * SEQ + n * 64 + gc_;
    g.z0 = *(const u32x4*)(P1 + row * NP1 + C_GZ + hh * 128 + seg * 16); g.z1 = *(const u32x4*)(P1 + row * NP1 + C_GZ + hh * 128 + seg * 16 + 8);
}
DI void scan_gate(const Params& p, LAS unsigned char* lds, int tid, int b, int hh, int n, const GateIn& g) {
    const int gc_ = tid >> 3, seg = tid & 7;
    bf16_t* mix = (bf16_t*)(p.ws + OFF_HB);
    const LAS float* st = (const LAS float*)(lds + S_STG) + gc_ * 132 + seg * 16;
    f32x4 ov[4]; float ss = 0.f;
#pragma unroll
    for (int k = 0; k < 4; ++k) { ov[k] = *(const LAS f32x4*)(st + 4 * k); ss += ov[k][0] * ov[k][0] + ov[k][1] * ov[k][1] + ov[k][2] * ov[k][2] + ov[k][3] * ov[k][3]; }
    ss += __shfl_xor(ss, 1); ss += __shfl_xor(ss, 2); ss += __shfl_xor(ss, 4);
    const float rstd = rsqrtf(ss * (1.0f / 128.0f) + EPS);
    const size_t row = (size_t)b * SEQ + n * 64 + gc_;
    const u32x4 z0 = g.z0, z1 = g.z1;
    f32x4 gnw[4];
#pragma unroll
    for (int k = 0; k < 4; ++k) gnw[k] = *(const f32x4*)(p.gdn_norm_w + seg * 16 + 4 * k);
    u32x4 w0, w1;
    w0.x = pk_bf16(ov[0][0] * rstd * gnw[0][0] * silu_f(bf_lo(z0.x)), ov[0][1] * rstd * gnw[0][1] * silu_f(bf_hi(z0.x)));
    w0.y = pk_bf16(ov[0][2] * rstd * gnw[0][2] * silu_f(bf_lo(z0.y)), ov[0][3] * rstd * gnw[0][3] * silu_f(bf_hi(z0.y)));
    w0.z = pk_bf16(ov[1][0] * rstd * gnw[1][0] * silu_f(bf_lo(z0.z)), ov[1][1] * rstd * gnw[1][1] * silu_f(bf_hi(z0.z)));
    w0.w = pk_bf16(ov[1][2] * rstd * gnw[1][2] * silu_f(bf_lo(z0.w)), ov[1][3] * rstd * gnw[1][3] * silu_f(bf_hi(z0.w)));
    w1.x = pk_bf16(ov[2][0] * rstd * gnw[2][0] * silu_f(bf_lo(z1.x)), ov[2][1] * rstd * gnw[2][1] * silu_f(bf_hi(z1.x)));
    w1.y = pk_bf16(ov[2][2] * rstd * gnw[2][2] * silu_f(bf_lo(z1.y)), ov[2][3] * rstd * gnw[2][3] * silu_f(bf_hi(z1.y)));
    w1.z = pk_bf16(ov[3][0] * rstd * gnw[3][0] * silu_f(bf_lo(z1.z)), ov[3][1] * rstd * gnw[3][1] * silu_f(bf_hi(z1.z)));
    w1.w = pk_bf16(ov[3][2] * rstd * gnw[3][2] * silu_f(bf_lo(z1.w)), ov[3][3] * rstd * gnw[3][3] * silu_f(bf_hi(z1.w)));
    bf16_t* mp = mix + row * DM + hh * 128 + seg * 16;
    *(u32x4*)mp = w0; *(u32x4*)(mp + 8) = w1;
}

struct ScanRegs { u32x4 t0[4], t1[4], t2[4], t3[2]; };
DI void scan_fetch(ScanRegs& R, const bf16_t* WN, const bf16_t* QD, const bf16_t* KD, const bf16_t* AQ, int ltid) {
#pragma unroll
    for (int i = 0; i < 4; ++i) { const int pi = ltid + 256 * i; R.t0[i] = *(const u32x4*)(WN + pi * 8); R.t1[i] = *(const u32x4*)(QD + pi * 8); R.t2[i] = *(const u32x4*)(KD + pi * 8); }
#pragma unroll
    for (int i = 0; i < 2; ++i) { const int pi = ltid + 256 * i; R.t3[i] = *(const u32x4*)(AQ + pi * 8); }
}
DI void scan_put(const ScanRegs& R, LAS unsigned char* dst, int ltid) {
#pragma unroll
    for (int i = 0; i < 4; ++i) { const int pi = ltid + 256 * i, row = pi >> 4, pc = pi & 15;
        *(LAS u32x4*)(dst + S_WN + row * 272 + pc * 16) = R.t0[i]; *(LAS u32x4*)(dst + S_QD + row * 272 + pc * 16) = R.t1[i]; *(LAS u32x4*)(dst + S_KD + row * 272 + pc * 16) = R.t2[i]; }
#pragma unroll
    for (int i = 0; i < 2; ++i) { const int pi = ltid + 256 * i, row = pi >> 3, pc = pi & 7; *(LAS u32x4*)(dst + S_AQ + row * 144 + pc * 16) = R.t3[i]; }
}

DI void gdn_scan(const Params& p, LAS unsigned char* lds, int bh) {
    int tid = threadIdx.x; asm volatile("" : "+v"(tid));
    const int lane = tid & 63, wid = __builtin_amdgcn_readfirstlane(tid >> 6), r = lane & 31, h2 = lane >> 5;
    const int b = bh >> 2, hh = bh & 3;
    const bf16_t* WN = (const bf16_t*)(p.ws + OFF_WN) + (size_t)bh * 32 * 8192;
    const bf16_t* QD = (const bf16_t*)(p.ws + OFF_QD) + (size_t)bh * 32 * 8192;
    const bf16_t* KD = (const bf16_t*)(p.ws + OFF_KD) + (size_t)bh * 32 * 8192;
    const bf16_t* AQ = (const bf16_t*)(p.ws + OFF_AQK) + (size_t)bh * 32 * 4096;
    const float* U = (const float*)(p.ws + OFF_U) + (size_t)bh * 32 * 8192;
    const float* GL = (const float*)(p.ws + OFF_GL) + bh * 32;
    if (wid >= 4) {
        const int ltid = tid & 255;
        ScanRegs R;
        scan_fetch(R, WN, QD, KD, AQ, ltid); scan_put(R, lds, ltid);
        scan_fetch(R, WN + 8192, QD + 8192, KD + 8192, AQ + 4096, ltid);
#pragma unroll 1
        for (int n = 0; n < 32; ++n) {
            __syncthreads();
            GateIn gi; scan_gate_load(p, tid, b, hh, n, gi);
            if (n + 1 < 32) scan_put(R, lds + ((n + 1) & 1) * S_BUF, ltid);
            if (n + 2 < 32) scan_fetch(R, WN + (size_t)(n + 2) * 8192, QD + (size_t)(n + 2) * 8192, KD + (size_t)(n + 2) * 8192, AQ + (size_t)(n + 2) * 4096, ltid);
            __syncthreads();
            scan_gate(p, lds, tid, b, hh, n, gi);
        }
    } else {
        const int i16 = lane & 15, q4 = i16 >> 2, pp = i16 & 3, blk = (lane >> 4) & 1;
        f32x16 St[4], u[2];
#pragma unroll
        for (int k = 0; k < 4; ++k)
#pragma unroll
            for (int i = 0; i < 16; ++i) St[k][i] = 0.f;
#pragma unroll
        for (int mt = 0; mt < 2; ++mt)
#pragma unroll
            for (int k = 0; k < 4; ++k) { const f32x4 v = *(const f32x4*)(U + ((wid * 2 + mt) * 64 + lane) * 16 + 4 * k); u[mt][4 * k] = v[0]; u[mt][4 * k + 1] = v[1]; u[mt][4 * k + 2] = v[2]; u[mt][4 * k + 3] = v[3]; }
#pragma unroll 1
        for (int n = 0; n < 32; ++n) {
            LAS unsigned char* buf = lds + (n & 1) * S_BUF;
            __syncthreads();
            GateIn gi; scan_gate_load(p, tid, b, hh, n, gi);
            const float egl = GL[n];
            f32x16 vn[2], o[2];
            vn[0] = u[0]; vn[1] = u[1];
#pragma unroll
            for (int mt = 0; mt < 2; ++mt)
#pragma unroll
                for (int i = 0; i < 16; ++i) o[mt][i] = 0.f;
#pragma unroll
            for (int ks = 0; ks < 8; ++ks) {
                const bf16x8 sf = pack8(St[ks >> 1], ks & 1);
#pragma unroll
                for (int mt = 0; mt < 2; ++mt) {
                    const bf16x8 wf = *(const LAS bf16x8*)(buf + S_WN + (32 * mt + r) * 272 + (16 * ks + 8 * h2) * 2);
                    vn[mt] = MFMA32(wf, sf, vn[mt]);
                    const bf16x8 qf = *(const LAS bf16x8*)(buf + S_QD + (32 * mt + r) * 272 + (16 * ks + 8 * h2) * 2);
                    o[mt] = MFMA32(qf, sf, o[mt]);
                }
                asm volatile("" ::: "memory");
            }
            bf16x8 vf[4];
#pragma unroll
            for (int k2 = 0; k2 < 4; ++k2) vf[k2] = pack8(vn[k2 >> 1], k2 & 1);
            {
                const int nn = (n + 1 < 32) ? n + 1 : n;
                const float* up = U + (size_t)nn * 8192 + ((wid * 2) * 64 + lane) * 16;
#pragma unroll
                for (int mt = 0; mt < 2; ++mt)
#pragma unroll
                    for (int k = 0; k < 4; ++k) { const f32x4 v = *(const f32x4*)(up + mt * 1024 + 4 * k); u[mt][4 * k] = v[0]; u[mt][4 * k + 1] = v[1]; u[mt][4 * k + 2] = v[2]; u[mt][4 * k + 3] = v[3]; }
            }
#pragma unroll
            for (int mt = 0; mt < 2; ++mt)
#pragma unroll
                for (int k2 = 0; k2 < 2 * (mt + 1); ++k2) {
                    const bf16x8 af = *(const LAS bf16x8*)(buf + S_AQ + (32 * mt + r) * 144 + (16 * k2 + 8 * h2) * 2);
                    o[mt] = MFMA32(af, vf[k2], o[mt]);
                }
            {
                LAS float* st = (LAS float*)(lds + S_STG);
#pragma unroll
                for (int mt = 0; mt < 2; ++mt)
#pragma unroll
                    for (int i = 0; i < 16; ++i) st[(32 * mt + crow(i, h2)) * 132 + 32 * wid + r] = o[mt][i];
            }
#pragma unroll
            for (int kt = 0; kt < 4; ++kt) {
#pragma unroll
                for (int i = 0; i < 16; ++i) St[kt][i] *= egl;
#pragma unroll
                for (int k2 = 0; k2 < 4; ++k2) {
                    const bf16x8 kf = tr_pair(buf + S_KD + (16 * k2 + 4 * h2 + q4) * 272 + (32 * kt + 16 * blk + 4 * pp) * 2, 8 * 272);
                    St[kt] = MFMA32(kf, vf[k2], St[kt]);
                }
                asm volatile("" ::: "memory");
            }
            __syncthreads();
            scan_gate(p, lds, tid, b, hh, n, gi);
        }
    }
    __syncthreads();
}

DI void zero_mix_half(const Params& p, int half) {
    bf16_t* mix = (bf16_t*)(p.ws + OFF_HB);
    const size_t n16 = (size_t)MTOK * 64;
    for (size_t i = (size_t)blockIdx.x * 512 + threadIdx.x; i < n16; i += (size_t)gridDim.x * 512) {
        const size_t row = i >> 6, pc = i & 63;
        *(u32x4*)(mix + row * DM + half * 512 + pc * 8) = (u32x4){0u, 0u, 0u, 0u};
    }
}

DI void phase_final(const Params& p) {
    int tid = threadIdx.x; asm volatile("" : "+v"(tid));
    const int lane = tid & 63, wid = tid >> 6;
    const float* rowsq = (const float*)(p.ws + OFF_ROWSQ);
    const bf16_t* yb = (const bf16_t*)(p.ws + OFF_YB);
    const int gw = blockIdx.x * 8 + wid, nw = gridDim.x * 8;
    f32x4 fw[4];
#pragma unroll
    for (int i = 0; i < 2; ++i) { fw[2 * i] = *(const f32x4*)(p.final_norm_w + 512 * i + 8 * lane); fw[2 * i + 1] = *(const f32x4*)(p.final_norm_w + 512 * i + 8 * lane + 4); }
#pragma unroll 1
    for (int row0 = gw; row0 < MTOK; row0 += 4 * nw) {
        u32x4 y[4][2]; float sq[4];
#pragma unroll
        for (int k = 0; k < 4; ++k) {
            const int row = row0 + k * nw, rc = row < MTOK ? row : row0;
#pragma unroll
            for (int i = 0; i < 2; ++i) y[k][i] = *(const u32x4*)(yb + (size_t)rc * DM + 512 * i + 8 * lane);
            sq[k] = lane < 16 ? rowsq[(size_t)rc * 16 + lane] : 0.f;
        }
#pragma unroll
        for (int k = 0; k < 4; ++k) {
            const int row = row0 + k * nw;
            const float ss = wave_sum(sq[k]);
            const float rstd = rsqrtf(ss * (1.0f / DM) + EPS);
            if (row < MTOK) {
                float* o = p.out + (size_t)row * DM;
#pragma unroll
                for (int i = 0; i < 2; ++i) {
                    const f32x4 a = {bf_lo(y[k][i].x), bf_hi(y[k][i].x), bf_lo(y[k][i].y), bf_hi(y[k][i].y)}, c = {bf_lo(y[k][i].z), bf_hi(y[k][i].z), bf_lo(y[k][i].w), bf_hi(y[k][i].w)};
                    *(f32x4*)(o + 512 * i + 8 * lane) = a * rstd * fw[2 * i];
                    *(f32x4*)(o + 512 * i + 8 * lane + 4) = c * rstd * fw[2 * i + 1];
                }
            }
        }
    }
}

__global__ void __launch_bounds__(512) mega(Params p) {
    extern __shared__ __attribute__((aligned(16))) unsigned char shm[];
    LAS unsigned char* lds = (LAS unsigned char*)shm;
    cg::grid_group grid = cg::this_grid();
    volatile LAS unsigned* bst = (volatile LAS unsigned*)(lds + LDS_BYTES - 16);
    if (threadIdx.x < 2) bst[threadIdx.x] = 0u;
    __syncthreads();
    const XcdBarrier xb = xcd_barrier_post((unsigned*)(p.ws + OFF_BAR), bst);
    if (p.ws == nullptr) grid.sync();

#pragma unroll 1
    for (int rep = 0; rep < REP_PREP; ++rep) phase_prep(p, lds);
    xcd_barrier(xb);
#pragma unroll 1
    for (int rep = 0; rep < REP_G1; ++rep)
    {
        pg8::Gemm g{(const bf16_t*)(p.ws + OFF_HB), (const bf16_t*)(p.ws + OFF_WINT), MTOK, NG1, DM};
        pg8::StaticOrder S; S.init(g.M, g.N, (int)gridDim.x, (int)blockIdx.x);
        pg8::EpiP1 E{(bf16_t*)(p.ws + OFF_P1), NP1, (bf16_t*)(p.ws + OFF_KX)};
        pg8::gemm_phase<pg8::EpiP1, false>(lds, g, S, E);
        pg8::Gemm g2{(const bf16_t*)(p.ws + OFF_HB), (const bf16_t*)(p.ws + OFF_WINT) + (size_t)NG1 * DM, MTOK, 512, DM};
        pg8::StaticOrder S2; S2.init(g2.M, g2.N, (int)gridDim.x, (int)blockIdx.x);
        pg8::EpiVT E2{(bf16_t*)(p.ws + OFF_VT)};
        pg8::gemm_phase<pg8::EpiVT, true>(lds, g2, S2, E2);
    }
    xcd_barrier(xb);
#pragma unroll 1
    for (int rep = 0; rep < REP_GP; ++rep)
    {
        if ((threadIdx.x >> 6) == 0 && (int)blockIdx.x < 2048) gdn_gates(p, (LAS float*)(lds + G_SM), blockIdx.x, threadIdx.x & 63);
        __syncthreads();
        int par = 0;
#pragma unroll 1
        for (int c2 = blockIdx.x; c2 < 2048; c2 += gridDim.x, par ^= 1) gdn_prep(p, lds, c2, c2 + (int)gridDim.x, par);
    }
    xcd_barrier(xb);
#pragma unroll 1
    for (int rep = 0; rep < REP_P3; ++rep) {
#pragma unroll 1
        for (int r2 = 0; r2 < REP_SCAN; ++r2)
            if (blockIdx.x < 64) gdn_scan(p, lds, blockIdx.x);
#if SCAN_SYNC
        xcd_barrier(xb);
#endif
        phase_attn(p, lds, rep);
#if REP_ATTN > 1
        xcd_barrier(xb);
        phase_attn(p, lds, 2);
#endif
#if REP_P3 > 1
        xcd_barrier(xb);
#endif
    }
    xcd_barrier(xb);
#pragma unroll 1
    for (int rnd = 0; rnd < 2; ++rnd) {
        pg8::Gemm g{(const bf16_t*)(p.ws + OFF_HB), (const bf16_t*)(p.ws + OFF_WOUTT), MTOK, DM, DM};
        pg8::StaticOrder S; S.init(g.M, g.N, (int)gridDim.x, (int)blockIdx.x); S.i0 = rnd; S.imax = 1;
        pg8::EpiOutFused E{p.x, p.out, (float*)(p.ws + OFF_ROWSQ), p.final_norm_w, xb};
        pg8::Unit u0;
        if (S.next(0, u0)) pg8::gemm_phase<pg8::EpiOutFused, false>(lds, g, S, E);
        else xcd_barrier(xb);
    }
}

extern "C" void kernel_launch(void* const* d_in, const int* in_sizes, int n_in, void* d_out, int out_size, void* d_ws, size_t ws_size, hipStream_t stream) {
    static int grid = 0;
    if (grid == 0) {
        if (ws_size < WS_END) { fprintf(stderr, "kernel_launch: workspace too small (%zu < %zu)\n", ws_size, (size_t)WS_END); grid = -1; return; }
        int dev = 0, cus = 0, per_cu = 0;
        hipGetDevice(&dev);
        hipDeviceGetAttribute(&cus, hipDeviceAttributeMultiprocessorCount, dev);
        if (hipFuncSetAttribute((const void*)mega, hipFuncAttributeMaxDynamicSharedMemorySize, LDS_BYTES) != hipSuccess) { fprintf(stderr, "kernel_launch: hipFuncSetAttribute failed\n"); grid = -1; return; }
        if (hipOccupancyMaxActiveBlocksPerMultiprocessor(&per_cu, (const void*)mega, 512, LDS_BYTES) != hipSuccess || per_cu < 1) per_cu = 1;
        (void)hipGetLastError();
        grid = cus * (per_cu > 1 ? 1 : per_cu);
    }
    if (grid < 0) return;
    Params p{};
    p.x = (const float*)d_in[0]; p.norm_w = (const float*)d_in[1]; p.w_in = (const float*)d_in[2]; p.conv_w = (const float*)d_in[3];
    p.a_log = (const float*)d_in[4]; p.dt_bias = (const float*)d_in[5]; p.gdn_norm_w = (const float*)d_in[6];
    p.lq1 = (const float*)d_in[7]; p.lk1 = (const float*)d_in[8]; p.lq2 = (const float*)d_in[9]; p.lk2 = (const float*)d_in[10];
    p.diff_norm_w = (const float*)d_in[11]; p.w_out = (const float*)d_in[12]; p.final_norm_w = (const float*)d_in[13];
    p.out = (float*)d_out; p.ws = (unsigned char*)d_ws;
    if (hipMemsetAsync((unsigned char*)d_ws + OFF_BAR, 0, 16384, stream) != hipSuccess) { fprintf(stderr, "kernel_launch: hipMemsetAsync failed\n"); return; }
    void* args[] = {&p};
    hipError_t e = hipLaunchCooperativeKernel((const void*)mega, dim3(grid), dim3(512), args, LDS_BYTES, stream);
    if (e != hipSuccess) fprintf(stderr, "cooperative launch failed: %s (grid %d)\n", hipGetErrorString(e), grid);
}
```

```cpp
#include <hip/hip_runtime.h>
#include <hip/hip_cooperative_groups.h>
#include <cstdio>
namespace cg = cooperative_groups;

#ifndef ENABLE_ATTN
#define ENABLE_ATTN 1
#endif
#ifndef ENABLE_GDN
#define ENABLE_GDN 1
#endif
#ifndef REP_PREP
#define REP_PREP 1
#endif
#ifndef REP_G1
#define REP_G1 1
#endif
#ifndef REP_GP
#define REP_GP 1
#endif
#ifndef REP_P3
#define REP_P3 1
#endif
#ifndef REP_G2
#define REP_G2 1
#endif
#ifndef REP_SCAN
#define REP_SCAN 1
#endif
#ifndef SCAN_SYNC
#define SCAN_SYNC 0
#endif
#ifndef REP_ATTN
#define REP_ATTN 1
#endif

#define LAS __attribute__((address_space(3)))
#define DI __device__ __forceinline__
typedef unsigned short bf16_t;
typedef short bf16x8 __attribute__((ext_vector_type(8)));
typedef short s16x4 __attribute__((ext_vector_type(4)));
typedef float f32x2 __attribute__((ext_vector_type(2)));
typedef float f32x4 __attribute__((ext_vector_type(4)));
typedef float f32x16 __attribute__((ext_vector_type(16)));
typedef unsigned u32x2 __attribute__((ext_vector_type(2)));
typedef unsigned u32x4 __attribute__((ext_vector_type(4)));
typedef __bf16 bf16x2_t __attribute__((ext_vector_type(2)));

#define MFMA32(a, b, c) __builtin_amdgcn_mfma_f32_32x32x16_bf16((a), (b), (c), 0, 0, 0)

constexpr int NB = 16, SEQ = 2048, DM = 1024, MTOK = NB * SEQ, NP1 = 3072, NG1 = 3584;
constexpr int C_GQ = 0, C_GK = 512, C_GV = 1024, C_GZ = 1536, C_DQ = 2048, C_DZ = 2560;
constexpr float EPS = 1e-6f;
constexpr float LOG2E = 1.4426950408889634f;

constexpr size_t OFF_HB = 0;
constexpr size_t OFF_WINT = OFF_HB + (size_t)MTOK * DM * 2;
constexpr size_t OFF_WOUTT = OFF_WINT + (size_t)4096 * 1024 * 2;
constexpr size_t OFF_GBGA = OFF_WOUTT + (size_t)1024 * 1024 * 2;
constexpr size_t OFF_P1 = OFF_GBGA + (size_t)MTOK * 8 * 4;
constexpr size_t OFF_KX = OFF_P1 + (size_t)MTOK * NP1 * 2;
constexpr size_t OFF_VT = OFF_KX + (size_t)64 * 2 * 2048 * 64 * 2;
constexpr size_t OFF_WN = OFF_VT + (size_t)64 * 128 * 2048 * 2;
constexpr size_t OFF_QD = OFF_WN + (size_t)2048 * 64 * 128 * 2;
constexpr size_t OFF_KD = OFF_QD + (size_t)2048 * 64 * 128 * 2;
constexpr size_t OFF_AQK = OFF_KD + (size_t)2048 * 64 * 128 * 2;
constexpr size_t OFF_U = OFF_AQK + (size_t)2048 * 64 * 64 * 2;
constexpr size_t OFF_GL = OFF_U + (size_t)2048 * 64 * 128 * 4;
constexpr size_t OFF_ROWSQ = OFF_GL + 8192;
constexpr size_t OFF_MISC = OFF_ROWSQ + (size_t)MTOK * 16 * 4;
constexpr size_t OFF_YB = OFF_P1;
constexpr size_t OFF_BAR = OFF_MISC + 256;
constexpr size_t WS_END = OFF_BAR + 16384;

constexpr int LDS_BYTES = 156 * 1024;

struct Params {
    const float *x, *norm_w, *w_in, *conv_w, *a_log, *dt_bias, *gdn_norm_w, *lq1, *lk1, *lq2, *lk2, *diff_norm_w, *w_out, *final_norm_w;
    float* out; unsigned char* ws;
};

DI unsigned pk_bf16(float a, float b) { f32x2 v = {a, b}; bf16x2_t r = __builtin_convertvector(v, bf16x2_t); return __builtin_bit_cast(unsigned, r); }
DI float bf_lo(unsigned u) { return __uint_as_float(u << 16); }
DI float bf_hi(unsigned u) { return __uint_as_float(u & 0xffff0000u); }
DI float wave_sum(float v) {
#pragma unroll
    for (int o = 32; o; o >>= 1) v += __shfl_xor(v, o);
    return v;
}
DI float xhalf_max(float v) {
    const u32x2 r = __builtin_amdgcn_permlane32_swap(__float_as_uint(v), __float_as_uint(v), false, false);
    return fmaxf(__uint_as_float(r.x), __uint_as_float(r.y));
}
DI float xhalf_sum(float v) {
    const u32x2 r = __builtin_amdgcn_permlane32_swap(__float_as_uint(v), __float_as_uint(v), false, false);
    return __uint_as_float(r.x) + __uint_as_float(r.y);
}
DI float silu_f(float z) { return z * __builtin_amdgcn_rcpf(1.0f + __builtin_amdgcn_exp2f(-LOG2E * z)); }
DI int perm23(int t) { return (t & ~12) | ((t & 4) << 1) | ((t & 8) >> 1); }
DI int crow(int i, int h2) { return (i & 3) + 8 * (i >> 2) + 4 * h2; }
DI bf16x8 pack8(const f32x16& x, int s) {
    u32x4 w; w.x = pk_bf16(x[8 * s + 0], x[8 * s + 1]); w.y = pk_bf16(x[8 * s + 2], x[8 * s + 3]); w.z = pk_bf16(x[8 * s + 4], x[8 * s + 5]); w.w = pk_bf16(x[8 * s + 6], x[8 * s + 7]);
    return __builtin_bit_cast(bf16x8, w);
}


#define XB_TMO      128
#define XB_XCNT(j)  (256  + 64 * (j))
#define XB_XSUB(j)  (1280 + 64 * (j))
#define XB_XGEN(j)  (2304 + 64 * (j))
#define XB_TOP      3328
#define XB_TOPGEN   3392
#define XCD_BAR_WORDS 3456
#define XB_SPIN_CAP (1u << 18)
struct XcdBarrier { unsigned* bar; unsigned x; volatile LAS unsigned* st; };
DI unsigned xb_ld(unsigned* p)              { return __hip_atomic_load(p, __ATOMIC_RELAXED, __HIP_MEMORY_SCOPE_AGENT); }
DI unsigned xb_add(unsigned* p, unsigned v) { return __hip_atomic_fetch_add(p, v, __ATOMIC_RELAXED, __HIP_MEMORY_SCOPE_AGENT); }
DI unsigned xb_xcc_id() { return (unsigned)__builtin_amdgcn_s_getreg((3 << 11) | 20) & 0xFu; }
#define XB_SPIN(cond, bar) do { unsigned _sp = 0; while (cond) { __builtin_amdgcn_s_sleep(1); \
    if ((++_sp & 255u) == 0u) { if (xb_ld(&(bar)[XB_TMO])) break; if (_sp > XB_SPIN_CAP) { atomicAdd(&(bar)[XB_TMO], 1u); break; } } } } while (0)
DI XcdBarrier xcd_barrier_post(unsigned* bar, volatile LAS unsigned* st) {
    XcdBarrier b; b.bar = bar; b.x = xb_xcc_id(); b.st = st;
    if (threadIdx.x == 0) (void)xb_add(&bar[XB_XCNT(b.x)], 1u);
    return b;
}
DI void xcd_barrier_complete(unsigned* bar, unsigned x, unsigned& nloc, unsigned& nx) {
    const unsigned G = gridDim.x * gridDim.y * gridDim.z;
    unsigned sum, cnt, mine, sp = 0u;
    for (;;) {
        sum = 0u; cnt = 0u; mine = 0u;
#pragma unroll
        for (unsigned j = 0; j < 16; ++j) { const unsigned c = xb_ld(&bar[XB_XCNT(j)]); sum += c; cnt += (c > 0u) ? 1u : 0u; mine = (j == x) ? c : mine; }
        if (sum == G) break;
        __builtin_amdgcn_s_sleep(1);
        if ((++sp & 255u) == 0u) { if (xb_ld(&bar[XB_TMO])) break; if (sp > XB_SPIN_CAP) { atomicAdd(&bar[XB_TMO], 1u); break; } }
    }
    nloc = mine > 0u ? mine : 1u; nx = cnt > 0u ? cnt : 1u;
}
DI void xcd_barrier(const XcdBarrier& b) {
    asm volatile("s_waitcnt vmcnt(0)" ::: "memory");
    __syncthreads();
    if (threadIdx.x == 0) {
        unsigned* bar = b.bar;
        __builtin_amdgcn_s_waitcnt(0);
        unsigned nloc = b.st[0], nx = b.st[1];
        if (nloc == 0u) { xcd_barrier_complete(bar, b.x, nloc, nx); b.st[0] = nloc; b.st[1] = nx; }
        const unsigned old = xb_add(&bar[XB_XSUB(b.x)], 1u);
        const unsigned gen = old / nloc;
        if (old + 1u == (gen + 1u) * nloc) {
            __builtin_amdgcn_fence(__ATOMIC_RELEASE, "agent");
            asm volatile("s_waitcnt vmcnt(0)" ::: "memory");
            const unsigned og = xb_add(&bar[XB_TOP], 1u);
            const unsigned tg = og / nx;
            if (og + 1u == (tg + 1u) * nx) xb_add(&bar[XB_TOPGEN], 1u);
            else XB_SPIN(xb_ld(&bar[XB_TOPGEN]) == tg, bar);
            __builtin_amdgcn_fence(__ATOMIC_ACQUIRE, "agent");
            xb_add(&bar[XB_XGEN(b.x)], 1u);
            asm volatile("s_waitcnt vmcnt(0)" ::: "memory");
        } else {
            XB_SPIN(xb_ld(&bar[XB_XGEN(b.x)]) == gen, bar);
            __builtin_amdgcn_fence(__ATOMIC_ACQUIRE, "agent");
            asm volatile("s_waitcnt vmcnt(0)" ::: "memory");
        }
    }
    __syncthreads();
}

namespace pg8 {
constexpr int BM = 256, BK = 64, HALF = 128, HTB = HALF * BK * 2, STAGE_BYTES = 8 * HTB, NXCD = 8, WGM = 8;
DI int lds_byte(int r, int c) { const int st = (r >> 4) * 2 + (c >> 5), rr = r & 15, cc = c & 31, ob = rr * 64 + cc * 2; return st * 1024 + (ob ^ (((ob >> 9) & 1) << 5)); }
DI void stage_rc(int b, int& R, int& C) { const int st = b / 1024, sb = b % 1024, swz = sb ^ (((sb >> 9) & 1) << 5); R = (st >> 1) * 16 + swz / 64; C = (st & 1) * 32 + (swz % 64) / 2; }
DI int perm32(int rho) { const int n = rho >> 4, i = rho & 15; return 8 * (i >> 2) + 4 * n + (i & 3); }
struct Unit { int pm, pn; };
struct Gemm { const bf16_t* A; const bf16_t* Bt; int M, N, K; };
struct StaticOrder {
    int nM, nN, nwg, G, c, i0 = 0, imax = 1 << 30;
    DI void init(int M, int N, int G_, int c_) { nM = M / BM; nN = N / BM; nwg = nM * nN; G = G_; c = c_; }
    DI bool next(int i, Unit& u) const {
        if (i >= imax) return false;
        const long L = (long)(i + i0) * G + c; if (L >= nwg) return false;
        int wgid = (int)L; { const int q = nwg / NXCD, r = nwg % NXCD, xcd = wgid % NXCD, off = wgid / NXCD; wgid = (xcd < r ? xcd * (q + 1) : r * (q + 1) + (xcd - r) * q) + off; }
        const int nig = WGM * nN, gid = wgid / nig, fm = gid * WGM, gsz = (nM - fm) < WGM ? (nM - fm) : WGM;
        u.pm = fm + ((wgid % nig) % gsz); u.pn = (wgid % nig) / gsz; return true;
    }
    DI void a_ready(const Unit&) const {}
    DI void done(const Unit&) const {}
};

struct EpiP1 {
    static constexpr bool PERM = true, PERM16 = true, AFTER_DRAIN = false;
    bf16_t* O; int ldc; bf16_t* KX;
    DI void operator()(const f32x4 (&acc)[2][2][4][2], const Unit& u, int wr, int wc, int fr, int fq) const {
        const int row0 = u.pm * BM + wr * 64 + fr, col0 = u.pn * BM + wc * 64 + 16 * fq;
        if (u.pn >= 12) {
            const int c = col0 - 12 * BM, hm = c >> 6, d = c & 63;
#pragma unroll
            for (int ai = 0; ai < 2; ++ai)
#pragma unroll
                for (int m = 0; m < 4; ++m) { const int row = row0 + ai * HALF + m * 16, b = row >> 11, tok = row & 2047;
                    bf16_t* dp = KX + ((size_t)(b * 8 + hm) * 2048 + tok) * 64 + d;
#pragma unroll
                    for (int bj = 0; bj < 2; ++bj) { const f32x4 v0 = acc[ai][bj][m][0], v1 = acc[ai][bj][m][1];
                        u32x4 w; w.x = pk_bf16(v0[0], v0[1]); w.y = pk_bf16(v0[2], v0[3]); w.z = pk_bf16(v1[0], v1[1]); w.w = pk_bf16(v1[2], v1[3]);
                        *(u32x4*)(dp + 8 * bj) = w; } }
            return;
        }
#pragma unroll
        for (int ai = 0; ai < 2; ++ai)
#pragma unroll
            for (int m = 0; m < 4; ++m) { bf16_t* rowp = O + (size_t)(row0 + ai * HALF + m * 16) * ldc + col0;
#pragma unroll
                for (int bj = 0; bj < 2; ++bj) { const f32x4 v0 = acc[ai][bj][m][0], v1 = acc[ai][bj][m][1];
                    u32x4 w; w.x = pk_bf16(v0[0], v0[1]); w.y = pk_bf16(v0[2], v0[3]); w.z = pk_bf16(v1[0], v1[1]); w.w = pk_bf16(v1[2], v1[3]);
                    *(u32x4*)(rowp + 8 * bj) = w; } }
    }
};
struct EpiVT {
    static constexpr bool PERM = false, PERM16 = false, AFTER_DRAIN = false;
    bf16_t* VT;
    DI void operator()(const f32x4 (&acc)[2][2][4][2], const Unit& u, int wr, int wc, int fr, int fq) const {
#pragma unroll
        for (int ai = 0; ai < 2; ++ai)
#pragma unroll
            for (int m = 0; m < 4; ++m) {
                const int t = u.pm * BM + ai * HALF + wr * 64 + m * 16 + 4 * fq, b = t >> 11, tok = t & 2047, pos = perm23(tok);
#pragma unroll
                for (int bj = 0; bj < 2; ++bj)
#pragma unroll
                    for (int n = 0; n < 2; ++n) {
                        const int c = u.pn * BM + bj * HALF + wc * 32 + n * 16 + fr, hh = c >> 7, dv = c & 127;
                        const f32x4 v = acc[ai][bj][m][n];
                        u32x2 w; w.x = pk_bf16(v[0], v[1]); w.y = pk_bf16(v[2], v[3]);
                        *(u32x2*)(VT + (((size_t)((b * 4 + hh) * 32 + (pos >> 6)) * 128 + dv)) * 64 + (pos & 63)) = w;
                    }
            }
    }
};
static_assert(WGM == 8, "EpiOutFused needs the four column tiles of a row panel in the same round");
struct EpiOutFused {
    static constexpr bool PERM = false, PERM16 = false, AFTER_DRAIN = true;
    const float* X; float* Out; float* rowsq; const float* fw; XcdBarrier xb;
    DI void operator()(const f32x4 (&)[2][2][4][2], const Unit&, int, int, int, int) const {}
    DI void fused(f32x4 (&acc)[2][2][4][2], const Unit& u, int wr, int wc, int fr, int fq) const {
        const int row0 = u.pm * BM + wr * 64 + fr, col0 = u.pn * BM + wc * 32 + 4 * fq;
#pragma unroll
        for (int ai = 0; ai < 2; ++ai)
#pragma unroll
            for (int m = 0; m < 4; ++m) {
                const int row = row0 + ai * HALF + m * 16; float ss = 0.f;
#pragma unroll
                for (int bj = 0; bj < 2; ++bj)
#pragma unroll
                    for (int n = 0; n < 2; ++n) {
                        const size_t o = (size_t)row * DM + col0 + bj * HALF + n * 16;
                        const f32x4 y = acc[ai][bj][m][n] + *(const f32x4*)(X + o);
                        acc[ai][bj][m][n] = y; ss += y[0] * y[0] + y[1] * y[1] + y[2] * y[2] + y[3] * y[3];
                    }
                ss += __shfl_xor(ss, 16); ss += __shfl_xor(ss, 32);
                if (fq == 0) rowsq[(size_t)row * 16 + u.pn * 4 + wc] = ss;
            }
        xcd_barrier(xb);
        f32x4 fwv[2][2];
#pragma unroll
        for (int bj = 0; bj < 2; ++bj)
#pragma unroll
            for (int n = 0; n < 2; ++n) fwv[bj][n] = *(const f32x4*)(fw + col0 + bj * HALF + n * 16);
#pragma unroll
        for (int ai = 0; ai < 2; ++ai)
#pragma unroll
            for (int m = 0; m < 4; ++m) {
                const int row = row0 + ai * HALF + m * 16;
                const f32x4* rq = (const f32x4*)(rowsq + (size_t)row * 16);
                const f32x4 q0 = rq[0], q1 = rq[1], q2 = rq[2], q3 = rq[3];
                const float tot = ((q0[0] + q0[1]) + (q0[2] + q0[3])) + ((q1[0] + q1[1]) + (q1[2] + q1[3])) + ((q2[0] + q2[1]) + (q2[2] + q2[3])) + ((q3[0] + q3[1]) + (q3[2] + q3[3]));
                const float rstd = rsqrtf(tot * (1.0f / DM) + EPS);
#pragma unroll
                for (int bj = 0; bj < 2; ++bj)
#pragma unroll
                    for (int n = 0; n < 2; ++n) {
                        const size_t o = (size_t)row * DM + col0 + bj * HALF + n * 16;
                        *(f32x4*)(Out + o) = acc[ai][bj][m][n] * rstd * fwv[bj][n];
                    }
            }
    }
};

template <class Epi, bool SWAP>
DI void gemm_phase(LAS unsigned char* lds, const Gemm g, const StaticOrder& S, const Epi& E) {
    int tid = threadIdx.x; asm volatile("" : "+v"(tid));
    const int wid = __builtin_amdgcn_readfirstlane(tid >> 6), lane = tid & 63, wr = wid >> 2, wc = wid & 3, fr = lane & 15, fq = lane >> 4;
    const int K = g.K, nt = K / BK;
    unsigned voffA[2], voffB[2], voffB1[2];
#pragma unroll
    for (int i = 0; i < 2; ++i) { int R, C; stage_rc(tid * 16 + i * 8192, R, C); const int Rb = Epi::PERM ? ((R & ~31) + perm32(R & 31)) : R;
        voffA[i] = (unsigned)(R * K + C) * 2u;
        if constexpr (Epi::PERM16) {
            const int c0 = 64 * (R >> 5) + 16 * ((R >> 2) & 3) + 4 * ((R >> 4) & 1) + (R & 3);
            voffB[i] = (unsigned)(c0 * K + C) * 2u; voffB1[i] = (unsigned)((c0 + 8) * K + C) * 2u;
        } else { voffB[i] = (unsigned)(Rb * K + C) * 2u; voffB1[i] = voffB[i]; } }
    const size_t kstep = (size_t)(BK * 2);
    const size_t hstep = (size_t)HALF * K * 2;
    const size_t tstep = 2 * hstep;
    const size_t hoff = Epi::PERM16 ? 0 : hstep;
    const unsigned ldsw = (unsigned)wid * 1024u;
    const int aoff = lds_byte(wr * 64 + fr, fq * 8), boff = lds_byte(wc * 32 + fr, fq * 8);
#define PG8_SA(b, h) (((b) * 2 + (h)) * HTB)
#define PG8_SB(b, h) ((4 + (b) * 2 + (h)) * HTB)
#define PG8_STAGE(bufoff, gbase, voff) do { _Pragma("unroll") for (int _i = 0; _i < 2; ++_i) \
        __builtin_amdgcn_global_load_lds((const unsigned*)((const char*)(gbase) + (voff)[_i]), (LAS unsigned*)(lds + (bufoff) + ldsw + _i * 8192), 16, 0, 0); } while (0)
#define PG8_LDA(dst, b, h) do { _Pragma("unroll") for (int m = 0; m < 4; ++m) _Pragma("unroll") for (int k = 0; k < 2; ++k) dst[m][k] = *(const LAS bf16x8*)(lds + PG8_SA(b, h) + aoff + m * 2048 + k * 1024); } while (0)
#define PG8_LDB(dst, b, h) do { _Pragma("unroll") for (int n = 0; n < 2; ++n) _Pragma("unroll") for (int k = 0; k < 2; ++k) dst[n][k] = *(const LAS bf16x8*)(lds + PG8_SB(b, h) + boff + n * 2048 + k * 1024); } while (0)
#define PG8_MMA(ai, bj, At, Bt) do { __builtin_amdgcn_s_setprio(1); _Pragma("unroll") for (int m = 0; m < 4; ++m) _Pragma("unroll") for (int n = 0; n < 2; ++n) _Pragma("unroll") for (int k = 0; k < 2; ++k) \
        acc[ai][bj][m][n] = SWAP ? __builtin_amdgcn_mfma_f32_16x16x32_bf16(At[m][k], Bt[n][k], acc[ai][bj][m][n], 0, 0, 0) \
                                 : __builtin_amdgcn_mfma_f32_16x16x32_bf16(Bt[n][k], At[m][k], acc[ai][bj][m][n], 0, 0, 0); __builtin_amdgcn_s_setprio(0); } while (0)
#define PG8_WAIT_V(n) asm volatile("s_waitcnt vmcnt(" #n ")" ::: "memory")
#define PG8_WAIT_L(n) asm volatile("s_waitcnt lgkmcnt(" #n ")" ::: "memory")
#define PG8_BAR __builtin_amdgcn_s_barrier()
#define PG8_SCHED __builtin_amdgcn_sched_barrier(0)
    Unit cur, nxt; int ui = 0;
    if (!S.next(0, cur)) return;
    f32x4 acc[2][2][4][2];
#pragma unroll
    for (int a = 0; a < 2; ++a)
#pragma unroll
        for (int b = 0; b < 2; ++b)
#pragma unroll
            for (int m = 0; m < 4; ++m)
#pragma unroll
                for (int n = 0; n < 2; ++n) acc[a][b][m][n] = (f32x4){0.f, 0.f, 0.f, 0.f};
    bf16x8 At[4][2], B0[2][2], B1[2][2];
    const char* cA = (const char*)g.A + (size_t)cur.pm * tstep; const char* cB = (const char*)g.Bt + (size_t)cur.pn * tstep;
    PG8_STAGE(PG8_SB(0, 0), cB, voffB); PG8_STAGE(PG8_SA(0, 0), cA, voffA); PG8_STAGE(PG8_SB(0, 1), cB + hoff, voffB1); PG8_STAGE(PG8_SA(0, 1), cA + hstep, voffA);
    if (wr == 1) PG8_BAR;
    PG8_WAIT_V(4); PG8_BAR;
    PG8_STAGE(PG8_SB(1, 0), cB + kstep, voffB); PG8_STAGE(PG8_SA(1, 0), cA + kstep, voffA); PG8_STAGE(PG8_SB(1, 1), cB + hoff + kstep, voffB1);
    PG8_WAIT_V(6); PG8_BAR;
    for (;;) {
        const bool has_next = S.next(ui + 1, nxt);
        const char* nA = has_next ? (const char*)g.A + (size_t)nxt.pm * tstep : cA; const char* nB = has_next ? (const char*)g.Bt + (size_t)nxt.pn * tstep : cB;
        for (int t = 0; t < nt; t += 2) {
            const bool last = (t == nt - 2);
            const char* a1 = cA + (size_t)(t + 1) * kstep;
            const char* a2 = last ? nA : cA + (size_t)(t + 2) * kstep; const char* b2 = last ? nB : cB + (size_t)(t + 2) * kstep;
            const char* a3 = a2 + kstep; const char* b3 = b2 + kstep;
            PG8_LDB(B0, 0, 0); PG8_SCHED; PG8_LDA(At, 0, 0); PG8_STAGE(PG8_SA(1, 1), a1 + hstep, voffA);
            PG8_WAIT_L(8); PG8_BAR; PG8_WAIT_L(0); PG8_MMA(0, 0, At, B0); PG8_BAR; PG8_SCHED;
            PG8_LDB(B1, 0, 1); PG8_STAGE(PG8_SB(0, 0), b2, voffB);
            PG8_BAR; PG8_WAIT_L(0); PG8_MMA(0, 1, At, B1); PG8_BAR;
            PG8_LDA(At, 0, 1); PG8_STAGE(PG8_SA(0, 0), a2, voffA);
            PG8_BAR; PG8_WAIT_L(0); PG8_MMA(1, 0, At, B0); PG8_BAR; PG8_SCHED;
            PG8_STAGE(PG8_SB(0, 1), b2 + hoff, voffB1);
            PG8_WAIT_V(6); PG8_BAR; PG8_MMA(1, 1, At, B1); PG8_BAR;
            PG8_LDB(B0, 1, 0); PG8_SCHED; PG8_LDA(At, 1, 0); PG8_STAGE(PG8_SA(0, 1), a2 + hstep, voffA);
            PG8_WAIT_L(8); PG8_BAR; PG8_WAIT_L(0); PG8_MMA(0, 0, At, B0); PG8_BAR; PG8_SCHED;
            PG8_LDB(B1, 1, 1); PG8_STAGE(PG8_SB(1, 0), b3, voffB);
            PG8_BAR; PG8_WAIT_L(0); PG8_MMA(0, 1, At, B1); PG8_BAR;
            PG8_LDA(At, 1, 1); PG8_STAGE(PG8_SA(1, 0), a3, voffA);
            PG8_BAR; PG8_WAIT_L(0); PG8_MMA(1, 0, At, B0); PG8_BAR; PG8_SCHED;
            PG8_STAGE(PG8_SB(1, 1), b3 + hoff, voffB1);
            PG8_WAIT_V(6); PG8_BAR; PG8_MMA(1, 1, At, B1); PG8_BAR;
        }
        if constexpr (!Epi::AFTER_DRAIN) E(acc, cur, wr, wc, fr, fq);
        if (!has_next) break;
#pragma unroll
        for (int a = 0; a < 2; ++a)
#pragma unroll
            for (int b = 0; b < 2; ++b)
#pragma unroll
                for (int m = 0; m < 4; ++m)
#pragma unroll
                    for (int n = 0; n < 2; ++n) acc[a][b][m][n] = (f32x4){0.f, 0.f, 0.f, 0.f};
        cur = nxt; cA = nA; cB = nB; ++ui;
    }
    PG8_WAIT_V(0);
    if (wr == 0) PG8_BAR;
    PG8_BAR;
    if constexpr (Epi::AFTER_DRAIN) E.fused(acc, cur, wr, wc, fr, fq);
#undef PG8_SA
#undef PG8_SB
#undef PG8_STAGE
#undef PG8_LDA
#undef PG8_LDB
#undef PG8_MMA
#undef PG8_WAIT_V
#undef PG8_WAIT_L
#undef PG8_BAR
#undef PG8_SCHED
}
}

DI int win_src_col(int n0) {
    if (n0 < 2048) return n0;
    if (n0 < 2560) return 2056 + (n0 - 2048);
    if (n0 < 3072) return 3592 + (n0 - 2560);
    if (n0 < 3584) return 2568 + (n0 - 3072);
    return 3080 + (n0 - 3584);
}
DI void phase_prep(const Params& p, LAS unsigned char* lds) {
    int tid = threadIdx.x; asm volatile("" : "+v"(tid));
    const int lane = tid & 63, wid = tid >> 6;
    if (blockIdx.x == 0 && wid == 0) {
        float a = p.lq1[lane] * p.lk1[lane], b = p.lq2[lane] * p.lk2[lane];
        a = wave_sum(a); b = wave_sum(b);
        if (lane == 0) { *(float*)(p.ws + OFF_MISC) = expf(a) - expf(b) + 0.2f; *(unsigned*)(p.ws + OFF_MISC + 4) = 0u; *(unsigned*)(p.ws + OFF_MISC + 8) = 0u; *(unsigned*)(p.ws + OFF_MISC + 12) = 0u; }
    }
    bf16_t* hb = (bf16_t*)(p.ws + OFF_HB);
    float* gbga = (float*)(p.ws + OFF_GBGA);
    const int gw = blockIdx.x * 8 + wid, nw = gridDim.x * 8;
    {
        f32x4 nwv[4]; float wq[16][8];
#pragma unroll
        for (int i = 0; i < 4; ++i) {
            nwv[i] = ((const f32x4*)p.norm_w)[lane + 64 * i];
#pragma unroll
            for (int e = 0; e < 4; ++e) {
                const int k = 4 * (lane + 64 * i) + e;
                const f32x4* wp = (const f32x4*)(p.w_in + (size_t)k * 4104 + 2048);
                const f32x4 w0 = wp[0], w1 = wp[1];
#pragma unroll
                for (int j = 0; j < 4; ++j) { wq[4 * i + e][j] = nwv[i][e] * w0[j]; wq[4 * i + e][4 + j] = nwv[i][e] * w1[j]; }
            }
        }
        const bool b5 = (lane & 32) != 0, b4 = (lane & 16) != 0, b3 = (lane & 8) != 0;
        const int col = (b5 ? 4 : 0) + (b4 ? 2 : 0) + (b3 ? 1 : 0);
        int row = gw;
        f32x4 v[4];
        if (row < MTOK) {
#pragma unroll
            for (int i = 0; i < 4; ++i) v[i] = __builtin_nontemporal_load((const f32x4*)(p.x + (size_t)row * DM) + lane + 64 * i);
        }
#pragma unroll 1
        for (; row < MTOK; row += nw) {
            f32x4 vnx[4];
            const int rnx = (row + nw < MTOK) ? row + nw : row;
#pragma unroll
            for (int i = 0; i < 4; ++i) vnx[i] = __builtin_nontemporal_load((const f32x4*)(p.x + (size_t)rnx * DM) + lane + 64 * i);
            float ss = 0.f, a8[8];
#pragma unroll
            for (int j = 0; j < 8; ++j) a8[j] = 0.f;
#pragma unroll
            for (int i = 0; i < 4; ++i)
#pragma unroll
                for (int e = 0; e < 4; ++e) {
                    ss += v[i][e] * v[i][e];
#pragma unroll
                    for (int j = 0; j < 8; ++j) a8[j] += v[i][e] * wq[4 * i + e][j];
                }
            ss = wave_sum(ss);
            const float rstd = rsqrtf(ss * (1.0f / DM) + EPS);
#pragma unroll
            for (int i = 0; i < 4; ++i) {
                const f32x4 h = v[i] * rstd * nwv[i];
                u32x2 w; w.x = pk_bf16(h[0], h[1]); w.y = pk_bf16(h[2], h[3]);
                *(u32x2*)(hb + (size_t)row * DM + 4 * (lane + 64 * i)) = w;
            }
            float c4[4], c2[2], c1;
#pragma unroll
            for (int j = 0; j < 4; ++j) { const float send = b5 ? a8[j] : a8[4 + j], keep = b5 ? a8[4 + j] : a8[j]; c4[j] = keep + __shfl_xor(send, 32); }
#pragma unroll
            for (int j = 0; j < 2; ++j) { const float send = b4 ? c4[j] : c4[2 + j], keep = b4 ? c4[2 + j] : c4[j]; c2[j] = keep + __shfl_xor(send, 16); }
            { const float send = b3 ? c2[0] : c2[1], keep = b3 ? c2[1] : c2[0]; c1 = keep + __shfl_xor(send, 8); }
            c1 += __shfl_xor(c1, 4); c1 += __shfl_xor(c1, 2); c1 += __shfl_xor(c1, 1);
            if ((lane & 7) == 0) gbga[(size_t)row * 8 + col] = c1 * rstd;
#pragma unroll
            for (int i = 0; i < 4; ++i) v[i] = vnx[i];
        }
    }
    LAS float* tl = (LAS float*)lds;
    for (int tile = blockIdx.x; tile < 1024 + 256; tile += gridDim.x) {
        const float* src; int ld, n0, k0, srcn0; bf16_t* dst;
        if (tile < 1024) { n0 = (tile >> 4) * 64; k0 = (tile & 15) * 64; srcn0 = win_src_col(n0); src = p.w_in; ld = 4104; dst = (bf16_t*)(p.ws + OFF_WINT); }
        else { const int t2 = tile - 1024; n0 = (t2 >> 4) * 64; k0 = (t2 & 15) * 64; srcn0 = n0; src = p.w_out; ld = 1024; dst = (bf16_t*)(p.ws + OFF_WOUTT); }
        const int kk = tid >> 4, n4 = tid & 15;
#pragma unroll
        for (int ps = 0; ps < 2; ++ps) { const int k = kk + 32 * ps;
            const f32x4 v = __builtin_nontemporal_load((const f32x4*)(src + (size_t)(k0 + k) * ld + srcn0 + 4 * n4));
#pragma unroll
            for (int e = 0; e < 4; ++e) tl[k * 65 + 4 * n4 + e] = v[e]; }
        __syncthreads();
        { const int n = tid >> 3, k8 = tid & 7; float f[8];
#pragma unroll
            for (int e = 0; e < 8; ++e) f[e] = tl[(8 * k8 + e) * 65 + n];
            u32x4 w; w.x = pk_bf16(f[0], f[1]); w.y = pk_bf16(f[2], f[3]); w.z = pk_bf16(f[4], f[5]); w.w = pk_bf16(f[6], f[7]);
            *(u32x4*)(dst + (size_t)(n0 + n) * 1024 + k0 + 8 * k8) = w; }
        __syncthreads();
    }
}

constexpr int AT_KB = 8192, AT_VB = 16384, AT_BUF = AT_KB + AT_VB, AT_NBUF = 3, AT_TASK = AT_NBUF * AT_BUF, AT_O1 = AT_TASK + 256;

DI void attn_qblock(const Params& p, LAS unsigned char* lds, int b, int hh, int qb, float lam) {
    int tid = threadIdx.x; asm volatile("" : "+v"(tid));
    const int lane = tid & 63, wid = __builtin_amdgcn_readfirstlane(tid >> 6);
    const bf16_t* P1 = (const bf16_t*)(p.ws + OFF_P1);
    const bf16_t* VT = (const bf16_t*)(p.ws + OFF_VT) + (size_t)(b * 4 + hh) * 32 * 128 * 64;
    const bf16_t* KX = (const bf16_t*)(p.ws + OFF_KX) + (size_t)(b * 4 + hh) * 2 * 2048 * 64;
    bf16_t* mix = (bf16_t*)(p.ws + OFF_HB);
    const int q0 = qb * 256 + wid * 32;
    const size_t tokbase = (size_t)b * SEQ;
    const int nkt = (qb + 1) * 4;
    const float sl2 = exp2f(-2.0f * (float)(hh + 1)) * LOG2E;
    const float c1 = 0.125f * LOG2E;
#pragma unroll 1
    for (int map = 0; map < 2; ++map) {
        f32x16 O[4];
#pragma unroll
        for (int mt = 0; mt < 4; ++mt)
#pragma unroll
            for (int i = 0; i < 16; ++i) O[mt][i] = 0.f;
        float m = -INFINITY, l = 0.f;
        int lane_m = lane; asm volatile("" : "+v"(lane_m));
        const int r = lane_m & 31, h2 = lane_m >> 5;
        int foff[4];
#pragma unroll
        for (int k = 0; k < 4; ++k) foff[k] = r * 128 + (((2 * k + h2) ^ ((r >> 1) & 7)) << 4);
        float kb[16];
#pragma unroll
        for (int i = 0; i < 16; ++i) kb[i] = sl2 * (float)crow(i, h2);
        const int krow_ = 8 * wid + (lane_m >> 3), vrow0 = 16 * wid + (lane_m >> 3), vrow1 = vrow0 + 8;
        const bf16_t* kgp = KX + ((size_t)map * 2048 + krow_) * 64 + (((lane_m & 7) ^ ((krow_ >> 1) & 7)) * 8);
        const bf16_t* vgp0 = VT + (size_t)vrow0 * 64 + (((lane_m & 7) ^ ((vrow0 >> 1) & 7)) * 8);
        const bf16_t* vgp1 = VT + (size_t)vrow1 * 64 + (((lane_m & 7) ^ ((vrow1 >> 1) & 7)) * 8);
#define AT_STAGE(bufi, tile) do { LAS unsigned char* _b = lds + (bufi) * AT_BUF; \
            __builtin_amdgcn_global_load_lds((const unsigned*)(kgp + (size_t)(tile) * 64 * 64), (LAS unsigned*)(_b + wid * 1024), 16, 0, 0); \
            __builtin_amdgcn_global_load_lds((const unsigned*)(vgp0 + (size_t)(tile) * 128 * 64), (LAS unsigned*)(_b + AT_KB + wid * 2048), 16, 0, 0); \
            __builtin_amdgcn_global_load_lds((const unsigned*)(vgp1 + (size_t)(tile) * 128 * 64), (LAS unsigned*)(_b + AT_KB + wid * 2048 + 1024), 16, 0, 0); } while (0)
        bf16x8 qf[4];
        { const bf16_t* qp = P1 + (tokbase + q0 + (lane_m & 31)) * NP1 + C_DQ + hh * 128 + map * 64 + 8 * (lane_m >> 5);
#pragma unroll
            for (int ks = 0; ks < 4; ++ks) qf[ks] = *(const bf16x8*)(qp + 16 * ks); }
        AT_STAGE(0, 0);
        AT_STAGE(1, 1);
        asm volatile("" : "+v"(qf[0]), "+v"(qf[1]), "+v"(qf[2]), "+v"(qf[3]));
        int cb = 0;
#pragma unroll 1
        for (int kt = 0; kt < nkt; ++kt) {
            asm volatile("s_waitcnt vmcnt(0)" ::: "memory");
            __builtin_amdgcn_s_barrier();
            asm volatile("" ::: "memory");
            if (kt + 2 < nkt) { const int nb = cb == 0 ? 2 : cb - 1; AT_STAGE(nb, kt + 2); }
            const LAS unsigned char* cur = lds + cb * AT_BUF;
            cb = cb == 2 ? 0 : cb + 1;
            const int k0 = kt * 64;
            if (k0 <= q0) {
                const bool sub1 = (k0 + 32 <= q0);
                const LAS unsigned char* vb = cur + AT_KB;
                bf16x8 kf[8];
#pragma unroll
                for (int ks = 0; ks < 4; ++ks) kf[ks] = *(const LAS bf16x8*)(cur + foff[ks]);
                if (sub1) {
#pragma unroll
                    for (int ks = 0; ks < 4; ++ks) kf[4 + ks] = *(const LAS bf16x8*)(cur + 4096 + foff[ks]);
                }
                f32x16 s0, s1;
#pragma unroll
                for (int i = 0; i < 16; ++i) { s0[i] = 0.f; s1[i] = 0.f; }
#pragma unroll
                for (int ks = 0; ks < 4; ++ks) s0 = MFMA32(kf[ks], qf[ks], s0);
                if (sub1) {
#pragma unroll
                    for (int ks = 0; ks < 4; ++ks) s1 = MFMA32(kf[4 + ks], qf[ks], s1);
                }
                __builtin_amdgcn_sched_barrier(0);
                bf16x8 va[8];
#pragma unroll
                for (int s2 = 0; s2 < 2; ++s2)
#pragma unroll
                    for (int mt = 0; mt < 4; ++mt) va[s2 * 4 + mt] = *(const LAS bf16x8*)(vb + mt * 4096 + foff[s2]);
                __builtin_amdgcn_sched_barrier(0);
                const float off0 = sl2 * (float)(k0 - q0), off1 = off0 + 32.0f * sl2;
                const f32x2 c1v = {c1, c1};
#pragma unroll
                for (int j = 0; j < 8; ++j) {
                    const f32x2 kv = {kb[2 * j], kb[2 * j + 1]};
                    f32x2 a = {s0[2 * j], s0[2 * j + 1]}, c = {s1[2 * j], s1[2 * j + 1]};
                    a = __builtin_elementwise_fma(a, c1v, kv); c = __builtin_elementwise_fma(c, c1v, kv);
                    s0[2 * j] = a.x; s0[2 * j + 1] = a.y; s1[2 * j] = c.x; s1[2 * j + 1] = c.y;
                }
                if (k0 == q0) {
#pragma unroll
                    for (int i = 0; i < 16; ++i) if (crow(i, h2) > r) s0[i] = -INFINITY;
                }
                if (k0 + 32 == q0) {
#pragma unroll
                    for (int i = 0; i < 16; ++i) if (crow(i, h2) > r) s1[i] = -INFINITY;
                }
                float mx0 = fmaxf(s0[0], s0[1]), mx1 = fmaxf(s1[0], s1[1]);
#pragma unroll
                for (int j = 1; j < 8; ++j) { mx0 = fmaxf(fmaxf(s0[2 * j], s0[2 * j + 1]), mx0); mx1 = fmaxf(fmaxf(s1[2 * j], s1[2 * j + 1]), mx1); }
                float mx = sub1 ? fmaxf(mx0 + off0, mx1 + off1) : mx0 + off0;
                mx = xhalf_max(mx);
                if (__builtin_amdgcn_ballot_w64(mx > m + 8.0f) != 0ull) {
                    const float mn = fmaxf(m, mx);
                    const float alpha = __builtin_amdgcn_exp2f(m - mn);
                    m = mn; l *= alpha;
#pragma unroll
                    for (int mt = 0; mt < 4; ++mt)
#pragma unroll
                        for (int i = 0; i < 16; ++i) O[mt][i] *= alpha;
                }
                const float r0 = m - off0, r1 = sub1 ? m - off1 : INFINITY;
                const f32x2 r0v = {r0, r0}, r1v = {r1, r1};
                f32x2 lsv = {0.f, 0.f};
#pragma unroll
                for (int j = 0; j < 8; ++j) {
                    f32x2 a = {s0[2 * j], s0[2 * j + 1]}, c = {s1[2 * j], s1[2 * j + 1]};
                    a = a - r0v; c = c - r1v;
                    a.x = __builtin_amdgcn_exp2f(a.x); a.y = __builtin_amdgcn_exp2f(a.y); c.x = __builtin_amdgcn_exp2f(c.x); c.y = __builtin_amdgcn_exp2f(c.y);
                    lsv = lsv + a; lsv = lsv + c;
                    s0[2 * j] = a.x; s0[2 * j + 1] = a.y; s1[2 * j] = c.x; s1[2 * j + 1] = c.y;
                }
                l += lsv.x + lsv.y;
                bf16x8 pf[4];
#pragma unroll
                for (int s = 0; s < 2; ++s) { pf[s] = pack8(s0, s); pf[2 + s] = pack8(s1, s); }
                __builtin_amdgcn_sched_barrier(0);
                bf16x8 vc[4], vd[4];
                if (sub1) {
#pragma unroll
                    for (int mt = 0; mt < 4; ++mt) vc[mt] = *(const LAS bf16x8*)(vb + mt * 4096 + foff[2]);
                }
#pragma unroll
                for (int mt = 0; mt < 4; ++mt) O[mt] = MFMA32(va[mt], pf[0], O[mt]);
                if (sub1) {
#pragma unroll
                    for (int mt = 0; mt < 4; ++mt) vd[mt] = *(const LAS bf16x8*)(vb + mt * 4096 + foff[3]);
                }
#pragma unroll
                for (int mt = 0; mt < 4; ++mt) O[mt] = MFMA32(va[4 + mt], pf[1], O[mt]);
                if (sub1) {
#pragma unroll
                    for (int mt = 0; mt < 4; ++mt) O[mt] = MFMA32(vc[mt], pf[2], O[mt]);
#pragma unroll
                    for (int mt = 0; mt < 4; ++mt) O[mt] = MFMA32(vd[mt], pf[3], O[mt]);
                }
            }
        }
        asm volatile("" ::: "memory");
        __builtin_amdgcn_s_barrier();
        asm volatile("" ::: "memory");
#undef AT_STAGE
        const float lt = xhalf_sum(l);
        int lane_o = lane; asm volatile("" : "+v"(lane_o));
        LAS unsigned* o1l = (LAS unsigned*)(lds + AT_O1 + wid * 8192) + lane_o;
        if (map == 0) {
            const float inv1 = 1.0f / lt;
#pragma unroll
            for (int mt = 0; mt < 4; ++mt)
#pragma unroll
                for (int j = 0; j < 8; ++j) o1l[(mt * 8 + j) * 64] = pk_bf16(O[mt][2 * j] * inv1, O[mt][2 * j + 1] * inv1);
        } else {
            const float inv2 = lam / lt;
            float ss = 0.f;
#pragma unroll
            for (int mt = 0; mt < 4; ++mt)
#pragma unroll
                for (int j = 0; j < 8; ++j) {
                    const unsigned o1 = o1l[(mt * 8 + j) * 64];
                    const float a = bf_lo(o1) - O[mt][2 * j] * inv2, c = bf_hi(o1) - O[mt][2 * j + 1] * inv2;
                    O[mt][2 * j] = a; O[mt][2 * j + 1] = c; ss += a * a + c * c;
                }
            ss = xhalf_sum(ss);
            const float rs = rsqrtf(ss * (1.0f / 128.0f) + EPS) * 0.8f;
#pragma unroll
            for (int mt = 0; mt < 4; ++mt)
#pragma unroll
                for (int j = 0; j < 8; ++j) o1l[(mt * 8 + j) * 64] = pk_bf16(O[mt][2 * j] * rs, O[mt][2 * j + 1] * rs);
            __builtin_amdgcn_wave_barrier();
            int lane_e = lane; asm volatile("" : "+v"(lane_e));
            const int dvg = lane_e & 15, qs = lane_e >> 4;
            const f32x4 nw0 = *(const f32x4*)(p.diff_norm_w + 8 * dvg), nw1 = *(const f32x4*)(p.diff_norm_w + 8 * dvg + 4);
            const LAS unsigned* ob = (const LAS unsigned*)(lds + AT_O1 + wid * 8192);
            const int slot = (dvg >> 2) * 8 + 2 * (dvg & 3);
            u32x4 dzv[8];
#pragma unroll
            for (int it = 0; it < 8; ++it) dzv[it] = *(const u32x4*)(P1 + (tokbase + q0 + it * 4 + qs) * NP1 + C_DZ + hh * 128 + 8 * dvg);
#pragma unroll
            for (int it = 0; it < 8; ++it) {
                const int q = it * 4 + qs; const size_t row = tokbase + q0 + q;
                const unsigned u0 = ob[slot * 64 + q], u1 = ob[(slot + 1) * 64 + q], u2 = ob[slot * 64 + q + 32], u3 = ob[(slot + 1) * 64 + q + 32];
                const u32x4 dz = dzv[it];
                u32x4 w;
                w.x = pk_bf16(bf_lo(u0) * nw0[0] * silu_f(bf_lo(dz.x)), bf_hi(u0) * nw0[1] * silu_f(bf_hi(dz.x)));
                w.y = pk_bf16(bf_lo(u1) * nw0[2] * silu_f(bf_lo(dz.y)), bf_hi(u1) * nw0[3] * silu_f(bf_hi(dz.y)));
                w.z = pk_bf16(bf_lo(u2) * nw1[0] * silu_f(bf_lo(dz.z)), bf_hi(u2) * nw1[1] * silu_f(bf_hi(dz.z)));
                w.w = pk_bf16(bf_lo(u3) * nw1[2] * silu_f(bf_lo(dz.w)), bf_hi(u3) * nw1[3] * silu_f(bf_hi(dz.w)));
                *(u32x4*)(mix + row * DM + 512 + hh * 128 + 8 * dvg) = w;
            }
            __builtin_amdgcn_wave_barrier();
        }
    }
}

DI void phase_attn(const Params& p, LAS unsigned char* lds, int rep) {
    const float lam = *(const float*)(p.ws + OFF_MISC);
    unsigned* counter = (unsigned*)(p.ws + OFF_MISC + 4 + 4 * rep);
    LAS int* tslot = (LAS int*)(lds + AT_TASK);
    for (;;) {
        if (threadIdx.x == 0) *tslot = (int)atomicAdd(counter, 1u);
        __syncthreads();
        const int t = *tslot;
        __syncthreads();
        if (t >= 512) break;
        const int qb = 7 - (t >> 6), bh = t & 63;
        attn_qblock(p, lds, bh >> 2, bh & 3, qb, lam);
    }
}


constexpr int G_QN = 0, G_KN = 17408, G_VB = 34816, G_KBG = 52224, G_M = 69632, G_T = 86016, G_SM = 95232;
DI bf16x8 tr_pair(const LAS unsigned char* lo_addr, int hi_off) {
    const s16x4 lo = __builtin_amdgcn_ds_read_tr16_b64_v4i16((LAS s16x4*)(lo_addr));
    const s16x4 hi = __builtin_amdgcn_ds_read_tr16_b64_v4i16((LAS s16x4*)(lo_addr + hi_off));
    return __builtin_shufflevector(lo, hi, 0, 1, 2, 3, 4, 5, 6, 7);
}
DI bf16_t bf16_1(float v) { return (bf16_t)(pk_bf16(v, 0.f) & 0xffffu); }

DI void gdn_gates(const Params& p, LAS float* sm, int c2, int lane) {
    const int b = c2 >> 7, hh = (c2 >> 5) & 3, n = c2 & 31;
    const size_t tok0 = (size_t)b * SEQ + (size_t)n * 64;
    const float* gg = (const float*)(p.ws + OFF_GBGA) + (tok0 + lane) * 8;
    const float gbv = gg[hh], gav = gg[4 + hh];
    const float beta = 1.0f / (1.0f + expf(-gbv));
    const float xs = gav + p.dt_bias[hh];
    const float sp = fmaxf(xs, 0.f) + log1pf(expf(-fabsf(xs)));
    float gc = -expf(p.a_log[hh]) * sp;
#pragma unroll
    for (int o = 1; o < 64; o <<= 1) { const float t = __shfl_up(gc, o); if (lane >= o) gc += t; }
    const float gl = __shfl(gc, 63);
    sm[lane] = beta; sm[64 + lane] = gc * LOG2E; sm[128 + lane] = expf(gc); sm[192 + lane] = expf(gl - gc);
    if (lane == 63) ((float*)(p.ws + OFF_GL))[c2] = expf(gl);
}

DI void gdn_prep(const Params& p, LAS unsigned char* lds, int c2, int c2next, int par) {
    int tid = threadIdx.x; asm volatile("" : "+v"(tid));
    const int lane = tid & 63, wid = __builtin_amdgcn_readfirstlane(tid >> 6), r = lane & 31, h2 = lane >> 5;
    const int b = c2 >> 7, hh = (c2 >> 5) & 3, n = c2 & 31;
    const size_t tok0 = (size_t)b * SEQ + (size_t)n * 64;
    const bf16_t* P1 = (const bf16_t*)(p.ws + OFF_P1);
    LAS float* sm = (LAS float*)(lds + G_SM + par * 1024);
    LAS float* Mf = (LAS float*)(lds + G_M);
    bf16_t* WN = (bf16_t*)(p.ws + OFF_WN) + (size_t)c2 * 8192;
    bf16_t* QD = (bf16_t*)(p.ws + OFF_QD) + (size_t)c2 * 8192;
    bf16_t* KD = (bf16_t*)(p.ws + OFF_KD) + (size_t)c2 * 8192;
    bf16_t* AQ = (bf16_t*)(p.ws + OFF_AQK) + (size_t)c2 * 4096;
    float* U = (float*)(p.ws + OFF_U) + (size_t)c2 * 8192;
    u32x4 raw[6][4];
#pragma unroll
    for (int i = 0; i < 6; ++i) {
        const int item = tid + 512 * i, g = item & 15, t = (item >> 4) & 63, part = i >> 1;
        const int ch = part * 512 + hh * 128 + g * 8;
#pragma unroll
        for (int j = 0; j < 4; ++j) {
            const int tt = n * 64 + t - 3 + j, ttc = tt < 0 ? 0 : tt;
            raw[i][j] = *(const u32x4*)(P1 + ((size_t)b * SEQ + ttc) * NP1 + ch);
            if (tt < 0) raw[i][j] = (u32x4){0u, 0u, 0u, 0u};
        }
    }
    float av[6][8];
#pragma unroll
    for (int i = 0; i < 6; ++i) {
        const int item = tid + 512 * i, g = item & 15, part = i >> 1;
        const int ch = part * 512 + hh * 128 + g * 8;
        float a[8];
#pragma unroll
        for (int e = 0; e < 8; ++e) a[e] = 0.f;
#pragma unroll
        for (int j = 0; j < 4; ++j) {
            const f32x4 w0 = *(const f32x4*)(p.conv_w + j * 1536 + ch), w1 = *(const f32x4*)(p.conv_w + j * 1536 + ch + 4);
            const u32x4 rw = raw[i][j];
            a[0] += w0[0] * bf_lo(rw.x); a[1] += w0[1] * bf_hi(rw.x); a[2] += w0[2] * bf_lo(rw.y); a[3] += w0[3] * bf_hi(rw.y);
            a[4] += w1[0] * bf_lo(rw.z); a[5] += w1[1] * bf_hi(rw.z); a[6] += w1[2] * bf_lo(rw.w); a[7] += w1[3] * bf_hi(rw.w);
        }
        float ss = 0.f;
#pragma unroll
        for (int e = 0; e < 8; ++e) { a[e] = silu_f(a[e]); ss += a[e] * a[e]; }
        float rn = 1.0f;
        if (part < 2) {
            ss += __shfl_xor(ss, 1); ss += __shfl_xor(ss, 2); ss += __shfl_xor(ss, 4); ss += __shfl_xor(ss, 8);
            rn = rsqrtf(ss + 1e-6f) * (part == 0 ? 0.08838834764831845f : 1.0f);
        }
#pragma unroll
        for (int e = 0; e < 8; ++e) av[i][e] = a[e] * rn;
    }
#pragma unroll
    for (int i = 0; i < 6; ++i) {
        const int item = tid + 512 * i, g = item & 15, t = (item >> 4) & 63, part = i >> 1;
        const float* a = av[i];
        const float beta = sm[t], egc = sm[128 + t], ekd = sm[192 + t];
        if (part < 2) {
            u32x4 w; w.x = pk_bf16(a[0], a[1]); w.y = pk_bf16(a[2], a[3]); w.z = pk_bf16(a[4], a[5]); w.w = pk_bf16(a[6], a[7]);
            *(LAS u32x4*)(lds + (part == 0 ? G_QN : G_KN) + t * 272 + g * 16) = w;
            if (part == 0) {
                u32x2 lo, hi; lo.x = pk_bf16(a[0] * egc, a[1] * egc); lo.y = pk_bf16(a[2] * egc, a[3] * egc); hi.x = pk_bf16(a[4] * egc, a[5] * egc); hi.y = pk_bf16(a[6] * egc, a[7] * egc);
                bf16_t* qd = QD + t * 128 + 16 * (g >> 1) + 4 * (g & 1);
                *(u32x2*)qd = lo; *(u32x2*)(qd + 8) = hi;
            } else {
                const float f1 = beta * egc;
                u32x4 w2; w2.x = pk_bf16(a[0] * f1, a[1] * f1); w2.y = pk_bf16(a[2] * f1, a[3] * f1); w2.z = pk_bf16(a[4] * f1, a[5] * f1); w2.w = pk_bf16(a[6] * f1, a[7] * f1);
                *(LAS u32x4*)(lds + G_KBG + t * 272 + g * 16) = w2;
                u32x4 w3; w3.x = pk_bf16(a[0] * ekd, a[1] * ekd); w3.y = pk_bf16(a[2] * ekd, a[3] * ekd); w3.z = pk_bf16(a[4] * ekd, a[5] * ekd); w3.w = pk_bf16(a[6] * ekd, a[7] * ekd);
                *(u32x4*)(KD + t * 128 + g * 8) = w3;
            }
        } else {
            u32x4 w; w.x = pk_bf16(a[0] * beta, a[1] * beta); w.y = pk_bf16(a[2] * beta, a[3] * beta); w.z = pk_bf16(a[4] * beta, a[5] * beta); w.w = pk_bf16(a[6] * beta, a[7] * beta);
            *(LAS u32x4*)(lds + G_VB + t * 272 + g * 16) = w;
        }
    }
    __syncthreads();
    {
        const int w4 = wid & 3, mt = w4 >> 1, nt = w4 & 1; const bool isqk = wid >= 4;
        if (!(mt == 0 && nt == 1)) {
            const LAS unsigned char* Ab = lds + (isqk ? G_QN : G_KN) + (32 * mt + r) * 272 + 16 * h2;
            const LAS unsigned char* Bb = lds + G_KN + (32 * nt + r) * 272 + 16 * h2;
            f32x16 X;
#pragma unroll
            for (int i = 0; i < 16; ++i) X[i] = 0.f;
#pragma unroll
            for (int ks = 0; ks < 8; ++ks) X = MFMA32(*(const LAS bf16x8*)(Ab + 32 * ks), *(const LAS bf16x8*)(Bb + 32 * ks), X);
            const int s = 32 * nt + r; const float gcs = sm[64 + s];
#pragma unroll
            for (int i = 0; i < 16; ++i) {
                const int c = 32 * mt + crow(i, h2);
                const float dec = __builtin_amdgcn_exp2f(sm[64 + c] - gcs);
                if (!isqk) Mf[c * 64 + s] = (c > s) ? sm[c] * X[i] * dec : 0.f;
                else AQ[c * 64 + perm23(s)] = bf16_1((c >= s) ? X[i] * dec : 0.f);
            }
        }
    }
    __syncthreads();
    if (wid == 0) {
        LAS bf16_t* Tb = (LAS bf16_t*)(lds + G_T);
        {
            const int c16 = lane & 15, b16 = lane >> 4;
            const LAS float* Mb = Mf + (16 * b16) * 64 + 16 * b16;
            float T[16];
#pragma unroll
            for (int i = 0; i < 16; ++i) T[i] = 0.f;
#pragma unroll
            for (int i = 0; i < 16; ++i) {
                float a0 = (i == c16) ? 1.f : 0.f, a1 = 0.f, a2 = 0.f, a3 = 0.f;
#pragma unroll
                for (int s4 = 0; s4 < (i + 3) / 4; ++s4) {
                    const f32x4 m4 = *(const LAS f32x4*)(Mb + i * 64 + 4 * s4);
                    a0 -= m4[0] * T[4 * s4]; a1 -= m4[1] * T[4 * s4 + 1]; a2 -= m4[2] * T[4 * s4 + 2]; a3 -= m4[3] * T[4 * s4 + 3];
                }
                T[i] = (a0 + a1) + (a2 + a3);
            }
#pragma unroll
            for (int i = 0; i < 16; ++i) {
                const int row = 16 * b16 + i;
                Tb[row * 72 + 16 * b16 + c16] = bf16_1(T[i]);
                if ((b16 & 1) == 0) Tb[row * 72 + 16 * b16 + 16 + c16] = 0;
                if (b16 < 2) { Tb[row * 72 + 32 + c16] = 0; Tb[row * 72 + 48 + c16] = 0; }
            }
        }
        __builtin_amdgcn_wave_barrier();
        asm volatile("s_waitcnt lgkmcnt(0)" ::: "memory");
        {
            const int qd = r >> 4, rr = r & 15;
            bf16x8 mfrag;
            { const LAS float* mp = Mf + (16 + 32 * qd + rr) * 64 + 32 * qd + 8 * h2;
              const f32x4 m0 = *(const LAS f32x4*)mp, m1 = *(const LAS f32x4*)(mp + 4);
              u32x4 aw; aw.x = pk_bf16(m0[0], m0[1]); aw.y = pk_bf16(m0[2], m0[3]); aw.z = pk_bf16(m1[0], m1[1]); aw.w = pk_bf16(m1[2], m1[3]);
              mfrag = __builtin_bit_cast(bf16x8, aw); }
            bf16x8 tfrag;
#pragma unroll
            for (int j = 0; j < 8; ++j) tfrag[j] = (short)Tb[(32 * qd + 8 * h2 + j) * 72 + 32 * qd + rr];
            bf16x8 t2frag;
            { const LAS unsigned char* tp = lds + G_T + (16 + 32 * qd + rr) * 144 + (16 + 32 * qd + 4 * h2) * 2;
              const u32x2 lo = *(const LAS u32x2*)tp, hi = *(const LAS u32x2*)(tp + 16);
              u32x4 aw; aw.x = lo.x; aw.y = lo.y; aw.z = hi.x; aw.w = hi.y; t2frag = __builtin_bit_cast(bf16x8, aw); }
            const bf16x8 zf = {0, 0, 0, 0, 0, 0, 0, 0};
            f32x16 Y1, Z1;
#pragma unroll
            for (int i = 0; i < 16; ++i) { Y1[i] = 0.f; Z1[i] = 0.f; }
#pragma unroll
            for (int ks = 0; ks < 2; ++ks) Y1 = MFMA32(qd == ks ? mfrag : zf, qd == ks ? tfrag : zf, Y1);
#pragma unroll
            for (int s2 = 0; s2 < 2; ++s2) Z1 = MFMA32(qd == s2 ? t2frag : zf, pack8(Y1, s2), Z1);
#pragma unroll
            for (int i = 0; i < 16; ++i) {
                const int row = crow(i, h2);
                if ((row >> 4) == qd) Tb[(16 + 32 * qd + (row & 15)) * 72 + 32 * qd + rr] = bf16_1(-Z1[i]);
            }
        }
        __builtin_amdgcn_wave_barrier();
        asm volatile("s_waitcnt lgkmcnt(0)" ::: "memory");
        const int i16 = lane & 15, q = i16 >> 2, pp = i16 & 3, blk = (lane >> 4) & 1;
        f32x16 Y;
#pragma unroll
        for (int i = 0; i < 16; ++i) Y[i] = 0.f;
#pragma unroll
        for (int ks = 0; ks < 2; ++ks) {
            const LAS float* mp = Mf + (32 + r) * 64 + 16 * ks + 8 * h2;
            const f32x4 m0 = *(const LAS f32x4*)mp, m1 = *(const LAS f32x4*)(mp + 4);
            u32x4 aw; aw.x = pk_bf16(m0[0], m0[1]); aw.y = pk_bf16(m0[2], m0[3]); aw.z = pk_bf16(m1[0], m1[1]); aw.w = pk_bf16(m1[2], m1[3]);
            const bf16x8 bfrag = tr_pair(lds + G_T + (16 * ks + 8 * h2 + q) * 144 + (16 * blk + 4 * pp) * 2, 4 * 144);
            Y = MFMA32(__builtin_bit_cast(bf16x8, aw), bfrag, Y);
        }
        f32x16 Z;
#pragma unroll
        for (int i = 0; i < 16; ++i) Z[i] = 0.f;
#pragma unroll
        for (int s = 0; s < 2; ++s) {
            const LAS unsigned char* tp = lds + G_T + (32 + r) * 144 + (32 + 16 * s + 4 * h2) * 2;
            const u32x2 lo = *(const LAS u32x2*)tp, hi = *(const LAS u32x2*)(tp + 16);
            u32x4 aw; aw.x = lo.x; aw.y = lo.y; aw.z = hi.x; aw.w = hi.y;
            Z = MFMA32(__builtin_bit_cast(bf16x8, aw), pack8(Y, s), Z);
        }
#pragma unroll
        for (int i = 0; i < 16; ++i) Tb[(32 + crow(i, h2)) * 72 + r] = bf16_1(-Z[i]);
    } else if (wid == 1) {
        if (c2next < 2048) gdn_gates(p, (LAS float*)(lds + G_SM + (par ^ 1) * 1024), c2next, lane);
    }
    __syncthreads();
    {
        const int mt = wid >> 2, nt = wid & 3;
        const int i16 = lane & 15, q = i16 >> 2, pp = i16 & 3, blk = (lane >> 4) & 1;
        f32x16 Xu, Xw;
#pragma unroll
        for (int i = 0; i < 16; ++i) { Xu[i] = 0.f; Xw[i] = 0.f; }
#pragma unroll
        for (int ks = 0; ks < 4; ++ks) {
            if (ks < 2 * (mt + 1)) {
                const bf16x8 af = *(const LAS bf16x8*)(lds + G_T + (32 * mt + r) * 144 + (16 * ks + 8 * h2) * 2);
                const int boff = (16 * ks + 8 * h2 + q) * 272 + (32 * nt + 16 * blk + 4 * pp) * 2;
                Xu = MFMA32(af, tr_pair(lds + G_VB + boff, 4 * 272), Xu);
                Xw = MFMA32(af, tr_pair(lds + G_KBG + boff, 4 * 272), Xw);
            }
        }
        const int d = 32 * nt + r, dp = perm23(d);
        {
            float* up = U + (nt * 2 + mt) * 1024 + lane * 4;
#pragma unroll
            for (int k = 0; k < 4; ++k) { const f32x4 v = {Xu[4 * k], Xu[4 * k + 1], Xu[4 * k + 2], Xu[4 * k + 3]}; *(f32x4*)(up + 256 * k) = v; }
        }
#pragma unroll
        for (int i = 0; i < 16; ++i) {
            const int c = 32 * mt + crow(i, h2);
            WN[c * 128 + dp] = bf16_1(-Xw[i]);
        }
    }
    __syncthreads();
}

constexpr int S_WN = 0, S_QD = 17408, S_KD = 34816, S_AQ = 52224, S_BUF = 61440, S_STG = 2 * S_BUF;

struct GateIn { u32x4 z0, z1; };
DI void scan_gate_load(const Params& p, int tid, int b, int hh, int n, GateIn& g) {
    const int gc_ = tid >> 3, seg = tid & 7;
    const bf16_t* P1 = (const bf16_t*)(p.ws + OFF_P1);
    const size_t row = (size_t)b * SEQ + n * 64 + gc_;
    g.z0 = *(const u32x4*)(P1 + row * NP1 + C_GZ + hh * 128 + seg * 16); g.z1 = *(const u32x4*)(P1 + row * NP1 + C_GZ + hh * 128 + seg * 16 + 8);
}
DI void scan_gate(const Params& p, LAS unsigned char* lds, int tid, int b, int hh, int n, const GateIn& g) {
    const int gc_ = tid >> 3, seg = tid & 7;
    bf16_t* mix = (bf16_t*)(p.ws + OFF_HB);
    const LAS float* st = (const LAS float*)(lds + S_STG) + gc_ * 132 + seg * 16;
    f32x4 ov[4]; float ss = 0.f;
#pragma unroll
    for (int k = 0; k < 4; ++k) { ov[k] = *(const LAS f32x4*)(st + 4 * k); ss += ov[k][0] * ov[k][0] + ov[k][1] * ov[k][1] + ov[k][2] * ov[k][2] + ov[k][3] * ov[k][3]; }
    ss += __shfl_xor(ss, 1); ss += __shfl_xor(ss, 2); ss += __shfl_xor(ss, 4);
    const float rstd = rsqrtf(ss * (1.0f / 128.0f) + EPS);
    const size_t row = (size_t)b * SEQ + n * 64 + gc_;
    const u32x4 z0 = g.z0, z1 = g.z1;
    f32x4 gnw[4];
#pragma unroll
    for (int k = 0; k < 4; ++k) gnw[k] = *(const f32x4*)(p.gdn_norm_w + seg * 16 + 4 * k);
    u32x4 w0, w1;
    w0.x = pk_bf16(ov[0][0] * rstd * gnw[0][0] * silu_f(bf_lo(z0.x)), ov[0][1] * rstd * gnw[0][1] * silu_f(bf_hi(z0.x)));
    w0.y = pk_bf16(ov[0][2] * rstd * gnw[0][2] * silu_f(bf_lo(z0.y)), ov[0][3] * rstd * gnw[0][3] * silu_f(bf_hi(z0.y)));
    w0.z = pk_bf16(ov[1][0] * rstd * gnw[1][0] * silu_f(bf_lo(z0.z)), ov[1][1] * rstd * gnw[1][1] * silu_f(bf_hi(z0.z)));
    w0.w = pk_bf16(ov[1][2] * rstd * gnw[1][2] * silu_f(bf_lo(z0.w)), ov[1][3] * rstd * gnw[1][3] * silu_f(bf_hi(z0.w)));
    w1.x = pk_bf16(ov[2][0] * rstd * gnw[2][0] * silu_f(bf_lo(z1.x)), ov[2][1] * rstd * gnw[2][1] * silu_f(bf_hi(z1.x)));
    w1.y = pk_bf16(ov[2][2] * rstd * gnw[2][2] * silu_f(bf_lo(z1.y)), ov[2][3] * rstd * gnw[2][3] * silu_f(bf_hi(z1.y)));
    w1.z = pk_bf16(ov[3][0] * rstd * gnw[3][0] * silu_f(bf_lo(z1.z)), ov[3][1] * rstd * gnw[3][1] * silu_f(bf_hi(z1.z)));
    w1.w = pk_bf16(ov[3][2] * rstd * gnw[3][2] * silu_f(bf_lo(z1.w)), ov[3][3] * rstd * gnw[3][3] * silu_f(bf_hi(z1.w)));
    bf16_t* mp = mix + row * DM + hh * 128 + seg * 16;
    *(u32x4*)mp = w0; *(u32x4*)(mp + 8) = w1;
}

struct ScanRegs { u32x4 t0[4], t1[4], t2[4], t3[2]; };
DI void scan_fetch(ScanRegs& R, const bf16_t* WN, const bf16_t* QD, const bf16_t* KD, const bf16_t* AQ, int ltid) {
#pragma unroll
    for (int i = 0; i < 4; ++i) { const int pi = ltid + 256 * i; R.t0[i] = *(const u32x4*)(WN + pi * 8); R.t1[i] = *(const u32x4*)(QD + pi * 8); R.t2[i] = *(const u32x4*)(KD + pi * 8); }
#pragma unroll
    for (int i = 0; i < 2; ++i) { const int pi = ltid + 256 * i; R.t3[i] = *(const u32x4*)(AQ + pi * 8); }
}
DI void scan_put(const ScanRegs& R, LAS unsigned char* dst, int ltid) {
#pragma unroll
    for (int i = 0; i < 4; ++i) { const int pi = ltid + 256 * i, row = pi >> 4, pc = pi & 15;
        *(LAS u32x4*)(dst + S_WN + row * 272 + pc * 16) = R.t0[i]; *(LAS u32x4*)(dst + S_QD + row * 272 + pc * 16) = R.t1[i]; *(LAS u32x4*)(dst + S_KD + row * 272 + pc * 16) = R.t2[i]; }
#pragma unroll
    for (int i = 0; i < 2; ++i) { const int pi = ltid + 256 * i, row = pi >> 3, pc = pi & 7; *(LAS u32x4*)(dst + S_AQ + row * 144 + pc * 16) = R.t3[i]; }
}

DI void gdn_scan(const Params& p, LAS unsigned char* lds, int bh) {
    int tid = threadIdx.x; asm volatile("" : "+v"(tid));
    const int lane = tid & 63, wid = __builtin_amdgcn_readfirstlane(tid >> 6), r = lane & 31, h2 = lane >> 5;
    const int b = bh >> 2, hh = bh & 3;
    const bf16_t* WN = (const bf16_t*)(p.ws + OFF_WN) + (size_t)bh * 32 * 8192;
    const bf16_t* QD = (const bf16_t*)(p.ws + OFF_QD) + (size_t)bh * 32 * 8192;
    const bf16_t* KD = (const bf16_t*)(p.ws + OFF_KD) + (size_t)bh * 32 * 8192;
    const bf16_t* AQ = (const bf16_t*)(p.ws + OFF_AQK) + (size_t)bh * 32 * 4096;
    const float* U = (const float*)(p.ws + OFF_U) + (size_t)bh * 32 * 8192;
    const float* GL = (const float*)(p.ws + OFF_GL) + bh * 32;
    if (wid >= 4) {
        const int ltid = tid & 255;
        ScanRegs R;
        scan_fetch(R, WN, QD, KD, AQ, ltid); scan_put(R, lds, ltid);
        scan_fetch(R, WN + 8192, QD + 8192, KD + 8192, AQ + 4096, ltid);
#pragma unroll 1
        for (int n = 0; n < 32; ++n) {
            __syncthreads();
            GateIn gi; scan_gate_load(p, tid, b, hh, n, gi);
            if (n + 1 < 32) scan_put(R, lds + ((n + 1) & 1) * S_BUF, ltid);
            if (n + 2 < 32) scan_fetch(R, WN + (size_t)(n + 2) * 8192, QD + (size_t)(n + 2) * 8192, KD + (size_t)(n + 2) * 8192, AQ + (size_t)(n + 2) * 4096, ltid);
            __syncthreads();
            scan_gate(p, lds, tid, b, hh, n, gi);
        }
    } else {
        const int i16 = lane & 15, q4 = i16 >> 2, pp = i16 & 3, blk = (lane >> 4) & 1;
        f32x16 St[4], u[2];
#pragma unroll
        for (int k = 0; k < 4; ++k)
#pragma unroll
            for (int i = 0; i < 16; ++i) St[k][i] = 0.f;
#pragma unroll
        for (int mt = 0; mt < 2; ++mt)
#pragma unroll
            for (int k = 0; k < 4; ++k) { const f32x4 v = *(const f32x4*)(U + (wid * 2 + mt) * 1024 + 256 * k + lane * 4); u[mt][4 * k] = v[0]; u[mt][4 * k + 1] = v[1]; u[mt][4 * k + 2] = v[2]; u[mt][4 * k + 3] = v[3]; }
#pragma unroll 1
        for (int n = 0; n < 32; ++n) {
            LAS unsigned char* buf = lds + (n & 1) * S_BUF;
            __syncthreads();
            GateIn gi; scan_gate_load(p, tid, b, hh, n, gi);
            const float egl = GL[n];
            f32x16 vn[2], o[2];
            vn[0] = u[0]; vn[1] = u[1];
#pragma unroll
            for (int mt = 0; mt < 2; ++mt)
#pragma unroll
                for (int i = 0; i < 16; ++i) o[mt][i] = 0.f;
#pragma unroll
            for (int ks = 0; ks < 8; ++ks) {
                const bf16x8 sf = pack8(St[ks >> 1], ks & 1);
#pragma unroll
                for (int mt = 0; mt < 2; ++mt) {
                    const bf16x8 wf = *(const LAS bf16x8*)(buf + S_WN + (32 * mt + r) * 272 + (16 * ks + 8 * h2) * 2);
                    vn[mt] = MFMA32(wf, sf, vn[mt]);
                    const bf16x8 qf = *(const LAS bf16x8*)(buf + S_QD + (32 * mt + r) * 272 + (16 * ks + 8 * h2) * 2);
                    o[mt] = MFMA32(qf, sf, o[mt]);
                }
                asm volatile("" ::: "memory");
            }
            bf16x8 vf[4];
#pragma unroll
            for (int k2 = 0; k2 < 4; ++k2) vf[k2] = pack8(vn[k2 >> 1], k2 & 1);
            {
                const int nn = (n + 1 < 32) ? n + 1 : n;
                const float* up = U + (size_t)nn * 8192 + (wid * 2) * 1024 + lane * 4;
#pragma unroll
                for (int mt = 0; mt < 2; ++mt)
#pragma unroll
                    for (int k = 0; k < 4; ++k) { const f32x4 v = *(const f32x4*)(up + mt * 1024 + 256 * k); u[mt][4 * k] = v[0]; u[mt][4 * k + 1] = v[1]; u[mt][4 * k + 2] = v[2]; u[mt][4 * k + 3] = v[3]; }
            }
#pragma unroll
            for (int mt = 0; mt < 2; ++mt)
#pragma unroll
                for (int k2 = 0; k2 < 2 * (mt + 1); ++k2) {
                    const bf16x8 af = *(const LAS bf16x8*)(buf + S_AQ + (32 * mt + r) * 144 + (16 * k2 + 8 * h2) * 2);
                    o[mt] = MFMA32(af, vf[k2], o[mt]);
                }
            {
                LAS float* st = (LAS float*)(lds + S_STG);
#pragma unroll
                for (int mt = 0; mt < 2; ++mt)
#pragma unroll
                    for (int i = 0; i < 16; ++i) st[(32 * mt + crow(i, h2)) * 132 + 32 * wid + r] = o[mt][i];
            }
#pragma unroll
            for (int kt = 0; kt < 4; ++kt) {
#pragma unroll
                for (int i = 0; i < 16; ++i) St[kt][i] *= egl;
#pragma unroll
                for (int k2 = 0; k2 < 4; ++k2) {
                    const bf16x8 kf = tr_pair(buf + S_KD + (16 * k2 + 4 * h2 + q4) * 272 + (32 * kt + 16 * blk + 4 * pp) * 2, 8 * 272);
                    St[kt] = MFMA32(kf, vf[k2], St[kt]);
                }
                asm volatile("" ::: "memory");
            }
            __syncthreads();
            scan_gate(p, lds, tid, b, hh, n, gi);
        }
    }
    __syncthreads();
}

DI void zero_mix_half(const Params& p, int half) {
    bf16_t* mix = (bf16_t*)(p.ws + OFF_HB);
    const size_t n16 = (size_t)MTOK * 64;
    for (size_t i = (size_t)blockIdx.x * 512 + threadIdx.x; i < n16; i += (size_t)gridDim.x * 512) {
        const size_t row = i >> 6, pc = i & 63;
        *(u32x4*)(mix + row * DM + half * 512 + pc * 8) = (u32x4){0u, 0u, 0u, 0u};
    }
}

DI void phase_final(const Params& p) {
    int tid = threadIdx.x; asm volatile("" : "+v"(tid));
    const int lane = tid & 63, wid = tid >> 6;
    const float* rowsq = (const float*)(p.ws + OFF_ROWSQ);
    const bf16_t* yb = (const bf16_t*)(p.ws + OFF_YB);
    const int gw = blockIdx.x * 8 + wid, nw = gridDim.x * 8;
    f32x4 fw[4];
#pragma unroll
    for (int i = 0; i < 2; ++i) { fw[2 * i] = *(const f32x4*)(p.final_norm_w + 512 * i + 8 * lane); fw[2 * i + 1] = *(const f32x4*)(p.final_norm_w + 512 * i + 8 * lane + 4); }
#pragma unroll 1
    for (int row0 = gw; row0 < MTOK; row0 += 4 * nw) {
        u32x4 y[4][2]; float sq[4];
#pragma unroll
        for (int k = 0; k < 4; ++k) {
            const int row = row0 + k * nw, rc = row < MTOK ? row : row0;
#pragma unroll
            for (int i = 0; i < 2; ++i) y[k][i] = *(const u32x4*)(yb + (size_t)rc * DM + 512 * i + 8 * lane);
            sq[k] = lane < 16 ? rowsq[(size_t)rc * 16 + lane] : 0.f;
        }
#pragma unroll
        for (int k = 0; k < 4; ++k) {
            const int row = row0 + k * nw;
            const float ss = wave_sum(sq[k]);
            const float rstd = rsqrtf(ss * (1.0f / DM) + EPS);
            if (row < MTOK) {
                float* o = p.out + (size_t)row * DM;
#pragma unroll
                for (int i = 0; i < 2; ++i) {
                    const f32x4 a = {bf_lo(y[k][i].x), bf_hi(y[k][i].x), bf_lo(y[k][i].y), bf_hi(y[k][i].y)}, c = {bf_lo(y[k][i].z), bf_hi(y[k][i].z), bf_lo(y[k][i].w), bf_hi(y[k][i].w)};
                    *(f32x4*)(o + 512 * i + 8 * lane) = a * rstd * fw[2 * i];
                    *(f32x4*)(o + 512 * i + 8 * lane + 4) = c * rstd * fw[2 * i + 1];
                }
            }
        }
    }
}

__global__ void __launch_bounds__(512) mega(Params p) {
    extern __shared__ __attribute__((aligned(16))) unsigned char shm[];
    LAS unsigned char* lds = (LAS unsigned char*)shm;
    cg::grid_group grid = cg::this_grid();
    volatile LAS unsigned* bst = (volatile LAS unsigned*)(lds + LDS_BYTES - 16);
    if (threadIdx.x < 2) bst[threadIdx.x] = 0u;
    __syncthreads();
    const XcdBarrier xb = xcd_barrier_post((unsigned*)(p.ws + OFF_BAR), bst);
    if (p.ws == nullptr) grid.sync();

#pragma unroll 1
    for (int rep = 0; rep < REP_PREP; ++rep) phase_prep(p, lds);
    xcd_barrier(xb);
#pragma unroll 1
    for (int rep = 0; rep < REP_G1; ++rep)
    {
        pg8::Gemm g{(const bf16_t*)(p.ws + OFF_HB), (const bf16_t*)(p.ws + OFF_WINT), MTOK, NG1, DM};
        pg8::StaticOrder S; S.init(g.M, g.N, (int)gridDim.x, (int)blockIdx.x);
        pg8::EpiP1 E{(bf16_t*)(p.ws + OFF_P1), NP1, (bf16_t*)(p.ws + OFF_KX)};
        pg8::gemm_phase<pg8::EpiP1, false>(lds, g, S, E);
        pg8::Gemm g2{(const bf16_t*)(p.ws + OFF_HB), (const bf16_t*)(p.ws + OFF_WINT) + (size_t)NG1 * DM, MTOK, 512, DM};
        pg8::StaticOrder S2; S2.init(g2.M, g2.N, (int)gridDim.x, (int)blockIdx.x);
        pg8::EpiVT E2{(bf16_t*)(p.ws + OFF_VT)};
        pg8::gemm_phase<pg8::EpiVT, true>(lds, g2, S2, E2);
    }
    xcd_barrier(xb);
#pragma unroll 1
    for (int rep = 0; rep < REP_GP; ++rep)
    {
        if ((threadIdx.x >> 6) == 0 && (int)blockIdx.x < 2048) gdn_gates(p, (LAS float*)(lds + G_SM), blockIdx.x, threadIdx.x & 63);
        __syncthreads();
        int par = 0;
#pragma unroll 1
        for (int c2 = blockIdx.x; c2 < 2048; c2 += gridDim.x, par ^= 1) gdn_prep(p, lds, c2, c2 + (int)gridDim.x, par);
    }
    xcd_barrier(xb);
#pragma unroll 1
    for (int rep = 0; rep < REP_P3; ++rep) {
#pragma unroll 1
        for (int r2 = 0; r2 < REP_SCAN; ++r2)
            if (blockIdx.x < 64) gdn_scan(p, lds, blockIdx.x);
#if SCAN_SYNC
        xcd_barrier(xb);
#endif
        phase_attn(p, lds, rep);
#if REP_ATTN > 1
        xcd_barrier(xb);
        phase_attn(p, lds, 2);
#endif
#if REP_P3 > 1
        xcd_barrier(xb);
#endif
    }
    xcd_barrier(xb);
#pragma unroll 1
    for (int rnd = 0; rnd < 2; ++rnd) {
        pg8::Gemm g{(const bf16_t*)(p.ws + OFF_HB), (const bf16_t*)(p.ws + OFF_WOUTT), MTOK, DM, DM};
        pg8::StaticOrder S; S.init(g.M, g.N, (int)gridDim.x, (int)blockIdx.x); S.i0 = rnd; S.imax = 1;
        pg8::EpiOutFused E{p.x, p.out, (float*)(p.ws + OFF_ROWSQ), p.final_norm_w, xb};
        pg8::Unit u0;
        if (S.next(0, u0)) pg8::gemm_phase<pg8::EpiOutFused, false>(lds, g, S, E);
        else xcd_barrier(xb);
    }
}

extern "C" void kernel_launch(void* const* d_in, const int* in_sizes, int n_in, void* d_out, int out_size, void* d_ws, size_t ws_size, hipStream_t stream) {
    static int grid = 0;
    if (grid == 0) {
        if (ws_size < WS_END) { fprintf(stderr, "kernel_launch: workspace too small (%zu < %zu)\n", ws_size, (size_t)WS_END); grid = -1; return; }
        int dev = 0, cus = 0, per_cu = 0;
        hipGetDevice(&dev);
        hipDeviceGetAttribute(&cus, hipDeviceAttributeMultiprocessorCount, dev);
        if (hipFuncSetAttribute((const void*)mega, hipFuncAttributeMaxDynamicSharedMemorySize, LDS_BYTES) != hipSuccess) { fprintf(stderr, "kernel_launch: hipFuncSetAttribute failed\n"); grid = -1; return; }
        if (hipOccupancyMaxActiveBlocksPerMultiprocessor(&per_cu, (const void*)mega, 512, LDS_BYTES) != hipSuccess || per_cu < 1) per_cu = 1;
        (void)hipGetLastError();
        grid = cus * (per_cu > 1 ? 1 : per_cu);
    }
    if (grid < 0) return;
    Params p{};
    p.x = (const float*)d_in[0]; p.norm_w = (const float*)d_in[1]; p.w_in = (const float*)d_in[2]; p.conv_w = (const float*)d_in[3];
    p.a_log = (const float*)d_in[4]; p.dt_bias = (const float*)d_in[5]; p.gdn_norm_w = (const float*)d_in[6];
    p.lq1 = (const float*)d_in[7]; p.lk1 = (const float*)d_in[8]; p.lq2 = (const float*)d_in[9]; p.lk2 = (const float*)d_in[10];
    p.diff_norm_w = (const float*)d_in[11]; p.w_out = (const float*)d_in[12]; p.final_norm_w = (const float*)d_in[13];
    p.out = (float*)d_out; p.ws = (unsigned char*)d_ws;
    if (hipMemsetAsync((unsigned char*)d_ws + OFF_BAR, 0, 16384, stream) != hipSuccess) { fprintf(stderr, "kernel_launch: hipMemsetAsync failed\n"); return; }
    void* args[] = {&p};
    hipError_t e = hipLaunchCooperativeKernel((const void*)mega, dim3(grid), dim3(512), args, LDS_BYTES, stream);
    if (e != hipSuccess) fprintf(stderr, "cooperative launch failed: %s (grid %d)\n", hipGetErrorString(e), grid);
}
```

```cpp
#include <hip/hip_runtime.h>
#include <hip/hip_cooperative_groups.h>
#include <cstdio>
namespace cg = cooperative_groups;

#ifndef ENABLE_ATTN
#define ENABLE_ATTN 1
#endif
#ifndef ENABLE_GDN
#define ENABLE_GDN 1
#endif
#ifndef REP_PREP
#define REP_PREP 1
#endif
#ifndef REP_G1
#define REP_G1 1
#endif
#ifndef REP_GP
#define REP_GP 1
#endif
#ifndef REP_P3
#define REP_P3 1
#endif
#ifndef REP_G2
#define REP_G2 1
#endif
#ifndef REP_SCAN
#define REP_SCAN 1
#endif
#ifndef SCAN_SYNC
#define SCAN_SYNC 0
#endif
#ifndef REP_ATTN
#define REP_ATTN 1
#endif

#define LAS __attribute__((address_space(3)))
#define DI __device__ __forceinline__
typedef unsigned short bf16_t;
typedef short bf16x8 __attribute__((ext_vector_type(8)));
typedef short s16x4 __attribute__((ext_vector_type(4)));
typedef float f32x2 __attribute__((ext_vector_type(2)));
typedef float f32x4 __attribute__((ext_vector_type(4)));
typedef float f32x16 __attribute__((ext_vector_type(16)));
typedef unsigned u32x2 __attribute__((ext_vector_type(2)));
typedef unsigned u32x4 __attribute__((ext_vector_type(4)));
typedef __bf16 bf16x2_t __attribute__((ext_vector_type(2)));

#define MFMA32(a, b, c) __builtin_amdgcn_mfma_f32_32x32x16_bf16((a), (b), (c), 0, 0, 0)

constexpr int NB = 16, SEQ = 2048, DM = 1024, MTOK = NB * SEQ, NP1 = 3072, NG1 = 3584;
constexpr int C_GQ = 0, C_GK = 512, C_GV = 1024, C_GZ = 1536, C_DQ = 2048, C_DZ = 2560;
constexpr float EPS = 1e-6f;
constexpr float LOG2E = 1.4426950408889634f;

constexpr size_t OFF_HB = 0;
constexpr size_t OFF_WINT = OFF_HB + (size_t)MTOK * DM * 2;
constexpr size_t OFF_WOUTT = OFF_WINT + (size_t)4096 * 1024 * 2;
constexpr size_t OFF_GBGA = OFF_WOUTT + (size_t)1024 * 1024 * 2;
constexpr size_t OFF_P1 = OFF_GBGA + (size_t)MTOK * 8 * 4;
constexpr size_t OFF_KX = OFF_P1 + (size_t)MTOK * NP1 * 2;
constexpr size_t OFF_VT = OFF_KX + (size_t)64 * 2 * 2048 * 64 * 2;
constexpr size_t OFF_WN = OFF_VT + (size_t)64 * 128 * 2048 * 2;
constexpr size_t OFF_QD = OFF_WN + (size_t)2048 * 64 * 128 * 2;
constexpr size_t OFF_KD = OFF_QD + (size_t)2048 * 64 * 128 * 2;
constexpr size_t OFF_AQK = OFF_KD + (size_t)2048 * 64 * 128 * 2;
constexpr size_t OFF_U = OFF_AQK + (size_t)2048 * 64 * 64 * 2;
constexpr size_t OFF_GL = OFF_U + (size_t)2048 * 64 * 128 * 4;
constexpr size_t OFF_ROWSQ = OFF_GL + 8192;
constexpr size_t OFF_MISC = OFF_ROWSQ + (size_t)MTOK * 16 * 4;
constexpr size_t OFF_YB = OFF_P1;
constexpr size_t OFF_BAR = OFF_MISC + 256;
constexpr size_t WS_END = OFF_BAR + 16384;

constexpr int LDS_BYTES = 156 * 1024;

struct Params {
    const float *x, *norm_w, *w_in, *conv_w, *a_log, *dt_bias, *gdn_norm_w, *lq1, *lk1, *lq2, *lk2, *diff_norm_w, *w_out, *final_norm_w;
    float* out; unsigned char* ws;
};

DI unsigned pk_bf16(float a, float b) { f32x2 v = {a, b}; bf16x2_t r = __builtin_convertvector(v, bf16x2_t); return __builtin_bit_cast(unsigned, r); }
DI float bf_lo(unsigned u) { return __uint_as_float(u << 16); }
DI float bf_hi(unsigned u) { return __uint_as_float(u & 0xffff0000u); }
DI float wave_sum(float v) {
#pragma unroll
    for (int o = 32; o; o >>= 1) v += __shfl_xor(v, o);
    return v;
}
DI float xhalf_max(float v) {
    const u32x2 r = __builtin_amdgcn_permlane32_swap(__float_as_uint(v), __float_as_uint(v), false, false);
    return fmaxf(__uint_as_float(r.x), __uint_as_float(r.y));
}
DI float xhalf_sum(float v) {
    const u32x2 r = __builtin_amdgcn_permlane32_swap(__float_as_uint(v), __float_as_uint(v), false, false);
    return __uint_as_float(r.x) + __uint_as_float(r.y);
}
DI float silu_f(float z) { return z * __builtin_amdgcn_rcpf(1.0f + __builtin_amdgcn_exp2f(-LOG2E * z)); }
DI int perm23(int t) { return (t & ~12) | ((t & 4) << 1) | ((t & 8) >> 1); }
DI int crow(int i, int h2) { return (i & 3) + 8 * (i >> 2) + 4 * h2; }
DI bf16x8 pack8(const f32x16& x, int s) {
    u32x4 w; w.x = pk_bf16(x[8 * s + 0], x[8 * s + 1]); w.y = pk_bf16(x[8 * s + 2], x[8 * s + 3]); w.z = pk_bf16(x[8 * s + 4], x[8 * s + 5]); w.w = pk_bf16(x[8 * s + 6], x[8 * s + 7]);
    return __builtin_bit_cast(bf16x8, w);
}


#define XB_TMO      128
#define XB_XCNT(j)  (256  + 64 * (j))
#define XB_XSUB(j)  (1280 + 64 * (j))
#define XB_XGEN(j)  (2304 + 64 * (j))
#define XB_TOP      3328
#define XB_TOPGEN   3392
#define XCD_BAR_WORDS 3456
#define XB_SPIN_CAP (1u << 18)
struct XcdBarrier { unsigned* bar; unsigned x; volatile LAS unsigned* st; };
DI unsigned xb_ld(unsigned* p)              { return __hip_atomic_load(p, __ATOMIC_RELAXED, __HIP_MEMORY_SCOPE_AGENT); }
DI unsigned xb_add(unsigned* p, unsigned v) { return __hip_atomic_fetch_add(p, v, __ATOMIC_RELAXED, __HIP_MEMORY_SCOPE_AGENT); }
DI unsigned xb_xcc_id() { return (unsigned)__builtin_amdgcn_s_getreg((3 << 11) | 20) & 0xFu; }
#define XB_SPIN(cond, bar) do { unsigned _sp = 0; while (cond) { __builtin_amdgcn_s_sleep(1); \
    if ((++_sp & 255u) == 0u) { if (xb_ld(&(bar)[XB_TMO])) break; if (_sp > XB_SPIN_CAP) { atomicAdd(&(bar)[XB_TMO], 1u); break; } } } } while (0)
DI XcdBarrier xcd_barrier_post(unsigned* bar, volatile LAS unsigned* st) {
    XcdBarrier b; b.bar = bar; b.x = xb_xcc_id(); b.st = st;
    if (threadIdx.x == 0) (void)xb_add(&bar[XB_XCNT(b.x)], 1u);
    return b;
}
DI void xcd_barrier_complete(unsigned* bar, unsigned x, unsigned& nloc, unsigned& nx) {
    const unsigned G = gridDim.x * gridDim.y * gridDim.z;
    unsigned sum, cnt, mine, sp = 0u;
    for (;;) {
        sum = 0u; cnt = 0u; mine = 0u;
#pragma unroll
        for (unsigned j = 0; j < 16; ++j) { const unsigned c = xb_ld(&bar[XB_XCNT(j)]); sum += c; cnt += (c > 0u) ? 1u : 0u; mine = (j == x) ? c : mine; }
        if (sum == G) break;
        __builtin_amdgcn_s_sleep(1);
        if ((++sp & 255u) == 0u) { if (xb_ld(&bar[XB_TMO])) break; if (sp > XB_SPIN_CAP) { atomicAdd(&bar[XB_TMO], 1u); break; } }
    }
    nloc = mine > 0u ? mine : 1u; nx = cnt > 0u ? cnt : 1u;
}
DI void xcd_barrier(const XcdBarrier& b) {
    asm volatile("s_waitcnt vmcnt(0)" ::: "memory");
    __syncthreads();
    if (threadIdx.x == 0) {
        unsigned* bar = b.bar;
        __builtin_amdgcn_s_waitcnt(0);
        unsigned nloc = b.st[0], nx = b.st[1];
        if (nloc == 0u) { xcd_barrier_complete(bar, b.x, nloc, nx); b.st[0] = nloc; b.st[1] = nx; }
        const unsigned old = xb_add(&bar[XB_XSUB(b.x)], 1u);
        const unsigned gen = old / nloc;
        if (old + 1u == (gen + 1u) * nloc) {
            __builtin_amdgcn_fence(__ATOMIC_RELEASE, "agent");
            asm volatile("s_waitcnt vmcnt(0)" ::: "memory");
            const unsigned og = xb_add(&bar[XB_TOP], 1u);
            const unsigned tg = og / nx;
            if (og + 1u == (tg + 1u) * nx) xb_add(&bar[XB_TOPGEN], 1u);
            else XB_SPIN(xb_ld(&bar[XB_TOPGEN]) == tg, bar);
            __builtin_amdgcn_fence(__ATOMIC_ACQUIRE, "agent");
            xb_add(&bar[XB_XGEN(b.x)], 1u);
            asm volatile("s_waitcnt vmcnt(0)" ::: "memory");
        } else {
            XB_SPIN(xb_ld(&bar[XB_XGEN(b.x)]) == gen, bar);
            __builtin_amdgcn_fence(__ATOMIC_ACQUIRE, "agent");
            asm volatile("s_waitcnt vmcnt(0)" ::: "memory");
        }
    }
    __syncthreads();
}

namespace pg8 {
constexpr int BM = 256, BK = 64, HALF = 128, HTB = HALF * BK * 2, STAGE_BYTES = 8 * HTB, NXCD = 8, WGM = 8;
DI int lds_byte(int r, int c) { const int st = (r >> 4) * 2 + (c >> 5), rr = r & 15, cc = c & 31, ob = rr * 64 + cc * 2; return st * 1024 + (ob ^ (((ob >> 9) & 1) << 5)); }
DI void stage_rc(int b, int& R, int& C) { const int st = b / 1024, sb = b % 1024, swz = sb ^ (((sb >> 9) & 1) << 5); R = (st >> 1) * 16 + swz / 64; C = (st & 1) * 32 + (swz % 64) / 2; }
DI int perm32(int rho) { const int n = rho >> 4, i = rho & 15; return 8 * (i >> 2) + 4 * n + (i & 3); }
struct Unit { int pm, pn; };
struct Gemm { const bf16_t* A; const bf16_t* Bt; int M, N, K; };
struct StaticOrder {
    int nM, nN, nwg, G, c, i0 = 0, imax = 1 << 30;
    DI void init(int M, int N, int G_, int c_) { nM = M / BM; nN = N / BM; nwg = nM * nN; G = G_; c = c_; }
    DI bool next(int i, Unit& u) const {
        if (i >= imax) return false;
        const long L = (long)(i + i0) * G + c; if (L >= nwg) return false;
        int wgid = (int)L; { const int q = nwg / NXCD, r = nwg % NXCD, xcd = wgid % NXCD, off = wgid / NXCD; wgid = (xcd < r ? xcd * (q + 1) : r * (q + 1) + (xcd - r) * q) + off; }
        const int nig = WGM * nN, gid = wgid / nig, fm = gid * WGM, gsz = (nM - fm) < WGM ? (nM - fm) : WGM;
        u.pm = fm + ((wgid % nig) % gsz); u.pn = (wgid % nig) / gsz; return true;
    }
    DI void a_ready(const Unit&) const {}
    DI void done(const Unit&) const {}
};

struct EpiP1 {
    static constexpr bool PERM = true, PERM16 = true, AFTER_DRAIN = false;
    bf16_t* O; int ldc; bf16_t* KX;
    DI void operator()(const f32x4 (&acc)[2][2][4][2], const Unit& u, int wr, int wc, int fr, int fq) const {
        const int row0 = u.pm * BM + wr * 64 + fr, col0 = u.pn * BM + wc * 64 + 16 * fq;
        if (u.pn >= 12) {
            const int c = col0 - 12 * BM, hm = c >> 6, d = c & 63;
#pragma unroll
            for (int ai = 0; ai < 2; ++ai)
#pragma unroll
                for (int m = 0; m < 4; ++m) { const int row = row0 + ai * HALF + m * 16, b = row >> 11, tok = row & 2047;
                    bf16_t* dp = KX + ((size_t)(b * 8 + hm) * 2048 + tok) * 64 + d;
#pragma unroll
                    for (int bj = 0; bj < 2; ++bj) { const f32x4 v0 = acc[ai][bj][m][0], v1 = acc[ai][bj][m][1];
                        u32x4 w; w.x = pk_bf16(v0[0], v0[1]); w.y = pk_bf16(v0[2], v0[3]); w.z = pk_bf16(v1[0], v1[1]); w.w = pk_bf16(v1[2], v1[3]);
                        *(u32x4*)(dp + 8 * bj) = w; } }
            return;
        }
#pragma unroll
        for (int ai = 0; ai < 2; ++ai)
#pragma unroll
            for (int m = 0; m < 4; ++m) { bf16_t* rowp = O + (size_t)(row0 + ai * HALF + m * 16) * ldc + col0;
#pragma unroll
                for (int bj = 0; bj < 2; ++bj) { const f32x4 v0 = acc[ai][bj][m][0], v1 = acc[ai][bj][m][1];
                    u32x4 w; w.x = pk_bf16(v0[0], v0[1]); w.y = pk_bf16(v0[2], v0[3]); w.z = pk_bf16(v1[0], v1[1]); w.w = pk_bf16(v1[2], v1[3]);
                    *(u32x4*)(rowp + 8 * bj) = w; } }
    }
};
struct EpiVT {
    static constexpr bool PERM = false, PERM16 = false, AFTER_DRAIN = false;
    bf16_t* VT;
    DI void operator()(const f32x4 (&acc)[2][2][4][2], const Unit& u, int wr, int wc, int fr, int fq) const {
#pragma unroll
        for (int ai = 0; ai < 2; ++ai)
#pragma unroll
            for (int m = 0; m < 4; ++m) {
                const int t = u.pm * BM + ai * HALF + wr * 64 + m * 16 + 4 * fq, b = t >> 11, tok = t & 2047, pos = perm23(tok);
#pragma unroll
                for (int bj = 0; bj < 2; ++bj)
#pragma unroll
                    for (int n = 0; n < 2; ++n) {
                        const int c = u.pn * BM + bj * HALF + wc * 32 + n * 16 + fr, hh = c >> 7, dv = c & 127;
                        const f32x4 v = acc[ai][bj][m][n];
                        u32x2 w; w.x = pk_bf16(v[0], v[1]); w.y = pk_bf16(v[2], v[3]);
                        *(u32x2*)(VT + (((size_t)((b * 4 + hh) * 32 + (pos >> 6)) * 128 + dv)) * 64 + (pos & 63)) = w;
                    }
            }
    }
};
static_assert(WGM == 8, "EpiOutFused needs the four column tiles of a row panel in the same round");
struct EpiOutFused {
    static constexpr bool PERM = false, PERM16 = false, AFTER_DRAIN = true;
    const float* X; float* Out; float* rowsq; const float* fw; XcdBarrier xb;
    DI void operator()(const f32x4 (&)[2][2][4][2], const Unit&, int, int, int, int) const {}
    DI void fused(f32x4 (&acc)[2][2][4][2], const Unit& u, int wr, int wc, int fr, int fq) const {
        const int row0 = u.pm * BM + wr * 64 + fr, col0 = u.pn * BM + wc * 32 + 4 * fq;
#pragma unroll
        for (int ai = 0; ai < 2; ++ai)
#pragma unroll
            for (int m = 0; m < 4; ++m) {
                const int row = row0 + ai * HALF + m * 16; float ss = 0.f;
#pragma unroll
                for (int bj = 0; bj < 2; ++bj)
#pragma unroll
                    for (int n = 0; n < 2; ++n) {
                        const size_t o = (size_t)row * DM + col0 + bj * HALF + n * 16;
                        const f32x4 y = acc[ai][bj][m][n] + *(const f32x4*)(X + o);
                        acc[ai][bj][m][n] = y; ss += y[0] * y[0] + y[1] * y[1] + y[2] * y[2] + y[3] * y[3];
                    }
                ss += __shfl_xor(ss, 16); ss += __shfl_xor(ss, 32);
                if (fq == 0) rowsq[(size_t)row * 16 + u.pn * 4 + wc] = ss;
            }
        xcd_barrier(xb);
        f32x4 fwv[2][2];
#pragma unroll
        for (int bj = 0; bj < 2; ++bj)
#pragma unroll
            for (int n = 0; n < 2; ++n) fwv[bj][n] = *(const f32x4*)(fw + col0 + bj * HALF + n * 16);
#pragma unroll
        for (int ai = 0; ai < 2; ++ai)
#pragma unroll
            for (int m = 0; m < 4; ++m) {
                const int row = row0 + ai * HALF + m * 16;
                const f32x4* rq = (const f32x4*)(rowsq + (size_t)row * 16);
                const f32x4 q0 = rq[0], q1 = rq[1], q2 = rq[2], q3 = rq[3];
                const float tot = ((q0[0] + q0[1]) + (q0[2] + q0[3])) + ((q1[0] + q1[1]) + (q1[2] + q1[3])) + ((q2[0] + q2[1]) + (q2[2] + q2[3])) + ((q3[0] + q3[1]) + (q3[2] + q3[3]));
                const float rstd = rsqrtf(tot * (1.0f / DM) + EPS);
#pragma unroll
                for (int bj = 0; bj < 2; ++bj)
#pragma unroll
                    for (int n = 0; n < 2; ++n) {
                        const size_t o = (size_t)row * DM + col0 + bj * HALF + n * 16;
                        *(f32x4*)(Out + o) = acc[ai][bj][m][n] * rstd * fwv[bj][n];
                    }
            }
    }
};

template <class Epi, bool SWAP>
DI void gemm_phase(LAS unsigned char* lds, const Gemm g, const StaticOrder& S, const Epi& E) {
    int tid = threadIdx.x; asm volatile("" : "+v"(tid));
    const int wid = __builtin_amdgcn_readfirstlane(tid >> 6), lane = tid & 63, wr = wid >> 2, wc = wid & 3, fr = lane & 15, fq = lane >> 4;
    const int K = g.K, nt = K / BK;
    unsigned voffA[2], voffB[2], voffB1[2];
#pragma unroll
    for (int i = 0; i < 2; ++i) { int R, C; stage_rc(tid * 16 + i * 8192, R, C); const int Rb = Epi::PERM ? ((R & ~31) + perm32(R & 31)) : R;
        voffA[i] = (unsigned)(R * K + C) * 2u;
        if constexpr (Epi::PERM16) {
            const int c0 = 64 * (R >> 5) + 16 * ((R >> 2) & 3) + 4 * ((R >> 4) & 1) + (R & 3);
            voffB[i] = (unsigned)(c0 * K + C) * 2u; voffB1[i] = (unsigned)((c0 + 8) * K + C) * 2u;
        } else { voffB[i] = (unsigned)(Rb * K + C) * 2u; voffB1[i] = voffB[i]; } }
    const size_t kstep = (size_t)(BK * 2);
    const size_t hstep = (size_t)HALF * K * 2;
    const size_t tstep = 2 * hstep;
    const size_t hoff = Epi::PERM16 ? 0 : hstep;
    const unsigned ldsw = (unsigned)wid * 1024u;
    const int aoff = lds_byte(wr * 64 + fr, fq * 8), boff = lds_byte(wc * 32 + fr, fq * 8);
#define PG8_SA(b, h) (((b) * 2 + (h)) * HTB)
#define PG8_SB(b, h) ((4 + (b) * 2 + (h)) * HTB)
#define PG8_STAGE(bufoff, gbase, voff) do { _Pragma("unroll") for (int _i = 0; _i < 2; ++_i) \
        __builtin_amdgcn_global_load_lds((const unsigned*)((const char*)(gbase) + (voff)[_i]), (LAS unsigned*)(lds + (bufoff) + ldsw + _i * 8192), 16, 0, 0); } while (0)
#define PG8_LDA(dst, b, h) do { _Pragma("unroll") for (int m = 0; m < 4; ++m) _Pragma("unroll") for (int k = 0; k < 2; ++k) dst[m][k] = *(const LAS bf16x8*)(lds + PG8_SA(b, h) + aoff + m * 2048 + k * 1024); } while (0)
#define PG8_LDB(dst, b, h) do { _Pragma("unroll") for (int n = 0; n < 2; ++n) _Pragma("unroll") for (int k = 0; k < 2; ++k) dst[n][k] = *(const LAS bf16x8*)(lds + PG8_SB(b, h) + boff + n * 2048 + k * 1024); } while (0)
#define PG8_MMA(ai, bj, At, Bt) do { __builtin_amdgcn_s_setprio(1); _Pragma("unroll") for (int m = 0; m < 4; ++m) _Pragma("unroll") for (int n = 0; n < 2; ++n) _Pragma("unroll") for (int k = 0; k < 2; ++k) \
        acc[ai][bj][m][n] = SWAP ? __builtin_amdgcn_mfma_f32_16x16x32_bf16(At[m][k], Bt[n][k], acc[ai][bj][m][n], 0, 0, 0) \
                                 : __builtin_amdgcn_mfma_f32_16x16x32_bf16(Bt[n][k], At[m][k], acc[ai][bj][m][n], 0, 0, 0); __builtin_amdgcn_s_setprio(0); } while (0)
#define PG8_WAIT_V(n) asm volatile("s_waitcnt vmcnt(" #n ")" ::: "memory")
#define PG8_WAIT_L(n) asm volatile("s_waitcnt lgkmcnt(" #n ")" ::: "memory")
#define PG8_BAR __builtin_amdgcn_s_barrier()
#define PG8_SCHED __builtin_amdgcn_sched_barrier(0)
    Unit cur, nxt; int ui = 0;
    if (!S.next(0, cur)) return;
    f32x4 acc[2][2][4][2];
#pragma unroll
    for (int a = 0; a < 2; ++a)
#pragma unroll
        for (int b = 0; b < 2; ++b)
#pragma unroll
            for (int m = 0; m < 4; ++m)
#pragma unroll
                for (int n = 0; n < 2; ++n) acc[a][b][m][n] = (f32x4){0.f, 0.f, 0.f, 0.f};
    bf16x8 At[4][2], B0[2][2], B1[2][2];
    const char* cA = (const char*)g.A + (size_t)cur.pm * tstep; const char* cB = (const char*)g.Bt + (size_t)cur.pn * tstep;
    PG8_STAGE(PG8_SB(0, 0), cB, voffB); PG8_STAGE(PG8_SA(0, 0), cA, voffA); PG8_STAGE(PG8_SB(0, 1), cB + hoff, voffB1); PG8_STAGE(PG8_SA(0, 1), cA + hstep, voffA);
    if (wr == 1) PG8_BAR;
    PG8_WAIT_V(4); PG8_BAR;
    PG8_STAGE(PG8_SB(1, 0), cB + kstep, voffB); PG8_STAGE(PG8_SA(1, 0), cA + kstep, voffA); PG8_STAGE(PG8_SB(1, 1), cB + hoff + kstep, voffB1);
    PG8_WAIT_V(6); PG8_BAR;
    for (;;) {
        const bool has_next = S.next(ui + 1, nxt);
        const char* nA = has_next ? (const char*)g.A + (size_t)nxt.pm * tstep : cA; const char* nB = has_next ? (const char*)g.Bt + (size_t)nxt.pn * tstep : cB;
        for (int t = 0; t < nt; t += 2) {
            const bool last = (t == nt - 2);
            const char* a1 = cA + (size_t)(t + 1) * kstep;
            const char* a2 = last ? nA : cA + (size_t)(t + 2) * kstep; const char* b2 = last ? nB : cB + (size_t)(t + 2) * kstep;
            const char* a3 = a2 + kstep; const char* b3 = b2 + kstep;
            PG8_LDB(B0, 0, 0); PG8_SCHED; PG8_LDA(At, 0, 0); PG8_STAGE(PG8_SA(1, 1), a1 + hstep, voffA);
            PG8_WAIT_L(8); PG8_BAR; PG8_WAIT_L(0); PG8_MMA(0, 0, At, B0); PG8_BAR; PG8_SCHED;
            PG8_LDB(B1, 0, 1); PG8_STAGE(PG8_SB(0, 0), b2, voffB);
            PG8_BAR; PG8_WAIT_L(0); PG8_MMA(0, 1, At, B1); PG8_BAR;
            PG8_LDA(At, 0, 1); PG8_STAGE(PG8_SA(0, 0), a2, voffA);
            PG8_BAR; PG8_WAIT_L(0); PG8_MMA(1, 0, At, B0); PG8_BAR; PG8_SCHED;
            PG8_STAGE(PG8_SB(0, 1), b2 + hoff, voffB1);
            PG8_WAIT_V(6); PG8_BAR; PG8_MMA(1, 1, At, B1); PG8_BAR;
            PG8_LDB(B0, 1, 0); PG8_SCHED; PG8_LDA(At, 1, 0); PG8_STAGE(PG8_SA(0, 1), a2 + hstep, voffA);
            PG8_WAIT_L(8); PG8_BAR; PG8_WAIT_L(0); PG8_MMA(0, 0, At, B0); PG8_BAR; PG8_SCHED;
            PG8_LDB(B1, 1, 1); PG8_STAGE(PG8_SB(1, 0), b3, voffB);
            PG8_BAR; PG8_WAIT_L(0); PG8_MMA(0, 1, At, B1); PG8_BAR;
            PG8_LDA(At, 1, 1); PG8_STAGE(PG8_SA(1, 0), a3, voffA);
            PG8_BAR; PG8_WAIT_L(0); PG8_MMA(1, 0, At, B0); PG8_BAR; PG8_SCHED;
            PG8_STAGE(PG8_SB(1, 1), b3 + hoff, voffB1);
            PG8_WAIT_V(6); PG8_BAR; PG8_MMA(1, 1, At, B1); PG8_BAR;
        }
        if constexpr (!Epi::AFTER_DRAIN) E(acc, cur, wr, wc, fr, fq);
        if (!has_next) break;
#pragma unroll
        for (int a = 0; a < 2; ++a)
#pragma unroll
            for (int b = 0; b < 2; ++b)
#pragma unroll
                for (int m = 0; m < 4; ++m)
#pragma unroll
                    for (int n = 0; n < 2; ++n) acc[a][b][m][n] = (f32x4){0.f, 0.f, 0.f, 0.f};
        cur = nxt; cA = nA; cB = nB; ++ui;
    }
    PG8_WAIT_V(0);
    if (wr == 0) PG8_BAR;
    PG8_BAR;
    if constexpr (Epi::AFTER_DRAIN) E.fused(acc, cur, wr, wc, fr, fq);
#undef PG8_SA
#undef PG8_SB
#undef PG8_STAGE
#undef PG8_LDA
#undef PG8_LDB
#undef PG8_MMA
#undef PG8_WAIT_V
#undef PG8_WAIT_L
#undef PG8_BAR
#undef PG8_SCHED
}
}

DI int win_src_col(int n0) {
    if (n0 < 2048) return n0;
    if (n0 < 2560) return 2056 + (n0 - 2048);
    if (n0 < 3072) return 3592 + (n0 - 2560);
    if (n0 < 3584) return 2568 + (n0 - 3072);
    return 3080 + (n0 - 3584);
}
DI void phase_prep(const Params& p, LAS unsigned char* lds) {
    int tid = threadIdx.x; asm volatile("" : "+v"(tid));
    const int lane = tid & 63, wid = tid >> 6;
    if (blockIdx.x == 0 && wid == 0) {
        float a = p.lq1[lane] * p.lk1[lane], b = p.lq2[lane] * p.lk2[lane];
        a = wave_sum(a); b = wave_sum(b);
        if (lane == 0) { *(float*)(p.ws + OFF_MISC) = expf(a) - expf(b) + 0.2f; *(unsigned*)(p.ws + OFF_MISC + 4) = 0u; *(unsigned*)(p.ws + OFF_MISC + 8) = 0u; *(unsigned*)(p.ws + OFF_MISC + 12) = 0u; }
    }
    bf16_t* hb = (bf16_t*)(p.ws + OFF_HB);
    float* gbga = (float*)(p.ws + OFF_GBGA);
    const int gw = blockIdx.x * 8 + wid, nw = gridDim.x * 8;
    {
        f32x4 nwv[4]; float wq[16][8];
#pragma unroll
        for (int i = 0; i < 4; ++i) {
            nwv[i] = ((const f32x4*)p.norm_w)[lane + 64 * i];
#pragma unroll
            for (int e = 0; e < 4; ++e) {
                const int k = 4 * (lane + 64 * i) + e;
                const f32x4* wp = (const f32x4*)(p.w_in + (size_t)k * 4104 + 2048);
                const f32x4 w0 = wp[0], w1 = wp[1];
#pragma unroll
                for (int j = 0; j < 4; ++j) { wq[4 * i + e][j] = nwv[i][e] * w0[j]; wq[4 * i + e][4 + j] = nwv[i][e] * w1[j]; }
            }
        }
        const bool b5 = (lane & 32) != 0, b4 = (lane & 16) != 0, b3 = (lane & 8) != 0;
        const int col = (b5 ? 4 : 0) + (b4 ? 2 : 0) + (b3 ? 1 : 0);
        int row = gw;
        f32x4 v[4];
        if (row < MTOK) {
#pragma unroll
            for (int i = 0; i < 4; ++i) v[i] = __builtin_nontemporal_load((const f32x4*)(p.x + (size_t)row * DM) + lane + 64 * i);
        }
#pragma unroll 1
        for (; row < MTOK; row += nw) {
            f32x4 vnx[4];
            const int rnx = (row + nw < MTOK) ? row + nw : row;
#pragma unroll
            for (int i = 0; i < 4; ++i) vnx[i] = __builtin_nontemporal_load((const f32x4*)(p.x + (size_t)rnx * DM) + lane + 64 * i);
            float ss = 0.f, a8[8];
#pragma unroll
            for (int j = 0; j < 8; ++j) a8[j] = 0.f;
#pragma unroll
            for (int i = 0; i < 4; ++i)
#pragma unroll
                for (int e = 0; e < 4; ++e) {
                    ss += v[i][e] * v[i][e];
#pragma unroll
                    for (int j = 0; j < 8; ++j) a8[j] += v[i][e] * wq[4 * i + e][j];
                }
            ss = wave_sum(ss);
            const float rstd = rsqrtf(ss * (1.0f / DM) + EPS);
#pragma unroll
            for (int i = 0; i < 4; ++i) {
                const f32x4 h = v[i] * rstd * nwv[i];
                u32x2 w; w.x = pk_bf16(h[0], h[1]); w.y = pk_bf16(h[2], h[3]);
                *(u32x2*)(hb + (size_t)row * DM + 4 * (lane + 64 * i)) = w;
            }
            float c4[4], c2[2], c1;
#pragma unroll
            for (int j = 0; j < 4; ++j) { const float send = b5 ? a8[j] : a8[4 + j], keep = b5 ? a8[4 + j] : a8[j]; c4[j] = keep + __shfl_xor(send, 32); }
#pragma unroll
            for (int j = 0; j < 2; ++j) { const float send = b4 ? c4[j] : c4[2 + j], keep = b4 ? c4[2 + j] : c4[j]; c2[j] = keep + __shfl_xor(send, 16); }
            { const float send = b3 ? c2[0] : c2[1], keep = b3 ? c2[1] : c2[0]; c1 = keep + __shfl_xor(send, 8); }
            c1 += __shfl_xor(c1, 4); c1 += __shfl_xor(c1, 2); c1 += __shfl_xor(c1, 1);
            if ((lane & 7) == 0) gbga[(size_t)row * 8 + col] = c1 * rstd;
#pragma unroll
            for (int i = 0; i < 4; ++i) v[i] = vnx[i];
        }
    }
    LAS float* tl = (LAS float*)lds;
    for (int tile = blockIdx.x; tile < 1024 + 256; tile += gridDim.x) {
        const float* src; int ld, n0, k0, srcn0; bf16_t* dst;
        if (tile < 1024) { n0 = (tile >> 4) * 64; k0 = (tile & 15) * 64; srcn0 = win_src_col(n0); src = p.w_in; ld = 4104; dst = (bf16_t*)(p.ws + OFF_WINT); }
        else { const int t2 = tile - 1024; n0 = (t2 >> 4) * 64; k0 = (t2 & 15) * 64; srcn0 = n0; src = p.w_out; ld = 1024; dst = (bf16_t*)(p.ws + OFF_WOUTT); }
        const int kk = tid >> 4, n4 = tid & 15;
#pragma unroll
        for (int ps = 0; ps < 2; ++ps) { const int k = kk + 32 * ps;
            const f32x4 v = __builtin_nontemporal_load((const f32x4*)(src + (size_t)(k0 + k) * ld + srcn0 + 4 * n4));
#pragma unroll
            for (int e = 0; e < 4; ++e) tl[k * 65 + 4 * n4 + e] = v[e]; }
        __syncthreads();
        { const int n = tid >> 3, k8 = tid & 7; float f[8];
#pragma unroll
            for (int e = 0; e < 8; ++e) f[e] = tl[(8 * k8 + e) * 65 + n];
            u32x4 w; w.x = pk_bf16(f[0], f[1]); w.y = pk_bf16(f[2], f[3]); w.z = pk_bf16(f[4], f[5]); w.w = pk_bf16(f[6], f[7]);
            *(u32x4*)(dst + (size_t)(n0 + n) * 1024 + k0 + 8 * k8) = w; }
        __syncthreads();
    }
}

constexpr int AT_KB = 8192, AT_VB = 16384, AT_BUF = AT_KB + AT_VB, AT_NBUF = 3, AT_TASK = AT_NBUF * AT_BUF, AT_O1 = AT_TASK + 256;

DI void attn_qblock(const Params& p, LAS unsigned char* lds, int b, int hh, int qb, float lam) {
    int tid = threadIdx.x; asm volatile("" : "+v"(tid));
    const int lane = tid & 63, wid = __builtin_amdgcn_readfirstlane(tid >> 6);
    const bf16_t* P1 = (const bf16_t*)(p.ws + OFF_P1);
    const bf16_t* VT = (const bf16_t*)(p.ws + OFF_VT) + (size_t)(b * 4 + hh) * 32 * 128 * 64;
    const bf16_t* KX = (const bf16_t*)(p.ws + OFF_KX) + (size_t)(b * 4 + hh) * 2 * 2048 * 64;
    bf16_t* mix = (bf16_t*)(p.ws + OFF_HB);
    const int q0 = qb * 256 + wid * 32;
    const size_t tokbase = (size_t)b * SEQ;
    const int nkt = (qb + 1) * 4;
    const float sl2 = exp2f(-2.0f * (float)(hh + 1)) * LOG2E;
    const float c1 = 0.125f * LOG2E;
#pragma unroll 1
    for (int map = 0; map < 2; ++map) {
        f32x16 O[4];
#pragma unroll
        for (int mt = 0; mt < 4; ++mt)
#pragma unroll
            for (int i = 0; i < 16; ++i) O[mt][i] = 0.f;
        float m = -INFINITY, l = 0.f;
        int lane_m = lane; asm volatile("" : "+v"(lane_m));
        const int r = lane_m & 31, h2 = lane_m >> 5;
        int foff[4];
#pragma unroll
        for (int k = 0; k < 4; ++k) foff[k] = r * 128 + (((2 * k + h2) ^ ((r >> 1) & 7)) << 4);
        float kb[16];
#pragma unroll
        for (int i = 0; i < 16; ++i) kb[i] = sl2 * (float)crow(i, h2);
        const int krow_ = 8 * wid + (lane_m >> 3), vrow0 = 16 * wid + (lane_m >> 3), vrow1 = vrow0 + 8;
        const bf16_t* kgp = KX + ((size_t)map * 2048 + krow_) * 64 + (((lane_m & 7) ^ ((krow_ >> 1) & 7)) * 8);
        const bf16_t* vgp0 = VT + (size_t)vrow0 * 64 + (((lane_m & 7) ^ ((vrow0 >> 1) & 7)) * 8);
        const bf16_t* vgp1 = VT + (size_t)vrow1 * 64 + (((lane_m & 7) ^ ((vrow1 >> 1) & 7)) * 8);
#define AT_STAGE(bufi, tile) do { LAS unsigned char* _b = lds + (bufi) * AT_BUF; \
            __builtin_amdgcn_global_load_lds((const unsigned*)(kgp + (size_t)(tile) * 64 * 64), (LAS unsigned*)(_b + wid * 1024), 16, 0, 0); \
            __builtin_amdgcn_global_load_lds((const unsigned*)(vgp0 + (size_t)(tile) * 128 * 64), (LAS unsigned*)(_b + AT_KB + wid * 2048), 16, 0, 0); \
            __builtin_amdgcn_global_load_lds((const unsigned*)(vgp1 + (size_t)(tile) * 128 * 64), (LAS unsigned*)(_b + AT_KB + wid * 2048 + 1024), 16, 0, 0); } while (0)
        bf16x8 qf[4];
        { const bf16_t* qp = P1 + (tokbase + q0 + (lane_m & 31)) * NP1 + C_DQ + hh * 128 + map * 64 + 8 * (lane_m >> 5);
#pragma unroll
            for (int ks = 0; ks < 4; ++ks) qf[ks] = *(const bf16x8*)(qp + 16 * ks); }
        AT_STAGE(0, 0);
        AT_STAGE(1, 1);
        asm volatile("" : "+v"(qf[0]), "+v"(qf[1]), "+v"(qf[2]), "+v"(qf[3]));
        int cb = 0;
#pragma unroll 1
        for (int kt = 0; kt < nkt; ++kt) {
            asm volatile("s_waitcnt vmcnt(0)" ::: "memory");
            __builtin_amdgcn_s_barrier();
            asm volatile("" ::: "memory");
            if (kt + 2 < nkt) { const int nb = cb == 0 ? 2 : cb - 1; AT_STAGE(nb, kt + 2); }
            const LAS unsigned char* cur = lds + cb * AT_BUF;
            cb = cb == 2 ? 0 : cb + 1;
            const int k0 = kt * 64;
            if (k0 <= q0) {
                const bool sub1 = (k0 + 32 <= q0);
                const LAS unsigned char* vb = cur + AT_KB;
                bf16x8 kf[8];
#pragma unroll
                for (int ks = 0; ks < 4; ++ks) kf[ks] = *(const LAS bf16x8*)(cur + foff[ks]);
                if (sub1) {
#pragma unroll
                    for (int ks = 0; ks < 4; ++ks) kf[4 + ks] = *(const LAS bf16x8*)(cur + 4096 + foff[ks]);
                }
                f32x16 s0, s1;
#pragma unroll
                for (int i = 0; i < 16; ++i) { s0[i] = 0.f; s1[i] = 0.f; }
#pragma unroll
                for (int ks = 0; ks < 4; ++ks) s0 = MFMA32(kf[ks], qf[ks], s0);
                if (sub1) {
#pragma unroll
                    for (int ks = 0; ks < 4; ++ks) s1 = MFMA32(kf[4 + ks], qf[ks], s1);
                }
                __builtin_amdgcn_sched_barrier(0);
                bf16x8 va[8];
#pragma unroll
                for (int s2 = 0; s2 < 2; ++s2)
#pragma unroll
                    for (int mt = 0; mt < 4; ++mt) va[s2 * 4 + mt] = *(const LAS bf16x8*)(vb + mt * 4096 + foff[s2]);
                __builtin_amdgcn_sched_barrier(0);
                const float off0 = sl2 * (float)(k0 - q0), off1 = off0 + 32.0f * sl2;
                const f32x2 c1v = {c1, c1};
#pragma unroll
                for (int j = 0; j < 8; ++j) {
                    const f32x2 kv = {kb[2 * j], kb[2 * j + 1]};
                    f32x2 a = {s0[2 * j], s0[2 * j + 1]}, c = {s1[2 * j], s1[2 * j + 1]};
                    a = __builtin_elementwise_fma(a, c1v, kv); c = __builtin_elementwise_fma(c, c1v, kv);
                    s0[2 * j] = a.x; s0[2 * j + 1] = a.y; s1[2 * j] = c.x; s1[2 * j + 1] = c.y;
                }
                if (k0 == q0) {
#pragma unroll
                    for (int i = 0; i < 16; ++i) if (crow(i, h2) > r) s0[i] = -INFINITY;
                }
                if (k0 + 32 == q0) {
#pragma unroll
                    for (int i = 0; i < 16; ++i) if (crow(i, h2) > r) s1[i] = -INFINITY;
                }
                float mx0 = fmaxf(s0[0], s0[1]), mx1 = fmaxf(s1[0], s1[1]);
#pragma unroll
                for (int j = 1; j < 8; ++j) { mx0 = fmaxf(fmaxf(s0[2 * j], s0[2 * j + 1]), mx0); mx1 = fmaxf(fmaxf(s1[2 * j], s1[2 * j + 1]), mx1); }
                float mx = sub1 ? fmaxf(mx0 + off0, mx1 + off1) : mx0 + off0;
                mx = xhalf_max(mx);
                if (__builtin_amdgcn_ballot_w64(mx > m + 8.0f) != 0ull) {
                    const float mn = fmaxf(m, mx);
                    const float alpha = __builtin_amdgcn_exp2f(m - mn);
                    m = mn; l *= alpha;
#pragma unroll
                    for (int mt = 0; mt < 4; ++mt)
#pragma unroll
                        for (int i = 0; i < 16; ++i) O[mt][i] *= alpha;
                }
                const float r0 = m - off0, r1 = sub1 ? m - off1 : INFINITY;
                const f32x2 r0v = {r0, r0}, r1v = {r1, r1};
                f32x2 lsv = {0.f, 0.f};
#pragma unroll
                for (int j = 0; j < 8; ++j) {
                    f32x2 a = {s0[2 * j], s0[2 * j + 1]}, c = {s1[2 * j], s1[2 * j + 1]};
                    a = a - r0v; c = c - r1v;
                    a.x = __builtin_amdgcn_exp2f(a.x); a.y = __builtin_amdgcn_exp2f(a.y); c.x = __builtin_amdgcn_exp2f(c.x); c.y = __builtin_amdgcn_exp2f(c.y);
                    lsv = lsv + a; lsv = lsv + c;
                    s0[2 * j] = a.x; s0[2 * j + 1] = a.y; s1[2 * j] = c.x; s1[2 * j + 1] = c.y;
                }
                l += lsv.x + lsv.y;
                bf16x8 pf[4];
#pragma unroll
                for (int s = 0; s < 2; ++s) { pf[s] = pack8(s0, s); pf[2 + s] = pack8(s1, s); }
                __builtin_amdgcn_sched_barrier(0);
                bf16x8 vc[4], vd[4];
                if (sub1) {
#pragma unroll
                    for (int mt = 0; mt < 4; ++mt) vc[mt] = *(const LAS bf16x8*)(vb + mt * 4096 + foff[2]);
                }
#pragma unroll
                for (int mt = 0; mt < 4; ++mt) O[mt] = MFMA32(va[mt], pf[0], O[mt]);
                if (sub1) {
#pragma unroll
                    for (int mt = 0; mt < 4; ++mt) vd[mt] = *(const LAS bf16x8*)(vb + mt * 4096 + foff[3]);
                }
#pragma unroll
                for (int mt = 0; mt < 4; ++mt) O[mt] = MFMA32(va[4 + mt], pf[1], O[mt]);
                if (sub1) {
#pragma unroll
                    for (int mt = 0; mt < 4; ++mt) O[mt] = MFMA32(vc[mt], pf[2], O[mt]);
#pragma unroll
                    for (int mt = 0; mt < 4; ++mt) O[mt] = MFMA32(vd[mt], pf[3], O[mt]);
                }
            }
        }
        asm volatile("" ::: "memory");
        __builtin_amdgcn_s_barrier();
        asm volatile("" ::: "memory");
#undef AT_STAGE
        const float lt = xhalf_sum(l);
        int lane_o = lane; asm volatile("" : "+v"(lane_o));
        LAS unsigned* o1l = (LAS unsigned*)(lds + AT_O1 + wid * 8192) + lane_o;
        if (map == 0) {
            const float inv1 = 1.0f / lt;
#pragma unroll
            for (int mt = 0; mt < 4; ++mt)
#pragma unroll
                for (int j = 0; j < 8; ++j) o1l[(mt * 8 + j) * 64] = pk_bf16(O[mt][2 * j] * inv1, O[mt][2 * j + 1] * inv1);
        } else {
            const float inv2 = lam / lt;
            float ss = 0.f;
#pragma unroll
            for (int mt = 0; mt < 4; ++mt)
#pragma unroll
                for (int j = 0; j < 8; ++j) {
                    const unsigned o1 = o1l[(mt * 8 + j) * 64];
                    const float a = bf_lo(o1) - O[mt][2 * j] * inv2, c = bf_hi(o1) - O[mt][2 * j + 1] * inv2;
                    O[mt][2 * j] = a; O[mt][2 * j + 1] = c; ss += a * a + c * c;
                }
            ss = xhalf_sum(ss);
            const float rs = rsqrtf(ss * (1.0f / 128.0f) + EPS) * 0.8f;
#pragma unroll
            for (int mt = 0; mt < 4; ++mt)
#pragma unroll
                for (int j = 0; j < 8; ++j) o1l[(mt * 8 + j) * 64] = pk_bf16(O[mt][2 * j] * rs, O[mt][2 * j + 1] * rs);
            __builtin_amdgcn_wave_barrier();
            int lane_e = lane; asm volatile("" : "+v"(lane_e));
            const int dvg = lane_e & 15, qs = lane_e >> 4;
            const f32x4 nw0 = *(const f32x4*)(p.diff_norm_w + 8 * dvg), nw1 = *(const f32x4*)(p.diff_norm_w + 8 * dvg + 4);
            const LAS unsigned* ob = (const LAS unsigned*)(lds + AT_O1 + wid * 8192);
            const int slot = (dvg >> 2) * 8 + 2 * (dvg & 3);
            u32x4 dzv[8];
#pragma unroll
            for (int it = 0; it < 8; ++it) dzv[it] = *(const u32x4*)(P1 + (tokbase + q0 + it * 4 + qs) * NP1 + C_DZ + hh * 128 + 8 * dvg);
#pragma unroll
            for (int it = 0; it < 8; ++it) {
                const int q = it * 4 + qs; const size_t row = tokbase + q0 + q;
                const unsigned u0 = ob[slot * 64 + q], u1 = ob[(slot + 1) * 64 + q], u2 = ob[slot * 64 + q + 32], u3 = ob[(slot + 1) * 64 + q + 32];
                const u32x4 dz = dzv[it];
                u32x4 w;
                w.x = pk_bf16(bf_lo(u0) * nw0[0] * silu_f(bf_lo(dz.x)), bf_hi(u0) * nw0[1] * silu_f(bf_hi(dz.x)));
                w.y = pk_bf16(bf_lo(u1) * nw0[2] * silu_f(bf_lo(dz.y)), bf_hi(u1) * nw0[3] * silu_f(bf_hi(dz.y)));
                w.z = pk_bf16(bf_lo(u2) * nw1[0] * silu_f(bf_lo(dz.z)), bf_hi(u2) * nw1[1] * silu_f(bf_hi(dz.z)));
                w.w = pk_bf16(bf_lo(u3) * nw1[2] * silu_f(bf_lo(dz.w)), bf_hi(u3) * nw1[3] * silu_f(bf_hi(dz.w)));
                *(u32x4*)(mix + row * DM + 512 + hh * 128 + 8 * dvg) = w;
            }
            __builtin_amdgcn_wave_barrier();
        }
    }
}

DI void phase_attn(const Params& p, LAS unsigned char* lds, int rep) {
    const float lam = *(const float*)(p.ws + OFF_MISC);
    unsigned* counter = (unsigned*)(p.ws + OFF_MISC + 4 + 4 * rep);
    LAS int* tslot = (LAS int*)(lds + AT_TASK);
    for (;;) {
        if (threadIdx.x == 0) *tslot = (int)atomicAdd(counter, 1u);
        __syncthreads();
        const int t = *tslot;
        __syncthreads();
        if (t >= 512) break;
        const int qb = 7 - (t >> 6), bh = t & 63;
        attn_qblock(p, lds, bh >> 2, bh & 3, qb, lam);
    }
}


constexpr int G_QN = 0, G_KN = 17408, G_VB = 34816, G_KBG = 52224, G_M = 69632, G_T = 86016, G_SM = 95232;
DI bf16x8 tr_pair(const LAS unsigned char* lo_addr, int hi_off) {
    const s16x4 lo = __builtin_amdgcn_ds_read_tr16_b64_v4i16((LAS s16x4*)(lo_addr));
    const s16x4 hi = __builtin_amdgcn_ds_read_tr16_b64_v4i16((LAS s16x4*)(lo_addr + hi_off));
    return __builtin_shufflevector(lo, hi, 0, 1, 2, 3, 4, 5, 6, 7);
}
DI bf16_t bf16_1(float v) { return (bf16_t)(pk_bf16(v, 0.f) & 0xffffu); }

DI void gdn_gates(const Params& p, LAS float* sm, int c2, int lane) {
    const int b = c2 >> 7, hh = (c2 >> 5) & 3, n = c2 & 31;
    const size_t tok0 = (size_t)b * SEQ + (size_t)n * 64;
    const float* gg = (const float*)(p.ws + OFF_GBGA) + (tok0 + lane) * 8;
    const float gbv = gg[hh], gav = gg[4 + hh];
    const float beta = 1.0f / (1.0f + expf(-gbv));
    const float xs = gav + p.dt_bias[hh];
    const float sp = fmaxf(xs, 0.f) + log1pf(expf(-fabsf(xs)));
    float gc = -expf(p.a_log[hh]) * sp;
#pragma unroll
    for (int o = 1; o < 64; o <<= 1) { const float t = __shfl_up(gc, o); if (lane >= o) gc += t; }
    const float gl = __shfl(gc, 63);
    sm[lane] = beta; sm[64 + lane] = gc * LOG2E; sm[128 + lane] = expf(gc); sm[192 + lane] = expf(gl - gc);
    if (lane == 63) ((float*)(p.ws + OFF_GL))[c2] = expf(gl);
}

DI void gdn_prep(const Params& p, LAS unsigned char* lds, int c2, int c2next, int par) {
    int tid = threadIdx.x; asm volatile("" : "+v"(tid));
    const int lane = tid & 63, wid = __builtin_amdgcn_readfirstlane(tid >> 6), r = lane & 31, h2 = lane >> 5;
    const int b = c2 >> 7, hh = (c2 >> 5) & 3, n = c2 & 31;
    const size_t tok0 = (size_t)b * SEQ + (size_t)n * 64;
    const bf16_t* P1 = (const bf16_t*)(p.ws + OFF_P1);
    LAS float* sm = (LAS float*)(lds + G_SM + par * 1024);
    LAS float* Mf = (LAS float*)(lds + G_M);
    bf16_t* WN = (bf16_t*)(p.ws + OFF_WN) + (size_t)c2 * 8192;
    bf16_t* QD = (bf16_t*)(p.ws + OFF_QD) + (size_t)c2 * 8192;
    bf16_t* KD = (bf16_t*)(p.ws + OFF_KD) + (size_t)c2 * 8192;
    bf16_t* AQ = (bf16_t*)(p.ws + OFF_AQK) + (size_t)c2 * 4096;
    float* U = (float*)(p.ws + OFF_U) + (size_t)c2 * 8192;
    u32x4 raw[6][4];
#pragma unroll
    for (int i = 0; i < 6; ++i) {
        const int item = tid + 512 * i, g = item & 15, t = (item >> 4) & 63, part = i >> 1;
        const int ch = part * 512 + hh * 128 + g * 8;
#pragma unroll
        for (int j = 0; j < 4; ++j) {
            const int tt = n * 64 + t - 3 + j, ttc = tt < 0 ? 0 : tt;
            raw[i][j] = *(const u32x4*)(P1 + ((size_t)b * SEQ + ttc) * NP1 + ch);
            if (tt < 0) raw[i][j] = (u32x4){0u, 0u, 0u, 0u};
        }
    }
    float av[6][8];
#pragma unroll
    for (int i = 0; i < 6; ++i) {
        const int item = tid + 512 * i, g = item & 15, part = i >> 1;
        const int ch = part * 512 + hh * 128 + g * 8;
        float a[8];
#pragma unroll
        for (int e = 0; e < 8; ++e) a[e] = 0.f;
#pragma unroll
        for (int j = 0; j < 4; ++j) {
            const f32x4 w0 = *(const f32x4*)(p.conv_w + j * 1536 + ch), w1 = *(const f32x4*)(p.conv_w + j * 1536 + ch + 4);
            const u32x4 rw = raw[i][j];
            a[0] += w0[0] * bf_lo(rw.x); a[1] += w0[1] * bf_hi(rw.x); a[2] += w0[2] * bf_lo(rw.y); a[3] += w0[3] * bf_hi(rw.y);
            a[4] += w1[0] * bf_lo(rw.z); a[5] += w1[1] * bf_hi(rw.z); a[6] += w1[2] * bf_lo(rw.w); a[7] += w1[3] * bf_hi(rw.w);
        }
        float ss = 0.f;
#pragma unroll
        for (int e = 0; e < 8; ++e) { a[e] = silu_f(a[e]); ss += a[e] * a[e]; }
        float rn = 1.0f;
        if (part < 2) {
            ss += __shfl_xor(ss, 1); ss += __shfl_xor(ss, 2); ss += __shfl_xor(ss, 4); ss += __shfl_xor(ss, 8);
            rn = rsqrtf(ss + 1e-6f) * (part == 0 ? 0.08838834764831845f : 1.0f);
        }
#pragma unroll
        for (int e = 0; e < 8; ++e) av[i][e] = a[e] * rn;
    }
#pragma unroll
    for (int i = 0; i < 6; ++i) {
        const int item = tid + 512 * i, g = item & 15, t = (item >> 4) & 63, part = i >> 1;
        const float* a = av[i];
        const float beta = sm[t], egc = sm[128 + t], ekd = sm[192 + t];
        if (part < 2) {
            u32x4 w; w.x = pk_bf16(a[0], a[1]); w.y = pk_bf16(a[2], a[3]); w.z = pk_bf16(a[4], a[5]); w.w = pk_bf16(a[6], a[7]);
            *(LAS u32x4*)(lds + (part == 0 ? G_QN : G_KN) + t * 272 + g * 16) = w;
            if (part == 0) {
                u32x2 lo, hi; lo.x = pk_bf16(a[0] * egc, a[1] * egc); lo.y = pk_bf16(a[2] * egc, a[3] * egc); hi.x = pk_bf16(a[4] * egc, a[5] * egc); hi.y = pk_bf16(a[6] * egc, a[7] * egc);
                bf16_t* qd = QD + t * 128 + 16 * (g >> 1) + 4 * (g & 1);
                *(u32x2*)qd = lo; *(u32x2*)(qd + 8) = hi;
            } else {
                const float f1 = beta * egc;
                u32x4 w2; w2.x = pk_bf16(a[0] * f1, a[1] * f1); w2.y = pk_bf16(a[2] * f1, a[3] * f1); w2.z = pk_bf16(a[4] * f1, a[5] * f1); w2.w = pk_bf16(a[6] * f1, a[7] * f1);
                *(LAS u32x4*)(lds + G_KBG + t * 272 + g * 16) = w2;
                u32x4 w3; w3.x = pk_bf16(a[0] * ekd, a[1] * ekd); w3.y = pk_bf16(a[2] * ekd, a[3] * ekd); w3.z = pk_bf16(a[4] * ekd, a[5] * ekd); w3.w = pk_bf16(a[6] * ekd, a[7] * ekd);
                *(u32x4*)(KD + t * 128 + g * 8) = w3;
            }
        } else {
            u32x4 w; w.x = pk_bf16(a[0] * beta, a[1] * beta); w.y = pk_bf16(a[2] * beta, a[3] * beta); w.z = pk_bf16(a[4] * beta, a[5] * beta); w.w = pk_bf16(a[6] * beta, a[7] * beta);
            *(LAS u32x4*)(lds + G_VB + t * 272 + g * 16) = w;
        }
    }
    __syncthreads();
    {
        const int w4 = wid & 3, mt = w4 >> 1, nt = w4 & 1; const bool isqk = wid >= 4;
        if (!(mt == 0 && nt == 1)) {
            const LAS unsigned char* Ab = lds + (isqk ? G_QN : G_KN) + (32 * mt + r) * 272 + 16 * h2;
            const LAS unsigned char* Bb = lds + G_KN + (32 * nt + r) * 272 + 16 * h2;
            bf16x8 fa[8], fb[8];
#pragma unroll
            for (int ks = 0; ks < 8; ++ks) { fa[ks] = *(const LAS bf16x8*)(Ab + 32 * ks); fb[ks] = *(const LAS bf16x8*)(Bb + 32 * ks); }
            f32x16 X;
#pragma unroll
            for (int i = 0; i < 16; ++i) X[i] = 0.f;
            if (!isqk) {
#pragma unroll
                for (int ks = 0; ks < 8; ++ks) X = MFMA32(fa[ks], fb[ks], X);
                const int s = 32 * nt + r; const float gcs = sm[64 + s];
#pragma unroll
                for (int i = 0; i < 16; ++i) {
                    const int c = 32 * mt + crow(i, h2);
                    const float dec = __builtin_amdgcn_exp2f(sm[64 + c] - gcs);
                    Mf[c * 64 + s] = (c > s) ? sm[c] * X[i] * dec : 0.f;
                }
            } else {
#pragma unroll
                for (int ks = 0; ks < 8; ++ks) X = MFMA32(fb[ks], fa[ks], X);
                const int c = 32 * mt + r; const float gcc = sm[64 + c];
#pragma unroll
                for (int g4 = 0; g4 < 4; ++g4) {
                    const int s0 = 32 * nt + 8 * g4 + 4 * h2;
                    float v[4];
#pragma unroll
                    for (int e = 0; e < 4; ++e) { const int sx = s0 + e; const float dec = __builtin_amdgcn_exp2f(gcc - sm[64 + sx]); v[e] = (c >= sx) ? X[4 * g4 + e] * dec : 0.f; }
                    u32x2 w; w.x = pk_bf16(v[0], v[1]); w.y = pk_bf16(v[2], v[3]);
                    *(u32x2*)(AQ + c * 64 + perm23(s0)) = w;
                }
            }
        }
    }
    __syncthreads();
    if (wid == 0) {
        LAS bf16_t* Tb = (LAS bf16_t*)(lds + G_T);
        {
            const int c16 = lane & 15, b16 = lane >> 4;
            const LAS float* Mb = Mf + (16 * b16) * 64 + 16 * b16;
            float T[16];
#pragma unroll
            for (int i = 0; i < 16; ++i) T[i] = 0.f;
#pragma unroll
            for (int i = 0; i < 16; ++i) {
                float a0 = (i == c16) ? 1.f : 0.f, a1 = 0.f, a2 = 0.f, a3 = 0.f;
#pragma unroll
                for (int s4 = 0; s4 < (i + 3) / 4; ++s4) {
                    const f32x4 m4 = *(const LAS f32x4*)(Mb + i * 64 + 4 * s4);
                    a0 -= m4[0] * T[4 * s4]; a1 -= m4[1] * T[4 * s4 + 1]; a2 -= m4[2] * T[4 * s4 + 2]; a3 -= m4[3] * T[4 * s4 + 3];
                }
                T[i] = (a0 + a1) + (a2 + a3);
            }
#pragma unroll
            for (int i = 0; i < 16; ++i) {
                const int row = 16 * b16 + i;
                Tb[row * 72 + 16 * b16 + c16] = bf16_1(T[i]);
                if ((b16 & 1) == 0) Tb[row * 72 + 16 * b16 + 16 + c16] = 0;
                if (b16 < 2) { Tb[row * 72 + 32 + c16] = 0; Tb[row * 72 + 48 + c16] = 0; }
            }
        }
        __builtin_amdgcn_wave_barrier();
        asm volatile("s_waitcnt lgkmcnt(0)" ::: "memory");
        {
            const int qd = r >> 4, rr = r & 15;
            bf16x8 mfrag;
            { const LAS float* mp = Mf + (16 + 32 * qd + rr) * 64 + 32 * qd + 8 * h2;
              const f32x4 m0 = *(const LAS f32x4*)mp, m1 = *(const LAS f32x4*)(mp + 4);
              u32x4 aw; aw.x = pk_bf16(m0[0], m0[1]); aw.y = pk_bf16(m0[2], m0[3]); aw.z = pk_bf16(m1[0], m1[1]); aw.w = pk_bf16(m1[2], m1[3]);
              mfrag = __builtin_bit_cast(bf16x8, aw); }
            bf16x8 tfrag;
#pragma unroll
            for (int j = 0; j < 8; ++j) tfrag[j] = (short)Tb[(32 * qd + 8 * h2 + j) * 72 + 32 * qd + rr];
            bf16x8 t2frag;
            { const LAS unsigned char* tp = lds + G_T + (16 + 32 * qd + rr) * 144 + (16 + 32 * qd + 4 * h2) * 2;
              const u32x2 lo = *(const LAS u32x2*)tp, hi = *(const LAS u32x2*)(tp + 16);
              u32x4 aw; aw.x = lo.x; aw.y = lo.y; aw.z = hi.x; aw.w = hi.y; t2frag = __builtin_bit_cast(bf16x8, aw); }
            const bf16x8 zf = {0, 0, 0, 0, 0, 0, 0, 0};
            f32x16 Y1, Z1;
#pragma unroll
            for (int i = 0; i < 16; ++i) { Y1[i] = 0.f; Z1[i] = 0.f; }
#pragma unroll
            for (int ks = 0; ks < 2; ++ks) Y1 = MFMA32(qd == ks ? mfrag : zf, qd == ks ? tfrag : zf, Y1);
#pragma unroll
            for (int s2 = 0; s2 < 2; ++s2) Z1 = MFMA32(qd == s2 ? t2frag : zf, pack8(Y1, s2), Z1);
#pragma unroll
            for (int i = 0; i < 16; ++i) {
                const int row = crow(i, h2);
                if ((row >> 4) == qd) Tb[(16 + 32 * qd + (row & 15)) * 72 + 32 * qd + rr] = bf16_1(-Z1[i]);
            }
        }
        __builtin_amdgcn_wave_barrier();
        asm volatile("s_waitcnt lgkmcnt(0)" ::: "memory");
        const int i16 = lane & 15, q = i16 >> 2, pp = i16 & 3, blk = (lane >> 4) & 1;
        f32x16 Y;
#pragma unroll
        for (int i = 0; i < 16; ++i) Y[i] = 0.f;
#pragma unroll
        for (int ks = 0; ks < 2; ++ks) {
            const LAS float* mp = Mf + (32 + r) * 64 + 16 * ks + 8 * h2;
            const f32x4 m0 = *(const LAS f32x4*)mp, m1 = *(const LAS f32x4*)(mp + 4);
            u32x4 aw; aw.x = pk_bf16(m0[0], m0[1]); aw.y = pk_bf16(m0[2], m0[3]); aw.z = pk_bf16(m1[0], m1[1]); aw.w = pk_bf16(m1[2], m1[3]);
            const bf16x8 bfrag = tr_pair(lds + G_T + (16 * ks + 8 * h2 + q) * 144 + (16 * blk + 4 * pp) * 2, 4 * 144);
            Y = MFMA32(__builtin_bit_cast(bf16x8, aw), bfrag, Y);
        }
        f32x16 Z;
#pragma unroll
        for (int i = 0; i < 16; ++i) Z[i] = 0.f;
#pragma unroll
        for (int s = 0; s < 2; ++s) {
            const LAS unsigned char* tp = lds + G_T + (32 + r) * 144 + (32 + 16 * s + 4 * h2) * 2;
            const u32x2 lo = *(const LAS u32x2*)tp, hi = *(const LAS u32x2*)(tp + 16);
            u32x4 aw; aw.x = lo.x; aw.y = lo.y; aw.z = hi.x; aw.w = hi.y;
            Z = MFMA32(__builtin_bit_cast(bf16x8, aw), pack8(Y, s), Z);
        }
#pragma unroll
        for (int i = 0; i < 16; ++i) Tb[(32 + crow(i, h2)) * 72 + r] = bf16_1(-Z[i]);
    } else if (wid == 1) {
        if (c2next < 2048) gdn_gates(p, (LAS float*)(lds + G_SM + (par ^ 1) * 1024), c2next, lane);
    }
    __syncthreads();
    {
        const int mt = wid >> 2, nt = wid & 3;
        const int i16 = lane & 15, q = i16 >> 2, pp = i16 & 3, blk = (lane >> 4) & 1;
        bf16x8 af[4], vf[4], kf[4];
#pragma unroll
        for (int ks = 0; ks < 4; ++ks) {
            if (ks < 2 * (mt + 1)) {
                af[ks] = *(const LAS bf16x8*)(lds + G_T + (32 * mt + r) * 144 + (16 * ks + 8 * h2) * 2);
                const int boff = (16 * ks + 8 * h2 + q) * 272 + (32 * nt + 16 * blk + 4 * pp) * 2;
                vf[ks] = tr_pair(lds + G_VB + boff, 4 * 272);
                kf[ks] = tr_pair(lds + G_KBG + boff, 4 * 272);
            }
        }
        f32x16 Xu, Xw;
#pragma unroll
        for (int i = 0; i < 16; ++i) { Xu[i] = 0.f; Xw[i] = 0.f; }
#pragma unroll
        for (int ks = 0; ks < 4; ++ks) {
            if (ks < 2 * (mt + 1)) {
                Xu = MFMA32(af[ks], vf[ks], Xu);
                Xw = MFMA32(kf[ks], af[ks], Xw);
            }
        }
        {
            float* up = U + (nt * 2 + mt) * 1024 + lane * 4;
#pragma unroll
            for (int k = 0; k < 4; ++k) { const f32x4 v = {Xu[4 * k], Xu[4 * k + 1], Xu[4 * k + 2], Xu[4 * k + 3]}; *(f32x4*)(up + 256 * k) = v; }
        }
        const int c = 32 * mt + r;
#pragma unroll
        for (int g4 = 0; g4 < 4; ++g4) {
            const int d0 = 32 * nt + 8 * g4 + 4 * h2;
            u32x2 w; w.x = pk_bf16(-Xw[4 * g4], -Xw[4 * g4 + 1]); w.y = pk_bf16(-Xw[4 * g4 + 2], -Xw[4 * g4 + 3]);
            *(u32x2*)(WN + c * 128 + perm23(d0)) = w;
        }
    }
    __syncthreads();
}

constexpr int S_WN = 0, S_QD = 17408, S_KD = 34816, S_AQ = 52224, S_BUF = 61440, S_STG = 2 * S_BUF;

struct GateIn { u32x4 z0, z1; };
DI void scan_gate_load(const Params& p, int tid, int b, int hh, int n, GateIn& g) {
    const int gc_ = tid >> 3, seg = tid & 7;
    const bf16_t* P1 = (const bf16_t*)(p.ws + OFF_P1);
    const size_t row = (size_t)b * SEQ + n * 64 + gc_;
    g.z0 = *(const u32x4*)(P1 + row * NP1 + C_GZ + hh * 128 + seg * 8); g.z1 = *(const u32x4*)(P1 + row * NP1 + C_GZ + hh * 128 + 64 + seg * 8);
}
DI void scan_gate(const Params& p, LAS unsigned char* lds, int tid, int b, int hh, int n, const GateIn& g) {
    const int gc_ = tid >> 3, seg = tid & 7;
    bf16_t* mix = (bf16_t*)(p.ws + OFF_HB);
    const LAS float* st = (const LAS float*)(lds + S_STG) + gc_ * 132 + seg * 8;
    f32x4 ov[4]; float ss = 0.f;
#pragma unroll
    for (int k = 0; k < 4; ++k) { ov[k] = *(const LAS f32x4*)(st + (k >> 1) * 64 + 4 * (k & 1)); ss += ov[k][0] * ov[k][0] + ov[k][1] * ov[k][1] + ov[k][2] * ov[k][2] + ov[k][3] * ov[k][3]; }
    ss += __shfl_xor(ss, 1); ss += __shfl_xor(ss, 2); ss += __shfl_xor(ss, 4);
    const float rstd = rsqrtf(ss * (1.0f / 128.0f) + EPS);
    const size_t row = (size_t)b * SEQ + n * 64 + gc_;
    const u32x4 z0 = g.z0, z1 = g.z1;
    f32x4 gnw[4];
#pragma unroll
    for (int k = 0; k < 4; ++k) gnw[k] = *(const f32x4*)(p.gdn_norm_w + seg * 8 + (k >> 1) * 64 + 4 * (k & 1));
    u32x4 w0, w1;
    w0.x = pk_bf16(ov[0][0] * rstd * gnw[0][0] * silu_f(bf_lo(z0.x)), ov[0][1] * rstd * gnw[0][1] * silu_f(bf_hi(z0.x)));
    w0.y = pk_bf16(ov[0][2] * rstd * gnw[0][2] * silu_f(bf_lo(z0.y)), ov[0][3] * rstd * gnw[0][3] * silu_f(bf_hi(z0.y)));
    w0.z = pk_bf16(ov[1][0] * rstd * gnw[1][0] * silu_f(bf_lo(z0.z)), ov[1][1] * rstd * gnw[1][1] * silu_f(bf_hi(z0.z)));
    w0.w = pk_bf16(ov[1][2] * rstd * gnw[1][2] * silu_f(bf_lo(z0.w)), ov[1][3] * rstd * gnw[1][3] * silu_f(bf_hi(z0.w)));
    w1.x = pk_bf16(ov[2][0] * rstd * gnw[2][0] * silu_f(bf_lo(z1.x)), ov[2][1] * rstd * gnw[2][1] * silu_f(bf_hi(z1.x)));
    w1.y = pk_bf16(ov[2][2] * rstd * gnw[2][2] * silu_f(bf_lo(z1.y)), ov[2][3] * rstd * gnw[2][3] * silu_f(bf_hi(z1.y)));
    w1.z = pk_bf16(ov[3][0] * rstd * gnw[3][0] * silu_f(bf_lo(z1.z)), ov[3][1] * rstd * gnw[3][1] * silu_f(bf_hi(z1.z)));
    w1.w = pk_bf16(ov[3][2] * rstd * gnw[3][2] * silu_f(bf_lo(z1.w)), ov[3][3] * rstd * gnw[3][3] * silu_f(bf_hi(z1.w)));
    bf16_t* mp = mix + row * DM + hh * 128 + seg * 8;
    *(u32x4*)mp = w0; *(u32x4*)(mp + 64) = w1;
}

struct ScanRegs { u32x4 t0[4], t1[4], t2[4], t3[2]; };
DI void scan_fetch(ScanRegs& R, const bf16_t* WN, const bf16_t* QD, const bf16_t* KD, const bf16_t* AQ, int ltid) {
#pragma unroll
    for (int i = 0; i < 4; ++i) { const int pi = ltid + 256 * i; R.t0[i] = *(const u32x4*)(WN + pi * 8); R.t1[i] = *(const u32x4*)(QD + pi * 8); R.t2[i] = *(const u32x4*)(KD + pi * 8); }
#pragma unroll
    for (int i = 0; i < 2; ++i) { const int pi = ltid + 256 * i; R.t3[i] = *(const u32x4*)(AQ + pi * 8); }
}
DI void scan_put(const ScanRegs& R, LAS unsigned char* dst, int ltid) {
#pragma unroll
    for (int i = 0; i < 4; ++i) { const int pi = ltid + 256 * i, row = pi >> 4, pc = pi & 15;
        *(LAS u32x4*)(dst + S_WN + row * 272 + pc * 16) = R.t0[i]; *(LAS u32x4*)(dst + S_QD + row * 272 + pc * 16) = R.t1[i]; *(LAS u32x4*)(dst + S_KD + row * 272 + pc * 16) = R.t2[i]; }
#pragma unroll
    for (int i = 0; i < 2; ++i) { const int pi = ltid + 256 * i, row = pi >> 3, pc = pi & 7; *(LAS u32x4*)(dst + S_AQ + row * 144 + pc * 16) = R.t3[i]; }
}

DI void gdn_scan(const Params& p, LAS unsigned char* lds, int bh) {
    int tid = threadIdx.x; asm volatile("" : "+v"(tid));
    const int lane = tid & 63, wid = __builtin_amdgcn_readfirstlane(tid >> 6), r = lane & 31, h2 = lane >> 5;
    const int b = bh >> 2, hh = bh & 3;
    const bf16_t* WN = (const bf16_t*)(p.ws + OFF_WN) + (size_t)bh * 32 * 8192;
    const bf16_t* QD = (const bf16_t*)(p.ws + OFF_QD) + (size_t)bh * 32 * 8192;
    const bf16_t* KD = (const bf16_t*)(p.ws + OFF_KD) + (size_t)bh * 32 * 8192;
    const bf16_t* AQ = (const bf16_t*)(p.ws + OFF_AQK) + (size_t)bh * 32 * 4096;
    const float* U = (const float*)(p.ws + OFF_U) + (size_t)bh * 32 * 8192;
    const float* GL = (const float*)(p.ws + OFF_GL) + bh * 32;
    if (wid >= 4) {
        const int ltid = tid & 255;
        ScanRegs R;
        scan_fetch(R, WN, QD, KD, AQ, ltid); scan_put(R, lds, ltid);
        scan_fetch(R, WN + 8192, QD + 8192, KD + 8192, AQ + 4096, ltid);
#pragma unroll 1
        for (int n = 0; n < 32; ++n) {
            __syncthreads();
            GateIn gi; scan_gate_load(p, tid, b, hh, n, gi);
            if (n + 1 < 32) scan_put(R, lds + ((n + 1) & 1) * S_BUF, ltid);
            if (n + 2 < 32) scan_fetch(R, WN + (size_t)(n + 2) * 8192, QD + (size_t)(n + 2) * 8192, KD + (size_t)(n + 2) * 8192, AQ + (size_t)(n + 2) * 4096, ltid);
            __syncthreads();
            scan_gate(p, lds, tid, b, hh, n, gi);
        }
    } else {
        const int i16 = lane & 15, q4 = i16 >> 2, pp = i16 & 3, blk = (lane >> 4) & 1;
        f32x16 St[4], u[2];
#pragma unroll
        for (int k = 0; k < 4; ++k)
#pragma unroll
            for (int i = 0; i < 16; ++i) St[k][i] = 0.f;
#pragma unroll
        for (int mt = 0; mt < 2; ++mt)
#pragma unroll
            for (int k = 0; k < 4; ++k) { const f32x4 v = *(const f32x4*)(U + (wid * 2 + mt) * 1024 + 256 * k + lane * 4); u[mt][4 * k] = v[0]; u[mt][4 * k + 1] = v[1]; u[mt][4 * k + 2] = v[2]; u[mt][4 * k + 3] = v[3]; }
#pragma unroll 1
        for (int n = 0; n < 32; ++n) {
            LAS unsigned char* buf = lds + (n & 1) * S_BUF;
            __syncthreads();
            GateIn gi; scan_gate_load(p, tid, b, hh, n, gi);
            const float egl = GL[n];
            f32x16 vn[2], o[2];
            vn[0] = u[0]; vn[1] = u[1];
#pragma unroll
            for (int mt = 0; mt < 2; ++mt)
#pragma unroll
                for (int i = 0; i < 16; ++i) o[mt][i] = 0.f;
#pragma unroll
            for (int ks = 0; ks < 8; ++ks) {
                const bf16x8 sf = pack8(St[ks >> 1], ks & 1);
#pragma unroll
                for (int mt = 0; mt < 2; ++mt) {
                    const bf16x8 wf = *(const LAS bf16x8*)(buf + S_WN + (32 * mt + r) * 272 + (16 * ks + 8 * h2) * 2);
                    vn[mt] = MFMA32(wf, sf, vn[mt]);
                    const bf16x8 qf = *(const LAS bf16x8*)(buf + S_QD + (32 * mt + r) * 272 + (16 * ks + 8 * h2) * 2);
                    o[mt] = MFMA32(qf, sf, o[mt]);
                }
                asm volatile("" ::: "memory");
            }
            bf16x8 vf[4];
#pragma unroll
            for (int k2 = 0; k2 < 4; ++k2) vf[k2] = pack8(vn[k2 >> 1], k2 & 1);
            {
                const int nn = (n + 1 < 32) ? n + 1 : n;
                const float* up = U + (size_t)nn * 8192 + (wid * 2) * 1024 + lane * 4;
#pragma unroll
                for (int mt = 0; mt < 2; ++mt)
#pragma unroll
                    for (int k = 0; k < 4; ++k) { const f32x4 v = *(const f32x4*)(up + mt * 1024 + 256 * k); u[mt][4 * k] = v[0]; u[mt][4 * k + 1] = v[1]; u[mt][4 * k + 2] = v[2]; u[mt][4 * k + 3] = v[3]; }
            }
#pragma unroll
            for (int mt = 0; mt < 2; ++mt)
#pragma unroll
                for (int k2 = 0; k2 < 2 * (mt + 1); ++k2) {
                    const bf16x8 af = *(const LAS bf16x8*)(buf + S_AQ + (32 * mt + r) * 144 + (16 * k2 + 8 * h2) * 2);
                    o[mt] = MFMA32(af, vf[k2], o[mt]);
                }
            {
                LAS float* st = (LAS float*)(lds + S_STG);
#pragma unroll
                for (int mt = 0; mt < 2; ++mt)
#pragma unroll
                    for (int i = 0; i < 16; ++i) st[(32 * mt + crow(i, h2)) * 132 + 32 * wid + r] = o[mt][i];
            }
#pragma unroll
            for (int kt = 0; kt < 4; ++kt) {
#pragma unroll
                for (int i = 0; i < 16; ++i) St[kt][i] *= egl;
#pragma unroll
                for (int k2 = 0; k2 < 4; ++k2) {
                    const bf16x8 kf = tr_pair(buf + S_KD + (16 * k2 + 4 * h2 + q4) * 272 + (32 * kt + 16 * blk + 4 * pp) * 2, 8 * 272);
                    St[kt] = MFMA32(kf, vf[k2], St[kt]);
                }
                asm volatile("" ::: "memory");
            }
            __syncthreads();
            scan_gate(p, lds, tid, b, hh, n, gi);
        }
    }
    __syncthreads();
}

DI void zero_mix_half(const Params& p, int half) {
    bf16_t* mix = (bf16_t*)(p.ws + OFF_HB);
    const size_t n16 = (size_t)MTOK * 64;
    for (size_t i = (size_t)blockIdx.x * 512 + threadIdx.x; i < n16; i += (size_t)gridDim.x * 512) {
        const size_t row = i >> 6, pc = i & 63;
        *(u32x4*)(mix + row * DM + half * 512 + pc * 8) = (u32x4){0u, 0u, 0u, 0u};
    }
}

DI void phase_final(const Params& p) {
    int tid = threadIdx.x; asm volatile("" : "+v"(tid));
    const int lane = tid & 63, wid = tid >> 6;
    const float* rowsq = (const float*)(p.ws + OFF_ROWSQ);
    const bf16_t* yb = (const bf16_t*)(p.ws + OFF_YB);
    const int gw = blockIdx.x * 8 + wid, nw = gridDim.x * 8;
    f32x4 fw[4];
#pragma unroll
    for (int i = 0; i < 2; ++i) { fw[2 * i] = *(const f32x4*)(p.final_norm_w + 512 * i + 8 * lane); fw[2 * i + 1] = *(const f32x4*)(p.final_norm_w + 512 * i + 8 * lane + 4); }
#pragma unroll 1
    for (int row0 = gw; row0 < MTOK; row0 += 4 * nw) {
        u32x4 y[4][2]; float sq[4];
#pragma unroll
        for (int k = 0; k < 4; ++k) {
            const int row = row0 + k * nw, rc = row < MTOK ? row : row0;
#pragma unroll
            for (int i = 0; i < 2; ++i) y[k][i] = *(const u32x4*)(yb + (size_t)rc * DM + 512 * i + 8 * lane);
            sq[k] = lane < 16 ? rowsq[(size_t)rc * 16 + lane] : 0.f;
        }
#pragma unroll
        for (int k = 0; k < 4; ++k) {
            const int row = row0 + k * nw;
            const float ss = wave_sum(sq[k]);
            const float rstd = rsqrtf(ss * (1.0f / DM) + EPS);
            if (row < MTOK) {
                float* o = p.out + (size_t)row * DM;
#pragma unroll
                for (int i = 0; i < 2; ++i) {
                    const f32x4 a = {bf_lo(y[k][i].x), bf_hi(y[k][i].x), bf_lo(y[k][i].y), bf_hi(y[k][i].y)}, c = {bf_lo(y[k][i].z), bf_hi(y[k][i].z), bf_lo(y[k][i].w), bf_hi(y[k][i].w)};
                    *(f32x4*)(o + 512 * i + 8 * lane) = a * rstd * fw[2 * i];
                    *(f32x4*)(o + 512 * i + 8 * lane + 4) = c * rstd * fw[2 * i + 1];
                }
            }
        }
    }
}

__global__ void __launch_bounds__(512) mega(Params p) {
    extern __shared__ __attribute__((aligned(16))) unsigned char shm[];
    LAS unsigned char* lds = (LAS unsigned char*)shm;
    cg::grid_group grid = cg::this_grid();
    volatile LAS unsigned* bst = (volatile LAS unsigned*)(lds + LDS_BYTES - 16);
    if (threadIdx.x < 2) bst[threadIdx.x] = 0u;
    __syncthreads();
    const XcdBarrier xb = xcd_barrier_post((unsigned*)(p.ws + OFF_BAR), bst);
    if (p.ws == nullptr) grid.sync();

#pragma unroll 1
    for (int rep = 0; rep < REP_PREP; ++rep) phase_prep(p, lds);
    xcd_barrier(xb);
#pragma unroll 1
    for (int rep = 0; rep < REP_G1; ++rep)
    {
        pg8::Gemm g{(const bf16_t*)(p.ws + OFF_HB), (const bf16_t*)(p.ws + OFF_WINT), MTOK, NG1, DM};
        pg8::StaticOrder S; S.init(g.M, g.N, (int)gridDim.x, (int)blockIdx.x);
        pg8::EpiP1 E{(bf16_t*)(p.ws + OFF_P1), NP1, (bf16_t*)(p.ws + OFF_KX)};
        pg8::gemm_phase<pg8::EpiP1, false>(lds, g, S, E);
        pg8::Gemm g2{(const bf16_t*)(p.ws + OFF_HB), (const bf16_t*)(p.ws + OFF_WINT) + (size_t)NG1 * DM, MTOK, 512, DM};
        pg8::StaticOrder S2; S2.init(g2.M, g2.N, (int)gridDim.x, (int)blockIdx.x);
        pg8::EpiVT E2{(bf16_t*)(p.ws + OFF_VT)};
        pg8::gemm_phase<pg8::EpiVT, true>(lds, g2, S2, E2);
    }
    xcd_barrier(xb);
#pragma unroll 1
    for (int rep = 0; rep < REP_GP; ++rep)
    {
        if ((threadIdx.x >> 6) == 0 && (int)blockIdx.x < 2048) gdn_gates(p, (LAS float*)(lds + G_SM), blockIdx.x, threadIdx.x & 63);
        __syncthreads();
        int par = 0;
#pragma unroll 1
        for (int c2 = blockIdx.x; c2 < 2048; c2 += gridDim.x, par ^= 1) gdn_prep(p, lds, c2, c2 + (int)gridDim.x, par);
    }
    xcd_barrier(xb);
#pragma unroll 1
    for (int rep = 0; rep < REP_P3; ++rep) {
#pragma unroll 1
        for (int r2 = 0; r2 < REP_SCAN; ++r2)
            if (blockIdx.x < 64) gdn_scan(p, lds, blockIdx.x);
#if SCAN_SYNC
        xcd_barrier(xb);
#endif
        phase_attn(p, lds, rep);
#if REP_ATTN > 1
        xcd_barrier(xb);
        phase_attn(p, lds, 2);
#endif
#if REP_P3 > 1
        xcd_barrier(xb);
#endif
    }
    xcd_barrier(xb);
#pragma unroll 1
    for (int rnd = 0; rnd < 2; ++rnd) {
        pg8::Gemm g{(const bf16_t*)(p.ws + OFF_HB), (const bf16_t*)(p.ws + OFF_WOUTT), MTOK, DM, DM};
        pg8::StaticOrder S; S.init(g.M, g.N, (int)gridDim.x, (int)blockIdx.x); S.i0 = rnd; S.imax = 1;
        pg8::EpiOutFused E{p.x, p.out, (float*)(p.ws + OFF_ROWSQ), p.final_norm_w, xb};
        pg8::Unit u0;
        if (S.next(0, u0)) pg8::gemm_phase<pg8::EpiOutFused, false>(lds, g, S, E);
        else xcd_barrier(xb);
    }
}

extern "C" void kernel_launch(void* const* d_in, const int* in_sizes, int n_in, void* d_out, int out_size, void* d_ws, size_t ws_size, hipStream_t stream) {
    static int grid = 0;
    if (grid == 0) {
        if (ws_size < WS_END) { fprintf(stderr, "kernel_launch: workspace too small (%zu < %zu)\n", ws_size, (size_t)WS_END); grid = -1; return; }
        int dev = 0, cus = 0, per_cu = 0;
        hipGetDevice(&dev);
        hipDeviceGetAttribute(&cus, hipDeviceAttributeMultiprocessorCount, dev);
        if (hipFuncSetAttribute((const void*)mega, hipFuncAttributeMaxDynamicSharedMemorySize, LDS_BYTES) != hipSuccess) { fprintf(stderr, "kernel_launch: hipFuncSetAttribute failed\n"); grid = -1; return; }
        if (hipOccupancyMaxActiveBlocksPerMultiprocessor(&per_cu, (const void*)mega, 512, LDS_BYTES) != hipSuccess || per_cu < 1) per_cu = 1;
        (void)hipGetLastError();
        grid = cus * (per_cu > 1 ? 1 : per_cu);
    }
    if (grid < 0) return;
    Params p{};
    p.x = (const float*)d_in[0]; p.norm_w = (const float*)d_in[1]; p.w_in = (const float*)d_in[2]; p.conv_w = (const float*)d_in[3];
    p.a_log = (const float*)d_in[4]; p.dt_bias = (const float*)d_in[5]; p.gdn_norm_w = (const float*)d_in[6];
    p.lq1 = (const float*)d_in[7]; p.lk1 = (const float*)d_in[8]; p.lq2 = (const float*)d_in[9]; p.lk2 = (const float*)d_in[10];
    p.diff_norm_w = (const float*)d_in[11]; p.w_out = (const float*)d_in[12]; p.final_norm_w = (const float*)d_in[13];
    p.out = (float*)d_out; p.ws = (unsigned char*)d_ws;
    if (hipMemsetAsync((unsigned char*)d_ws + OFF_BAR, 0, 16384, stream) != hipSuccess) { fprintf(stderr, "kernel_launch: hipMemsetAsync failed\n"); return; }
    void* args[] = {&p};
    hipError_t e = hipLaunchCooperativeKernel((const void*)mega, dim3(grid), dim3(512), args, LDS_BYTES, stream);
    if (e != hipSuccess) fprintf(stderr, "cooperative launch failed: %s (grid %d)\n", hipGetErrorString(e), grid);
}
```

```cpp
#include <hip/hip_runtime.h>
#include <hip/hip_cooperative_groups.h>
#include <cstdio>
namespace cg = cooperative_groups;

#ifndef ENABLE_ATTN
#define ENABLE_ATTN 1
#endif
#ifndef ENABLE_GDN
#define ENABLE_GDN 1
#endif
#ifndef REP_PREP
#define REP_PREP 1
#endif
#ifndef REP_G1
#define REP_G1 1
#endif
#ifndef REP_GP
#define REP_GP 1
#endif
#ifndef REP_P3
#define REP_P3 1
#endif
#ifndef REP_G2
#define REP_G2 1
#endif
#ifndef REP_SCAN
#define REP_SCAN 1
#endif
#ifndef SCAN_SYNC
#define SCAN_SYNC 0
#endif
#ifndef REP_ATTN
#define REP_ATTN 1
#endif

#define LAS __attribute__((address_space(3)))
#define DI __device__ __forceinline__
typedef unsigned short bf16_t;
typedef short bf16x8 __attribute__((ext_vector_type(8)));
typedef short s16x4 __attribute__((ext_vector_type(4)));
typedef float f32x2 __attribute__((ext_vector_type(2)));
typedef float f32x4 __attribute__((ext_vector_type(4)));
typedef float f32x16 __attribute__((ext_vector_type(16)));
typedef unsigned u32x2 __attribute__((ext_vector_type(2)));
typedef unsigned u32x4 __attribute__((ext_vector_type(4)));
typedef __bf16 bf16x2_t __attribute__((ext_vector_type(2)));

#define MFMA32(a, b, c) __builtin_amdgcn_mfma_f32_32x32x16_bf16((a), (b), (c), 0, 0, 0)

constexpr int NB = 16, SEQ = 2048, DM = 1024, MTOK = NB * SEQ, NP1 = 3072, NG1 = 3584;
constexpr int C_GQ = 0, C_GK = 512, C_GV = 1024, C_GZ = 1536, C_DQ = 2048, C_DZ = 2560;
constexpr float EPS = 1e-6f;
constexpr float LOG2E = 1.4426950408889634f;

constexpr size_t OFF_HB = 0;
constexpr size_t OFF_WINT = OFF_HB + (size_t)MTOK * DM * 2;
constexpr size_t OFF_WOUTT = OFF_WINT + (size_t)4096 * 1024 * 2;
constexpr size_t OFF_GBGA = OFF_WOUTT + (size_t)1024 * 1024 * 2;
constexpr size_t OFF_P1 = OFF_GBGA + (size_t)MTOK * 8 * 4;
constexpr size_t OFF_KX = OFF_P1 + (size_t)MTOK * NP1 * 2;
constexpr size_t OFF_VT = OFF_KX + (size_t)64 * 2 * 2048 * 64 * 2;
constexpr size_t OFF_WN = OFF_VT + (size_t)64 * 128 * 2048 * 2;
constexpr size_t OFF_QD = OFF_WN + (size_t)2048 * 64 * 128 * 2;
constexpr size_t OFF_KD = OFF_QD + (size_t)2048 * 64 * 128 * 2;
constexpr size_t OFF_AQK = OFF_KD + (size_t)2048 * 64 * 128 * 2;
constexpr size_t OFF_U = OFF_AQK + (size_t)2048 * 64 * 64 * 2;
constexpr size_t OFF_GL = OFF_U + (size_t)2048 * 64 * 128 * 4;
constexpr size_t OFF_ROWSQ = OFF_GL + 8192;
constexpr size_t OFF_MISC = OFF_ROWSQ + (size_t)MTOK * 16 * 4;
constexpr size_t OFF_YB = OFF_P1;
constexpr size_t OFF_BAR = OFF_MISC + 256;
constexpr size_t WS_END = OFF_BAR + 16384;

constexpr int LDS_BYTES = 156 * 1024;

struct Params {
    const float *x, *norm_w, *w_in, *conv_w, *a_log, *dt_bias, *gdn_norm_w, *lq1, *lk1, *lq2, *lk2, *diff_norm_w, *w_out, *final_norm_w;
    float* out; unsigned char* ws;
};

DI unsigned pk_bf16(float a, float b) { f32x2 v = {a, b}; bf16x2_t r = __builtin_convertvector(v, bf16x2_t); return __builtin_bit_cast(unsigned, r); }
DI float bf_lo(unsigned u) { return __uint_as_float(u << 16); }
DI float bf_hi(unsigned u) { return __uint_as_float(u & 0xffff0000u); }
DI float wave_sum(float v) {
#pragma unroll
    for (int o = 32; o; o >>= 1) v += __shfl_xor(v, o);
    return v;
}
DI float xhalf_max(float v) {
    const u32x2 r = __builtin_amdgcn_permlane32_swap(__float_as_uint(v), __float_as_uint(v), false, false);
    return fmaxf(__uint_as_float(r.x), __uint_as_float(r.y));
}
DI float xhalf_sum(float v) {
    const u32x2 r = __builtin_amdgcn_permlane32_swap(__float_as_uint(v), __float_as_uint(v), false, false);
    return __uint_as_float(r.x) + __uint_as_float(r.y);
}
DI float silu_f(float z) { return z * __builtin_amdgcn_rcpf(1.0f + __builtin_amdgcn_exp2f(-LOG2E * z)); }
DI int perm23(int t) { return (t & ~12) | ((t & 4) << 1) | ((t & 8) >> 1); }
DI int crow(int i, int h2) { return (i & 3) + 8 * (i >> 2) + 4 * h2; }
DI bf16x8 pack8(const f32x16& x, int s) {
    u32x4 w; w.x = pk_bf16(x[8 * s + 0], x[8 * s + 1]); w.y = pk_bf16(x[8 * s + 2], x[8 * s + 3]); w.z = pk_bf16(x[8 * s + 4], x[8 * s + 5]); w.w = pk_bf16(x[8 * s + 6], x[8 * s + 7]);
    return __builtin_bit_cast(bf16x8, w);
}


#define XB_TMO      128
#define XB_XCNT(j)  (256  + 64 * (j))
#define XB_XSUB(j)  (1280 + 64 * (j))
#define XB_XGEN(j)  (2304 + 64 * (j))
#define XB_TOP      3328
#define XB_TOPGEN   3392
#define XCD_BAR_WORDS 3456
#define XB_SPIN_CAP (1u << 18)
struct XcdBarrier { unsigned* bar; unsigned x; volatile LAS unsigned* st; };
DI unsigned xb_ld(unsigned* p)              { return __hip_atomic_load(p, __ATOMIC_RELAXED, __HIP_MEMORY_SCOPE_AGENT); }
DI unsigned xb_add(unsigned* p, unsigned v) { return __hip_atomic_fetch_add(p, v, __ATOMIC_RELAXED, __HIP_MEMORY_SCOPE_AGENT); }
DI unsigned xb_xcc_id() { return (unsigned)__builtin_amdgcn_s_getreg((3 << 11) | 20) & 0xFu; }
#define XB_SPIN(cond, bar) do { unsigned _sp = 0; while (cond) { __builtin_amdgcn_s_sleep(1); \
    if ((++_sp & 255u) == 0u) { if (xb_ld(&(bar)[XB_TMO])) break; if (_sp > XB_SPIN_CAP) { atomicAdd(&(bar)[XB_TMO], 1u); break; } } } } while (0)
DI XcdBarrier xcd_barrier_post(unsigned* bar, volatile LAS unsigned* st) {
    XcdBarrier b; b.bar = bar; b.x = xb_xcc_id(); b.st = st;
    if (threadIdx.x == 0) (void)xb_add(&bar[XB_XCNT(b.x)], 1u);
    return b;
}
DI void xcd_barrier_complete(unsigned* bar, unsigned x, unsigned& nloc, unsigned& nx) {
    const unsigned G = gridDim.x * gridDim.y * gridDim.z;
    unsigned sum, cnt, mine, sp = 0u;
    for (;;) {
        sum = 0u; cnt = 0u; mine = 0u;
#pragma unroll
        for (unsigned j = 0; j < 16; ++j) { const unsigned c = xb_ld(&bar[XB_XCNT(j)]); sum += c; cnt += (c > 0u) ? 1u : 0u; mine = (j == x) ? c : mine; }
        if (sum == G) break;
        __builtin_amdgcn_s_sleep(1);
        if ((++sp & 255u) == 0u) { if (xb_ld(&bar[XB_TMO])) break; if (sp > XB_SPIN_CAP) { atomicAdd(&bar[XB_TMO], 1u); break; } }
    }
    nloc = mine > 0u ? mine : 1u; nx = cnt > 0u ? cnt : 1u;
}
DI void xcd_barrier(const XcdBarrier& b) {
    asm volatile("s_waitcnt vmcnt(0)" ::: "memory");
    __syncthreads();
    if (threadIdx.x == 0) {
        unsigned* bar = b.bar;
        __builtin_amdgcn_s_waitcnt(0);
        unsigned nloc = b.st[0], nx = b.st[1];
        if (nloc == 0u) { xcd_barrier_complete(bar, b.x, nloc, nx); b.st[0] = nloc; b.st[1] = nx; }
        const unsigned old = xb_add(&bar[XB_XSUB(b.x)], 1u);
        const unsigned gen = old / nloc;
        if (old + 1u == (gen + 1u) * nloc) {
            __builtin_amdgcn_fence(__ATOMIC_RELEASE, "agent");
            asm volatile("s_waitcnt vmcnt(0)" ::: "memory");
            const unsigned og = xb_add(&bar[XB_TOP], 1u);
            const unsigned tg = og / nx;
            if (og + 1u == (tg + 1u) * nx) xb_add(&bar[XB_TOPGEN], 1u);
            else XB_SPIN(xb_ld(&bar[XB_TOPGEN]) == tg, bar);
            __builtin_amdgcn_fence(__ATOMIC_ACQUIRE, "agent");
            xb_add(&bar[XB_XGEN(b.x)], 1u);
            asm volatile("s_waitcnt vmcnt(0)" ::: "memory");
        } else {
            XB_SPIN(xb_ld(&bar[XB_XGEN(b.x)]) == gen, bar);
            __builtin_amdgcn_fence(__ATOMIC_ACQUIRE, "agent");
            asm volatile("s_waitcnt vmcnt(0)" ::: "memory");
        }
    }
    __syncthreads();
}

namespace pg8 {
constexpr int BM = 256, BK = 64, HALF = 128, HTB = HALF * BK * 2, STAGE_BYTES = 8 * HTB, NXCD = 8, WGM = 8;
DI int lds_byte(int r, int c) { const int st = (r >> 4) * 2 + (c >> 5), rr = r & 15, cc = c & 31, ob = rr * 64 + cc * 2; return st * 1024 + (ob ^ (((ob >> 9) & 1) << 5)); }
DI void stage_rc(int b, int& R, int& C) { const int st = b / 1024, sb = b % 1024, swz = sb ^ (((sb >> 9) & 1) << 5); R = (st >> 1) * 16 + swz / 64; C = (st & 1) * 32 + (swz % 64) / 2; }
DI int perm32(int rho) { const int n = rho >> 4, i = rho & 15; return 8 * (i >> 2) + 4 * n + (i & 3); }
struct Unit { int pm, pn; };
struct Gemm { const bf16_t* A; const bf16_t* Bt; int M, N, K; };
struct StaticOrder {
    int nM, nN, nwg, G, c, i0 = 0, imax = 1 << 30;
    DI void init(int M, int N, int G_, int c_) { nM = M / BM; nN = N / BM; nwg = nM * nN; G = G_; c = c_; }
    DI bool next(int i, Unit& u) const {
        if (i >= imax) return false;
        const long L = (long)(i + i0) * G + c; if (L >= nwg) return false;
        int wgid = (int)L; { const int q = nwg / NXCD, r = nwg % NXCD, xcd = wgid % NXCD, off = wgid / NXCD; wgid = (xcd < r ? xcd * (q + 1) : r * (q + 1) + (xcd - r) * q) + off; }
        const int nig = WGM * nN, gid = wgid / nig, fm = gid * WGM, gsz = (nM - fm) < WGM ? (nM - fm) : WGM;
        u.pm = fm + ((wgid % nig) % gsz); u.pn = (wgid % nig) / gsz; return true;
    }
    DI void a_ready(const Unit&) const {}
    DI void done(const Unit&) const {}
};

struct EpiP1 {
    static constexpr bool PERM = true, PERM16 = true, AFTER_DRAIN = false;
    bf16_t* O; int ldc; bf16_t* KX;
    DI void operator()(const f32x4 (&acc)[2][2][4][2], const Unit& u, int wr, int wc, int fr, int fq) const {
        const int row0 = u.pm * BM + wr * 64 + fr, col0 = u.pn * BM + wc * 64 + 8 * fq;
        if (u.pn >= 12) {
            const int c = col0 - 12 * BM, hm = c >> 6, d = c & 63;
#pragma unroll
            for (int ai = 0; ai < 2; ++ai)
#pragma unroll
                for (int m = 0; m < 4; ++m) { const int row = row0 + ai * HALF + m * 16, b = row >> 11, tok = row & 2047;
                    bf16_t* dp = KX + ((size_t)(b * 8 + hm) * 2048 + tok) * 64 + d;
#pragma unroll
                    for (int bj = 0; bj < 2; ++bj) { const f32x4 v0 = acc[ai][bj][m][0], v1 = acc[ai][bj][m][1];
                        u32x4 w; w.x = pk_bf16(v0[0], v0[1]); w.y = pk_bf16(v0[2], v0[3]); w.z = pk_bf16(v1[0], v1[1]); w.w = pk_bf16(v1[2], v1[3]);
                        *(u32x4*)(dp + 32 * bj) = w; } }
            return;
        }
#pragma unroll
        for (int ai = 0; ai < 2; ++ai)
#pragma unroll
            for (int m = 0; m < 4; ++m) { bf16_t* rowp = O + (size_t)(row0 + ai * HALF + m * 16) * ldc + col0;
#pragma unroll
                for (int bj = 0; bj < 2; ++bj) { const f32x4 v0 = acc[ai][bj][m][0], v1 = acc[ai][bj][m][1];
                    u32x4 w; w.x = pk_bf16(v0[0], v0[1]); w.y = pk_bf16(v0[2], v0[3]); w.z = pk_bf16(v1[0], v1[1]); w.w = pk_bf16(v1[2], v1[3]);
                    *(u32x4*)(rowp + 32 * bj) = w; } }
    }
};
struct EpiVT {
    static constexpr bool PERM = false, PERM16 = false, AFTER_DRAIN = false;
    bf16_t* VT;
    DI void operator()(const f32x4 (&acc)[2][2][4][2], const Unit& u, int wr, int wc, int fr, int fq) const {
#pragma unroll
        for (int ai = 0; ai < 2; ++ai)
#pragma unroll
            for (int m = 0; m < 4; ++m) {
                const int t = u.pm * BM + ai * HALF + wr * 64 + m * 16 + 4 * fq, b = t >> 11, tok = t & 2047, pos = perm23(tok);
#pragma unroll
                for (int bj = 0; bj < 2; ++bj)
#pragma unroll
                    for (int n = 0; n < 2; ++n) {
                        const int c = u.pn * BM + bj * HALF + wc * 32 + n * 16 + fr, hh = c >> 7, dv = c & 127;
                        const f32x4 v = acc[ai][bj][m][n];
                        u32x2 w; w.x = pk_bf16(v[0], v[1]); w.y = pk_bf16(v[2], v[3]);
                        *(u32x2*)(VT + (((size_t)((b * 4 + hh) * 32 + (pos >> 6)) * 128 + dv)) * 64 + (pos & 63)) = w;
                    }
            }
    }
};
static_assert(WGM == 8, "EpiOutFused needs the four column tiles of a row panel in the same round");
struct EpiOutFused {
    static constexpr bool PERM = false, PERM16 = false, AFTER_DRAIN = true;
    const float* X; float* Out; float* rowsq; const float* fw; XcdBarrier xb;
    DI void operator()(const f32x4 (&)[2][2][4][2], const Unit&, int, int, int, int) const {}
    DI void fused(f32x4 (&acc)[2][2][4][2], const Unit& u, int wr, int wc, int fr, int fq) const {
        const int row0 = u.pm * BM + wr * 64 + fr, col0 = u.pn * BM + wc * 32 + 4 * fq;
#pragma unroll
        for (int ai = 0; ai < 2; ++ai)
#pragma unroll
            for (int m = 0; m < 4; ++m) {
                const int row = row0 + ai * HALF + m * 16; float ss = 0.f;
#pragma unroll
                for (int bj = 0; bj < 2; ++bj)
#pragma unroll
                    for (int n = 0; n < 2; ++n) {
                        const size_t o = (size_t)row * DM + col0 + bj * HALF + n * 16;
                        const f32x4 y = acc[ai][bj][m][n] + *(const f32x4*)(X + o);
                        acc[ai][bj][m][n] = y; ss += y[0] * y[0] + y[1] * y[1] + y[2] * y[2] + y[3] * y[3];
                    }
                ss += __shfl_xor(ss, 16); ss += __shfl_xor(ss, 32);
                if (fq == 0) rowsq[(size_t)row * 16 + u.pn * 4 + wc] = ss;
            }
        xcd_barrier(xb);
        f32x4 fwv[2][2];
#pragma unroll
        for (int bj = 0; bj < 2; ++bj)
#pragma unroll
            for (int n = 0; n < 2; ++n) fwv[bj][n] = *(const f32x4*)(fw + col0 + bj * HALF + n * 16);
#pragma unroll
        for (int ai = 0; ai < 2; ++ai)
#pragma unroll
            for (int m = 0; m < 4; ++m) {
                const int row = row0 + ai * HALF + m * 16;
                const f32x4* rq = (const f32x4*)(rowsq + (size_t)row * 16);
                const f32x4 q0 = rq[0], q1 = rq[1], q2 = rq[2], q3 = rq[3];
                const float tot = ((q0[0] + q0[1]) + (q0[2] + q0[3])) + ((q1[0] + q1[1]) + (q1[2] + q1[3])) + ((q2[0] + q2[1]) + (q2[2] + q2[3])) + ((q3[0] + q3[1]) + (q3[2] + q3[3]));
                const float rstd = rsqrtf(tot * (1.0f / DM) + EPS);
#pragma unroll
                for (int bj = 0; bj < 2; ++bj)
#pragma unroll
                    for (int n = 0; n < 2; ++n) {
                        const size_t o = (size_t)row * DM + col0 + bj * HALF + n * 16;
                        *(f32x4*)(Out + o) = acc[ai][bj][m][n] * rstd * fwv[bj][n];
                    }
            }
    }
};

template <class Epi, bool SWAP>
DI void gemm_phase(LAS unsigned char* lds, const Gemm g, const StaticOrder& S, const Epi& E) {
    int tid = threadIdx.x; asm volatile("" : "+v"(tid));
    const int wid = __builtin_amdgcn_readfirstlane(tid >> 6), lane = tid & 63, wr = wid >> 2, wc = wid & 3, fr = lane & 15, fq = lane >> 4;
    const int K = g.K, nt = K / BK;
    unsigned voffA[2], voffB[2], voffB1[2];
#pragma unroll
    for (int i = 0; i < 2; ++i) { int R, C; stage_rc(tid * 16 + i * 8192, R, C); const int Rb = Epi::PERM ? ((R & ~31) + perm32(R & 31)) : R;
        voffA[i] = (unsigned)(R * K + C) * 2u;
        if constexpr (Epi::PERM16) {
            const int c0 = 64 * (R >> 5) + 8 * ((R >> 2) & 3) + 4 * ((R >> 4) & 1) + (R & 3);
            voffB[i] = (unsigned)(c0 * K + C) * 2u; voffB1[i] = (unsigned)((c0 + 32) * K + C) * 2u;
        } else { voffB[i] = (unsigned)(Rb * K + C) * 2u; voffB1[i] = voffB[i]; } }
    const size_t kstep = (size_t)(BK * 2);
    const size_t hstep = (size_t)HALF * K * 2;
    const size_t tstep = 2 * hstep;
    const size_t hoff = Epi::PERM16 ? 0 : hstep;
    const unsigned ldsw = (unsigned)wid * 1024u;
    const int aoff = lds_byte(wr * 64 + fr, fq * 8), boff = lds_byte(wc * 32 + fr, fq * 8);
#define PG8_SA(b, h) (((b) * 2 + (h)) * HTB)
#define PG8_SB(b, h) ((4 + (b) * 2 + (h)) * HTB)
#define PG8_STAGE(bufoff, gbase, voff) do { _Pragma("unroll") for (int _i = 0; _i < 2; ++_i) \
        __builtin_amdgcn_global_load_lds((const unsigned*)((const char*)(gbase) + (voff)[_i]), (LAS unsigned*)(lds + (bufoff) + ldsw + _i * 8192), 16, 0, 0); } while (0)
#define PG8_LDA(dst, b, h) do { _Pragma("unroll") for (int m = 0; m < 4; ++m) _Pragma("unroll") for (int k = 0; k < 2; ++k) dst[m][k] = *(const LAS bf16x8*)(lds + PG8_SA(b, h) + aoff + m * 2048 + k * 1024); } while (0)
#define PG8_LDB(dst, b, h) do { _Pragma("unroll") for (int n = 0; n < 2; ++n) _Pragma("unroll") for (int k = 0; k < 2; ++k) dst[n][k] = *(const LAS bf16x8*)(lds + PG8_SB(b, h) + boff + n * 2048 + k * 1024); } while (0)
#define PG8_MMA(ai, bj, At, Bt) do { __builtin_amdgcn_s_setprio(1); _Pragma("unroll") for (int m = 0; m < 4; ++m) _Pragma("unroll") for (int n = 0; n < 2; ++n) _Pragma("unroll") for (int k = 0; k < 2; ++k) \
        acc[ai][bj][m][n] = SWAP ? __builtin_amdgcn_mfma_f32_16x16x32_bf16(At[m][k], Bt[n][k], acc[ai][bj][m][n], 0, 0, 0) \
                                 : __builtin_amdgcn_mfma_f32_16x16x32_bf16(Bt[n][k], At[m][k], acc[ai][bj][m][n], 0, 0, 0); __builtin_amdgcn_s_setprio(0); } while (0)
#define PG8_WAIT_V(n) asm volatile("s_waitcnt vmcnt(" #n ")" ::: "memory")
#define PG8_WAIT_L(n) asm volatile("s_waitcnt lgkmcnt(" #n ")" ::: "memory")
#define PG8_BAR __builtin_amdgcn_s_barrier()
#define PG8_SCHED __builtin_amdgcn_sched_barrier(0)
    Unit cur, nxt; int ui = 0;
    if (!S.next(0, cur)) return;
    f32x4 acc[2][2][4][2];
#pragma unroll
    for (int a = 0; a < 2; ++a)
#pragma unroll
        for (int b = 0; b < 2; ++b)
#pragma unroll
            for (int m = 0; m < 4; ++m)
#pragma unroll
                for (int n = 0; n < 2; ++n) acc[a][b][m][n] = (f32x4){0.f, 0.f, 0.f, 0.f};
    bf16x8 At[4][2], B0[2][2], B1[2][2];
    const char* cA = (const char*)g.A + (size_t)cur.pm * tstep; const char* cB = (const char*)g.Bt + (size_t)cur.pn * tstep;
    PG8_STAGE(PG8_SB(0, 0), cB, voffB); PG8_STAGE(PG8_SA(0, 0), cA, voffA); PG8_STAGE(PG8_SB(0, 1), cB + hoff, voffB1); PG8_STAGE(PG8_SA(0, 1), cA + hstep, voffA);
    if (wr == 1) PG8_BAR;
    PG8_WAIT_V(4); PG8_BAR;
    PG8_STAGE(PG8_SB(1, 0), cB + kstep, voffB); PG8_STAGE(PG8_SA(1, 0), cA + kstep, voffA); PG8_STAGE(PG8_SB(1, 1), cB + hoff + kstep, voffB1);
    PG8_WAIT_V(6); PG8_BAR;
    for (;;) {
        const bool has_next = S.next(ui + 1, nxt);
        const char* nA = has_next ? (const char*)g.A + (size_t)nxt.pm * tstep : cA; const char* nB = has_next ? (const char*)g.Bt + (size_t)nxt.pn * tstep : cB;
        for (int t = 0; t < nt; t += 2) {
            const bool last = (t == nt - 2);
            const char* a1 = cA + (size_t)(t + 1) * kstep;
            const char* a2 = last ? nA : cA + (size_t)(t + 2) * kstep; const char* b2 = last ? nB : cB + (size_t)(t + 2) * kstep;
            const char* a3 = a2 + kstep; const char* b3 = b2 + kstep;
            PG8_LDB(B0, 0, 0); PG8_SCHED; PG8_LDA(At, 0, 0); PG8_STAGE(PG8_SA(1, 1), a1 + hstep, voffA);
            PG8_WAIT_L(8); PG8_BAR; PG8_WAIT_L(0); PG8_MMA(0, 0, At, B0); PG8_BAR; PG8_SCHED;
            PG8_LDB(B1, 0, 1); PG8_STAGE(PG8_SB(0, 0), b2, voffB);
            PG8_BAR; PG8_WAIT_L(0); PG8_MMA(0, 1, At, B1); PG8_BAR;
            PG8_LDA(At, 0, 1); PG8_STAGE(PG8_SA(0, 0), a2, voffA);
            PG8_BAR; PG8_WAIT_L(0); PG8_MMA(1, 0, At, B0); PG8_BAR; PG8_SCHED;
            PG8_STAGE(PG8_SB(0, 1), b2 + hoff, voffB1);
            PG8_WAIT_V(6); PG8_BAR; PG8_MMA(1, 1, At, B1); PG8_BAR;
            PG8_LDB(B0, 1, 0); PG8_SCHED; PG8_LDA(At, 1, 0); PG8_STAGE(PG8_SA(0, 1), a2 + hstep, voffA);
            PG8_WAIT_L(8); PG8_BAR; PG8_WAIT_L(0); PG8_MMA(0, 0, At, B0); PG8_BAR; PG8_SCHED;
            PG8_LDB(B1, 1, 1); PG8_STAGE(PG8_SB(1, 0), b3, voffB);
            PG8_BAR; PG8_WAIT_L(0); PG8_MMA(0, 1, At, B1); PG8_BAR;
            PG8_LDA(At, 1, 1); PG8_STAGE(PG8_SA(1, 0), a3, voffA);
            PG8_BAR; PG8_WAIT_L(0); PG8_MMA(1, 0, At, B0); PG8_BAR; PG8_SCHED;
            PG8_STAGE(PG8_SB(1, 1), b3 + hoff, voffB1);
            PG8_WAIT_V(6); PG8_BAR; PG8_MMA(1, 1, At, B1); PG8_BAR;
        }
        if constexpr (!Epi::AFTER_DRAIN) E(acc, cur, wr, wc, fr, fq);
        if (!has_next) break;
#pragma unroll
        for (int a = 0; a < 2; ++a)
#pragma unroll
            for (int b = 0; b < 2; ++b)
#pragma unroll
                for (int m = 0; m < 4; ++m)
#pragma unroll
                    for (int n = 0; n < 2; ++n) acc[a][b][m][n] = (f32x4){0.f, 0.f, 0.f, 0.f};
        cur = nxt; cA = nA; cB = nB; ++ui;
    }
    PG8_WAIT_V(0);
    if (wr == 0) PG8_BAR;
    PG8_BAR;
    if constexpr (Epi::AFTER_DRAIN) E.fused(acc, cur, wr, wc, fr, fq);
#undef PG8_SA
#undef PG8_SB
#undef PG8_STAGE
#undef PG8_LDA
#undef PG8_LDB
#undef PG8_MMA
#undef PG8_WAIT_V
#undef PG8_WAIT_L
#undef PG8_BAR
#undef PG8_SCHED
}
}

DI int win_src_col(int n0) {
    if (n0 < 2048) return n0;
    if (n0 < 2560) return 2056 + (n0 - 2048);
    if (n0 < 3072) return 3592 + (n0 - 2560);
    if (n0 < 3584) return 2568 + (n0 - 3072);
    return 3080 + (n0 - 3584);
}
DI void phase_prep(const Params& p, LAS unsigned char* lds) {
    int tid = threadIdx.x; asm volatile("" : "+v"(tid));
    const int lane = tid & 63, wid = tid >> 6;
    if (blockIdx.x == 0 && wid == 0) {
        float a = p.lq1[lane] * p.lk1[lane], b = p.lq2[lane] * p.lk2[lane];
        a = wave_sum(a); b = wave_sum(b);
        if (lane == 0) { *(float*)(p.ws + OFF_MISC) = expf(a) - expf(b) + 0.2f; *(unsigned*)(p.ws + OFF_MISC + 4) = 0u; *(unsigned*)(p.ws + OFF_MISC + 8) = 0u; *(unsigned*)(p.ws + OFF_MISC + 12) = 0u; }
    }
    bf16_t* hb = (bf16_t*)(p.ws + OFF_HB);
    float* gbga = (float*)(p.ws + OFF_GBGA);
    const int gw = blockIdx.x * 8 + wid, nw = gridDim.x * 8;
    {
        f32x4 nwv[4]; float wq[16][8];
#pragma unroll
        for (int i = 0; i < 4; ++i) {
            nwv[i] = ((const f32x4*)p.norm_w)[lane + 64 * i];
#pragma unroll
            for (int e = 0; e < 4; ++e) {
                const int k = 4 * (lane + 64 * i) + e;
                const f32x4* wp = (const f32x4*)(p.w_in + (size_t)k * 4104 + 2048);
                const f32x4 w0 = wp[0], w1 = wp[1];
#pragma unroll
                for (int j = 0; j < 4; ++j) { wq[4 * i + e][j] = nwv[i][e] * w0[j]; wq[4 * i + e][4 + j] = nwv[i][e] * w1[j]; }
            }
        }
        const bool b5 = (lane & 32) != 0, b4 = (lane & 16) != 0, b3 = (lane & 8) != 0;
        const int col = (b5 ? 4 : 0) + (b4 ? 2 : 0) + (b3 ? 1 : 0);
        int row = gw;
        f32x4 v[4];
        if (row < MTOK) {
#pragma unroll
            for (int i = 0; i < 4; ++i) v[i] = __builtin_nontemporal_load((const f32x4*)(p.x + (size_t)row * DM) + lane + 64 * i);
        }
#pragma unroll 1
        for (; row < MTOK; row += nw) {
            f32x4 vnx[4];
            const int rnx = (row + nw < MTOK) ? row + nw : row;
#pragma unroll
            for (int i = 0; i < 4; ++i) vnx[i] = __builtin_nontemporal_load((const f32x4*)(p.x + (size_t)rnx * DM) + lane + 64 * i);
            float ss = 0.f, a8[8];
#pragma unroll
            for (int j = 0; j < 8; ++j) a8[j] = 0.f;
#pragma unroll
            for (int i = 0; i < 4; ++i)
#pragma unroll
                for (int e = 0; e < 4; ++e) {
                    ss += v[i][e] * v[i][e];
#pragma unroll
                    for (int j = 0; j < 8; ++j) a8[j] += v[i][e] * wq[4 * i + e][j];
                }
            ss = wave_sum(ss);
            const float rstd = rsqrtf(ss * (1.0f / DM) + EPS);
#pragma unroll
            for (int i = 0; i < 4; ++i) {
                const f32x4 h = v[i] * rstd * nwv[i];
                u32x2 w; w.x = pk_bf16(h[0], h[1]); w.y = pk_bf16(h[2], h[3]);
                *(u32x2*)(hb + (size_t)row * DM + 4 * (lane + 64 * i)) = w;
            }
            float c4[4], c2[2], c1;
#pragma unroll
            for (int j = 0; j < 4; ++j) { const float send = b5 ? a8[j] : a8[4 + j], keep = b5 ? a8[4 + j] : a8[j]; c4[j] = keep + __shfl_xor(send, 32); }
#pragma unroll
            for (int j = 0; j < 2; ++j) { const float send = b4 ? c4[j] : c4[2 + j], keep = b4 ? c4[2 + j] : c4[j]; c2[j] = keep + __shfl_xor(send, 16); }
            { const float send = b3 ? c2[0] : c2[1], keep = b3 ? c2[1] : c2[0]; c1 = keep + __shfl_xor(send, 8); }
            c1 += __shfl_xor(c1, 4); c1 += __shfl_xor(c1, 2); c1 += __shfl_xor(c1, 1);
            if ((lane & 7) == 0) gbga[(size_t)row * 8 + col] = c1 * rstd;
#pragma unroll
            for (int i = 0; i < 4; ++i) v[i] = vnx[i];
        }
    }
    LAS float* tl = (LAS float*)lds;
    for (int tile = blockIdx.x; tile < 1024 + 256; tile += gridDim.x) {
        const float* src; int ld, n0, k0, srcn0; bf16_t* dst;
        if (tile < 1024) { n0 = (tile >> 4) * 64; k0 = (tile & 15) * 64; srcn0 = win_src_col(n0); src = p.w_in; ld = 4104; dst = (bf16_t*)(p.ws + OFF_WINT); }
        else { const int t2 = tile - 1024; n0 = (t2 >> 4) * 64; k0 = (t2 & 15) * 64; srcn0 = n0; src = p.w_out; ld = 1024; dst = (bf16_t*)(p.ws + OFF_WOUTT); }
        const int kk = tid >> 4, n4 = tid & 15;
#pragma unroll
        for (int ps = 0; ps < 2; ++ps) { const int k = kk + 32 * ps;
            const f32x4 v = __builtin_nontemporal_load((const f32x4*)(src + (size_t)(k0 + k) * ld + srcn0 + 4 * n4));
#pragma unroll
            for (int e = 0; e < 4; ++e) tl[k * 65 + 4 * n4 + e] = v[e]; }
        __syncthreads();
        { const int n = tid >> 3, k8 = tid & 7; float f[8];
#pragma unroll
            for (int e = 0; e < 8; ++e) f[e] = tl[(8 * k8 + e) * 65 + n];
            u32x4 w; w.x = pk_bf16(f[0], f[1]); w.y = pk_bf16(f[2], f[3]); w.z = pk_bf16(f[4], f[5]); w.w = pk_bf16(f[6], f[7]);
            *(u32x4*)(dst + (size_t)(n0 + n) * 1024 + k0 + 8 * k8) = w; }
        __syncthreads();
    }
}

constexpr int AT_KB = 8192, AT_VB = 16384, AT_BUF = AT_KB + AT_VB, AT_NBUF = 3, AT_TASK = AT_NBUF * AT_BUF, AT_O1 = AT_TASK + 256;

DI void attn_qblock(const Params& p, LAS unsigned char* lds, int b, int hh, int qb, float lam) {
    int tid = threadIdx.x; asm volatile("" : "+v"(tid));
    const int lane = tid & 63, wid = __builtin_amdgcn_readfirstlane(tid >> 6);
    const bf16_t* P1 = (const bf16_t*)(p.ws + OFF_P1);
    const bf16_t* VT = (const bf16_t*)(p.ws + OFF_VT) + (size_t)(b * 4 + hh) * 32 * 128 * 64;
    const bf16_t* KX = (const bf16_t*)(p.ws + OFF_KX) + (size_t)(b * 4 + hh) * 2 * 2048 * 64;
    bf16_t* mix = (bf16_t*)(p.ws + OFF_HB);
    const int q0 = qb * 256 + wid * 32;
    const size_t tokbase = (size_t)b * SEQ;
    const int nkt = (qb + 1) * 4;
    const float sl2 = exp2f(-2.0f * (float)(hh + 1)) * LOG2E;
    const float c1 = 0.125f * LOG2E;
#pragma unroll 1
    for (int map = 0; map < 2; ++map) {
        f32x16 O[4];
#pragma unroll
        for (int mt = 0; mt < 4; ++mt)
#pragma unroll
            for (int i = 0; i < 16; ++i) O[mt][i] = 0.f;
        float m = -INFINITY, l = 0.f;
        int lane_m = lane; asm volatile("" : "+v"(lane_m));
        const int r = lane_m & 31, h2 = lane_m >> 5;
        int foff[4];
#pragma unroll
        for (int k = 0; k < 4; ++k) foff[k] = r * 128 + (((2 * k + h2) ^ ((r >> 1) & 7)) << 4);
        float kb[16];
#pragma unroll
        for (int i = 0; i < 16; ++i) kb[i] = sl2 * (float)crow(i, h2);
        const int krow_ = 8 * wid + (lane_m >> 3), vrow0 = 16 * wid + (lane_m >> 3), vrow1 = vrow0 + 8;
        const bf16_t* kgp = KX + ((size_t)map * 2048 + krow_) * 64 + (((lane_m & 7) ^ ((krow_ >> 1) & 7)) * 8);
        const bf16_t* vgp0 = VT + (size_t)vrow0 * 64 + (((lane_m & 7) ^ ((vrow0 >> 1) & 7)) * 8);
        const bf16_t* vgp1 = VT + (size_t)vrow1 * 64 + (((lane_m & 7) ^ ((vrow1 >> 1) & 7)) * 8);
#define AT_STAGE(bufi, tile) do { LAS unsigned char* _b = lds + (bufi) * AT_BUF; \
            __builtin_amdgcn_global_load_lds((const unsigned*)(kgp + (size_t)(tile) * 64 * 64), (LAS unsigned*)(_b + wid * 1024), 16, 0, 0); \
            __builtin_amdgcn_global_load_lds((const unsigned*)(vgp0 + (size_t)(tile) * 128 * 64), (LAS unsigned*)(_b + AT_KB + wid * 2048), 16, 0, 0); \
            __builtin_amdgcn_global_load_lds((const unsigned*)(vgp1 + (size_t)(tile) * 128 * 64), (LAS unsigned*)(_b + AT_KB + wid * 2048 + 1024), 16, 0, 0); } while (0)
        bf16x8 qf[4];
        { const bf16_t* qp = P1 + (tokbase + q0 + (lane_m & 31)) * NP1 + C_DQ + hh * 128 + map * 64 + 8 * (lane_m >> 5);
#pragma unroll
            for (int ks = 0; ks < 4; ++ks) qf[ks] = *(const bf16x8*)(qp + 16 * ks); }
        AT_STAGE(0, 0);
        AT_STAGE(1, 1);
        asm volatile("" : "+v"(qf[0]), "+v"(qf[1]), "+v"(qf[2]), "+v"(qf[3]));
        int cb = 0;
#pragma unroll 1
        for (int kt = 0; kt < nkt; ++kt) {
            asm volatile("s_waitcnt vmcnt(0)" ::: "memory");
            __builtin_amdgcn_s_barrier();
            asm volatile("" ::: "memory");
            if (kt + 2 < nkt) { const int nb = cb == 0 ? 2 : cb - 1; AT_STAGE(nb, kt + 2); }
            const LAS unsigned char* cur = lds + cb * AT_BUF;
            cb = cb == 2 ? 0 : cb + 1;
            const int k0 = kt * 64;
            if (k0 <= q0) {
                const bool sub1 = (k0 + 32 <= q0);
                const LAS unsigned char* vb = cur + AT_KB;
                bf16x8 kf[8];
#pragma unroll
                for (int ks = 0; ks < 4; ++ks) kf[ks] = *(const LAS bf16x8*)(cur + foff[ks]);
                if (sub1) {
#pragma unroll
                    for (int ks = 0; ks < 4; ++ks) kf[4 + ks] = *(const LAS bf16x8*)(cur + 4096 + foff[ks]);
                }
                f32x16 s0, s1;
#pragma unroll
                for (int i = 0; i < 16; ++i) { s0[i] = 0.f; s1[i] = 0.f; }
#pragma unroll
                for (int ks = 0; ks < 4; ++ks) s0 = MFMA32(kf[ks], qf[ks], s0);
                if (sub1) {
#pragma unroll
                    for (int ks = 0; ks < 4; ++ks) s1 = MFMA32(kf[4 + ks], qf[ks], s1);
                }
                __builtin_amdgcn_sched_barrier(0);
                bf16x8 va[8];
#pragma unroll
                for (int s2 = 0; s2 < 2; ++s2)
#pragma unroll
                    for (int mt = 0; mt < 4; ++mt) va[s2 * 4 + mt] = *(const LAS bf16x8*)(vb + mt * 4096 + foff[s2]);
                __builtin_amdgcn_sched_barrier(0);
                const float off0 = sl2 * (float)(k0 - q0), off1 = off0 + 32.0f * sl2;
                const f32x2 c1v = {c1, c1};
#pragma unroll
                for (int j = 0; j < 8; ++j) {
                    const f32x2 kv = {kb[2 * j], kb[2 * j + 1]};
                    f32x2 a = {s0[2 * j], s0[2 * j + 1]}, c = {s1[2 * j], s1[2 * j + 1]};
                    a = __builtin_elementwise_fma(a, c1v, kv); c = __builtin_elementwise_fma(c, c1v, kv);
                    s0[2 * j] = a.x; s0[2 * j + 1] = a.y; s1[2 * j] = c.x; s1[2 * j + 1] = c.y;
                }
                if (k0 == q0) {
#pragma unroll
                    for (int i = 0; i < 16; ++i) if (crow(i, h2) > r) s0[i] = -INFINITY;
                }
                if (k0 + 32 == q0) {
#pragma unroll
                    for (int i = 0; i < 16; ++i) if (crow(i, h2) > r) s1[i] = -INFINITY;
                }
                float mx0 = fmaxf(s0[0], s0[1]), mx1 = fmaxf(s1[0], s1[1]);
#pragma unroll
                for (int j = 1; j < 8; ++j) { mx0 = fmaxf(fmaxf(s0[2 * j], s0[2 * j + 1]), mx0); mx1 = fmaxf(fmaxf(s1[2 * j], s1[2 * j + 1]), mx1); }
                float mx = sub1 ? fmaxf(mx0 + off0, mx1 + off1) : mx0 + off0;
                mx = xhalf_max(mx);
                if (__builtin_amdgcn_ballot_w64(mx > m + 8.0f) != 0ull) {
                    const float mn = fmaxf(m, mx);
                    const float alpha = __builtin_amdgcn_exp2f(m - mn);
                    m = mn; l *= alpha;
#pragma unroll
                    for (int mt = 0; mt < 4; ++mt)
#pragma unroll
                        for (int i = 0; i < 16; ++i) O[mt][i] *= alpha;
                }
                const float r0 = m - off0, r1 = sub1 ? m - off1 : INFINITY;
                const f32x2 r0v = {r0, r0}, r1v = {r1, r1};
                f32x2 lsv = {0.f, 0.f};
#pragma unroll
                for (int j = 0; j < 8; ++j) {
                    f32x2 a = {s0[2 * j], s0[2 * j + 1]}, c = {s1[2 * j], s1[2 * j + 1]};
                    a = a - r0v; c = c - r1v;
                    a.x = __builtin_amdgcn_exp2f(a.x); a.y = __builtin_amdgcn_exp2f(a.y); c.x = __builtin_amdgcn_exp2f(c.x); c.y = __builtin_amdgcn_exp2f(c.y);
                    lsv = lsv + a; lsv = lsv + c;
                    s0[2 * j] = a.x; s0[2 * j + 1] = a.y; s1[2 * j] = c.x; s1[2 * j + 1] = c.y;
                }
                l += lsv.x + lsv.y;
                bf16x8 pf[4];
#pragma unroll
                for (int s = 0; s < 2; ++s) { pf[s] = pack8(s0, s); pf[2 + s] = pack8(s1, s); }
                __builtin_amdgcn_sched_barrier(0);
                bf16x8 vc[4], vd[4];
                if (sub1) {
#pragma unroll
                    for (int mt = 0; mt < 4; ++mt) vc[mt] = *(const LAS bf16x8*)(vb + mt * 4096 + foff[2]);
                }
#pragma unroll
                for (int mt = 0; mt < 4; ++mt) O[mt] = MFMA32(va[mt], pf[0], O[mt]);
                if (sub1) {
#pragma unroll
                    for (int mt = 0; mt < 4; ++mt) vd[mt] = *(const LAS bf16x8*)(vb + mt * 4096 + foff[3]);
                }
#pragma unroll
                for (int mt = 0; mt < 4; ++mt) O[mt] = MFMA32(va[4 + mt], pf[1], O[mt]);
                if (sub1) {
#pragma unroll
                    for (int mt = 0; mt < 4; ++mt) O[mt] = MFMA32(vc[mt], pf[2], O[mt]);
#pragma unroll
                    for (int mt = 0; mt < 4; ++mt) O[mt] = MFMA32(vd[mt], pf[3], O[mt]);
                }
            }
        }
        asm volatile("" ::: "memory");
        __builtin_amdgcn_s_barrier();
        asm volatile("" ::: "memory");
#undef AT_STAGE
        const float lt = xhalf_sum(l);
        int lane_o = lane; asm volatile("" : "+v"(lane_o));
        LAS unsigned* o1l = (LAS unsigned*)(lds + AT_O1 + wid * 8192) + lane_o;
        if (map == 0) {
            const float inv1 = 1.0f / lt;
#pragma unroll
            for (int mt = 0; mt < 4; ++mt)
#pragma unroll
                for (int j = 0; j < 8; ++j) o1l[(mt * 8 + j) * 64] = pk_bf16(O[mt][2 * j] * inv1, O[mt][2 * j + 1] * inv1);
        } else {
            const float inv2 = lam / lt;
            float ss = 0.f;
#pragma unroll
            for (int mt = 0; mt < 4; ++mt)
#pragma unroll
                for (int j = 0; j < 8; ++j) {
                    const unsigned o1 = o1l[(mt * 8 + j) * 64];
                    const float a = bf_lo(o1) - O[mt][2 * j] * inv2, c = bf_hi(o1) - O[mt][2 * j + 1] * inv2;
                    O[mt][2 * j] = a; O[mt][2 * j + 1] = c; ss += a * a + c * c;
                }
            ss = xhalf_sum(ss);
            const float rs = rsqrtf(ss * (1.0f / 128.0f) + EPS) * 0.8f;
#pragma unroll
            for (int mt = 0; mt < 4; ++mt)
#pragma unroll
                for (int j = 0; j < 8; ++j) o1l[(mt * 8 + j) * 64] = pk_bf16(O[mt][2 * j] * rs, O[mt][2 * j + 1] * rs);
            __builtin_amdgcn_wave_barrier();
            int lane_e = lane; asm volatile("" : "+v"(lane_e));
            const int dvg = lane_e & 15, qs = lane_e >> 4;
            const f32x4 nw0 = *(const f32x4*)(p.diff_norm_w + 8 * dvg), nw1 = *(const f32x4*)(p.diff_norm_w + 8 * dvg + 4);
            const LAS unsigned* ob = (const LAS unsigned*)(lds + AT_O1 + wid * 8192);
            const int slot = (dvg >> 2) * 8 + 2 * (dvg & 3);
            u32x4 dzv[8];
#pragma unroll
            for (int it = 0; it < 8; ++it) dzv[it] = *(const u32x4*)(P1 + (tokbase + q0 + it * 4 + qs) * NP1 + C_DZ + hh * 128 + 8 * dvg);
#pragma unroll
            for (int it = 0; it < 8; ++it) {
                const int q = it * 4 + qs; const size_t row = tokbase + q0 + q;
                const unsigned u0 = ob[slot * 64 + q], u1 = ob[(slot + 1) * 64 + q], u2 = ob[slot * 64 + q + 32], u3 = ob[(slot + 1) * 64 + q + 32];
                const u32x4 dz = dzv[it];
                u32x4 w;
                w.x = pk_bf16(bf_lo(u0) * nw0[0] * silu_f(bf_lo(dz.x)), bf_hi(u0) * nw0[1] * silu_f(bf_hi(dz.x)));
                w.y = pk_bf16(bf_lo(u1) * nw0[2] * silu_f(bf_lo(dz.y)), bf_hi(u1) * nw0[3] * silu_f(bf_hi(dz.y)));
                w.z = pk_bf16(bf_lo(u2) * nw1[0] * silu_f(bf_lo(dz.z)), bf_hi(u2) * nw1[1] * silu_f(bf_hi(dz.z)));
                w.w = pk_bf16(bf_lo(u3) * nw1[2] * silu_f(bf_lo(dz.w)), bf_hi(u3) * nw1[3] * silu_f(bf_hi(dz.w)));
                *(u32x4*)(mix + row * DM + 512 + hh * 128 + 8 * dvg) = w;
            }
            __builtin_amdgcn_wave_barrier();
        }
    }
}

DI void phase_attn(const Params& p, LAS unsigned char* lds, int rep) {
    const float lam = *(const float*)(p.ws + OFF_MISC);
    unsigned* counter = (unsigned*)(p.ws + OFF_MISC + 4 + 4 * rep);
    LAS int* tslot = (LAS int*)(lds + AT_TASK);
    for (;;) {
        if (threadIdx.x == 0) *tslot = (int)atomicAdd(counter, 1u);
        __syncthreads();
        const int t = *tslot;
        __syncthreads();
        if (t >= 512) break;
        const int qb = 7 - (t >> 6), bh = t & 63;
        attn_qblock(p, lds, bh >> 2, bh & 3, qb, lam);
    }
}


constexpr int G_QN = 0, G_KN = 17408, G_VB = 34816, G_KBG = 52224, G_M = 69632, G_T = 86016, G_SM = 95232;
DI bf16x8 tr_pair(const LAS unsigned char* lo_addr, int hi_off) {
    const s16x4 lo = __builtin_amdgcn_ds_read_tr16_b64_v4i16((LAS s16x4*)(lo_addr));
    const s16x4 hi = __builtin_amdgcn_ds_read_tr16_b64_v4i16((LAS s16x4*)(lo_addr + hi_off));
    return __builtin_shufflevector(lo, hi, 0, 1, 2, 3, 4, 5, 6, 7);
}
DI bf16_t bf16_1(float v) { return (bf16_t)(pk_bf16(v, 0.f) & 0xffffu); }

DI void gdn_gates(const Params& p, LAS float* sm, int c2, int lane) {
    const int b = c2 >> 7, hh = (c2 >> 5) & 3, n = c2 & 31;
    const size_t tok0 = (size_t)b * SEQ + (size_t)n * 64;
    const float* gg = (const float*)(p.ws + OFF_GBGA) + (tok0 + lane) * 8;
    const float gbv = gg[hh], gav = gg[4 + hh];
    const float beta = 1.0f / (1.0f + expf(-gbv));
    const float xs = gav + p.dt_bias[hh];
    const float sp = fmaxf(xs, 0.f) + log1pf(expf(-fabsf(xs)));
    float gc = -expf(p.a_log[hh]) * sp;
#pragma unroll
    for (int o = 1; o < 64; o <<= 1) { const float t = __shfl_up(gc, o); if (lane >= o) gc += t; }
    const float gl = __shfl(gc, 63);
    sm[lane] = beta; sm[64 + lane] = gc * LOG2E; sm[128 + lane] = expf(gc); sm[192 + lane] = expf(gl - gc);
    if (lane == 63) ((float*)(p.ws + OFF_GL))[c2] = expf(gl);
}

DI void gdn_prep(const Params& p, LAS unsigned char* lds, int c2, int c2next, int par) {
    int tid = threadIdx.x; asm volatile("" : "+v"(tid));
    const int lane = tid & 63, wid = __builtin_amdgcn_readfirstlane(tid >> 6), r = lane & 31, h2 = lane >> 5;
    const int b = c2 >> 7, hh = (c2 >> 5) & 3, n = c2 & 31;
    const size_t tok0 = (size_t)b * SEQ + (size_t)n * 64;
    const bf16_t* P1 = (const bf16_t*)(p.ws + OFF_P1);
    LAS float* sm = (LAS float*)(lds + G_SM + par * 1024);
    LAS float* Mf = (LAS float*)(lds + G_M);
    bf16_t* WN = (bf16_t*)(p.ws + OFF_WN) + (size_t)c2 * 8192;
    bf16_t* QD = (bf16_t*)(p.ws + OFF_QD) + (size_t)c2 * 8192;
    bf16_t* KD = (bf16_t*)(p.ws + OFF_KD) + (size_t)c2 * 8192;
    bf16_t* AQ = (bf16_t*)(p.ws + OFF_AQK) + (size_t)c2 * 4096;
    float* U = (float*)(p.ws + OFF_U) + (size_t)c2 * 8192;
    u32x4 raw[6][4];
#pragma unroll
    for (int i = 0; i < 6; ++i) {
        const int item = tid + 512 * i, g = item & 15, t = (item >> 4) & 63, part = i >> 1;
        const int ch = part * 512 + hh * 128 + g * 8;
#pragma unroll
        for (int j = 0; j < 4; ++j) {
            const int tt = n * 64 + t - 3 + j, ttc = tt < 0 ? 0 : tt;
            raw[i][j] = *(const u32x4*)(P1 + ((size_t)b * SEQ + ttc) * NP1 + ch);
            if (tt < 0) raw[i][j] = (u32x4){0u, 0u, 0u, 0u};
        }
    }
    float av[6][8];
#pragma unroll
    for (int i = 0; i < 6; ++i) {
        const int item = tid + 512 * i, g = item & 15, part = i >> 1;
        const int ch = part * 512 + hh * 128 + g * 8;
        float a[8];
#pragma unroll
        for (int e = 0; e < 8; ++e) a[e] = 0.f;
#pragma unroll
        for (int j = 0; j < 4; ++j) {
            const f32x4 w0 = *(const f32x4*)(p.conv_w + j * 1536 + ch), w1 = *(const f32x4*)(p.conv_w + j * 1536 + ch + 4);
            const u32x4 rw = raw[i][j];
            a[0] += w0[0] * bf_lo(rw.x); a[1] += w0[1] * bf_hi(rw.x); a[2] += w0[2] * bf_lo(rw.y); a[3] += w0[3] * bf_hi(rw.y);
            a[4] += w1[0] * bf_lo(rw.z); a[5] += w1[1] * bf_hi(rw.z); a[6] += w1[2] * bf_lo(rw.w); a[7] += w1[3] * bf_hi(rw.w);
        }
        float ss = 0.f;
#pragma unroll
        for (int e = 0; e < 8; ++e) { a[e] = silu_f(a[e]); ss += a[e] * a[e]; }
        float rn = 1.0f;
        if (part < 2) {
            ss += __shfl_xor(ss, 1); ss += __shfl_xor(ss, 2); ss += __shfl_xor(ss, 4); ss += __shfl_xor(ss, 8);
            rn = rsqrtf(ss + 1e-6f) * (part == 0 ? 0.08838834764831845f : 1.0f);
        }
#pragma unroll
        for (int e = 0; e < 8; ++e) av[i][e] = a[e] * rn;
    }
#pragma unroll
    for (int i = 0; i < 6; ++i) {
        const int item = tid + 512 * i, g = item & 15, t = (item >> 4) & 63, part = i >> 1;
        const float* a = av[i];
        const float beta = sm[t], egc = sm[128 + t], ekd = sm[192 + t];
        if (part < 2) {
            u32x4 w; w.x = pk_bf16(a[0], a[1]); w.y = pk_bf16(a[2], a[3]); w.z = pk_bf16(a[4], a[5]); w.w = pk_bf16(a[6], a[7]);
            *(LAS u32x4*)(lds + (part == 0 ? G_QN : G_KN) + t * 272 + g * 16) = w;
            if (part == 0) {
                u32x2 lo, hi; lo.x = pk_bf16(a[0] * egc, a[1] * egc); lo.y = pk_bf16(a[2] * egc, a[3] * egc); hi.x = pk_bf16(a[4] * egc, a[5] * egc); hi.y = pk_bf16(a[6] * egc, a[7] * egc);
                bf16_t* qd = QD + t * 128 + 16 * (g >> 1) + 4 * (g & 1);
                *(u32x2*)qd = lo; *(u32x2*)(qd + 8) = hi;
            } else {
                const float f1 = beta * egc;
                u32x4 w2; w2.x = pk_bf16(a[0] * f1, a[1] * f1); w2.y = pk_bf16(a[2] * f1, a[3] * f1); w2.z = pk_bf16(a[4] * f1, a[5] * f1); w2.w = pk_bf16(a[6] * f1, a[7] * f1);
                *(LAS u32x4*)(lds + G_KBG + t * 272 + g * 16) = w2;
                u32x4 w3; w3.x = pk_bf16(a[0] * ekd, a[1] * ekd); w3.y = pk_bf16(a[2] * ekd, a[3] * ekd); w3.z = pk_bf16(a[4] * ekd, a[5] * ekd); w3.w = pk_bf16(a[6] * ekd, a[7] * ekd);
                *(u32x4*)(KD + t * 128 + g * 8) = w3;
            }
        } else {
            u32x4 w; w.x = pk_bf16(a[0] * beta, a[1] * beta); w.y = pk_bf16(a[2] * beta, a[3] * beta); w.z = pk_bf16(a[4] * beta, a[5] * beta); w.w = pk_bf16(a[6] * beta, a[7] * beta);
            *(LAS u32x4*)(lds + G_VB + t * 272 + g * 16) = w;
        }
    }
    __syncthreads();
    {
        const int w4 = wid & 3, mt = w4 >> 1, nt = w4 & 1; const bool isqk = wid >= 4;
        if (!(mt == 0 && nt == 1)) {
            const LAS unsigned char* Ab = lds + (isqk ? G_QN : G_KN) + (32 * mt + r) * 272 + 16 * h2;
            const LAS unsigned char* Bb = lds + G_KN + (32 * nt + r) * 272 + 16 * h2;
            bf16x8 fa[8], fb[8];
#pragma unroll
            for (int ks = 0; ks < 8; ++ks) { fa[ks] = *(const LAS bf16x8*)(Ab + 32 * ks); fb[ks] = *(const LAS bf16x8*)(Bb + 32 * ks); }
            f32x16 X;
#pragma unroll
            for (int i = 0; i < 16; ++i) X[i] = 0.f;
            if (!isqk) {
#pragma unroll
                for (int ks = 0; ks < 8; ++ks) X = MFMA32(fa[ks], fb[ks], X);
                const int s = 32 * nt + r; const float gcs = sm[64 + s];
#pragma unroll
                for (int i = 0; i < 16; ++i) {
                    const int c = 32 * mt + crow(i, h2);
                    const float dec = __builtin_amdgcn_exp2f(sm[64 + c] - gcs);
                    Mf[c * 64 + s] = (c > s) ? sm[c] * X[i] * dec : 0.f;
                }
            } else {
#pragma unroll
                for (int ks = 0; ks < 8; ++ks) X = MFMA32(fb[ks], fa[ks], X);
                const int c = 32 * mt + r; const float gcc = sm[64 + c];
#pragma unroll
                for (int g4 = 0; g4 < 4; ++g4) {
                    const int s0 = 32 * nt + 8 * g4 + 4 * h2;
                    float v[4];
#pragma unroll
                    for (int e = 0; e < 4; ++e) { const int sx = s0 + e; const float dec = __builtin_amdgcn_exp2f(gcc - sm[64 + sx]); v[e] = (c >= sx) ? X[4 * g4 + e] * dec : 0.f; }
                    u32x2 w; w.x = pk_bf16(v[0], v[1]); w.y = pk_bf16(v[2], v[3]);
                    *(u32x2*)(AQ + c * 64 + perm23(s0)) = w;
                }
            }
        }
    }
    __syncthreads();
    if (wid == 0) {
        LAS bf16_t* Tb = (LAS bf16_t*)(lds + G_T);
        {
            const int c16 = lane & 15, b16 = lane >> 4;
            const LAS float* Mb = Mf + (16 * b16) * 64 + 16 * b16;
            float T[16];
#pragma unroll
            for (int i = 0; i < 16; ++i) T[i] = 0.f;
#pragma unroll
            for (int i = 0; i < 16; ++i) {
                float a0 = (i == c16) ? 1.f : 0.f, a1 = 0.f, a2 = 0.f, a3 = 0.f;
#pragma unroll
                for (int s4 = 0; s4 < (i + 3) / 4; ++s4) {
                    const f32x4 m4 = *(const LAS f32x4*)(Mb + i * 64 + 4 * s4);
                    a0 -= m4[0] * T[4 * s4]; a1 -= m4[1] * T[4 * s4 + 1]; a2 -= m4[2] * T[4 * s4 + 2]; a3 -= m4[3] * T[4 * s4 + 3];
                }
                T[i] = (a0 + a1) + (a2 + a3);
            }
#pragma unroll
            for (int i = 0; i < 16; ++i) {
                const int row = 16 * b16 + i;
                Tb[row * 72 + 16 * b16 + c16] = bf16_1(T[i]);
                if ((b16 & 1) == 0) Tb[row * 72 + 16 * b16 + 16 + c16] = 0;
                if (b16 < 2) { Tb[row * 72 + 32 + c16] = 0; Tb[row * 72 + 48 + c16] = 0; }
            }
        }
        __builtin_amdgcn_wave_barrier();
        asm volatile("s_waitcnt lgkmcnt(0)" ::: "memory");
        {
            const int qd = r >> 4, rr = r & 15;
            bf16x8 mfrag;
            { const LAS float* mp = Mf + (16 + 32 * qd + rr) * 64 + 32 * qd + 8 * h2;
              const f32x4 m0 = *(const LAS f32x4*)mp, m1 = *(const LAS f32x4*)(mp + 4);
              u32x4 aw; aw.x = pk_bf16(m0[0], m0[1]); aw.y = pk_bf16(m0[2], m0[3]); aw.z = pk_bf16(m1[0], m1[1]); aw.w = pk_bf16(m1[2], m1[3]);
              mfrag = __builtin_bit_cast(bf16x8, aw); }
            bf16x8 tfrag;
#pragma unroll
            for (int j = 0; j < 8; ++j) tfrag[j] = (short)Tb[(32 * qd + 8 * h2 + j) * 72 + 32 * qd + rr];
            bf16x8 t2frag;
            { const LAS unsigned char* tp = lds + G_T + (16 + 32 * qd + rr) * 144 + (16 + 32 * qd + 4 * h2) * 2;
              const u32x2 lo = *(const LAS u32x2*)tp, hi = *(const LAS u32x2*)(tp + 16);
              u32x4 aw; aw.x = lo.x; aw.y = lo.y; aw.z = hi.x; aw.w = hi.y; t2frag = __builtin_bit_cast(bf16x8, aw); }
            const bf16x8 zf = {0, 0, 0, 0, 0, 0, 0, 0};
            f32x16 Y1, Z1;
#pragma unroll
            for (int i = 0; i < 16; ++i) { Y1[i] = 0.f; Z1[i] = 0.f; }
#pragma unroll
            for (int ks = 0; ks < 2; ++ks) Y1 = MFMA32(qd == ks ? mfrag : zf, qd == ks ? tfrag : zf, Y1);
#pragma unroll
            for (int s2 = 0; s2 < 2; ++s2) Z1 = MFMA32(qd == s2 ? t2frag : zf, pack8(Y1, s2), Z1);
#pragma unroll
            for (int i = 0; i < 16; ++i) {
                const int row = crow(i, h2);
                if ((row >> 4) == qd) Tb[(16 + 32 * qd + (row & 15)) * 72 + 32 * qd + rr] = bf16_1(-Z1[i]);
            }
        }
        __builtin_amdgcn_wave_barrier();
        asm volatile("s_waitcnt lgkmcnt(0)" ::: "memory");
        const int i16 = lane & 15, q = i16 >> 2, pp = i16 & 3, blk = (lane >> 4) & 1;
        f32x16 Y;
#pragma unroll
        for (int i = 0; i < 16; ++i) Y[i] = 0.f;
#pragma unroll
        for (int ks = 0; ks < 2; ++ks) {
            const LAS float* mp = Mf + (32 + r) * 64 + 16 * ks + 8 * h2;
            const f32x4 m0 = *(const LAS f32x4*)mp, m1 = *(const LAS f32x4*)(mp + 4);
            u32x4 aw; aw.x = pk_bf16(m0[0], m0[1]); aw.y = pk_bf16(m0[2], m0[3]); aw.z = pk_bf16(m1[0], m1[1]); aw.w = pk_bf16(m1[2], m1[3]);
            const bf16x8 bfrag = tr_pair(lds + G_T + (16 * ks + 8 * h2 + q) * 144 + (16 * blk + 4 * pp) * 2, 4 * 144);
            Y = MFMA32(__builtin_bit_cast(bf16x8, aw), bfrag, Y);
        }
        f32x16 Z;
#pragma unroll
        for (int i = 0; i < 16; ++i) Z[i] = 0.f;
#pragma unroll
        for (int s = 0; s < 2; ++s) {
            const LAS unsigned char* tp = lds + G_T + (32 + r) * 144 + (32 + 16 * s + 4 * h2) * 2;
            const u32x2 lo = *(const LAS u32x2*)tp, hi = *(const LAS u32x2*)(tp + 16);
            u32x4 aw; aw.x = lo.x; aw.y = lo.y; aw.z = hi.x; aw.w = hi.y;
            Z = MFMA32(__builtin_bit_cast(bf16x8, aw), pack8(Y, s), Z);
        }
#pragma unroll
        for (int i = 0; i < 16; ++i) Tb[(32 + crow(i, h2)) * 72 + r] = bf16_1(-Z[i]);
    } else if (wid == 1) {
        if (c2next < 2048) gdn_gates(p, (LAS float*)(lds + G_SM + (par ^ 1) * 1024), c2next, lane);
    }
    __syncthreads();
    {
        const int mt = wid >> 2, nt = wid & 3;
        const int i16 = lane & 15, q = i16 >> 2, pp = i16 & 3, blk = (lane >> 4) & 1;
        bf16x8 af[4], vf[4], kf[4];
#pragma unroll
        for (int ks = 0; ks < 4; ++ks) {
            if (ks < 2 * (mt + 1)) {
                af[ks] = *(const LAS bf16x8*)(lds + G_T + (32 * mt + r) * 144 + (16 * ks + 8 * h2) * 2);
                const int boff = (16 * ks + 8 * h2 + q) * 272 + (32 * nt + 16 * blk + 4 * pp) * 2;
                vf[ks] = tr_pair(lds + G_VB + boff, 4 * 272);
                kf[ks] = tr_pair(lds + G_KBG + boff, 4 * 272);
            }
        }
        f32x16 Xu, Xw;
#pragma unroll
        for (int i = 0; i < 16; ++i) { Xu[i] = 0.f; Xw[i] = 0.f; }
#pragma unroll
        for (int ks = 0; ks < 4; ++ks) {
            if (ks < 2 * (mt + 1)) {
                Xu = MFMA32(af[ks], vf[ks], Xu);
                Xw = MFMA32(kf[ks], af[ks], Xw);
            }
        }
        {
            float* up = U + (nt * 2 + mt) * 1024 + lane * 4;
#pragma unroll
            for (int k = 0; k < 4; ++k) { const f32x4 v = {Xu[4 * k], Xu[4 * k + 1], Xu[4 * k + 2], Xu[4 * k + 3]}; *(f32x4*)(up + 256 * k) = v; }
        }
        const int c = 32 * mt + r;
#pragma unroll
        for (int g4 = 0; g4 < 4; ++g4) {
            const int d0 = 32 * nt + 8 * g4 + 4 * h2;
            u32x2 w; w.x = pk_bf16(-Xw[4 * g4], -Xw[4 * g4 + 1]); w.y = pk_bf16(-Xw[4 * g4 + 2], -Xw[4 * g4 + 3]);
            *(u32x2*)(WN + c * 128 + perm23(d0)) = w;
        }
    }
    __syncthreads();
}

constexpr int S_WN = 0, S_QD = 17408, S_KD = 34816, S_AQ = 52224, S_BUF = 61440, S_STG = 2 * S_BUF;

struct GateIn { u32x4 z0, z1; };
DI void scan_gate_load(const Params& p, int tid, int b, int hh, int n, GateIn& g) {
    const int gc_ = tid >> 3, seg = tid & 7;
    const bf16_t* P1 = (const bf16_t*)(p.ws + OFF_P1);
    const size_t row = (size_t)b * SEQ + n * 64 + gc_;
    g.z0 = *(const u32x4*)(P1 + row * NP1 + C_GZ + hh * 128 + seg * 8); g.z1 = *(const u32x4*)(P1 + row * NP1 + C_GZ + hh * 128 + 64 + seg * 8);
}
DI void scan_gate(const Params& p, LAS unsigned char* lds, int tid, int b, int hh, int n, const GateIn& g) {
    const int gc_ = tid >> 3, seg = tid & 7;
    bf16_t* mix = (bf16_t*)(p.ws + OFF_HB);
    const LAS float* st = (const LAS float*)(lds + S_STG) + gc_ * 132 + seg * 8;
    f32x4 ov[4]; float ss = 0.f;
#pragma unroll
    for (int k = 0; k < 4; ++k) { ov[k] = *(const LAS f32x4*)(st + (k >> 1) * 64 + 4 * (k & 1)); ss += ov[k][0] * ov[k][0] + ov[k][1] * ov[k][1] + ov[k][2] * ov[k][2] + ov[k][3] * ov[k][3]; }
    ss += __shfl_xor(ss, 1); ss += __shfl_xor(ss, 2); ss += __shfl_xor(ss, 4);
    const float rstd = rsqrtf(ss * (1.0f / 128.0f) + EPS);
    const size_t row = (size_t)b * SEQ + n * 64 + gc_;
    const u32x4 z0 = g.z0, z1 = g.z1;
    f32x4 gnw[4];
#pragma unroll
    for (int k = 0; k < 4; ++k) gnw[k] = *(const f32x4*)(p.gdn_norm_w + seg * 8 + (k >> 1) * 64 + 4 * (k & 1));
    u32x4 w0, w1;
    w0.x = pk_bf16(ov[0][0] * rstd * gnw[0][0] * silu_f(bf_lo(z0.x)), ov[0][1] * rstd * gnw[0][1] * silu_f(bf_hi(z0.x)));
    w0.y = pk_bf16(ov[0][2] * rstd * gnw[0][2] * silu_f(bf_lo(z0.y)), ov[0][3] * rstd * gnw[0][3] * silu_f(bf_hi(z0.y)));
    w0.z = pk_bf16(ov[1][0] * rstd * gnw[1][0] * silu_f(bf_lo(z0.z)), ov[1][1] * rstd * gnw[1][1] * silu_f(bf_hi(z0.z)));
    w0.w = pk_bf16(ov[1][2] * rstd * gnw[1][2] * silu_f(bf_lo(z0.w)), ov[1][3] * rstd * gnw[1][3] * silu_f(bf_hi(z0.w)));
    w1.x = pk_bf16(ov[2][0] * rstd * gnw[2][0] * silu_f(bf_lo(z1.x)), ov[2][1] * rstd * gnw[2][1] * silu_f(bf_hi(z1.x)));
    w1.y = pk_bf16(ov[2][2] * rstd * gnw[2][2] * silu_f(bf_lo(z1.y)), ov[2][3] * rstd * gnw[2][3] * silu_f(bf_hi(z1.y)));
    w1.z = pk_bf16(ov[3][0] * rstd * gnw[3][0] * silu_f(bf_lo(z1.z)), ov[3][1] * rstd * gnw[3][1] * silu_f(bf_hi(z1.z)));
    w1.w = pk_bf16(ov[3][2] * rstd * gnw[3][2] * silu_f(bf_lo(z1.w)), ov[3][3] * rstd * gnw[3][3] * silu_f(bf_hi(z1.w)));
    bf16_t* mp = mix + row * DM + hh * 128 + seg * 8;
    *(u32x4*)mp = w0; *(u32x4*)(mp + 64) = w1;
}

struct ScanRegs { u32x4 t0[4], t1[4], t2[4], t3[2]; };
DI void scan_fetch(ScanRegs& R, const bf16_t* WN, const bf16_t* QD, const bf16_t* KD, const bf16_t* AQ, int ltid) {
#pragma unroll
    for (int i = 0; i < 4; ++i) { const int pi = ltid + 256 * i; R.t0[i] = *(const u32x4*)(WN + pi * 8); R.t1[i] = *(const u32x4*)(QD + pi * 8); R.t2[i] = *(const u32x4*)(KD + pi * 8); }
#pragma unroll
    for (int i = 0; i < 2; ++i) { const int pi = ltid + 256 * i; R.t3[i] = *(const u32x4*)(AQ + pi * 8); }
}
DI void scan_put(const ScanRegs& R, LAS unsigned char* dst, int ltid) {
#pragma unroll
    for (int i = 0; i < 4; ++i) { const int pi = ltid + 256 * i, row = pi >> 4, pc = pi & 15;
        *(LAS u32x4*)(dst + S_WN + row * 272 + pc * 16) = R.t0[i]; *(LAS u32x4*)(dst + S_QD + row * 272 + pc * 16) = R.t1[i]; *(LAS u32x4*)(dst + S_KD + row * 272 + pc * 16) = R.t2[i]; }
#pragma unroll
    for (int i = 0; i < 2; ++i) { const int pi = ltid + 256 * i, row = pi >> 3, pc = pi & 7; *(LAS u32x4*)(dst + S_AQ + row * 144 + pc * 16) = R.t3[i]; }
}

DI void gdn_scan(const Params& p, LAS unsigned char* lds, int bh) {
    int tid = threadIdx.x; asm volatile("" : "+v"(tid));
    const int lane = tid & 63, wid = __builtin_amdgcn_readfirstlane(tid >> 6), r = lane & 31, h2 = lane >> 5;
    const int b = bh >> 2, hh = bh & 3;
    const bf16_t* WN = (const bf16_t*)(p.ws + OFF_WN) + (size_t)bh * 32 * 8192;
    const bf16_t* QD = (const bf16_t*)(p.ws + OFF_QD) + (size_t)bh * 32 * 8192;
    const bf16_t* KD = (const bf16_t*)(p.ws + OFF_KD) + (size_t)bh * 32 * 8192;
    const bf16_t* AQ = (const bf16_t*)(p.ws + OFF_AQK) + (size_t)bh * 32 * 4096;
    const float* U = (const float*)(p.ws + OFF_U) + (size_t)bh * 32 * 8192;
    const float* GL = (const float*)(p.ws + OFF_GL) + bh * 32;
    if (wid >= 4) {
        const int ltid = tid & 255;
        ScanRegs R;
        scan_fetch(R, WN, QD, KD, AQ, ltid); scan_put(R, lds, ltid);
        scan_fetch(R, WN + 8192, QD + 8192, KD + 8192, AQ + 4096, ltid);
#pragma unroll 1
        for (int n = 0; n < 32; ++n) {
            __syncthreads();
            GateIn gi; scan_gate_load(p, tid, b, hh, n, gi);
            if (n + 1 < 32) scan_put(R, lds + ((n + 1) & 1) * S_BUF, ltid);
            if (n + 2 < 32) scan_fetch(R, WN + (size_t)(n + 2) * 8192, QD + (size_t)(n + 2) * 8192, KD + (size_t)(n + 2) * 8192, AQ + (size_t)(n + 2) * 4096, ltid);
            __syncthreads();
            scan_gate(p, lds, tid, b, hh, n, gi);
        }
    } else {
        const int i16 = lane & 15, q4 = i16 >> 2, pp = i16 & 3, blk = (lane >> 4) & 1;
        f32x16 St[4], u[2];
#pragma unroll
        for (int k = 0; k < 4; ++k)
#pragma unroll
            for (int i = 0; i < 16; ++i) St[k][i] = 0.f;
#pragma unroll
        for (int mt = 0; mt < 2; ++mt)
#pragma unroll
            for (int k = 0; k < 4; ++k) { const f32x4 v = *(const f32x4*)(U + (wid * 2 + mt) * 1024 + 256 * k + lane * 4); u[mt][4 * k] = v[0]; u[mt][4 * k + 1] = v[1]; u[mt][4 * k + 2] = v[2]; u[mt][4 * k + 3] = v[3]; }
#pragma unroll 1
        for (int n = 0; n < 32; ++n) {
            LAS unsigned char* buf = lds + (n & 1) * S_BUF;
            __syncthreads();
            GateIn gi; scan_gate_load(p, tid, b, hh, n, gi);
            const float egl = GL[n];
            f32x16 vn[2], o[2];
            vn[0] = u[0]; vn[1] = u[1];
#pragma unroll
            for (int mt = 0; mt < 2; ++mt)
#pragma unroll
                for (int i = 0; i < 16; ++i) o[mt][i] = 0.f;
#pragma unroll
            for (int ks = 0; ks < 8; ++ks) {
                const bf16x8 sf = pack8(St[ks >> 1], ks & 1);
#pragma unroll
                for (int mt = 0; mt < 2; ++mt) {
                    const bf16x8 wf = *(const LAS bf16x8*)(buf + S_WN + (32 * mt + r) * 272 + (16 * ks + 8 * h2) * 2);
                    vn[mt] = MFMA32(wf, sf, vn[mt]);
                    const bf16x8 qf = *(const LAS bf16x8*)(buf + S_QD + (32 * mt + r) * 272 + (16 * ks + 8 * h2) * 2);
                    o[mt] = MFMA32(qf, sf, o[mt]);
                }
                asm volatile("" ::: "memory");
            }
            bf16x8 vf[4];
#pragma unroll
            for (int k2 = 0; k2 < 4; ++k2) vf[k2] = pack8(vn[k2 >> 1], k2 & 1);
            {
                const int nn = (n + 1 < 32) ? n + 1 : n;
                const float* up = U + (size_t)nn * 8192 + (wid * 2) * 1024 + lane * 4;
#pragma unroll
                for (int mt = 0; mt < 2; ++mt)
#pragma unroll
                    for (int k = 0; k < 4; ++k) { const f32x4 v = *(const f32x4*)(up + mt * 1024 + 256 * k); u[mt][4 * k] = v[0]; u[mt][4 * k + 1] = v[1]; u[mt][4 * k + 2] = v[2]; u[mt][4 * k + 3] = v[3]; }
            }
#pragma unroll
            for (int mt = 0; mt < 2; ++mt)
#pragma unroll
                for (int k2 = 0; k2 < 2 * (mt + 1); ++k2) {
                    const bf16x8 af = *(const LAS bf16x8*)(buf + S_AQ + (32 * mt + r) * 144 + (16 * k2 + 8 * h2) * 2);
                    o[mt] = MFMA32(af, vf[k2], o[mt]);
                }
            {
                LAS float* st = (LAS float*)(lds + S_STG);
#pragma unroll
                for (int mt = 0; mt < 2; ++mt)
#pragma unroll
                    for (int i = 0; i < 16; ++i) st[(32 * mt + crow(i, h2)) * 132 + 32 * wid + r] = o[mt][i];
            }
#pragma unroll
            for (int kt = 0; kt < 4; ++kt) {
#pragma unroll
                for (int i = 0; i < 16; ++i) St[kt][i] *= egl;
#pragma unroll
                for (int k2 = 0; k2 < 4; ++k2) {
                    const bf16x8 kf = tr_pair(buf + S_KD + (16 * k2 + 4 * h2 + q4) * 272 + (32 * kt + 16 * blk + 4 * pp) * 2, 8 * 272);
                    St[kt] = MFMA32(kf, vf[k2], St[kt]);
                }
                asm volatile("" ::: "memory");
            }
            __syncthreads();
            scan_gate(p, lds, tid, b, hh, n, gi);
        }
    }
    __syncthreads();
}

DI void zero_mix_half(const Params& p, int half) {
    bf16_t* mix = (bf16_t*)(p.ws + OFF_HB);
    const size_t n16 = (size_t)MTOK * 64;
    for (size_t i = (size_t)blockIdx.x * 512 + threadIdx.x; i < n16; i += (size_t)gridDim.x * 512) {
        const size_t row = i >> 6, pc = i & 63;
        *(u32x4*)(mix + row * DM + half * 512 + pc * 8) = (u32x4){0u, 0u, 0u, 0u};
    }
}

DI void phase_final(const Params& p) {
    int tid = threadIdx.x; asm volatile("" : "+v"(tid));
    const int lane = tid & 63, wid = tid >> 6;
    const float* rowsq = (const float*)(p.ws + OFF_ROWSQ);
    const bf16_t* yb = (const bf16_t*)(p.ws + OFF_YB);
    const int gw = blockIdx.x * 8 + wid, nw = gridDim.x * 8;
    f32x4 fw[4];
#pragma unroll
    for (int i = 0; i < 2; ++i) { fw[2 * i] = *(const f32x4*)(p.final_norm_w + 512 * i + 8 * lane); fw[2 * i + 1] = *(const f32x4*)(p.final_norm_w + 512 * i + 8 * lane + 4); }
#pragma unroll 1
    for (int row0 = gw; row0 < MTOK; row0 += 4 * nw) {
        u32x4 y[4][2]; float sq[4];
#pragma unroll
        for (int k = 0; k < 4; ++k) {
            const int row = row0 + k * nw, rc = row < MTOK ? row : row0;
#pragma unroll
            for (int i = 0; i < 2; ++i) y[k][i] = *(const u32x4*)(yb + (size_t)rc * DM + 512 * i + 8 * lane);
            sq[k] = lane < 16 ? rowsq[(size_t)rc * 16 + lane] : 0.f;
        }
#pragma unroll
        for (int k = 0; k < 4; ++k) {
            const int row = row0 + k * nw;
            const float ss = wave_sum(sq[k]);
            const float rstd = rsqrtf(ss * (1.0f / DM) + EPS);
            if (row < MTOK) {
                float* o = p.out + (size_t)row * DM;
#pragma unroll
                for (int i = 0; i < 2; ++i) {
                    const f32x4 a = {bf_lo(y[k][i].x), bf_hi(y[k][i].x), bf_lo(y[k][i].y), bf_hi(y[k][i].y)}, c = {bf_lo(y[k][i].z), bf_hi(y[k][i].z), bf_lo(y[k][i].w), bf_hi(y[k][i].w)};
                    *(f32x4*)(o + 512 * i + 8 * lane) = a * rstd * fw[2 * i];
                    *(f32x4*)(o + 512 * i + 8 * lane + 4) = c * rstd * fw[2 * i + 1];
                }
            }
        }
    }
}

__global__ void __launch_bounds__(512) mega(Params p) {
    extern __shared__ __attribute__((aligned(16))) unsigned char shm[];
    LAS unsigned char* lds = (LAS unsigned char*)shm;
    cg::grid_group grid = cg::this_grid();
    volatile LAS unsigned* bst = (volatile LAS unsigned*)(lds + LDS_BYTES - 16);
    if (threadIdx.x < 2) bst[threadIdx.x] = 0u;
    __syncthreads();
    const XcdBarrier xb = xcd_barrier_post((unsigned*)(p.ws + OFF_BAR), bst);
    if (p.ws == nullptr) grid.sync();

#pragma unroll 1
    for (int rep = 0; rep < REP_PREP; ++rep) phase_prep(p, lds);
    xcd_barrier(xb);
#pragma unroll 1
    for (int rep = 0; rep < REP_G1; ++rep)
    {
        pg8::Gemm g{(const bf16_t*)(p.ws + OFF_HB), (const bf16_t*)(p.ws + OFF_WINT), MTOK, NG1, DM};
        pg8::StaticOrder S; S.init(g.M, g.N, (int)gridDim.x, (int)blockIdx.x);
        pg8::EpiP1 E{(bf16_t*)(p.ws + OFF_P1), NP1, (bf16_t*)(p.ws + OFF_KX)};
        pg8::gemm_phase<pg8::EpiP1, false>(lds, g, S, E);
        pg8::Gemm g2{(const bf16_t*)(p.ws + OFF_HB), (const bf16_t*)(p.ws + OFF_WINT) + (size_t)NG1 * DM, MTOK, 512, DM};
        pg8::StaticOrder S2; S2.init(g2.M, g2.N, (int)gridDim.x, (int)blockIdx.x);
        pg8::EpiVT E2{(bf16_t*)(p.ws + OFF_VT)};
        pg8::gemm_phase<pg8::EpiVT, true>(lds, g2, S2, E2);
    }
    xcd_barrier(xb);
#pragma unroll 1
    for (int rep = 0; rep < REP_GP; ++rep)
    {
        if ((threadIdx.x >> 6) == 0 && (int)blockIdx.x < 2048) gdn_gates(p, (LAS float*)(lds + G_SM), blockIdx.x, threadIdx.x & 63);
        __syncthreads();
        int par = 0;
#pragma unroll 1
        for (int c2 = blockIdx.x; c2 < 2048; c2 += gridDim.x, par ^= 1) gdn_prep(p, lds, c2, c2 + (int)gridDim.x, par);
    }
    xcd_barrier(xb);
#pragma unroll 1
    for (int rep = 0; rep < REP_P3; ++rep) {
#pragma unroll 1
        for (int r2 = 0; r2 < REP_SCAN; ++r2)
            if (blockIdx.x < 64) gdn_scan(p, lds, blockIdx.x);
#if SCAN_SYNC
        xcd_barrier(xb);
#endif
        phase_attn(p, lds, rep);
#if REP_ATTN > 1
        xcd_barrier(xb);
        phase_attn(p, lds, 2);
#endif
#if REP_P3 > 1
        xcd_barrier(xb);
#endif
    }
    xcd_barrier(xb);
#pragma unroll 1
    for (int rnd = 0; rnd < 2; ++rnd) {
        pg8::Gemm g{(const bf16_t*)(p.ws + OFF_HB), (const bf16_t*)(p.ws + OFF_WOUTT), MTOK, DM, DM};
        pg8::StaticOrder S; S.init(g.M, g.N, (int)gridDim.x, (int)blockIdx.x); S.i0 = rnd; S.imax = 1;
        pg8::EpiOutFused E{p.x, p.out, (float*)(p.ws + OFF_ROWSQ), p.final_norm_w, xb};
        pg8::Unit u0;
        if (S.next(0, u0)) pg8::gemm_phase<pg8::EpiOutFused, false>(lds, g, S, E);
        else xcd_barrier(xb);
    }
}

extern "C" void kernel_launch(void* const* d_in, const int* in_sizes, int n_in, void* d_out, int out_size, void* d_ws, size_t ws_size, hipStream_t stream) {
    static int grid = 0;
    if (grid == 0) {
        if (ws_size < WS_END) { fprintf(stderr, "kernel_launch: workspace too small (%zu < %zu)\n", ws_size, (size_t)WS_END); grid = -1; return; }
        int dev = 0, cus = 0, per_cu = 0;
        hipGetDevice(&dev);
        hipDeviceGetAttribute(&cus, hipDeviceAttributeMultiprocessorCount, dev);
        if (hipFuncSetAttribute((const void*)mega, hipFuncAttributeMaxDynamicSharedMemorySize, LDS_BYTES) != hipSuccess) { fprintf(stderr, "kernel_launch: hipFuncSetAttribute failed\n"); grid = -1; return; }
        if (hipOccupancyMaxActiveBlocksPerMultiprocessor(&per_cu, (const void*)mega, 512, LDS_BYTES) != hipSuccess || per_cu < 1) per_cu = 1;
        (void)hipGetLastError();
        grid = cus * (per_cu > 1 ? 1 : per_cu);
    }
    if (grid < 0) return;
    Params p{};
    p.x = (const float*)d_in[0]; p.norm_w = (const float*)d_in[1]; p.w_in = (const float*)d_in[2]; p.conv_w = (const float*)d_in[3];
    p.a_log = (const float*)d_in[4]; p.dt_bias = (const float*)d_in[5]; p.gdn_norm_w = (const float*)d_in[6];
    p.lq1 = (const float*)d_in[7]; p.lk1 = (const float*)d_in[8]; p.lq2 = (const float*)d_in[9]; p.lk2 = (const float*)d_in[10];
    p.diff_norm_w = (const float*)d_in[11]; p.w_out = (const float*)d_in[12]; p.final_norm_w = (const float*)d_in[13];
    p.out = (float*)d_out; p.ws = (unsigned char*)d_ws;
    if (hipMemsetAsync((unsigned char*)d_ws + OFF_BAR, 0, 16384, stream) != hipSuccess) { fprintf(stderr, "kernel_launch: hipMemsetAsync failed\n"); return; }
    void* args[] = {&p};
    hipError_t e = hipLaunchCooperativeKernel((const void*)mega, dim3(grid), dim3(512), args, LDS_BYTES, stream);
    if (e != hipSuccess) fprintf(stderr, "cooperative launch failed: %s (grid %d)\n", hipGetErrorString(e), grid);
}
```

```cpp
#include <hip/hip_runtime.h>
#include <hip/hip_cooperative_groups.h>
#include <cstdio>
namespace cg = cooperative_groups;

#ifndef ENABLE_ATTN
#define ENABLE_ATTN 1
#endif
#ifndef ENABLE_GDN
#define ENABLE_GDN 1
#endif
#ifndef REP_PREP
#define REP_PREP 1
#endif
#ifndef REP_G1
#define REP_G1 1
#endif
#ifndef REP_GP
#define REP_GP 1
#endif
#ifndef REP_P3
#define REP_P3 1
#endif
#ifndef REP_G2
#define REP_G2 1
#endif
#ifndef REP_SCAN
#define REP_SCAN 1
#endif
#ifndef SCAN_SYNC
#define SCAN_SYNC 0
#endif
#ifndef REP_ATTN
#define REP_ATTN 1
#endif

#define LAS __attribute__((address_space(3)))
#define DI __device__ __forceinline__
typedef unsigned short bf16_t;
typedef short bf16x8 __attribute__((ext_vector_type(8)));
typedef short s16x4 __attribute__((ext_vector_type(4)));
typedef float f32x2 __attribute__((ext_vector_type(2)));
typedef float f32x4 __attribute__((ext_vector_type(4)));
typedef float f32x16 __attribute__((ext_vector_type(16)));
typedef unsigned u32x2 __attribute__((ext_vector_type(2)));
typedef unsigned u32x4 __attribute__((ext_vector_type(4)));
typedef __bf16 bf16x2_t __attribute__((ext_vector_type(2)));

#define MFMA32(a, b, c) __builtin_amdgcn_mfma_f32_32x32x16_bf16((a), (b), (c), 0, 0, 0)

constexpr int NB = 16, SEQ = 2048, DM = 1024, MTOK = NB * SEQ, NP1 = 3072, NG1 = 3584;
constexpr int C_GQ = 0, C_GK = 512, C_GV = 1024, C_GZ = 1536, C_DQ = 2048, C_DZ = 2560;
constexpr float EPS = 1e-6f;
constexpr float LOG2E = 1.4426950408889634f;

constexpr size_t OFF_HB = 0;
constexpr size_t OFF_WINT = OFF_HB + (size_t)MTOK * DM * 2;
constexpr size_t OFF_WOUTT = OFF_WINT + (size_t)4096 * 1024 * 2;
constexpr size_t OFF_GBGA = OFF_WOUTT + (size_t)1024 * 1024 * 2;
constexpr size_t OFF_P1 = OFF_GBGA + (size_t)MTOK * 8 * 4;
constexpr size_t OFF_KX = OFF_P1 + (size_t)MTOK * NP1 * 2;
constexpr size_t OFF_VT = OFF_KX + (size_t)64 * 2 * 2048 * 64 * 2;
constexpr size_t OFF_WN = OFF_VT + (size_t)64 * 128 * 2048 * 2;
constexpr size_t OFF_QD = OFF_WN + (size_t)2048 * 64 * 128 * 2;
constexpr size_t OFF_KD = OFF_QD + (size_t)2048 * 64 * 128 * 2;
constexpr size_t OFF_AQK = OFF_KD + (size_t)2048 * 64 * 128 * 2;
constexpr size_t OFF_U = OFF_AQK + (size_t)2048 * 64 * 64 * 2;
constexpr size_t OFF_GL = OFF_U + (size_t)2048 * 64 * 128 * 4;
constexpr size_t OFF_ROWSQ = OFF_GL + 8192;
constexpr size_t OFF_MISC = OFF_ROWSQ + (size_t)MTOK * 16 * 4;
constexpr size_t OFF_YB = OFF_P1;
constexpr size_t OFF_BAR = OFF_MISC + 256;
constexpr size_t WS_END = OFF_BAR + 16384;

constexpr int LDS_BYTES = 156 * 1024;

struct Params {
    const float *x, *norm_w, *w_in, *conv_w, *a_log, *dt_bias, *gdn_norm_w, *lq1, *lk1, *lq2, *lk2, *diff_norm_w, *w_out, *final_norm_w;
    float* out; unsigned char* ws;
};

DI unsigned pk_bf16(float a, float b) { f32x2 v = {a, b}; bf16x2_t r = __builtin_convertvector(v, bf16x2_t); return __builtin_bit_cast(unsigned, r); }
DI float bf_lo(unsigned u) { return __uint_as_float(u << 16); }
DI float bf_hi(unsigned u) { return __uint_as_float(u & 0xffff0000u); }
DI float wave_sum(float v) {
#pragma unroll
    for (int o = 32; o; o >>= 1) v += __shfl_xor(v, o);
    return v;
}
DI float xhalf_max(float v) {
    const u32x2 r = __builtin_amdgcn_permlane32_swap(__float_as_uint(v), __float_as_uint(v), false, false);
    return fmaxf(__uint_as_float(r.x), __uint_as_float(r.y));
}
DI float xhalf_sum(float v) {
    const u32x2 r = __builtin_amdgcn_permlane32_swap(__float_as_uint(v), __float_as_uint(v), false, false);
    return __uint_as_float(r.x) + __uint_as_float(r.y);
}
DI float silu_f(float z) { return z * __builtin_amdgcn_rcpf(1.0f + __builtin_amdgcn_exp2f(-LOG2E * z)); }
DI int perm23(int t) { return (t & ~12) | ((t & 4) << 1) | ((t & 8) >> 1); }
DI int crow(int i, int h2) { return (i & 3) + 8 * (i >> 2) + 4 * h2; }
DI bf16x8 pack8(const f32x16& x, int s) {
    u32x4 w; w.x = pk_bf16(x[8 * s + 0], x[8 * s + 1]); w.y = pk_bf16(x[8 * s + 2], x[8 * s + 3]); w.z = pk_bf16(x[8 * s + 4], x[8 * s + 5]); w.w = pk_bf16(x[8 * s + 6], x[8 * s + 7]);
    return __builtin_bit_cast(bf16x8, w);
}


#define XB_TMO      128
#define XB_XCNT(j)  (256  + 64 * (j))
#define XB_XSUB(j)  (1280 + 64 * (j))
#define XB_XGEN(j)  (2304 + 64 * (j))
#define XB_TOP      3328
#define XB_TOPGEN   3392
#define XCD_BAR_WORDS 3456
#define XB_SPIN_CAP (1u << 18)
struct XcdBarrier { unsigned* bar; unsigned x; volatile LAS unsigned* st; };
DI unsigned xb_ld(unsigned* p)              { return __hip_atomic_load(p, __ATOMIC_RELAXED, __HIP_MEMORY_SCOPE_AGENT); }
DI unsigned xb_add(unsigned* p, unsigned v) { return __hip_atomic_fetch_add(p, v, __ATOMIC_RELAXED, __HIP_MEMORY_SCOPE_AGENT); }
DI unsigned xb_xcc_id() { return (unsigned)__builtin_amdgcn_s_getreg((3 << 11) | 20) & 0xFu; }
#define XB_SPIN(cond, bar) do { unsigned _sp = 0; while (cond) { __builtin_amdgcn_s_sleep(1); \
    if ((++_sp & 255u) == 0u) { if (xb_ld(&(bar)[XB_TMO])) break; if (_sp > XB_SPIN_CAP) { atomicAdd(&(bar)[XB_TMO], 1u); break; } } } } while (0)
DI XcdBarrier xcd_barrier_post(unsigned* bar, volatile LAS unsigned* st) {
    XcdBarrier b; b.bar = bar; b.x = xb_xcc_id(); b.st = st;
    if (threadIdx.x == 0) (void)xb_add(&bar[XB_XCNT(b.x)], 1u);
    return b;
}
DI void xcd_barrier_complete(unsigned* bar, unsigned x, unsigned& nloc, unsigned& nx) {
    const unsigned G = gridDim.x * gridDim.y * gridDim.z;
    unsigned sum, cnt, mine, sp = 0u;
    for (;;) {
        sum = 0u; cnt = 0u; mine = 0u;
#pragma unroll
        for (unsigned j = 0; j < 16; ++j) { const unsigned c = xb_ld(&bar[XB_XCNT(j)]); sum += c; cnt += (c > 0u) ? 1u : 0u; mine = (j == x) ? c : mine; }
        if (sum == G) break;
        __builtin_amdgcn_s_sleep(1);
        if ((++sp & 255u) == 0u) { if (xb_ld(&bar[XB_TMO])) break; if (sp > XB_SPIN_CAP) { atomicAdd(&bar[XB_TMO], 1u); break; } }
    }
    nloc = mine > 0u ? mine : 1u; nx = cnt > 0u ? cnt : 1u;
}
DI void xcd_barrier(const XcdBarrier& b) {
    asm volatile("s_waitcnt vmcnt(0)" ::: "memory");
    __syncthreads();
    if (threadIdx.x == 0) {
        unsigned* bar = b.bar;
        __builtin_amdgcn_s_waitcnt(0);
        unsigned nloc = b.st[0], nx = b.st[1];
        if (nloc == 0u) { xcd_barrier_complete(bar, b.x, nloc, nx); b.st[0] = nloc; b.st[1] = nx; }
        const unsigned old = xb_add(&bar[XB_XSUB(b.x)], 1u);
        const unsigned gen = old / nloc;
        if (old + 1u == (gen + 1u) * nloc) {
            __builtin_amdgcn_fence(__ATOMIC_RELEASE, "agent");
            asm volatile("s_waitcnt vmcnt(0)" ::: "memory");
            const unsigned og = xb_add(&bar[XB_TOP], 1u);
            const unsigned tg = og / nx;
            if (og + 1u == (tg + 1u) * nx) xb_add(&bar[XB_TOPGEN], 1u);
            else XB_SPIN(xb_ld(&bar[XB_TOPGEN]) == tg, bar);
            __builtin_amdgcn_fence(__ATOMIC_ACQUIRE, "agent");
            xb_add(&bar[XB_XGEN(b.x)], 1u);
            asm volatile("s_waitcnt vmcnt(0)" ::: "memory");
        } else {
            XB_SPIN(xb_ld(&bar[XB_XGEN(b.x)]) == gen, bar);
            __builtin_amdgcn_fence(__ATOMIC_ACQUIRE, "agent");
            asm volatile("s_waitcnt vmcnt(0)" ::: "memory");
        }
    }
    __syncthreads();
}

namespace pg8 {
constexpr int BM = 256, BK = 64, HALF = 128, HTB = HALF * BK * 2, STAGE_BYTES = 8 * HTB, NXCD = 8, WGM = 8;
DI int lds_byte(int r, int c) { const int st = (r >> 4) * 2 + (c >> 5), rr = r & 15, cc = c & 31, ob = rr * 64 + cc * 2; return st * 1024 + (ob ^ (((ob >> 9) & 1) << 5)); }
DI void stage_rc(int b, int& R, int& C) { const int st = b / 1024, sb = b % 1024, swz = sb ^ (((sb >> 9) & 1) << 5); R = (st >> 1) * 16 + swz / 64; C = (st & 1) * 32 + (swz % 64) / 2; }
DI int perm32(int rho) { const int n = rho >> 4, i = rho & 15; return 8 * (i >> 2) + 4 * n + (i & 3); }
struct Unit { int pm, pn; };
struct Gemm { const bf16_t* A; const bf16_t* Bt; int M, N, K; };
struct StaticOrder {
    int nM, nN, nwg, G, c, i0 = 0, imax = 1 << 30;
    DI void init(int M, int N, int G_, int c_) { nM = M / BM; nN = N / BM; nwg = nM * nN; G = G_; c = c_; }
    DI bool next(int i, Unit& u) const {
        if (i >= imax) return false;
        const long L = (long)(i + i0) * G + c; if (L >= nwg) return false;
        int wgid = (int)L; { const int q = nwg / NXCD, r = nwg % NXCD, xcd = wgid % NXCD, off = wgid / NXCD; wgid = (xcd < r ? xcd * (q + 1) : r * (q + 1) + (xcd - r) * q) + off; }
        const int nig = WGM * nN, gid = wgid / nig, fm = gid * WGM, gsz = (nM - fm) < WGM ? (nM - fm) : WGM;
        u.pm = fm + ((wgid % nig) % gsz); u.pn = (wgid % nig) / gsz; return true;
    }
    DI void a_ready(const Unit&) const {}
    DI void done(const Unit&) const {}
};

struct EpiP1 {
    static constexpr bool PERM = true, PERM16 = true, AFTER_DRAIN = false;
    bf16_t* O; int ldc; bf16_t* KX;
    DI void operator()(const f32x4 (&acc)[2][2][4][2], const Unit& u, int wr, int wc, int fr, int fq) const {
        const int row0 = u.pm * BM + wr * 64 + fr, col0 = u.pn * BM + wc * 64 + 8 * fq;
        if (u.pn >= 12) {
            const int c = col0 - 12 * BM, hm = c >> 6, d = c & 63;
#pragma unroll
            for (int ai = 0; ai < 2; ++ai)
#pragma unroll
                for (int m = 0; m < 4; ++m) { const int row = row0 + ai * HALF + m * 16, b = row >> 11, tok = row & 2047;
                    bf16_t* dp = KX + ((size_t)(b * 8 + hm) * 2048 + tok) * 64 + d;
#pragma unroll
                    for (int bj = 0; bj < 2; ++bj) { const f32x4 v0 = acc[ai][bj][m][0], v1 = acc[ai][bj][m][1];
                        u32x4 w; w.x = pk_bf16(v0[0], v0[1]); w.y = pk_bf16(v0[2], v0[3]); w.z = pk_bf16(v1[0], v1[1]); w.w = pk_bf16(v1[2], v1[3]);
                        *(u32x4*)(dp + 32 * bj) = w; } }
            return;
        }
#pragma unroll
        for (int ai = 0; ai < 2; ++ai)
#pragma unroll
            for (int m = 0; m < 4; ++m) { bf16_t* rowp = O + (size_t)(row0 + ai * HALF + m * 16) * ldc + col0;
#pragma unroll
                for (int bj = 0; bj < 2; ++bj) { const f32x4 v0 = acc[ai][bj][m][0], v1 = acc[ai][bj][m][1];
                    u32x4 w; w.x = pk_bf16(v0[0], v0[1]); w.y = pk_bf16(v0[2], v0[3]); w.z = pk_bf16(v1[0], v1[1]); w.w = pk_bf16(v1[2], v1[3]);
                    *(u32x4*)(rowp + 32 * bj) = w; } }
    }
};
struct EpiVT {
    static constexpr bool PERM = false, PERM16 = false, AFTER_DRAIN = false;
    bf16_t* VT;
    DI void operator()(const f32x4 (&acc)[2][2][4][2], const Unit& u, int wr, int wc, int fr, int fq) const {
#pragma unroll
        for (int ai = 0; ai < 2; ++ai)
#pragma unroll
            for (int m = 0; m < 4; ++m) {
                const int t = u.pm * BM + ai * HALF + wr * 64 + m * 16 + 4 * fq, b = t >> 11, tok = t & 2047, pos = perm23(tok);
#pragma unroll
                for (int bj = 0; bj < 2; ++bj)
#pragma unroll
                    for (int n = 0; n < 2; ++n) {
                        const int c = u.pn * BM + bj * HALF + wc * 32 + n * 16 + fr, hh = c >> 7, dv = c & 127;
                        const f32x4 v = acc[ai][bj][m][n];
                        u32x2 w; w.x = pk_bf16(v[0], v[1]); w.y = pk_bf16(v[2], v[3]);
                        *(u32x2*)(VT + (((size_t)((b * 4 + hh) * 32 + (pos >> 6)) * 128 + dv)) * 64 + (pos & 63)) = w;
                    }
            }
    }
};
static_assert(WGM == 8, "EpiOutFused needs the four column tiles of a row panel in the same round");
struct EpiOutFused {
    static constexpr bool PERM = false, PERM16 = false, AFTER_DRAIN = true;
    const float* X; float* Out; float* rowsq; const float* fw; XcdBarrier xb;
    DI void operator()(const f32x4 (&)[2][2][4][2], const Unit&, int, int, int, int) const {}
    DI void fused(f32x4 (&acc)[2][2][4][2], const Unit& u, int wr, int wc, int fr, int fq) const {
        const int row0 = u.pm * BM + wr * 64 + fr, col0 = u.pn * BM + wc * 32 + 4 * fq;
#pragma unroll
        for (int ai = 0; ai < 2; ++ai) {
            f32x4 xv[4][2][2];
#pragma unroll
            for (int m = 0; m < 4; ++m)
#pragma unroll
                for (int bj = 0; bj < 2; ++bj)
#pragma unroll
                    for (int n = 0; n < 2; ++n) xv[m][bj][n] = *(const f32x4*)(X + (size_t)(row0 + ai * HALF + m * 16) * DM + col0 + bj * HALF + n * 16);
            __builtin_amdgcn_sched_group_barrier(0x020, 16, 0);
            __builtin_amdgcn_sched_group_barrier(0x002, 400, 0);
#pragma unroll
            for (int m = 0; m < 4; ++m) {
                const int row = row0 + ai * HALF + m * 16; float ss = 0.f;
#pragma unroll
                for (int bj = 0; bj < 2; ++bj)
#pragma unroll
                    for (int n = 0; n < 2; ++n) {
                        const f32x4 y = acc[ai][bj][m][n] + xv[m][bj][n];
                        acc[ai][bj][m][n] = y; ss += y[0] * y[0] + y[1] * y[1] + y[2] * y[2] + y[3] * y[3];
                    }
                ss += __shfl_xor(ss, 16); ss += __shfl_xor(ss, 32);
                if (fq == 0) rowsq[(size_t)row * 16 + u.pn * 4 + wc] = ss;
            }
            __builtin_amdgcn_sched_barrier(0);
        }
        xcd_barrier(xb);
        f32x4 fwv[2][2];
#pragma unroll
        for (int bj = 0; bj < 2; ++bj)
#pragma unroll
            for (int n = 0; n < 2; ++n) fwv[bj][n] = *(const f32x4*)(fw + col0 + bj * HALF + n * 16);
#pragma unroll
        for (int ai = 0; ai < 2; ++ai)
#pragma unroll
            for (int m = 0; m < 4; ++m) {
                const int row = row0 + ai * HALF + m * 16;
                const f32x4* rq = (const f32x4*)(rowsq + (size_t)row * 16);
                const f32x4 q0 = rq[0], q1 = rq[1], q2 = rq[2], q3 = rq[3];
                const float tot = ((q0[0] + q0[1]) + (q0[2] + q0[3])) + ((q1[0] + q1[1]) + (q1[2] + q1[3])) + ((q2[0] + q2[1]) + (q2[2] + q2[3])) + ((q3[0] + q3[1]) + (q3[2] + q3[3]));
                const float rstd = rsqrtf(tot * (1.0f / DM) + EPS);
#pragma unroll
                for (int bj = 0; bj < 2; ++bj)
#pragma unroll
                    for (int n = 0; n < 2; ++n) {
                        const size_t o = (size_t)row * DM + col0 + bj * HALF + n * 16;
                        *(f32x4*)(Out + o) = acc[ai][bj][m][n] * rstd * fwv[bj][n];
                    }
            }
    }
};

template <class Epi, bool SWAP>
DI void gemm_phase(LAS unsigned char* lds, const Gemm g, const StaticOrder& S, const Epi& E) {
    int tid = threadIdx.x; asm volatile("" : "+v"(tid));
    const int wid = __builtin_amdgcn_readfirstlane(tid >> 6), lane = tid & 63, wr = wid >> 2, wc = wid & 3, fr = lane & 15, fq = lane >> 4;
    const int K = g.K, nt = K / BK;
    unsigned voffA[2], voffB[2], voffB1[2];
#pragma unroll
    for (int i = 0; i < 2; ++i) { int R, C; stage_rc(tid * 16 + i * 8192, R, C); const int Rb = Epi::PERM ? ((R & ~31) + perm32(R & 31)) : R;
        voffA[i] = (unsigned)(R * K + C) * 2u;
        if constexpr (Epi::PERM16) {
            const int c0 = 64 * (R >> 5) + 8 * ((R >> 2) & 3) + 4 * ((R >> 4) & 1) + (R & 3);
            voffB[i] = (unsigned)(c0 * K + C) * 2u; voffB1[i] = (unsigned)((c0 + 32) * K + C) * 2u;
        } else { voffB[i] = (unsigned)(Rb * K + C) * 2u; voffB1[i] = voffB[i]; } }
    const size_t kstep = (size_t)(BK * 2);
    const size_t hstep = (size_t)HALF * K * 2;
    const size_t tstep = 2 * hstep;
    const size_t hoff = Epi::PERM16 ? 0 : hstep;
    const unsigned ldsw = (unsigned)wid * 1024u;
    const int aoff = lds_byte(wr * 64 + fr, fq * 8), boff = lds_byte(wc * 32 + fr, fq * 8);
#define PG8_SA(b, h) (((b) * 2 + (h)) * HTB)
#define PG8_SB(b, h) ((4 + (b) * 2 + (h)) * HTB)
#define PG8_STAGE(bufoff, gbase, voff) do { _Pragma("unroll") for (int _i = 0; _i < 2; ++_i) \
        __builtin_amdgcn_global_load_lds((const unsigned*)((const char*)(gbase) + (voff)[_i]), (LAS unsigned*)(lds + (bufoff) + ldsw + _i * 8192), 16, 0, 0); } while (0)
#define PG8_LDA(dst, b, h) do { _Pragma("unroll") for (int m = 0; m < 4; ++m) _Pragma("unroll") for (int k = 0; k < 2; ++k) dst[m][k] = *(const LAS bf16x8*)(lds + PG8_SA(b, h) + aoff + m * 2048 + k * 1024); } while (0)
#define PG8_LDB(dst, b, h) do { _Pragma("unroll") for (int n = 0; n < 2; ++n) _Pragma("unroll") for (int k = 0; k < 2; ++k) dst[n][k] = *(const LAS bf16x8*)(lds + PG8_SB(b, h) + boff + n * 2048 + k * 1024); } while (0)
#define PG8_MMA(ai, bj, At, Bt) do { __builtin_amdgcn_s_setprio(1); _Pragma("unroll") for (int m = 0; m < 4; ++m) _Pragma("unroll") for (int n = 0; n < 2; ++n) _Pragma("unroll") for (int k = 0; k < 2; ++k) \
        acc[ai][bj][m][n] = SWAP ? __builtin_amdgcn_mfma_f32_16x16x32_bf16(At[m][k], Bt[n][k], acc[ai][bj][m][n], 0, 0, 0) \
                                 : __builtin_amdgcn_mfma_f32_16x16x32_bf16(Bt[n][k], At[m][k], acc[ai][bj][m][n], 0, 0, 0); __builtin_amdgcn_s_setprio(0); } while (0)
#define PG8_WAIT_V(n) asm volatile("s_waitcnt vmcnt(" #n ")" ::: "memory")
#define PG8_WAIT_L(n) asm volatile("s_waitcnt lgkmcnt(" #n ")" ::: "memory")
#define PG8_BAR __builtin_amdgcn_s_barrier()
#define PG8_SCHED __builtin_amdgcn_sched_barrier(0)
    Unit cur, nxt; int ui = 0;
    if (!S.next(0, cur)) return;
    f32x4 acc[2][2][4][2];
#pragma unroll
    for (int a = 0; a < 2; ++a)
#pragma unroll
        for (int b = 0; b < 2; ++b)
#pragma unroll
            for (int m = 0; m < 4; ++m)
#pragma unroll
                for (int n = 0; n < 2; ++n) acc[a][b][m][n] = (f32x4){0.f, 0.f, 0.f, 0.f};
    bf16x8 At[4][2], B0[2][2], B1[2][2];
    const char* cA = (const char*)g.A + (size_t)cur.pm * tstep; const char* cB = (const char*)g.Bt + (size_t)cur.pn * tstep;
    PG8_STAGE(PG8_SB(0, 0), cB, voffB); PG8_STAGE(PG8_SA(0, 0), cA, voffA); PG8_STAGE(PG8_SB(0, 1), cB + hoff, voffB1); PG8_STAGE(PG8_SA(0, 1), cA + hstep, voffA);
    if (wr == 1) PG8_BAR;
    PG8_WAIT_V(4); PG8_BAR;
    PG8_STAGE(PG8_SB(1, 0), cB + kstep, voffB); PG8_STAGE(PG8_SA(1, 0), cA + kstep, voffA); PG8_STAGE(PG8_SB(1, 1), cB + hoff + kstep, voffB1);
    PG8_WAIT_V(6); PG8_BAR;
    for (;;) {
        const bool has_next = S.next(ui + 1, nxt);
        const char* nA = has_next ? (const char*)g.A + (size_t)nxt.pm * tstep : cA; const char* nB = has_next ? (const char*)g.Bt + (size_t)nxt.pn * tstep : cB;
        for (int t = 0; t < nt; t += 2) {
            const bool last = (t == nt - 2);
            const char* a1 = cA + (size_t)(t + 1) * kstep;
            const char* a2 = last ? nA : cA + (size_t)(t + 2) * kstep; const char* b2 = last ? nB : cB + (size_t)(t + 2) * kstep;
            const char* a3 = a2 + kstep; const char* b3 = b2 + kstep;
            PG8_LDB(B0, 0, 0); PG8_SCHED; PG8_LDA(At, 0, 0); PG8_STAGE(PG8_SA(1, 1), a1 + hstep, voffA);
            PG8_WAIT_L(8); PG8_BAR; PG8_WAIT_L(0); PG8_MMA(0, 0, At, B0); PG8_BAR; PG8_SCHED;
            PG8_LDB(B1, 0, 1); PG8_STAGE(PG8_SB(0, 0), b2, voffB);
            PG8_BAR; PG8_WAIT_L(0); PG8_MMA(0, 1, At, B1); PG8_BAR;
            PG8_LDA(At, 0, 1); PG8_STAGE(PG8_SA(0, 0), a2, voffA);
            PG8_BAR; PG8_WAIT_L(0); PG8_MMA(1, 0, At, B0); PG8_BAR; PG8_SCHED;
            PG8_STAGE(PG8_SB(0, 1), b2 + hoff, voffB1);
            PG8_WAIT_V(6); PG8_BAR; PG8_MMA(1, 1, At, B1); PG8_BAR;
            PG8_LDB(B0, 1, 0); PG8_SCHED; PG8_LDA(At, 1, 0); PG8_STAGE(PG8_SA(0, 1), a2 + hstep, voffA);
            PG8_WAIT_L(8); PG8_BAR; PG8_WAIT_L(0); PG8_MMA(0, 0, At, B0); PG8_BAR; PG8_SCHED;
            PG8_LDB(B1, 1, 1); PG8_STAGE(PG8_SB(1, 0), b3, voffB);
            PG8_BAR; PG8_WAIT_L(0); PG8_MMA(0, 1, At, B1); PG8_BAR;
            PG8_LDA(At, 1, 1); PG8_STAGE(PG8_SA(1, 0), a3, voffA);
            PG8_BAR; PG8_WAIT_L(0); PG8_MMA(1, 0, At, B0); PG8_BAR; PG8_SCHED;
            PG8_STAGE(PG8_SB(1, 1), b3 + hoff, voffB1);
            PG8_WAIT_V(6); PG8_BAR; PG8_MMA(1, 1, At, B1); PG8_BAR;
        }
        if constexpr (!Epi::AFTER_DRAIN) E(acc, cur, wr, wc, fr, fq);
        if (!has_next) break;
#pragma unroll
        for (int a = 0; a < 2; ++a)
#pragma unroll
            for (int b = 0; b < 2; ++b)
#pragma unroll
                for (int m = 0; m < 4; ++m)
#pragma unroll
                    for (int n = 0; n < 2; ++n) acc[a][b][m][n] = (f32x4){0.f, 0.f, 0.f, 0.f};
        cur = nxt; cA = nA; cB = nB; ++ui;
    }
    PG8_WAIT_V(0);
    if (wr == 0) PG8_BAR;
    PG8_BAR;
    if constexpr (Epi::AFTER_DRAIN) E.fused(acc, cur, wr, wc, fr, fq);
#undef PG8_SA
#undef PG8_SB
#undef PG8_STAGE
#undef PG8_LDA
#undef PG8_LDB
#undef PG8_MMA
#undef PG8_WAIT_V
#undef PG8_WAIT_L
#undef PG8_BAR
#undef PG8_SCHED
}
}

DI int win_src_col(int n0) {
    if (n0 < 2048) return n0;
    if (n0 < 2560) return 2056 + (n0 - 2048);
    if (n0 < 3072) return 3592 + (n0 - 2560);
    if (n0 < 3584) return 2568 + (n0 - 3072);
    return 3080 + (n0 - 3584);
}
DI void phase_prep(const Params& p, LAS unsigned char* lds) {
    int tid = threadIdx.x; asm volatile("" : "+v"(tid));
    const int lane = tid & 63, wid = tid >> 6;
    if (blockIdx.x == 0 && wid == 0) {
        float a = p.lq1[lane] * p.lk1[lane], b = p.lq2[lane] * p.lk2[lane];
        a = wave_sum(a); b = wave_sum(b);
        if (lane == 0) { *(float*)(p.ws + OFF_MISC) = expf(a) - expf(b) + 0.2f; *(unsigned*)(p.ws + OFF_MISC + 4) = 0u; *(unsigned*)(p.ws + OFF_MISC + 8) = 0u; *(unsigned*)(p.ws + OFF_MISC + 12) = 0u; }
    }
    bf16_t* hb = (bf16_t*)(p.ws + OFF_HB);
    float* gbga = (float*)(p.ws + OFF_GBGA);
    const int gw = blockIdx.x * 8 + wid, nw = gridDim.x * 8;
    {
        f32x4 nwv[4]; float wq[16][8];
#pragma unroll
        for (int i = 0; i < 4; ++i) {
            nwv[i] = ((const f32x4*)p.norm_w)[lane + 64 * i];
#pragma unroll
            for (int e = 0; e < 4; ++e) {
                const int k = 4 * (lane + 64 * i) + e;
                const f32x4* wp = (const f32x4*)(p.w_in + (size_t)k * 4104 + 2048);
                const f32x4 w0 = wp[0], w1 = wp[1];
#pragma unroll
                for (int j = 0; j < 4; ++j) { wq[4 * i + e][j] = nwv[i][e] * w0[j]; wq[4 * i + e][4 + j] = nwv[i][e] * w1[j]; }
            }
        }
        const bool b5 = (lane & 32) != 0, b4 = (lane & 16) != 0, b3 = (lane & 8) != 0;
        const int col = (b5 ? 4 : 0) + (b4 ? 2 : 0) + (b3 ? 1 : 0);
        int row = gw;
        f32x4 v[4];
        if (row < MTOK) {
#pragma unroll
            for (int i = 0; i < 4; ++i) v[i] = __builtin_nontemporal_load((const f32x4*)(p.x + (size_t)row * DM) + lane + 64 * i);
        }
#pragma unroll 1
        for (; row < MTOK; row += nw) {
            f32x4 vnx[4];
            const int rnx = (row + nw < MTOK) ? row + nw : row;
#pragma unroll
            for (int i = 0; i < 4; ++i) vnx[i] = __builtin_nontemporal_load((const f32x4*)(p.x + (size_t)rnx * DM) + lane + 64 * i);
            float ss = 0.f, a8[8];
#pragma unroll
            for (int j = 0; j < 8; ++j) a8[j] = 0.f;
#pragma unroll
            for (int i = 0; i < 4; ++i)
#pragma unroll
                for (int e = 0; e < 4; ++e) {
                    ss += v[i][e] * v[i][e];
#pragma unroll
                    for (int j = 0; j < 8; ++j) a8[j] += v[i][e] * wq[4 * i + e][j];
                }
            ss = wave_sum(ss);
            const float rstd = rsqrtf(ss * (1.0f / DM) + EPS);
#pragma unroll
            for (int i = 0; i < 4; ++i) {
                const f32x4 h = v[i] * rstd * nwv[i];
                u32x2 w; w.x = pk_bf16(h[0], h[1]); w.y = pk_bf16(h[2], h[3]);
                *(u32x2*)(hb + (size_t)row * DM + 4 * (lane + 64 * i)) = w;
            }
            float c4[4], c2[2], c1;
#pragma unroll
            for (int j = 0; j < 4; ++j) { const float send = b5 ? a8[j] : a8[4 + j], keep = b5 ? a8[4 + j] : a8[j]; c4[j] = keep + __shfl_xor(send, 32); }
#pragma unroll
            for (int j = 0; j < 2; ++j) { const float send = b4 ? c4[j] : c4[2 + j], keep = b4 ? c4[2 + j] : c4[j]; c2[j] = keep + __shfl_xor(send, 16); }
            { const float send = b3 ? c2[0] : c2[1], keep = b3 ? c2[1] : c2[0]; c1 = keep + __shfl_xor(send, 8); }
            c1 += __shfl_xor(c1, 4); c1 += __shfl_xor(c1, 2); c1 += __shfl_xor(c1, 1);
            if ((lane & 7) == 0) gbga[(size_t)row * 8 + col] = c1 * rstd;
#pragma unroll
            for (int i = 0; i < 4; ++i) v[i] = vnx[i];
        }
    }
    LAS float* tl = (LAS float*)lds;
    for (int tile = blockIdx.x; tile < 1024 + 256; tile += gridDim.x) {
        const float* src; int ld, n0, k0, srcn0; bf16_t* dst;
        if (tile < 1024) { n0 = (tile >> 4) * 64; k0 = (tile & 15) * 64; srcn0 = win_src_col(n0); src = p.w_in; ld = 4104; dst = (bf16_t*)(p.ws + OFF_WINT); }
        else { const int t2 = tile - 1024; n0 = (t2 >> 4) * 64; k0 = (t2 & 15) * 64; srcn0 = n0; src = p.w_out; ld = 1024; dst = (bf16_t*)(p.ws + OFF_WOUTT); }
        const int kk = tid >> 4, n4 = tid & 15;
#pragma unroll
        for (int ps = 0; ps < 2; ++ps) { const int k = kk + 32 * ps;
            const f32x4 v = __builtin_nontemporal_load((const f32x4*)(src + (size_t)(k0 + k) * ld + srcn0 + 4 * n4));
#pragma unroll
            for (int e = 0; e < 4; ++e) tl[k * 65 + 4 * n4 + e] = v[e]; }
        __syncthreads();
        { const int n = tid >> 3, k8 = tid & 7; float f[8];
#pragma unroll
            for (int e = 0; e < 8; ++e) f[e] = tl[(8 * k8 + e) * 65 + n];
            u32x4 w; w.x = pk_bf16(f[0], f[1]); w.y = pk_bf16(f[2], f[3]); w.z = pk_bf16(f[4], f[5]); w.w = pk_bf16(f[6], f[7]);
            *(u32x4*)(dst + (size_t)(n0 + n) * 1024 + k0 + 8 * k8) = w; }
        __syncthreads();
    }
}

constexpr int AT_KB = 8192, AT_VB = 16384, AT_BUF = AT_KB + AT_VB, AT_NBUF = 3, AT_TASK = AT_NBUF * AT_BUF, AT_O1 = AT_TASK + 256;

DI void attn_qblock(const Params& p, LAS unsigned char* lds, int b, int hh, int qb, float lam) {
    int tid = threadIdx.x; asm volatile("" : "+v"(tid));
    const int lane = tid & 63, wid = __builtin_amdgcn_readfirstlane(tid >> 6);
    const bf16_t* P1 = (const bf16_t*)(p.ws + OFF_P1);
    const bf16_t* VT = (const bf16_t*)(p.ws + OFF_VT) + (size_t)(b * 4 + hh) * 32 * 128 * 64;
    const bf16_t* KX = (const bf16_t*)(p.ws + OFF_KX) + (size_t)(b * 4 + hh) * 2 * 2048 * 64;
    bf16_t* mix = (bf16_t*)(p.ws + OFF_HB);
    const int q0 = qb * 256 + wid * 32;
    const size_t tokbase = (size_t)b * SEQ;
    const int nkt = (qb + 1) * 4;
    const float sl2 = exp2f(-2.0f * (float)(hh + 1)) * LOG2E;
    const float c1 = 0.125f * LOG2E;
#pragma unroll 1
    for (int map = 0; map < 2; ++map) {
        f32x16 O[4];
#pragma unroll
        for (int mt = 0; mt < 4; ++mt)
#pragma unroll
            for (int i = 0; i < 16; ++i) O[mt][i] = 0.f;
        float m = -INFINITY, l = 0.f;
        int lane_m = lane; asm volatile("" : "+v"(lane_m));
        const int r = lane_m & 31, h2 = lane_m >> 5;
        int foff[4];
#pragma unroll
        for (int k = 0; k < 4; ++k) foff[k] = r * 128 + (((2 * k + h2) ^ ((r >> 1) & 7)) << 4);
        float kb[16];
#pragma unroll
        for (int i = 0; i < 16; ++i) kb[i] = sl2 * (float)crow(i, h2);
        const int krow_ = 8 * wid + (lane_m >> 3), vrow0 = 16 * wid + (lane_m >> 3), vrow1 = vrow0 + 8;
        const bf16_t* kgp = KX + ((size_t)map * 2048 + krow_) * 64 + (((lane_m & 7) ^ ((krow_ >> 1) & 7)) * 8);
        const bf16_t* vgp0 = VT + (size_t)vrow0 * 64 + (((lane_m & 7) ^ ((vrow0 >> 1) & 7)) * 8);
        const bf16_t* vgp1 = VT + (size_t)vrow1 * 64 + (((lane_m & 7) ^ ((vrow1 >> 1) & 7)) * 8);
#define AT_STAGE(bufi, tile) do { LAS unsigned char* _b = lds + (bufi) * AT_BUF; \
            __builtin_amdgcn_global_load_lds((const unsigned*)(kgp + (size_t)(tile) * 64 * 64), (LAS unsigned*)(_b + wid * 1024), 16, 0, 0); \
            __builtin_amdgcn_global_load_lds((const unsigned*)(vgp0 + (size_t)(tile) * 128 * 64), (LAS unsigned*)(_b + AT_KB + wid * 2048), 16, 0, 0); \
            __builtin_amdgcn_global_load_lds((const unsigned*)(vgp1 + (size_t)(tile) * 128 * 64), (LAS unsigned*)(_b + AT_KB + wid * 2048 + 1024), 16, 0, 0); } while (0)
        bf16x8 qf[4];
        { const bf16_t* qp = P1 + (tokbase + q0 + (lane_m & 31)) * NP1 + C_DQ + hh * 128 + map * 64 + 8 * (lane_m >> 5);
#pragma unroll
            for (int ks = 0; ks < 4; ++ks) qf[ks] = *(const bf16x8*)(qp + 16 * ks); }
        AT_STAGE(0, 0);
        AT_STAGE(1, 1);
        asm volatile("" : "+v"(qf[0]), "+v"(qf[1]), "+v"(qf[2]), "+v"(qf[3]));
        int cb = 0;
#pragma unroll 1
        for (int kt = 0; kt < nkt; ++kt) {
            asm volatile("s_waitcnt vmcnt(0)" ::: "memory");
            __builtin_amdgcn_s_barrier();
            asm volatile("" ::: "memory");
            if (kt + 2 < nkt) { const int nb = cb == 0 ? 2 : cb - 1; AT_STAGE(nb, kt + 2); }
            const LAS unsigned char* cur = lds + cb * AT_BUF;
            cb = cb == 2 ? 0 : cb + 1;
            const int k0 = kt * 64;
            if (k0 <= q0) {
                const bool sub1 = (k0 + 32 <= q0);
                const LAS unsigned char* vb = cur + AT_KB;
                bf16x8 kf[8];
#pragma unroll
                for (int ks = 0; ks < 4; ++ks) kf[ks] = *(const LAS bf16x8*)(cur + foff[ks]);
                if (sub1) {
#pragma unroll
                    for (int ks = 0; ks < 4; ++ks) kf[4 + ks] = *(const LAS bf16x8*)(cur + 4096 + foff[ks]);
                }
                f32x16 s0, s1;
#pragma unroll
                for (int i = 0; i < 16; ++i) { s0[i] = 0.f; s1[i] = 0.f; }
#pragma unroll
                for (int ks = 0; ks < 4; ++ks) s0 = MFMA32(kf[ks], qf[ks], s0);
                if (sub1) {
#pragma unroll
                    for (int ks = 0; ks < 4; ++ks) s1 = MFMA32(kf[4 + ks], qf[ks], s1);
                }
                __builtin_amdgcn_sched_barrier(0);
                bf16x8 va[8];
#pragma unroll
                for (int s2 = 0; s2 < 2; ++s2)
#pragma unroll
                    for (int mt = 0; mt < 4; ++mt) va[s2 * 4 + mt] = *(const LAS bf16x8*)(vb + mt * 4096 + foff[s2]);
                __builtin_amdgcn_sched_barrier(0);
                const float off0 = sl2 * (float)(k0 - q0), off1 = off0 + 32.0f * sl2;
                const f32x2 c1v = {c1, c1};
#pragma unroll
                for (int j = 0; j < 8; ++j) {
                    const f32x2 kv = {kb[2 * j], kb[2 * j + 1]};
                    f32x2 a = {s0[2 * j], s0[2 * j + 1]}, c = {s1[2 * j], s1[2 * j + 1]};
                    a = __builtin_elementwise_fma(a, c1v, kv); c = __builtin_elementwise_fma(c, c1v, kv);
                    s0[2 * j] = a.x; s0[2 * j + 1] = a.y; s1[2 * j] = c.x; s1[2 * j + 1] = c.y;
                }
                if (k0 == q0) {
#pragma unroll
                    for (int i = 0; i < 16; ++i) if (crow(i, h2) > r) s0[i] = -INFINITY;
                }
                if (k0 + 32 == q0) {
#pragma unroll
                    for (int i = 0; i < 16; ++i) if (crow(i, h2) > r) s1[i] = -INFINITY;
                }
                float mx0 = fmaxf(s0[0], s0[1]), mx1 = fmaxf(s1[0], s1[1]);
#pragma unroll
                for (int j = 1; j < 8; ++j) { mx0 = fmaxf(fmaxf(s0[2 * j], s0[2 * j + 1]), mx0); mx1 = fmaxf(fmaxf(s1[2 * j], s1[2 * j + 1]), mx1); }
                float mx = sub1 ? fmaxf(mx0 + off0, mx1 + off1) : mx0 + off0;
                mx = xhalf_max(mx);
                if (__builtin_amdgcn_ballot_w64(mx > m + 8.0f) != 0ull) {
                    const float mn = fmaxf(m, mx);
                    const float alpha = __builtin_amdgcn_exp2f(m - mn);
                    m = mn; l *= alpha;
#pragma unroll
                    for (int mt = 0; mt < 4; ++mt)
#pragma unroll
                        for (int i = 0; i < 16; ++i) O[mt][i] *= alpha;
                }
                const float r0 = m - off0, r1 = sub1 ? m - off1 : INFINITY;
                const f32x2 r0v = {r0, r0}, r1v = {r1, r1};
                f32x2 lsv = {0.f, 0.f};
#pragma unroll
                for (int j = 0; j < 8; ++j) {
                    f32x2 a = {s0[2 * j], s0[2 * j + 1]}, c = {s1[2 * j], s1[2 * j + 1]};
                    a = a - r0v; c = c - r1v;
                    a.x = __builtin_amdgcn_exp2f(a.x); a.y = __builtin_amdgcn_exp2f(a.y); c.x = __builtin_amdgcn_exp2f(c.x); c.y = __builtin_amdgcn_exp2f(c.y);
                    lsv = lsv + a; lsv = lsv + c;
                    s0[2 * j] = a.x; s0[2 * j + 1] = a.y; s1[2 * j] = c.x; s1[2 * j + 1] = c.y;
                }
                l += lsv.x + lsv.y;
                bf16x8 pf[4];
#pragma unroll
                for (int s = 0; s < 2; ++s) { pf[s] = pack8(s0, s); pf[2 + s] = pack8(s1, s); }
                __builtin_amdgcn_sched_barrier(0);
                bf16x8 vc[4], vd[4];
                if (sub1) {
#pragma unroll
                    for (int mt = 0; mt < 4; ++mt) vc[mt] = *(const LAS bf16x8*)(vb + mt * 4096 + foff[2]);
                }
#pragma unroll
                for (int mt = 0; mt < 4; ++mt) O[mt] = MFMA32(va[mt], pf[0], O[mt]);
                if (sub1) {
#pragma unroll
                    for (int mt = 0; mt < 4; ++mt) vd[mt] = *(const LAS bf16x8*)(vb + mt * 4096 + foff[3]);
                }
#pragma unroll
                for (int mt = 0; mt < 4; ++mt) O[mt] = MFMA32(va[4 + mt], pf[1], O[mt]);
                if (sub1) {
#pragma unroll
                    for (int mt = 0; mt < 4; ++mt) O[mt] = MFMA32(vc[mt], pf[2], O[mt]);
#pragma unroll
                    for (int mt = 0; mt < 4; ++mt) O[mt] = MFMA32(vd[mt], pf[3], O[mt]);
                }
            }
        }
        asm volatile("" ::: "memory");
        __builtin_amdgcn_s_barrier();
        asm volatile("" ::: "memory");
#undef AT_STAGE
        const float lt = xhalf_sum(l);
        int lane_o = lane; asm volatile("" : "+v"(lane_o));
        LAS unsigned* o1l = (LAS unsigned*)(lds + AT_O1 + wid * 8192) + lane_o;
        if (map == 0) {
            const float inv1 = 1.0f / lt;
#pragma unroll
            for (int mt = 0; mt < 4; ++mt)
#pragma unroll
                for (int j = 0; j < 8; ++j) o1l[(mt * 8 + j) * 64] = pk_bf16(O[mt][2 * j] * inv1, O[mt][2 * j + 1] * inv1);
        } else {
            const float inv2 = lam / lt;
            float ss = 0.f;
#pragma unroll
            for (int mt = 0; mt < 4; ++mt)
#pragma unroll
                for (int j = 0; j < 8; ++j) {
                    const unsigned o1 = o1l[(mt * 8 + j) * 64];
                    const float a = bf_lo(o1) - O[mt][2 * j] * inv2, c = bf_hi(o1) - O[mt][2 * j + 1] * inv2;
                    O[mt][2 * j] = a; O[mt][2 * j + 1] = c; ss += a * a + c * c;
                }
            ss = xhalf_sum(ss);
            const float rs = rsqrtf(ss * (1.0f / 128.0f) + EPS) * 0.8f;
#pragma unroll
            for (int mt = 0; mt < 4; ++mt)
#pragma unroll
                for (int j = 0; j < 8; ++j) o1l[(mt * 8 + j) * 64] = pk_bf16(O[mt][2 * j] * rs, O[mt][2 * j + 1] * rs);
            __builtin_amdgcn_wave_barrier();
            int lane_e = lane; asm volatile("" : "+v"(lane_e));
            const int dvg = lane_e & 15, qs = lane_e >> 4;
            const f32x4 nw0 = *(const f32x4*)(p.diff_norm_w + 8 * dvg), nw1 = *(const f32x4*)(p.diff_norm_w + 8 * dvg + 4);
            const LAS unsigned* ob = (const LAS unsigned*)(lds + AT_O1 + wid * 8192);
            const int slot = (dvg >> 2) * 8 + 2 * (dvg & 3);
            u32x4 dzv[8];
#pragma unroll
            for (int it = 0; it < 8; ++it) dzv[it] = *(const u32x4*)(P1 + (tokbase + q0 + it * 4 + qs) * NP1 + C_DZ + hh * 128 + 8 * dvg);
#pragma unroll
            for (int it = 0; it < 8; ++it) {
                const int q = it * 4 + qs; const size_t row = tokbase + q0 + q;
                const unsigned u0 = ob[slot * 64 + q], u1 = ob[(slot + 1) * 64 + q], u2 = ob[slot * 64 + q + 32], u3 = ob[(slot + 1) * 64 + q + 32];
                const u32x4 dz = dzv[it];
                u32x4 w;
                w.x = pk_bf16(bf_lo(u0) * nw0[0] * silu_f(bf_lo(dz.x)), bf_hi(u0) * nw0[1] * silu_f(bf_hi(dz.x)));
                w.y = pk_bf16(bf_lo(u1) * nw0[2] * silu_f(bf_lo(dz.y)), bf_hi(u1) * nw0[3] * silu_f(bf_hi(dz.y)));
                w.z = pk_bf16(bf_lo(u2) * nw1[0] * silu_f(bf_lo(dz.z)), bf_hi(u2) * nw1[1] * silu_f(bf_hi(dz.z)));
                w.w = pk_bf16(bf_lo(u3) * nw1[2] * silu_f(bf_lo(dz.w)), bf_hi(u3) * nw1[3] * silu_f(bf_hi(dz.w)));
                *(u32x4*)(mix + row * DM + 512 + hh * 128 + 8 * dvg) = w;
            }
            __builtin_amdgcn_wave_barrier();
        }
    }
}

DI void phase_attn(const Params& p, LAS unsigned char* lds, int rep) {
    const float lam = *(const float*)(p.ws + OFF_MISC);
    unsigned* counter = (unsigned*)(p.ws + OFF_MISC + 4 + 4 * rep);
    LAS int* tslot = (LAS int*)(lds + AT_TASK);
    for (;;) {
        if (threadIdx.x == 0) *tslot = (int)atomicAdd(counter, 1u);
        __syncthreads();
        const int t = *tslot;
        __syncthreads();
        if (t >= 512) break;
        const int qb = 7 - (t >> 6), bh = t & 63;
        attn_qblock(p, lds, bh >> 2, bh & 3, qb, lam);
    }
}


constexpr int G_QN = 0, G_KN = 17408, G_VB = 34816, G_KBG = 52224, G_M = 69632, G_T = 86016, G_SM = 95232;
DI bf16x8 tr_pair(const LAS unsigned char* lo_addr, int hi_off) {
    const s16x4 lo = __builtin_amdgcn_ds_read_tr16_b64_v4i16((LAS s16x4*)(lo_addr));
    const s16x4 hi = __builtin_amdgcn_ds_read_tr16_b64_v4i16((LAS s16x4*)(lo_addr + hi_off));
    return __builtin_shufflevector(lo, hi, 0, 1, 2, 3, 4, 5, 6, 7);
}
DI bf16_t bf16_1(float v) { return (bf16_t)(pk_bf16(v, 0.f) & 0xffffu); }

DI void gdn_gates(const Params& p, LAS float* sm, int c2, int lane) {
    const int b = c2 >> 7, hh = (c2 >> 5) & 3, n = c2 & 31;
    const size_t tok0 = (size_t)b * SEQ + (size_t)n * 64;
    const float* gg = (const float*)(p.ws + OFF_GBGA) + (tok0 + lane) * 8;
    const float gbv = gg[hh], gav = gg[4 + hh];
    const float beta = 1.0f / (1.0f + expf(-gbv));
    const float xs = gav + p.dt_bias[hh];
    const float sp = fmaxf(xs, 0.f) + log1pf(expf(-fabsf(xs)));
    float gc = -expf(p.a_log[hh]) * sp;
#pragma unroll
    for (int o = 1; o < 64; o <<= 1) { const float t = __shfl_up(gc, o); if (lane >= o) gc += t; }
    const float gl = __shfl(gc, 63);
    sm[lane] = beta; sm[64 + lane] = gc * LOG2E; sm[128 + lane] = expf(gc); sm[192 + lane] = expf(gl - gc);
    if (lane == 63) ((float*)(p.ws + OFF_GL))[c2] = expf(gl);
}

DI void gdn_prep(const Params& p, LAS unsigned char* lds, int c2, int c2next, int par) {
    int tid = threadIdx.x; asm volatile("" : "+v"(tid));
    const int lane = tid & 63, wid = __builtin_amdgcn_readfirstlane(tid >> 6), r = lane & 31, h2 = lane >> 5;
    const int b = c2 >> 7, hh = (c2 >> 5) & 3, n = c2 & 31;
    const size_t tok0 = (size_t)b * SEQ + (size_t)n * 64;
    const bf16_t* P1 = (const bf16_t*)(p.ws + OFF_P1);
    LAS float* sm = (LAS float*)(lds + G_SM + par * 1024);
    LAS float* Mf = (LAS float*)(lds + G_M);
    bf16_t* WN = (bf16_t*)(p.ws + OFF_WN) + (size_t)c2 * 8192;
    bf16_t* QD = (bf16_t*)(p.ws + OFF_QD) + (size_t)c2 * 8192;
    bf16_t* KD = (bf16_t*)(p.ws + OFF_KD) + (size_t)c2 * 8192;
    bf16_t* AQ = (bf16_t*)(p.ws + OFF_AQK) + (size_t)c2 * 4096;
    float* U = (float*)(p.ws + OFF_U) + (size_t)c2 * 8192;
    u32x4 raw[6][4];
#pragma unroll
    for (int i = 0; i < 6; ++i) {
        const int item = tid + 512 * i, g = item & 15, t = (item >> 4) & 63, part = i >> 1;
        const int ch = part * 512 + hh * 128 + g * 8;
#pragma unroll
        for (int j = 0; j < 4; ++j) {
            const int tt = n * 64 + t - 3 + j, ttc = tt < 0 ? 0 : tt;
            raw[i][j] = *(const u32x4*)(P1 + ((size_t)b * SEQ + ttc) * NP1 + ch);
            if (tt < 0) raw[i][j] = (u32x4){0u, 0u, 0u, 0u};
        }
    }
    float av[6][8];
#pragma unroll
    for (int i = 0; i < 6; ++i) {
        const int item = tid + 512 * i, g = item & 15, part = i >> 1;
        const int ch = part * 512 + hh * 128 + g * 8;
        float a[8];
#pragma unroll
        for (int e = 0; e < 8; ++e) a[e] = 0.f;
#pragma unroll
        for (int j = 0; j < 4; ++j) {
            const f32x4 w0 = *(const f32x4*)(p.conv_w + j * 1536 + ch), w1 = *(const f32x4*)(p.conv_w + j * 1536 + ch + 4);
            const u32x4 rw = raw[i][j];
            a[0] += w0[0] * bf_lo(rw.x); a[1] += w0[1] * bf_hi(rw.x); a[2] += w0[2] * bf_lo(rw.y); a[3] += w0[3] * bf_hi(rw.y);
            a[4] += w1[0] * bf_lo(rw.z); a[5] += w1[1] * bf_hi(rw.z); a[6] += w1[2] * bf_lo(rw.w); a[7] += w1[3] * bf_hi(rw.w);
        }
        float ss = 0.f;
#pragma unroll
        for (int e = 0; e < 8; ++e) { a[e] = silu_f(a[e]); ss += a[e] * a[e]; }
        float rn = 1.0f;
        if (part < 2) {
            ss += __shfl_xor(ss, 1); ss += __shfl_xor(ss, 2); ss += __shfl_xor(ss, 4); ss += __shfl_xor(ss, 8);
            rn = rsqrtf(ss + 1e-6f) * (part == 0 ? 0.08838834764831845f : 1.0f);
        }
#pragma unroll
        for (int e = 0; e < 8; ++e) av[i][e] = a[e] * rn;
    }
#pragma unroll
    for (int i = 0; i < 6; ++i) {
        const int item = tid + 512 * i, g = item & 15, t = (item >> 4) & 63, part = i >> 1;
        const float* a = av[i];
        const float beta = sm[t], egc = sm[128 + t], ekd = sm[192 + t];
        if (part < 2) {
            u32x4 w; w.x = pk_bf16(a[0], a[1]); w.y = pk_bf16(a[2], a[3]); w.z = pk_bf16(a[4], a[5]); w.w = pk_bf16(a[6], a[7]);
            *(LAS u32x4*)(lds + (part == 0 ? G_QN : G_KN) + t * 272 + g * 16) = w;
            if (part == 0) {
                u32x2 lo, hi; lo.x = pk_bf16(a[0] * egc, a[1] * egc); lo.y = pk_bf16(a[2] * egc, a[3] * egc); hi.x = pk_bf16(a[4] * egc, a[5] * egc); hi.y = pk_bf16(a[6] * egc, a[7] * egc);
                bf16_t* qd = QD + t * 128 + 16 * (g >> 1) + 4 * (g & 1);
                *(u32x2*)qd = lo; *(u32x2*)(qd + 8) = hi;
            } else {
                const float f1 = beta * egc;
                u32x4 w2; w2.x = pk_bf16(a[0] * f1, a[1] * f1); w2.y = pk_bf16(a[2] * f1, a[3] * f1); w2.z = pk_bf16(a[4] * f1, a[5] * f1); w2.w = pk_bf16(a[6] * f1, a[7] * f1);
                *(LAS u32x4*)(lds + G_KBG + t * 272 + g * 16) = w2;
                u32x4 w3; w3.x = pk_bf16(a[0] * ekd, a[1] * ekd); w3.y = pk_bf16(a[2] * ekd, a[3] * ekd); w3.z = pk_bf16(a[4] * ekd, a[5] * ekd); w3.w = pk_bf16(a[6] * ekd, a[7] * ekd);
                *(u32x4*)(KD + t * 128 + g * 8) = w3;
            }
        } else {
            u32x4 w; w.x = pk_bf16(a[0] * beta, a[1] * beta); w.y = pk_bf16(a[2] * beta, a[3] * beta); w.z = pk_bf16(a[4] * beta, a[5] * beta); w.w = pk_bf16(a[6] * beta, a[7] * beta);
            *(LAS u32x4*)(lds + G_VB + t * 272 + g * 16) = w;
        }
    }
    __syncthreads();
    {
        const int w4 = wid & 3, mt = w4 >> 1, nt = w4 & 1; const bool isqk = wid >= 4;
        if (!(mt == 0 && nt == 1)) {
            const LAS unsigned char* Ab = lds + (isqk ? G_QN : G_KN) + (32 * mt + r) * 272 + 16 * h2;
            const LAS unsigned char* Bb = lds + G_KN + (32 * nt + r) * 272 + 16 * h2;
            bf16x8 fa[8], fb[8];
#pragma unroll
            for (int ks = 0; ks < 8; ++ks) { fa[ks] = *(const LAS bf16x8*)(Ab + 32 * ks); fb[ks] = *(const LAS bf16x8*)(Bb + 32 * ks); }
            f32x16 X;
#pragma unroll
            for (int i = 0; i < 16; ++i) X[i] = 0.f;
            if (!isqk) {
#pragma unroll
                for (int ks = 0; ks < 8; ++ks) X = MFMA32(fa[ks], fb[ks], X);
                const int s = 32 * nt + r; const float gcs = sm[64 + s];
#pragma unroll
                for (int i = 0; i < 16; ++i) {
                    const int c = 32 * mt + crow(i, h2);
                    const float dec = __builtin_amdgcn_exp2f(sm[64 + c] - gcs);
                    Mf[c * 64 + s] = (c > s) ? sm[c] * X[i] * dec : 0.f;
                }
            } else {
#pragma unroll
                for (int ks = 0; ks < 8; ++ks) X = MFMA32(fb[ks], fa[ks], X);
                const int c = 32 * mt + r; const float gcc = sm[64 + c];
#pragma unroll
                for (int g4 = 0; g4 < 4; ++g4) {
                    const int s0 = 32 * nt + 8 * g4 + 4 * h2;
                    float v[4];
#pragma unroll
                    for (int e = 0; e < 4; ++e) { const int sx = s0 + e; const float dec = __builtin_amdgcn_exp2f(gcc - sm[64 + sx]); v[e] = (c >= sx) ? X[4 * g4 + e] * dec : 0.f; }
                    u32x2 w; w.x = pk_bf16(v[0], v[1]); w.y = pk_bf16(v[2], v[3]);
                    *(u32x2*)(AQ + c * 64 + perm23(s0)) = w;
                }
            }
        }
    }
    __syncthreads();
    if (wid == 0) {
        LAS bf16_t* Tb = (LAS bf16_t*)(lds + G_T);
        {
            const int c16 = lane & 15, b16 = lane >> 4;
            const LAS float* Mb = Mf + (16 * b16) * 64 + 16 * b16;
            float T[16];
#pragma unroll
            for (int i = 0; i < 16; ++i) T[i] = 0.f;
#pragma unroll
            for (int i = 0; i < 16; ++i) {
                float a0 = (i == c16) ? 1.f : 0.f, a1 = 0.f, a2 = 0.f, a3 = 0.f;
#pragma unroll
                for (int s4 = 0; s4 < (i + 3) / 4; ++s4) {
                    const f32x4 m4 = *(const LAS f32x4*)(Mb + i * 64 + 4 * s4);
                    a0 -= m4[0] * T[4 * s4]; a1 -= m4[1] * T[4 * s4 + 1]; a2 -= m4[2] * T[4 * s4 + 2]; a3 -= m4[3] * T[4 * s4 + 3];
                }
                T[i] = (a0 + a1) + (a2 + a3);
            }
#pragma unroll
            for (int i = 0; i < 16; ++i) {
                const int row = 16 * b16 + i;
                Tb[row * 72 + 16 * b16 + c16] = bf16_1(T[i]);
                if ((b16 & 1) == 0) Tb[row * 72 + 16 * b16 + 16 + c16] = 0;
                if (b16 < 2) { Tb[row * 72 + 32 + c16] = 0; Tb[row * 72 + 48 + c16] = 0; }
            }
        }
        __builtin_amdgcn_wave_barrier();
        asm volatile("s_waitcnt lgkmcnt(0)" ::: "memory");
        {
            const int qd = r >> 4, rr = r & 15;
            bf16x8 mfrag;
            { const LAS float* mp = Mf + (16 + 32 * qd + rr) * 64 + 32 * qd + 8 * h2;
              const f32x4 m0 = *(const LAS f32x4*)mp, m1 = *(const LAS f32x4*)(mp + 4);
              u32x4 aw; aw.x = pk_bf16(m0[0], m0[1]); aw.y = pk_bf16(m0[2], m0[3]); aw.z = pk_bf16(m1[0], m1[1]); aw.w = pk_bf16(m1[2], m1[3]);
              mfrag = __builtin_bit_cast(bf16x8, aw); }
            bf16x8 tfrag;
#pragma unroll
            for (int j = 0; j < 8; ++j) tfrag[j] = (short)Tb[(32 * qd + 8 * h2 + j) * 72 + 32 * qd + rr];
            bf16x8 t2frag;
            { const LAS unsigned char* tp = lds + G_T + (16 + 32 * qd + rr) * 144 + (16 + 32 * qd + 4 * h2) * 2;
              const u32x2 lo = *(const LAS u32x2*)tp, hi = *(const LAS u32x2*)(tp + 16);
              u32x4 aw; aw.x = lo.x; aw.y = lo.y; aw.z = hi.x; aw.w = hi.y; t2frag = __builtin_bit_cast(bf16x8, aw); }
            const bf16x8 zf = {0, 0, 0, 0, 0, 0, 0, 0};
            f32x16 Y1, Z1;
#pragma unroll
            for (int i = 0; i < 16; ++i) { Y1[i] = 0.f; Z1[i] = 0.f; }
#pragma unroll
            for (int ks = 0; ks < 2; ++ks) Y1 = MFMA32(qd == ks ? mfrag : zf, qd == ks ? tfrag : zf, Y1);
#pragma unroll
            for (int s2 = 0; s2 < 2; ++s2) Z1 = MFMA32(qd == s2 ? t2frag : zf, pack8(Y1, s2), Z1);
#pragma unroll
            for (int i = 0; i < 16; ++i) {
                const int row = crow(i, h2);
                if ((row >> 4) == qd) Tb[(16 + 32 * qd + (row & 15)) * 72 + 32 * qd + rr] = bf16_1(-Z1[i]);
            }
        }
        __builtin_amdgcn_wave_barrier();
        asm volatile("s_waitcnt lgkmcnt(0)" ::: "memory");
        const int i16 = lane & 15, q = i16 >> 2, pp = i16 & 3, blk = (lane >> 4) & 1;
        f32x16 Y;
#pragma unroll
        for (int i = 0; i < 16; ++i) Y[i] = 0.f;
#pragma unroll
        for (int ks = 0; ks < 2; ++ks) {
            const LAS float* mp = Mf + (32 + r) * 64 + 16 * ks + 8 * h2;
            const f32x4 m0 = *(const LAS f32x4*)mp, m1 = *(const LAS f32x4*)(mp + 4);
            u32x4 aw; aw.x = pk_bf16(m0[0], m0[1]); aw.y = pk_bf16(m0[2], m0[3]); aw.z = pk_bf16(m1[0], m1[1]); aw.w = pk_bf16(m1[2], m1[3]);
            const bf16x8 bfrag = tr_pair(lds + G_T + (16 * ks + 8 * h2 + q) * 144 + (16 * blk + 4 * pp) * 2, 4 * 144);
            Y = MFMA32(__builtin_bit_cast(bf16x8, aw), bfrag, Y);
        }
        f32x16 Z;
#pragma unroll
        for (int i = 0; i < 16; ++i) Z[i] = 0.f;
#pragma unroll
        for (int s = 0; s < 2; ++s) {
            const LAS unsigned char* tp = lds + G_T + (32 + r) * 144 + (32 + 16 * s + 4 * h2) * 2;
            const u32x2 lo = *(const LAS u32x2*)tp, hi = *(const LAS u32x2*)(tp + 16);
            u32x4 aw; aw.x = lo.x; aw.y = lo.y; aw.z = hi.x; aw.w = hi.y;
            Z = MFMA32(__builtin_bit_cast(bf16x8, aw), pack8(Y, s), Z);
        }
#pragma unroll
        for (int i = 0; i < 16; ++i) Tb[(32 + crow(i, h2)) * 72 + r] = bf16_1(-Z[i]);
    } else if (wid == 1) {
        if (c2next < 2048) gdn_gates(p, (LAS float*)(lds + G_SM + (par ^ 1) * 1024), c2next, lane);
    }
    __syncthreads();
    {
        const int mt = wid >> 2, nt = wid & 3;
        const int i16 = lane & 15, q = i16 >> 2, pp = i16 & 3, blk = (lane >> 4) & 1;
        bf16x8 af[4], vf[4], kf[4];
#pragma unroll
        for (int ks = 0; ks < 4; ++ks) {
            if (ks < 2 * (mt + 1)) {
                af[ks] = *(const LAS bf16x8*)(lds + G_T + (32 * mt + r) * 144 + (16 * ks + 8 * h2) * 2);
                const int boff = (16 * ks + 8 * h2 + q) * 272 + (32 * nt + 16 * blk + 4 * pp) * 2;
                vf[ks] = tr_pair(lds + G_VB + boff, 4 * 272);
                kf[ks] = tr_pair(lds + G_KBG + boff, 4 * 272);
            }
        }
        f32x16 Xu, Xw;
#pragma unroll
        for (int i = 0; i < 16; ++i) { Xu[i] = 0.f; Xw[i] = 0.f; }
#pragma unroll
        for (int ks = 0; ks < 4; ++ks) {
            if (ks < 2 * (mt + 1)) {
                Xu = MFMA32(af[ks], vf[ks], Xu);
                Xw = MFMA32(kf[ks], af[ks], Xw);
            }
        }
        {
            float* up = U + (nt * 2 + mt) * 1024 + lane * 4;
#pragma unroll
            for (int k = 0; k < 4; ++k) { const f32x4 v = {Xu[4 * k], Xu[4 * k + 1], Xu[4 * k + 2], Xu[4 * k + 3]}; *(f32x4*)(up + 256 * k) = v; }
        }
        const int c = 32 * mt + r;
#pragma unroll
        for (int g4 = 0; g4 < 4; ++g4) {
            const int d0 = 32 * nt + 8 * g4 + 4 * h2;
            u32x2 w; w.x = pk_bf16(-Xw[4 * g4], -Xw[4 * g4 + 1]); w.y = pk_bf16(-Xw[4 * g4 + 2], -Xw[4 * g4 + 3]);
            *(u32x2*)(WN + c * 128 + perm23(d0)) = w;
        }
    }
    __syncthreads();
}

constexpr int S_WN = 0, S_QD = 17408, S_KD = 34816, S_AQ = 52224, S_BUF = 61440, S_STG = 2 * S_BUF;

struct GateIn { u32x4 z0, z1; };
DI void scan_gate_load(const Params& p, int tid, int b, int hh, int n, GateIn& g) {
    const int gc_ = tid >> 3, seg = tid & 7;
    const bf16_t* P1 = (const bf16_t*)(p.ws + OFF_P1);
    const size_t row = (size_t)b * SEQ + n * 64 + gc_;
    g.z0 = *(const u32x4*)(P1 + row * NP1 + C_GZ + hh * 128 + seg * 8); g.z1 = *(const u32x4*)(P1 + row * NP1 + C_GZ + hh * 128 + 64 + seg * 8);
}
DI void scan_gate(const Params& p, LAS unsigned char* lds, int tid, int b, int hh, int n, const GateIn& g) {
    const int gc_ = tid >> 3, seg = tid & 7;
    bf16_t* mix = (bf16_t*)(p.ws + OFF_HB);
    const LAS float* st = (const LAS float*)(lds + S_STG) + gc_ * 132 + seg * 8;
    f32x4 ov[4]; float ss = 0.f;
#pragma unroll
    for (int k = 0; k < 4; ++k) { ov[k] = *(const LAS f32x4*)(st + (k >> 1) * 64 + 4 * (k & 1)); ss += ov[k][0] * ov[k][0] + ov[k][1] * ov[k][1] + ov[k][2] * ov[k][2] + ov[k][3] * ov[k][3]; }
    ss += __shfl_xor(ss, 1); ss += __shfl_xor(ss, 2); ss += __shfl_xor(ss, 4);
    const float rstd = rsqrtf(ss * (1.0f / 128.0f) + EPS);
    const size_t row = (size_t)b * SEQ + n * 64 + gc_;
    const u32x4 z0 = g.z0, z1 = g.z1;
    f32x4 gnw[4];
#pragma unroll
    for (int k = 0; k < 4; ++k) gnw[k] = *(const f32x4*)(p.gdn_norm_w + seg * 8 + (k >> 1) * 64 + 4 * (k & 1));
    u32x4 w0, w1;
    w0.x = pk_bf16(ov[0][0] * rstd * gnw[0][0] * silu_f(bf_lo(z0.x)), ov[0][1] * rstd * gnw[0][1] * silu_f(bf_hi(z0.x)));
    w0.y = pk_bf16(ov[0][2] * rstd * gnw[0][2] * silu_f(bf_lo(z0.y)), ov[0][3] * rstd * gnw[0][3] * silu_f(bf_hi(z0.y)));
    w0.z = pk_bf16(ov[1][0] * rstd * gnw[1][0] * silu_f(bf_lo(z0.z)), ov[1][1] * rstd * gnw[1][1] * silu_f(bf_hi(z0.z)));
    w0.w = pk_bf16(ov[1][2] * rstd * gnw[1][2] * silu_f(bf_lo(z0.w)), ov[1][3] * rstd * gnw[1][3] * silu_f(bf_hi(z0.w)));
    w1.x = pk_bf16(ov[2][0] * rstd * gnw[2][0] * silu_f(bf_lo(z1.x)), ov[2][1] * rstd * gnw[2][1] * silu_f(bf_hi(z1.x)));
    w1.y = pk_bf16(ov[2][2] * rstd * gnw[2][2] * silu_f(bf_lo(z1.y)), ov[2][3] * rstd * gnw[2][3] * silu_f(bf_hi(z1.y)));
    w1.z = pk_bf16(ov[3][0] * rstd * gnw[3][0] * silu_f(bf_lo(z1.z)), ov[3][1] * rstd * gnw[3][1] * silu_f(bf_hi(z1.z)));
    w1.w = pk_bf16(ov[3][2] * rstd * gnw[3][2] * silu_f(bf_lo(z1.w)), ov[3][3] * rstd * gnw[3][3] * silu_f(bf_hi(z1.w)));
    bf16_t* mp = mix + row * DM + hh * 128 + seg * 8;
    *(u32x4*)mp = w0; *(u32x4*)(mp + 64) = w1;
}

struct ScanRegs { u32x4 t0[4], t1[4], t2[4], t3[2]; };
DI void scan_fetch(ScanRegs& R, const bf16_t* WN, const bf16_t* QD, const bf16_t* KD, const bf16_t* AQ, int ltid) {
#pragma unroll
    for (int i = 0; i < 4; ++i) { const int pi = ltid + 256 * i; R.t0[i] = *(const u32x4*)(WN + pi * 8); R.t1[i] = *(const u32x4*)(QD + pi * 8); R.t2[i] = *(const u32x4*)(KD + pi * 8); }
#pragma unroll
    for (int i = 0; i < 2; ++i) { const int pi = ltid + 256 * i; R.t3[i] = *(const u32x4*)(AQ + pi * 8); }
}
DI void scan_put(const ScanRegs& R, LAS unsigned char* dst, int ltid) {
#pragma unroll
    for (int i = 0; i < 4; ++i) { const int pi = ltid + 256 * i, row = pi >> 4, pc = pi & 15;
        *(LAS u32x4*)(dst + S_WN + row * 272 + pc * 16) = R.t0[i]; *(LAS u32x4*)(dst + S_QD + row * 272 + pc * 16) = R.t1[i]; *(LAS u32x4*)(dst + S_KD + row * 272 + pc * 16) = R.t2[i]; }
#pragma unroll
    for (int i = 0; i < 2; ++i) { const int pi = ltid + 256 * i, row = pi >> 3, pc = pi & 7; *(LAS u32x4*)(dst + S_AQ + row * 144 + pc * 16) = R.t3[i]; }
}

DI void gdn_scan(const Params& p, LAS unsigned char* lds, int bh) {
    int tid = threadIdx.x; asm volatile("" : "+v"(tid));
    const int lane = tid & 63, wid = __builtin_amdgcn_readfirstlane(tid >> 6), r = lane & 31, h2 = lane >> 5;
    const int b = bh >> 2, hh = bh & 3;
    const bf16_t* WN = (const bf16_t*)(p.ws + OFF_WN) + (size_t)bh * 32 * 8192;
    const bf16_t* QD = (const bf16_t*)(p.ws + OFF_QD) + (size_t)bh * 32 * 8192;
    const bf16_t* KD = (const bf16_t*)(p.ws + OFF_KD) + (size_t)bh * 32 * 8192;
    const bf16_t* AQ = (const bf16_t*)(p.ws + OFF_AQK) + (size_t)bh * 32 * 4096;
    const float* U = (const float*)(p.ws + OFF_U) + (size_t)bh * 32 * 8192;
    const float* GL = (const float*)(p.ws + OFF_GL) + bh * 32;
    if (wid >= 4) {
        const int ltid = tid & 255;
        ScanRegs R;
        scan_fetch(R, WN, QD, KD, AQ, ltid); scan_put(R, lds, ltid);
        scan_fetch(R, WN + 8192, QD + 8192, KD + 8192, AQ + 4096, ltid);
#pragma unroll 1
        for (int n = 0; n < 32; ++n) {
            __syncthreads();
            GateIn gi; scan_gate_load(p, tid, b, hh, n, gi);
            if (n + 1 < 32) scan_put(R, lds + ((n + 1) & 1) * S_BUF, ltid);
            if (n + 2 < 32) scan_fetch(R, WN + (size_t)(n + 2) * 8192, QD + (size_t)(n + 2) * 8192, KD + (size_t)(n + 2) * 8192, AQ + (size_t)(n + 2) * 4096, ltid);
            __syncthreads();
            scan_gate(p, lds, tid, b, hh, n, gi);
        }
    } else {
        const int i16 = lane & 15, q4 = i16 >> 2, pp = i16 & 3, blk = (lane >> 4) & 1;
        f32x16 St[4], u[2];
#pragma unroll
        for (int k = 0; k < 4; ++k)
#pragma unroll
            for (int i = 0; i < 16; ++i) St[k][i] = 0.f;
#pragma unroll
        for (int mt = 0; mt < 2; ++mt)
#pragma unroll
            for (int k = 0; k < 4; ++k) { const f32x4 v = *(const f32x4*)(U + (wid * 2 + mt) * 1024 + 256 * k + lane * 4); u[mt][4 * k] = v[0]; u[mt][4 * k + 1] = v[1]; u[mt][4 * k + 2] = v[2]; u[mt][4 * k + 3] = v[3]; }
#pragma unroll 1
        for (int n = 0; n < 32; ++n) {
            LAS unsigned char* buf = lds + (n & 1) * S_BUF;
            __syncthreads();
            GateIn gi; scan_gate_load(p, tid, b, hh, n, gi);
            const float egl = GL[n];
            f32x16 vn[2], o[2];
            vn[0] = u[0]; vn[1] = u[1];
#pragma unroll
            for (int mt = 0; mt < 2; ++mt)
#pragma unroll
                for (int i = 0; i < 16; ++i) o[mt][i] = 0.f;
#pragma unroll
            for (int ks = 0; ks < 8; ++ks) {
                const bf16x8 sf = pack8(St[ks >> 1], ks & 1);
#pragma unroll
                for (int mt = 0; mt < 2; ++mt) {
                    const bf16x8 wf = *(const LAS bf16x8*)(buf + S_WN + (32 * mt + r) * 272 + (16 * ks + 8 * h2) * 2);
                    vn[mt] = MFMA32(wf, sf, vn[mt]);
                    const bf16x8 qf = *(const LAS bf16x8*)(buf + S_QD + (32 * mt + r) * 272 + (16 * ks + 8 * h2) * 2);
                    o[mt] = MFMA32(qf, sf, o[mt]);
                }
                asm volatile("" ::: "memory");
            }
            bf16x8 vf[4];
#pragma unroll
            for (int k2 = 0; k2 < 4; ++k2) vf[k2] = pack8(vn[k2 >> 1], k2 & 1);
            {
                const int nn = (n + 1 < 32) ? n + 1 : n;
                const float* up = U + (size_t)nn * 8192 + (wid * 2) * 1024 + lane * 4;
#pragma unroll
                for (int mt = 0; mt < 2; ++mt)
#pragma unroll
                    for (int k = 0; k < 4; ++k) { const f32x4 v = *(const f32x4*)(up + mt * 1024 + 256 * k); u[mt][4 * k] = v[0]; u[mt][4 * k + 1] = v[1]; u[mt][4 * k + 2] = v[2]; u[mt][4 * k + 3] = v[3]; }
            }
#pragma unroll
            for (int mt = 0; mt < 2; ++mt)
#pragma unroll
                for (int k2 = 0; k2 < 2 * (mt + 1); ++k2) {
                    const bf16x8 af = *(const LAS bf16x8*)(buf + S_AQ + (32 * mt + r) * 144 + (16 * k2 + 8 * h2) * 2);
                    o[mt] = MFMA32(af, vf[k2], o[mt]);
                }
            {
                LAS float* st = (LAS float*)(lds + S_STG);
#pragma unroll
                for (int mt = 0; mt < 2; ++mt)
#pragma unroll
                    for (int i = 0; i < 16; ++i) st[(32 * mt + crow(i, h2)) * 132 + 32 * wid + r] = o[mt][i];
            }
#pragma unroll
            for (int kt = 0; kt < 4; ++kt) {
#pragma unroll
                for (int i = 0; i < 16; ++i) St[kt][i] *= egl;
#pragma unroll
                for (int k2 = 0; k2 < 4; ++k2) {
                    const bf16x8 kf = tr_pair(buf + S_KD + (16 * k2 + 4 * h2 + q4) * 272 + (32 * kt + 16 * blk + 4 * pp) * 2, 8 * 272);
                    St[kt] = MFMA32(kf, vf[k2], St[kt]);
                }
                asm volatile("" ::: "memory");
            }
            __syncthreads();
            scan_gate(p, lds, tid, b, hh, n, gi);
        }
    }
    __syncthreads();
}

DI void zero_mix_half(const Params& p, int half) {
    bf16_t* mix = (bf16_t*)(p.ws + OFF_HB);
    const size_t n16 = (size_t)MTOK * 64;
    for (size_t i = (size_t)blockIdx.x * 512 + threadIdx.x; i < n16; i += (size_t)gridDim.x * 512) {
        const size_t row = i >> 6, pc = i & 63;
        *(u32x4*)(mix + row * DM + half * 512 + pc * 8) = (u32x4){0u, 0u, 0u, 0u};
    }
}

DI void phase_final(const Params& p) {
    int tid = threadIdx.x; asm volatile("" : "+v"(tid));
    const int lane = tid & 63, wid = tid >> 6;
    const float* rowsq = (const float*)(p.ws + OFF_ROWSQ);
    const bf16_t* yb = (const bf16_t*)(p.ws + OFF_YB);
    const int gw = blockIdx.x * 8 + wid, nw = gridDim.x * 8;
    f32x4 fw[4];
#pragma unroll
    for (int i = 0; i < 2; ++i) { fw[2 * i] = *(const f32x4*)(p.final_norm_w + 512 * i + 8 * lane); fw[2 * i + 1] = *(const f32x4*)(p.final_norm_w + 512 * i + 8 * lane + 4); }
#pragma unroll 1
    for (int row0 = gw; row0 < MTOK; row0 += 4 * nw) {
        u32x4 y[4][2]; float sq[4];
#pragma unroll
        for (int k = 0; k < 4; ++k) {
            const int row = row0 + k * nw, rc = row < MTOK ? row : row0;
#pragma unroll
            for (int i = 0; i < 2; ++i) y[k][i] = *(const u32x4*)(yb + (size_t)rc * DM + 512 * i + 8 * lane);
            sq[k] = lane < 16 ? rowsq[(size_t)rc * 16 + lane] : 0.f;
        }
#pragma unroll
        for (int k = 0; k < 4; ++k) {
            const int row = row0 + k * nw;
            const float ss = wave_sum(sq[k]);
            const float rstd = rsqrtf(ss * (1.0f / DM) + EPS);
            if (row < MTOK) {
                float* o = p.out + (size_t)row * DM;
#pragma unroll
                for (int i = 0; i < 2; ++i) {
                    const f32x4 a = {bf_lo(y[k][i].x), bf_hi(y[k][i].x), bf_lo(y[k][i].y), bf_hi(y[k][i].y)}, c = {bf_lo(y[k][i].z), bf_hi(y[k][i].z), bf_lo(y[k][i].w), bf_hi(y[k][i].w)};
                    *(f32x4*)(o + 512 * i + 8 * lane) = a * rstd * fw[2 * i];
                    *(f32x4*)(o + 512 * i + 8 * lane + 4) = c * rstd * fw[2 * i + 1];
                }
            }
        }
    }
}

__global__ void __launch_bounds__(512) mega(Params p) {
    extern __shared__ __attribute__((aligned(16))) unsigned char shm[];
    LAS unsigned char* lds = (LAS unsigned char*)shm;
    cg::grid_group grid = cg::this_grid();
    volatile LAS unsigned* bst = (volatile LAS unsigned*)(lds + LDS_BYTES - 16);
    if (threadIdx.x < 2) bst[threadIdx.x] = 0u;
    __syncthreads();
    const XcdBarrier xb = xcd_barrier_post((unsigned*)(p.ws + OFF_BAR), bst);
    if (p.ws == nullptr) grid.sync();

#pragma unroll 1
    for (int rep = 0; rep < REP_PREP; ++rep) phase_prep(p, lds);
    xcd_barrier(xb);
#pragma unroll 1
    for (int rep = 0; rep < REP_G1; ++rep)
    {
        pg8::Gemm g{(const bf16_t*)(p.ws + OFF_HB), (const bf16_t*)(p.ws + OFF_WINT), MTOK, NG1, DM};
        pg8::StaticOrder S; S.init(g.M, g.N, (int)gridDim.x, (int)blockIdx.x);
        pg8::EpiP1 E{(bf16_t*)(p.ws + OFF_P1), NP1, (bf16_t*)(p.ws + OFF_KX)};
        pg8::gemm_phase<pg8::EpiP1, false>(lds, g, S, E);
        pg8::Gemm g2{(const bf16_t*)(p.ws + OFF_HB), (const bf16_t*)(p.ws + OFF_WINT) + (size_t)NG1 * DM, MTOK, 512, DM};
        pg8::StaticOrder S2; S2.init(g2.M, g2.N, (int)gridDim.x, (int)blockIdx.x);
        pg8::EpiVT E2{(bf16_t*)(p.ws + OFF_VT)};
        pg8::gemm_phase<pg8::EpiVT, true>(lds, g2, S2, E2);
    }
    xcd_barrier(xb);
#pragma unroll 1
    for (int rep = 0; rep < REP_GP; ++rep)
    {
        if ((threadIdx.x >> 6) == 0 && (int)blockIdx.x < 2048) gdn_gates(p, (LAS float*)(lds + G_SM), blockIdx.x, threadIdx.x & 63);
        __syncthreads();
        int par = 0;
#pragma unroll 1
        for (int c2 = blockIdx.x; c2 < 2048; c2 += gridDim.x, par ^= 1) gdn_prep(p, lds, c2, c2 + (int)gridDim.x, par);
    }
    xcd_barrier(xb);
#pragma unroll 1
    for (int rep = 0; rep < REP_P3; ++rep) {
#pragma unroll 1
        for (int r2 = 0; r2 < REP_SCAN; ++r2)
            if (blockIdx.x < 64) gdn_scan(p, lds, blockIdx.x);
#if SCAN_SYNC
        xcd_barrier(xb);
#endif
        phase_attn(p, lds, rep);
#if REP_ATTN > 1
        xcd_barrier(xb);
        phase_attn(p, lds, 2);
#endif
#if REP_P3 > 1
        xcd_barrier(xb);
#endif
    }
    xcd_barrier(xb);
#pragma unroll 1
    for (int rnd = 0; rnd < 2; ++rnd) {
        pg8::Gemm g{(const bf16_t*)(p.ws + OFF_HB), (const bf16_t*)(p.ws + OFF_WOUTT), MTOK, DM, DM};
        pg8::StaticOrder S; S.init(g.M, g.N, (int)gridDim.x, (int)blockIdx.x); S.i0 = rnd; S.imax = 1;
        pg8::EpiOutFused E{p.x, p.out, (float*)(p.ws + OFF_ROWSQ), p.final_norm_w, xb};
        pg8::Unit u0;
        if (S.next(0, u0)) pg8::gemm_phase<pg8::EpiOutFused, false>(lds, g, S, E);
        else xcd_barrier(xb);
    }
}

extern "C" void kernel_launch(void* const* d_in, const int* in_sizes, int n_in, void* d_out, int out_size, void* d_ws, size_t ws_size, hipStream_t stream) {
    static int grid = 0;
    if (grid == 0) {
        if (ws_size < WS_END) { fprintf(stderr, "kernel_launch: workspace too small (%zu < %zu)\n", ws_size, (size_t)WS_END); grid = -1; return; }
        int dev = 0, cus = 0, per_cu = 0;
        hipGetDevice(&dev);
        hipDeviceGetAttribute(&cus, hipDeviceAttributeMultiprocessorCount, dev);
        if (hipFuncSetAttribute((const void*)mega, hipFuncAttributeMaxDynamicSharedMemorySize, LDS_BYTES) != hipSuccess) { fprintf(stderr, "kernel_launch: hipFuncSetAttribute failed\n"); grid = -1; return; }
        if (hipOccupancyMaxActiveBlocksPerMultiprocessor(&per_cu, (const void*)mega, 512, LDS_BYTES) != hipSuccess || per_cu < 1) per_cu = 1;
        (void)hipGetLastError();
        grid = cus * (per_cu > 1 ? 1 : per_cu);
    }
    if (grid < 0) return;
    Params p{};
    p.x = (const float*)d_in[0]; p.norm_w = (const float*)d_in[1]; p.w_in = (const float*)d_in[2]; p.conv_w = (const float*)d_in[3];
    p.a_log = (const float*)d_in[4]; p.dt_bias = (const float*)d_in[5]; p.gdn_norm_w = (const float*)d_in[6];
    p.lq1 = (const float*)d_in[7]; p.lk1 = (const float*)d_in[8]; p.lq2 = (const float*)d_in[9]; p.lk2 = (const float*)d_in[10];
    p.diff_norm_w = (const float*)d_in[11]; p.w_out = (const float*)d_in[12]; p.final_norm_w = (const float*)d_in[13];
    p.out = (float*)d_out; p.ws = (unsigned char*)d_ws;
    if (hipMemsetAsync((unsigned char*)d_ws + OFF_BAR, 0, 16384, stream) != hipSuccess) { fprintf(stderr, "kernel_launch: hipMemsetAsync failed\n"); return; }
    void* args[] = {&p};
    hipError_t e = hipLaunchCooperativeKernel((const void*)mega, dim3(grid), dim3(512), args, LDS_BYTES, stream);
    if (e != hipSuccess) fprintf(stderr, "cooperative launch failed: %s (grid %d)\n", hipGetErrorString(e), grid);
}
```

```cpp
#include <hip/hip_runtime.h>
#include <hip/hip_cooperative_groups.h>
#include <cstdio>
namespace cg = cooperative_groups;

#ifndef ENABLE_ATTN
#define ENABLE_ATTN 1
#endif
#ifndef ENABLE_GDN
#define ENABLE_GDN 1
#endif
#ifndef REP_PREP
#define REP_PREP 1
#endif
#ifndef REP_G1
#define REP_G1 1
#endif
#ifndef REP_GP
#define REP_GP 1
#endif
#ifndef REP_P3
#define REP_P3 1
#endif
#ifndef REP_G2
#define REP_G2 1
#endif
#ifndef REP_SCAN
#define REP_SCAN 1
#endif
#ifndef SCAN_SYNC
#define SCAN_SYNC 0
#endif
#ifndef REP_ATTN
#define REP_ATTN 1
#endif

#define LAS __attribute__((address_space(3)))
#define DI __device__ __forceinline__
typedef unsigned short bf16_t;
typedef short bf16x8 __attribute__((ext_vector_type(8)));
typedef short s16x4 __attribute__((ext_vector_type(4)));
typedef float f32x2 __attribute__((ext_vector_type(2)));
typedef float f32x4 __attribute__((ext_vector_type(4)));
typedef float f32x16 __attribute__((ext_vector_type(16)));
typedef unsigned u32x2 __attribute__((ext_vector_type(2)));
typedef unsigned u32x4 __attribute__((ext_vector_type(4)));
typedef __bf16 bf16x2_t __attribute__((ext_vector_type(2)));

#define MFMA32(a, b, c) __builtin_amdgcn_mfma_f32_32x32x16_bf16((a), (b), (c), 0, 0, 0)

constexpr int NB = 16, SEQ = 2048, DM = 1024, MTOK = NB * SEQ, NP1 = 3072, NG1 = 3584;
constexpr int C_GQ = 0, C_GK = 512, C_GV = 1024, C_GZ = 1536, C_DQ = 2048, C_DZ = 2560;
constexpr float EPS = 1e-6f;
constexpr float LOG2E = 1.4426950408889634f;

constexpr size_t OFF_HB = 0;
constexpr size_t OFF_WINT = OFF_HB + (size_t)MTOK * DM * 2;
constexpr size_t OFF_WOUTT = OFF_WINT + (size_t)4096 * 1024 * 2;
constexpr size_t OFF_GBGA = OFF_WOUTT + (size_t)1024 * 1024 * 2;
constexpr size_t OFF_P1 = OFF_GBGA + (size_t)MTOK * 8 * 4;
constexpr size_t OFF_KX = OFF_P1 + (size_t)MTOK * NP1 * 2;
constexpr size_t OFF_VT = OFF_KX + (size_t)64 * 2 * 2048 * 64 * 2;
constexpr size_t OFF_WN = OFF_VT + (size_t)64 * 128 * 2048 * 2;
constexpr size_t OFF_QD = OFF_WN + (size_t)2048 * 64 * 128 * 2;
constexpr size_t OFF_KD = OFF_QD + (size_t)2048 * 64 * 128 * 2;
constexpr size_t OFF_AQK = OFF_KD + (size_t)2048 * 64 * 128 * 2;
constexpr size_t OFF_U = OFF_AQK + (size_t)2048 * 64 * 64 * 2;
constexpr size_t OFF_GL = OFF_U + (size_t)2048 * 64 * 128 * 4;
constexpr size_t OFF_ROWSQ = OFF_GL + 8192;
constexpr size_t OFF_MISC = OFF_ROWSQ + (size_t)MTOK * 16 * 4;
constexpr size_t OFF_YB = OFF_P1;
constexpr size_t OFF_BAR = OFF_MISC + 256;
constexpr size_t WS_END = OFF_BAR + 16384;

constexpr int LDS_BYTES = 156 * 1024;

struct Params {
    const float *x, *norm_w, *w_in, *conv_w, *a_log, *dt_bias, *gdn_norm_w, *lq1, *lk1, *lq2, *lk2, *diff_norm_w, *w_out, *final_norm_w;
    float* out; unsigned char* ws;
};

DI unsigned pk_bf16(float a, float b) { f32x2 v = {a, b}; bf16x2_t r = __builtin_convertvector(v, bf16x2_t); return __builtin_bit_cast(unsigned, r); }
DI float bf_lo(unsigned u) { return __uint_as_float(u << 16); }
DI float bf_hi(unsigned u) { return __uint_as_float(u & 0xffff0000u); }
DI float wave_sum(float v) {
#pragma unroll
    for (int o = 32; o; o >>= 1) v += __shfl_xor(v, o);
    return v;
}
DI float xhalf_max(float v) {
    const u32x2 r = __builtin_amdgcn_permlane32_swap(__float_as_uint(v), __float_as_uint(v), false, false);
    return fmaxf(__uint_as_float(r.x), __uint_as_float(r.y));
}
DI float xhalf_sum(float v) {
    const u32x2 r = __builtin_amdgcn_permlane32_swap(__float_as_uint(v), __float_as_uint(v), false, false);
    return __uint_as_float(r.x) + __uint_as_float(r.y);
}
DI float silu_f(float z) { return z * __builtin_amdgcn_rcpf(1.0f + __builtin_amdgcn_exp2f(-LOG2E * z)); }
DI int perm23(int t) { return (t & ~12) | ((t & 4) << 1) | ((t & 8) >> 1); }
DI int crow(int i, int h2) { return (i & 3) + 8 * (i >> 2) + 4 * h2; }
DI bf16x8 pack8(const f32x16& x, int s) {
    u32x4 w; w.x = pk_bf16(x[8 * s + 0], x[8 * s + 1]); w.y = pk_bf16(x[8 * s + 2], x[8 * s + 3]); w.z = pk_bf16(x[8 * s + 4], x[8 * s + 5]); w.w = pk_bf16(x[8 * s + 6], x[8 * s + 7]);
    return __builtin_bit_cast(bf16x8, w);
}


#define XB_TMO      128
#define XB_XCNT(j)  (256  + 64 * (j))
#define XB_XSUB(j)  (1280 + 64 * (j))
#define XB_XGEN(j)  (2304 + 64 * (j))
#define XB_TOP      3328
#define XB_TOPGEN   3392
#define XCD_BAR_WORDS 3456
#define XB_SPIN_CAP (1u << 18)
struct XcdBarrier { unsigned* bar; unsigned x; volatile LAS unsigned* st; };
DI unsigned xb_ld(unsigned* p)              { return __hip_atomic_load(p, __ATOMIC_RELAXED, __HIP_MEMORY_SCOPE_AGENT); }
DI unsigned xb_add(unsigned* p, unsigned v) { return __hip_atomic_fetch_add(p, v, __ATOMIC_RELAXED, __HIP_MEMORY_SCOPE_AGENT); }
DI unsigned xb_xcc_id() { return (unsigned)__builtin_amdgcn_s_getreg((3 << 11) | 20) & 0xFu; }
#define XB_SPIN(cond, bar) do { unsigned _sp = 0; while (cond) { __builtin_amdgcn_s_sleep(1); \
    if ((++_sp & 255u) == 0u) { if (xb_ld(&(bar)[XB_TMO])) break; if (_sp > XB_SPIN_CAP) { atomicAdd(&(bar)[XB_TMO], 1u); break; } } } } while (0)
DI XcdBarrier xcd_barrier_post(unsigned* bar, volatile LAS unsigned* st) {
    XcdBarrier b; b.bar = bar; b.x = xb_xcc_id(); b.st = st;
    if (threadIdx.x == 0) (void)xb_add(&bar[XB_XCNT(b.x)], 1u);
    return b;
}
DI void xcd_barrier_complete(unsigned* bar, unsigned x, unsigned& nloc, unsigned& nx) {
    const unsigned G = gridDim.x * gridDim.y * gridDim.z;
    unsigned sum, cnt, mine, sp = 0u;
    for (;;) {
        sum = 0u; cnt = 0u; mine = 0u;
#pragma unroll
        for (unsigned j = 0; j < 16; ++j) { const unsigned c = xb_ld(&bar[XB_XCNT(j)]); sum += c; cnt += (c > 0u) ? 1u : 0u; mine = (j == x) ? c : mine; }
        if (sum == G) break;
        __builtin_amdgcn_s_sleep(1);
        if ((++sp & 255u) == 0u) { if (xb_ld(&bar[XB_TMO])) break; if (sp > XB_SPIN_CAP) { atomicAdd(&bar[XB_TMO], 1u); break; } }
    }
    nloc = mine > 0u ? mine : 1u; nx = cnt > 0u ? cnt : 1u;
}
DI void xcd_barrier(const XcdBarrier& b) {
    asm volatile("s_waitcnt vmcnt(0)" ::: "memory");
    __syncthreads();
    if (threadIdx.x == 0) {
        unsigned* bar = b.bar;
        __builtin_amdgcn_s_waitcnt(0);
        unsigned nloc = b.st[0], nx = b.st[1];
        if (nloc == 0u) { xcd_barrier_complete(bar, b.x, nloc, nx); b.st[0] = nloc; b.st[1] = nx; }
        const unsigned old = xb_add(&bar[XB_XSUB(b.x)], 1u);
        const unsigned gen = old / nloc;
        if (old + 1u == (gen + 1u) * nloc) {
            __builtin_amdgcn_fence(__ATOMIC_RELEASE, "agent");
            asm volatile("s_waitcnt vmcnt(0)" ::: "memory");
            const unsigned og = xb_add(&bar[XB_TOP], 1u);
            const unsigned tg = og / nx;
            if (og + 1u == (tg + 1u) * nx) xb_add(&bar[XB_TOPGEN], 1u);
            else XB_SPIN(xb_ld(&bar[XB_TOPGEN]) == tg, bar);
            __builtin_amdgcn_fence(__ATOMIC_ACQUIRE, "agent");
            xb_add(&bar[XB_XGEN(b.x)], 1u);
            asm volatile("s_waitcnt vmcnt(0)" ::: "memory");
        } else {
            XB_SPIN(xb_ld(&bar[XB_XGEN(b.x)]) == gen, bar);
            __builtin_amdgcn_fence(__ATOMIC_ACQUIRE, "agent");
            asm volatile("s_waitcnt vmcnt(0)" ::: "memory");
        }
    }
    __syncthreads();
}

namespace pg8 {
constexpr int BM = 256, BK = 64, HALF = 128, HTB = HALF * BK * 2, STAGE_BYTES = 8 * HTB, NXCD = 8, WGM = 8;
DI int lds_byte(int r, int c) { const int st = (r >> 4) * 2 + (c >> 5), rr = r & 15, cc = c & 31, ob = rr * 64 + cc * 2; return st * 1024 + (ob ^ (((ob >> 9) & 1) << 5)); }
DI void stage_rc(int b, int& R, int& C) { const int st = b / 1024, sb = b % 1024, swz = sb ^ (((sb >> 9) & 1) << 5); R = (st >> 1) * 16 + swz / 64; C = (st & 1) * 32 + (swz % 64) / 2; }
DI int perm32(int rho) { const int n = rho >> 4, i = rho & 15; return 8 * (i >> 2) + 4 * n + (i & 3); }
struct Unit { int pm, pn; };
struct Gemm { const bf16_t* A; const bf16_t* Bt; int M, N, K; };
struct StaticOrder {
    int nM, nN, nwg, G, c, i0 = 0, imax = 1 << 30;
    DI void init(int M, int N, int G_, int c_) { nM = M / BM; nN = N / BM; nwg = nM * nN; G = G_; c = c_; }
    DI bool next(int i, Unit& u) const {
        if (i >= imax) return false;
        const long L = (long)(i + i0) * G + c; if (L >= nwg) return false;
        int wgid = (int)L; { const int q = nwg / NXCD, r = nwg % NXCD, xcd = wgid % NXCD, off = wgid / NXCD; wgid = (xcd < r ? xcd * (q + 1) : r * (q + 1) + (xcd - r) * q) + off; }
        const int nig = WGM * nN, gid = wgid / nig, fm = gid * WGM, gsz = (nM - fm) < WGM ? (nM - fm) : WGM;
        u.pm = fm + ((wgid % nig) % gsz); u.pn = (wgid % nig) / gsz; return true;
    }
    DI void a_ready(const Unit&) const {}
    DI void done(const Unit&) const {}
};

struct EpiP1 {
    static constexpr bool PERM = true, PERM16 = true, AFTER_DRAIN = false;
    bf16_t* O; int ldc; bf16_t* KX;
    DI void operator()(const f32x4 (&acc)[2][2][4][2], const Unit& u, int wr, int wc, int fr, int fq) const {
        const int row0 = u.pm * BM + wr * 64 + fr, col0 = u.pn * BM + wc * 64 + 8 * fq;
        if (u.pn >= 12) {
            const int c = col0 - 12 * BM, hm = c >> 6, d = c & 63;
#pragma unroll
            for (int ai = 0; ai < 2; ++ai)
#pragma unroll
                for (int m = 0; m < 4; ++m) { const int row = row0 + ai * HALF + m * 16, b = row >> 11, tok = row & 2047;
                    bf16_t* dp = KX + ((size_t)(b * 8 + hm) * 2048 + tok) * 64 + d;
#pragma unroll
                    for (int bj = 0; bj < 2; ++bj) { const f32x4 v0 = acc[ai][bj][m][0], v1 = acc[ai][bj][m][1];
                        u32x4 w; w.x = pk_bf16(v0[0], v0[1]); w.y = pk_bf16(v0[2], v0[3]); w.z = pk_bf16(v1[0], v1[1]); w.w = pk_bf16(v1[2], v1[3]);
                        *(u32x4*)(dp + 32 * bj) = w; } }
            return;
        }
#pragma unroll
        for (int ai = 0; ai < 2; ++ai)
#pragma unroll
            for (int m = 0; m < 4; ++m) { bf16_t* rowp = O + (size_t)(row0 + ai * HALF + m * 16) * ldc + col0;
#pragma unroll
                for (int bj = 0; bj < 2; ++bj) { const f32x4 v0 = acc[ai][bj][m][0], v1 = acc[ai][bj][m][1];
                    u32x4 w; w.x = pk_bf16(v0[0], v0[1]); w.y = pk_bf16(v0[2], v0[3]); w.z = pk_bf16(v1[0], v1[1]); w.w = pk_bf16(v1[2], v1[3]);
                    *(u32x4*)(rowp + 32 * bj) = w; } }
    }
};
struct EpiVT {
    static constexpr bool PERM = false, PERM16 = false, AFTER_DRAIN = false;
    bf16_t* VT;
    DI void operator()(const f32x4 (&acc)[2][2][4][2], const Unit& u, int wr, int wc, int fr, int fq) const {
#pragma unroll
        for (int ai = 0; ai < 2; ++ai)
#pragma unroll
            for (int m = 0; m < 4; ++m) {
                const int t = u.pm * BM + ai * HALF + wr * 64 + m * 16 + 4 * fq, b = t >> 11, tok = t & 2047, pos = perm23(tok);
#pragma unroll
                for (int bj = 0; bj < 2; ++bj)
#pragma unroll
                    for (int n = 0; n < 2; ++n) {
                        const int c = u.pn * BM + bj * HALF + wc * 32 + n * 16 + fr, hh = c >> 7, dv = c & 127;
                        const f32x4 v = acc[ai][bj][m][n];
                        u32x2 w; w.x = pk_bf16(v[0], v[1]); w.y = pk_bf16(v[2], v[3]);
                        *(u32x2*)(VT + (((size_t)((b * 4 + hh) * 32 + (pos >> 6)) * 128 + dv)) * 64 + (pos & 63)) = w;
                    }
            }
    }
};
static_assert(WGM == 8, "EpiOutFused needs the four column tiles of a row panel in the same round");
struct EpiOutFused {
    static constexpr bool PERM = false, PERM16 = false, AFTER_DRAIN = true;
    const float* X; float* Out; float* rowsq; const float* fw; XcdBarrier xb;
    DI void operator()(const f32x4 (&)[2][2][4][2], const Unit&, int, int, int, int) const {}
    DI void fused(f32x4 (&acc)[2][2][4][2], const Unit& u, int wr, int wc, int fr, int fq) const {
        const int row0 = u.pm * BM + wr * 64 + fr, col0 = u.pn * BM + wc * 32 + 4 * fq;
#pragma unroll
        for (int ai = 0; ai < 2; ++ai) {
            f32x4 xv[4][2][2];
#pragma unroll
            for (int m = 0; m < 4; ++m)
#pragma unroll
                for (int bj = 0; bj < 2; ++bj)
#pragma unroll
                    for (int n = 0; n < 2; ++n) xv[m][bj][n] = *(const f32x4*)(X + (size_t)(row0 + ai * HALF + m * 16) * DM + col0 + bj * HALF + n * 16);
            __builtin_amdgcn_sched_group_barrier(0x020, 16, 0);
            __builtin_amdgcn_sched_group_barrier(0x002, 400, 0);
#pragma unroll
            for (int m = 0; m < 4; ++m) {
                const int row = row0 + ai * HALF + m * 16; float ss = 0.f;
#pragma unroll
                for (int bj = 0; bj < 2; ++bj)
#pragma unroll
                    for (int n = 0; n < 2; ++n) {
                        const f32x4 y = acc[ai][bj][m][n] + xv[m][bj][n];
                        acc[ai][bj][m][n] = y; ss += y[0] * y[0] + y[1] * y[1] + y[2] * y[2] + y[3] * y[3];
                    }
                ss += __shfl_xor(ss, 16); ss += __shfl_xor(ss, 32);
                if (fq == 0) rowsq[(size_t)row * 16 + u.pn * 4 + wc] = ss;
            }
            __builtin_amdgcn_sched_barrier(0);
        }
        xcd_barrier(xb);
        f32x4 fwv[2][2];
#pragma unroll
        for (int bj = 0; bj < 2; ++bj)
#pragma unroll
            for (int n = 0; n < 2; ++n) fwv[bj][n] = *(const f32x4*)(fw + col0 + bj * HALF + n * 16);
#pragma unroll
        for (int ai = 0; ai < 2; ++ai)
#pragma unroll
            for (int m = 0; m < 4; ++m) {
                const int row = row0 + ai * HALF + m * 16;
                const f32x4* rq = (const f32x4*)(rowsq + (size_t)row * 16);
                const f32x4 q0 = rq[0], q1 = rq[1], q2 = rq[2], q3 = rq[3];
                const float tot = ((q0[0] + q0[1]) + (q0[2] + q0[3])) + ((q1[0] + q1[1]) + (q1[2] + q1[3])) + ((q2[0] + q2[1]) + (q2[2] + q2[3])) + ((q3[0] + q3[1]) + (q3[2] + q3[3]));
                const float rstd = rsqrtf(tot * (1.0f / DM) + EPS);
#pragma unroll
                for (int bj = 0; bj < 2; ++bj)
#pragma unroll
                    for (int n = 0; n < 2; ++n) {
                        const size_t o = (size_t)row * DM + col0 + bj * HALF + n * 16;
                        *(f32x4*)(Out + o) = acc[ai][bj][m][n] * rstd * fwv[bj][n];
                    }
            }
    }
};

template <class Epi, bool SWAP>
DI void gemm_phase(LAS unsigned char* lds, const Gemm g, const StaticOrder& S, const Epi& E) {
    int tid = threadIdx.x; asm volatile("" : "+v"(tid));
    const int wid = __builtin_amdgcn_readfirstlane(tid >> 6), lane = tid & 63, wr = wid >> 2, wc = wid & 3, fr = lane & 15, fq = lane >> 4;
    const int K = g.K, nt = K / BK;
    unsigned voffA[2], voffB[2], voffB1[2];
#pragma unroll
    for (int i = 0; i < 2; ++i) { int R, C; stage_rc(tid * 16 + i * 8192, R, C); const int Rb = Epi::PERM ? ((R & ~31) + perm32(R & 31)) : R;
        voffA[i] = (unsigned)(R * K + C) * 2u;
        if constexpr (Epi::PERM16) {
            const int c0 = 64 * (R >> 5) + 8 * ((R >> 2) & 3) + 4 * ((R >> 4) & 1) + (R & 3);
            voffB[i] = (unsigned)(c0 * K + C) * 2u; voffB1[i] = (unsigned)((c0 + 32) * K + C) * 2u;
        } else { voffB[i] = (unsigned)(Rb * K + C) * 2u; voffB1[i] = voffB[i]; } }
    const size_t kstep = (size_t)(BK * 2);
    const size_t hstep = (size_t)HALF * K * 2;
    const size_t tstep = 2 * hstep;
    const size_t hoff = Epi::PERM16 ? 0 : hstep;
    const unsigned ldsw = (unsigned)wid * 1024u;
    const int aoff = lds_byte(wr * 64 + fr, fq * 8), boff = lds_byte(wc * 32 + fr, fq * 8);
#define PG8_SA(b, h) (((b) * 2 + (h)) * HTB)
#define PG8_SB(b, h) ((4 + (b) * 2 + (h)) * HTB)
#define PG8_STAGE(bufoff, gbase, voff) do { _Pragma("unroll") for (int _i = 0; _i < 2; ++_i) \
        __builtin_amdgcn_global_load_lds((const unsigned*)((const char*)(gbase) + (voff)[_i]), (LAS unsigned*)(lds + (bufoff) + ldsw + _i * 8192), 16, 0, 0); } while (0)
#define PG8_LDA(dst, b, h) do { _Pragma("unroll") for (int m = 0; m < 4; ++m) _Pragma("unroll") for (int k = 0; k < 2; ++k) dst[m][k] = *(const LAS bf16x8*)(lds + PG8_SA(b, h) + aoff + m * 2048 + k * 1024); } while (0)
#define PG8_LDB(dst, b, h) do { _Pragma("unroll") for (int n = 0; n < 2; ++n) _Pragma("unroll") for (int k = 0; k < 2; ++k) dst[n][k] = *(const LAS bf16x8*)(lds + PG8_SB(b, h) + boff + n * 2048 + k * 1024); } while (0)
#define PG8_MMA(ai, bj, At, Bt) do { __builtin_amdgcn_s_setprio(1); _Pragma("unroll") for (int m = 0; m < 4; ++m) _Pragma("unroll") for (int n = 0; n < 2; ++n) _Pragma("unroll") for (int k = 0; k < 2; ++k) \
        acc[ai][bj][m][n] = SWAP ? __builtin_amdgcn_mfma_f32_16x16x32_bf16(At[m][k], Bt[n][k], acc[ai][bj][m][n], 0, 0, 0) \
                                 : __builtin_amdgcn_mfma_f32_16x16x32_bf16(Bt[n][k], At[m][k], acc[ai][bj][m][n], 0, 0, 0); __builtin_amdgcn_s_setprio(0); } while (0)
#define PG8_WAIT_V(n) asm volatile("s_waitcnt vmcnt(" #n ")" ::: "memory")
#define PG8_WAIT_L(n) asm volatile("s_waitcnt lgkmcnt(" #n ")" ::: "memory")
#define PG8_BAR __builtin_amdgcn_s_barrier()
#define PG8_SCHED __builtin_amdgcn_sched_barrier(0)
    Unit cur, nxt; int ui = 0;
    if (!S.next(0, cur)) return;
    f32x4 acc[2][2][4][2];
#pragma unroll
    for (int a = 0; a < 2; ++a)
#pragma unroll
        for (int b = 0; b < 2; ++b)
#pragma unroll
            for (int m = 0; m < 4; ++m)
#pragma unroll
                for (int n = 0; n < 2; ++n) acc[a][b][m][n] = (f32x4){0.f, 0.f, 0.f, 0.f};
    bf16x8 At[4][2], B0[2][2], B1[2][2];
    const char* cA = (const char*)g.A + (size_t)cur.pm * tstep; const char* cB = (const char*)g.Bt + (size_t)cur.pn * tstep;
    PG8_STAGE(PG8_SB(0, 0), cB, voffB); PG8_STAGE(PG8_SA(0, 0), cA, voffA); PG8_STAGE(PG8_SB(0, 1), cB + hoff, voffB1); PG8_STAGE(PG8_SA(0, 1), cA + hstep, voffA);
    if (wr == 1) PG8_BAR;
    PG8_WAIT_V(4); PG8_BAR;
    PG8_STAGE(PG8_SB(1, 0), cB + kstep, voffB); PG8_STAGE(PG8_SA(1, 0), cA + kstep, voffA); PG8_STAGE(PG8_SB(1, 1), cB + hoff + kstep, voffB1);
    PG8_WAIT_V(6); PG8_BAR;
    for (;;) {
        const bool has_next = S.next(ui + 1, nxt);
        const char* nA = has_next ? (const char*)g.A + (size_t)nxt.pm * tstep : cA; const char* nB = has_next ? (const char*)g.Bt + (size_t)nxt.pn * tstep : cB;
        for (int t = 0; t < nt; t += 2) {
            const bool last = (t == nt - 2);
            const char* a1 = cA + (size_t)(t + 1) * kstep;
            const char* a2 = last ? nA : cA + (size_t)(t + 2) * kstep; const char* b2 = last ? nB : cB + (size_t)(t + 2) * kstep;
            const char* a3 = a2 + kstep; const char* b3 = b2 + kstep;
            PG8_LDB(B0, 0, 0); PG8_SCHED; PG8_LDA(At, 0, 0); PG8_STAGE(PG8_SA(1, 1), a1 + hstep, voffA);
            PG8_WAIT_L(8); PG8_BAR; PG8_WAIT_L(0); PG8_MMA(0, 0, At, B0); PG8_BAR; PG8_SCHED;
            PG8_LDB(B1, 0, 1); PG8_STAGE(PG8_SB(0, 0), b2, voffB);
            PG8_BAR; PG8_WAIT_L(0); PG8_MMA(0, 1, At, B1); PG8_BAR;
            PG8_LDA(At, 0, 1); PG8_STAGE(PG8_SA(0, 0), a2, voffA);
            PG8_BAR; PG8_WAIT_L(0); PG8_MMA(1, 0, At, B0); PG8_BAR; PG8_SCHED;
            PG8_STAGE(PG8_SB(0, 1), b2 + hoff, voffB1);
            PG8_WAIT_V(6); PG8_BAR; PG8_MMA(1, 1, At, B1); PG8_BAR;
            PG8_LDB(B0, 1, 0); PG8_SCHED; PG8_LDA(At, 1, 0); PG8_STAGE(PG8_SA(0, 1), a2 + hstep, voffA);
            PG8_WAIT_L(8); PG8_BAR; PG8_WAIT_L(0); PG8_MMA(0, 0, At, B0); PG8_BAR; PG8_SCHED;
            PG8_LDB(B1, 1, 1); PG8_STAGE(PG8_SB(1, 0), b3, voffB);
            PG8_BAR; PG8_WAIT_L(0); PG8_MMA(0, 1, At, B1); PG8_BAR;
            PG8_LDA(At, 1, 1); PG8_STAGE(PG8_SA(1, 0), a3, voffA);
            PG8_BAR; PG8_WAIT_L(0); PG8_MMA(1, 0, At, B0); PG8_BAR; PG8_SCHED;
            PG8_STAGE(PG8_SB(1, 1), b3 + hoff, voffB1);
            PG8_WAIT_V(6); PG8_BAR; PG8_MMA(1, 1, At, B1); PG8_BAR;
        }
        if constexpr (!Epi::AFTER_DRAIN) E(acc, cur, wr, wc, fr, fq);
        if (!has_next) break;
#pragma unroll
        for (int a = 0; a < 2; ++a)
#pragma unroll
            for (int b = 0; b < 2; ++b)
#pragma unroll
                for (int m = 0; m < 4; ++m)
#pragma unroll
                    for (int n = 0; n < 2; ++n) acc[a][b][m][n] = (f32x4){0.f, 0.f, 0.f, 0.f};
        cur = nxt; cA = nA; cB = nB; ++ui;
    }
    PG8_WAIT_V(0);
    if (wr == 0) PG8_BAR;
    PG8_BAR;
    if constexpr (Epi::AFTER_DRAIN) E.fused(acc, cur, wr, wc, fr, fq);
#undef PG8_SA
#undef PG8_SB
#undef PG8_STAGE
#undef PG8_LDA
#undef PG8_LDB
#undef PG8_MMA
#undef PG8_WAIT_V
#undef PG8_WAIT_L
#undef PG8_BAR
#undef PG8_SCHED
}
}

DI int win_src_col(int n0) {
    if (n0 < 2048) return n0;
    if (n0 < 2560) return 2056 + (n0 - 2048);
    if (n0 < 3072) return 3592 + (n0 - 2560);
    if (n0 < 3584) return 2568 + (n0 - 3072);
    return 3080 + (n0 - 3584);
}
DI void phase_prep(const Params& p, LAS unsigned char* lds) {
    int tid = threadIdx.x; asm volatile("" : "+v"(tid));
    const int lane = tid & 63, wid = tid >> 6;
    if (blockIdx.x == 0 && wid == 0) {
        float a = p.lq1[lane] * p.lk1[lane], b = p.lq2[lane] * p.lk2[lane];
        a = wave_sum(a); b = wave_sum(b);
        if (lane == 0) { *(float*)(p.ws + OFF_MISC) = expf(a) - expf(b) + 0.2f; *(unsigned*)(p.ws + OFF_MISC + 4) = 0u; *(unsigned*)(p.ws + OFF_MISC + 8) = 0u; *(unsigned*)(p.ws + OFF_MISC + 12) = 0u; }
    }
    bf16_t* hb = (bf16_t*)(p.ws + OFF_HB);
    float* gbga = (float*)(p.ws + OFF_GBGA);
    const int gw = blockIdx.x * 8 + wid, nw = gridDim.x * 8;
    {
        f32x4 nwv[4]; float wq[16][8];
#pragma unroll
        for (int i = 0; i < 4; ++i) {
            nwv[i] = ((const f32x4*)p.norm_w)[lane + 64 * i];
#pragma unroll
            for (int e = 0; e < 4; ++e) {
                const int k = 4 * (lane + 64 * i) + e;
                const f32x4* wp = (const f32x4*)(p.w_in + (size_t)k * 4104 + 2048);
                const f32x4 w0 = wp[0], w1 = wp[1];
#pragma unroll
                for (int j = 0; j < 4; ++j) { wq[4 * i + e][j] = nwv[i][e] * w0[j]; wq[4 * i + e][4 + j] = nwv[i][e] * w1[j]; }
            }
        }
        const bool b5 = (lane & 32) != 0, b4 = (lane & 16) != 0, b3 = (lane & 8) != 0;
        const int col = (b5 ? 4 : 0) + (b4 ? 2 : 0) + (b3 ? 1 : 0);
        int row = gw;
        f32x4 v[4];
        if (row < MTOK) {
#pragma unroll
            for (int i = 0; i < 4; ++i) v[i] = __builtin_nontemporal_load((const f32x4*)(p.x + (size_t)row * DM) + lane + 64 * i);
        }
#pragma unroll 1
        for (; row < MTOK; row += nw) {
            f32x4 vnx[4];
            const int rnx = (row + nw < MTOK) ? row + nw : row;
#pragma unroll
            for (int i = 0; i < 4; ++i) vnx[i] = __builtin_nontemporal_load((const f32x4*)(p.x + (size_t)rnx * DM) + lane + 64 * i);
            float ss = 0.f, a8[8];
#pragma unroll
            for (int j = 0; j < 8; ++j) a8[j] = 0.f;
#pragma unroll
            for (int i = 0; i < 4; ++i)
#pragma unroll
                for (int e = 0; e < 4; ++e) {
                    ss += v[i][e] * v[i][e];
#pragma unroll
                    for (int j = 0; j < 8; ++j) a8[j] += v[i][e] * wq[4 * i + e][j];
                }
            ss = wave_sum(ss);
            const float rstd = rsqrtf(ss * (1.0f / DM) + EPS);
#pragma unroll
            for (int i = 0; i < 4; ++i) {
                const f32x4 h = v[i] * rstd * nwv[i];
                u32x2 w; w.x = pk_bf16(h[0], h[1]); w.y = pk_bf16(h[2], h[3]);
                *(u32x2*)(hb + (size_t)row * DM + 4 * (lane + 64 * i)) = w;
            }
            float c4[4], c2[2], c1;
#pragma unroll
            for (int j = 0; j < 4; ++j) { const float send = b5 ? a8[j] : a8[4 + j], keep = b5 ? a8[4 + j] : a8[j]; c4[j] = keep + __shfl_xor(send, 32); }
#pragma unroll
            for (int j = 0; j < 2; ++j) { const float send = b4 ? c4[j] : c4[2 + j], keep = b4 ? c4[2 + j] : c4[j]; c2[j] = keep + __shfl_xor(send, 16); }
            { const float send = b3 ? c2[0] : c2[1], keep = b3 ? c2[1] : c2[0]; c1 = keep + __shfl_xor(send, 8); }
            c1 += __shfl_xor(c1, 4); c1 += __shfl_xor(c1, 2); c1 += __shfl_xor(c1, 1);
            if ((lane & 7) == 0) gbga[(size_t)row * 8 + col] = c1 * rstd;
#pragma unroll
            for (int i = 0; i < 4; ++i) v[i] = vnx[i];
        }
    }
    LAS float* tl = (LAS float*)lds;
    for (int tile = blockIdx.x; tile < 1024 + 256; tile += gridDim.x) {
        const float* src; int ld, n0, k0, srcn0; bf16_t* dst;
        if (tile < 1024) { n0 = (tile >> 4) * 64; k0 = (tile & 15) * 64; srcn0 = win_src_col(n0); src = p.w_in; ld = 4104; dst = (bf16_t*)(p.ws + OFF_WINT); }
        else { const int t2 = tile - 1024; n0 = (t2 >> 4) * 64; k0 = (t2 & 15) * 64; srcn0 = n0; src = p.w_out; ld = 1024; dst = (bf16_t*)(p.ws + OFF_WOUTT); }
        const int kk = tid >> 4, n4 = tid & 15;
#pragma unroll
        for (int ps = 0; ps < 2; ++ps) { const int k = kk + 32 * ps;
            const f32x4 v = __builtin_nontemporal_load((const f32x4*)(src + (size_t)(k0 + k) * ld + srcn0 + 4 * n4));
#pragma unroll
            for (int e = 0; e < 4; ++e) tl[k * 65 + 4 * n4 + e] = v[e]; }
        __syncthreads();
        { const int n = tid >> 3, k8 = tid & 7; float f[8];
#pragma unroll
            for (int e = 0; e < 8; ++e) f[e] = tl[(8 * k8 + e) * 65 + n];
            u32x4 w; w.x = pk_bf16(f[0], f[1]); w.y = pk_bf16(f[2], f[3]); w.z = pk_bf16(f[4], f[5]); w.w = pk_bf16(f[6], f[7]);
            *(u32x4*)(dst + (size_t)(n0 + n) * 1024 + k0 + 8 * k8) = w; }
        __syncthreads();
    }
}

constexpr int AT_KB = 8192, AT_VB = 16384, AT_BUF = AT_KB + AT_VB, AT_NBUF = 3, AT_TASK = AT_NBUF * AT_BUF, AT_O1 = AT_TASK + 256;

DI void attn_qblock(const Params& p, LAS unsigned char* lds, int b, int hh, int qb, float lam) {
    int tid = threadIdx.x; asm volatile("" : "+v"(tid));
    const int lane = tid & 63, wid = __builtin_amdgcn_readfirstlane(tid >> 6);
    const bf16_t* P1 = (const bf16_t*)(p.ws + OFF_P1);
    const bf16_t* VT = (const bf16_t*)(p.ws + OFF_VT) + (size_t)(b * 4 + hh) * 32 * 128 * 64;
    const bf16_t* KX = (const bf16_t*)(p.ws + OFF_KX) + (size_t)(b * 4 + hh) * 2 * 2048 * 64;
    bf16_t* mix = (bf16_t*)(p.ws + OFF_HB);
    const int q0 = qb * 256 + wid * 32;
    const size_t tokbase = (size_t)b * SEQ;
    const int nkt = (qb + 1) * 4;
    const float sl2 = exp2f(-2.0f * (float)(hh + 1)) * LOG2E;
    const float c1 = 0.125f * LOG2E;
#pragma unroll 1
    for (int map = 0; map < 2; ++map) {
        f32x16 O[4];
#pragma unroll
        for (int mt = 0; mt < 4; ++mt)
#pragma unroll
            for (int i = 0; i < 16; ++i) O[mt][i] = 0.f;
        float m = -INFINITY, l = 0.f;
        int lane_m = lane; asm volatile("" : "+v"(lane_m));
        const int r = lane_m & 31, h2 = lane_m >> 5;
        int foff[4];
#pragma unroll
        for (int k = 0; k < 4; ++k) foff[k] = r * 128 + (((2 * k + h2) ^ ((r >> 1) & 7)) << 4);
        float kb[16];
#pragma unroll
        for (int i = 0; i < 16; ++i) kb[i] = sl2 * (float)crow(i, h2);
        const int krow_ = 8 * wid + (lane_m >> 3), vrow0 = 16 * wid + (lane_m >> 3), vrow1 = vrow0 + 8;
        const bf16_t* kgp = KX + ((size_t)map * 2048 + krow_) * 64 + (((lane_m & 7) ^ ((krow_ >> 1) & 7)) * 8);
        const bf16_t* vgp0 = VT + (size_t)vrow0 * 64 + (((lane_m & 7) ^ ((vrow0 >> 1) & 7)) * 8);
        const bf16_t* vgp1 = VT + (size_t)vrow1 * 64 + (((lane_m & 7) ^ ((vrow1 >> 1) & 7)) * 8);
#define AT_STAGE(bufi, tile) do { LAS unsigned char* _b = lds + (bufi) * AT_BUF; \
            __builtin_amdgcn_global_load_lds((const unsigned*)(kgp + (size_t)(tile) * 64 * 64), (LAS unsigned*)(_b + wid * 1024), 16, 0, 0); \
            __builtin_amdgcn_global_load_lds((const unsigned*)(vgp0 + (size_t)(tile) * 128 * 64), (LAS unsigned*)(_b + AT_KB + wid * 2048), 16, 0, 0); \
            __builtin_amdgcn_global_load_lds((const unsigned*)(vgp1 + (size_t)(tile) * 128 * 64), (LAS unsigned*)(_b + AT_KB + wid * 2048 + 1024), 16, 0, 0); } while (0)
        bf16x8 qf[4];
        { const bf16_t* qp = P1 + (tokbase + q0 + (lane_m & 31)) * NP1 + C_DQ + hh * 128 + map * 64 + 8 * (lane_m >> 5);
#pragma unroll
            for (int ks = 0; ks < 4; ++ks) qf[ks] = *(const bf16x8*)(qp + 16 * ks); }
        AT_STAGE(0, 0);
        AT_STAGE(1, 1);
        asm volatile("" : "+v"(qf[0]), "+v"(qf[1]), "+v"(qf[2]), "+v"(qf[3]));
        int cb = 0;
#pragma unroll 1
        for (int kt = 0; kt < nkt; ++kt) {
            asm volatile("s_waitcnt vmcnt(0)" ::: "memory");
            __builtin_amdgcn_s_barrier();
            asm volatile("" ::: "memory");
            if (kt + 2 < nkt) { const int nb = cb == 0 ? 2 : cb - 1; AT_STAGE(nb, kt + 2); }
            const LAS unsigned char* cur = lds + cb * AT_BUF;
            cb = cb == 2 ? 0 : cb + 1;
            const int k0 = kt * 64;
            if (k0 <= q0) {
                const bool sub1 = (k0 + 32 <= q0);
                const LAS unsigned char* vb = cur + AT_KB;
                bf16x8 kf[8];
#pragma unroll
                for (int ks = 0; ks < 4; ++ks) kf[ks] = *(const LAS bf16x8*)(cur + foff[ks]);
                if (sub1) {
#pragma unroll
                    for (int ks = 0; ks < 4; ++ks) kf[4 + ks] = *(const LAS bf16x8*)(cur + 4096 + foff[ks]);
                }
                f32x16 s0, s1;
#pragma unroll
                for (int i = 0; i < 16; ++i) { s0[i] = 0.f; s1[i] = 0.f; }
#pragma unroll
                for (int ks = 0; ks < 4; ++ks) s0 = MFMA32(kf[ks], qf[ks], s0);
                if (sub1) {
#pragma unroll
                    for (int ks = 0; ks < 4; ++ks) s1 = MFMA32(kf[4 + ks], qf[ks], s1);
                }
                __builtin_amdgcn_sched_barrier(0);
                bf16x8 va[8];
#pragma unroll
                for (int s2 = 0; s2 < 2; ++s2)
#pragma unroll
                    for (int mt = 0; mt < 4; ++mt) va[s2 * 4 + mt] = *(const LAS bf16x8*)(vb + mt * 4096 + foff[s2]);
                __builtin_amdgcn_sched_barrier(0);
                const float off0 = sl2 * (float)(k0 - q0), off1 = off0 + 32.0f * sl2;
                const f32x2 c1v = {c1, c1};
#pragma unroll
                for (int j = 0; j < 8; ++j) {
                    const f32x2 kv = {kb[2 * j], kb[2 * j + 1]};
                    f32x2 a = {s0[2 * j], s0[2 * j + 1]}, c = {s1[2 * j], s1[2 * j + 1]};
                    a = __builtin_elementwise_fma(a, c1v, kv); c = __builtin_elementwise_fma(c, c1v, kv);
                    s0[2 * j] = a.x; s0[2 * j + 1] = a.y; s1[2 * j] = c.x; s1[2 * j + 1] = c.y;
                }
                if (k0 == q0) {
#pragma unroll
                    for (int i = 0; i < 16; ++i) if (crow(i, h2) > r) s0[i] = -INFINITY;
                }
                if (k0 + 32 == q0) {
#pragma unroll
                    for (int i = 0; i < 16; ++i) if (crow(i, h2) > r) s1[i] = -INFINITY;
                }
                float mx0 = fmaxf(s0[0], s0[1]), mx1 = fmaxf(s1[0], s1[1]);
#pragma unroll
                for (int j = 1; j < 8; ++j) { mx0 = fmaxf(fmaxf(s0[2 * j], s0[2 * j + 1]), mx0); mx1 = fmaxf(fmaxf(s1[2 * j], s1[2 * j + 1]), mx1); }
                float mx = sub1 ? fmaxf(mx0 + off0, mx1 + off1) : mx0 + off0;
                mx = xhalf_max(mx);
                if (__builtin_amdgcn_ballot_w64(mx > m + 8.0f) != 0ull) {
                    const float mn = fmaxf(m, mx);
                    const float alpha = __builtin_amdgcn_exp2f(m - mn);
                    m = mn; l *= alpha;
#pragma unroll
                    for (int mt = 0; mt < 4; ++mt)
#pragma unroll
                        for (int i = 0; i < 16; ++i) O[mt][i] *= alpha;
                }
                const float r0 = m - off0, r1 = sub1 ? m - off1 : INFINITY;
                const f32x2 r0v = {r0, r0}, r1v = {r1, r1};
                f32x2 lsv = {0.f, 0.f};
#pragma unroll
                for (int j = 0; j < 8; ++j) {
                    f32x2 a = {s0[2 * j], s0[2 * j + 1]}, c = {s1[2 * j], s1[2 * j + 1]};
                    a = a - r0v; c = c - r1v;
                    a.x = __builtin_amdgcn_exp2f(a.x); a.y = __builtin_amdgcn_exp2f(a.y); c.x = __builtin_amdgcn_exp2f(c.x); c.y = __builtin_amdgcn_exp2f(c.y);
                    lsv = lsv + a; lsv = lsv + c;
                    s0[2 * j] = a.x; s0[2 * j + 1] = a.y; s1[2 * j] = c.x; s1[2 * j + 1] = c.y;
                }
                l += lsv.x + lsv.y;
                bf16x8 pf[4];
#pragma unroll
                for (int s = 0; s < 2; ++s) { pf[s] = pack8(s0, s); pf[2 + s] = pack8(s1, s); }
                __builtin_amdgcn_sched_barrier(0);
                bf16x8 vc[4], vd[4];
                if (sub1) {
#pragma unroll
                    for (int mt = 0; mt < 4; ++mt) vc[mt] = *(const LAS bf16x8*)(vb + mt * 4096 + foff[2]);
                }
#pragma unroll
                for (int mt = 0; mt < 4; ++mt) O[mt] = MFMA32(va[mt], pf[0], O[mt]);
                if (sub1) {
#pragma unroll
                    for (int mt = 0; mt < 4; ++mt) vd[mt] = *(const LAS bf16x8*)(vb + mt * 4096 + foff[3]);
                }
#pragma unroll
                for (int mt = 0; mt < 4; ++mt) O[mt] = MFMA32(va[4 + mt], pf[1], O[mt]);
                if (sub1) {
#pragma unroll
                    for (int mt = 0; mt < 4; ++mt) O[mt] = MFMA32(vc[mt], pf[2], O[mt]);
#pragma unroll
                    for (int mt = 0; mt < 4; ++mt) O[mt] = MFMA32(vd[mt], pf[3], O[mt]);
                }
            }
        }
        asm volatile("" ::: "memory");
        __builtin_amdgcn_s_barrier();
        asm volatile("" ::: "memory");
#undef AT_STAGE
        const float lt = xhalf_sum(l);
        int lane_o = lane; asm volatile("" : "+v"(lane_o));
        LAS unsigned* o1l = (LAS unsigned*)(lds + AT_O1 + wid * 8192) + lane_o;
        if (map == 0) {
            const float inv1 = 1.0f / lt;
#pragma unroll
            for (int mt = 0; mt < 4; ++mt)
#pragma unroll
                for (int j = 0; j < 8; ++j) o1l[(mt * 8 + j) * 64] = pk_bf16(O[mt][2 * j] * inv1, O[mt][2 * j + 1] * inv1);
        } else {
            const float inv2 = lam / lt;
            float ss = 0.f;
#pragma unroll
            for (int mt = 0; mt < 4; ++mt)
#pragma unroll
                for (int j = 0; j < 8; ++j) {
                    const unsigned o1 = o1l[(mt * 8 + j) * 64];
                    const float a = bf_lo(o1) - O[mt][2 * j] * inv2, c = bf_hi(o1) - O[mt][2 * j + 1] * inv2;
                    O[mt][2 * j] = a; O[mt][2 * j + 1] = c; ss += a * a + c * c;
                }
            ss = xhalf_sum(ss);
            const float rs = rsqrtf(ss * (1.0f / 128.0f) + EPS) * 0.8f;
#pragma unroll
            for (int mt = 0; mt < 4; ++mt)
#pragma unroll
                for (int j = 0; j < 8; ++j) o1l[(mt * 8 + j) * 64] = pk_bf16(O[mt][2 * j] * rs, O[mt][2 * j + 1] * rs);
            __builtin_amdgcn_wave_barrier();
            int lane_e = lane; asm volatile("" : "+v"(lane_e));
            const int dvg = lane_e & 15, qs = lane_e >> 4;
            const f32x4 nw0 = *(const f32x4*)(p.diff_norm_w + 8 * dvg), nw1 = *(const f32x4*)(p.diff_norm_w + 8 * dvg + 4);
            const LAS unsigned* ob = (const LAS unsigned*)(lds + AT_O1 + wid * 8192);
            const int slot = (dvg >> 2) * 8 + 2 * (dvg & 3);
            u32x4 dzv[8];
#pragma unroll
            for (int it = 0; it < 8; ++it) dzv[it] = *(const u32x4*)(P1 + (tokbase + q0 + it * 4 + qs) * NP1 + C_DZ + hh * 128 + 8 * dvg);
#pragma unroll
            for (int it = 0; it < 8; ++it) {
                const int q = it * 4 + qs; const size_t row = tokbase + q0 + q;
                const unsigned u0 = ob[slot * 64 + q], u1 = ob[(slot + 1) * 64 + q], u2 = ob[slot * 64 + q + 32], u3 = ob[(slot + 1) * 64 + q + 32];
                const u32x4 dz = dzv[it];
                u32x4 w;
                w.x = pk_bf16(bf_lo(u0) * nw0[0] * silu_f(bf_lo(dz.x)), bf_hi(u0) * nw0[1] * silu_f(bf_hi(dz.x)));
                w.y = pk_bf16(bf_lo(u1) * nw0[2] * silu_f(bf_lo(dz.y)), bf_hi(u1) * nw0[3] * silu_f(bf_hi(dz.y)));
                w.z = pk_bf16(bf_lo(u2) * nw1[0] * silu_f(bf_lo(dz.z)), bf_hi(u2) * nw1[1] * silu_f(bf_hi(dz.z)));
                w.w = pk_bf16(bf_lo(u3) * nw1[2] * silu_f(bf_lo(dz.w)), bf_hi(u3) * nw1[3] * silu_f(bf_hi(dz.w)));
                *(u32x4*)(mix + row * DM + 512 + hh * 128 + 8 * dvg) = w;
            }
            __builtin_amdgcn_wave_barrier();
        }
    }
}

DI void phase_attn(const Params& p, LAS unsigned char* lds, int rep) {
    const float lam = *(const float*)(p.ws + OFF_MISC);
    unsigned* counter = (unsigned*)(p.ws + OFF_MISC + 4 + 4 * rep);
    LAS int* tslot = (LAS int*)(lds + AT_TASK);
    for (;;) {
        if (threadIdx.x == 0) *tslot = (int)atomicAdd(counter, 1u);
        __syncthreads();
        const int t = *tslot;
        __syncthreads();
        if (t >= 512) break;
        const int qb = 7 - (t >> 6), bh = t & 63;
        attn_qblock(p, lds, bh >> 2, bh & 3, qb, lam);
    }
}


constexpr int G_QN = 0, G_KN = 17408, G_VB = 34816, G_KBG = 52224, G_M = 69632, G_T = 86016, G_SM = 95232;
DI bf16x8 tr_pair(const LAS unsigned char* lo_addr, int hi_off) {
    const s16x4 lo = __builtin_amdgcn_ds_read_tr16_b64_v4i16((LAS s16x4*)(lo_addr));
    const s16x4 hi = __builtin_amdgcn_ds_read_tr16_b64_v4i16((LAS s16x4*)(lo_addr + hi_off));
    return __builtin_shufflevector(lo, hi, 0, 1, 2, 3, 4, 5, 6, 7);
}
DI bf16_t bf16_1(float v) { return (bf16_t)(pk_bf16(v, 0.f) & 0xffffu); }

DI void gdn_gates(const Params& p, LAS float* sm, int c2, int lane) {
    const int b = c2 >> 7, hh = (c2 >> 5) & 3, n = c2 & 31;
    const size_t tok0 = (size_t)b * SEQ + (size_t)n * 64;
    const float* gg = (const float*)(p.ws + OFF_GBGA) + (tok0 + lane) * 8;
    const float gbv = gg[hh], gav = gg[4 + hh];
    const float beta = 1.0f / (1.0f + expf(-gbv));
    const float xs = gav + p.dt_bias[hh];
    const float sp = fmaxf(xs, 0.f) + log1pf(expf(-fabsf(xs)));
    float gc = -expf(p.a_log[hh]) * sp;
#pragma unroll
    for (int o = 1; o < 64; o <<= 1) { const float t = __shfl_up(gc, o); if (lane >= o) gc += t; }
    const float gl = __shfl(gc, 63);
    sm[lane] = beta; sm[64 + lane] = gc * LOG2E; sm[128 + lane] = expf(gc); sm[192 + lane] = expf(gl - gc);
    if (lane == 63) ((float*)(p.ws + OFF_GL))[c2] = expf(gl);
}

DI void gdn_prep(const Params& p, LAS unsigned char* lds, int c2, int c2next, int par) {
    int tid = threadIdx.x; asm volatile("" : "+v"(tid));
    const int lane = tid & 63, wid = __builtin_amdgcn_readfirstlane(tid >> 6), r = lane & 31, h2 = lane >> 5;
    const int b = c2 >> 7, hh = (c2 >> 5) & 3, n = c2 & 31;
    const size_t tok0 = (size_t)b * SEQ + (size_t)n * 64;
    const bf16_t* P1 = (const bf16_t*)(p.ws + OFF_P1);
    LAS float* sm = (LAS float*)(lds + G_SM + par * 1024);
    LAS float* Mf = (LAS float*)(lds + G_M);
    bf16_t* WN = (bf16_t*)(p.ws + OFF_WN) + (size_t)c2 * 8192;
    bf16_t* QD = (bf16_t*)(p.ws + OFF_QD) + (size_t)c2 * 8192;
    bf16_t* KD = (bf16_t*)(p.ws + OFF_KD) + (size_t)c2 * 8192;
    bf16_t* AQ = (bf16_t*)(p.ws + OFF_AQK) + (size_t)c2 * 4096;
    float* U = (float*)(p.ws + OFF_U) + (size_t)c2 * 8192;
    u32x4 raw[6][4];
#pragma unroll
    for (int i = 0; i < 6; ++i) {
        const int item = tid + 512 * i, g = item & 15, t = (item >> 4) & 63, part = i >> 1;
        const int ch = part * 512 + hh * 128 + g * 8;
#pragma unroll
        for (int j = 0; j < 4; ++j) {
            const int tt = n * 64 + t - 3 + j, ttc = tt < 0 ? 0 : tt;
            raw[i][j] = *(const u32x4*)(P1 + ((size_t)b * SEQ + ttc) * NP1 + ch);
            if (tt < 0) raw[i][j] = (u32x4){0u, 0u, 0u, 0u};
        }
    }
    float av[6][8];
#pragma unroll
    for (int i = 0; i < 6; ++i) {
        const int item = tid + 512 * i, g = item & 15, part = i >> 1;
        const int ch = part * 512 + hh * 128 + g * 8;
        float a[8];
#pragma unroll
        for (int e = 0; e < 8; ++e) a[e] = 0.f;
#pragma unroll
        for (int j = 0; j < 4; ++j) {
            const f32x4 w0 = *(const f32x4*)(p.conv_w + j * 1536 + ch), w1 = *(const f32x4*)(p.conv_w + j * 1536 + ch + 4);
            const u32x4 rw = raw[i][j];
            a[0] += w0[0] * bf_lo(rw.x); a[1] += w0[1] * bf_hi(rw.x); a[2] += w0[2] * bf_lo(rw.y); a[3] += w0[3] * bf_hi(rw.y);
            a[4] += w1[0] * bf_lo(rw.z); a[5] += w1[1] * bf_hi(rw.z); a[6] += w1[2] * bf_lo(rw.w); a[7] += w1[3] * bf_hi(rw.w);
        }
        float ss = 0.f;
#pragma unroll
        for (int e = 0; e < 8; ++e) { a[e] = silu_f(a[e]); ss += a[e] * a[e]; }
        float rn = 1.0f;
        if (part < 2) {
            ss += __shfl_xor(ss, 1); ss += __shfl_xor(ss, 2); ss += __shfl_xor(ss, 4); ss += __shfl_xor(ss, 8);
            rn = rsqrtf(ss + 1e-6f) * (part == 0 ? 0.08838834764831845f : 1.0f);
        }
#pragma unroll
        for (int e = 0; e < 8; ++e) av[i][e] = a[e] * rn;
    }
#pragma unroll
    for (int i = 0; i < 6; ++i) {
        const int item = tid + 512 * i, g = item & 15, t = (item >> 4) & 63, part = i >> 1;
        const float* a = av[i];
        const float beta = sm[t], egc = sm[128 + t], ekd = sm[192 + t];
        if (part < 2) {
            u32x4 w; w.x = pk_bf16(a[0], a[1]); w.y = pk_bf16(a[2], a[3]); w.z = pk_bf16(a[4], a[5]); w.w = pk_bf16(a[6], a[7]);
            *(LAS u32x4*)(lds + (part == 0 ? G_QN : G_KN) + t * 272 + g * 16) = w;
            if (part == 0) {
                u32x2 lo, hi; lo.x = pk_bf16(a[0] * egc, a[1] * egc); lo.y = pk_bf16(a[2] * egc, a[3] * egc); hi.x = pk_bf16(a[4] * egc, a[5] * egc); hi.y = pk_bf16(a[6] * egc, a[7] * egc);
                bf16_t* qd = QD + t * 128 + 16 * (g >> 1) + 4 * (g & 1);
                *(u32x2*)qd = lo; *(u32x2*)(qd + 8) = hi;
            } else {
                const float f1 = beta * egc;
                u32x4 w2; w2.x = pk_bf16(a[0] * f1, a[1] * f1); w2.y = pk_bf16(a[2] * f1, a[3] * f1); w2.z = pk_bf16(a[4] * f1, a[5] * f1); w2.w = pk_bf16(a[6] * f1, a[7] * f1);
                *(LAS u32x4*)(lds + G_KBG + t * 272 + g * 16) = w2;
                u32x4 w3; w3.x = pk_bf16(a[0] * ekd, a[1] * ekd); w3.y = pk_bf16(a[2] * ekd, a[3] * ekd); w3.z = pk_bf16(a[4] * ekd, a[5] * ekd); w3.w = pk_bf16(a[6] * ekd, a[7] * ekd);
                *(u32x4*)(KD + t * 128 + g * 8) = w3;
            }
        } else {
            u32x4 w; w.x = pk_bf16(a[0] * beta, a[1] * beta); w.y = pk_bf16(a[2] * beta, a[3] * beta); w.z = pk_bf16(a[4] * beta, a[5] * beta); w.w = pk_bf16(a[6] * beta, a[7] * beta);
            *(LAS u32x4*)(lds + G_VB + t * 272 + g * 16) = w;
        }
    }
    __syncthreads();
    {
        const int w4 = wid & 3, mt = w4 >> 1, nt = w4 & 1; const bool isqk = wid >= 4;
        if (!(mt == 0 && nt == 1)) {
            const LAS unsigned char* Ab = lds + (isqk ? G_QN : G_KN) + (32 * mt + r) * 272 + 16 * h2;
            const LAS unsigned char* Bb = lds + G_KN + (32 * nt + r) * 272 + 16 * h2;
            bf16x8 fa[8], fb[8];
#pragma unroll
            for (int ks = 0; ks < 8; ++ks) { fa[ks] = *(const LAS bf16x8*)(Ab + 32 * ks); fb[ks] = *(const LAS bf16x8*)(Bb + 32 * ks); }
            f32x16 X;
#pragma unroll
            for (int i = 0; i < 16; ++i) X[i] = 0.f;
            if (!isqk) {
#pragma unroll
                for (int ks = 0; ks < 8; ++ks) X = MFMA32(fa[ks], fb[ks], X);
                const int s = 32 * nt + r; const float gcs = sm[64 + s];
                float gv[16], bv[16];
#pragma unroll
                for (int i = 0; i < 16; ++i) { const int c = 32 * mt + crow(i, h2); gv[i] = sm[64 + c]; bv[i] = sm[c]; }
#pragma unroll
                for (int i = 0; i < 16; ++i) {
                    const int c = 32 * mt + crow(i, h2);
                    const float dec = __builtin_amdgcn_exp2f(fminf(gv[i] - gcs, 0.f));
                    const float val = bv[i] * X[i] * dec;
                    Mf[c * 64 + s] = (c > s) ? val : 0.f;
                }
            } else {
#pragma unroll
                for (int ks = 0; ks < 8; ++ks) X = MFMA32(fb[ks], fa[ks], X);
                const int c = 32 * mt + r; const float gcc = sm[64 + c];
                float gv[16];
#pragma unroll
                for (int i = 0; i < 16; ++i) gv[i] = sm[64 + 32 * nt + crow(i, h2)];
#pragma unroll
                for (int g4 = 0; g4 < 4; ++g4) {
                    const int s0 = 32 * nt + 8 * g4 + 4 * h2;
                    float v[4];
#pragma unroll
                    for (int e = 0; e < 4; ++e) { const int sx = s0 + e; const float dec = __builtin_amdgcn_exp2f(fminf(gcc - gv[4 * g4 + e], 0.f)); const float val = X[4 * g4 + e] * dec; v[e] = (c >= sx) ? val : 0.f; }
                    u32x2 w; w.x = pk_bf16(v[0], v[1]); w.y = pk_bf16(v[2], v[3]);
                    *(u32x2*)(AQ + c * 64 + perm23(s0)) = w;
                }
            }
        }
    }
    __syncthreads();
    if (wid == 0) {
        LAS bf16_t* Tb = (LAS bf16_t*)(lds + G_T);
        {
            const int c16 = lane & 15, b16 = lane >> 4;
            const LAS float* Mb = Mf + (16 * b16) * 64 + 16 * b16;
            float T[16];
#pragma unroll
            for (int i = 0; i < 16; ++i) T[i] = 0.f;
#pragma unroll
            for (int i = 0; i < 16; ++i) {
                float a0 = (i == c16) ? 1.f : 0.f, a1 = 0.f, a2 = 0.f, a3 = 0.f;
#pragma unroll
                for (int s4 = 0; s4 < (i + 3) / 4; ++s4) {
                    const f32x4 m4 = *(const LAS f32x4*)(Mb + i * 64 + 4 * s4);
                    a0 -= m4[0] * T[4 * s4]; a1 -= m4[1] * T[4 * s4 + 1]; a2 -= m4[2] * T[4 * s4 + 2]; a3 -= m4[3] * T[4 * s4 + 3];
                }
                T[i] = (a0 + a1) + (a2 + a3);
            }
#pragma unroll
            for (int i = 0; i < 16; ++i) {
                const int row = 16 * b16 + i;
                Tb[row * 72 + 16 * b16 + c16] = bf16_1(T[i]);
                if ((b16 & 1) == 0) Tb[row * 72 + 16 * b16 + 16 + c16] = 0;
                if (b16 < 2) { Tb[row * 72 + 32 + c16] = 0; Tb[row * 72 + 48 + c16] = 0; }
            }
        }
        __builtin_amdgcn_wave_barrier();
        asm volatile("s_waitcnt lgkmcnt(0)" ::: "memory");
        {
            const int qd = r >> 4, rr = r & 15;
            bf16x8 mfrag;
            { const LAS float* mp = Mf + (16 + 32 * qd + rr) * 64 + 32 * qd + 8 * h2;
              const f32x4 m0 = *(const LAS f32x4*)mp, m1 = *(const LAS f32x4*)(mp + 4);
              u32x4 aw; aw.x = pk_bf16(m0[0], m0[1]); aw.y = pk_bf16(m0[2], m0[3]); aw.z = pk_bf16(m1[0], m1[1]); aw.w = pk_bf16(m1[2], m1[3]);
              mfrag = __builtin_bit_cast(bf16x8, aw); }
            bf16x8 tfrag;
#pragma unroll
            for (int j = 0; j < 8; ++j) tfrag[j] = (short)Tb[(32 * qd + 8 * h2 + j) * 72 + 32 * qd + rr];
            bf16x8 t2frag;
            { const LAS unsigned char* tp = lds + G_T + (16 + 32 * qd + rr) * 144 + (16 + 32 * qd + 4 * h2) * 2;
              const u32x2 lo = *(const LAS u32x2*)tp, hi = *(const LAS u32x2*)(tp + 16);
              u32x4 aw; aw.x = lo.x; aw.y = lo.y; aw.z = hi.x; aw.w = hi.y; t2frag = __builtin_bit_cast(bf16x8, aw); }
            const bf16x8 zf = {0, 0, 0, 0, 0, 0, 0, 0};
            f32x16 Y1, Z1;
#pragma unroll
            for (int i = 0; i < 16; ++i) { Y1[i] = 0.f; Z1[i] = 0.f; }
#pragma unroll
            for (int ks = 0; ks < 2; ++ks) Y1 = MFMA32(qd == ks ? mfrag : zf, qd == ks ? tfrag : zf, Y1);
#pragma unroll
            for (int s2 = 0; s2 < 2; ++s2) Z1 = MFMA32(qd == s2 ? t2frag : zf, pack8(Y1, s2), Z1);
#pragma unroll
            for (int i = 0; i < 16; ++i) {
                const int row = crow(i, h2);
                if ((row >> 4) == qd) Tb[(16 + 32 * qd + (row & 15)) * 72 + 32 * qd + rr] = bf16_1(-Z1[i]);
            }
        }
        __builtin_amdgcn_wave_barrier();
        asm volatile("s_waitcnt lgkmcnt(0)" ::: "memory");
        const int i16 = lane & 15, q = i16 >> 2, pp = i16 & 3, blk = (lane >> 4) & 1;
        f32x16 Y;
#pragma unroll
        for (int i = 0; i < 16; ++i) Y[i] = 0.f;
#pragma unroll
        for (int ks = 0; ks < 2; ++ks) {
            const LAS float* mp = Mf + (32 + r) * 64 + 16 * ks + 8 * h2;
            const f32x4 m0 = *(const LAS f32x4*)mp, m1 = *(const LAS f32x4*)(mp + 4);
            u32x4 aw; aw.x = pk_bf16(m0[0], m0[1]); aw.y = pk_bf16(m0[2], m0[3]); aw.z = pk_bf16(m1[0], m1[1]); aw.w = pk_bf16(m1[2], m1[3]);
            const bf16x8 bfrag = tr_pair(lds + G_T + (16 * ks + 8 * h2 + q) * 144 + (16 * blk + 4 * pp) * 2, 4 * 144);
            Y = MFMA32(__builtin_bit_cast(bf16x8, aw), bfrag, Y);
        }
        f32x16 Z;
#pragma unroll
        for (int i = 0; i < 16; ++i) Z[i] = 0.f;
#pragma unroll
        for (int s = 0; s < 2; ++s) {
            const LAS unsigned char* tp = lds + G_T + (32 + r) * 144 + (32 + 16 * s + 4 * h2) * 2;
            const u32x2 lo = *(const LAS u32x2*)tp, hi = *(const LAS u32x2*)(tp + 16);
            u32x4 aw; aw.x = lo.x; aw.y = lo.y; aw.z = hi.x; aw.w = hi.y;
            Z = MFMA32(__builtin_bit_cast(bf16x8, aw), pack8(Y, s), Z);
        }
#pragma unroll
        for (int i = 0; i < 16; ++i) Tb[(32 + crow(i, h2)) * 72 + r] = bf16_1(-Z[i]);
    } else if (wid == 1) {
        if (c2next < 2048) gdn_gates(p, (LAS float*)(lds + G_SM + (par ^ 1) * 1024), c2next, lane);
    }
    __syncthreads();
    {
        const int mt = wid >> 2, nt = wid & 3;
        const int i16 = lane & 15, q = i16 >> 2, pp = i16 & 3, blk = (lane >> 4) & 1;
        bf16x8 af[4], vf[4], kf[4];
#pragma unroll
        for (int ks = 0; ks < 4; ++ks) {
            if (ks < 2 * (mt + 1)) {
                af[ks] = *(const LAS bf16x8*)(lds + G_T + (32 * mt + r) * 144 + (16 * ks + 8 * h2) * 2);
                const int boff = (16 * ks + 8 * h2 + q) * 272 + (32 * nt + 16 * blk + 4 * pp) * 2;
                vf[ks] = tr_pair(lds + G_VB + boff, 4 * 272);
                kf[ks] = tr_pair(lds + G_KBG + boff, 4 * 272);
            }
        }
        f32x16 Xu, Xw;
#pragma unroll
        for (int i = 0; i < 16; ++i) { Xu[i] = 0.f; Xw[i] = 0.f; }
#pragma unroll
        for (int ks = 0; ks < 4; ++ks) {
            if (ks < 2 * (mt + 1)) {
                Xu = MFMA32(af[ks], vf[ks], Xu);
                Xw = MFMA32(kf[ks], af[ks], Xw);
            }
        }
        {
            float* up = U + (nt * 2 + mt) * 1024 + lane * 4;
#pragma unroll
            for (int k = 0; k < 4; ++k) { const f32x4 v = {Xu[4 * k], Xu[4 * k + 1], Xu[4 * k + 2], Xu[4 * k + 3]}; *(f32x4*)(up + 256 * k) = v; }
        }
        const int c = 32 * mt + r;
#pragma unroll
        for (int g4 = 0; g4 < 4; ++g4) {
            const int d0 = 32 * nt + 8 * g4 + 4 * h2;
            u32x2 w; w.x = pk_bf16(-Xw[4 * g4], -Xw[4 * g4 + 1]); w.y = pk_bf16(-Xw[4 * g4 + 2], -Xw[4 * g4 + 3]);
            *(u32x2*)(WN + c * 128 + perm23(d0)) = w;
        }
    }
    __syncthreads();
}

constexpr int S_WN = 0, S_QD = 17408, S_KD = 34816, S_AQ = 52224, S_BUF = 61440, S_STG = 2 * S_BUF;

struct GateIn { u32x4 z0, z1; };
DI void scan_gate_load(const Params& p, int tid, int b, int hh, int n, GateIn& g) {
    const int gc_ = tid >> 3, seg = tid & 7;
    const bf16_t* P1 = (const bf16_t*)(p.ws + OFF_P1);
    const size_t row = (size_t)b * SEQ + n * 64 + gc_;
    g.z0 = *(const u32x4*)(P1 + row * NP1 + C_GZ + hh * 128 + seg * 8); g.z1 = *(const u32x4*)(P1 + row * NP1 + C_GZ + hh * 128 + 64 + seg * 8);
}
DI void scan_gate(const Params& p, LAS unsigned char* lds, int tid, int b, int hh, int n, const GateIn& g) {
    const int gc_ = tid >> 3, seg = tid & 7;
    bf16_t* mix = (bf16_t*)(p.ws + OFF_HB);
    const LAS float* st = (const LAS float*)(lds + S_STG) + gc_ * 132 + seg * 8;
    f32x4 ov[4]; float ss = 0.f;
#pragma unroll
    for (int k = 0; k < 4; ++k) { ov[k] = *(const LAS f32x4*)(st + (k >> 1) * 64 + 4 * (k & 1)); ss += ov[k][0] * ov[k][0] + ov[k][1] * ov[k][1] + ov[k][2] * ov[k][2] + ov[k][3] * ov[k][3]; }
    ss += __shfl_xor(ss, 1); ss += __shfl_xor(ss, 2); ss += __shfl_xor(ss, 4);
    const float rstd = rsqrtf(ss * (1.0f / 128.0f) + EPS);
    const size_t row = (size_t)b * SEQ + n * 64 + gc_;
    const u32x4 z0 = g.z0, z1 = g.z1;
    f32x4 gnw[4];
#pragma unroll
    for (int k = 0; k < 4; ++k) gnw[k] = *(const f32x4*)(p.gdn_norm_w + seg * 8 + (k >> 1) * 64 + 4 * (k & 1));
    u32x4 w0, w1;
    w0.x = pk_bf16(ov[0][0] * rstd * gnw[0][0] * silu_f(bf_lo(z0.x)), ov[0][1] * rstd * gnw[0][1] * silu_f(bf_hi(z0.x)));
    w0.y = pk_bf16(ov[0][2] * rstd * gnw[0][2] * silu_f(bf_lo(z0.y)), ov[0][3] * rstd * gnw[0][3] * silu_f(bf_hi(z0.y)));
    w0.z = pk_bf16(ov[1][0] * rstd * gnw[1][0] * silu_f(bf_lo(z0.z)), ov[1][1] * rstd * gnw[1][1] * silu_f(bf_hi(z0.z)));
    w0.w = pk_bf16(ov[1][2] * rstd * gnw[1][2] * silu_f(bf_lo(z0.w)), ov[1][3] * rstd * gnw[1][3] * silu_f(bf_hi(z0.w)));
    w1.x = pk_bf16(ov[2][0] * rstd * gnw[2][0] * silu_f(bf_lo(z1.x)), ov[2][1] * rstd * gnw[2][1] * silu_f(bf_hi(z1.x)));
    w1.y = pk_bf16(ov[2][2] * rstd * gnw[2][2] * silu_f(bf_lo(z1.y)), ov[2][3] * rstd * gnw[2][3] * silu_f(bf_hi(z1.y)));
    w1.z = pk_bf16(ov[3][0] * rstd * gnw[3][0] * silu_f(bf_lo(z1.z)), ov[3][1] * rstd * gnw[3][1] * silu_f(bf_hi(z1.z)));
    w1.w = pk_bf16(ov[3][2] * rstd * gnw[3][2] * silu_f(bf_lo(z1.w)), ov[3][3] * rstd * gnw[3][3] * silu_f(bf_hi(z1.w)));
    bf16_t* mp = mix + row * DM + hh * 128 + seg * 8;
    *(u32x4*)mp = w0; *(u32x4*)(mp + 64) = w1;
}

struct ScanRegs { u32x4 t0[4], t1[4], t2[4], t3[2]; };
DI void scan_fetch(ScanRegs& R, const bf16_t* WN, const bf16_t* QD, const bf16_t* KD, const bf16_t* AQ, int ltid) {
#pragma unroll
    for (int i = 0; i < 4; ++i) { const int pi = ltid + 256 * i; R.t0[i] = *(const u32x4*)(WN + pi * 8); R.t1[i] = *(const u32x4*)(QD + pi * 8); R.t2[i] = *(const u32x4*)(KD + pi * 8); }
#pragma unroll
    for (int i = 0; i < 2; ++i) { const int pi = ltid + 256 * i; R.t3[i] = *(const u32x4*)(AQ + pi * 8); }
}
DI void scan_put(const ScanRegs& R, LAS unsigned char* dst, int ltid) {
#pragma unroll
    for (int i = 0; i < 4; ++i) { const int pi = ltid + 256 * i, row = pi >> 4, pc = pi & 15;
        *(LAS u32x4*)(dst + S_WN + row * 272 + pc * 16) = R.t0[i]; *(LAS u32x4*)(dst + S_QD + row * 272 + pc * 16) = R.t1[i]; *(LAS u32x4*)(dst + S_KD + row * 272 + pc * 16) = R.t2[i]; }
#pragma unroll
    for (int i = 0; i < 2; ++i) { const int pi = ltid + 256 * i, row = pi >> 3, pc = pi & 7; *(LAS u32x4*)(dst + S_AQ + row * 144 + pc * 16) = R.t3[i]; }
}

DI void gdn_scan(const Params& p, LAS unsigned char* lds, int bh) {
    int tid = threadIdx.x; asm volatile("" : "+v"(tid));
    const int lane = tid & 63, wid = __builtin_amdgcn_readfirstlane(tid >> 6), r = lane & 31, h2 = lane >> 5;
    const int b = bh >> 2, hh = bh & 3;
    const bf16_t* WN = (const bf16_t*)(p.ws + OFF_WN) + (size_t)bh * 32 * 8192;
    const bf16_t* QD = (const bf16_t*)(p.ws + OFF_QD) + (size_t)bh * 32 * 8192;
    const bf16_t* KD = (const bf16_t*)(p.ws + OFF_KD) + (size_t)bh * 32 * 8192;
    const bf16_t* AQ = (const bf16_t*)(p.ws + OFF_AQK) + (size_t)bh * 32 * 4096;
    const float* U = (const float*)(p.ws + OFF_U) + (size_t)bh * 32 * 8192;
    const float* GL = (const float*)(p.ws + OFF_GL) + bh * 32;
    if (wid >= 4) {
        const int ltid = tid & 255;
        ScanRegs R;
        scan_fetch(R, WN, QD, KD, AQ, ltid); scan_put(R, lds, ltid);
        scan_fetch(R, WN + 8192, QD + 8192, KD + 8192, AQ + 4096, ltid);
#pragma unroll 1
        for (int n = 0; n < 32; ++n) {
            __syncthreads();
            GateIn gi; scan_gate_load(p, tid, b, hh, n, gi);
            if (n + 1 < 32) scan_put(R, lds + ((n + 1) & 1) * S_BUF, ltid);
            if (n + 2 < 32) scan_fetch(R, WN + (size_t)(n + 2) * 8192, QD + (size_t)(n + 2) * 8192, KD + (size_t)(n + 2) * 8192, AQ + (size_t)(n + 2) * 4096, ltid);
            __syncthreads();
            scan_gate(p, lds, tid, b, hh, n, gi);
        }
    } else {
        const int i16 = lane & 15, q4 = i16 >> 2, pp = i16 & 3, blk = (lane >> 4) & 1;
        f32x16 St[4], u[2];
#pragma unroll
        for (int k = 0; k < 4; ++k)
#pragma unroll
            for (int i = 0; i < 16; ++i) St[k][i] = 0.f;
#pragma unroll
        for (int mt = 0; mt < 2; ++mt)
#pragma unroll
            for (int k = 0; k < 4; ++k) { const f32x4 v = *(const f32x4*)(U + (wid * 2 + mt) * 1024 + 256 * k + lane * 4); u[mt][4 * k] = v[0]; u[mt][4 * k + 1] = v[1]; u[mt][4 * k + 2] = v[2]; u[mt][4 * k + 3] = v[3]; }
#pragma unroll 1
        for (int n = 0; n < 32; ++n) {
            LAS unsigned char* buf = lds + (n & 1) * S_BUF;
            __syncthreads();
            GateIn gi; scan_gate_load(p, tid, b, hh, n, gi);
            const float egl = GL[n];
            f32x16 vn[2], o[2];
            vn[0] = u[0]; vn[1] = u[1];
#pragma unroll
            for (int mt = 0; mt < 2; ++mt)
#pragma unroll
                for (int i = 0; i < 16; ++i) o[mt][i] = 0.f;
#pragma unroll
            for (int ks = 0; ks < 8; ++ks) {
                const bf16x8 sf = pack8(St[ks >> 1], ks & 1);
#pragma unroll
                for (int mt = 0; mt < 2; ++mt) {
                    const bf16x8 wf = *(const LAS bf16x8*)(buf + S_WN + (32 * mt + r) * 272 + (16 * ks + 8 * h2) * 2);
                    vn[mt] = MFMA32(wf, sf, vn[mt]);
                    const bf16x8 qf = *(const LAS bf16x8*)(buf + S_QD + (32 * mt + r) * 272 + (16 * ks + 8 * h2) * 2);
                    o[mt] = MFMA32(qf, sf, o[mt]);
                }
                asm volatile("" ::: "memory");
            }
            bf16x8 vf[4];
#pragma unroll
            for (int k2 = 0; k2 < 4; ++k2) vf[k2] = pack8(vn[k2 >> 1], k2 & 1);
            {
                const int nn = (n + 1 < 32) ? n + 1 : n;
                const float* up = U + (size_t)nn * 8192 + (wid * 2) * 1024 + lane * 4;
#pragma unroll
                for (int mt = 0; mt < 2; ++mt)
#pragma unroll
                    for (int k = 0; k < 4; ++k) { const f32x4 v = *(const f32x4*)(up + mt * 1024 + 256 * k); u[mt][4 * k] = v[0]; u[mt][4 * k + 1] = v[1]; u[mt][4 * k + 2] = v[2]; u[mt][4 * k + 3] = v[3]; }
            }
#pragma unroll
            for (int mt = 0; mt < 2; ++mt)
#pragma unroll
                for (int k2 = 0; k2 < 2 * (mt + 1); ++k2) {
                    const bf16x8 af = *(const LAS bf16x8*)(buf + S_AQ + (32 * mt + r) * 144 + (16 * k2 + 8 * h2) * 2);
                    o[mt] = MFMA32(af, vf[k2], o[mt]);
                }
            {
                LAS float* st = (LAS float*)(lds + S_STG);
#pragma unroll
                for (int mt = 0; mt < 2; ++mt)
#pragma unroll
                    for (int i = 0; i < 16; ++i) st[(32 * mt + crow(i, h2)) * 132 + 32 * wid + r] = o[mt][i];
            }
#pragma unroll
            for (int kt = 0; kt < 4; ++kt) {
#pragma unroll
                for (int i = 0; i < 16; ++i) St[kt][i] *= egl;
#pragma unroll
                for (int k2 = 0; k2 < 4; ++k2) {
                    const bf16x8 kf = tr_pair(buf + S_KD + (16 * k2 + 4 * h2 + q4) * 272 + (32 * kt + 16 * blk + 4 * pp) * 2, 8 * 272);
                    St[kt] = MFMA32(kf, vf[k2], St[kt]);
                }
                asm volatile("" ::: "memory");
            }
            __syncthreads();
            scan_gate(p, lds, tid, b, hh, n, gi);
        }
    }
    __syncthreads();
}

DI void zero_mix_half(const Params& p, int half) {
    bf16_t* mix = (bf16_t*)(p.ws + OFF_HB);
    const size_t n16 = (size_t)MTOK * 64;
    for (size_t i = (size_t)blockIdx.x * 512 + threadIdx.x; i < n16; i += (size_t)gridDim.x * 512) {
        const size_t row = i >> 6, pc = i & 63;
        *(u32x4*)(mix + row * DM + half * 512 + pc * 8) = (u32x4){0u, 0u, 0u, 0u};
    }
}

DI void phase_final(const Params& p) {
    int tid = threadIdx.x; asm volatile("" : "+v"(tid));
    const int lane = tid & 63, wid = tid >> 6;
    const float* rowsq = (const float*)(p.ws + OFF_ROWSQ);
    const bf16_t* yb = (const bf16_t*)(p.ws + OFF_YB);
    const int gw = blockIdx.x * 8 + wid, nw = gridDim.x * 8;
    f32x4 fw[4];
#pragma unroll
    for (int i = 0; i < 2; ++i) { fw[2 * i] = *(const f32x4*)(p.final_norm_w + 512 * i + 8 * lane); fw[2 * i + 1] = *(const f32x4*)(p.final_norm_w + 512 * i + 8 * lane + 4); }
#pragma unroll 1
    for (int row0 = gw; row0 < MTOK; row0 += 4 * nw) {
        u32x4 y[4][2]; float sq[4];
#pragma unroll
        for (int k = 0; k < 4; ++k) {
            const int row = row0 + k * nw, rc = row < MTOK ? row : row0;
#pragma unroll
            for (int i = 0; i < 2; ++i) y[k][i] = *(const u32x4*)(yb + (size_t)rc * DM + 512 * i + 8 * lane);
            sq[k] = lane < 16 ? rowsq[(size_t)rc * 16 + lane] : 0.f;
        }
#pragma unroll
        for (int k = 0; k < 4; ++k) {
            const int row = row0 + k * nw;
            const float ss = wave_sum(sq[k]);
            const float rstd = rsqrtf(ss * (1.0f / DM) + EPS);
            if (row < MTOK) {
                float* o = p.out + (size_t)row * DM;
#pragma unroll
                for (int i = 0; i < 2; ++i) {
                    const f32x4 a = {bf_lo(y[k][i].x), bf_hi(y[k][i].x), bf_lo(y[k][i].y), bf_hi(y[k][i].y)}, c = {bf_lo(y[k][i].z), bf_hi(y[k][i].z), bf_lo(y[k][i].w), bf_hi(y[k][i].w)};
                    *(f32x4*)(o + 512 * i + 8 * lane) = a * rstd * fw[2 * i];
                    *(f32x4*)(o + 512 * i + 8 * lane + 4) = c * rstd * fw[2 * i + 1];
                }
            }
        }
    }
}

__global__ void __launch_bounds__(512) mega(Params p) {
    extern __shared__ __attribute__((aligned(16))) unsigned char shm[];
    LAS unsigned char* lds = (LAS unsigned char*)shm;
    cg::grid_group grid = cg::this_grid();
    volatile LAS unsigned* bst = (volatile LAS unsigned*)(lds + LDS_BYTES - 16);
    if (threadIdx.x < 2) bst[threadIdx.x] = 0u;
    __syncthreads();
    const XcdBarrier xb = xcd_barrier_post((unsigned*)(p.ws + OFF_BAR), bst);
    if (p.ws == nullptr) grid.sync();

#pragma unroll 1
    for (int rep = 0; rep < REP_PREP; ++rep) phase_prep(p, lds);
    xcd_barrier(xb);
#pragma unroll 1
    for (int rep = 0; rep < REP_G1; ++rep)
    {
        pg8::Gemm g{(const bf16_t*)(p.ws + OFF_HB), (const bf16_t*)(p.ws + OFF_WINT), MTOK, NG1, DM};
        pg8::StaticOrder S; S.init(g.M, g.N, (int)gridDim.x, (int)blockIdx.x);
        pg8::EpiP1 E{(bf16_t*)(p.ws + OFF_P1), NP1, (bf16_t*)(p.ws + OFF_KX)};
        pg8::gemm_phase<pg8::EpiP1, false>(lds, g, S, E);
        pg8::Gemm g2{(const bf16_t*)(p.ws + OFF_HB), (const bf16_t*)(p.ws + OFF_WINT) + (size_t)NG1 * DM, MTOK, 512, DM};
        pg8::StaticOrder S2; S2.init(g2.M, g2.N, (int)gridDim.x, (int)blockIdx.x);
        pg8::EpiVT E2{(bf16_t*)(p.ws + OFF_VT)};
        pg8::gemm_phase<pg8::EpiVT, true>(lds, g2, S2, E2);
    }
    xcd_barrier(xb);
#pragma unroll 1
    for (int rep = 0; rep < REP_GP; ++rep)
    {
        if ((threadIdx.x >> 6) == 0 && (int)blockIdx.x < 2048) gdn_gates(p, (LAS float*)(lds + G_SM), blockIdx.x, threadIdx.x & 63);
        __syncthreads();
        int par = 0;
#pragma unroll 1
        for (int c2 = blockIdx.x; c2 < 2048; c2 += gridDim.x, par ^= 1) gdn_prep(p, lds, c2, c2 + (int)gridDim.x, par);
    }
    xcd_barrier(xb);
#pragma unroll 1
    for (int rep = 0; rep < REP_P3; ++rep) {
#pragma unroll 1
        for (int r2 = 0; r2 < REP_SCAN; ++r2)
            if (blockIdx.x < 64) gdn_scan(p, lds, blockIdx.x);
#if SCAN_SYNC
        xcd_barrier(xb);
#endif
        phase_attn(p, lds, rep);
#if REP_ATTN > 1
        xcd_barrier(xb);
        phase_attn(p, lds, 2);
#endif
#if REP_P3 > 1
        xcd_barrier(xb);
#endif
    }
    xcd_barrier(xb);
#pragma unroll 1
    for (int rnd = 0; rnd < 2; ++rnd) {
        pg8::Gemm g{(const bf16_t*)(p.ws + OFF_HB), (const bf16_t*)(p.ws + OFF_WOUTT), MTOK, DM, DM};
        pg8::StaticOrder S; S.init(g.M, g.N, (int)gridDim.x, (int)blockIdx.x); S.i0 = rnd; S.imax = 1;
        pg8::EpiOutFused E{p.x, p.out, (float*)(p.ws + OFF_ROWSQ), p.final_norm_w, xb};
        pg8::Unit u0;
        if (S.next(0, u0)) pg8::gemm_phase<pg8::EpiOutFused, false>(lds, g, S, E);
        else xcd_barrier(xb);
    }
}

extern "C" void kernel_launch(void* const* d_in, const int* in_sizes, int n_in, void* d_out, int out_size, void* d_ws, size_t ws_size, hipStream_t stream) {
    static int grid = 0;
    if (grid == 0) {
        if (ws_size < WS_END) { fprintf(stderr, "kernel_launch: workspace too small (%zu < %zu)\n", ws_size, (size_t)WS_END); grid = -1; return; }
        int dev = 0, cus = 0, per_cu = 0;
        hipGetDevice(&dev);
        hipDeviceGetAttribute(&cus, hipDeviceAttributeMultiprocessorCount, dev);
        if (hipFuncSetAttribute((const void*)mega, hipFuncAttributeMaxDynamicSharedMemorySize, LDS_BYTES) != hipSuccess) { fprintf(stderr, "kernel_launch: hipFuncSetAttribute failed\n"); grid = -1; return; }
        if (hipOccupancyMaxActiveBlocksPerMultiprocessor(&per_cu, (const void*)mega, 512, LDS_BYTES) != hipSuccess || per_cu < 1) per_cu = 1;
        (void)hipGetLastError();
        grid = cus * (per_cu > 1 ? 1 : per_cu);
    }
    if (grid < 0) return;
    Params p{};
    p.x = (const float*)d_in[0]; p.norm_w = (const float*)d_in[1]; p.w_in = (const float*)d_in[2]; p.conv_w = (const float*)d_in[3];
    p.a_log = (const float*)d_in[4]; p.dt_bias = (const float*)d_in[5]; p.gdn_norm_w = (const float*)d_in[6];
    p.lq1 = (const float*)d_in[7]; p.lk1 = (const float*)d_in[8]; p.lq2 = (const float*)d_in[9]; p.lk2 = (const float*)d_in[10];
    p.diff_norm_w = (const float*)d_in[11]; p.w_out = (const float*)d_in[12]; p.final_norm_w = (const float*)d_in[13];
    p.out = (float*)d_out; p.ws = (unsigned char*)d_ws;
    if (hipMemsetAsync((unsigned char*)d_ws + OFF_BAR, 0, 16384, stream) != hipSuccess) { fprintf(stderr, "kernel_launch: hipMemsetAsync failed\n"); return; }
    void* args[] = {&p};
    hipError_t e = hipLaunchCooperativeKernel((const void*)mega, dim3(grid), dim3(512), args, LDS_BYTES, stream);
    if (e != hipSuccess) fprintf(stderr, "cooperative launch failed: %s (grid %d)\n", hipGetErrorString(e), grid);
}
```

```cpp
#include <hip/hip_runtime.h>
#include <hip/hip_cooperative_groups.h>
#include <cstdio>
namespace cg = cooperative_groups;

#ifndef ENABLE_ATTN
#define ENABLE_ATTN 1
#endif
#ifndef ENABLE_GDN
#define ENABLE_GDN 1
#endif
#ifndef REP_PREP
#define REP_PREP 1
#endif
#ifndef REP_G1
#define REP_G1 1
#endif
#ifndef REP_GP
#define REP_GP 1
#endif
#ifndef REP_P3
#define REP_P3 1
#endif
#ifndef REP_G2
#define REP_G2 1
#endif
#ifndef REP_SCAN
#define REP_SCAN 1
#endif
#ifndef SCAN_SYNC
#define SCAN_SYNC 0
#endif
#ifndef REP_ATTN
#define REP_ATTN 1
#endif

#define LAS __attribute__((address_space(3)))
#define DI __device__ __forceinline__
typedef unsigned short bf16_t;
typedef short bf16x8 __attribute__((ext_vector_type(8)));
typedef short s16x4 __attribute__((ext_vector_type(4)));
typedef float f32x2 __attribute__((ext_vector_type(2)));
typedef float f32x4 __attribute__((ext_vector_type(4)));
typedef float f32x16 __attribute__((ext_vector_type(16)));
typedef unsigned u32x2 __attribute__((ext_vector_type(2)));
typedef unsigned u32x4 __attribute__((ext_vector_type(4)));
typedef __bf16 bf16x2_t __attribute__((ext_vector_type(2)));

#define MFMA32(a, b, c) __builtin_amdgcn_mfma_f32_32x32x16_bf16((a), (b), (c), 0, 0, 0)

constexpr int NB = 16, SEQ = 2048, DM = 1024, MTOK = NB * SEQ, NP1 = 3072, NG1 = 3584;
constexpr int C_GQ = 0, C_GK = 512, C_GV = 1024, C_GZ = 1536, C_DQ = 2048, C_DZ = 2560;
constexpr float EPS = 1e-6f;
constexpr float LOG2E = 1.4426950408889634f;

constexpr size_t OFF_HB = 0;
constexpr size_t OFF_WINT = OFF_HB + (size_t)MTOK * DM * 2;
constexpr size_t OFF_WOUTT = OFF_WINT + (size_t)4096 * 1024 * 2;
constexpr size_t OFF_GBGA = OFF_WOUTT + (size_t)1024 * 1024 * 2;
constexpr size_t OFF_P1 = OFF_GBGA + (size_t)MTOK * 8 * 4;
constexpr size_t OFF_KX = OFF_P1 + (size_t)MTOK * NP1 * 2;
constexpr size_t OFF_VT = OFF_KX + (size_t)64 * 2 * 2048 * 64 * 2;
constexpr size_t OFF_WN = OFF_VT + (size_t)64 * 128 * 2048 * 2;
constexpr size_t OFF_QD = OFF_WN + (size_t)2048 * 64 * 128 * 2;
constexpr size_t OFF_KD = OFF_QD + (size_t)2048 * 64 * 128 * 2;
constexpr size_t OFF_AQK = OFF_KD + (size_t)2048 * 64 * 128 * 2;
constexpr size_t OFF_U = OFF_AQK + (size_t)2048 * 64 * 64 * 2;
constexpr size_t OFF_GL = OFF_U + (size_t)2048 * 64 * 128 * 4;
constexpr size_t OFF_ROWSQ = OFF_GL + 8192;
constexpr size_t OFF_MISC = OFF_ROWSQ + (size_t)MTOK * 16 * 4;
constexpr size_t OFF_YB = OFF_P1;
constexpr size_t OFF_BAR = OFF_MISC + 256;
constexpr size_t WS_END = OFF_BAR + 16384;

constexpr int LDS_BYTES = 156 * 1024;

struct Params {
    const float *x, *norm_w, *w_in, *conv_w, *a_log, *dt_bias, *gdn_norm_w, *lq1, *lk1, *lq2, *lk2, *diff_norm_w, *w_out, *final_norm_w;
    float* out; unsigned char* ws;
};

DI unsigned pk_bf16(float a, float b) { f32x2 v = {a, b}; bf16x2_t r = __builtin_convertvector(v, bf16x2_t); return __builtin_bit_cast(unsigned, r); }
DI float bf_lo(unsigned u) { return __uint_as_float(u << 16); }
DI float bf_hi(unsigned u) { return __uint_as_float(u & 0xffff0000u); }
DI float wave_sum(float v) {
#pragma unroll
    for (int o = 32; o; o >>= 1) v += __shfl_xor(v, o);
    return v;
}
DI float xhalf_max(float v) {
    const u32x2 r = __builtin_amdgcn_permlane32_swap(__float_as_uint(v), __float_as_uint(v), false, false);
    return fmaxf(__uint_as_float(r.x), __uint_as_float(r.y));
}
DI float xhalf_sum(float v) {
    const u32x2 r = __builtin_amdgcn_permlane32_swap(__float_as_uint(v), __float_as_uint(v), false, false);
    return __uint_as_float(r.x) + __uint_as_float(r.y);
}
DI float silu_f(float z) { return z * __builtin_amdgcn_rcpf(1.0f + __builtin_amdgcn_exp2f(-LOG2E * z)); }
DI int perm23(int t) { return (t & ~12) | ((t & 4) << 1) | ((t & 8) >> 1); }
DI int crow(int i, int h2) { return (i & 3) + 8 * (i >> 2) + 4 * h2; }
DI bf16x8 pack8(const f32x16& x, int s) {
    u32x4 w; w.x = pk_bf16(x[8 * s + 0], x[8 * s + 1]); w.y = pk_bf16(x[8 * s + 2], x[8 * s + 3]); w.z = pk_bf16(x[8 * s + 4], x[8 * s + 5]); w.w = pk_bf16(x[8 * s + 6], x[8 * s + 7]);
    return __builtin_bit_cast(bf16x8, w);
}


#define XB_TMO      128
#define XB_XCNT(j)  (256  + 64 * (j))
#define XB_XSUB(j)  (1280 + 64 * (j))
#define XB_XGEN(j)  (2304 + 64 * (j))
#define XB_TOP      3328
#define XB_TOPGEN   3392
#define XCD_BAR_WORDS 3456
#define XB_SPIN_CAP (1u << 18)
struct XcdBarrier { unsigned* bar; unsigned x; volatile LAS unsigned* st; };
DI unsigned xb_ld(unsigned* p)              { return __hip_atomic_load(p, __ATOMIC_RELAXED, __HIP_MEMORY_SCOPE_AGENT); }
DI unsigned xb_add(unsigned* p, unsigned v) { return __hip_atomic_fetch_add(p, v, __ATOMIC_RELAXED, __HIP_MEMORY_SCOPE_AGENT); }
DI unsigned xb_xcc_id() { return (unsigned)__builtin_amdgcn_s_getreg((3 << 11) | 20) & 0xFu; }
#define XB_SPIN(cond, bar) do { unsigned _sp = 0; while (cond) { __builtin_amdgcn_s_sleep(1); \
    if ((++_sp & 255u) == 0u) { if (xb_ld(&(bar)[XB_TMO])) break; if (_sp > XB_SPIN_CAP) { atomicAdd(&(bar)[XB_TMO], 1u); break; } } } } while (0)
DI XcdBarrier xcd_barrier_post(unsigned* bar, volatile LAS unsigned* st) {
    XcdBarrier b; b.bar = bar; b.x = xb_xcc_id(); b.st = st;
    if (threadIdx.x == 0) (void)xb_add(&bar[XB_XCNT(b.x)], 1u);
    return b;
}
DI void xcd_barrier_complete(unsigned* bar, unsigned x, unsigned& nloc, unsigned& nx) {
    const unsigned G = gridDim.x * gridDim.y * gridDim.z;
    unsigned sum, cnt, mine, sp = 0u;
    for (;;) {
        sum = 0u; cnt = 0u; mine = 0u;
#pragma unroll
        for (unsigned j = 0; j < 16; ++j) { const unsigned c = xb_ld(&bar[XB_XCNT(j)]); sum += c; cnt += (c > 0u) ? 1u : 0u; mine = (j == x) ? c : mine; }
        if (sum == G) break;
        __builtin_amdgcn_s_sleep(1);
        if ((++sp & 255u) == 0u) { if (xb_ld(&bar[XB_TMO])) break; if (sp > XB_SPIN_CAP) { atomicAdd(&bar[XB_TMO], 1u); break; } }
    }
    nloc = mine > 0u ? mine : 1u; nx = cnt > 0u ? cnt : 1u;
}
DI void xcd_barrier(const XcdBarrier& b) {
    asm volatile("s_waitcnt vmcnt(0)" ::: "memory");
    __syncthreads();
    if (threadIdx.x == 0) {
        unsigned* bar = b.bar;
        __builtin_amdgcn_s_waitcnt(0);
        unsigned nloc = b.st[0], nx = b.st[1];
        if (nloc == 0u) { xcd_barrier_complete(bar, b.x, nloc, nx); b.st[0] = nloc; b.st[1] = nx; }
        const unsigned old = xb_add(&bar[XB_XSUB(b.x)], 1u);
        const unsigned gen = old / nloc;
        if (old + 1u == (gen + 1u) * nloc) {
            __builtin_amdgcn_fence(__ATOMIC_RELEASE, "agent");
            asm volatile("s_waitcnt vmcnt(0)" ::: "memory");
            const unsigned og = xb_add(&bar[XB_TOP], 1u);
            const unsigned tg = og / nx;
            if (og + 1u == (tg + 1u) * nx) xb_add(&bar[XB_TOPGEN], 1u);
            else XB_SPIN(xb_ld(&bar[XB_TOPGEN]) == tg, bar);
            __builtin_amdgcn_fence(__ATOMIC_ACQUIRE, "agent");
            xb_add(&bar[XB_XGEN(b.x)], 1u);
            asm volatile("s_waitcnt vmcnt(0)" ::: "memory");
        } else {
            XB_SPIN(xb_ld(&bar[XB_XGEN(b.x)]) == gen, bar);
            __builtin_amdgcn_fence(__ATOMIC_ACQUIRE, "agent");
            asm volatile("s_waitcnt vmcnt(0)" ::: "memory");
        }
    }
    __syncthreads();
}

namespace pg8 {
constexpr int BM = 256, BK = 64, HALF = 128, HTB = HALF * BK * 2, STAGE_BYTES = 8 * HTB, NXCD = 8, WGM = 8;
DI int lds_byte(int r, int c) { const int st = (r >> 4) * 2 + (c >> 5), rr = r & 15, cc = c & 31, ob = rr * 64 + cc * 2; return st * 1024 + (ob ^ (((ob >> 9) & 1) << 5)); }
DI void stage_rc(int b, int& R, int& C) { const int st = b / 1024, sb = b % 1024, swz = sb ^ (((sb >> 9) & 1) << 5); R = (st >> 1) * 16 + swz / 64; C = (st & 1) * 32 + (swz % 64) / 2; }
DI int perm32(int rho) { const int n = rho >> 4, i = rho & 15; return 8 * (i >> 2) + 4 * n + (i & 3); }
struct Unit { int pm, pn; };
struct Gemm { const bf16_t* A; const bf16_t* Bt; int M, N, K; };
struct StaticOrder {
    int nM, nN, nwg, G, c, i0 = 0, imax = 1 << 30;
    DI void init(int M, int N, int G_, int c_) { nM = M / BM; nN = N / BM; nwg = nM * nN; G = G_; c = c_; }
    DI bool next(int i, Unit& u) const {
        if (i >= imax) return false;
        const long L = (long)(i + i0) * G + c; if (L >= nwg) return false;
        int wgid = (int)L; { const int q = nwg / NXCD, r = nwg % NXCD, xcd = wgid % NXCD, off = wgid / NXCD; wgid = (xcd < r ? xcd * (q + 1) : r * (q + 1) + (xcd - r) * q) + off; }
        const int nig = WGM * nN, gid = wgid / nig, fm = gid * WGM, gsz = (nM - fm) < WGM ? (nM - fm) : WGM;
        u.pm = fm + ((wgid % nig) % gsz); u.pn = (wgid % nig) / gsz; return true;
    }
    DI void a_ready(const Unit&) const {}
    DI void done(const Unit&) const {}
};

struct EpiP1 {
    static constexpr bool PERM = true, PERM16 = true, AFTER_DRAIN = false;
    bf16_t* O; int ldc; bf16_t* KX;
    DI void operator()(const f32x4 (&acc)[2][2][4][2], const Unit& u, int wr, int wc, int fr, int fq) const {
        const int row0 = u.pm * BM + wr * 64 + fr, col0 = u.pn * BM + wc * 64 + 8 * fq;
        if (u.pn >= 12) {
            const int c = col0 - 12 * BM, hm = c >> 6, d = c & 63;
#pragma unroll
            for (int ai = 0; ai < 2; ++ai)
#pragma unroll
                for (int m = 0; m < 4; ++m) { const int row = row0 + ai * HALF + m * 16, b = row >> 11, tok = row & 2047;
                    bf16_t* dp = KX + ((size_t)(b * 8 + hm) * 2048 + tok) * 64 + d;
#pragma unroll
                    for (int bj = 0; bj < 2; ++bj) { const f32x4 v0 = acc[ai][bj][m][0], v1 = acc[ai][bj][m][1];
                        u32x4 w; w.x = pk_bf16(v0[0], v0[1]); w.y = pk_bf16(v0[2], v0[3]); w.z = pk_bf16(v1[0], v1[1]); w.w = pk_bf16(v1[2], v1[3]);
                        *(u32x4*)(dp + 32 * bj) = w; } }
            return;
        }
#pragma unroll
        for (int ai = 0; ai < 2; ++ai)
#pragma unroll
            for (int m = 0; m < 4; ++m) { bf16_t* rowp = O + (size_t)(row0 + ai * HALF + m * 16) * ldc + col0;
#pragma unroll
                for (int bj = 0; bj < 2; ++bj) { const f32x4 v0 = acc[ai][bj][m][0], v1 = acc[ai][bj][m][1];
                    u32x4 w; w.x = pk_bf16(v0[0], v0[1]); w.y = pk_bf16(v0[2], v0[3]); w.z = pk_bf16(v1[0], v1[1]); w.w = pk_bf16(v1[2], v1[3]);
                    *(u32x4*)(rowp + 32 * bj) = w; } }
    }
};
struct EpiVT {
    static constexpr bool PERM = false, PERM16 = false, AFTER_DRAIN = false;
    bf16_t* VT;
    DI void operator()(const f32x4 (&acc)[2][2][4][2], const Unit& u, int wr, int wc, int fr, int fq) const {
#pragma unroll
        for (int ai = 0; ai < 2; ++ai)
#pragma unroll
            for (int m = 0; m < 4; ++m) {
                const int t = u.pm * BM + ai * HALF + wr * 64 + m * 16 + 4 * fq, b = t >> 11, tok = t & 2047, pos = perm23(tok);
#pragma unroll
                for (int bj = 0; bj < 2; ++bj)
#pragma unroll
                    for (int n = 0; n < 2; ++n) {
                        const int c = u.pn * BM + bj * HALF + wc * 32 + n * 16 + fr, hh = c >> 7, dv = c & 127;
                        const f32x4 v = acc[ai][bj][m][n];
                        u32x2 w; w.x = pk_bf16(v[0], v[1]); w.y = pk_bf16(v[2], v[3]);
                        *(u32x2*)(VT + (((size_t)((b * 4 + hh) * 32 + (pos >> 6)) * 128 + dv)) * 64 + (pos & 63)) = w;
                    }
            }
    }
};
static_assert(WGM == 8, "EpiOutFused needs the four column tiles of a row panel in the same round");
struct EpiOutFused {
    static constexpr bool PERM = false, PERM16 = false, AFTER_DRAIN = true;
    const float* X; float* Out; float* rowsq; const float* fw; XcdBarrier xb;
    DI void operator()(const f32x4 (&)[2][2][4][2], const Unit&, int, int, int, int) const {}
    DI void fused(f32x4 (&acc)[2][2][4][2], const Unit& u, int wr, int wc, int fr, int fq) const {
        const int row0 = u.pm * BM + wr * 64 + fr, col0 = u.pn * BM + wc * 32 + 4 * fq;
#pragma unroll
        for (int ai = 0; ai < 2; ++ai) {
            f32x4 xv[4][2][2];
#pragma unroll
            for (int m = 0; m < 4; ++m)
#pragma unroll
                for (int bj = 0; bj < 2; ++bj)
#pragma unroll
                    for (int n = 0; n < 2; ++n) xv[m][bj][n] = *(const f32x4*)(X + (size_t)(row0 + ai * HALF + m * 16) * DM + col0 + bj * HALF + n * 16);
            __builtin_amdgcn_sched_group_barrier(0x020, 16, 0);
            __builtin_amdgcn_sched_group_barrier(0x002, 400, 0);
#pragma unroll
            for (int m = 0; m < 4; ++m) {
                const int row = row0 + ai * HALF + m * 16; float ss = 0.f;
#pragma unroll
                for (int bj = 0; bj < 2; ++bj)
#pragma unroll
                    for (int n = 0; n < 2; ++n) {
                        const f32x4 y = acc[ai][bj][m][n] + xv[m][bj][n];
                        acc[ai][bj][m][n] = y; ss += y[0] * y[0] + y[1] * y[1] + y[2] * y[2] + y[3] * y[3];
                    }
                ss += __shfl_xor(ss, 16); ss += __shfl_xor(ss, 32);
                if (fq == 0) rowsq[(size_t)row * 16 + u.pn * 4 + wc] = ss;
            }
            __builtin_amdgcn_sched_barrier(0);
        }
        xcd_barrier(xb);
        f32x4 fwv[2][2];
#pragma unroll
        for (int bj = 0; bj < 2; ++bj)
#pragma unroll
            for (int n = 0; n < 2; ++n) fwv[bj][n] = *(const f32x4*)(fw + col0 + bj * HALF + n * 16);
        f32x4 rqv[2][4];
#pragma unroll
        for (int ai = 0; ai < 2; ++ai)
#pragma unroll
            for (int m = 0; m < 4; ++m) rqv[ai][m] = *(const f32x4*)(rowsq + (size_t)(row0 + ai * HALF + m * 16) * 16 + 4 * fq);
        __builtin_amdgcn_sched_group_barrier(0x020, 12, 0);
#pragma unroll
        for (int ai = 0; ai < 2; ++ai)
#pragma unroll
            for (int m = 0; m < 4; ++m) {
                const int row = row0 + ai * HALF + m * 16;
                float tot = (rqv[ai][m][0] + rqv[ai][m][1]) + (rqv[ai][m][2] + rqv[ai][m][3]);
                tot += __shfl_xor(tot, 16); tot += __shfl_xor(tot, 32);
                const float rstd = rsqrtf(tot * (1.0f / DM) + EPS);
#pragma unroll
                for (int bj = 0; bj < 2; ++bj)
#pragma unroll
                    for (int n = 0; n < 2; ++n) {
                        const size_t o = (size_t)row * DM + col0 + bj * HALF + n * 16;
                        *(f32x4*)(Out + o) = acc[ai][bj][m][n] * rstd * fwv[bj][n];
                    }
            }
    }
};

template <class Epi, bool SWAP>
DI void gemm_phase(LAS unsigned char* lds, const Gemm g, const StaticOrder& S, const Epi& E) {
    int tid = threadIdx.x; asm volatile("" : "+v"(tid));
    const int wid = __builtin_amdgcn_readfirstlane(tid >> 6), lane = tid & 63, wr = wid >> 2, wc = wid & 3, fr = lane & 15, fq = lane >> 4;
    const int K = g.K, nt = K / BK;
    unsigned voffA[2], voffB[2], voffB1[2];
#pragma unroll
    for (int i = 0; i < 2; ++i) { int R, C; stage_rc(tid * 16 + i * 8192, R, C); const int Rb = Epi::PERM ? ((R & ~31) + perm32(R & 31)) : R;
        voffA[i] = (unsigned)(R * K + C) * 2u;
        if constexpr (Epi::PERM16) {
            const int c0 = 64 * (R >> 5) + 8 * ((R >> 2) & 3) + 4 * ((R >> 4) & 1) + (R & 3);
            voffB[i] = (unsigned)(c0 * K + C) * 2u; voffB1[i] = (unsigned)((c0 + 32) * K + C) * 2u;
        } else { voffB[i] = (unsigned)(Rb * K + C) * 2u; voffB1[i] = voffB[i]; } }
    const size_t kstep = (size_t)(BK * 2);
    const size_t hstep = (size_t)HALF * K * 2;
    const size_t tstep = 2 * hstep;
    const size_t hoff = Epi::PERM16 ? 0 : hstep;
    const unsigned ldsw = (unsigned)wid * 1024u;
    const int aoff = lds_byte(wr * 64 + fr, fq * 8), boff = lds_byte(wc * 32 + fr, fq * 8);
#define PG8_SA(b, h) (((b) * 2 + (h)) * HTB)
#define PG8_SB(b, h) ((4 + (b) * 2 + (h)) * HTB)
#define PG8_STAGE(bufoff, gbase, voff) do { _Pragma("unroll") for (int _i = 0; _i < 2; ++_i) \
        __builtin_amdgcn_global_load_lds((const unsigned*)((const char*)(gbase) + (voff)[_i]), (LAS unsigned*)(lds + (bufoff) + ldsw + _i * 8192), 16, 0, 0); } while (0)
#define PG8_LDA(dst, b, h) do { _Pragma("unroll") for (int m = 0; m < 4; ++m) _Pragma("unroll") for (int k = 0; k < 2; ++k) dst[m][k] = *(const LAS bf16x8*)(lds + PG8_SA(b, h) + aoff + m * 2048 + k * 1024); } while (0)
#define PG8_LDB(dst, b, h) do { _Pragma("unroll") for (int n = 0; n < 2; ++n) _Pragma("unroll") for (int k = 0; k < 2; ++k) dst[n][k] = *(const LAS bf16x8*)(lds + PG8_SB(b, h) + boff + n * 2048 + k * 1024); } while (0)
#define PG8_MMA(ai, bj, At, Bt) do { __builtin_amdgcn_s_setprio(1); _Pragma("unroll") for (int m = 0; m < 4; ++m) _Pragma("unroll") for (int n = 0; n < 2; ++n) _Pragma("unroll") for (int k = 0; k < 2; ++k) \
        acc[ai][bj][m][n] = SWAP ? __builtin_amdgcn_mfma_f32_16x16x32_bf16(At[m][k], Bt[n][k], acc[ai][bj][m][n], 0, 0, 0) \
                                 : __builtin_amdgcn_mfma_f32_16x16x32_bf16(Bt[n][k], At[m][k], acc[ai][bj][m][n], 0, 0, 0); __builtin_amdgcn_s_setprio(0); } while (0)
#define PG8_WAIT_V(n) asm volatile("s_waitcnt vmcnt(" #n ")" ::: "memory")
#define PG8_WAIT_L(n) asm volatile("s_waitcnt lgkmcnt(" #n ")" ::: "memory")
#define PG8_BAR __builtin_amdgcn_s_barrier()
#define PG8_SCHED __builtin_amdgcn_sched_barrier(0)
    Unit cur, nxt; int ui = 0;
    if (!S.next(0, cur)) return;
    f32x4 acc[2][2][4][2];
#pragma unroll
    for (int a = 0; a < 2; ++a)
#pragma unroll
        for (int b = 0; b < 2; ++b)
#pragma unroll
            for (int m = 0; m < 4; ++m)
#pragma unroll
                for (int n = 0; n < 2; ++n) acc[a][b][m][n] = (f32x4){0.f, 0.f, 0.f, 0.f};
    bf16x8 At[4][2], B0[2][2], B1[2][2];
    const char* cA = (const char*)g.A + (size_t)cur.pm * tstep; const char* cB = (const char*)g.Bt + (size_t)cur.pn * tstep;
    PG8_STAGE(PG8_SB(0, 0), cB, voffB); PG8_STAGE(PG8_SA(0, 0), cA, voffA); PG8_STAGE(PG8_SB(0, 1), cB + hoff, voffB1); PG8_STAGE(PG8_SA(0, 1), cA + hstep, voffA);
    if (wr == 1) PG8_BAR;
    PG8_WAIT_V(4); PG8_BAR;
    PG8_STAGE(PG8_SB(1, 0), cB + kstep, voffB); PG8_STAGE(PG8_SA(1, 0), cA + kstep, voffA); PG8_STAGE(PG8_SB(1, 1), cB + hoff + kstep, voffB1);
    PG8_WAIT_V(6); PG8_BAR;
    for (;;) {
        const bool has_next = S.next(ui + 1, nxt);
        const char* nA = has_next ? (const char*)g.A + (size_t)nxt.pm * tstep : cA; const char* nB = has_next ? (const char*)g.Bt + (size_t)nxt.pn * tstep : cB;
        for (int t = 0; t < nt; t += 2) {
            const bool last = (t == nt - 2);
            const char* a1 = cA + (size_t)(t + 1) * kstep;
            const char* a2 = last ? nA : cA + (size_t)(t + 2) * kstep; const char* b2 = last ? nB : cB + (size_t)(t + 2) * kstep;
            const char* a3 = a2 + kstep; const char* b3 = b2 + kstep;
            PG8_LDB(B0, 0, 0); PG8_SCHED; PG8_LDA(At, 0, 0); PG8_STAGE(PG8_SA(1, 1), a1 + hstep, voffA);
            PG8_WAIT_L(8); PG8_BAR; PG8_WAIT_L(0); PG8_MMA(0, 0, At, B0); PG8_BAR; PG8_SCHED;
            PG8_LDB(B1, 0, 1); PG8_STAGE(PG8_SB(0, 0), b2, voffB);
            PG8_BAR; PG8_WAIT_L(0); PG8_MMA(0, 1, At, B1); PG8_BAR;
            PG8_LDA(At, 0, 1); PG8_STAGE(PG8_SA(0, 0), a2, voffA);
            PG8_BAR; PG8_WAIT_L(0); PG8_MMA(1, 0, At, B0); PG8_BAR; PG8_SCHED;
            PG8_STAGE(PG8_SB(0, 1), b2 + hoff, voffB1);
            PG8_WAIT_V(6); PG8_BAR; PG8_MMA(1, 1, At, B1); PG8_BAR;
            PG8_LDB(B0, 1, 0); PG8_SCHED; PG8_LDA(At, 1, 0); PG8_STAGE(PG8_SA(0, 1), a2 + hstep, voffA);
            PG8_WAIT_L(8); PG8_BAR; PG8_WAIT_L(0); PG8_MMA(0, 0, At, B0); PG8_BAR; PG8_SCHED;
            PG8_LDB(B1, 1, 1); PG8_STAGE(PG8_SB(1, 0), b3, voffB);
            PG8_BAR; PG8_WAIT_L(0); PG8_MMA(0, 1, At, B1); PG8_BAR;
            PG8_LDA(At, 1, 1); PG8_STAGE(PG8_SA(1, 0), a3, voffA);
            PG8_BAR; PG8_WAIT_L(0); PG8_MMA(1, 0, At, B0); PG8_BAR; PG8_SCHED;
            PG8_STAGE(PG8_SB(1, 1), b3 + hoff, voffB1);
            PG8_WAIT_V(6); PG8_BAR; PG8_MMA(1, 1, At, B1); PG8_BAR;
        }
        if constexpr (!Epi::AFTER_DRAIN) E(acc, cur, wr, wc, fr, fq);
        if (!has_next) break;
#pragma unroll
        for (int a = 0; a < 2; ++a)
#pragma unroll
            for (int b = 0; b < 2; ++b)
#pragma unroll
                for (int m = 0; m < 4; ++m)
#pragma unroll
                    for (int n = 0; n < 2; ++n) acc[a][b][m][n] = (f32x4){0.f, 0.f, 0.f, 0.f};
        cur = nxt; cA = nA; cB = nB; ++ui;
    }
    PG8_WAIT_V(0);
    if (wr == 0) PG8_BAR;
    PG8_BAR;
    if constexpr (Epi::AFTER_DRAIN) E.fused(acc, cur, wr, wc, fr, fq);
#undef PG8_SA
#undef PG8_SB
#undef PG8_STAGE
#undef PG8_LDA
#undef PG8_LDB
#undef PG8_MMA
#undef PG8_WAIT_V
#undef PG8_WAIT_L
#undef PG8_BAR
#undef PG8_SCHED
}
}

DI int win_src_col(int n0) {
    if (n0 < 2048) return n0;
    if (n0 < 2560) return 2056 + (n0 - 2048);
    if (n0 < 3072) return 3592 + (n0 - 2560);
    if (n0 < 3584) return 2568 + (n0 - 3072);
    return 3080 + (n0 - 3584);
}
DI void phase_prep(const Params& p, LAS unsigned char* lds) {
    int tid = threadIdx.x; asm volatile("" : "+v"(tid));
    const int lane = tid & 63, wid = tid >> 6;
    if (blockIdx.x == 0 && wid == 0) {
        float a = p.lq1[lane] * p.lk1[lane], b = p.lq2[lane] * p.lk2[lane];
        a = wave_sum(a); b = wave_sum(b);
        if (lane == 0) { *(float*)(p.ws + OFF_MISC) = expf(a) - expf(b) + 0.2f; *(unsigned*)(p.ws + OFF_MISC + 4) = 0u; *(unsigned*)(p.ws + OFF_MISC + 8) = 0u; *(unsigned*)(p.ws + OFF_MISC + 12) = 0u; }
    }
    bf16_t* hb = (bf16_t*)(p.ws + OFF_HB);
    float* gbga = (float*)(p.ws + OFF_GBGA);
    const int gw = blockIdx.x * 8 + wid, nw = gridDim.x * 8;
    {
        f32x4 nwv[4]; float wq[16][8];
#pragma unroll
        for (int i = 0; i < 4; ++i) {
            nwv[i] = ((const f32x4*)p.norm_w)[lane + 64 * i];
#pragma unroll
            for (int e = 0; e < 4; ++e) {
                const int k = 4 * (lane + 64 * i) + e;
                const f32x4* wp = (const f32x4*)(p.w_in + (size_t)k * 4104 + 2048);
                const f32x4 w0 = wp[0], w1 = wp[1];
#pragma unroll
                for (int j = 0; j < 4; ++j) { wq[4 * i + e][j] = nwv[i][e] * w0[j]; wq[4 * i + e][4 + j] = nwv[i][e] * w1[j]; }
            }
        }
        const bool b5 = (lane & 32) != 0, b4 = (lane & 16) != 0, b3 = (lane & 8) != 0;
        const int col = (b5 ? 4 : 0) + (b4 ? 2 : 0) + (b3 ? 1 : 0);
        int row = gw;
        f32x4 v[4];
        if (row < MTOK) {
#pragma unroll
            for (int i = 0; i < 4; ++i) v[i] = __builtin_nontemporal_load((const f32x4*)(p.x + (size_t)row * DM) + lane + 64 * i);
        }
#pragma unroll 1
        for (; row < MTOK; row += nw) {
            f32x4 vnx[4];
            const int rnx = (row + nw < MTOK) ? row + nw : row;
#pragma unroll
            for (int i = 0; i < 4; ++i) vnx[i] = __builtin_nontemporal_load((const f32x4*)(p.x + (size_t)rnx * DM) + lane + 64 * i);
            float ss = 0.f, a8[8];
#pragma unroll
            for (int j = 0; j < 8; ++j) a8[j] = 0.f;
#pragma unroll
            for (int i = 0; i < 4; ++i)
#pragma unroll
                for (int e = 0; e < 4; ++e) {
                    ss += v[i][e] * v[i][e];
#pragma unroll
                    for (int j = 0; j < 8; ++j) a8[j] += v[i][e] * wq[4 * i + e][j];
                }
            ss = wave_sum(ss);
            const float rstd = rsqrtf(ss * (1.0f / DM) + EPS);
#pragma unroll
            for (int i = 0; i < 4; ++i) {
                const f32x4 h = v[i] * rstd * nwv[i];
                u32x2 w; w.x = pk_bf16(h[0], h[1]); w.y = pk_bf16(h[2], h[3]);
                *(u32x2*)(hb + (size_t)row * DM + 4 * (lane + 64 * i)) = w;
            }
            float c4[4], c2[2], c1;
#pragma unroll
            for (int j = 0; j < 4; ++j) { const float send = b5 ? a8[j] : a8[4 + j], keep = b5 ? a8[4 + j] : a8[j]; c4[j] = keep + __shfl_xor(send, 32); }
#pragma unroll
            for (int j = 0; j < 2; ++j) { const float send = b4 ? c4[j] : c4[2 + j], keep = b4 ? c4[2 + j] : c4[j]; c2[j] = keep + __shfl_xor(send, 16); }
            { const float send = b3 ? c2[0] : c2[1], keep = b3 ? c2[1] : c2[0]; c1 = keep + __shfl_xor(send, 8); }
            c1 += __shfl_xor(c1, 4); c1 += __shfl_xor(c1, 2); c1 += __shfl_xor(c1, 1);
            if ((lane & 7) == 0) gbga[(size_t)row * 8 + col] = c1 * rstd;
#pragma unroll
            for (int i = 0; i < 4; ++i) v[i] = vnx[i];
        }
    }
    LAS float* tl = (LAS float*)lds;
    for (int tile = blockIdx.x; tile < 1024 + 256; tile += gridDim.x) {
        const float* src; int ld, n0, k0, srcn0; bf16_t* dst;
        if (tile < 1024) { n0 = (tile >> 4) * 64; k0 = (tile & 15) * 64; srcn0 = win_src_col(n0); src = p.w_in; ld = 4104; dst = (bf16_t*)(p.ws + OFF_WINT); }
        else { const int t2 = tile - 1024; n0 = (t2 >> 4) * 64; k0 = (t2 & 15) * 64; srcn0 = n0; src = p.w_out; ld = 1024; dst = (bf16_t*)(p.ws + OFF_WOUTT); }
        const int kk = tid >> 4, n4 = tid & 15;
#pragma unroll
        for (int ps = 0; ps < 2; ++ps) { const int k = kk + 32 * ps;
            const f32x4 v = __builtin_nontemporal_load((const f32x4*)(src + (size_t)(k0 + k) * ld + srcn0 + 4 * n4));
#pragma unroll
            for (int e = 0; e < 4; ++e) tl[k * 65 + 4 * n4 + e] = v[e]; }
        __syncthreads();
        { const int n = tid >> 3, k8 = tid & 7; float f[8];
#pragma unroll
            for (int e = 0; e < 8; ++e) f[e] = tl[(8 * k8 + e) * 65 + n];
            u32x4 w; w.x = pk_bf16(f[0], f[1]); w.y = pk_bf16(f[2], f[3]); w.z = pk_bf16(f[4], f[5]); w.w = pk_bf16(f[6], f[7]);
            *(u32x4*)(dst + (size_t)(n0 + n) * 1024 + k0 + 8 * k8) = w; }
        __syncthreads();
    }
}

constexpr int AT_KB = 8192, AT_VB = 16384, AT_BUF = AT_KB + AT_VB, AT_NBUF = 3, AT_TASK = AT_NBUF * AT_BUF, AT_O1 = AT_TASK + 256;

DI void attn_qblock(const Params& p, LAS unsigned char* lds, int b, int hh, int qb, float lam) {
    int tid = threadIdx.x; asm volatile("" : "+v"(tid));
    const int lane = tid & 63, wid = __builtin_amdgcn_readfirstlane(tid >> 6);
    const bf16_t* P1 = (const bf16_t*)(p.ws + OFF_P1);
    const bf16_t* VT = (const bf16_t*)(p.ws + OFF_VT) + (size_t)(b * 4 + hh) * 32 * 128 * 64;
    const bf16_t* KX = (const bf16_t*)(p.ws + OFF_KX) + (size_t)(b * 4 + hh) * 2 * 2048 * 64;
    bf16_t* mix = (bf16_t*)(p.ws + OFF_HB);
    const int q0 = qb * 256 + wid * 32;
    const size_t tokbase = (size_t)b * SEQ;
    const int nkt = (qb + 1) * 4;
    const float sl2 = exp2f(-2.0f * (float)(hh + 1)) * LOG2E;
    const float c1 = 0.125f * LOG2E;
#pragma unroll 1
    for (int map = 0; map < 2; ++map) {
        f32x16 O[4];
#pragma unroll
        for (int mt = 0; mt < 4; ++mt)
#pragma unroll
            for (int i = 0; i < 16; ++i) O[mt][i] = 0.f;
        float m = -INFINITY, l = 0.f;
        int lane_m = lane; asm volatile("" : "+v"(lane_m));
        const int r = lane_m & 31, h2 = lane_m >> 5;
        int foff[4];
#pragma unroll
        for (int k = 0; k < 4; ++k) foff[k] = r * 128 + (((2 * k + h2) ^ ((r >> 1) & 7)) << 4);
        float kb[16];
#pragma unroll
        for (int i = 0; i < 16; ++i) kb[i] = sl2 * (float)crow(i, h2);
        const int krow_ = 8 * wid + (lane_m >> 3), vrow0 = 16 * wid + (lane_m >> 3), vrow1 = vrow0 + 8;
        const bf16_t* kgp = KX + ((size_t)map * 2048 + krow_) * 64 + (((lane_m & 7) ^ ((krow_ >> 1) & 7)) * 8);
        const bf16_t* vgp0 = VT + (size_t)vrow0 * 64 + (((lane_m & 7) ^ ((vrow0 >> 1) & 7)) * 8);
        const bf16_t* vgp1 = VT + (size_t)vrow1 * 64 + (((lane_m & 7) ^ ((vrow1 >> 1) & 7)) * 8);
#define AT_STAGE(bufi, tile) do { LAS unsigned char* _b = lds + (bufi) * AT_BUF; \
            __builtin_amdgcn_global_load_lds((const unsigned*)(kgp + (size_t)(tile) * 64 * 64), (LAS unsigned*)(_b + wid * 1024), 16, 0, 0); \
            __builtin_amdgcn_global_load_lds((const unsigned*)(vgp0 + (size_t)(tile) * 128 * 64), (LAS unsigned*)(_b + AT_KB + wid * 2048), 16, 0, 0); \
            __builtin_amdgcn_global_load_lds((const unsigned*)(vgp1 + (size_t)(tile) * 128 * 64), (LAS unsigned*)(_b + AT_KB + wid * 2048 + 1024), 16, 0, 0); } while (0)
        bf16x8 qf[4];
        { const bf16_t* qp = P1 + (tokbase + q0 + (lane_m & 31)) * NP1 + C_DQ + hh * 128 + map * 64 + 8 * (lane_m >> 5);
#pragma unroll
            for (int ks = 0; ks < 4; ++ks) qf[ks] = *(const bf16x8*)(qp + 16 * ks); }
        AT_STAGE(0, 0);
        AT_STAGE(1, 1);
        asm volatile("" : "+v"(qf[0]), "+v"(qf[1]), "+v"(qf[2]), "+v"(qf[3]));
        int cb = 0;
#pragma unroll 1
        for (int kt = 0; kt < nkt; ++kt) {
            asm volatile("s_waitcnt vmcnt(0)" ::: "memory");
            __builtin_amdgcn_s_barrier();
            asm volatile("" ::: "memory");
            if (kt + 2 < nkt) { const int nb = cb == 0 ? 2 : cb - 1; AT_STAGE(nb, kt + 2); }
            const LAS unsigned char* cur = lds + cb * AT_BUF;
            cb = cb == 2 ? 0 : cb + 1;
            const int k0 = kt * 64;
            if (k0 <= q0) {
                const bool sub1 = (k0 + 32 <= q0);
                const LAS unsigned char* vb = cur + AT_KB;
                bf16x8 kf[8];
#pragma unroll
                for (int ks = 0; ks < 4; ++ks) kf[ks] = *(const LAS bf16x8*)(cur + foff[ks]);
                if (sub1) {
#pragma unroll
                    for (int ks = 0; ks < 4; ++ks) kf[4 + ks] = *(const LAS bf16x8*)(cur + 4096 + foff[ks]);
                }
                f32x16 s0, s1;
#pragma unroll
                for (int i = 0; i < 16; ++i) { s0[i] = 0.f; s1[i] = 0.f; }
#pragma unroll
                for (int ks = 0; ks < 4; ++ks) s0 = MFMA32(kf[ks], qf[ks], s0);
                if (sub1) {
#pragma unroll
                    for (int ks = 0; ks < 4; ++ks) s1 = MFMA32(kf[4 + ks], qf[ks], s1);
                }
                __builtin_amdgcn_sched_barrier(0);
                bf16x8 va[8];
#pragma unroll
                for (int s2 = 0; s2 < 2; ++s2)
#pragma unroll
                    for (int mt = 0; mt < 4; ++mt) va[s2 * 4 + mt] = *(const LAS bf16x8*)(vb + mt * 4096 + foff[s2]);
                __builtin_amdgcn_sched_barrier(0);
                const float off0 = sl2 * (float)(k0 - q0), off1 = off0 + 32.0f * sl2;
                const f32x2 c1v = {c1, c1};
#pragma unroll
                for (int j = 0; j < 8; ++j) {
                    const f32x2 kv = {kb[2 * j], kb[2 * j + 1]};
                    f32x2 a = {s0[2 * j], s0[2 * j + 1]}, c = {s1[2 * j], s1[2 * j + 1]};
                    a = __builtin_elementwise_fma(a, c1v, kv); c = __builtin_elementwise_fma(c, c1v, kv);
                    s0[2 * j] = a.x; s0[2 * j + 1] = a.y; s1[2 * j] = c.x; s1[2 * j + 1] = c.y;
                }
                if (k0 == q0) {
#pragma unroll
                    for (int i = 0; i < 16; ++i) if (crow(i, h2) > r) s0[i] = -INFINITY;
                }
                if (k0 + 32 == q0) {
#pragma unroll
                    for (int i = 0; i < 16; ++i) if (crow(i, h2) > r) s1[i] = -INFINITY;
                }
                float mx0 = fmaxf(s0[0], s0[1]), mx1 = fmaxf(s1[0], s1[1]);
#pragma unroll
                for (int j = 1; j < 8; ++j) { mx0 = fmaxf(fmaxf(s0[2 * j], s0[2 * j + 1]), mx0); mx1 = fmaxf(fmaxf(s1[2 * j], s1[2 * j + 1]), mx1); }
                float mx = sub1 ? fmaxf(mx0 + off0, mx1 + off1) : mx0 + off0;
                mx = xhalf_max(mx);
                if (__builtin_amdgcn_ballot_w64(mx > m + 8.0f) != 0ull) {
                    const float mn = fmaxf(m, mx);
                    const float alpha = __builtin_amdgcn_exp2f(m - mn);
                    m = mn; l *= alpha;
#pragma unroll
                    for (int mt = 0; mt < 4; ++mt)
#pragma unroll
                        for (int i = 0; i < 16; ++i) O[mt][i] *= alpha;
                }
                const float r0 = m - off0, r1 = sub1 ? m - off1 : INFINITY;
                const f32x2 r0v = {r0, r0}, r1v = {r1, r1};
                f32x2 lsv = {0.f, 0.f};
#pragma unroll
                for (int j = 0; j < 8; ++j) {
                    f32x2 a = {s0[2 * j], s0[2 * j + 1]}, c = {s1[2 * j], s1[2 * j + 1]};
                    a = a - r0v; c = c - r1v;
                    a.x = __builtin_amdgcn_exp2f(a.x); a.y = __builtin_amdgcn_exp2f(a.y); c.x = __builtin_amdgcn_exp2f(c.x); c.y = __builtin_amdgcn_exp2f(c.y);
                    lsv = lsv + a; lsv = lsv + c;
                    s0[2 * j] = a.x; s0[2 * j + 1] = a.y; s1[2 * j] = c.x; s1[2 * j + 1] = c.y;
                }
                l += lsv.x + lsv.y;
                bf16x8 pf[4];
#pragma unroll
                for (int s = 0; s < 2; ++s) { pf[s] = pack8(s0, s); pf[2 + s] = pack8(s1, s); }
                __builtin_amdgcn_sched_barrier(0);
                bf16x8 vc[4], vd[4];
                if (sub1) {
#pragma unroll
                    for (int mt = 0; mt < 4; ++mt) vc[mt] = *(const LAS bf16x8*)(vb + mt * 4096 + foff[2]);
                }
#pragma unroll
                for (int mt = 0; mt < 4; ++mt) O[mt] = MFMA32(va[mt], pf[0], O[mt]);
                if (sub1) {
#pragma unroll
                    for (int mt = 0; mt < 4; ++mt) vd[mt] = *(const LAS bf16x8*)(vb + mt * 4096 + foff[3]);
                }
#pragma unroll
                for (int mt = 0; mt < 4; ++mt) O[mt] = MFMA32(va[4 + mt], pf[1], O[mt]);
                if (sub1) {
#pragma unroll
                    for (int mt = 0; mt < 4; ++mt) O[mt] = MFMA32(vc[mt], pf[2], O[mt]);
#pragma unroll
                    for (int mt = 0; mt < 4; ++mt) O[mt] = MFMA32(vd[mt], pf[3], O[mt]);
                }
            }
        }
        asm volatile("" ::: "memory");
        __builtin_amdgcn_s_barrier();
        asm volatile("" ::: "memory");
#undef AT_STAGE
        const float lt = xhalf_sum(l);
        int lane_o = lane; asm volatile("" : "+v"(lane_o));
        LAS unsigned* o1l = (LAS unsigned*)(lds + AT_O1 + wid * 8192) + lane_o;
        if (map == 0) {
            const float inv1 = 1.0f / lt;
#pragma unroll
            for (int mt = 0; mt < 4; ++mt)
#pragma unroll
                for (int j = 0; j < 8; ++j) o1l[(mt * 8 + j) * 64] = pk_bf16(O[mt][2 * j] * inv1, O[mt][2 * j + 1] * inv1);
        } else {
            const float inv2 = lam / lt;
            float ss = 0.f;
#pragma unroll
            for (int mt = 0; mt < 4; ++mt)
#pragma unroll
                for (int j = 0; j < 8; ++j) {
                    const unsigned o1 = o1l[(mt * 8 + j) * 64];
                    const float a = bf_lo(o1) - O[mt][2 * j] * inv2, c = bf_hi(o1) - O[mt][2 * j + 1] * inv2;
                    O[mt][2 * j] = a; O[mt][2 * j + 1] = c; ss += a * a + c * c;
                }
            ss = xhalf_sum(ss);
            const float rs = rsqrtf(ss * (1.0f / 128.0f) + EPS) * 0.8f;
#pragma unroll
            for (int mt = 0; mt < 4; ++mt)
#pragma unroll
                for (int j = 0; j < 8; ++j) o1l[(mt * 8 + j) * 64] = pk_bf16(O[mt][2 * j] * rs, O[mt][2 * j + 1] * rs);
            __builtin_amdgcn_wave_barrier();
            int lane_e = lane; asm volatile("" : "+v"(lane_e));
            const int dvg = lane_e & 15, qs = lane_e >> 4;
            const f32x4 nw0 = *(const f32x4*)(p.diff_norm_w + 8 * dvg), nw1 = *(const f32x4*)(p.diff_norm_w + 8 * dvg + 4);
            const LAS unsigned* ob = (const LAS unsigned*)(lds + AT_O1 + wid * 8192);
            const int slot = (dvg >> 2) * 8 + 2 * (dvg & 3);
            u32x4 dzv[8];
#pragma unroll
            for (int it = 0; it < 8; ++it) dzv[it] = *(const u32x4*)(P1 + (tokbase + q0 + it * 4 + qs) * NP1 + C_DZ + hh * 128 + 8 * dvg);
#pragma unroll
            for (int it = 0; it < 8; ++it) {
                const int q = it * 4 + qs; const size_t row = tokbase + q0 + q;
                const unsigned u0 = ob[slot * 64 + q], u1 = ob[(slot + 1) * 64 + q], u2 = ob[slot * 64 + q + 32], u3 = ob[(slot + 1) * 64 + q + 32];
                const u32x4 dz = dzv[it];
                u32x4 w;
                w.x = pk_bf16(bf_lo(u0) * nw0[0] * silu_f(bf_lo(dz.x)), bf_hi(u0) * nw0[1] * silu_f(bf_hi(dz.x)));
                w.y = pk_bf16(bf_lo(u1) * nw0[2] * silu_f(bf_lo(dz.y)), bf_hi(u1) * nw0[3] * silu_f(bf_hi(dz.y)));
                w.z = pk_bf16(bf_lo(u2) * nw1[0] * silu_f(bf_lo(dz.z)), bf_hi(u2) * nw1[1] * silu_f(bf_hi(dz.z)));
                w.w = pk_bf16(bf_lo(u3) * nw1[2] * silu_f(bf_lo(dz.w)), bf_hi(u3) * nw1[3] * silu_f(bf_hi(dz.w)));
                *(u32x4*)(mix + row * DM + 512 + hh * 128 + 8 * dvg) = w;
            }
            __builtin_amdgcn_wave_barrier();
        }
    }
}

DI void phase_attn(const Params& p, LAS unsigned char* lds, int rep) {
    const float lam = *(const float*)(p.ws + OFF_MISC);
    unsigned* counter = (unsigned*)(p.ws + OFF_MISC + 4 + 4 * rep);
    LAS int* tslot = (LAS int*)(lds + AT_TASK);
    for (;;) {
        if (threadIdx.x == 0) *tslot = (int)atomicAdd(counter, 1u);
        __syncthreads();
        const int t = *tslot;
        __syncthreads();
        if (t >= 512) break;
        const int qb = 7 - (t >> 6), bh = t & 63;
        attn_qblock(p, lds, bh >> 2, bh & 3, qb, lam);
    }
}


constexpr int G_QN = 0, G_KN = 17408, G_VB = 34816, G_KBG = 52224, G_M = 69632, G_T = 86016, G_SM = 95232;
DI bf16x8 tr_pair(const LAS unsigned char* lo_addr, int hi_off) {
    const s16x4 lo = __builtin_amdgcn_ds_read_tr16_b64_v4i16((LAS s16x4*)(lo_addr));
    const s16x4 hi = __builtin_amdgcn_ds_read_tr16_b64_v4i16((LAS s16x4*)(lo_addr + hi_off));
    return __builtin_shufflevector(lo, hi, 0, 1, 2, 3, 4, 5, 6, 7);
}
DI bf16_t bf16_1(float v) { return (bf16_t)(pk_bf16(v, 0.f) & 0xffffu); }

DI void gdn_gates(const Params& p, LAS float* sm, int c2, int lane) {
    const int b = c2 >> 7, hh = (c2 >> 5) & 3, n = c2 & 31;
    const size_t tok0 = (size_t)b * SEQ + (size_t)n * 64;
    const float* gg = (const float*)(p.ws + OFF_GBGA) + (tok0 + lane) * 8;
    const float gbv = gg[hh], gav = gg[4 + hh];
    const float beta = 1.0f / (1.0f + expf(-gbv));
    const float xs = gav + p.dt_bias[hh];
    const float sp = fmaxf(xs, 0.f) + log1pf(expf(-fabsf(xs)));
    float gc = -expf(p.a_log[hh]) * sp;
#pragma unroll
    for (int o = 1; o < 64; o <<= 1) { const float t = __shfl_up(gc, o); if (lane >= o) gc += t; }
    const float gl = __shfl(gc, 63);
    sm[lane] = beta; sm[64 + lane] = gc * LOG2E; sm[128 + lane] = expf(gc); sm[192 + lane] = expf(gl - gc);
    if (lane == 63) ((float*)(p.ws + OFF_GL))[c2] = expf(gl);
}

DI void gdn_prep(const Params& p, LAS unsigned char* lds, int c2, int c2next, int par) {
    int tid = threadIdx.x; asm volatile("" : "+v"(tid));
    const int lane = tid & 63, wid = __builtin_amdgcn_readfirstlane(tid >> 6), r = lane & 31, h2 = lane >> 5;
    const int b = c2 >> 7, hh = (c2 >> 5) & 3, n = c2 & 31;
    const size_t tok0 = (size_t)b * SEQ + (size_t)n * 64;
    const bf16_t* P1 = (const bf16_t*)(p.ws + OFF_P1);
    LAS float* sm = (LAS float*)(lds + G_SM + par * 1024);
    LAS float* Mf = (LAS float*)(lds + G_M);
    bf16_t* WN = (bf16_t*)(p.ws + OFF_WN) + (size_t)c2 * 8192;
    bf16_t* QD = (bf16_t*)(p.ws + OFF_QD) + (size_t)c2 * 8192;
    bf16_t* KD = (bf16_t*)(p.ws + OFF_KD) + (size_t)c2 * 8192;
    bf16_t* AQ = (bf16_t*)(p.ws + OFF_AQK) + (size_t)c2 * 4096;
    float* U = (float*)(p.ws + OFF_U) + (size_t)c2 * 8192;
    u32x4 raw[6][4];
#pragma unroll
    for (int i = 0; i < 6; ++i) {
        const int item = tid + 512 * i, g = item & 15, t = (item >> 4) & 63, part = i >> 1;
        const int ch = part * 512 + hh * 128 + g * 8;
#pragma unroll
        for (int j = 0; j < 4; ++j) {
            const int tt = n * 64 + t - 3 + j, ttc = tt < 0 ? 0 : tt;
            raw[i][j] = *(const u32x4*)(P1 + ((size_t)b * SEQ + ttc) * NP1 + ch);
            if (tt < 0) raw[i][j] = (u32x4){0u, 0u, 0u, 0u};
        }
    }
    float av[6][8];
#pragma unroll
    for (int i = 0; i < 6; ++i) {
        const int item = tid + 512 * i, g = item & 15, part = i >> 1;
        const int ch = part * 512 + hh * 128 + g * 8;
        float a[8];
#pragma unroll
        for (int e = 0; e < 8; ++e) a[e] = 0.f;
#pragma unroll
        for (int j = 0; j < 4; ++j) {
            const f32x4 w0 = *(const f32x4*)(p.conv_w + j * 1536 + ch), w1 = *(const f32x4*)(p.conv_w + j * 1536 + ch + 4);
            const u32x4 rw = raw[i][j];
            a[0] += w0[0] * bf_lo(rw.x); a[1] += w0[1] * bf_hi(rw.x); a[2] += w0[2] * bf_lo(rw.y); a[3] += w0[3] * bf_hi(rw.y);
            a[4] += w1[0] * bf_lo(rw.z); a[5] += w1[1] * bf_hi(rw.z); a[6] += w1[2] * bf_lo(rw.w); a[7] += w1[3] * bf_hi(rw.w);
        }
        float ss = 0.f;
#pragma unroll
        for (int e = 0; e < 8; ++e) { a[e] = silu_f(a[e]); ss += a[e] * a[e]; }
        float rn = 1.0f;
        if (part < 2) {
            ss += __shfl_xor(ss, 1); ss += __shfl_xor(ss, 2); ss += __shfl_xor(ss, 4); ss += __shfl_xor(ss, 8);
            rn = rsqrtf(ss + 1e-6f) * (part == 0 ? 0.08838834764831845f : 1.0f);
        }
#pragma unroll
        for (int e = 0; e < 8; ++e) av[i][e] = a[e] * rn;
    }
#pragma unroll
    for (int i = 0; i < 6; ++i) {
        const int item = tid + 512 * i, g = item & 15, t = (item >> 4) & 63, part = i >> 1;
        const float* a = av[i];
        const float beta = sm[t], egc = sm[128 + t], ekd = sm[192 + t];
        if (part < 2) {
            u32x4 w; w.x = pk_bf16(a[0], a[1]); w.y = pk_bf16(a[2], a[3]); w.z = pk_bf16(a[4], a[5]); w.w = pk_bf16(a[6], a[7]);
            *(LAS u32x4*)(lds + (part == 0 ? G_QN : G_KN) + t * 272 + g * 16) = w;
            if (part == 0) {
                u32x2 lo, hi; lo.x = pk_bf16(a[0] * egc, a[1] * egc); lo.y = pk_bf16(a[2] * egc, a[3] * egc); hi.x = pk_bf16(a[4] * egc, a[5] * egc); hi.y = pk_bf16(a[6] * egc, a[7] * egc);
                bf16_t* qd = QD + t * 128 + 16 * (g >> 1) + 4 * (g & 1);
                *(u32x2*)qd = lo; *(u32x2*)(qd + 8) = hi;
            } else {
                const float f1 = beta * egc;
                u32x4 w2; w2.x = pk_bf16(a[0] * f1, a[1] * f1); w2.y = pk_bf16(a[2] * f1, a[3] * f1); w2.z = pk_bf16(a[4] * f1, a[5] * f1); w2.w = pk_bf16(a[6] * f1, a[7] * f1);
                *(LAS u32x4*)(lds + G_KBG + t * 272 + g * 16) = w2;
                u32x4 w3; w3.x = pk_bf16(a[0] * ekd, a[1] * ekd); w3.y = pk_bf16(a[2] * ekd, a[3] * ekd); w3.z = pk_bf16(a[4] * ekd, a[5] * ekd); w3.w = pk_bf16(a[6] * ekd, a[7] * ekd);
                *(u32x4*)(KD + t * 128 + g * 8) = w3;
            }
        } else {
            u32x4 w; w.x = pk_bf16(a[0] * beta, a[1] * beta); w.y = pk_bf16(a[2] * beta, a[3] * beta); w.z = pk_bf16(a[4] * beta, a[5] * beta); w.w = pk_bf16(a[6] * beta, a[7] * beta);
            *(LAS u32x4*)(lds + G_VB + t * 272 + g * 16) = w;
        }
    }
    __syncthreads();
    {
        const int w4 = wid & 3, mt = w4 >> 1, nt = w4 & 1; const bool isqk = wid >= 4;
        if (!(mt == 0 && nt == 1)) {
            const LAS unsigned char* Ab = lds + (isqk ? G_QN : G_KN) + (32 * mt + r) * 272 + 16 * h2;
            const LAS unsigned char* Bb = lds + G_KN + (32 * nt + r) * 272 + 16 * h2;
            bf16x8 fa[8], fb[8];
#pragma unroll
            for (int ks = 0; ks < 8; ++ks) { fa[ks] = *(const LAS bf16x8*)(Ab + 32 * ks); fb[ks] = *(const LAS bf16x8*)(Bb + 32 * ks); }
            f32x16 X;
#pragma unroll
            for (int i = 0; i < 16; ++i) X[i] = 0.f;
            if (!isqk) {
#pragma unroll
                for (int ks = 0; ks < 8; ++ks) X = MFMA32(fa[ks], fb[ks], X);
                const int s = 32 * nt + r; const float gcs = sm[64 + s];
                float gv[16], bv[16];
#pragma unroll
                for (int i = 0; i < 16; ++i) { const int c = 32 * mt + crow(i, h2); gv[i] = sm[64 + c]; bv[i] = sm[c]; }
#pragma unroll
                for (int i = 0; i < 16; ++i) {
                    const int c = 32 * mt + crow(i, h2);
                    const float dec = __builtin_amdgcn_exp2f(fminf(gv[i] - gcs, 0.f));
                    const float val = bv[i] * X[i] * dec;
                    Mf[c * 64 + s] = (c > s) ? val : 0.f;
                }
            } else {
#pragma unroll
                for (int ks = 0; ks < 8; ++ks) X = MFMA32(fb[ks], fa[ks], X);
                const int c = 32 * mt + r; const float gcc = sm[64 + c];
                float gv[16];
#pragma unroll
                for (int i = 0; i < 16; ++i) gv[i] = sm[64 + 32 * nt + crow(i, h2)];
#pragma unroll
                for (int g4 = 0; g4 < 4; ++g4) {
                    const int s0 = 32 * nt + 8 * g4 + 4 * h2;
                    float v[4];
#pragma unroll
                    for (int e = 0; e < 4; ++e) { const int sx = s0 + e; const float dec = __builtin_amdgcn_exp2f(fminf(gcc - gv[4 * g4 + e], 0.f)); const float val = X[4 * g4 + e] * dec; v[e] = (c >= sx) ? val : 0.f; }
                    u32x2 w; w.x = pk_bf16(v[0], v[1]); w.y = pk_bf16(v[2], v[3]);
                    *(u32x2*)(AQ + c * 64 + perm23(s0)) = w;
                }
            }
        }
    }
    __syncthreads();
    if (wid == 0) {
        LAS bf16_t* Tb = (LAS bf16_t*)(lds + G_T);
        {
            const int c16 = lane & 15, b16 = lane >> 4;
            const LAS float* Mb = Mf + (16 * b16) * 64 + 16 * b16;
            float T[16];
#pragma unroll
            for (int i = 0; i < 16; ++i) T[i] = 0.f;
#pragma unroll
            for (int i = 0; i < 16; ++i) {
                float a0 = (i == c16) ? 1.f : 0.f, a1 = 0.f, a2 = 0.f, a3 = 0.f;
#pragma unroll
                for (int s4 = 0; s4 < (i + 3) / 4; ++s4) {
                    const f32x4 m4 = *(const LAS f32x4*)(Mb + i * 64 + 4 * s4);
                    a0 -= m4[0] * T[4 * s4]; a1 -= m4[1] * T[4 * s4 + 1]; a2 -= m4[2] * T[4 * s4 + 2]; a3 -= m4[3] * T[4 * s4 + 3];
                }
                T[i] = (a0 + a1) + (a2 + a3);
            }
#pragma unroll
            for (int i = 0; i < 16; ++i) {
                const int row = 16 * b16 + i;
                Tb[row * 72 + 16 * b16 + c16] = bf16_1(T[i]);
                if ((b16 & 1) == 0) Tb[row * 72 + 16 * b16 + 16 + c16] = 0;
                if (b16 < 2) { Tb[row * 72 + 32 + c16] = 0; Tb[row * 72 + 48 + c16] = 0; }
            }
        }
        __builtin_amdgcn_wave_barrier();
        asm volatile("s_waitcnt lgkmcnt(0)" ::: "memory");
        {
            const int qd = r >> 4, rr = r & 15;
            bf16x8 mfrag;
            { const LAS float* mp = Mf + (16 + 32 * qd + rr) * 64 + 32 * qd + 8 * h2;
              const f32x4 m0 = *(const LAS f32x4*)mp, m1 = *(const LAS f32x4*)(mp + 4);
              u32x4 aw; aw.x = pk_bf16(m0[0], m0[1]); aw.y = pk_bf16(m0[2], m0[3]); aw.z = pk_bf16(m1[0], m1[1]); aw.w = pk_bf16(m1[2], m1[3]);
              mfrag = __builtin_bit_cast(bf16x8, aw); }
            bf16x8 tfrag;
#pragma unroll
            for (int j = 0; j < 8; ++j) tfrag[j] = (short)Tb[(32 * qd + 8 * h2 + j) * 72 + 32 * qd + rr];
            bf16x8 t2frag;
            { const LAS unsigned char* tp = lds + G_T + (16 + 32 * qd + rr) * 144 + (16 + 32 * qd + 4 * h2) * 2;
              const u32x2 lo = *(const LAS u32x2*)tp, hi = *(const LAS u32x2*)(tp + 16);
              u32x4 aw; aw.x = lo.x; aw.y = lo.y; aw.z = hi.x; aw.w = hi.y; t2frag = __builtin_bit_cast(bf16x8, aw); }
            const bf16x8 zf = {0, 0, 0, 0, 0, 0, 0, 0};
            f32x16 Y1, Z1;
#pragma unroll
            for (int i = 0; i < 16; ++i) { Y1[i] = 0.f; Z1[i] = 0.f; }
#pragma unroll
            for (int ks = 0; ks < 2; ++ks) Y1 = MFMA32(qd == ks ? mfrag : zf, qd == ks ? tfrag : zf, Y1);
#pragma unroll
            for (int s2 = 0; s2 < 2; ++s2) Z1 = MFMA32(qd == s2 ? t2frag : zf, pack8(Y1, s2), Z1);
#pragma unroll
            for (int i = 0; i < 16; ++i) {
                const int row = crow(i, h2);
                if ((row >> 4) == qd) Tb[(16 + 32 * qd + (row & 15)) * 72 + 32 * qd + rr] = bf16_1(-Z1[i]);
            }
        }
        __builtin_amdgcn_wave_barrier();
        asm volatile("s_waitcnt lgkmcnt(0)" ::: "memory");
        const int i16 = lane & 15, q = i16 >> 2, pp = i16 & 3, blk = (lane >> 4) & 1;
        f32x16 Y;
#pragma unroll
        for (int i = 0; i < 16; ++i) Y[i] = 0.f;
#pragma unroll
        for (int ks = 0; ks < 2; ++ks) {
            const LAS float* mp = Mf + (32 + r) * 64 + 16 * ks + 8 * h2;
            const f32x4 m0 = *(const LAS f32x4*)mp, m1 = *(const LAS f32x4*)(mp + 4);
            u32x4 aw; aw.x = pk_bf16(m0[0], m0[1]); aw.y = pk_bf16(m0[2], m0[3]); aw.z = pk_bf16(m1[0], m1[1]); aw.w = pk_bf16(m1[2], m1[3]);
            const bf16x8 bfrag = tr_pair(lds + G_T + (16 * ks + 8 * h2 + q) * 144 + (16 * blk + 4 * pp) * 2, 4 * 144);
            Y = MFMA32(__builtin_bit_cast(bf16x8, aw), bfrag, Y);
        }
        f32x16 Z;
#pragma unroll
        for (int i = 0; i < 16; ++i) Z[i] = 0.f;
#pragma unroll
        for (int s = 0; s < 2; ++s) {
            const LAS unsigned char* tp = lds + G_T + (32 + r) * 144 + (32 + 16 * s + 4 * h2) * 2;
            const u32x2 lo = *(const LAS u32x2*)tp, hi = *(const LAS u32x2*)(tp + 16);
            u32x4 aw; aw.x = lo.x; aw.y = lo.y; aw.z = hi.x; aw.w = hi.y;
            Z = MFMA32(__builtin_bit_cast(bf16x8, aw), pack8(Y, s), Z);
        }
#pragma unroll
        for (int i = 0; i < 16; ++i) Tb[(32 + crow(i, h2)) * 72 + r] = bf16_1(-Z[i]);
    } else if (wid == 1) {
        if (c2next < 2048) gdn_gates(p, (LAS float*)(lds + G_SM + (par ^ 1) * 1024), c2next, lane);
    }
    __syncthreads();
    {
        const int mt = wid >> 2, nt = wid & 3;
        const int i16 = lane & 15, q = i16 >> 2, pp = i16 & 3, blk = (lane >> 4) & 1;
        bf16x8 af[4], vf[4], kf[4];
#pragma unroll
        for (int ks = 0; ks < 4; ++ks) {
            if (ks < 2 * (mt + 1)) {
                af[ks] = *(const LAS bf16x8*)(lds + G_T + (32 * mt + r) * 144 + (16 * ks + 8 * h2) * 2);
                const int boff = (16 * ks + 8 * h2 + q) * 272 + (32 * nt + 16 * blk + 4 * pp) * 2;
                vf[ks] = tr_pair(lds + G_VB + boff, 4 * 272);
                kf[ks] = tr_pair(lds + G_KBG + boff, 4 * 272);
            }
        }
        f32x16 Xu, Xw;
#pragma unroll
        for (int i = 0; i < 16; ++i) { Xu[i] = 0.f; Xw[i] = 0.f; }
#pragma unroll
        for (int ks = 0; ks < 4; ++ks) {
            if (ks < 2 * (mt + 1)) {
                Xu = MFMA32(af[ks], vf[ks], Xu);
                Xw = MFMA32(kf[ks], af[ks], Xw);
            }
        }
        {
            float* up = U + (nt * 2 + mt) * 1024 + lane * 4;
#pragma unroll
            for (int k = 0; k < 4; ++k) { const f32x4 v = {Xu[4 * k], Xu[4 * k + 1], Xu[4 * k + 2], Xu[4 * k + 3]}; *(f32x4*)(up + 256 * k) = v; }
        }
        const int c = 32 * mt + r;
#pragma unroll
        for (int g4 = 0; g4 < 4; ++g4) {
            const int d0 = 32 * nt + 8 * g4 + 4 * h2;
            u32x2 w; w.x = pk_bf16(-Xw[4 * g4], -Xw[4 * g4 + 1]); w.y = pk_bf16(-Xw[4 * g4 + 2], -Xw[4 * g4 + 3]);
            *(u32x2*)(WN + c * 128 + perm23(d0)) = w;
        }
    }
    __syncthreads();
}

constexpr int S_WN = 0, S_QD = 17408, S_KD = 34816, S_AQ = 52224, S_BUF = 61440, S_STG = 2 * S_BUF;

struct GateIn { u32x4 z0, z1; };
DI void scan_gate_load(const Params& p, int tid, int b, int hh, int n, GateIn& g) {
    const int gc_ = tid >> 3, seg = tid & 7;
    const bf16_t* P1 = (const bf16_t*)(p.ws + OFF_P1);
    const size_t row = (size_t)b * SEQ + n * 64 + gc_;
    g.z0 = *(const u32x4*)(P1 + row * NP1 + C_GZ + hh * 128 + seg * 8); g.z1 = *(const u32x4*)(P1 + row * NP1 + C_GZ + hh * 128 + 64 + seg * 8);
}
DI void scan_gate(const Params& p, LAS unsigned char* lds, int tid, int b, int hh, int n, const GateIn& g) {
    const int gc_ = tid >> 3, seg = tid & 7;
    bf16_t* mix = (bf16_t*)(p.ws + OFF_HB);
    const LAS float* st = (const LAS float*)(lds + S_STG) + gc_ * 132 + seg * 8;
    f32x4 ov[4]; float ss = 0.f;
#pragma unroll
    for (int k = 0; k < 4; ++k) { ov[k] = *(const LAS f32x4*)(st + (k >> 1) * 64 + 4 * (k & 1)); ss += ov[k][0] * ov[k][0] + ov[k][1] * ov[k][1] + ov[k][2] * ov[k][2] + ov[k][3] * ov[k][3]; }
    ss += __shfl_xor(ss, 1); ss += __shfl_xor(ss, 2); ss += __shfl_xor(ss, 4);
    const float rstd = rsqrtf(ss * (1.0f / 128.0f) + EPS);
    const size_t row = (size_t)b * SEQ + n * 64 + gc_;
    const u32x4 z0 = g.z0, z1 = g.z1;
    f32x4 gnw[4];
#pragma unroll
    for (int k = 0; k < 4; ++k) gnw[k] = *(const f32x4*)(p.gdn_norm_w + seg * 8 + (k >> 1) * 64 + 4 * (k & 1));
    u32x4 w0, w1;
    w0.x = pk_bf16(ov[0][0] * rstd * gnw[0][0] * silu_f(bf_lo(z0.x)), ov[0][1] * rstd * gnw[0][1] * silu_f(bf_hi(z0.x)));
    w0.y = pk_bf16(ov[0][2] * rstd * gnw[0][2] * silu_f(bf_lo(z0.y)), ov[0][3] * rstd * gnw[0][3] * silu_f(bf_hi(z0.y)));
    w0.z = pk_bf16(ov[1][0] * rstd * gnw[1][0] * silu_f(bf_lo(z0.z)), ov[1][1] * rstd * gnw[1][1] * silu_f(bf_hi(z0.z)));
    w0.w = pk_bf16(ov[1][2] * rstd * gnw[1][2] * silu_f(bf_lo(z0.w)), ov[1][3] * rstd * gnw[1][3] * silu_f(bf_hi(z0.w)));
    w1.x = pk_bf16(ov[2][0] * rstd * gnw[2][0] * silu_f(bf_lo(z1.x)), ov[2][1] * rstd * gnw[2][1] * silu_f(bf_hi(z1.x)));
    w1.y = pk_bf16(ov[2][2] * rstd * gnw[2][2] * silu_f(bf_lo(z1.y)), ov[2][3] * rstd * gnw[2][3] * silu_f(bf_hi(z1.y)));
    w1.z = pk_bf16(ov[3][0] * rstd * gnw[3][0] * silu_f(bf_lo(z1.z)), ov[3][1] * rstd * gnw[3][1] * silu_f(bf_hi(z1.z)));
    w1.w = pk_bf16(ov[3][2] * rstd * gnw[3][2] * silu_f(bf_lo(z1.w)), ov[3][3] * rstd * gnw[3][3] * silu_f(bf_hi(z1.w)));
    bf16_t* mp = mix + row * DM + hh * 128 + seg * 8;
    *(u32x4*)mp = w0; *(u32x4*)(mp + 64) = w1;
}

struct ScanRegs { u32x4 t0[4], t1[4], t2[4], t3[2]; };
DI void scan_fetch(ScanRegs& R, const bf16_t* WN, const bf16_t* QD, const bf16_t* KD, const bf16_t* AQ, int ltid) {
#pragma unroll
    for (int i = 0; i < 4; ++i) { const int pi = ltid + 256 * i; R.t0[i] = *(const u32x4*)(WN + pi * 8); R.t1[i] = *(const u32x4*)(QD + pi * 8); R.t2[i] = *(const u32x4*)(KD + pi * 8); }
#pragma unroll
    for (int i = 0; i < 2; ++i) { const int pi = ltid + 256 * i; R.t3[i] = *(const u32x4*)(AQ + pi * 8); }
}
DI void scan_put(const ScanRegs& R, LAS unsigned char* dst, int ltid) {
#pragma unroll
    for (int i = 0; i < 4; ++i) { const int pi = ltid + 256 * i, row = pi >> 4, pc = pi & 15;
        *(LAS u32x4*)(dst + S_WN + row * 272 + pc * 16) = R.t0[i]; *(LAS u32x4*)(dst + S_QD + row * 272 + pc * 16) = R.t1[i]; *(LAS u32x4*)(dst + S_KD + row * 272 + pc * 16) = R.t2[i]; }
#pragma unroll
    for (int i = 0; i < 2; ++i) { const int pi = ltid + 256 * i, row = pi >> 3, pc = pi & 7; *(LAS u32x4*)(dst + S_AQ + row * 144 + pc * 16) = R.t3[i]; }
}

DI void gdn_scan(const Params& p, LAS unsigned char* lds, int bh) {
    int tid = threadIdx.x; asm volatile("" : "+v"(tid));
    const int lane = tid & 63, wid = __builtin_amdgcn_readfirstlane(tid >> 6), r = lane & 31, h2 = lane >> 5;
    const int b = bh >> 2, hh = bh & 3;
    const bf16_t* WN = (const bf16_t*)(p.ws + OFF_WN) + (size_t)bh * 32 * 8192;
    const bf16_t* QD = (const bf16_t*)(p.ws + OFF_QD) + (size_t)bh * 32 * 8192;
    const bf16_t* KD = (const bf16_t*)(p.ws + OFF_KD) + (size_t)bh * 32 * 8192;
    const bf16_t* AQ = (const bf16_t*)(p.ws + OFF_AQK) + (size_t)bh * 32 * 4096;
    const float* U = (const float*)(p.ws + OFF_U) + (size_t)bh * 32 * 8192;
    const float* GL = (const float*)(p.ws + OFF_GL) + bh * 32;
    if (wid >= 4) {
        const int ltid = tid & 255;
        ScanRegs R;
        scan_fetch(R, WN, QD, KD, AQ, ltid); scan_put(R, lds, ltid);
        scan_fetch(R, WN + 8192, QD + 8192, KD + 8192, AQ + 4096, ltid);
#pragma unroll 1
        for (int n = 0; n < 32; ++n) {
            __syncthreads();
            GateIn gi; scan_gate_load(p, tid, b, hh, n, gi);
            if (n + 1 < 32) scan_put(R, lds + ((n + 1) & 1) * S_BUF, ltid);
            if (n + 2 < 32) scan_fetch(R, WN + (size_t)(n + 2) * 8192, QD + (size_t)(n + 2) * 8192, KD + (size_t)(n + 2) * 8192, AQ + (size_t)(n + 2) * 4096, ltid);
            __syncthreads();
            scan_gate(p, lds, tid, b, hh, n, gi);
        }
    } else {
        const int i16 = lane & 15, q4 = i16 >> 2, pp = i16 & 3, blk = (lane >> 4) & 1;
        f32x16 St[4], u[2];
#pragma unroll
        for (int k = 0; k < 4; ++k)
#pragma unroll
            for (int i = 0; i < 16; ++i) St[k][i] = 0.f;
#pragma unroll
        for (int mt = 0; mt < 2; ++mt)
#pragma unroll
            for (int k = 0; k < 4; ++k) { const f32x4 v = *(const f32x4*)(U + (wid * 2 + mt) * 1024 + 256 * k + lane * 4); u[mt][4 * k] = v[0]; u[mt][4 * k + 1] = v[1]; u[mt][4 * k + 2] = v[2]; u[mt][4 * k + 3] = v[3]; }
#pragma unroll 1
        for (int n = 0; n < 32; ++n) {
            LAS unsigned char* buf = lds + (n & 1) * S_BUF;
            __syncthreads();
            GateIn gi; scan_gate_load(p, tid, b, hh, n, gi);
            const float egl = GL[n];
            f32x16 vn[2], o[2];
            vn[0] = u[0]; vn[1] = u[1];
#pragma unroll
            for (int mt = 0; mt < 2; ++mt)
#pragma unroll
                for (int i = 0; i < 16; ++i) o[mt][i] = 0.f;
#pragma unroll
            for (int ks = 0; ks < 8; ++ks) {
                const bf16x8 sf = pack8(St[ks >> 1], ks & 1);
#pragma unroll
                for (int mt = 0; mt < 2; ++mt) {
                    const bf16x8 wf = *(const LAS bf16x8*)(buf + S_WN + (32 * mt + r) * 272 + (16 * ks + 8 * h2) * 2);
                    vn[mt] = MFMA32(wf, sf, vn[mt]);
                    const bf16x8 qf = *(const LAS bf16x8*)(buf + S_QD + (32 * mt + r) * 272 + (16 * ks + 8 * h2) * 2);
                    o[mt] = MFMA32(qf, sf, o[mt]);
                }
                asm volatile("" ::: "memory");
            }
            bf16x8 vf[4];
#pragma unroll
            for (int k2 = 0; k2 < 4; ++k2) vf[k2] = pack8(vn[k2 >> 1], k2 & 1);
            {
                const int nn = (n + 1 < 32) ? n + 1 : n;
                const float* up = U + (size_t)nn * 8192 + (wid * 2) * 1024 + lane * 4;
#pragma unroll
                for (int mt = 0; mt < 2; ++mt)
#pragma unroll
                    for (int k = 0; k < 4; ++k) { const f32x4 v = *(const f32x4*)(up + mt * 1024 + 256 * k); u[mt][4 * k] = v[0]; u[mt][4 * k + 1] = v[1]; u[mt][4 * k + 2] = v[2]; u[mt][4 * k + 3] = v[3]; }
            }
#pragma unroll
            for (int mt = 0; mt < 2; ++mt)
#pragma unroll
                for (int k2 = 0; k2 < 2 * (mt + 1); ++k2) {
                    const bf16x8 af = *(const LAS bf16x8*)(buf + S_AQ + (32 * mt + r) * 144 + (16 * k2 + 8 * h2) * 2);
                    o[mt] = MFMA32(af, vf[k2], o[mt]);
                }
            {
                LAS float* st = (LAS float*)(lds + S_STG);
#pragma unroll
                for (int mt = 0; mt < 2; ++mt)
#pragma unroll
                    for (int i = 0; i < 16; ++i) st[(32 * mt + crow(i, h2)) * 132 + 32 * wid + r] = o[mt][i];
            }
#pragma unroll
            for (int kt = 0; kt < 4; ++kt) {
#pragma unroll
                for (int i = 0; i < 16; ++i) St[kt][i] *= egl;
#pragma unroll
                for (int k2 = 0; k2 < 4; ++k2) {
                    const bf16x8 kf = tr_pair(buf + S_KD + (16 * k2 + 4 * h2 + q4) * 272 + (32 * kt + 16 * blk + 4 * pp) * 2, 8 * 272);
                    St[kt] = MFMA32(kf, vf[k2], St[kt]);
                }
                asm volatile("" ::: "memory");
            }
            __syncthreads();
            scan_gate(p, lds, tid, b, hh, n, gi);
        }
    }
    __syncthreads();
}

DI void zero_mix_half(const Params& p, int half) {
    bf16_t* mix = (bf16_t*)(p.ws + OFF_HB);
    const size_t n16 = (size_t)MTOK * 64;
    for (size_t i = (size_t)blockIdx.x * 512 + threadIdx.x; i < n16; i += (size_t)gridDim.x * 512) {
        const size_t row = i >> 6, pc = i & 63;
        *(u32x4*)(mix + row * DM + half * 512 + pc * 8) = (u32x4){0u, 0u, 0u, 0u};
    }
}

DI void phase_final(const Params& p) {
    int tid = threadIdx.x; asm volatile("" : "+v"(tid));
    const int lane = tid & 63, wid = tid >> 6;
    const float* rowsq = (const float*)(p.ws + OFF_ROWSQ);
    const bf16_t* yb = (const bf16_t*)(p.ws + OFF_YB);
    const int gw = blockIdx.x * 8 + wid, nw = gridDim.x * 8;
    f32x4 fw[4];
#pragma unroll
    for (int i = 0; i < 2; ++i) { fw[2 * i] = *(const f32x4*)(p.final_norm_w + 512 * i + 8 * lane); fw[2 * i + 1] = *(const f32x4*)(p.final_norm_w + 512 * i + 8 * lane + 4); }
#pragma unroll 1
    for (int row0 = gw; row0 < MTOK; row0 += 4 * nw) {
        u32x4 y[4][2]; float sq[4];
#pragma unroll
        for (int k = 0; k < 4; ++k) {
            const int row = row0 + k * nw, rc = row < MTOK ? row : row0;
#pragma unroll
            for (int i = 0; i < 2; ++i) y[k][i] = *(const u32x4*)(yb + (size_t)rc * DM + 512 * i + 8 * lane);
            sq[k] = lane < 16 ? rowsq[(size_t)rc * 16 + lane] : 0.f;
        }
#pragma unroll
        for (int k = 0; k < 4; ++k) {
            const int row = row0 + k * nw;
            const float ss = wave_sum(sq[k]);
            const float rstd = rsqrtf(ss * (1.0f / DM) + EPS);
            if (row < MTOK) {
                float* o = p.out + (size_t)row * DM;
#pragma unroll
                for (int i = 0; i < 2; ++i) {
                    const f32x4 a = {bf_lo(y[k][i].x), bf_hi(y[k][i].x), bf_lo(y[k][i].y), bf_hi(y[k][i].y)}, c = {bf_lo(y[k][i].z), bf_hi(y[k][i].z), bf_lo(y[k][i].w), bf_hi(y[k][i].w)};
                    *(f32x4*)(o + 512 * i + 8 * lane) = a * rstd * fw[2 * i];
                    *(f32x4*)(o + 512 * i + 8 * lane + 4) = c * rstd * fw[2 * i + 1];
                }
            }
        }
    }
}

__global__ void __launch_bounds__(512) mega(Params p) {
    extern __shared__ __attribute__((aligned(16))) unsigned char shm[];
    LAS unsigned char* lds = (LAS unsigned char*)shm;
    cg::grid_group grid = cg::this_grid();
    volatile LAS unsigned* bst = (volatile LAS unsigned*)(lds + LDS_BYTES - 16);
    if (threadIdx.x < 2) bst[threadIdx.x] = 0u;
    __syncthreads();
    const XcdBarrier xb = xcd_barrier_post((unsigned*)(p.ws + OFF_BAR), bst);
    if (p.ws == nullptr) grid.sync();

#pragma unroll 1
    for (int rep = 0; rep < REP_PREP; ++rep) phase_prep(p, lds);
    xcd_barrier(xb);
#pragma unroll 1
    for (int rep = 0; rep < REP_G1; ++rep)
    {
        pg8::Gemm g{(const bf16_t*)(p.ws + OFF_HB), (const bf16_t*)(p.ws + OFF_WINT), MTOK, NG1, DM};
        pg8::StaticOrder S; S.init(g.M, g.N, (int)gridDim.x, (int)blockIdx.x);
        pg8::EpiP1 E{(bf16_t*)(p.ws + OFF_P1), NP1, (bf16_t*)(p.ws + OFF_KX)};
        pg8::gemm_phase<pg8::EpiP1, false>(lds, g, S, E);
        pg8::Gemm g2{(const bf16_t*)(p.ws + OFF_HB), (const bf16_t*)(p.ws + OFF_WINT) + (size_t)NG1 * DM, MTOK, 512, DM};
        pg8::StaticOrder S2; S2.init(g2.M, g2.N, (int)gridDim.x, (int)blockIdx.x);
        pg8::EpiVT E2{(bf16_t*)(p.ws + OFF_VT)};
        pg8::gemm_phase<pg8::EpiVT, true>(lds, g2, S2, E2);
    }
    xcd_barrier(xb);
#pragma unroll 1
    for (int rep = 0; rep < REP_GP; ++rep)
    {
        if ((threadIdx.x >> 6) == 0 && (int)blockIdx.x < 2048) gdn_gates(p, (LAS float*)(lds + G_SM), blockIdx.x, threadIdx.x & 63);
        __syncthreads();
        int par = 0;
#pragma unroll 1
        for (int c2 = blockIdx.x; c2 < 2048; c2 += gridDim.x, par ^= 1) gdn_prep(p, lds, c2, c2 + (int)gridDim.x, par);
    }
    xcd_barrier(xb);
#pragma unroll 1
    for (int rep = 0; rep < REP_P3; ++rep) {
#pragma unroll 1
        for (int r2 = 0; r2 < REP_SCAN; ++r2)
            if (blockIdx.x < 64) gdn_scan(p, lds, blockIdx.x);
#if SCAN_SYNC
        xcd_barrier(xb);
#endif
        phase_attn(p, lds, rep);
#if REP_ATTN > 1
        xcd_barrier(xb);
        phase_attn(p, lds, 2);
#endif
#if REP_P3 > 1
        xcd_barrier(xb);
#endif
    }
    xcd_barrier(xb);
#pragma unroll 1
    for (int rnd = 0; rnd < 2; ++rnd) {
        pg8::Gemm g{(const bf16_t*)(p.ws + OFF_HB), (const bf16_t*)(p.ws + OFF_WOUTT), MTOK, DM, DM};
        pg8::StaticOrder S; S.init(g.M, g.N, (int)gridDim.x, (int)blockIdx.x); S.i0 = rnd; S.imax = 1;
        pg8::EpiOutFused E{p.x, p.out, (float*)(p.ws + OFF_ROWSQ), p.final_norm_w, xb};
        pg8::Unit u0;
        if (S.next(0, u0)) pg8::gemm_phase<pg8::EpiOutFused, false>(lds, g, S, E);
        else xcd_barrier(xb);
    }
}

extern "C" void kernel_launch(void* const* d_in, const int* in_sizes, int n_in, void* d_out, int out_size, void* d_ws, size_t ws_size, hipStream_t stream) {
    static int grid = 0;
    if (grid == 0) {
        if (ws_size < WS_END) { fprintf(stderr, "kernel_launch: workspace too small (%zu < %zu)\n", ws_size, (size_t)WS_END); grid = -1; return; }
        int dev = 0, cus = 0, per_cu = 0;
        hipGetDevice(&dev);
        hipDeviceGetAttribute(&cus, hipDeviceAttributeMultiprocessorCount, dev);
        if (hipFuncSetAttribute((const void*)mega, hipFuncAttributeMaxDynamicSharedMemorySize, LDS_BYTES) != hipSuccess) { fprintf(stderr, "kernel_launch: hipFuncSetAttribute failed\n"); grid = -1; return; }
        if (hipOccupancyMaxActiveBlocksPerMultiprocessor(&per_cu, (const void*)mega, 512, LDS_BYTES) != hipSuccess || per_cu < 1) per_cu = 1;
        (void)hipGetLastError();
        grid = cus * (per_cu > 1 ? 1 : per_cu);
    }
    if (grid < 0) return;
    Params p{};
    p.x = (const float*)d_in[0]; p.norm_w = (const float*)d_in[1]; p.w_in = (const float*)d_in[2]; p.conv_w = (const float*)d_in[3];
    p.a_log = (const float*)d_in[4]; p.dt_bias = (const float*)d_in[5]; p.gdn_norm_w = (const float*)d_in[6];
    p.lq1 = (const float*)d_in[7]; p.lk1 = (const float*)d_in[8]; p.lq2 = (const float*)d_in[9]; p.lk2 = (const float*)d_in[10];
    p.diff_norm_w = (const float*)d_in[11]; p.w_out = (const float*)d_in[12]; p.final_norm_w = (const float*)d_in[13];
    p.out = (float*)d_out; p.ws = (unsigned char*)d_ws;
    if (hipMemsetAsync((unsigned char*)d_ws + OFF_BAR, 0, 16384, stream) != hipSuccess) { fprintf(stderr, "kernel_launch: hipMemsetAsync failed\n"); return; }
    void* args[] = {&p};
    hipError_t e = hipLaunchCooperativeKernel((const void*)mega, dim3(grid), dim3(512), args, LDS_BYTES, stream);
    if (e != hipSuccess) fprintf(stderr, "cooperative launch failed: %s (grid %d)\n", hipGetErrorString(e), grid);
}
```
